# Optimizing an MI355X kernel written in HIP

```python
import math
import jax
import jax.numpy as jnp
from jax import lax
import numpy as np


D_MODEL = 1024
BATCH = 2
SEQ = 16384
DEPTH = 2

N_META = 16
A_HEAD_DIM = 64
A_W = D_MODEL // 2
A_HEADS = A_W // A_HEAD_DIM
IDX_HEADS = 8
IDX_DIM = 64
TOPK_MAX = 256
B_HEAD_DIM = 64
B_HALF = B_HEAD_DIM // 2
B_W = D_MODEL // 4
B_HEADS = B_W // B_HEAD_DIM
C_HEAD_DIM = 64
C_W = D_MODEL // 4
C_HEADS = C_W // C_HEAD_DIM
RET_CHUNK = 128
ROPE_BASE = 10000.0
REL_BUCKETS = 32
REL_MAX_DIST = 128
D_FF = 4 * D_MODEL
Q_BLOCK = 128
EPS = 1e-6
IN_SIZES = (A_W, A_W, A_W, IDX_HEADS * IDX_DIM, IDX_DIM, IDX_HEADS, B_W, B_W, B_W, C_W, C_W, C_W, C_W)
IN_COLS = sum(IN_SIZES)

kernel_name = 'hybrid_dsa_diff_retention_block'


def _split_points():
    pts, acc = [], 0
    for s in IN_SIZES[:-1]:
        acc += s
        pts.append(acc)
    return pts


def rmsnorm(x, g):
    xf = x.astype(jnp.float32)
    y = xf * lax.rsqrt(jnp.mean(xf * xf, axis=-1, keepdims=True) + EPS)
    return (y * g.astype(jnp.float32)).astype(x.dtype)


def rel_bucket(dist):
    n = jnp.maximum(dist, 0)
    max_exact = REL_BUCKETS // 2
    nf = jnp.maximum(n, 1).astype(jnp.float32)
    large = max_exact + (jnp.log(nf / max_exact) / math.log(REL_MAX_DIST / max_exact)
                         * (REL_BUCKETS - max_exact)).astype(jnp.int32)
    large = jnp.minimum(large, REL_BUCKETS - 1)
    return jnp.where(n < max_exact, n, large)


def rotary(x, pos):
    d = x.shape[-1]
    inv = ROPE_BASE ** (-jnp.arange(0, d, 2, dtype=jnp.float32) / d)
    ang = pos.astype(jnp.float32)[:, None] * inv[None, :]
    cos = jnp.cos(ang)[None, :, None, :]
    sin = jnp.sin(ang)[None, :, None, :]
    xf = x.astype(jnp.float32)
    x1, x2 = xf[..., : d // 2], xf[..., d // 2:]
    return jnp.concatenate([x1 * cos - x2 * sin, x1 * sin + x2 * cos], axis=-1).astype(x.dtype)


def to_blocks(a, nblk):
    pad = nblk * Q_BLOCK - a.shape[1]
    a = jnp.pad(a, [(0, 0), (0, pad)] + [(0, 0)] * (a.ndim - 2))
    a = a.reshape((a.shape[0], nblk, Q_BLOCK) + a.shape[2:])
    return jnp.moveaxis(a, 1, 0)


def from_blocks(a, t_len):
    a = jnp.moveaxis(a, 0, 1)
    a = a.reshape((a.shape[0], -1) + a.shape[3:])
    return a[:, :t_len]


def sparse_indexer_attention(q, k, v, qi, ki, wi, bias_table, topk):
    bsz, t_len = q.shape[0], q.shape[1]
    nblk = -(-t_len // Q_BLOCK)
    key_pos = jnp.arange(t_len)
    scale = A_HEAD_DIM ** -0.5
    wi = wi.astype(jnp.float32) * (IDX_HEADS ** -0.5 * IDX_DIM ** -0.5)
    bidx = jnp.arange(bsz)[:, None]

    def body(xs):
        qb, qib, wib, start = xs
        qpos = start + jnp.arange(Q_BLOCK)
        causal = key_pos[None, :] <= qpos[:, None]
        dots = jax.nn.relu(jnp.einsum('bqhd,bsd->bqhs', qib, ki)).astype(jnp.float32)
        score = jnp.einsum('bqh,bqhs->bqs', wib, dots)
        score = jnp.where(causal[None], score, -jnp.inf)
        _, idx = lax.top_k(score, topk)
        flat = idx.reshape(bsz, Q_BLOCK * topk)
        kg = k[bidx, flat].reshape(bsz, Q_BLOCK, topk, A_HEADS, A_HEAD_DIM)
        vg = v[bidx, flat].reshape(bsz, Q_BLOCK, topk, A_HEADS, A_HEAD_DIM)
        dist = qpos[None, :, None] - idx
        bias = jnp.moveaxis(bias_table[rel_bucket(dist)], -1, 1).astype(jnp.float32)
        logits = jnp.einsum('bqhd,bqkhd->bhqk', qb, kg).astype(jnp.float32) * scale + bias
        logits = jnp.where((dist >= 0)[:, None], logits, -jnp.inf)
        p = jax.nn.softmax(logits, axis=-1).astype(v.dtype)
        return jnp.einsum('bhqk,bqkhd->bqhd', p, vg)

    starts = jnp.arange(nblk) * Q_BLOCK
    out = lax.map(body, (to_blocks(q, nblk), to_blocks(qi, nblk), to_blocks(wi, nblk), starts))
    return from_blocks(out, t_len)


def diff_attention(q, k, v, bias_table, lam):
    t_len = q.shape[1]
    nblk = -(-t_len // Q_BLOCK)
    key_pos = jnp.arange(t_len)
    scale = B_HALF ** -0.5

    def body(xs):
        qb, start = xs
        qpos = start + jnp.arange(Q_BLOCK)
        dist = qpos[:, None] - key_pos[None, :]
        bias = jnp.moveaxis(bias_table[rel_bucket(dist)], -1, 0).astype(jnp.float32)
        logits = jnp.einsum('bqhcd,bshcd->bchqs', qb, k).astype(jnp.float32) * scale + bias[None, None]
        logits = jnp.where(dist >= 0, logits, -jnp.inf)
        p = jax.nn.softmax(logits, axis=-1)
        w = (p[:, 0] - lam * p[:, 1]).astype(v.dtype)
        return jnp.einsum('bhqs,bshd->bqhd', w, v)

    starts = jnp.arange(nblk) * Q_BLOCK
    out = lax.map(body, (to_blocks(q, nblk), starts))
    return from_blocks(out, t_len)


def _retention_chunk(qc, kc, vc, state, log_gamma):
    L = qc.shape[1]
    i = jnp.arange(L, dtype=jnp.float32)
    diff = i[:, None] - i[None, :]
    dmat = jnp.where(diff >= 0, jnp.exp(log_gamma[:, None, None] * jnp.maximum(diff, 0.0)), 0.0)
    inner = jnp.einsum('bihd,bjhd->bhij', qc, kc) * dmat
    out = jnp.einsum('bhij,bjhe->bihe', inner, vc)
    q_decay = jnp.exp(log_gamma[None, :] * (i[:, None] + 1.0))
    out = out + jnp.einsum('bihd,bhde->bihe', qc, state) * q_decay[None, :, :, None]
    k_decay = jnp.exp(log_gamma[None, :] * (L - 1.0 - i[:, None]))
    state = state * jnp.exp(log_gamma * L)[None, :, None, None] + jnp.einsum('bjhd,jh,bjhe->bhde', kc, k_decay, vc)
    return out, state


def retention(q, k, v):
    bsz, t_len, nh, dk = q.shape
    dv = v.shape[-1]
    log_gamma = jnp.log1p(-jnp.exp2(-5.0 - jnp.arange(nh, dtype=jnp.float32)))
    qf = q.astype(jnp.float32)
    kf = k.astype(jnp.float32) * (dk ** -0.5)
    vf = v.astype(jnp.float32)
    state0 = jnp.zeros((bsz, nh, dk, dv), jnp.float32)
    out_meta, state = _retention_chunk(qf[:, :N_META], kf[:, :N_META], vf[:, :N_META], state0, log_gamma)
    nc = (t_len - N_META) // RET_CHUNK

    def to_chunks(a):
        return jnp.moveaxis(a[:, N_META:].reshape(bsz, nc, RET_CHUNK, nh, a.shape[-1]), 1, 0)

    def step(s, xs):
        qc, kc, vc = xs
        o, s = _retention_chunk(qc, kc, vc, s, log_gamma)
        return s, o

    _, outs = lax.scan(step, state, (to_chunks(qf), to_chunks(kf), to_chunks(vf)))
    out_real = jnp.moveaxis(outs, 0, 1).reshape(bsz, nc * RET_CHUNK, nh, dv)
    return jnp.concatenate([out_meta, out_real], axis=1)


def setup_inputs(seed: int = 0) -> dict:
    key = jax.random.key(seed)
    ks = jax.random.split(key, 16)

    def nrm(k, shape, scale):
        return jax.random.normal(k, shape, jnp.float32) * scale

    return {
        'x': nrm(ks[0], (BATCH, SEQ, D_MODEL), 1.0),
        'meta': nrm(ks[1], (N_META, D_MODEL), 1.0),
        'rel_bias': nrm(ks[2], (REL_BUCKETS, A_HEADS + B_HEADS), 0.5),
        'w_in': nrm(ks[3], (DEPTH, D_MODEL, IN_COLS), D_MODEL ** -0.5),
        'norm_mix': 1.0 + nrm(ks[4], (DEPTH, D_MODEL), 0.01),
        'diff_lambda': nrm(ks[5], (DEPTH, 4, B_HALF), 0.1),
        'diff_norm': 1.0 + nrm(ks[6], (DEPTH, B_HEAD_DIM), 0.01),
        'ret_norm': 1.0 + nrm(ks[7], (DEPTH, C_W), 0.01),
        'w_out': nrm(ks[8], (DEPTH, D_MODEL, D_MODEL), 0.5 * D_MODEL ** -0.5),
        'norm_ff': 1.0 + nrm(ks[9], (DEPTH, D_MODEL), 0.01),
        'w_ff1': nrm(ks[10], (DEPTH, D_MODEL, D_FF), D_MODEL ** -0.5),
        'w_ff2': nrm(ks[11], (DEPTH, D_FF, D_MODEL), 0.5 * D_FF ** -0.5),
        'final_norm': 1.0 + nrm(ks[12], (D_MODEL,), 0.01),
    }


def reference(x, meta, rel_bias, w_in, norm_mix, diff_lambda, diff_norm, ret_norm, w_out, norm_ff, w_ff1, w_ff2, final_norm):
    bsz, s_len, _ = x.shape
    t_len = s_len + N_META
    topk = min(TOPK_MAX, s_len // 4)
    h = jnp.concatenate([jnp.broadcast_to(meta.astype(x.dtype)[None], (bsz, N_META, D_MODEL)), x], axis=1)
    pos = jnp.arange(t_len)
    split_pts = _split_points()
    bias_a = rel_bias[:, :A_HEADS]
    bias_b = rel_bias[:, A_HEADS:]
    for l in range(DEPTH):
        u = rmsnorm(h, norm_mix[l])
        proj = u @ w_in[l]
        (qa, ka, va, qi, ki, wi, qb, kb, vb, qc, kc, vc, gc) = jnp.split(proj, split_pts, axis=-1)

        a_out = sparse_indexer_attention(
            qa.reshape(bsz, t_len, A_HEADS, A_HEAD_DIM),
            ka.reshape(bsz, t_len, A_HEADS, A_HEAD_DIM),
            va.reshape(bsz, t_len, A_HEADS, A_HEAD_DIM),
            qi.reshape(bsz, t_len, IDX_HEADS, IDX_DIM), ki, wi, bias_a, topk,
        ).reshape(bsz, t_len, A_W)

        lambda_init = 0.8 - 0.6 * math.exp(-0.3 * l)
        lp = diff_lambda[l].astype(jnp.float32)
        lam = jnp.exp(jnp.sum(lp[0] * lp[1])) - jnp.exp(jnp.sum(lp[2] * lp[3])) + lambda_init
        b_heads = diff_attention(
            qb.reshape(bsz, t_len, B_HEADS, 2, B_HALF),
            kb.reshape(bsz, t_len, B_HEADS, 2, B_HALF),
            vb.reshape(bsz, t_len, B_HEADS, B_HEAD_DIM), bias_b, lam,
        )
        b_out = (rmsnorm(b_heads, diff_norm[l]) * (1.0 - lambda_init)).reshape(bsz, t_len, B_W)

        qcr = rotary(qc.reshape(bsz, t_len, C_HEADS, C_HEAD_DIM), pos)
        kcr = rotary(kc.reshape(bsz, t_len, C_HEADS, C_HEAD_DIM), pos)
        ret = retention(qcr, kcr, vc.reshape(bsz, t_len, C_HEADS, C_HEAD_DIM)).astype(h.dtype)
        ret = rmsnorm(ret, ret_norm[l].reshape(C_HEADS, C_HEAD_DIM)).reshape(bsz, t_len, C_W)
        c_out = jax.nn.silu(gc) * ret

        h = h + jnp.concatenate([a_out, b_out, c_out], axis=-1) @ w_out[l]
        u = rmsnorm(h, norm_ff[l])
        h = h + jnp.square(jax.nn.relu(u @ w_ff1[l])) @ w_ff2[l]
    return rmsnorm(h, final_norm)[:, N_META:]
```

```cpp
#include <hip/hip_runtime.h>
#include <cstdio>
#include <cstdint>
typedef _Float16 h8 __attribute__((ext_vector_type(8)));
typedef _Float16 h4 __attribute__((ext_vector_type(4)));
typedef _Float16 h2 __attribute__((ext_vector_type(2)));
typedef short s16x8 __attribute__((ext_vector_type(8)));
typedef short s16x4 __attribute__((ext_vector_type(4)));
typedef float f32x16 __attribute__((ext_vector_type(16)));
typedef float f32x2 __attribute__((ext_vector_type(2)));
typedef unsigned u32x2 __attribute__((ext_vector_type(2)));
namespace pg8 {
#define PG8_LAS __attribute__((address_space(3)))
typedef unsigned short bf16_t;
typedef short bf16x8 __attribute__((ext_vector_type(8)));
typedef float f32x4 __attribute__((ext_vector_type(4)));
typedef unsigned u32x4 __attribute__((ext_vector_type(4)));
constexpr int BM = 256, BK = 64, HALF = 128, HTB = HALF * BK * 2  , STAGE_BYTES = 8 * HTB, NXCD = 8, WGM = 8;

__host__ __device__ __forceinline__ int lds_byte(int r, int c) { const int st = (r >> 4) * 2 + (c >> 5), rr = r & 15, cc = c & 31, ob = rr * 64 + cc * 2; return st * 1024 + (ob ^ (((ob >> 9) & 1) << 5)); }
__host__ __device__ __forceinline__ void stage_rc(int b, int& R, int& C) { const int st = b / 1024, sb = b % 1024, swz = sb ^ (((sb >> 9) & 1) << 5); R = (st >> 1) * 16 + swz / 64; C = (st & 1) * 32 + (swz % 64) / 2; }
__host__ __device__ __forceinline__ int perm32(int rho) { const int n = rho >> 4, i = rho & 15; return 8 * (i >> 2) + 4 * n + (i & 3); }

struct Unit { int pm, pn; };
struct Gemm { const bf16_t* A; const bf16_t* Bt; int M, N, K; };

struct StaticOrder {
    int nM, nN, nwg, G, c;
    __host__ __device__ void init(int M, int N, int G_, int c_) { nM = M / BM; nN = N / BM; nwg = nM * nN; G = G_; c = c_; }
    __host__ __device__ bool next(int i, Unit& u) const {
        const long L = (long)i * G + c; if (L >= nwg) return false;
        int wgid = (int)L; { const int q = nwg / NXCD, r = nwg % NXCD, xcd = wgid % NXCD, off = wgid / NXCD; wgid = (xcd < r ? xcd * (q + 1) : r * (q + 1) + (xcd - r) * q) + off; }
        const int nig = WGM * nN, gid = wgid / nig, fm = gid * WGM, gsz = (nM - fm) < WGM ? (nM - fm) : WGM;
        u.pm = fm + ((wgid % nig) % gsz); u.pn = (wgid % nig) / gsz; return true;
    }
    __device__ __forceinline__ void a_ready(const Unit&) const {}
    __device__ __forceinline__ void done(const Unit&) const {}
};

template <class Epi, class Sched, bool STAMP = false>
__device__ __forceinline__ void gemm_phase(PG8_LAS unsigned char* lds, const Gemm g, const Sched& S, const Epi& E, unsigned long long* stamps) {
    int tid_ = threadIdx.x; asm volatile("" : "+v"(tid_));
    const int tid = tid_, wid = __builtin_amdgcn_readfirstlane(tid >> 6), lane = tid & 63, wr = wid >> 2, wc = wid & 3, fr = lane & 15, fq = lane >> 4;
    const int K = g.K, nt = K / BK;
    int ts_lo = 0, ts_hi = 0, nts = 0; const unsigned long long rt_entry = STAMP ? (unsigned long long)wall_clock64() : 0ull;
#define PG8_STAMP() do { if (STAMP && wid == 0 && nts < 64) { const unsigned long long _c = (unsigned long long)clock64(); \
        ts_lo = (lane == nts) ? (int)(unsigned)_c : ts_lo; ts_hi = (lane == nts) ? (int)(unsigned)(_c >> 32) : ts_hi; ++nts; } } while (0)
    PG8_STAMP();
    unsigned voffA[2], voffB[2];
#pragma unroll
    for (int i = 0; i < 2; ++i) { int R, C; stage_rc(tid * 16 + i * 8192, R, C); const int Rb = Epi::PERM ? ((R & ~31) + perm32(R & 31)) : R;
        voffA[i] = (unsigned)(R * K + C) * 2u; voffB[i] = (unsigned)(Rb * K + C) * 2u; }
    const size_t kstep = (size_t)(BK * 2);
    const size_t hstep = (size_t)HALF * K * 2;
    const size_t tstep = 2 * hstep;
    const unsigned ldsw = (unsigned)wid * 1024u;
    const int aoff = lds_byte(wr * 64 + fr, fq * 8), boff = lds_byte(wc * 32 + fr, fq * 8);
#define PG8_SA(b, h) (((b) * 2 + (h)) * HTB)
#define PG8_SB(b, h) ((4 + (b) * 2 + (h)) * HTB)
#define PG8_STAGE(bufoff, gbase, voff) do { _Pragma("unroll") for (int _i = 0; _i < 2; ++_i) \
        __builtin_amdgcn_global_load_lds((const unsigned*)((const char*)(gbase) + (voff)[_i]), (PG8_LAS unsigned*)(lds + (bufoff) + ldsw + _i * 8192), 16, 0, 0); } while (0)
#define PG8_LDA(dst, b, h) do { _Pragma("unroll") for (int m = 0; m < 4; ++m) _Pragma("unroll") for (int k = 0; k < 2; ++k) dst[m][k] = *(const PG8_LAS bf16x8*)(lds + PG8_SA(b, h) + aoff + m * 2048 + k * 1024); } while (0)
#define PG8_LDB(dst, b, h) do { _Pragma("unroll") for (int n = 0; n < 2; ++n) _Pragma("unroll") for (int k = 0; k < 2; ++k) dst[n][k] = *(const PG8_LAS bf16x8*)(lds + PG8_SB(b, h) + boff + n * 2048 + k * 1024); } while (0)
#define PG8_MMA(ai, bj, At, Bt) do { __builtin_amdgcn_s_setprio(1); _Pragma("unroll") for (int m = 0; m < 4; ++m) _Pragma("unroll") for (int n = 0; n < 2; ++n) _Pragma("unroll") for (int k = 0; k < 2; ++k) \
        acc[ai][bj][m][n] = __builtin_amdgcn_mfma_f32_16x16x32_f16(__builtin_bit_cast(h8, Bt[n][k]), __builtin_bit_cast(h8, At[m][k]), acc[ai][bj][m][n], 0, 0, 0); __builtin_amdgcn_s_setprio(0); } while (0)
#define PG8_WAIT_V(n) asm volatile("s_waitcnt vmcnt(" #n ")" ::: "memory")
#define PG8_WAIT_L(n) asm volatile("s_waitcnt lgkmcnt(" #n ")" ::: "memory")
#define PG8_BAR __builtin_amdgcn_s_barrier()
#define PG8_SCHED __builtin_amdgcn_sched_barrier(0)
    Unit cur, nxt; int ui = 0;
    if (!S.next(0, cur)) return;
    f32x4 acc[2][2][4][2];
#pragma unroll
    for (int a = 0; a < 2; ++a)
#pragma unroll
        for (int b = 0; b < 2; ++b)
#pragma unroll
            for (int m = 0; m < 4; ++m)
#pragma unroll
                for (int n = 0; n < 2; ++n) acc[a][b][m][n] = (f32x4){0.f, 0.f, 0.f, 0.f};
    bf16x8 At[4][2], B0[2][2], B1[2][2];
    const char* cA = (const char*)g.A + (size_t)cur.pm * tstep; const char* cB = (const char*)g.Bt + (size_t)cur.pn * tstep;
    S.a_ready(cur);
    PG8_STAGE(PG8_SB(0, 0), cB, voffB); PG8_STAGE(PG8_SA(0, 0), cA, voffA); PG8_STAGE(PG8_SB(0, 1), cB + hstep, voffB); PG8_STAGE(PG8_SA(0, 1), cA + hstep, voffA);
    if (wr == 1) PG8_BAR;
    PG8_WAIT_V(4); PG8_BAR;
    PG8_STAGE(PG8_SB(1, 0), cB + kstep, voffB); PG8_STAGE(PG8_SA(1, 0), cA + kstep, voffA); PG8_STAGE(PG8_SB(1, 1), cB + hstep + kstep, voffB);
    PG8_WAIT_V(6); PG8_BAR;
    PG8_STAMP();
    for (;;) {
        const bool has_next = S.next(ui + 1, nxt);
        const char* nA = has_next ? (const char*)g.A + (size_t)nxt.pm * tstep : cA; const char* nB = has_next ? (const char*)g.Bt + (size_t)nxt.pn * tstep : cB;
        for (int t = 0; t < nt; t += 2) {
            const bool last = (t == nt - 2);
            const char* a1 = cA + (size_t)(t + 1) * kstep;
            const char* a2 = last ? nA : cA + (size_t)(t + 2) * kstep; const char* b2 = last ? nB : cB + (size_t)(t + 2) * kstep;
            const char* a3 = a2 + kstep; const char* b3 = b2 + kstep;
            if (last && has_next) S.a_ready(nxt);
            PG8_LDB(B0, 0, 0); PG8_SCHED; PG8_LDA(At, 0, 0); PG8_STAGE(PG8_SA(1, 1), a1 + hstep, voffA);
            PG8_WAIT_L(8); PG8_BAR; PG8_WAIT_L(0); PG8_MMA(0, 0, At, B0); PG8_BAR; PG8_SCHED;
            PG8_LDB(B1, 0, 1); PG8_STAGE(PG8_SB(0, 0), b2, voffB);
            PG8_BAR; PG8_WAIT_L(0); PG8_MMA(0, 1, At, B1); PG8_BAR;
            PG8_LDA(At, 0, 1); PG8_STAGE(PG8_SA(0, 0), a2, voffA);
            PG8_BAR; PG8_WAIT_L(0); PG8_MMA(1, 0, At, B0); PG8_BAR; PG8_SCHED;
            PG8_STAGE(PG8_SB(0, 1), b2 + hstep, voffB);
            PG8_WAIT_V(6); PG8_BAR; PG8_MMA(1, 1, At, B1); PG8_BAR;
            PG8_LDB(B0, 1, 0); PG8_SCHED; PG8_LDA(At, 1, 0); PG8_STAGE(PG8_SA(0, 1), a2 + hstep, voffA);
            PG8_WAIT_L(8); PG8_BAR; PG8_WAIT_L(0); PG8_MMA(0, 0, At, B0); PG8_BAR; PG8_SCHED;
            PG8_LDB(B1, 1, 1); PG8_STAGE(PG8_SB(1, 0), b3, voffB);
            PG8_BAR; PG8_WAIT_L(0); PG8_MMA(0, 1, At, B1); PG8_BAR;
            PG8_LDA(At, 1, 1); PG8_STAGE(PG8_SA(1, 0), a3, voffA);
            PG8_BAR; PG8_WAIT_L(0); PG8_MMA(1, 0, At, B0); PG8_BAR; PG8_SCHED;
            PG8_STAGE(PG8_SB(1, 1), b3 + hstep, voffB);
            PG8_WAIT_V(6); PG8_BAR; PG8_MMA(1, 1, At, B1); PG8_BAR;
        }
        PG8_STAMP();
        if constexpr (!Epi::AFTER_DRAIN) { E(acc, cur, wr, wc, fr, fq); S.done(cur); }
        PG8_STAMP();
        if (!has_next) break;
#pragma unroll
        for (int a = 0; a < 2; ++a)
#pragma unroll
            for (int b = 0; b < 2; ++b)
#pragma unroll
                for (int m = 0; m < 4; ++m)
#pragma unroll
                    for (int n = 0; n < 2; ++n) acc[a][b][m][n] = (f32x4){0.f, 0.f, 0.f, 0.f};
        cur = nxt; cA = nA; cB = nB; ++ui;
    }
    PG8_WAIT_V(0);
    if (wr == 0) PG8_BAR;
    PG8_BAR;
    if constexpr (Epi::AFTER_DRAIN) { E.fused(acc, cur, wr, wc, fr, fq, lds, wid, lane); S.done(cur); }
    PG8_STAMP();
    if (STAMP && wid == 0) { stamps[lane] = lane < nts ? (((unsigned long long)(unsigned)ts_hi << 32) | (unsigned)ts_lo) : 0ull;
        if (lane == 62) stamps[62] = rt_entry; if (lane == 63) stamps[63] = (unsigned long long)wall_clock64(); }
#undef PG8_STAMP
#undef PG8_SA
#undef PG8_SB
#undef PG8_STAGE
#undef PG8_LDA
#undef PG8_LDB
#undef PG8_MMA
#undef PG8_WAIT_V
#undef PG8_WAIT_L
#undef PG8_BAR
#undef PG8_SCHED
}
}

#define XB_TMO      128
#define XB_XCNT(j)  (256  + 64 * (j))
#define XB_XSUB(j)  (1280 + 64 * (j))
#define XB_XGEN(j)  (2304 + 64 * (j))
#define XB_TOP      3328
#define XB_TOPGEN   3392
#define XCD_BAR_WORDS 3456
#define XB_SPIN_CAP (1u << 18)
#define LAS __attribute__((address_space(3)))

__device__ __forceinline__ unsigned xb_ld(unsigned* p)              { return __hip_atomic_load(p, __ATOMIC_RELAXED, __HIP_MEMORY_SCOPE_AGENT); }
__device__ __forceinline__ unsigned xb_add(unsigned* p, unsigned v) { return __hip_atomic_fetch_add(p, v, __ATOMIC_RELAXED, __HIP_MEMORY_SCOPE_AGENT); }
__device__ __forceinline__ unsigned xb_xcc_id() { return (unsigned)__builtin_amdgcn_s_getreg((3 << 11) | 20) & 0xFu; }
#define XB_SPIN(cond, bar) do { unsigned _sp = 0; while (cond) { __builtin_amdgcn_s_sleep(1); \
    if ((++_sp & 255u) == 0u) { if (xb_ld(&(bar)[XB_TMO])) break; if (_sp > XB_SPIN_CAP) { atomicAdd(&(bar)[XB_TMO], 1u); break; } } } } while (0)

struct XcdBarrier {
    unsigned* bar; unsigned x;
    volatile LAS unsigned* st;
};

__device__ __forceinline__ XcdBarrier xcd_barrier_post(unsigned* bar, volatile LAS unsigned* st) {
    XcdBarrier b; b.bar = bar; b.x = xb_xcc_id(); b.st = st;
    if (threadIdx.x == 0) (void)xb_add(&bar[XB_XCNT(b.x)], 1u);
    return b;
}
__device__ __forceinline__ void xcd_barrier_complete(unsigned* bar, unsigned x, unsigned& nloc, unsigned& nx) {
    const unsigned G = gridDim.x * gridDim.y * gridDim.z;
    unsigned sum, cnt, mine, sp = 0u;
    for (;;) {
        sum = 0u; cnt = 0u; mine = 0u;
#pragma unroll
        for (unsigned j = 0; j < 16; ++j) { const unsigned c = xb_ld(&bar[XB_XCNT(j)]); sum += c; cnt += (c > 0u) ? 1u : 0u; mine = (j == x) ? c : mine; }
        if (sum == G) break;
        __builtin_amdgcn_s_sleep(1);
        if ((++sp & 255u) == 0u) { if (xb_ld(&bar[XB_TMO])) break; if (sp > XB_SPIN_CAP) { atomicAdd(&bar[XB_TMO], 1u); break; } }
    }
    nloc = mine > 0u ? mine : 1u; nx = cnt > 0u ? cnt : 1u;
}

__device__ __forceinline__ void xcd_barrier(const XcdBarrier& b) {
    asm volatile("s_waitcnt vmcnt(0)" ::: "memory");
    __syncthreads();
    if (threadIdx.x == 0) {
        unsigned* bar = b.bar;
        __builtin_amdgcn_s_waitcnt(0);
        unsigned nloc = b.st[0], nx = b.st[1];
        if (nloc == 0u) { xcd_barrier_complete(bar, b.x, nloc, nx); b.st[0] = nloc; b.st[1] = nx; }
        const unsigned old = xb_add(&bar[XB_XSUB(b.x)], 1u);
        const unsigned gen = old / nloc;
        if (old + 1u == (gen + 1u) * nloc) {
            __builtin_amdgcn_fence(__ATOMIC_RELEASE, "agent");
            asm volatile("s_waitcnt vmcnt(0)" ::: "memory");
            const unsigned og = xb_add(&bar[XB_TOP], 1u);
            const unsigned tg = og / nx;
            if (og + 1u == (tg + 1u) * nx) xb_add(&bar[XB_TOPGEN], 1u);
            else XB_SPIN(xb_ld(&bar[XB_TOPGEN]) == tg, bar);
            __builtin_amdgcn_fence(__ATOMIC_ACQUIRE, "agent");
            xb_add(&bar[XB_XGEN(b.x)], 1u);
            asm volatile("s_waitcnt vmcnt(0)" ::: "memory");
        } else {
            XB_SPIN(xb_ld(&bar[XB_XGEN(b.x)]) == gen, bar);
            __builtin_amdgcn_fence(__ATOMIC_ACQUIRE, "agent");
            asm volatile("s_waitcnt vmcnt(0)" ::: "memory");
        }
    }
    __syncthreads();
}

constexpr int NB = 2, SEQ = 16384, TLEN = 16400, DM = 1024, NMETA = 16, DEPTH = 2;
constexpr int MR = NB * SEQ;
constexpr int MV = MR + NB * NMETA;
constexpr int MP = 33024;
constexpr int INCOLS = 3912, NPAD = 4096, DFF = 4096;
constexpr int NTHREADS = 512;
constexpr float LOG2E = 1.4426950408889634f;
constexpr float QA_SCALE = 0.125f * LOG2E;
constexpr float QB_SCALE = 0.17677669529663687f * LOG2E;
constexpr float WI_SCALE = 0.044194173824159216f;
constexpr int NKS = 513;

constexpr size_t al256(size_t x) { return (x + 255) & ~(size_t)255; }
constexpr size_t WS_CTL   = 0;
constexpr size_t CTL_BYTES = 65536;
constexpr size_t WS_HMETA = CTL_BYTES;
constexpr size_t WS_ROPE  = WS_HMETA + (size_t)256 * DM * 4;
constexpr size_t WS_W     = al256(WS_ROPE + (size_t)TLEN * 32 * 8);
constexpr size_t W_IN_OFF = 0, W_OUT_OFF = (size_t)NPAD * DM * 2, W_FF1_OFF = W_OUT_OFF + (size_t)DM * DM * 2,
                 W_FF2_OFF = W_FF1_OFF + (size_t)DFF * DM * 2, W_LAYER = W_FF2_OFF + (size_t)DM * DFF * 2;
constexpr size_t WS_ABUF  = al256(WS_W + DEPTH * W_LAYER);
constexpr size_t WS_MASK  = WS_ABUF + (size_t)MP * DM * 2;
constexpr size_t WS_U     = al256(WS_MASK + (size_t)NB * NKS * TLEN * 4);
constexpr size_t WS_S     = WS_U + (size_t)NB * 4 * 129 * 4096 * 4;
constexpr size_t WS_PROJ  = WS_S + (size_t)NB * 4 * 129 * 4096 * 4;
constexpr size_t P512 = (size_t)MP * 512 * 2, P256 = (size_t)MP * 256 * 2;
constexpr size_t PJ_QA = 0, PJ_KA = P512, PJ_VA = 2 * P512, PJ_QI = 3 * P512, PJ_256 = 4 * P512;
constexpr size_t PJ_QB = PJ_256, PJ_KB = PJ_256 + P256, PJ_VB = PJ_256 + 2 * P256, PJ_QC = PJ_256 + 3 * P256, PJ_KC = PJ_256 + 4 * P256,
                 PJ_VC = PJ_256 + 5 * P256, PJ_GC = PJ_256 + 6 * P256, PJ_KI = PJ_256 + 7 * P256, PJ_WI = PJ_KI + (size_t)MP * 64 * 2,
                 PJ_END = PJ_WI + (size_t)MP * 8 * 4;
constexpr size_t ACT_BYTES = (size_t)MP * DFF * 2;
constexpr size_t WS_END = WS_PROJ + (ACT_BYTES > PJ_END ? ACT_BYTES : PJ_END);
constexpr int CW_BAR = 0;
constexpr int CW_KMAX = 4096;

constexpr int LDS_BYTES = 156 * 1024;
constexpr int LDS_MISC = 0, LDS_GEN = 256;

struct Args { const float* in[13]; float* out; unsigned char* ws; int ph_lo, ph_hi; };

struct Frame {
    const float *x, *meta, *rel_bias, *w_in, *norm_mix, *diff_lambda, *diff_norm, *ret_norm, *w_out, *norm_ff, *w_ff1, *w_ff2, *final_norm;
    float* out; unsigned char* ws; LAS unsigned char* lds; int tid, lane, wave, bid, G;
};

__device__ __forceinline__ float wave_sum(float v) { v += __shfl_xor(v, 32); v += __shfl_xor(v, 16); v += __shfl_xor(v, 8); v += __shfl_xor(v, 4); v += __shfl_xor(v, 2); v += __shfl_xor(v, 1); return v; }
__device__ __forceinline__ unsigned cvt_pk_bf16(float lo, float hi) { unsigned r; asm volatile("v_cvt_pk_bf16_f32 %0, %1, %2" : "=v"(r) : "v"(lo), "v"(hi)); return r; }
__device__ __forceinline__ unsigned cvt_pk_f16(float lo, float hi) { h2 p; p.x = (_Float16)lo; p.y = (_Float16)hi; return __builtin_bit_cast(unsigned, p); }
typedef unsigned u32x4 __attribute__((ext_vector_type(4)));
typedef float f32x4 __attribute__((ext_vector_type(4)));
__device__ __forceinline__ u32x4 pack8(const f32x4& a, const f32x4& b, bool bf) {
    u32x4 w;
    if (bf) { w.x = cvt_pk_bf16(a[0], a[1]); w.y = cvt_pk_bf16(a[2], a[3]); w.z = cvt_pk_bf16(b[0], b[1]); w.w = cvt_pk_bf16(b[2], b[3]); }
    else    { w.x = cvt_pk_f16(a[0], a[1]);  w.y = cvt_pk_f16(a[2], a[3]);  w.z = cvt_pk_f16(b[0], b[1]);  w.w = cvt_pk_f16(b[2], b[3]); }
    return w;
}
__device__ __forceinline__ int row_pos(int r) { return r < MR ? (r & (SEQ - 1)) + NMETA : ((r - MR) & 15); }

__device__ __forceinline__ int incol_map(int n) {
    if (n < 2048) return n;
    if (n < 2816) return n - 2048 + 2120;
    if (n < 3328) {
        const int seg = (n - 2816) >> 8, c = (n - 2816) & 255, head = c >> 6, p = c & 63;
        const int g = p >> 3, nn = (p >> 2) & 1, i = p & 3, d = 32 * nn + 4 * g + i;
        return (seg ? 3144 : 2888) + head * 64 + d;
    }
    if (n < 3840) return n - 3328 + 3400;
    if (n < 3904) return n - 3840 + 2048;
    if (n < 3912) return n - 3904 + 2112;
    return -1;
}

__constant__ double ROPE_REV[32] = {0.15915494309189535, 0.11934937021124886, 0.08949940160889101, 0.06711508300522726, 0.050329212104487035, 0.03774158471741977, 0.0283021958306234, 0.02122365276477766, 0.015915494309189534, 0.011934937021124886, 0.008949940160889102, 0.006711508300522725, 0.005032921210448704, 0.003774158471741977, 0.00283021958306234, 0.0021223652764777662, 0.0015915494309189536, 0.0011934937021124885, 0.0008949940160889102, 0.0006711508300522726, 0.0005032921210448703, 0.00037741584717419774, 0.00028302195830623395, 0.0002122365276477766, 0.00015915494309189535, 0.00011934937021124886, 8.949940160889102e-05, 6.711508300522725e-05, 5.0329212104487035e-05, 3.774158471741978e-05, 2.8302195830623396e-05, 2.122365276477766e-05};

struct EpiInProj {
    static constexpr bool PERM = true, AFTER_DRAIN = false;
    unsigned char* proj; const f32x2* rope; unsigned* kmax;
    __device__ __forceinline__ void kmax_update(const pg8::f32x4 (&acc)[2][2][4][2], int bj, unsigned* word, int fr, int fq) const {
        float mx = 0.f;
#pragma unroll
        for (int ai = 0; ai < 2; ++ai)
#pragma unroll
            for (int m = 0; m < 4; ++m) {
                const pg8::f32x4 a = acc[ai][bj][m][0], b = acc[ai][bj][m][1];
                float s = (a[0] * a[0] + a[1] * a[1]) + (a[2] * a[2] + a[3] * a[3]) + (b[0] * b[0] + b[1] * b[1]) + (b[2] * b[2] + b[3] * b[3]);
                s += __shfl_xor(s, 16); s += __shfl_xor(s, 32);
                mx = fmaxf(mx, s);
            }
        mx = fmaxf(mx, __shfl_xor(mx, 1)); mx = fmaxf(mx, __shfl_xor(mx, 2)); mx = fmaxf(mx, __shfl_xor(mx, 4)); mx = fmaxf(mx, __shfl_xor(mx, 8));
        if (fr == 0 && fq == 0) atomicMax(word, __float_as_uint(mx));
    }
    __device__ __forceinline__ void operator()(const pg8::f32x4 (&acc)[2][2][4][2], const pg8::Unit& u, int wr, int wc, int fr, int fq) const {
        const int pn = u.pn, rbase = u.pm * 256 + wr * 64 + fr, cw = wc * 32 + 8 * fq;
        if (pn <= 7 || (pn <= 14 && pn != 11 && pn != 12)) {
            unsigned char* base; int ld, colt; float scale = 1.f; bool bf = false;
            if (pn <= 7) { const int arr = pn >> 1; base = proj + (size_t)arr * P512; ld = 512; colt = (pn & 1) * 256; if (arr == 0) scale = QA_SCALE; bf = (arr == 2); }
            else { const int arr = pn - 8; base = proj + PJ_256 + (size_t)arr * P256; ld = 256; colt = 0; if (arr == 0) scale = QB_SCALE; bf = (arr == 2); }
#pragma unroll
            for (int ai = 0; ai < 2; ++ai)
#pragma unroll
                for (int m = 0; m < 4; ++m) {
                    const int row = rbase + ai * 128 + m * 16;
#pragma unroll
                    for (int bj = 0; bj < 2; ++bj) {
                        const pg8::f32x4 v0 = acc[ai][bj][m][0] * scale, v1 = acc[ai][bj][m][1] * scale;
                        *(u32x4*)(base + ((size_t)row * ld + colt + bj * 128 + cw) * 2) = pack8(v0, v1, bf);
                    }
                }
            if (pn == 2 || pn == 3) {
#pragma unroll
                for (int bj = 0; bj < 2; ++bj) { const int head = ((pn & 1) * 256 + bj * 128 + wc * 32) >> 6; kmax_update(acc, bj, kmax + head * 2 + (wc & 1), fr, fq); }
            }
            if (pn == 9) {
#pragma unroll
                for (int bj = 0; bj < 2; ++bj) { const int head = 2 * bj + (wc >> 1); kmax_update(acc, bj, kmax + 16 + head * 2 + (wc & 1), fr, fq); }
            }
        } else if (pn == 11 || pn == 12) {
            unsigned char* base = proj + PJ_256 + (size_t)(pn - 8) * P256;
            const float sc = (pn == 12) ? 0.125f : 1.f;
            const int g = 4 * (wc & 1) + fq;
#pragma unroll
            for (int ai = 0; ai < 2; ++ai)
#pragma unroll
                for (int m = 0; m < 4; ++m) {
                    const int row = rbase + ai * 128 + m * 16, t = row_pos(row);
                    const pg8::f32x4 cs0 = *(const pg8::f32x4*)(rope + (size_t)t * 32 + 4 * g), cs1 = *(const pg8::f32x4*)(rope + (size_t)t * 32 + 4 * g + 2);
                    const float c[4] = {cs0[0], cs0[2], cs1[0], cs1[2]}, s[4] = {cs0[1], cs0[3], cs1[1], cs1[3]};
#pragma unroll
                    for (int bj = 0; bj < 2; ++bj) {
                        const pg8::f32x4 x1 = acc[ai][bj][m][0], x2 = acc[ai][bj][m][1];
                        float o1[4], o2[4];
#pragma unroll
                        for (int i = 0; i < 4; ++i) { o1[i] = (x1[i] * c[i] - x2[i] * s[i]) * sc; o2[i] = (x1[i] * s[i] + x2[i] * c[i]) * sc; }
                        const int head = 2 * bj + (wc >> 1);
                        unsigned char* rp = base + ((size_t)row * 256 + head * 64 + 4 * g) * 2;
                        u32x2 w1, w2; w1.x = cvt_pk_f16(o1[0], o1[1]); w1.y = cvt_pk_f16(o1[2], o1[3]); w2.x = cvt_pk_f16(o2[0], o2[1]); w2.y = cvt_pk_f16(o2[2], o2[3]);
                        *(u32x2*)rp = w1; *(u32x2*)(rp + 64) = w2;
                    }
                }
        } else {
#pragma unroll
            for (int ai = 0; ai < 2; ++ai)
#pragma unroll
                for (int m = 0; m < 4; ++m) {
                    const int row = rbase + ai * 128 + m * 16;
                    const pg8::f32x4 v0 = acc[ai][0][m][0], v1 = acc[ai][0][m][1];
                    if (wc < 2) *(u32x4*)(proj + PJ_KI + ((size_t)row * 64 + cw) * 2) = pack8(v0, v1, false);
                    else if (wc == 2 && fq == 0) { float* wp = (float*)(proj + PJ_WI) + (size_t)row * 8; *(pg8::f32x4*)wp = v0 * WI_SCALE; *(pg8::f32x4*)(wp + 4) = v1 * WI_SCALE; }
                }
        }
    }
};
struct EpiRes {
    static constexpr bool PERM = false, AFTER_DRAIN = false;
    const float* res_main; float* out_main; float* hmeta;
    __device__ __forceinline__ void operator()(const pg8::f32x4 (&acc)[2][2][4][2], const pg8::Unit& u, int wr, int wc, int fr, int fq) const {
        const bool mt = (u.pm * 256 >= MR);
        const float* rb = mt ? hmeta : res_main; float* ob = mt ? hmeta : out_main;
        const int row0 = (mt ? u.pm * 256 - MR : u.pm * 256) + wr * 64 + fr, col0 = u.pn * 256 + wc * 32 + 4 * fq;
#pragma unroll
        for (int ai = 0; ai < 2; ++ai)
#pragma unroll
            for (int m = 0; m < 4; ++m) {
                const size_t ro = (size_t)(row0 + ai * 128 + m * 16) * DM + col0;
#pragma unroll
                for (int bj = 0; bj < 2; ++bj)
#pragma unroll
                    for (int n = 0; n < 2; ++n) { const pg8::f32x4 v = *(const pg8::f32x4*)(rb + ro + bj * 128 + n * 16) + acc[ai][bj][m][n]; *(pg8::f32x4*)(ob + ro + bj * 128 + n * 16) = v; }
            }
    }
};
struct EpiRelu2 {
    static constexpr bool PERM = true, AFTER_DRAIN = false;
    unsigned char* act;
    __device__ __forceinline__ void operator()(const pg8::f32x4 (&acc)[2][2][4][2], const pg8::Unit& u, int wr, int wc, int fr, int fq) const {
        const int rbase = u.pm * 256 + wr * 64 + fr, col0 = u.pn * 256 + wc * 32 + 8 * fq;
#pragma unroll
        for (int ai = 0; ai < 2; ++ai)
#pragma unroll
            for (int m = 0; m < 4; ++m) {
                const int row = rbase + ai * 128 + m * 16;
#pragma unroll
                for (int bj = 0; bj < 2; ++bj) {
                    pg8::f32x4 v0 = acc[ai][bj][m][0], v1 = acc[ai][bj][m][1];
#pragma unroll
                    for (int i = 0; i < 4; ++i) { const float a = fmaxf(v0[i], 0.f), b = fmaxf(v1[i], 0.f); v0[i] = a * a; v1[i] = b * b; }
                    *(u32x4*)(act + ((size_t)row * DFF + col0 + bj * 128) * 2) = pack8(v0, v1, false);
                }
            }
    }
};

__device__ __forceinline__ void wtrans_tile(LAS float* tile, const float* src, int ldsrc, int k0, int n0, _Float16* dst, int K, bool mapped, int tid) {
    { const int kk = tid >> 4, nn = (tid & 15) * 4;
#pragma unroll
      for (int hh = 0; hh < 2; ++hh) { const int k = k0 + kk + 32 * hh;
#pragma unroll
        for (int e = 0; e < 4; ++e) { const int n = n0 + nn + e; const int sc = mapped ? incol_map(n) : n; tile[(nn + e) * 65 + kk + 32 * hh] = sc >= 0 ? src[(size_t)k * ldsrc + sc] : 0.f; } } }
    __syncthreads();
    { const int nn = tid >> 3, kk8 = (tid & 7) * 8; h8 o;
#pragma unroll
      for (int e = 0; e < 8; ++e) o[e] = (_Float16)tile[nn * 65 + kk8 + e];
      *(h8*)(dst + (size_t)(n0 + nn) * K + k0 + kk8) = o; }
    __syncthreads();
}
__device__ __forceinline__ void wtrans(const Frame& F, const float* src, int K, int Nsrc, int Ndst, _Float16* dst, bool mapped, int& tctr) {
    const int tk = K / 64, tn = Ndst / 64, nt = tk * tn;
    for (int t = 0; t < nt; ++t, ++tctr) { if (tctr % F.G != F.bid) continue; wtrans_tile((LAS float*)(F.lds + LDS_GEN), src, Nsrc, (t % tk) * 64, (t / tk) * 64, dst, K, mapped, F.tid); }
}
template <int MODE> __device__ __forceinline__ void norm_to_abuf(const Frame& F, const float* gain) {
    _Float16* abuf = (_Float16*)(F.ws + WS_ABUF); const float* hmeta = (const float*)(F.ws + WS_HMETA);
    const int nw = F.G * 8;
    for (int r = F.bid * 8 + F.wave; r < MP; r += nw) {
        _Float16* dst = abuf + (size_t)r * DM;
        if (r >= MV) { const h4 z = {(_Float16)0.f, (_Float16)0.f, (_Float16)0.f, (_Float16)0.f};
#pragma unroll
            for (int j = 0; j < 4; ++j) *(h4*)(dst + j * 256 + F.lane * 4) = z; continue; }
        const float* src = MODE == 0 ? (r < MR ? F.x + (size_t)r * DM : F.meta + (size_t)((r - MR) & 15) * DM) : (r < MR ? F.out + (size_t)r * DM : hmeta + (size_t)(r - MR) * DM);
        f32x4 v[4]; float ss = 0.f;
#pragma unroll
        for (int j = 0; j < 4; ++j) { v[j] = *(const f32x4*)(src + j * 256 + F.lane * 4); ss += (v[j][0] * v[j][0] + v[j][1] * v[j][1]) + (v[j][2] * v[j][2] + v[j][3] * v[j][3]); }
        ss = wave_sum(ss); const float rstd = rsqrtf(ss * (1.0f / DM) + 1e-6f);
#pragma unroll
        for (int j = 0; j < 4; ++j) { const f32x4 g = *(const f32x4*)(gain + j * 256 + F.lane * 4); h4 o;
#pragma unroll
            for (int e = 0; e < 4; ++e) o[e] = (_Float16)(v[j][e] * rstd * g[e]);
            *(h4*)(dst + j * 256 + F.lane * 4) = o; }
    }
}
__device__ __forceinline__ void final_norm(const Frame& F) {
    const int nw = F.G * 8;
    for (int r = F.bid * 8 + F.wave; r < MR; r += nw) {
        float* p = F.out + (size_t)r * DM; f32x4 v[4]; float ss = 0.f;
#pragma unroll
        for (int j = 0; j < 4; ++j) { v[j] = *(const f32x4*)(p + j * 256 + F.lane * 4); ss += (v[j][0] * v[j][0] + v[j][1] * v[j][1]) + (v[j][2] * v[j][2] + v[j][3] * v[j][3]); }
        ss = wave_sum(ss); const float rstd = rsqrtf(ss * (1.0f / DM) + 1e-6f);
#pragma unroll
        for (int j = 0; j < 4; ++j) { const f32x4 g = *(const f32x4*)(F.final_norm + j * 256 + F.lane * 4); *(f32x4*)(p + j * 256 + F.lane * 4) = v[j] * rstd * g; }
    }
}
__device__ __forceinline__ void prologue(const Frame& F) {
    const int gtid = F.bid * NTHREADS + F.tid, gsz = F.G * NTHREADS;
    float* hmeta = (float*)(F.ws + WS_HMETA);
    for (int i = gtid; i < 256 * DM / 4; i += gsz) { const int row = i / (DM / 4), c4 = i % (DM / 4); f32x4 v = {0.f, 0.f, 0.f, 0.f}; if (row < NB * NMETA) v = *(const f32x4*)(F.meta + (size_t)(row & 15) * DM + c4 * 4); *(f32x4*)(hmeta + (size_t)row * DM + c4 * 4) = v; }
    f32x2* rope = (f32x2*)(F.ws + WS_ROPE);
    for (int i = gtid; i < TLEN * 32; i += gsz) { const int t = i >> 5, d = i & 31; const double rev = (double)t * ROPE_REV[d]; const float fr = (float)(rev - __builtin_floor(rev)); f32x2 cs; cs.x = __builtin_amdgcn_cosf(fr); cs.y = __builtin_amdgcn_sinf(fr); rope[i] = cs; }
    int tctr = 0;
    for (int l = 0; l < DEPTH; ++l) {
        unsigned char* wl = F.ws + WS_W + (size_t)l * W_LAYER;
        wtrans(F, F.w_in + (size_t)l * DM * INCOLS, DM, INCOLS, NPAD, (_Float16*)(wl + W_IN_OFF), true, tctr);
        wtrans(F, F.w_out + (size_t)l * DM * DM, DM, DM, DM, (_Float16*)(wl + W_OUT_OFF), false, tctr);
        wtrans(F, F.w_ff1 + (size_t)l * DM * DFF, DM, DFF, DFF, (_Float16*)(wl + W_FF1_OFF), false, tctr);
        wtrans(F, F.w_ff2 + (size_t)l * DFF * DM, DFF, DM, DM, (_Float16*)(wl + W_FF2_OFF), false, tctr);
    }
    norm_to_abuf<0>(F, F.norm_mix);
}
__device__ __forceinline__ void zero_abuf(const Frame& F) {
    u32x4* p = (u32x4*)(F.ws + WS_ABUF); const u32x4 z = {0u, 0u, 0u, 0u};
    for (size_t i = (size_t)F.bid * NTHREADS + F.tid; i < (size_t)MP * DM * 2 / 16; i += (size_t)F.G * NTHREADS) p[i] = z;
}

typedef short bf16x8v __attribute__((ext_vector_type(8)));
__constant__ unsigned char BUCKET_LUT[128] = {0, 1, 2, 3, 4, 5, 6, 7, 8, 9, 10, 11, 12, 13, 14, 15, 16, 16, 16, 17, 17, 18, 18, 18, 19, 19, 19, 20, 20, 20, 20, 21, 21, 21, 21, 22, 22, 22, 22, 22, 23, 23, 23, 23, 23, 23, 24, 24, 24, 24, 24, 24, 25, 25, 25, 25, 25, 25, 25, 26, 26, 26, 26, 26, 26, 26, 26, 27, 27, 27, 27, 27, 27, 27, 27, 27, 27, 28, 28, 28, 28, 28, 28, 28, 28, 28, 28, 29, 29, 29, 29, 29, 29, 29, 29, 29, 29, 29, 29, 30, 30, 30, 30, 30, 30, 30, 30, 30, 30, 30, 30, 30, 30, 31, 31, 31, 31, 31, 31, 31, 31, 31, 31, 31, 31, 31, 31, 31};
__device__ __forceinline__ int crow(int i, int h) { return (i & 3) + 8 * (i >> 2) + 4 * h; }
__device__ __forceinline__ bf16x8v pack_p(const f32x16& x, int s) {
    u32x4 p; p.x = cvt_pk_bf16(x[8 * s + 0], x[8 * s + 1]); p.y = cvt_pk_bf16(x[8 * s + 2], x[8 * s + 3]); p.z = cvt_pk_bf16(x[8 * s + 4], x[8 * s + 5]); p.w = cvt_pk_bf16(x[8 * s + 6], x[8 * s + 7]);
    return __builtin_bit_cast(bf16x8v, p);
}
__device__ __forceinline__ bf16x8v vt_frag(LAS unsigned char* vimg, int dblk, int keybase, int s, int lane) {
    const int h = lane >> 5, blk = (lane >> 4) & 1, i16 = lane & 15, q = i16 >> 2, p = i16 & 3;
    LAS unsigned char* a = vimg + dblk * 4096 + (keybase + 16 * s + 4 * h + q) * 64 + (16 * blk + 4 * p) * 2;
    const s16x4 lo = __builtin_amdgcn_ds_read_tr16_b64_v4i16((LAS s16x4*)a);
    const s16x4 hi = __builtin_amdgcn_ds_read_tr16_b64_v4i16((LAS s16x4*)(a + 8 * 64));
    return __builtin_shufflevector(lo, hi, 0, 1, 2, 3, 4, 5, 6, 7);
}

constexpr int KS_PITCH = 144;
constexpr int B_KS = 0, B_VS = 2 * 64 * KS_PITCH, B_LUT = B_VS + 2 * 8192, B_END = B_LUT + 512;
__device__ __forceinline__ void mixB_unit(const Frame& F, int l, int b, int hh, int qblk, float lam, float oscale) {
    LAS unsigned char* L = F.lds + LDS_GEN;
    const int tid = F.tid, lane = F.lane, wave = F.wave, r = lane & 31, h = lane >> 5;
    const unsigned char* proj = F.ws + WS_PROJ;
    const _Float16* QB = (const _Float16*)(proj + PJ_QB); const unsigned char* KB = proj + PJ_KB; const unsigned char* VB = proj + PJ_VB;
    const unsigned* kmax = (const unsigned*)(F.ws + WS_CTL) + CW_KMAX + 32 * l + 16;
    const bool meta_u = qblk < 0;
    const int qrow0 = meta_u ? MR + b * NMETA : b * SEQ + qblk * 256;
    const int qpos0 = meta_u ? 0 : NMETA + qblk * 256;
    const int nreal = meta_u ? 0 : 4 * qblk + 4;
    const int wq0 = 32 * wave;
    const bool wave_on = meta_u ? (wave == 0) : true;
    const int my_row = wave_on ? qrow0 + wq0 + r : qrow0, my_pos = qpos0 + wq0 + r;
    __syncthreads();
    if (tid < 128) ((LAS float*)(L + B_LUT))[tid] = F.rel_bias[BUCKET_LUT[tid] * 12 + 8 + hh] * LOG2E;
    float bmax = (lane < 32) ? F.rel_bias[lane * 12 + 8 + hh] * LOG2E : -1e30f;
    bmax = fmaxf(bmax, __shfl_xor(bmax, 16)); bmax = fmaxf(bmax, __shfl_xor(bmax, 8)); bmax = fmaxf(bmax, __shfl_xor(bmax, 4)); bmax = fmaxf(bmax, __shfl_xor(bmax, 2)); bmax = fmaxf(bmax, __shfl_xor(bmax, 1));
    bmax = __shfl(bmax, 0);
    const float bfar = F.rel_bias[31 * 12 + 8 + hh] * LOG2E;
    h8 qf[2][2]; float mq[2];
#pragma unroll
    for (int c = 0; c < 2; ++c) {
        float n2 = 0.f;
#pragma unroll
        for (int s = 0; s < 2; ++s) { qf[c][s] = *(const h8*)(QB + (size_t)my_row * 256 + hh * 64 + c * 32 + 16 * s + 8 * h);
#pragma unroll
            for (int j = 0; j < 8; ++j) { const float v = (float)qf[c][s][j]; n2 += v * v; } }
        n2 += __shfl_xor(n2, 32);
        mq[c] = sqrtf(n2 * __uint_as_float(kmax[hh * 2 + c])) * 1.002f + bmax;
    }
    f32x16 cfar[2];
#pragma unroll
    for (int c = 0; c < 2; ++c)
#pragma unroll
        for (int i = 0; i < 16; ++i) cfar[c][i] = bfar - mq[c];
    f32x16 O[2][2]; float lsum[2] = {0.f, 0.f};
#pragma unroll
    for (int c = 0; c < 2; ++c)
#pragma unroll
        for (int d = 0; d < 2; ++d)
#pragma unroll
            for (int i = 0; i < 16; ++i) O[c][d][i] = 0.f;
    const int skey = tid >> 3, sch = tid & 7;
    const unsigned kdst = skey * KS_PITCH + sch * 16, vdst = (sch >> 2) * 4096 + skey * 64 + (sch & 3) * 16;
    const int ntiles = 1 + nreal;
    auto tile_row0 = [&](int t) -> int { return t == 0 ? MR + b * NMETA : b * SEQ + (t - 1) * 64; };
    u32x4 kreg, vreg;
    { const size_t rr = (size_t)(tile_row0(0) + skey); kreg = *(const u32x4*)(KB + rr * 512 + hh * 128 + sch * 16); vreg = *(const u32x4*)(VB + rr * 512 + hh * 128 + sch * 16); }
    *(LAS u32x4*)(L + B_KS + kdst) = kreg; *(LAS u32x4*)(L + B_VS + vdst) = vreg;
    __syncthreads();
#pragma unroll 1
    for (int t = 0; t < ntiles; ++t) {
        const int buf = t & 1;
        if (t + 1 < ntiles) { const size_t rr = (size_t)(tile_row0(t + 1) + skey); kreg = *(const u32x4*)(KB + rr * 512 + hh * 128 + sch * 16); vreg = *(const u32x4*)(VB + rr * 512 + hh * 128 + sch * 16); }
        const int kpos0 = (t == 0) ? 0 : NMETA + (t - 1) * 64, nvalid = (t == 0) ? NMETA : 64;
        const int wpos0 = qpos0 + wq0;
        if (wave_on && kpos0 <= wpos0 + 31) {
            LAS unsigned char* Kb = L + B_KS + buf * (64 * KS_PITCH); LAS unsigned char* Vb = L + B_VS + buf * 8192;
            const bool slow = (t == 0) || (kpos0 + 63 > wpos0 - 128);
#pragma unroll
            for (int sub = 0; sub < 2; ++sub) {
                if (sub * 32 >= nvalid || kpos0 + sub * 32 > wpos0 + 31) continue;
                f32x16 S[2];
#pragma unroll
                for (int c = 0; c < 2; ++c) {
                    if (slow) {
#pragma unroll
                        for (int i = 0; i < 16; ++i) S[c][i] = 0.f; } else S[c] = cfar[c];
#pragma unroll
                    for (int s = 0; s < 2; ++s) { const h8 kf = *(const LAS h8*)(Kb + (sub * 32 + r) * KS_PITCH + (c * 32 + 16 * s + 8 * h) * 2);
                        S[c] = __builtin_amdgcn_mfma_f32_32x32x16_f16(kf, qf[c][s], S[c], 0, 0, 0); }
                }
                if (slow) {
#pragma unroll
                    for (int i = 0; i < 16; ++i) {
                        const int kidx = sub * 32 + crow(i, h), dist = my_pos - (kpos0 + kidx);
                        const bool ok = dist >= 0 && kidx < nvalid;
                        const float bias = ((const LAS float*)(L + B_LUT))[min(max(dist, 0), 127)];
#pragma unroll
                        for (int c = 0; c < 2; ++c) S[c][i] = ok ? __builtin_amdgcn_exp2f(S[c][i] + bias - mq[c]) : 0.f;
                    }
                } else {
#pragma unroll
                    for (int c = 0; c < 2; ++c)
#pragma unroll
                        for (int i = 0; i < 16; ++i) S[c][i] = __builtin_amdgcn_exp2f(S[c][i]);
                }
#pragma unroll
                for (int c = 0; c < 2; ++c) { float a = 0.f;
#pragma unroll
                    for (int i = 0; i < 16; ++i) a += S[c][i];
                    lsum[c] += a; }
                bf16x8v pf[2][2];
#pragma unroll
                for (int c = 0; c < 2; ++c) { pf[c][0] = pack_p(S[c], 0); pf[c][1] = pack_p(S[c], 1); }
#pragma unroll
                for (int d = 0; d < 2; ++d)
#pragma unroll
                    for (int s = 0; s < 2; ++s) { const bf16x8v vf = vt_frag(Vb, d, sub * 32, s, lane);
#pragma unroll
                        for (int c = 0; c < 2; ++c) O[c][d] = __builtin_amdgcn_mfma_f32_32x32x16_bf16(vf, pf[c][s], O[c][d], 0, 0, 0); }
            }
        }
        if (t + 1 < ntiles) { *(LAS u32x4*)(L + B_KS + (buf ^ 1) * (64 * KS_PITCH) + kdst) = kreg; *(LAS u32x4*)(L + B_VS + (buf ^ 1) * 8192 + vdst) = vreg; }
        __syncthreads();
    }
    if (wave_on) {
        const float l0 = lsum[0] + __shfl_xor(lsum[0], 32), l1 = lsum[1] + __shfl_xor(lsum[1], 32);
        const float i0 = 1.0f / l0, i1 = lam / l1;
        float o[2][16], ss = 0.f;
#pragma unroll
        for (int d = 0; d < 2; ++d)
#pragma unroll
            for (int i = 0; i < 16; ++i) { o[d][i] = O[0][d][i] * i0 - O[1][d][i] * i1; ss += o[d][i] * o[d][i]; }
        ss += __shfl_xor(ss, 32);
        const float rstd = rsqrtf(ss * (1.0f / 64.0f) + 1e-6f) * oscale;
        const float* gn = F.diff_norm + l * 64;
        if (!meta_u || r < NMETA) {
            _Float16* dst = (_Float16*)(F.ws + WS_ABUF) + (size_t)my_row * DM + 512 + hh * 64;
#pragma unroll
            for (int d = 0; d < 2; ++d)
#pragma unroll
                for (int g4 = 0; g4 < 4; ++g4) { const int d0 = 32 * d + 8 * g4 + 4 * h; const f32x4 gv = *(const f32x4*)(gn + d0);
                    u32x2 w; w.x = cvt_pk_f16(o[d][4 * g4 + 0] * rstd * gv[0], o[d][4 * g4 + 1] * rstd * gv[1]); w.y = cvt_pk_f16(o[d][4 * g4 + 2] * rstd * gv[2], o[d][4 * g4 + 3] * rstd * gv[3]);
                    *(u32x2*)(dst + d0) = w; }
        }
    }
}
__device__ __forceinline__ void mixB_phase(const Frame& F, int l) {
    const float* lp = F.diff_lambda + l * 128;
    float a = (F.lane < 32) ? lp[F.lane] * lp[32 + F.lane] : 0.f, c = (F.lane < 32) ? lp[64 + F.lane] * lp[96 + F.lane] : 0.f;
    a = wave_sum(a); c = wave_sum(c);
    const float linit = 0.8f - 0.6f * expf(-0.3f * (float)l);
    const float lam = expf(a) - expf(c) + linit, oscale = 1.0f - linit;
#pragma unroll 1
    for (int cidx = F.bid; cidx < 256; cidx += F.G) { const int bh = cidx & 7, i = cidx >> 3;
#pragma unroll 1
        for (int k = 0; k < 3; ++k) { if (k == 2 && cidx >= 8) break; mixB_unit(F, l, bh >> 2, bh & 3, k == 0 ? 63 - i : (k == 1 ? i : -1), lam, oscale); }
    }
}
__device__ __forceinline__ h8 tr_frag_nat(LAS unsigned char* img_blk, int rowbase, int s, int lane) {
    const int h = lane >> 5, blk = (lane >> 4) & 1, i16 = lane & 15, q = i16 >> 2, p = i16 & 3;
    LAS unsigned char* a = img_blk + (rowbase + 16 * s + 8 * h + q) * 64 + (16 * blk + 4 * p) * 2;
    const s16x4 lo = __builtin_amdgcn_ds_read_tr16_b64_v4i16((LAS s16x4*)a);
    const s16x4 hi = __builtin_amdgcn_ds_read_tr16_b64_v4i16((LAS s16x4*)(a + 4 * 64));
    return __builtin_bit_cast(h8, __builtin_shufflevector(lo, hi, 0, 1, 2, 3, 4, 5, 6, 7));
}
__device__ __forceinline__ h8 tr_frag_krow(LAS unsigned char* img_blk, int rowbase, int s, int lane) {
    const int h = lane >> 5, blk = (lane >> 4) & 1, i16 = lane & 15, q = i16 >> 2, p = i16 & 3;
    LAS unsigned char* a = img_blk + (rowbase + 16 * s + 4 * h + q) * 64 + (16 * blk + 4 * p) * 2;
    const s16x4 lo = __builtin_amdgcn_ds_read_tr16_b64_v4i16((LAS s16x4*)a);
    const s16x4 hi = __builtin_amdgcn_ds_read_tr16_b64_v4i16((LAS s16x4*)(a + 8 * 64));
    return __builtin_bit_cast(h8, __builtin_shufflevector(lo, hi, 0, 1, 2, 3, 4, 5, 6, 7));
}
__device__ __forceinline__ float ret_log2gamma(int hc) { return log2f(1.0f - exp2f(-5.0f - (float)hc)); }
__device__ __forceinline__ h8 scale_h8(const h8& v, float sc) { h8 o;
#pragma unroll
    for (int e = 0; e < 8; ++e) o[e] = (_Float16)((float)v[e] * sc);
    return o; }

__device__ __forceinline__ void mixC1_unit(const Frame& F, int b, int hp, int c) {
    LAS unsigned char* L = F.lds + LDS_GEN;
    const int tid = F.tid, lane = F.lane, wave = F.wave;
    const unsigned char* proj = F.ws + WS_PROJ;
    const int row0 = c == 0 ? MR + b * NMETA : b * SEQ + 128 * (c - 1), Lc = c == 0 ? NMETA : 128;
    __syncthreads();
#pragma unroll 1
    for (int idx = tid; idx < 4096; idx += NTHREADS) {
        const int head = idx >> 11, arr = (idx >> 10) & 1, j = (idx >> 3) & 127, ch = idx & 7, hc = 2 * hp + head;
        h8 v;
#pragma unroll
        for (int e = 0; e < 8; ++e) v[e] = (_Float16)0.f;
        if (j < Lc) { v = *(const h8*)(proj + (arr ? PJ_VC : PJ_KC) + (size_t)(row0 + j) * 512 + hc * 128 + ch * 16);
            if (arr) v = scale_h8(v, exp2f((float)(Lc - 1 - j) * ret_log2gamma(hc))); }
        *(LAS h8*)(L + head * 32768 + arr * 16384 + (ch >> 2) * 8192 + j * 64 + (ch & 3) * 16) = v;
    }
    __syncthreads();
    const int head = wave >> 2, mb = (wave >> 1) & 1, nb = wave & 1, r = lane & 31, h = lane >> 5;
    f32x16 acc;
#pragma unroll
    for (int i = 0; i < 16; ++i) acc[i] = 0.f;
#pragma unroll
    for (int s = 0; s < 8; ++s) { const h8 a = tr_frag_nat(L + head * 32768 + mb * 8192, 0, s, lane), bb = tr_frag_nat(L + head * 32768 + 16384 + nb * 8192, 0, s, lane);
        acc = __builtin_amdgcn_mfma_f32_32x32x16_f16(a, bb, acc, 0, 0, 0); }
    float* U = (float*)(F.ws + WS_U) + ((size_t)((b * 4 + 2 * hp + head) * 129 + c)) * 4096;
#pragma unroll
    for (int i = 0; i < 16; ++i) U[(32 * mb + crow(i, h)) * 64 + 32 * nb + r] = acc[i];
}
__device__ __forceinline__ void mixC1_phase(const Frame& F) {
#pragma unroll 1
    for (int u = F.bid; u < NB * 2 * 129; u += F.G) { const int c = u % 129, bh = u / 129; mixC1_unit(F, bh >> 1, bh & 1, c); }
}
__device__ __forceinline__ void mixC_scan(const Frame& F) {
    if (F.tid >= 128) return;
    const int e = F.bid * 128 + F.tid;
    if (e >= NB * 4 * 4096) return;
    const int bh = e >> 12, el = e & 4095, hc = bh & 3;
    const float lg = ret_log2gamma(hc), g128 = exp2f(128.f * lg), g16 = exp2f(16.f * lg);
    const float* U = (const float*)(F.ws + WS_U) + (size_t)bh * 129 * 4096 + el; float* S = (float*)(F.ws + WS_S) + (size_t)bh * 129 * 4096 + el;
    float st = U[0];
    S[4096] = st;
#pragma unroll 1
    for (int c0 = 1; c0 < 128; c0 += 16) {
        float u[16];
#pragma unroll
        for (int k = 0; k < 16; ++k) u[k] = (c0 + k < 128) ? U[(size_t)(c0 + k) * 4096] : 0.f;
#pragma unroll
        for (int k = 0; k < 16; ++k) if (c0 + k < 128) { st = st * g128 + u[k]; S[(size_t)(c0 + k + 1) * 4096] = st; }
    }
    (void)g16;
}
constexpr int C2_KI = 0, C2_VI = 128 * KS_PITCH, C2_ST = C2_VI + 16384, C2_HEAD = C2_ST + 64 * KS_PITCH;
__device__ __forceinline__ void mixC2_unit(const Frame& F, int l, int b, int hp, int c) {
    LAS unsigned char* L = F.lds + LDS_GEN;
    const int tid = F.tid, lane = F.lane, wave = F.wave, r = lane & 31, h = lane >> 5;
    const unsigned char* proj = F.ws + WS_PROJ;
    const int row0 = c == 0 ? MR + b * NMETA : b * SEQ + 128 * (c - 1), Lc = c == 0 ? NMETA : 128;
    __syncthreads();
#pragma unroll 1
    for (int idx = tid; idx < 4096; idx += NTHREADS) {
        const int head = idx >> 11, arr = (idx >> 10) & 1, j = (idx >> 3) & 127, ch = idx & 7, hc = 2 * hp + head;
        h8 v;
#pragma unroll
        for (int e = 0; e < 8; ++e) v[e] = (_Float16)0.f;
        if (j < Lc) v = *(const h8*)(proj + (arr ? PJ_VC : PJ_KC) + (size_t)(row0 + j) * 512 + hc * 128 + ch * 16);
        if (arr) *(LAS h8*)(L + head * C2_HEAD + C2_VI + (ch >> 2) * 8192 + j * 64 + (ch & 3) * 16) = v;
        else     *(LAS h8*)(L + head * C2_HEAD + C2_KI + j * KS_PITCH + ch * 16) = v;
    }
    if (c > 0) {
#pragma unroll 1
        for (int idx = tid; idx < 2 * 4096; idx += NTHREADS) { const int head = idx >> 12, el = idx & 4095, dk = el >> 6, dv = el & 63;
            const float v = ((const float*)(F.ws + WS_S))[((size_t)((b * 4 + 2 * hp + head) * 129 + c)) * 4096 + el];
            *(LAS _Float16*)(L + head * C2_HEAD + C2_ST + dv * KS_PITCH + dk * 2) = (_Float16)v; }
    }
    __syncthreads();
    const int head = wave >> 2, wq = wave & 3, hc = 2 * hp + head;
    if (wq * 32 < Lc) {
        LAS unsigned char* Hb = L + head * C2_HEAD;
        const int qi = wq * 32 + r, my_row = row0 + qi;
        const float lg = ret_log2gamma(hc);
        h8 qf[4];
#pragma unroll
        for (int s = 0; s < 4; ++s) qf[s] = *(const h8*)(proj + PJ_QC + (size_t)my_row * 512 + hc * 128 + (16 * s + 8 * h) * 2);
        f32x16 O[2];
#pragma unroll
        for (int d = 0; d < 2; ++d)
#pragma unroll
            for (int i = 0; i < 16; ++i) O[d][i] = 0.f;
        if (c > 0) {
#pragma unroll
            for (int d = 0; d < 2; ++d)
#pragma unroll
                for (int s = 0; s < 4; ++s) { const h8 a = *(const LAS h8*)(Hb + C2_ST + (32 * d + r) * KS_PITCH + (16 * s + 8 * h) * 2);
                    O[d] = __builtin_amdgcn_mfma_f32_32x32x16_f16(a, qf[s], O[d], 0, 0, 0); }
            const float qd = exp2f((float)(qi + 1) * lg);
#pragma unroll
            for (int d = 0; d < 2; ++d)
#pragma unroll
                for (int i = 0; i < 16; ++i) O[d][i] *= qd;
        }
#pragma unroll 1
        for (int jb = 0; jb <= wq; ++jb) {
            f32x16 S;
#pragma unroll
            for (int i = 0; i < 16; ++i) S[i] = 0.f;
#pragma unroll
            for (int s = 0; s < 4; ++s) { const h8 kf = *(const LAS h8*)(Hb + C2_KI + (32 * jb + r) * KS_PITCH + (16 * s + 8 * h) * 2);
                S = __builtin_amdgcn_mfma_f32_32x32x16_f16(kf, qf[s], S, 0, 0, 0); }
#pragma unroll
            for (int i = 0; i < 16; ++i) { const int dd = qi - (32 * jb + crow(i, h)); S[i] = dd >= 0 ? S[i] * exp2f((float)dd * lg) : 0.f; }
            h8 pf[2];
#pragma unroll
            for (int s = 0; s < 2; ++s) { u32x4 p; p.x = cvt_pk_f16(S[8 * s + 0], S[8 * s + 1]); p.y = cvt_pk_f16(S[8 * s + 2], S[8 * s + 3]); p.z = cvt_pk_f16(S[8 * s + 4], S[8 * s + 5]); p.w = cvt_pk_f16(S[8 * s + 6], S[8 * s + 7]); pf[s] = __builtin_bit_cast(h8, p); }
#pragma unroll
            for (int d = 0; d < 2; ++d)
#pragma unroll
                for (int s = 0; s < 2; ++s) { const h8 vf = tr_frag_krow(Hb + C2_VI + d * 8192, 32 * jb, s, lane);
                    O[d] = __builtin_amdgcn_mfma_f32_32x32x16_f16(vf, pf[s], O[d], 0, 0, 0); }
        }
        float ss = 0.f;
#pragma unroll
        for (int d = 0; d < 2; ++d)
#pragma unroll
            for (int i = 0; i < 16; ++i) ss += O[d][i] * O[d][i];
        ss += __shfl_xor(ss, 32);
        const float rstd = rsqrtf(ss * (1.0f / 64.0f) + 1e-6f);
        if (qi < Lc) {
            const float* gn = F.ret_norm + l * 256 + hc * 64;
            const _Float16* gc = (const _Float16*)(proj + PJ_GC) + (size_t)my_row * 256 + hc * 64;
            _Float16* dst = (_Float16*)(F.ws + WS_ABUF) + (size_t)my_row * DM + 768 + hc * 64;
#pragma unroll
            for (int d = 0; d < 2; ++d)
#pragma unroll
                for (int g4 = 0; g4 < 4; ++g4) { const int d0 = 32 * d + 8 * g4 + 4 * h; const f32x4 gv = *(const f32x4*)(gn + d0); const h4 gg = *(const h4*)(gc + d0);
                    float o[4];
#pragma unroll
                    for (int e = 0; e < 4; ++e) { const float g = (float)gg[e]; o[e] = O[d][4 * g4 + e] * rstd * gv[e] * (g / (1.0f + __expf(-g))); }
                    u32x2 w; w.x = cvt_pk_f16(o[0], o[1]); w.y = cvt_pk_f16(o[2], o[3]); *(u32x2*)(dst + d0) = w; }
        }
    }
}
__device__ __forceinline__ void mixC2_phase(const Frame& F, int l) {
#pragma unroll 1
    for (int u = F.bid; u < NB * 2 * 129; u += F.G) { const int c = u % 129, bh = u / 129; mixC2_unit(F, l, bh >> 1, bh & 1, c); }
}
constexpr int IDX_HIST = 0, IDX_STATS = 16512, IDX_RNG = 18560, IDX_INFO = 18816, IDX_CCNT = 19072, IDX_MASK = 19456, IDX_CAND = 85248, IDX_Q = IDX_CAND + 32 * 128 * 8, IDX_QPITCH = 1040, IDX_END = IDX_Q + 32 * IDX_QPITCH;
constexpr int IDX_CAP = 128;
static_assert(IDX_END + LDS_GEN <= LDS_BYTES, "indexer LDS");
__device__ __forceinline__ void idx_scores(const LAS unsigned char* qimg_lane, const float (&w)[8], const unsigned char* krow_ptr, int h, f32x16& sc) {
    h8 kf[4];
#pragma unroll
    for (int s = 0; s < 4; ++s) kf[s] = *(const h8*)(krow_ptr + (16 * s + 8 * h) * 2);
#pragma unroll
    for (int i = 0; i < 16; ++i) sc[i] = 0.f;
#pragma unroll
    for (int hd = 0; hd < 8; ++hd) {
        f32x16 S;
#pragma unroll
        for (int i = 0; i < 16; ++i) S[i] = 0.f;
#pragma unroll
        for (int s = 0; s < 4; ++s) { const h8 qv = *(const LAS h8*)(qimg_lane + (hd * 64 + 16 * s) * 2); S = __builtin_amdgcn_mfma_f32_32x32x16_f16(kf[s], qv, S, 0, 0, 0); }
#pragma unroll
        for (int i = 0; i < 16; ++i) sc[i] = __builtin_fmaf(w[hd], fmaxf(S[i], 0.f), sc[i]);
    }
}
__device__ __forceinline__ int idx_bin(float s, float lo, float inv) { const float x = (s - lo) * inv; const int b = (int)fminf(fmaxf(x, 0.f), 255.f); return b; }
__device__ __forceinline__ int suffix_sum(int v, int lane) {
#pragma unroll
    for (int off = 1; off < 64; off <<= 1) { const int t = __shfl_down(v, off); if (lane + off < 64) v += t; }
    return v;
}
__device__ __forceinline__ void mixA_index_unit(const Frame& F, int b, int g) {
    LAS unsigned char* L = F.lds + LDS_GEN;
    const int tid = F.tid, lane = F.lane, wave = F.wave, r = lane & 31, h = lane >> 5;
    const unsigned char* proj = F.ws + WS_PROJ;
    const unsigned char* KI = proj + PJ_KI;
    const int nq = g == 0 ? NMETA : 32;
    const int qrow = g == 0 ? MR + b * NMETA + (r & 15) : b * SEQ + 32 * (g - 1) + r;
    const int tq0 = g == 0 ? 0 : NMETA + 32 * (g - 1);
    const bool qvalid = r < nq;
    auto ks_row0 = [&](int ks) -> int { return ks == 0 ? MR + b * NMETA : b * SEQ + 32 * (ks - 1); };
    __syncthreads();
    for (int i = tid; i < 32 * 129; i += NTHREADS) ((LAS unsigned*)(L + IDX_HIST))[i] = 0u;
    if (tid < 32) ((LAS unsigned*)(L + IDX_CCNT))[tid] = 0u;
    float w[8];
    const LAS unsigned char* qf = L + IDX_Q + r * IDX_QPITCH + 8 * h * 2;
    { for (int i = tid; i < 32 * 64; i += NTHREADS) { const int qq = i >> 6, ch = i & 63; const int qr = g == 0 ? MR + b * NMETA + (qq & 15) : b * SEQ + 32 * (g - 1) + qq;
          *(LAS u32x4*)(L + IDX_Q + qq * IDX_QPITCH + ch * 16) = *(const u32x4*)(proj + PJ_QI + (size_t)qr * 1024 + ch * 16); }
      const float* WI = (const float*)(proj + PJ_WI) + (size_t)qrow * 8; const f32x4 w0 = *(const f32x4*)WI, w1 = *(const f32x4*)(WI + 4);
      w[0] = w0[0]; w[1] = w0[1]; w[2] = w0[2]; w[3] = w0[3]; w[4] = w1[0]; w[5] = w1[1]; w[6] = w1[2]; w[7] = w1[3]; }
    __syncthreads();
    if (wave < 4) {
        f32x16 sc; idx_scores(qf, w, KI + (size_t)(b * SEQ + 32 * wave + r) * 128, h, sc);
        float s1 = 0.f, s2 = 0.f;
#pragma unroll
        for (int i = 0; i < 16; ++i) { s1 += sc[i]; s2 += sc[i] * sc[i]; }
        s1 += __shfl_xor(s1, 32); s2 += __shfl_xor(s2, 32);
        if (h == 0) { ((LAS float*)(L + IDX_STATS))[(wave * 32 + r) * 2] = s1; ((LAS float*)(L + IDX_STATS))[(wave * 32 + r) * 2 + 1] = s2; }
    }
    __syncthreads();
    float lo, inv;
    { float s1 = 0.f, s2 = 0.f;
#pragma unroll
      for (int k = 0; k < 4; ++k) { s1 += ((LAS float*)(L + IDX_STATS))[(k * 32 + r) * 2]; s2 += ((LAS float*)(L + IDX_STATS))[(k * 32 + r) * 2 + 1]; }
      const float mean = s1 * (1.0f / 128.0f), var = fmaxf(s2 * (1.0f / 128.0f) - mean * mean, 0.f), sd = fmaxf(sqrtf(var), 1e-12f);
      lo = mean - 4.0f * sd; inv = 256.0f / (14.0f * sd); }
#pragma unroll 1
    for (int ks = wave; ks <= g; ks += 8) {
        f32x16 sc; idx_scores(qf, w, KI + (size_t)(ks_row0(ks) + r) * 128, h, sc);
#pragma unroll
        for (int i = 0; i < 16; ++i) {
            const int kidx = crow(i, h);
            const bool ok = qvalid && (ks == 0 ? kidx < NMETA && (g > 0 || kidx <= r) : (ks < g || kidx <= r));
            if (ok) { const int bin = idx_bin(sc[i], lo, inv); __hip_atomic_fetch_add((LAS unsigned*)(L + IDX_HIST) + r * 129 + (bin >> 1), 1u << (16 * (bin & 1)), __ATOMIC_RELAXED, __HIP_MEMORY_SCOPE_WORKGROUP); }
        }
    }
    __syncthreads();
#pragma unroll 1
    for (int k = 0; k < 4; ++k) {
        const int row = 4 * wave + k;
        const unsigned wl = ((LAS unsigned*)(L + IDX_HIST))[row * 129 + lane], wh = ((LAS unsigned*)(L + IDX_HIST))[row * 129 + 64 + lane];
        const int c0 = wl & 0xffff, c1 = wl >> 16, c2 = wh & 0xffff, c3 = wh >> 16;
        const int SH = suffix_sum(c2 + c3, lane), TH = __shfl(SH, 0), SL = TH + suffix_sum(c0 + c1, lane), NT = __shfl(SL, 0);
        int bstar = -1, need = 0;
        if (NT > 256) {
            const unsigned long long mh = __ballot(SH >= 256);
            if (mh) { const int lH = 63 - __builtin_clzll(mh); const int sh = __shfl(SH, lH), t2 = __shfl(c2, lH), t3 = __shfl(c3, lH); const int above = sh - t2 - t3;
                if (above + t3 >= 256) { bstar = 128 + 2 * lH + 1; need = 256 - above; } else { bstar = 128 + 2 * lH; need = 256 - above - t3; } }
            else { const unsigned long long ml = __ballot(SL >= 256); const int lL = 63 - __builtin_clzll(ml); const int sl = __shfl(SL, lL), t0 = __shfl(c0, lL), t1 = __shfl(c1, lL); const int above = sl - t0 - t1;
                if (above + t1 >= 256) { bstar = 2 * lL + 1; need = 256 - above; } else { bstar = 2 * lL; need = 256 - above - t1; } }
        }
        if (lane == 0) { ((LAS int*)(L + IDX_INFO))[row * 2] = bstar; ((LAS int*)(L + IDX_INFO))[row * 2 + 1] = need; }
    }
    __syncthreads();
    const int bstar = ((LAS int*)(L + IDX_INFO))[r * 2];
#pragma unroll 1
    for (int ks = wave; ks <= g; ks += 8) {
        f32x16 sc; idx_scores(qf, w, KI + (size_t)(ks_row0(ks) + r) * 128, h, sc);
        unsigned part = 0u;
#pragma unroll
        for (int i = 0; i < 16; ++i) {
            const int kidx = crow(i, h);
            const bool ok = qvalid && (ks == 0 ? kidx < NMETA && (g > 0 || kidx <= r) : (ks < g || kidx <= r));
            if (ok) { const int bin = idx_bin(sc[i], lo, inv);
                if (bin > bstar) part |= 1u << kidx;
                else if (bin == bstar) { const unsigned slot = __hip_atomic_fetch_add((LAS unsigned*)(L + IDX_CCNT) + r, 1u, __ATOMIC_RELAXED, __HIP_MEMORY_SCOPE_WORKGROUP);
                    if (slot < IDX_CAP) { LAS float* cp = (LAS float*)(L + IDX_CAND) + (r * IDX_CAP + slot) * 2; cp[0] = sc[i]; ((LAS int*)cp)[1] = ks * 32 + kidx; } } }
        }
        part |= __shfl_xor(part, 32);
        if (h == 0) ((LAS unsigned*)(L + IDX_MASK))[ks * 32 + r] = part;
    }
    __syncthreads();
#pragma unroll 1
    for (int k = 0; k < 4; ++k) {
        const int row = 4 * wave + k;
        const int need = ((LAS int*)(L + IDX_INFO))[row * 2 + 1];
        int nc = (int)((LAS unsigned*)(L + IDX_CCNT))[row]; nc = nc < IDX_CAP ? nc : IDX_CAP;
        const LAS float* cb = (const LAS float*)(L + IDX_CAND) + row * IDX_CAP * 2;
#pragma unroll 1
        for (int ci = lane; ci < nc; ci += 64) {
            const float sv = cb[ci * 2]; const int kv = ((const LAS int*)cb)[ci * 2 + 1];
            int rank = 0;
            if (need < nc) { for (int j = 0; j < nc; ++j) { const float sj = cb[j * 2]; const int kj = ((const LAS int*)cb)[j * 2 + 1]; rank += (sj > sv || (sj == sv && kj < kv)) ? 1 : 0; } }
            if (rank < need) __hip_atomic_fetch_or((LAS unsigned*)(L + IDX_MASK) + (kv >> 5) * 32 + row, 1u << (kv & 31), __ATOMIC_RELAXED, __HIP_MEMORY_SCOPE_WORKGROUP);
        }
    }
    __syncthreads();
    unsigned* MK = (unsigned*)(F.ws + WS_MASK) + (size_t)b * NKS * TLEN;
    for (int i = tid; i < (g + 1) * 32; i += NTHREADS) { const int ks = i >> 5, rr = i & 31; if (rr < nq) MK[(size_t)ks * TLEN + tq0 + rr] = ((LAS unsigned*)(L + IDX_MASK))[i]; }
}
__device__ __forceinline__ void mixA_index_phase(const Frame& F) {
#pragma unroll 1
    for (int c = F.bid; c < 256; c += F.G) {
#pragma unroll 1
        for (int k = 0; k < 5; ++k) {
            int u; if (k == 0) u = c; else if (k == 1) u = 511 - c; else if (k == 2) u = 512 + c; else if (k == 3) u = 1023 - c; else { if (c >= 2) break; u = 1024 + c; }
            mixA_index_unit(F, u & 1, 512 - (u >> 1));
        }
    }
}

__device__ __forceinline__ void mixA3_unit(const Frame& F, int l, int b, int ha, int qblk) {
    LAS unsigned char* L = F.lds + LDS_GEN;
    const int tid = F.tid, lane = F.lane, wave = F.wave, r = lane & 31, h = lane >> 5;
    const unsigned char* proj = F.ws + WS_PROJ;
    const _Float16* QA = (const _Float16*)(proj + PJ_QA); const unsigned char* KA = proj + PJ_KA; const unsigned char* VA = proj + PJ_VA;
    const unsigned* kmax = (const unsigned*)(F.ws + WS_CTL) + CW_KMAX + 32 * l;
    const unsigned* MK = (const unsigned*)(F.ws + WS_MASK) + (size_t)b * NKS * TLEN;
    const bool meta_u = qblk < 0;
    const int qrow0 = meta_u ? MR + b * NMETA : b * SEQ + qblk * 256;
    const int qpos0 = meta_u ? 0 : NMETA + qblk * 256;
    const int nreal = meta_u ? 0 : 4 * qblk + 4;
    const int wq0 = 32 * wave;
    const bool wave_on = meta_u ? (wave == 0) : true;
    const int my_row = wave_on ? qrow0 + wq0 + r : qrow0, my_pos = wave_on ? qpos0 + wq0 + r : 0;
    __syncthreads();
    if (tid < 128) ((LAS float*)(L + B_LUT))[tid] = F.rel_bias[BUCKET_LUT[tid] * 12 + ha] * LOG2E;
    float bmax = (lane < 32) ? F.rel_bias[lane * 12 + ha] * LOG2E : -1e30f;
    bmax = fmaxf(bmax, __shfl_xor(bmax, 16)); bmax = fmaxf(bmax, __shfl_xor(bmax, 8)); bmax = fmaxf(bmax, __shfl_xor(bmax, 4)); bmax = fmaxf(bmax, __shfl_xor(bmax, 2)); bmax = fmaxf(bmax, __shfl_xor(bmax, 1));
    bmax = __shfl(bmax, 0);
    const float bfar = F.rel_bias[31 * 12 + ha] * LOG2E;
    h8 qf[4]; float mq;
    { float n2 = 0.f;
#pragma unroll
      for (int s = 0; s < 4; ++s) { qf[s] = *(const h8*)(QA + (size_t)my_row * 512 + ha * 64 + 16 * s + 8 * h);
#pragma unroll
          for (int j = 0; j < 8; ++j) { const float v = (float)qf[s][j]; n2 += v * v; } }
      n2 += __shfl_xor(n2, 32);
      mq = sqrtf(n2 * (__uint_as_float(kmax[ha * 2]) + __uint_as_float(kmax[ha * 2 + 1]))) * 1.002f + bmax; }
    f32x16 cfar;
#pragma unroll
    for (int i = 0; i < 16; ++i) cfar[i] = bfar - mq;
    f32x16 O[2]; float lsum = 0.f;
#pragma unroll
    for (int d = 0; d < 2; ++d)
#pragma unroll
        for (int i = 0; i < 16; ++i) O[d][i] = 0.f;
    const int skey = tid >> 3, sch = tid & 7;
    const unsigned kdst = skey * KS_PITCH + sch * 16, vdst = (sch >> 2) * 4096 + skey * 64 + (sch & 3) * 16;
    const int ntiles = 1 + nreal;
    auto tile_row0 = [&](int t) -> int { return t == 0 ? MR + b * NMETA : b * SEQ + (t - 1) * 64; };
    u32x4 kreg, vreg;
    { const size_t rr = (size_t)(tile_row0(0) + skey); kreg = *(const u32x4*)(KA + rr * 1024 + ha * 128 + sch * 16); vreg = *(const u32x4*)(VA + rr * 1024 + ha * 128 + sch * 16); }
    *(LAS u32x4*)(L + B_KS + kdst) = kreg; *(LAS u32x4*)(L + B_VS + vdst) = vreg;
    __syncthreads();
#pragma unroll 1
    for (int t = 0; t < ntiles; ++t) {
        const int buf = t & 1;
        if (t + 1 < ntiles) { const size_t rr = (size_t)(tile_row0(t + 1) + skey); kreg = *(const u32x4*)(KA + rr * 1024 + ha * 128 + sch * 16); vreg = *(const u32x4*)(VA + rr * 1024 + ha * 128 + sch * 16); }
        const int kpos0 = (t == 0) ? 0 : NMETA + (t - 1) * 64, nvalid = (t == 0) ? NMETA : 64;
        const int wpos0 = qpos0 + wq0;
        if (wave_on && kpos0 <= wpos0 + 31) {
            LAS unsigned char* Kb = L + B_KS + buf * (64 * KS_PITCH); LAS unsigned char* Vb = L + B_VS + buf * 8192;
            const bool slow = (t == 0) || (kpos0 + 63 > wpos0 - 128);
#pragma unroll
            for (int sub = 0; sub < 2; ++sub) {
                if (sub * 32 >= nvalid || kpos0 + sub * 32 > wpos0 + 31) continue;
                const int ks = (t == 0) ? 0 : 1 + 2 * (t - 1) + sub;
                const unsigned mword = MK[(size_t)ks * TLEN + my_pos] >> (4 * h);
                f32x16 S;
                if (slow) {
#pragma unroll
                    for (int i = 0; i < 16; ++i) S[i] = 0.f; } else S = cfar;
#pragma unroll
                for (int s = 0; s < 4; ++s) { const h8 kf = *(const LAS h8*)(Kb + (sub * 32 + r) * KS_PITCH + (16 * s + 8 * h) * 2);
                    S = __builtin_amdgcn_mfma_f32_32x32x16_f16(kf, qf[s], S, 0, 0, 0); }
                if (slow) {
#pragma unroll
                    for (int i = 0; i < 16; ++i) {
                        const int kidx = sub * 32 + crow(i, h), dist = my_pos - (kpos0 + kidx);
                        const bool ok = ((mword >> ((i & 3) + 8 * (i >> 2))) & 1u) != 0u && dist >= 0 && kidx < nvalid;
                        const float bias = ((const LAS float*)(L + B_LUT))[min(max(dist, 0), 127)];
                        S[i] = ok ? __builtin_amdgcn_exp2f(S[i] + bias - mq) : 0.f;
                    }
                } else {
#pragma unroll
                    for (int i = 0; i < 16; ++i) S[i] = ((mword >> ((i & 3) + 8 * (i >> 2))) & 1u) ? __builtin_amdgcn_exp2f(S[i]) : 0.f;
                }
                { float a = 0.f;
#pragma unroll
                  for (int i = 0; i < 16; ++i) a += S[i];
                  lsum += a; }
                bf16x8v pf[2]; pf[0] = pack_p(S, 0); pf[1] = pack_p(S, 1);
#pragma unroll
                for (int d = 0; d < 2; ++d)
#pragma unroll
                    for (int s = 0; s < 2; ++s) { const bf16x8v vf = vt_frag(Vb, d, sub * 32, s, lane); O[d] = __builtin_amdgcn_mfma_f32_32x32x16_bf16(vf, pf[s], O[d], 0, 0, 0); }
            }
        }
        if (t + 1 < ntiles) { *(LAS u32x4*)(L + B_KS + (buf ^ 1) * (64 * KS_PITCH) + kdst) = kreg; *(LAS u32x4*)(L + B_VS + (buf ^ 1) * 8192 + vdst) = vreg; }
        __syncthreads();
    }
    if (wave_on) {
        const float lt = lsum + __shfl_xor(lsum, 32), il = 1.0f / lt;
        if (!meta_u || r < NMETA) {
            _Float16* dst = (_Float16*)(F.ws + WS_ABUF) + (size_t)my_row * DM + ha * 64;
#pragma unroll
            for (int d = 0; d < 2; ++d)
#pragma unroll
                for (int g4 = 0; g4 < 4; ++g4) { const int d0 = 32 * d + 8 * g4 + 4 * h;
                    u32x2 w; w.x = cvt_pk_f16(O[d][4 * g4 + 0] * il, O[d][4 * g4 + 1] * il); w.y = cvt_pk_f16(O[d][4 * g4 + 2] * il, O[d][4 * g4 + 3] * il);
                    *(u32x2*)(dst + d0) = w; }
        }
    }
}
__device__ __forceinline__ void mixA3_phase(const Frame& F, int l) {
#pragma unroll 1
    for (int c = F.bid; c < 256; c += F.G) { const int bh = c & 15, i1 = c >> 4, i2 = 31 - i1;
#pragma unroll 1
        for (int k = 0; k < 5; ++k) { if (k == 4 && c >= 16) break;
            const int qb = k == 0 ? 63 - i1 : (k == 1 ? 32 + i1 : (k == 2 ? i2 : (k == 3 ? i1 : -1)));
            mixA3_unit(F, l, bh >> 3, bh & 7, qb); }
    }
}
constexpr int NPHASES = 19;
__global__ void __launch_bounds__(NTHREADS, 2) fwd(Args args) {
    extern __shared__ __attribute__((aligned(16))) unsigned char lds_raw[];
    Frame F;
    F.x = args.in[0]; F.meta = args.in[1]; F.rel_bias = args.in[2]; F.w_in = args.in[3]; F.norm_mix = args.in[4]; F.diff_lambda = args.in[5]; F.diff_norm = args.in[6];
    F.ret_norm = args.in[7]; F.w_out = args.in[8]; F.norm_ff = args.in[9]; F.w_ff1 = args.in[10]; F.w_ff2 = args.in[11]; F.final_norm = args.in[12];
    F.out = args.out; F.ws = args.ws; F.lds = (LAS unsigned char*)lds_raw;
    F.bid = blockIdx.x; F.G = gridDim.x; F.tid = threadIdx.x; F.lane = F.tid & 63; F.wave = __builtin_amdgcn_readfirstlane(F.tid >> 6);
    if (F.tid < 64) ((LAS unsigned*)(F.lds + LDS_MISC))[F.tid] = 0u;
    __syncthreads();
    unsigned* ctl = (unsigned*)(F.ws + WS_CTL);
    XcdBarrier bar = xcd_barrier_post(ctl + CW_BAR, (volatile LAS unsigned*)(F.lds + LDS_MISC));
    const int lo = args.ph_lo, hi = args.ph_hi;
#define IN(k) (lo <= (k) && (k) < hi)
#define SEAM(k) do { if (IN(k) && IN((k) + 1)) xcd_barrier(bar); } while (0)
    LAS unsigned char* stage = F.lds + LDS_GEN;
    if (IN(0)) { prologue(F); SEAM(0); }
#pragma unroll 1
    for (int l = 0; l < DEPTH; ++l) {
        const int pb = 1 + 9 * l;
        { int t_ = threadIdx.x; asm volatile("" : "+v"(t_)); F.tid = t_; F.lane = t_ & 63;
          unsigned char* w_ = args.ws; float* o_ = args.out; int b_ = blockIdx.x, g_ = gridDim.x; asm volatile("" : "+s"(w_), "+s"(o_), "+s"(b_), "+s"(g_)); F.ws = w_; F.out = o_; F.bid = b_; F.G = g_; }
        unsigned char* wl = F.ws + WS_W + (size_t)l * W_LAYER;
        unsigned char* proj = F.ws + WS_PROJ;
        if (IN(pb + 0)) {
            pg8::Gemm g{(const pg8::bf16_t*)(F.ws + WS_ABUF), (const pg8::bf16_t*)(wl + W_IN_OFF), MP, NPAD, DM}; pg8::StaticOrder S; S.init(MP, NPAD, F.G, F.bid);
            EpiInProj E{proj, (const f32x2*)(F.ws + WS_ROPE), ctl + CW_KMAX + 32 * l};
            pg8::gemm_phase<EpiInProj, pg8::StaticOrder>(stage, g, S, E, nullptr);
            SEAM(pb + 0);
        }
        if (IN(pb + 1)) { mixA_index_phase(F); mixC1_phase(F); SEAM(pb + 1); }
        if (IN(pb + 2)) { mixC_scan(F); mixB_phase(F, l); SEAM(pb + 2); }
        if (IN(pb + 3)) { mixA3_phase(F, l); mixC2_phase(F, l); SEAM(pb + 3); }
        if (IN(pb + 4)) {
            pg8::Gemm g{(const pg8::bf16_t*)(F.ws + WS_ABUF), (const pg8::bf16_t*)(wl + W_OUT_OFF), MP, DM, DM}; pg8::StaticOrder S; S.init(MP, DM, F.G, F.bid);
            EpiRes E{l == 0 ? F.x : F.out, F.out, (float*)(F.ws + WS_HMETA)};
            pg8::gemm_phase<EpiRes, pg8::StaticOrder>(stage, g, S, E, nullptr);
            SEAM(pb + 4);
        }
        if (IN(pb + 5)) { norm_to_abuf<1>(F, F.norm_ff + (size_t)l * DM); SEAM(pb + 5); }
        if (IN(pb + 6)) {
            pg8::Gemm g{(const pg8::bf16_t*)(F.ws + WS_ABUF), (const pg8::bf16_t*)(wl + W_FF1_OFF), MP, DFF, DM}; pg8::StaticOrder S; S.init(MP, DFF, F.G, F.bid);
            EpiRelu2 E{proj};
            pg8::gemm_phase<EpiRelu2, pg8::StaticOrder>(stage, g, S, E, nullptr);
            SEAM(pb + 6);
        }
        if (IN(pb + 7)) {
            pg8::Gemm g{(const pg8::bf16_t*)proj, (const pg8::bf16_t*)(wl + W_FF2_OFF), MP, DM, DFF}; pg8::StaticOrder S; S.init(MP, DM, F.G, F.bid);
            EpiRes E{F.out, F.out, (float*)(F.ws + WS_HMETA)};
            pg8::gemm_phase<EpiRes, pg8::StaticOrder>(stage, g, S, E, nullptr);
            SEAM(pb + 7);
        }
        if (IN(pb + 8)) {
            if (l + 1 < DEPTH) { norm_to_abuf<1>(F, F.norm_mix + (size_t)(l + 1) * DM); SEAM(pb + 8); }
            else final_norm(F);
        }
    }
#undef IN
#undef SEAM
}

#ifndef MK_SPLIT
#define MK_SPLIT 0
#endif
extern "C" void kernel_launch(void* const* d_in, const int* in_sizes, int n_in, void* d_out, int out_size, void* d_ws, size_t ws_size, hipStream_t stream) {
    static int grid = 0;
    if (grid == 0) {
        if (n_in != 13 || ws_size < WS_END) { fprintf(stderr, "kernel_launch: need 13 inputs and %zu bytes of workspace; got %d, %zu\n", (size_t)WS_END, n_in, ws_size); grid = -1; return; }
        int dev = 0, cus = 0, per_cu = 0;
        if (hipGetDevice(&dev) != hipSuccess || hipDeviceGetAttribute(&cus, hipDeviceAttributeMultiprocessorCount, dev) != hipSuccess) { grid = -1; return; }
        if (hipFuncSetAttribute((const void*)fwd, hipFuncAttributeMaxDynamicSharedMemorySize, LDS_BYTES) != hipSuccess) { fprintf(stderr, "kernel_launch: hipFuncSetAttribute failed\n"); grid = -1; return; }
        if (hipOccupancyMaxActiveBlocksPerMultiprocessor(&per_cu, (const void*)fwd, NTHREADS, LDS_BYTES) != hipSuccess || per_cu < 1) { fprintf(stderr, "kernel_launch: occupancy query says %d\n", per_cu); }
        (void)hipGetLastError();
        grid = cus;
    }
    if (grid < 0) return;
    (void)hipMemsetAsync((char*)d_ws + WS_CTL, 0, CTL_BYTES, stream);
    Args a{};
    for (int i = 0; i < 13; ++i) a.in[i] = (const float*)d_in[i];
    a.out = (float*)d_out; a.ws = (unsigned char*)d_ws;
#if MK_SPLIT
    for (int p = 0; p < NPHASES; ++p) { a.ph_lo = p; a.ph_hi = p + 1; hipLaunchKernelGGL(fwd, dim3(grid), dim3(NTHREADS), LDS_BYTES, stream, a); }
#else
    a.ph_lo = 0; a.ph_hi = NPHASES; hipLaunchKernelGGL(fwd, dim3(grid), dim3(NTHREADS), LDS_BYTES, stream, a);
#endif
}
```

```cpp
#include <hip/hip_runtime.h>
#include <cstdio>
#include <cstdint>
typedef _Float16 h8 __attribute__((ext_vector_type(8)));
typedef _Float16 h4 __attribute__((ext_vector_type(4)));
typedef _Float16 h2 __attribute__((ext_vector_type(2)));
typedef short s16x8 __attribute__((ext_vector_type(8)));
typedef short s16x4 __attribute__((ext_vector_type(4)));
typedef float f32x16 __attribute__((ext_vector_type(16)));
typedef float f32x2 __attribute__((ext_vector_type(2)));
typedef unsigned u32x2 __attribute__((ext_vector_type(2)));
namespace pg8 {
#define PG8_LAS __attribute__((address_space(3)))
typedef unsigned short bf16_t;
typedef short bf16x8 __attribute__((ext_vector_type(8)));
typedef float f32x4 __attribute__((ext_vector_type(4)));
typedef unsigned u32x4 __attribute__((ext_vector_type(4)));
constexpr int BM = 256, BK = 64, HALF = 128, HTB = HALF * BK * 2  , STAGE_BYTES = 8 * HTB, NXCD = 8, WGM = 8;

__host__ __device__ __forceinline__ int lds_byte(int r, int c) { const int st = (r >> 4) * 2 + (c >> 5), rr = r & 15, cc = c & 31, ob = rr * 64 + cc * 2; return st * 1024 + (ob ^ (((ob >> 9) & 1) << 5)); }
__host__ __device__ __forceinline__ void stage_rc(int b, int& R, int& C) { const int st = b / 1024, sb = b % 1024, swz = sb ^ (((sb >> 9) & 1) << 5); R = (st >> 1) * 16 + swz / 64; C = (st & 1) * 32 + (swz % 64) / 2; }
__host__ __device__ __forceinline__ int perm32(int rho) { const int n = rho >> 4, i = rho & 15; return 8 * (i >> 2) + 4 * n + (i & 3); }

struct Unit { int pm, pn; };
struct Gemm { const bf16_t* A; const bf16_t* Bt; int M, N, K; };

struct StaticOrder {
    int nM, nN, nwg, G, c;
    __host__ __device__ void init(int M, int N, int G_, int c_) { nM = M / BM; nN = N / BM; nwg = nM * nN; G = G_; c = c_; }
    __host__ __device__ bool next(int i, Unit& u) const {
        const long L = (long)i * G + c; if (L >= nwg) return false;
        int wgid = (int)L; { const int q = nwg / NXCD, r = nwg % NXCD, xcd = wgid % NXCD, off = wgid / NXCD; wgid = (xcd < r ? xcd * (q + 1) : r * (q + 1) + (xcd - r) * q) + off; }
        const int nig = WGM * nN, gid = wgid / nig, fm = gid * WGM, gsz = (nM - fm) < WGM ? (nM - fm) : WGM;
        u.pm = fm + ((wgid % nig) % gsz); u.pn = (wgid % nig) / gsz; return true;
    }
    __device__ __forceinline__ void a_ready(const Unit&) const {}
    __device__ __forceinline__ void done(const Unit&) const {}
};

template <class Epi, class Sched, bool STAMP = false>
__device__ __forceinline__ void gemm_phase(PG8_LAS unsigned char* lds, const Gemm g, const Sched& S, const Epi& E, unsigned long long* stamps, int tid_in) {
    int tid_ = tid_in; asm volatile("" : "+v"(tid_));
    const int tid = tid_, wid = __builtin_amdgcn_readfirstlane(tid >> 6), lane = tid & 63, wr = wid >> 2, wc = wid & 3, fr = lane & 15, fq = lane >> 4;
    const int K = g.K, nt = K / BK;
    int ts_lo = 0, ts_hi = 0, nts = 0; const unsigned long long rt_entry = STAMP ? (unsigned long long)wall_clock64() : 0ull;
#define PG8_STAMP() do { if (STAMP && wid == 0 && nts < 64) { const unsigned long long _c = (unsigned long long)clock64(); \
        ts_lo = (lane == nts) ? (int)(unsigned)_c : ts_lo; ts_hi = (lane == nts) ? (int)(unsigned)(_c >> 32) : ts_hi; ++nts; } } while (0)
    PG8_STAMP();
    unsigned voffA[2], voffB[2];
#pragma unroll
    for (int i = 0; i < 2; ++i) { int R, C; stage_rc(tid * 16 + i * 8192, R, C); const int Rb = Epi::PERM ? ((R & ~31) + perm32(R & 31)) : R;
        voffA[i] = (unsigned)(R * K + C) * 2u; voffB[i] = (unsigned)(Rb * K + C) * 2u; }
    const size_t kstep = (size_t)(BK * 2);
    const size_t hstep = (size_t)HALF * K * 2;
    const size_t tstep = 2 * hstep;
    const unsigned ldsw = (unsigned)wid * 1024u;
    const int aoff = lds_byte(wr * 64 + fr, fq * 8), boff = lds_byte(wc * 32 + fr, fq * 8);
#define PG8_SA(b, h) (((b) * 2 + (h)) * HTB)
#define PG8_SB(b, h) ((4 + (b) * 2 + (h)) * HTB)
#define PG8_STAGE(bufoff, gbase, voff) do { _Pragma("unroll") for (int _i = 0; _i < 2; ++_i) \
        __builtin_amdgcn_global_load_lds((const unsigned*)((const char*)(gbase) + (voff)[_i]), (PG8_LAS unsigned*)(lds + (bufoff) + ldsw + _i * 8192), 16, 0, 0); } while (0)
#define PG8_LDA(dst, b, h) do { _Pragma("unroll") for (int m = 0; m < 4; ++m) _Pragma("unroll") for (int k = 0; k < 2; ++k) dst[m][k] = *(const PG8_LAS bf16x8*)(lds + PG8_SA(b, h) + aoff + m * 2048 + k * 1024); } while (0)
#define PG8_LDB(dst, b, h) do { _Pragma("unroll") for (int n = 0; n < 2; ++n) _Pragma("unroll") for (int k = 0; k < 2; ++k) dst[n][k] = *(const PG8_LAS bf16x8*)(lds + PG8_SB(b, h) + boff + n * 2048 + k * 1024); } while (0)
#define PG8_MMA(ai, bj, At, Bt) do { __builtin_amdgcn_s_setprio(1); _Pragma("unroll") for (int m = 0; m < 4; ++m) _Pragma("unroll") for (int n = 0; n < 2; ++n) _Pragma("unroll") for (int k = 0; k < 2; ++k) \
        acc[ai][bj][m][n] = __builtin_amdgcn_mfma_f32_16x16x32_f16(__builtin_bit_cast(h8, Bt[n][k]), __builtin_bit_cast(h8, At[m][k]), acc[ai][bj][m][n], 0, 0, 0); __builtin_amdgcn_s_setprio(0); } while (0)
#define PG8_WAIT_V(n) asm volatile("s_waitcnt vmcnt(" #n ")" ::: "memory")
#define PG8_WAIT_L(n) asm volatile("s_waitcnt lgkmcnt(" #n ")" ::: "memory")
#define PG8_BAR __builtin_amdgcn_s_barrier()
#define PG8_SCHED __builtin_amdgcn_sched_barrier(0)
    Unit cur, nxt; int ui = 0;
    if (!S.next(0, cur)) return;
    f32x4 acc[2][2][4][2];
#pragma unroll
    for (int a = 0; a < 2; ++a)
#pragma unroll
        for (int b = 0; b < 2; ++b)
#pragma unroll
            for (int m = 0; m < 4; ++m)
#pragma unroll
                for (int n = 0; n < 2; ++n) acc[a][b][m][n] = (f32x4){0.f, 0.f, 0.f, 0.f};
    bf16x8 At[4][2], B0[2][2], B1[2][2];
    const char* cA = (const char*)g.A + (size_t)cur.pm * tstep; const char* cB = (const char*)g.Bt + (size_t)cur.pn * tstep;
    S.a_ready(cur);
    PG8_STAGE(PG8_SB(0, 0), cB, voffB); PG8_STAGE(PG8_SA(0, 0), cA, voffA); PG8_STAGE(PG8_SB(0, 1), cB + hstep, voffB); PG8_STAGE(PG8_SA(0, 1), cA + hstep, voffA);
    if (wr == 1) PG8_BAR;
    PG8_WAIT_V(4); PG8_BAR;
    PG8_STAGE(PG8_SB(1, 0), cB + kstep, voffB); PG8_STAGE(PG8_SA(1, 0), cA + kstep, voffA); PG8_STAGE(PG8_SB(1, 1), cB + hstep + kstep, voffB);
    PG8_WAIT_V(6); PG8_BAR;
    PG8_STAMP();
    for (;;) {
        const bool has_next = S.next(ui + 1, nxt);
        const char* nA = has_next ? (const char*)g.A + (size_t)nxt.pm * tstep : cA; const char* nB = has_next ? (const char*)g.Bt + (size_t)nxt.pn * tstep : cB;
        for (int t = 0; t < nt; t += 2) {
            const bool last = (t == nt - 2);
            const char* a1 = cA + (size_t)(t + 1) * kstep;
            const char* a2 = last ? nA : cA + (size_t)(t + 2) * kstep; const char* b2 = last ? nB : cB + (size_t)(t + 2) * kstep;
            const char* a3 = a2 + kstep; const char* b3 = b2 + kstep;
            if (last && has_next) S.a_ready(nxt);
            PG8_LDB(B0, 0, 0); PG8_SCHED; PG8_LDA(At, 0, 0); PG8_STAGE(PG8_SA(1, 1), a1 + hstep, voffA);
            PG8_WAIT_L(8); PG8_BAR; PG8_WAIT_L(0); PG8_MMA(0, 0, At, B0); PG8_BAR; PG8_SCHED;
            PG8_LDB(B1, 0, 1); PG8_STAGE(PG8_SB(0, 0), b2, voffB);
            PG8_BAR; PG8_WAIT_L(0); PG8_MMA(0, 1, At, B1); PG8_BAR;
            PG8_LDA(At, 0, 1); PG8_STAGE(PG8_SA(0, 0), a2, voffA);
            PG8_BAR; PG8_WAIT_L(0); PG8_MMA(1, 0, At, B0); PG8_BAR; PG8_SCHED;
            PG8_STAGE(PG8_SB(0, 1), b2 + hstep, voffB);
            PG8_WAIT_V(6); PG8_BAR; PG8_MMA(1, 1, At, B1); PG8_BAR;
            PG8_LDB(B0, 1, 0); PG8_SCHED; PG8_LDA(At, 1, 0); PG8_STAGE(PG8_SA(0, 1), a2 + hstep, voffA);
            PG8_WAIT_L(8); PG8_BAR; PG8_WAIT_L(0); PG8_MMA(0, 0, At, B0); PG8_BAR; PG8_SCHED;
            PG8_LDB(B1, 1, 1); PG8_STAGE(PG8_SB(1, 0), b3, voffB);
            PG8_BAR; PG8_WAIT_L(0); PG8_MMA(0, 1, At, B1); PG8_BAR;
            PG8_LDA(At, 1, 1); PG8_STAGE(PG8_SA(1, 0), a3, voffA);
            PG8_BAR; PG8_WAIT_L(0); PG8_MMA(1, 0, At, B0); PG8_BAR; PG8_SCHED;
            PG8_STAGE(PG8_SB(1, 1), b3 + hstep, voffB);
            PG8_WAIT_V(6); PG8_BAR; PG8_MMA(1, 1, At, B1); PG8_BAR;
        }
        PG8_STAMP();
        if constexpr (!Epi::AFTER_DRAIN) { E(acc, cur, wr, wc, fr, fq); S.done(cur); }
        PG8_STAMP();
        if (!has_next) break;
#pragma unroll
        for (int a = 0; a < 2; ++a)
#pragma unroll
            for (int b = 0; b < 2; ++b)
#pragma unroll
                for (int m = 0; m < 4; ++m)
#pragma unroll
                    for (int n = 0; n < 2; ++n) acc[a][b][m][n] = (f32x4){0.f, 0.f, 0.f, 0.f};
        cur = nxt; cA = nA; cB = nB; ++ui;
    }
    PG8_WAIT_V(0);
    if (wr == 0) PG8_BAR;
    PG8_BAR;
    if constexpr (Epi::AFTER_DRAIN) { E.fused(acc, cur, wr, wc, fr, fq, lds, wid, lane); S.done(cur); }
    PG8_STAMP();
    if (STAMP && wid == 0) { stamps[lane] = lane < nts ? (((unsigned long long)(unsigned)ts_hi << 32) | (unsigned)ts_lo) : 0ull;
        if (lane == 62) stamps[62] = rt_entry; if (lane == 63) stamps[63] = (unsigned long long)wall_clock64(); }
#undef PG8_STAMP
#undef PG8_SA
#undef PG8_SB
#undef PG8_STAGE
#undef PG8_LDA
#undef PG8_LDB
#undef PG8_MMA
#undef PG8_WAIT_V
#undef PG8_WAIT_L
#undef PG8_BAR
#undef PG8_SCHED
}
}

#define XB_TMO      128
#define XB_XCNT(j)  (256  + 64 * (j))
#define XB_XSUB(j)  (1280 + 64 * (j))
#define XB_XGEN(j)  (2304 + 64 * (j))
#define XB_TOP      3328
#define XB_TOPGEN   3392
#define XCD_BAR_WORDS 3456
#define XB_SPIN_CAP (1u << 18)
#define LAS __attribute__((address_space(3)))

__device__ __forceinline__ unsigned xb_ld(unsigned* p)              { return __hip_atomic_load(p, __ATOMIC_RELAXED, __HIP_MEMORY_SCOPE_AGENT); }
__device__ __forceinline__ unsigned xb_add(unsigned* p, unsigned v) { return __hip_atomic_fetch_add(p, v, __ATOMIC_RELAXED, __HIP_MEMORY_SCOPE_AGENT); }
__device__ __forceinline__ unsigned xb_xcc_id() { return (unsigned)__builtin_amdgcn_s_getreg((3 << 11) | 20) & 0xFu; }
#define XB_SPIN(cond, bar) do { unsigned _sp = 0; while (cond) { __builtin_amdgcn_s_sleep(1); \
    if ((++_sp & 255u) == 0u) { if (xb_ld(&(bar)[XB_TMO])) break; if (_sp > XB_SPIN_CAP) { atomicAdd(&(bar)[XB_TMO], 1u); break; } } } } while (0)

struct XcdBarrier {
    unsigned* bar; unsigned x;
    volatile LAS unsigned* st;
};

__device__ __forceinline__ XcdBarrier xcd_barrier_post(unsigned* bar, volatile LAS unsigned* st) {
    XcdBarrier b; b.bar = bar; b.x = xb_xcc_id(); b.st = st;
    if (threadIdx.x == 0) (void)xb_add(&bar[XB_XCNT(b.x)], 1u);
    return b;
}
__device__ __forceinline__ void xcd_barrier_complete(unsigned* bar, unsigned x, unsigned& nloc, unsigned& nx) {
    const unsigned G = gridDim.x * gridDim.y * gridDim.z;
    unsigned sum, cnt, mine, sp = 0u;
    for (;;) {
        sum = 0u; cnt = 0u; mine = 0u;
#pragma unroll
        for (unsigned j = 0; j < 16; ++j) { const unsigned c = xb_ld(&bar[XB_XCNT(j)]); sum += c; cnt += (c > 0u) ? 1u : 0u; mine = (j == x) ? c : mine; }
        if (sum == G) break;
        __builtin_amdgcn_s_sleep(1);
        if ((++sp & 255u) == 0u) { if (xb_ld(&bar[XB_TMO])) break; if (sp > XB_SPIN_CAP) { atomicAdd(&bar[XB_TMO], 1u); break; } }
    }
    nloc = mine > 0u ? mine : 1u; nx = cnt > 0u ? cnt : 1u;
}

__device__ __forceinline__ void xcd_barrier(const XcdBarrier& b, const bool leader_thread) {
    asm volatile("s_waitcnt vmcnt(0)" ::: "memory");
    __syncthreads();
    if (leader_thread) {
        unsigned* bar = b.bar;
        __builtin_amdgcn_s_waitcnt(0);
        unsigned nloc = b.st[0], nx = b.st[1];
        if (nloc == 0u) { xcd_barrier_complete(bar, b.x, nloc, nx); b.st[0] = nloc; b.st[1] = nx; }
        const unsigned old = xb_add(&bar[XB_XSUB(b.x)], 1u);
        const unsigned gen = old / nloc;
        if (old + 1u == (gen + 1u) * nloc) {
            __builtin_amdgcn_fence(__ATOMIC_RELEASE, "agent");
            asm volatile("s_waitcnt vmcnt(0)" ::: "memory");
            const unsigned og = xb_add(&bar[XB_TOP], 1u);
            const unsigned tg = og / nx;
            if (og + 1u == (tg + 1u) * nx) xb_add(&bar[XB_TOPGEN], 1u);
            else XB_SPIN(xb_ld(&bar[XB_TOPGEN]) == tg, bar);
            __builtin_amdgcn_fence(__ATOMIC_ACQUIRE, "agent");
            xb_add(&bar[XB_XGEN(b.x)], 1u);
            asm volatile("s_waitcnt vmcnt(0)" ::: "memory");
        } else {
            XB_SPIN(xb_ld(&bar[XB_XGEN(b.x)]) == gen, bar);
            __builtin_amdgcn_fence(__ATOMIC_ACQUIRE, "agent");
            asm volatile("s_waitcnt vmcnt(0)" ::: "memory");
        }
    }
    __syncthreads();
}

constexpr int NB = 2, SEQ = 16384, TLEN = 16400, DM = 1024, NMETA = 16, DEPTH = 2;
constexpr int MR = NB * SEQ;
constexpr int MV = MR + NB * NMETA;
constexpr int MP = 33024;
constexpr int INCOLS = 3912, NPAD = 4096, DFF = 4096;
constexpr int NTHREADS = 512;
constexpr float LOG2E = 1.4426950408889634f;
constexpr float QA_SCALE = 0.125f * LOG2E;
constexpr float QB_SCALE = 0.17677669529663687f * LOG2E;
constexpr float WI_SCALE = 0.044194173824159216f;
constexpr int NKS = 513;

constexpr size_t al256(size_t x) { return (x + 255) & ~(size_t)255; }
constexpr size_t WS_CTL   = 0;
constexpr size_t CTL_BYTES = 65536;
constexpr size_t WS_HMETA = CTL_BYTES;
constexpr size_t WS_ROPE  = WS_HMETA + (size_t)256 * DM * 4;
constexpr size_t WS_W     = al256(WS_ROPE + (size_t)TLEN * 32 * 8);
constexpr size_t W_IN_OFF = 0, W_OUT_OFF = (size_t)NPAD * DM * 2, W_FF1_OFF = W_OUT_OFF + (size_t)DM * DM * 2,
                 W_FF2_OFF = W_FF1_OFF + (size_t)DFF * DM * 2, W_LAYER = W_FF2_OFF + (size_t)DM * DFF * 2;
constexpr size_t WS_ABUF  = al256(WS_W + DEPTH * W_LAYER);
constexpr size_t WS_MASK  = WS_ABUF + (size_t)MP * DM * 2;
constexpr size_t WS_U     = al256(WS_MASK + (size_t)NB * NKS * TLEN * 4);
constexpr size_t WS_S     = WS_U + (size_t)NB * 4 * 129 * 4096 * 4;
constexpr size_t WS_PROJ  = WS_S + (size_t)NB * 4 * 129 * 4096 * 4;
constexpr size_t P512 = (size_t)MP * 512 * 2, P256 = (size_t)MP * 256 * 2;
constexpr size_t PJ_QA = 0, PJ_KA = P512, PJ_VA = 2 * P512, PJ_QI = 3 * P512, PJ_256 = 4 * P512;
constexpr size_t PJ_QB = PJ_256, PJ_KB = PJ_256 + P256, PJ_VB = PJ_256 + 2 * P256, PJ_QC = PJ_256 + 3 * P256, PJ_KC = PJ_256 + 4 * P256,
                 PJ_VC = PJ_256 + 5 * P256, PJ_GC = PJ_256 + 6 * P256, PJ_KI = PJ_256 + 7 * P256, PJ_WI = PJ_KI + (size_t)MP * 64 * 2,
                 PJ_END = PJ_WI + (size_t)MP * 8 * 4;
constexpr size_t ACT_BYTES = (size_t)MP * DFF * 2;
constexpr size_t WS_END = WS_PROJ + (ACT_BYTES > PJ_END ? ACT_BYTES : PJ_END);
constexpr int CW_BAR = 0;
constexpr int CW_KMAX = 4096;

constexpr int LDS_BYTES = 156 * 1024;
constexpr int LDS_MISC = 0, LDS_GEN = 256;

struct Args { const float* in[13]; float* out; unsigned char* ws; int ph_lo, ph_hi; };

struct Frame {
    const float *x, *meta, *rel_bias, *w_in, *norm_mix, *diff_lambda, *diff_norm, *ret_norm, *w_out, *norm_ff, *w_ff1, *w_ff2, *final_norm;
    float* out; unsigned char* ws; LAS unsigned char* lds; int tid, lane, wave, bid, G;
};

__device__ __forceinline__ float shx(float v, int m, int lane) { return __builtin_bit_cast(float, __builtin_amdgcn_ds_bpermute((lane ^ m) << 2, __builtin_bit_cast(int, v))); }
template <int M> __device__ __forceinline__ float sx(float v, int lane) { return shx(v, M, lane); }
__device__ __forceinline__ float hsum32(float v, int lane) { return v + shx(v, 32, lane); }
__device__ __forceinline__ unsigned hor32(unsigned v, int lane) { return v | (unsigned)__builtin_amdgcn_ds_bpermute((lane ^ 32) << 2, (int)v); }
__device__ __forceinline__ float bcast0(float v) { return __builtin_bit_cast(float, __builtin_amdgcn_ds_bpermute(0, __builtin_bit_cast(int, v))); }
__device__ __forceinline__ float wave_sum(float v, int lane) { v = hsum32(v, lane); v += sx<16>(v, lane); v += sx<8>(v, lane); v += sx<4>(v, lane); v += sx<2>(v, lane); v += sx<1>(v, lane); return v; }
__device__ __forceinline__ unsigned cvt_pk_bf16(float lo, float hi) { unsigned r; asm volatile("v_cvt_pk_bf16_f32 %0, %1, %2" : "=v"(r) : "v"(lo), "v"(hi)); return r; }
__device__ __forceinline__ unsigned cvt_pk_f16(float lo, float hi) { h2 p; p.x = (_Float16)lo; p.y = (_Float16)hi; return __builtin_bit_cast(unsigned, p); }
typedef unsigned u32x4 __attribute__((ext_vector_type(4)));
typedef float f32x4 __attribute__((ext_vector_type(4)));
__device__ __forceinline__ u32x4 pack8(const f32x4& a, const f32x4& b, bool bf) {
    u32x4 w;
    if (bf) { w.x = cvt_pk_bf16(a[0], a[1]); w.y = cvt_pk_bf16(a[2], a[3]); w.z = cvt_pk_bf16(b[0], b[1]); w.w = cvt_pk_bf16(b[2], b[3]); }
    else    { w.x = cvt_pk_f16(a[0], a[1]);  w.y = cvt_pk_f16(a[2], a[3]);  w.z = cvt_pk_f16(b[0], b[1]);  w.w = cvt_pk_f16(b[2], b[3]); }
    return w;
}
__device__ __forceinline__ int row_pos(int r) { return r < MR ? (r & (SEQ - 1)) + NMETA : ((r - MR) & 15); }

__device__ __forceinline__ int incol_map(int n) {
    if (n < 2048) return n;
    if (n < 2816) return n - 2048 + 2120;
    if (n < 3328) {
        const int seg = (n - 2816) >> 8, c = (n - 2816) & 255, head = c >> 6, p = c & 63;
        const int g = p >> 3, nn = (p >> 2) & 1, i = p & 3, d = 32 * nn + 4 * g + i;
        return (seg ? 3144 : 2888) + head * 64 + d;
    }
    if (n < 3840) return n - 3328 + 3400;
    if (n < 3904) return n - 3840 + 2048;
    if (n < 3912) return n - 3904 + 2112;
    return -1;
}

__constant__ double ROPE_REV[32] = {0.15915494309189535, 0.11934937021124886, 0.08949940160889101, 0.06711508300522726, 0.050329212104487035, 0.03774158471741977, 0.0283021958306234, 0.02122365276477766, 0.015915494309189534, 0.011934937021124886, 0.008949940160889102, 0.006711508300522725, 0.005032921210448704, 0.003774158471741977, 0.00283021958306234, 0.0021223652764777662, 0.0015915494309189536, 0.0011934937021124885, 0.0008949940160889102, 0.0006711508300522726, 0.0005032921210448703, 0.00037741584717419774, 0.00028302195830623395, 0.0002122365276477766, 0.00015915494309189535, 0.00011934937021124886, 8.949940160889102e-05, 6.711508300522725e-05, 5.0329212104487035e-05, 3.774158471741978e-05, 2.8302195830623396e-05, 2.122365276477766e-05};

struct EpiInProj {
    static constexpr bool PERM = true, AFTER_DRAIN = false;
    unsigned char* proj; const f32x2* rope; unsigned* kmax;
    __device__ __forceinline__ void kmax_update(const pg8::f32x4 (&acc)[2][2][4][2], int bj, unsigned* word, int fr, int fq) const {
        float mx = 0.f; const int LN = fq * 16 + fr;
#pragma unroll
        for (int ai = 0; ai < 2; ++ai)
#pragma unroll
            for (int m = 0; m < 4; ++m) {
                const pg8::f32x4 a = acc[ai][bj][m][0], b = acc[ai][bj][m][1];
                float s = (a[0] * a[0] + a[1] * a[1]) + (a[2] * a[2] + a[3] * a[3]) + (b[0] * b[0] + b[1] * b[1]) + (b[2] * b[2] + b[3] * b[3]);
                s += sx<16>(s, LN); s = hsum32(s, LN);
                mx = fmaxf(mx, s);
            }
        mx = fmaxf(mx, sx<1>(mx, LN)); mx = fmaxf(mx, sx<2>(mx, LN)); mx = fmaxf(mx, sx<4>(mx, LN)); mx = fmaxf(mx, sx<8>(mx, LN));
        if (fr == 0 && fq == 0) atomicMax(word, __float_as_uint(mx));
    }
    __device__ __forceinline__ void operator()(const pg8::f32x4 (&acc)[2][2][4][2], const pg8::Unit& u, int wr, int wc, int fr, int fq) const {
        const int pn = u.pn, rbase = u.pm * 256 + wr * 64 + fr, cw = wc * 32 + 8 * fq;
        if (pn <= 7 || (pn <= 14 && pn != 11 && pn != 12)) {
            unsigned char* base; int ld, colt; float scale = 1.f; bool bf = false;
            if (pn <= 7) { const int arr = pn >> 1; base = proj + (size_t)arr * P512; ld = 512; colt = (pn & 1) * 256; if (arr == 0) scale = QA_SCALE; bf = (arr == 2); }
            else { const int arr = pn - 8; base = proj + PJ_256 + (size_t)arr * P256; ld = 256; colt = 0; if (arr == 0) scale = QB_SCALE; bf = (arr == 2); }
#pragma unroll
            for (int ai = 0; ai < 2; ++ai)
#pragma unroll
                for (int m = 0; m < 4; ++m) {
                    const int row = rbase + ai * 128 + m * 16;
#pragma unroll
                    for (int bj = 0; bj < 2; ++bj) {
                        const pg8::f32x4 v0 = acc[ai][bj][m][0] * scale, v1 = acc[ai][bj][m][1] * scale;
                        *(u32x4*)(base + ((size_t)row * ld + colt + bj * 128 + cw) * 2) = pack8(v0, v1, bf);
                    }
                }
            if (pn == 2 || pn == 3) {
#pragma unroll
                for (int bj = 0; bj < 2; ++bj) { const int head = ((pn & 1) * 256 + bj * 128 + wc * 32) >> 6; kmax_update(acc, bj, kmax + head * 2 + (wc & 1), fr, fq); }
            }
            if (pn == 9) {
#pragma unroll
                for (int bj = 0; bj < 2; ++bj) { const int head = 2 * bj + (wc >> 1); kmax_update(acc, bj, kmax + 16 + head * 2 + (wc & 1), fr, fq); }
            }
        } else if (pn == 11 || pn == 12) {
            unsigned char* base = proj + PJ_256 + (size_t)(pn - 8) * P256;
            const float sc = (pn == 12) ? 0.125f : 1.f;
            const int g = 4 * (wc & 1) + fq;
#pragma unroll
            for (int ai = 0; ai < 2; ++ai)
#pragma unroll
                for (int m = 0; m < 4; ++m) {
                    const int row = rbase + ai * 128 + m * 16, t = row_pos(row);
                    const pg8::f32x4 cs0 = *(const pg8::f32x4*)(rope + (size_t)t * 32 + 4 * g), cs1 = *(const pg8::f32x4*)(rope + (size_t)t * 32 + 4 * g + 2);
                    const float c[4] = {cs0[0], cs0[2], cs1[0], cs1[2]}, s[4] = {cs0[1], cs0[3], cs1[1], cs1[3]};
#pragma unroll
                    for (int bj = 0; bj < 2; ++bj) {
                        const pg8::f32x4 x1 = acc[ai][bj][m][0], x2 = acc[ai][bj][m][1];
                        float o1[4], o2[4];
#pragma unroll
                        for (int i = 0; i < 4; ++i) { o1[i] = (x1[i] * c[i] - x2[i] * s[i]) * sc; o2[i] = (x1[i] * s[i] + x2[i] * c[i]) * sc; }
                        const int head = 2 * bj + (wc >> 1);
                        unsigned char* rp = base + ((size_t)row * 256 + head * 64 + 4 * g) * 2;
                        u32x2 w1, w2; w1.x = cvt_pk_f16(o1[0], o1[1]); w1.y = cvt_pk_f16(o1[2], o1[3]); w2.x = cvt_pk_f16(o2[0], o2[1]); w2.y = cvt_pk_f16(o2[2], o2[3]);
                        *(u32x2*)rp = w1; *(u32x2*)(rp + 64) = w2;
                    }
                }
        } else {
#pragma unroll
            for (int ai = 0; ai < 2; ++ai)
#pragma unroll
                for (int m = 0; m < 4; ++m) {
                    const int row = rbase + ai * 128 + m * 16;
                    const pg8::f32x4 v0 = acc[ai][0][m][0], v1 = acc[ai][0][m][1];
                    if (wc < 2) *(u32x4*)(proj + PJ_KI + ((size_t)row * 64 + cw) * 2) = pack8(v0, v1, false);
                    else if (wc == 2 && fq == 0) { float* wp = (float*)(proj + PJ_WI) + (size_t)row * 8; *(pg8::f32x4*)wp = v0 * WI_SCALE; *(pg8::f32x4*)(wp + 4) = v1 * WI_SCALE; }
                }
        }
    }
};
struct EpiRes {
    static constexpr bool PERM = false, AFTER_DRAIN = false;
    const float* res_main; float* out_main; float* hmeta;
    __device__ __forceinline__ void operator()(const pg8::f32x4 (&acc)[2][2][4][2], const pg8::Unit& u, int wr, int wc, int fr, int fq) const {
        const bool mt = (u.pm * 256 >= MR);
        const float* rb = mt ? hmeta : res_main; float* ob = mt ? hmeta : out_main;
        const int row0 = (mt ? u.pm * 256 - MR : u.pm * 256) + wr * 64 + fr, col0 = u.pn * 256 + wc * 32 + 4 * fq;
#pragma unroll
        for (int ai = 0; ai < 2; ++ai)
#pragma unroll
            for (int m = 0; m < 4; ++m) {
                const size_t ro = (size_t)(row0 + ai * 128 + m * 16) * DM + col0;
#pragma unroll
                for (int bj = 0; bj < 2; ++bj)
#pragma unroll
                    for (int n = 0; n < 2; ++n) { const pg8::f32x4 v = *(const pg8::f32x4*)(rb + ro + bj * 128 + n * 16) + acc[ai][bj][m][n]; *(pg8::f32x4*)(ob + ro + bj * 128 + n * 16) = v; }
            }
    }
};
struct EpiRelu2 {
    static constexpr bool PERM = true, AFTER_DRAIN = false;
    unsigned char* act;
    __device__ __forceinline__ void operator()(const pg8::f32x4 (&acc)[2][2][4][2], const pg8::Unit& u, int wr, int wc, int fr, int fq) const {
        const int rbase = u.pm * 256 + wr * 64 + fr, col0 = u.pn * 256 + wc * 32 + 8 * fq;
#pragma unroll
        for (int ai = 0; ai < 2; ++ai)
#pragma unroll
            for (int m = 0; m < 4; ++m) {
                const int row = rbase + ai * 128 + m * 16;
#pragma unroll
                for (int bj = 0; bj < 2; ++bj) {
                    pg8::f32x4 v0 = acc[ai][bj][m][0], v1 = acc[ai][bj][m][1];
#pragma unroll
                    for (int i = 0; i < 4; ++i) { const float a = fmaxf(v0[i], 0.f), b = fmaxf(v1[i], 0.f); v0[i] = a * a; v1[i] = b * b; }
                    *(u32x4*)(act + ((size_t)row * DFF + col0 + bj * 128) * 2) = pack8(v0, v1, false);
                }
            }
    }
};

struct WTile { const float* src; _Float16* dst; int ld, K, k0, n0, mapped; };
constexpr int WT_PER_LAYER = 16 * 64 + 16 * 16 + 16 * 64 + 64 * 16, WT_TOTAL = DEPTH * WT_PER_LAYER;
__device__ __forceinline__ WTile wt_desc(const Frame& F, int t) {
    WTile d; const int l = t / WT_PER_LAYER; int r = t - l * WT_PER_LAYER;
    unsigned char* wl = F.ws + WS_W + (size_t)l * W_LAYER;
    if (r < 1024)      { d.src = F.w_in + (size_t)l * DM * INCOLS; d.dst = (_Float16*)(wl + W_IN_OFF);  d.ld = INCOLS; d.K = DM;  d.mapped = 1; d.k0 = (r & 15) * 64; d.n0 = (r >> 4) * 64; }
    else if (r < 1280) { r -= 1024; d.src = F.w_out + (size_t)l * DM * DM;  d.dst = (_Float16*)(wl + W_OUT_OFF); d.ld = DM;  d.K = DM;  d.mapped = 0; d.k0 = (r & 15) * 64; d.n0 = (r >> 4) * 64; }
    else if (r < 2304) { r -= 1280; d.src = F.w_ff1 + (size_t)l * DM * DFF; d.dst = (_Float16*)(wl + W_FF1_OFF); d.ld = DFF; d.K = DM;  d.mapped = 0; d.k0 = (r & 15) * 64; d.n0 = (r >> 4) * 64; }
    else               { r -= 2304; d.src = F.w_ff2 + (size_t)l * DFF * DM; d.dst = (_Float16*)(wl + W_FF2_OFF); d.ld = DM;  d.K = DFF; d.mapped = 0; d.k0 = (r & 63) * 64; d.n0 = (r >> 6) * 64; }
    return d;
}
__device__ __forceinline__ void wt_load(const WTile& d, int tid, f32x4& v0, f32x4& v1) {
    const int kk = tid >> 4, n4 = (tid & 15) * 4; const int sc = d.mapped ? incol_map(d.n0 + n4) : d.n0 + n4;
    v0 = (f32x4){0.f, 0.f, 0.f, 0.f}; v1 = v0;
    if (sc >= 0) { v0 = *(const f32x4*)(d.src + (size_t)(d.k0 + kk) * d.ld + sc); v1 = *(const f32x4*)(d.src + (size_t)(d.k0 + kk + 32) * d.ld + sc); }
}
__device__ __forceinline__ void wtrans_all(const Frame& F) {
    LAS float* tile = (LAS float*)(F.lds + LDS_GEN); const int tid = F.tid;
    int t = F.bid; if (t >= WT_TOTAL) return;
    WTile d = wt_desc(F, t); f32x4 v0, v1; wt_load(d, tid, v0, v1);
#pragma unroll 1
    for (;;) {
        const int tn = t + F.G; WTile dn = d; f32x4 n0 = v0, n1 = v1;
        if (tn < WT_TOTAL) { dn = wt_desc(F, tn); wt_load(dn, tid, n0, n1); }
        { const int kk = tid >> 4, n4 = (tid & 15) * 4;
#pragma unroll
          for (int e = 0; e < 4; ++e) { tile[kk * 65 + n4 + e] = v0[e]; tile[(kk + 32) * 65 + n4 + e] = v1[e]; } }
        __syncthreads();
        { const int nn = tid >> 3, k8 = (tid & 7) * 8; h8 o;
#pragma unroll
          for (int e = 0; e < 8; ++e) o[e] = (_Float16)tile[(k8 + e) * 65 + nn];
          *(h8*)(d.dst + (size_t)(d.n0 + nn) * d.K + d.k0 + k8) = o; }
        __syncthreads();
        if (tn >= WT_TOTAL) break;
        t = tn; d = dn; v0 = n0; v1 = n1;
    }
}
template <int MODE> __device__ __forceinline__ void norm_to_abuf(const Frame& F, const float* gain) {
    _Float16* abuf = (_Float16*)(F.ws + WS_ABUF); const float* hmeta = (const float*)(F.ws + WS_HMETA);
    const int nw = F.G * 8;
    for (int r = F.bid * 8 + F.wave; r < MP; r += nw) {
        _Float16* dst = abuf + (size_t)r * DM;
        if (r >= MV) { const h4 z = {(_Float16)0.f, (_Float16)0.f, (_Float16)0.f, (_Float16)0.f};
#pragma unroll
            for (int j = 0; j < 4; ++j) *(h4*)(dst + j * 256 + F.lane * 4) = z; continue; }
        const float* src = MODE == 0 ? (r < MR ? F.x + (size_t)r * DM : F.meta + (size_t)((r - MR) & 15) * DM) : (r < MR ? F.out + (size_t)r * DM : hmeta + (size_t)(r - MR) * DM);
        f32x4 v[4]; float ss = 0.f;
#pragma unroll
        for (int j = 0; j < 4; ++j) { v[j] = *(const f32x4*)(src + j * 256 + F.lane * 4); ss += (v[j][0] * v[j][0] + v[j][1] * v[j][1]) + (v[j][2] * v[j][2] + v[j][3] * v[j][3]); }
        ss = wave_sum(ss, F.lane); const float rstd = rsqrtf(ss * (1.0f / DM) + 1e-6f);
#pragma unroll
        for (int j = 0; j < 4; ++j) { const f32x4 g = *(const f32x4*)(gain + j * 256 + F.lane * 4); h4 o;
#pragma unroll
            for (int e = 0; e < 4; ++e) o[e] = (_Float16)(v[j][e] * rstd * g[e]);
            *(h4*)(dst + j * 256 + F.lane * 4) = o; }
    }
}
__device__ __forceinline__ void final_norm(const Frame& F) {
    const int nw = F.G * 8;
    for (int r = F.bid * 8 + F.wave; r < MR; r += nw) {
        float* p = F.out + (size_t)r * DM; f32x4 v[4]; float ss = 0.f;
#pragma unroll
        for (int j = 0; j < 4; ++j) { v[j] = *(const f32x4*)(p + j * 256 + F.lane * 4); ss += (v[j][0] * v[j][0] + v[j][1] * v[j][1]) + (v[j][2] * v[j][2] + v[j][3] * v[j][3]); }
        ss = wave_sum(ss, F.lane); const float rstd = rsqrtf(ss * (1.0f / DM) + 1e-6f);
#pragma unroll
        for (int j = 0; j < 4; ++j) { const f32x4 g = *(const f32x4*)(F.final_norm + j * 256 + F.lane * 4); *(f32x4*)(p + j * 256 + F.lane * 4) = v[j] * rstd * g; }
    }
}
__device__ __forceinline__ void prologue(const Frame& F) {
    const int gtid = F.bid * NTHREADS + F.tid, gsz = F.G * NTHREADS;
    float* hmeta = (float*)(F.ws + WS_HMETA);
    for (int i = gtid; i < 256 * DM / 4; i += gsz) { const int row = i / (DM / 4), c4 = i % (DM / 4); f32x4 v = {0.f, 0.f, 0.f, 0.f}; if (row < NB * NMETA) v = *(const f32x4*)(F.meta + (size_t)(row & 15) * DM + c4 * 4); *(f32x4*)(hmeta + (size_t)row * DM + c4 * 4) = v; }
    f32x2* rope = (f32x2*)(F.ws + WS_ROPE);
    for (int i = gtid; i < TLEN * 32; i += gsz) { const int t = i >> 5, d = i & 31; const double rev = (double)t * ROPE_REV[d]; const float fr = (float)(rev - __builtin_floor(rev)); f32x2 cs; cs.x = __builtin_amdgcn_cosf(fr); cs.y = __builtin_amdgcn_sinf(fr); rope[i] = cs; }
    wtrans_all(F);
    norm_to_abuf<0>(F, F.norm_mix);
}
__device__ __forceinline__ void zero_abuf(const Frame& F) {
    u32x4* p = (u32x4*)(F.ws + WS_ABUF); const u32x4 z = {0u, 0u, 0u, 0u};
    for (size_t i = (size_t)F.bid * NTHREADS + F.tid; i < (size_t)MP * DM * 2 / 16; i += (size_t)F.G * NTHREADS) p[i] = z;
}

typedef short bf16x8v __attribute__((ext_vector_type(8)));
__constant__ unsigned char BUCKET_LUT[128] = {0, 1, 2, 3, 4, 5, 6, 7, 8, 9, 10, 11, 12, 13, 14, 15, 16, 16, 16, 17, 17, 18, 18, 18, 19, 19, 19, 20, 20, 20, 20, 21, 21, 21, 21, 22, 22, 22, 22, 22, 23, 23, 23, 23, 23, 23, 24, 24, 24, 24, 24, 24, 25, 25, 25, 25, 25, 25, 25, 26, 26, 26, 26, 26, 26, 26, 26, 27, 27, 27, 27, 27, 27, 27, 27, 27, 27, 28, 28, 28, 28, 28, 28, 28, 28, 28, 28, 29, 29, 29, 29, 29, 29, 29, 29, 29, 29, 29, 29, 30, 30, 30, 30, 30, 30, 30, 30, 30, 30, 30, 30, 30, 30, 31, 31, 31, 31, 31, 31, 31, 31, 31, 31, 31, 31, 31, 31, 31};
__device__ __forceinline__ int crow(int i, int h) { return (i & 3) + 8 * (i >> 2) + 4 * h; }
__device__ __forceinline__ bf16x8v pack_p(const f32x16& x, int s) {
    u32x4 p; p.x = cvt_pk_bf16(x[8 * s + 0], x[8 * s + 1]); p.y = cvt_pk_bf16(x[8 * s + 2], x[8 * s + 3]); p.z = cvt_pk_bf16(x[8 * s + 4], x[8 * s + 5]); p.w = cvt_pk_bf16(x[8 * s + 6], x[8 * s + 7]);
    return __builtin_bit_cast(bf16x8v, p);
}
__device__ __forceinline__ bf16x8v vt_frag(LAS unsigned char* vimg, int dblk, int keybase, int s, int lane) {
    const int h = lane >> 5, blk = (lane >> 4) & 1, i16 = lane & 15, q = i16 >> 2, p = i16 & 3;
    LAS unsigned char* a = vimg + dblk * 4096 + (keybase + 16 * s + 4 * h + q) * 64 + (16 * blk + 4 * p) * 2;
    const s16x4 lo = __builtin_amdgcn_ds_read_tr16_b64_v4i16((LAS s16x4*)a);
    const s16x4 hi = __builtin_amdgcn_ds_read_tr16_b64_v4i16((LAS s16x4*)(a + 8 * 64));
    return __builtin_shufflevector(lo, hi, 0, 1, 2, 3, 4, 5, 6, 7);
}

constexpr int KS_PITCH = 144;
constexpr int B_KS = 0, B_VS = 2 * 64 * KS_PITCH, B_LUT = B_VS + 2 * 8192, B_END = B_LUT + 512;
__device__ __forceinline__ void mixB_unit(const Frame& F, int l, int b, int hh, int qblk, float lam, float oscale) {
    LAS unsigned char* L = F.lds + LDS_GEN;
    const int tid = F.tid, lane = F.lane, wave = F.wave, r = lane & 31, h = lane >> 5;
    const unsigned char* proj = F.ws + WS_PROJ;
    const _Float16* QB = (const _Float16*)(proj + PJ_QB); const unsigned char* KB = proj + PJ_KB; const unsigned char* VB = proj + PJ_VB;
    const unsigned* kmax = (const unsigned*)(F.ws + WS_CTL) + CW_KMAX + 32 * l + 16;
    const bool meta_u = qblk < 0;
    const int qrow0 = meta_u ? MR + b * NMETA : b * SEQ + qblk * 256;
    const int qpos0 = meta_u ? 0 : NMETA + qblk * 256;
    const int nreal = meta_u ? 0 : 4 * qblk + 4;
    const int wq0 = 32 * wave;
    const bool wave_on = meta_u ? (wave == 0) : true;
    const int my_row = wave_on ? qrow0 + wq0 + r : qrow0, my_pos = qpos0 + wq0 + r;
    __syncthreads();
    if (tid < 128) ((LAS float*)(L + B_LUT))[tid] = F.rel_bias[BUCKET_LUT[tid] * 12 + 8 + hh] * LOG2E;
    float bmax = (lane < 32) ? F.rel_bias[lane * 12 + 8 + hh] * LOG2E : -1e30f;
    bmax = fmaxf(bmax, sx<16>(bmax, lane)); bmax = fmaxf(bmax, sx<8>(bmax, lane)); bmax = fmaxf(bmax, sx<4>(bmax, lane)); bmax = fmaxf(bmax, sx<2>(bmax, lane)); bmax = fmaxf(bmax, sx<1>(bmax, lane));
    bmax = bcast0(bmax);
    const float bfar = F.rel_bias[31 * 12 + 8 + hh] * LOG2E;
    h8 qf[2][2]; float mq[2];
#pragma unroll
    for (int c = 0; c < 2; ++c) {
        float n2 = 0.f;
#pragma unroll
        for (int s = 0; s < 2; ++s) { qf[c][s] = *(const h8*)(QB + (size_t)my_row * 256 + hh * 64 + c * 32 + 16 * s + 8 * h);
#pragma unroll
            for (int j = 0; j < 8; ++j) { const float v = (float)qf[c][s][j]; n2 += v * v; } }
        n2 = hsum32(n2, lane);
        mq[c] = sqrtf(n2 * __uint_as_float(kmax[hh * 2 + c])) * 1.002f + bmax;
    }
    f32x16 cfar[2];
#pragma unroll
    for (int c = 0; c < 2; ++c)
#pragma unroll
        for (int i = 0; i < 16; ++i) cfar[c][i] = bfar - mq[c];
    f32x16 O[2][2]; float lsum[2] = {0.f, 0.f};
#pragma unroll
    for (int c = 0; c < 2; ++c)
#pragma unroll
        for (int d = 0; d < 2; ++d)
#pragma unroll
            for (int i = 0; i < 16; ++i) O[c][d][i] = 0.f;
    const int skey = tid >> 3, sch = tid & 7;
    const unsigned kdst = skey * KS_PITCH + sch * 16, vdst = (sch >> 2) * 4096 + skey * 64 + (sch & 3) * 16;
    const int ntiles = 1 + nreal;
    auto tile_row0 = [&](int t) -> int { return t == 0 ? MR + b * NMETA : b * SEQ + (t - 1) * 64; };
    u32x4 kreg, vreg;
    { const size_t rr = (size_t)(tile_row0(0) + skey); kreg = *(const u32x4*)(KB + rr * 512 + hh * 128 + sch * 16); vreg = *(const u32x4*)(VB + rr * 512 + hh * 128 + sch * 16); }
    *(LAS u32x4*)(L + B_KS + kdst) = kreg; *(LAS u32x4*)(L + B_VS + vdst) = vreg;
    __syncthreads();
#pragma unroll 1
    for (int t = 0; t < ntiles; ++t) {
        const int buf = t & 1;
        if (t + 1 < ntiles) { const size_t rr = (size_t)(tile_row0(t + 1) + skey); kreg = *(const u32x4*)(KB + rr * 512 + hh * 128 + sch * 16); vreg = *(const u32x4*)(VB + rr * 512 + hh * 128 + sch * 16); }
        const int kpos0 = (t == 0) ? 0 : NMETA + (t - 1) * 64, nvalid = (t == 0) ? NMETA : 64;
        const int wpos0 = qpos0 + wq0;
        if (wave_on && kpos0 <= wpos0 + 31) {
            LAS unsigned char* Kb = L + B_KS + buf * (64 * KS_PITCH); LAS unsigned char* Vb = L + B_VS + buf * 8192;
            const bool slow = (t == 0) || (kpos0 + 63 > wpos0 - 128);
#pragma unroll
            for (int sub = 0; sub < 2; ++sub) {
                if (sub * 32 >= nvalid || kpos0 + sub * 32 > wpos0 + 31) continue;
                f32x16 S[2];
                h8 kfr[2][2]; bf16x8v vfr[2][2];
#pragma unroll
                for (int c = 0; c < 2; ++c)
#pragma unroll
                    for (int s = 0; s < 2; ++s) kfr[c][s] = *(const LAS h8*)(Kb + (sub * 32 + r) * KS_PITCH + (c * 32 + 16 * s + 8 * h) * 2);
#pragma unroll
                for (int d = 0; d < 2; ++d)
#pragma unroll
                    for (int s = 0; s < 2; ++s) vfr[d][s] = vt_frag(Vb, d, sub * 32, s, lane);
                __builtin_amdgcn_sched_barrier(0);
#pragma unroll
                for (int c = 0; c < 2; ++c) {
                    if (slow) {
#pragma unroll
                        for (int i = 0; i < 16; ++i) S[c][i] = 0.f; } else S[c] = cfar[c];
#pragma unroll
                    for (int s = 0; s < 2; ++s) S[c] = __builtin_amdgcn_mfma_f32_32x32x16_f16(kfr[c][s], qf[c][s], S[c], 0, 0, 0);
                }
                if (slow) {
#pragma unroll
                    for (int i = 0; i < 16; ++i) {
                        const int kidx = sub * 32 + crow(i, h), dist = my_pos - (kpos0 + kidx);
                        const bool ok = dist >= 0 && kidx < nvalid;
                        const float bias = ((const LAS float*)(L + B_LUT))[min(max(dist, 0), 127)];
#pragma unroll
                        for (int c = 0; c < 2; ++c) S[c][i] = ok ? __builtin_amdgcn_exp2f(S[c][i] + bias - mq[c]) : 0.f;
                    }
                } else {
#pragma unroll
                    for (int c = 0; c < 2; ++c)
#pragma unroll
                        for (int i = 0; i < 16; ++i) S[c][i] = __builtin_amdgcn_exp2f(S[c][i]);
                }
#pragma unroll
                for (int c = 0; c < 2; ++c) { float a0 = S[c][0], a1 = S[c][1], a2 = S[c][2], a3 = S[c][3];
#pragma unroll
                    for (int i = 4; i < 16; i += 4) { a0 += S[c][i]; a1 += S[c][i + 1]; a2 += S[c][i + 2]; a3 += S[c][i + 3]; }
                    lsum[c] += (a0 + a1) + (a2 + a3); }
                bf16x8v pf[2][2];
#pragma unroll
                for (int c = 0; c < 2; ++c) { pf[c][0] = pack_p(S[c], 0); pf[c][1] = pack_p(S[c], 1); }
#pragma unroll
                for (int d = 0; d < 2; ++d)
#pragma unroll
                    for (int s = 0; s < 2; ++s) {
#pragma unroll
                        for (int c = 0; c < 2; ++c) O[c][d] = __builtin_amdgcn_mfma_f32_32x32x16_bf16(vfr[d][s], pf[c][s], O[c][d], 0, 0, 0); }
            }
        }
        if (t + 1 < ntiles) { *(LAS u32x4*)(L + B_KS + (buf ^ 1) * (64 * KS_PITCH) + kdst) = kreg; *(LAS u32x4*)(L + B_VS + (buf ^ 1) * 8192 + vdst) = vreg; }
        __syncthreads();
    }
    if (wave_on) {
        const float l0 = hsum32(lsum[0], lane), l1 = hsum32(lsum[1], lane);
        const float i0 = 1.0f / l0, i1 = lam / l1;
        float o[2][16], ss = 0.f;
#pragma unroll
        for (int d = 0; d < 2; ++d)
#pragma unroll
            for (int i = 0; i < 16; ++i) { o[d][i] = O[0][d][i] * i0 - O[1][d][i] * i1; ss += o[d][i] * o[d][i]; }
        ss = hsum32(ss, lane);
        const float rstd = rsqrtf(ss * (1.0f / 64.0f) + 1e-6f) * oscale;
        const float* gn = F.diff_norm + l * 64;
        if (!meta_u || r < NMETA) {
            _Float16* dst = (_Float16*)(F.ws + WS_ABUF) + (size_t)my_row * DM + 512 + hh * 64;
#pragma unroll
            for (int d = 0; d < 2; ++d)
#pragma unroll
                for (int g4 = 0; g4 < 4; ++g4) { const int d0 = 32 * d + 8 * g4 + 4 * h; const f32x4 gv = *(const f32x4*)(gn + d0);
                    u32x2 w; w.x = cvt_pk_f16(o[d][4 * g4 + 0] * rstd * gv[0], o[d][4 * g4 + 1] * rstd * gv[1]); w.y = cvt_pk_f16(o[d][4 * g4 + 2] * rstd * gv[2], o[d][4 * g4 + 3] * rstd * gv[3]);
                    *(u32x2*)(dst + d0) = w; }
        }
    }
}
__device__ __forceinline__ void mixB_phase(const Frame& F, int l) {
    const float* lp = F.diff_lambda + l * 128;
    float a = (F.lane < 32) ? lp[F.lane] * lp[32 + F.lane] : 0.f, c = (F.lane < 32) ? lp[64 + F.lane] * lp[96 + F.lane] : 0.f;
    a = wave_sum(a, F.lane); c = wave_sum(c, F.lane);
    const float linit = 0.8f - 0.6f * expf(-0.3f * (float)l);
    const float lam = expf(a) - expf(c) + linit, oscale = 1.0f - linit;
#pragma unroll 1
    for (int cidx = F.bid; cidx < 256; cidx += F.G) { const int bh = cidx & 7, i = cidx >> 3;
#pragma unroll 1
        for (int k = 0; k < 3; ++k) { if (k == 2 && cidx >= 8) break; mixB_unit(F, l, bh >> 2, bh & 3, k == 0 ? 63 - i : (k == 1 ? i : -1), lam, oscale); }
    }
}
__device__ __forceinline__ h8 tr_frag_nat(LAS unsigned char* img_blk, int rowbase, int s, int lane) {
    const int h = lane >> 5, blk = (lane >> 4) & 1, i16 = lane & 15, q = i16 >> 2, p = i16 & 3;
    LAS unsigned char* a = img_blk + (rowbase + 16 * s + 8 * h + q) * 64 + (16 * blk + 4 * p) * 2;
    const s16x4 lo = __builtin_amdgcn_ds_read_tr16_b64_v4i16((LAS s16x4*)a);
    const s16x4 hi = __builtin_amdgcn_ds_read_tr16_b64_v4i16((LAS s16x4*)(a + 4 * 64));
    return __builtin_bit_cast(h8, __builtin_shufflevector(lo, hi, 0, 1, 2, 3, 4, 5, 6, 7));
}
__device__ __forceinline__ h8 tr_frag_krow(LAS unsigned char* img_blk, int rowbase, int s, int lane) {
    const int h = lane >> 5, blk = (lane >> 4) & 1, i16 = lane & 15, q = i16 >> 2, p = i16 & 3;
    LAS unsigned char* a = img_blk + (rowbase + 16 * s + 4 * h + q) * 64 + (16 * blk + 4 * p) * 2;
    const s16x4 lo = __builtin_amdgcn_ds_read_tr16_b64_v4i16((LAS s16x4*)a);
    const s16x4 hi = __builtin_amdgcn_ds_read_tr16_b64_v4i16((LAS s16x4*)(a + 8 * 64));
    return __builtin_bit_cast(h8, __builtin_shufflevector(lo, hi, 0, 1, 2, 3, 4, 5, 6, 7));
}
__device__ __forceinline__ float ret_log2gamma(int hc) { return log2f(1.0f - exp2f(-5.0f - (float)hc)); }
__device__ __forceinline__ h8 scale_h8(const h8& v, float sc) { h8 o;
#pragma unroll
    for (int e = 0; e < 8; ++e) o[e] = (_Float16)((float)v[e] * sc);
    return o; }

__device__ __forceinline__ void mixC1_unit(const Frame& F, int b, int hp, int c) {
    LAS unsigned char* L = F.lds + LDS_GEN;
    const int tid = F.tid, lane = F.lane, wave = F.wave;
    const unsigned char* proj = F.ws + WS_PROJ;
    const int row0 = c == 0 ? MR + b * NMETA : b * SEQ + 128 * (c - 1), Lc = c == 0 ? NMETA : 128;
    __syncthreads();
#pragma unroll 1
    for (int idx = tid; idx < 4096; idx += NTHREADS) {
        const int head = idx >> 11, arr = (idx >> 10) & 1, j = (idx >> 3) & 127, ch = idx & 7, hc = 2 * hp + head;
        h8 v;
#pragma unroll
        for (int e = 0; e < 8; ++e) v[e] = (_Float16)0.f;
        if (j < Lc) { v = *(const h8*)(proj + (arr ? PJ_VC : PJ_KC) + (size_t)(row0 + j) * 512 + hc * 128 + ch * 16);
            if (arr) v = scale_h8(v, exp2f((float)(Lc - 1 - j) * ret_log2gamma(hc))); }
        *(LAS h8*)(L + head * 32768 + arr * 16384 + (ch >> 2) * 8192 + j * 64 + (ch & 3) * 16) = v;
    }
    __syncthreads();
    const int head = wave >> 2, mb = (wave >> 1) & 1, nb = wave & 1, r = lane & 31, h = lane >> 5;
    f32x16 acc;
#pragma unroll
    for (int i = 0; i < 16; ++i) acc[i] = 0.f;
#pragma unroll
    for (int s = 0; s < 8; ++s) { const h8 a = tr_frag_nat(L + head * 32768 + mb * 8192, 0, s, lane), bb = tr_frag_nat(L + head * 32768 + 16384 + nb * 8192, 0, s, lane);
        acc = __builtin_amdgcn_mfma_f32_32x32x16_f16(a, bb, acc, 0, 0, 0); }
    float* U = (float*)(F.ws + WS_U) + ((size_t)((b * 4 + 2 * hp + head) * 129 + c)) * 4096;
#pragma unroll
    for (int i = 0; i < 16; ++i) U[(32 * mb + crow(i, h)) * 64 + 32 * nb + r] = acc[i];
}
__device__ __forceinline__ void mixC1_phase(const Frame& F) {
#pragma unroll 1
    for (int u = F.bid; u < NB * 2 * 129; u += F.G) { const int c = u % 129, bh = u / 129; mixC1_unit(F, bh >> 1, bh & 1, c); }
}
__device__ __forceinline__ void mixC_scan(const Frame& F) {
    if (F.tid >= 128) return;
    const int e = F.bid * 128 + F.tid;
    if (e >= NB * 4 * 4096) return;
    const int bh = e >> 12, el = e & 4095, hc = bh & 3;
    const float lg = ret_log2gamma(hc), g128 = exp2f(128.f * lg), g16 = exp2f(16.f * lg);
    const float* U = (const float*)(F.ws + WS_U) + (size_t)bh * 129 * 4096 + el; float* S = (float*)(F.ws + WS_S) + (size_t)bh * 129 * 4096 + el;
    float st = U[0];
    S[4096] = st;
#pragma unroll 1
    for (int c0 = 1; c0 < 128; c0 += 16) {
        float u[16];
#pragma unroll
        for (int k = 0; k < 16; ++k) u[k] = (c0 + k < 128) ? U[(size_t)(c0 + k) * 4096] : 0.f;
#pragma unroll
        for (int k = 0; k < 16; ++k) if (c0 + k < 128) { st = st * g128 + u[k]; S[(size_t)(c0 + k + 1) * 4096] = st; }
    }
    (void)g16;
}
constexpr int C2_KI = 0, C2_VI = 128 * KS_PITCH, C2_ST = C2_VI + 16384, C2_HEAD = C2_ST + 64 * KS_PITCH;
__device__ __forceinline__ void mixC2_unit(const Frame& F, int l, int b, int hp, int c) {
    LAS unsigned char* L = F.lds + LDS_GEN;
    const int tid = F.tid, lane = F.lane, wave = F.wave, r = lane & 31, h = lane >> 5;
    const unsigned char* proj = F.ws + WS_PROJ;
    const int row0 = c == 0 ? MR + b * NMETA : b * SEQ + 128 * (c - 1), Lc = c == 0 ? NMETA : 128;
    __syncthreads();
#pragma unroll 1
    for (int idx = tid; idx < 4096; idx += NTHREADS) {
        const int head = idx >> 11, arr = (idx >> 10) & 1, j = (idx >> 3) & 127, ch = idx & 7, hc = 2 * hp + head;
        h8 v;
#pragma unroll
        for (int e = 0; e < 8; ++e) v[e] = (_Float16)0.f;
        if (j < Lc) v = *(const h8*)(proj + (arr ? PJ_VC : PJ_KC) + (size_t)(row0 + j) * 512 + hc * 128 + ch * 16);
        if (arr) *(LAS h8*)(L + head * C2_HEAD + C2_VI + (ch >> 2) * 8192 + j * 64 + (ch & 3) * 16) = v;
        else     *(LAS h8*)(L + head * C2_HEAD + C2_KI + j * KS_PITCH + ch * 16) = v;
    }
    if (c > 0) {
#pragma unroll 1
        for (int idx = tid; idx < 2 * 4096; idx += NTHREADS) { const int head = idx >> 12, el = idx & 4095, dk = el >> 6, dv = el & 63;
            const float v = ((const float*)(F.ws + WS_S))[((size_t)((b * 4 + 2 * hp + head) * 129 + c)) * 4096 + el];
            *(LAS _Float16*)(L + head * C2_HEAD + C2_ST + dv * KS_PITCH + dk * 2) = (_Float16)v; }
    }
    __syncthreads();
    const int head = wave >> 2, wq = wave & 3, hc = 2 * hp + head;
    if (wq * 32 < Lc) {
        LAS unsigned char* Hb = L + head * C2_HEAD;
        const int qi = wq * 32 + r, my_row = row0 + qi;
        const float lg = ret_log2gamma(hc);
        h8 qf[4];
#pragma unroll
        for (int s = 0; s < 4; ++s) qf[s] = *(const h8*)(proj + PJ_QC + (size_t)my_row * 512 + hc * 128 + (16 * s + 8 * h) * 2);
        f32x16 O[2];
#pragma unroll
        for (int d = 0; d < 2; ++d)
#pragma unroll
            for (int i = 0; i < 16; ++i) O[d][i] = 0.f;
        if (c > 0) {
#pragma unroll
            for (int d = 0; d < 2; ++d)
#pragma unroll
                for (int s = 0; s < 4; ++s) { const h8 a = *(const LAS h8*)(Hb + C2_ST + (32 * d + r) * KS_PITCH + (16 * s + 8 * h) * 2);
                    O[d] = __builtin_amdgcn_mfma_f32_32x32x16_f16(a, qf[s], O[d], 0, 0, 0); }
            const float qd = exp2f((float)(qi + 1) * lg);
#pragma unroll
            for (int d = 0; d < 2; ++d)
#pragma unroll
                for (int i = 0; i < 16; ++i) O[d][i] *= qd;
        }
#pragma unroll 1
        for (int jb = 0; jb <= wq; ++jb) {
            f32x16 S;
#pragma unroll
            for (int i = 0; i < 16; ++i) S[i] = 0.f;
#pragma unroll
            for (int s = 0; s < 4; ++s) { const h8 kf = *(const LAS h8*)(Hb + C2_KI + (32 * jb + r) * KS_PITCH + (16 * s + 8 * h) * 2);
                S = __builtin_amdgcn_mfma_f32_32x32x16_f16(kf, qf[s], S, 0, 0, 0); }
#pragma unroll
            for (int i = 0; i < 16; ++i) { const int dd = qi - (32 * jb + crow(i, h)); S[i] = dd >= 0 ? S[i] * exp2f((float)dd * lg) : 0.f; }
            h8 pf[2];
#pragma unroll
            for (int s = 0; s < 2; ++s) { u32x4 p; p.x = cvt_pk_f16(S[8 * s + 0], S[8 * s + 1]); p.y = cvt_pk_f16(S[8 * s + 2], S[8 * s + 3]); p.z = cvt_pk_f16(S[8 * s + 4], S[8 * s + 5]); p.w = cvt_pk_f16(S[8 * s + 6], S[8 * s + 7]); pf[s] = __builtin_bit_cast(h8, p); }
#pragma unroll
            for (int d = 0; d < 2; ++d)
#pragma unroll
                for (int s = 0; s < 2; ++s) { const h8 vf = tr_frag_krow(Hb + C2_VI + d * 8192, 32 * jb, s, lane);
                    O[d] = __builtin_amdgcn_mfma_f32_32x32x16_f16(vf, pf[s], O[d], 0, 0, 0); }
        }
        float ss = 0.f;
#pragma unroll
        for (int d = 0; d < 2; ++d)
#pragma unroll
            for (int i = 0; i < 16; ++i) ss += O[d][i] * O[d][i];
        ss = hsum32(ss, lane);
        const float rstd = rsqrtf(ss * (1.0f / 64.0f) + 1e-6f);
        if (qi < Lc) {
            const float* gn = F.ret_norm + l * 256 + hc * 64;
            const _Float16* gc = (const _Float16*)(proj + PJ_GC) + (size_t)my_row * 256 + hc * 64;
            _Float16* dst = (_Float16*)(F.ws + WS_ABUF) + (size_t)my_row * DM + 768 + hc * 64;
#pragma unroll
            for (int d = 0; d < 2; ++d)
#pragma unroll
                for (int g4 = 0; g4 < 4; ++g4) { const int d0 = 32 * d + 8 * g4 + 4 * h; const f32x4 gv = *(const f32x4*)(gn + d0); const h4 gg = *(const h4*)(gc + d0);
                    float o[4];
#pragma unroll
                    for (int e = 0; e < 4; ++e) { const float g = (float)gg[e]; o[e] = O[d][4 * g4 + e] * rstd * gv[e] * (g / (1.0f + __expf(-g))); }
                    u32x2 w; w.x = cvt_pk_f16(o[0], o[1]); w.y = cvt_pk_f16(o[2], o[3]); *(u32x2*)(dst + d0) = w; }
        }
    }
}
__device__ __forceinline__ void mixC2_phase(const Frame& F, int l) {
#pragma unroll 1
    for (int u = F.bid; u < NB * 2 * 129; u += F.G) { const int c = u % 129, bh = u / 129; mixC2_unit(F, l, bh >> 1, bh & 1, c); }
}
constexpr int IDX_HIST = 0, IDX_STATS = 16512, IDX_INFO = 18816, IDX_CCNT = 19072, IDX_MASK = 19456, IDX_CAND = 85248, IDX_Q = IDX_CAND + 32 * 128 * 8, IDX_QPITCH = 1168, IDX_END = IDX_Q + 32 * IDX_QPITCH;
#ifndef PROBE_REP
#define PROBE_REP 0
#endif
constexpr int IDX_CAP = 128, IDX_NBIN = 128;
static_assert(IDX_END + LDS_GEN <= LDS_BYTES, "indexer LDS");
struct KFrag { h8 v[4]; };
__device__ __forceinline__ KFrag idx_load_k(const unsigned char* krow_ptr, int h) { KFrag k;
#pragma unroll
    for (int s = 0; s < 4; ++s) k.v[s] = *(const h8*)(krow_ptr + (16 * s + 8 * h) * 2);
    return k; }
#define IDX_LOADQ(dst, hd) do { _Pragma("unroll") for (int s_ = 0; s_ < 4; ++s_) dst[s_] = *(const LAS h8*)(qimg_lane + ((hd) * 64 + 16 * s_) * 2); } while (0)
#define IDX_MFMA4(acc, q) do { _Pragma("unroll") for (int s_ = 0; s_ < 4; ++s_) acc = __builtin_amdgcn_mfma_f32_32x32x16_f16(kf.v[s_], q[s_], acc, 0, 0, 0); } while (0)
#define IDX_FMA(hd, S) do { _Pragma("unroll") for (int i_ = 0; i_ < 16; ++i_) sc[i_] = __builtin_fmaf(w[hd], __builtin_fabsf(S[i_]), sc[i_]); } while (0)
#define IDX_SB __builtin_amdgcn_sched_barrier(0)
__device__ __forceinline__ void idx_scores(const LAS unsigned char* qimg_lane, const float (&w)[8], const KFrag& kf, f32x16& sc) {
    h8 q[2][4]; f32x16 S[2];
    IDX_LOADQ(q[0], 8); IDX_SB;
#pragma unroll
    for (int i = 0; i < 16; ++i) sc[i] = 0.f;
    IDX_MFMA4(sc, q[0]); IDX_LOADQ(q[1], 0); IDX_SB;
#pragma unroll
    for (int hd = 0; hd < 8; ++hd) {
#pragma unroll
        for (int i = 0; i < 16; ++i) S[hd & 1][i] = 0.f;
        IDX_MFMA4(S[hd & 1], q[(hd + 1) & 1]);
        if (hd < 7) IDX_LOADQ(q[hd & 1], hd + 1);
        if (hd > 0) IDX_FMA(hd - 1, S[(hd - 1) & 1]);
        IDX_SB;
    }
    IDX_FMA(7, S[1]);
}
__device__ __forceinline__ int suffix_sum(int v, int lane) {
#pragma unroll
    for (int off = 1; off < 64; off <<= 1) { const int t = __builtin_amdgcn_ds_bpermute((lane + off) << 2, v); if (lane + off < 64) v += t; }
    return v;
}
__device__ __forceinline__ void mixA_index_unit(const Frame& F, int b, int g) {
    LAS unsigned char* L = F.lds + LDS_GEN;
    int tid_ = F.tid; asm volatile("" : "+v"(tid_));
    const int tid = tid_, lane = F.lane, wave = F.wave, r = lane & 31, h = lane >> 5;
    const unsigned char* proj = F.ws + WS_PROJ;
    const unsigned char* KI = proj + PJ_KI;
    const int nq = g == 0 ? NMETA : 32;
    const int qrow = g == 0 ? MR + b * NMETA + (r & 15) : b * SEQ + 32 * (g - 1) + r;
    const int tq0 = g == 0 ? 0 : NMETA + 32 * (g - 1);
    const bool qvalid = r < nq;
    auto ks_row0 = [&](int ks) -> int { return ks == 0 ? MR + b * NMETA : b * SEQ + 32 * (ks - 1); };
    __syncthreads();
    for (int i = tid; i < 32 * 129; i += NTHREADS) ((LAS unsigned*)(L + IDX_HIST))[i] = 0u;
    if (tid < 32) ((LAS unsigned*)(L + IDX_CCNT))[tid] = 0u;
    float w[8];
    const LAS unsigned char* qf = L + IDX_Q + r * IDX_QPITCH + 8 * h * 2;
    { for (int i = tid; i < 32 * 64; i += NTHREADS) { const int qq = i >> 6, ch = i & 63; const int qr = g == 0 ? MR + b * NMETA + (qq & 15) : b * SEQ + 32 * (g - 1) + qq;
          *(LAS u32x4*)(L + IDX_Q + qq * IDX_QPITCH + ch * 16) = *(const u32x4*)(proj + PJ_QI + (size_t)qr * 1024 + ch * 16); }
      const float* WI = (const float*)(proj + PJ_WI) + (size_t)qrow * 8; const f32x4 w0 = *(const f32x4*)WI, w1 = *(const f32x4*)(WI + 4);
      w[0] = w0[0]; w[1] = w0[1]; w[2] = w0[2]; w[3] = w0[3]; w[4] = w1[0]; w[5] = w1[1]; w[6] = w1[2]; w[7] = w1[3]; }
    __syncthreads();
    if (tid < 256) { const int qq = tid >> 3, dc = tid & 7; const int qr = g == 0 ? MR + b * NMETA + (qq & 15) : b * SEQ + 32 * (g - 1) + qq;
        const float* WI = (const float*)(proj + PJ_WI) + (size_t)qr * 8; float a[8] = {0.f, 0.f, 0.f, 0.f, 0.f, 0.f, 0.f, 0.f};
#pragma unroll
        for (int hd = 0; hd < 8; ++hd) { const float wv = WI[hd]; const h8 q = *(const LAS h8*)(L + IDX_Q + qq * IDX_QPITCH + (hd * 64 + dc * 8) * 2);
#pragma unroll
            for (int e = 0; e < 8; ++e) a[e] += wv * (float)q[e]; }
        h8 o;
#pragma unroll
        for (int e = 0; e < 8; ++e) o[e] = (_Float16)a[e];
        *(LAS h8*)(L + IDX_Q + qq * IDX_QPITCH + (512 + dc * 8) * 2) = o; }
    __syncthreads();
    if (wave < 4) {
        const KFrag kf = idx_load_k(KI + (size_t)(b * SEQ + 32 * wave + r) * 128, h);
        f32x16 sc; idx_scores(qf, w, kf, sc);
        float s1 = 0.f, s2 = 0.f;
#pragma unroll
        for (int i = 0; i < 16; ++i) { s1 += sc[i]; s2 += sc[i] * sc[i]; }
        s1 = hsum32(s1, lane); s2 = hsum32(s2, lane);
        if (h == 0) { ((LAS float*)(L + IDX_STATS))[(wave * 32 + r) * 2] = s1; ((LAS float*)(L + IDX_STATS))[(wave * 32 + r) * 2 + 1] = s2; }
    }
    __syncthreads();
    float c0f, inv;
    { float s1 = 0.f, s2 = 0.f;
#pragma unroll
      for (int k = 0; k < 4; ++k) { s1 += ((LAS float*)(L + IDX_STATS))[(k * 32 + r) * 2]; s2 += ((LAS float*)(L + IDX_STATS))[(k * 32 + r) * 2 + 1]; }
      const float mean = s1 * (1.0f / 128.0f), var = fmaxf(s2 * (1.0f / 128.0f) - mean * mean, 0.f), sd = fmaxf(sqrtf(var), 1e-12f);
      inv = (float)IDX_NBIN / (10.0f * sd); c0f = -(mean - 3.0f * sd) * inv; }
    LAS unsigned* hrow = (LAS unsigned*)(L + IDX_HIST) + r * 129;
#if PROBE_REP == 12
    for (int rep12 = 0; rep12 < 2; ++rep12) { __syncthreads(); for (int i = tid; i < 32 * 129; i += NTHREADS) ((LAS unsigned*)(L + IDX_HIST))[i] = 0u; __syncthreads();
#else
    {
#endif
        KFrag kf = idx_load_k(KI + (size_t)(ks_row0(wave <= g ? wave : 0) + r) * 128, h);
#pragma unroll 1
        for (int ks = wave; ks <= g; ks += 8) {
            const KFrag kn = idx_load_k(KI + (size_t)(ks_row0(ks + 8 <= g ? ks + 8 : ks) + r) * 128, h);
            f32x16 sc; idx_scores(qf, w, kf, sc);
#if PROBE_REP == 11
            { f32x16 sc2; idx_scores(qf, w, kn, sc2); if (sc2[0] == 1.2345e30f) inv = 0.f; }
#endif
            if (ks == 0 || ks == g) {
#pragma unroll
                for (int i = 0; i < 16; ++i) {
                    const int kidx = crow(i, h);
                    const bool ok = qvalid && (ks == 0 ? kidx < NMETA && (g > 0 || kidx <= r) : kidx <= r);
                    if (ok) { const unsigned bin = (unsigned)__builtin_amdgcn_fmed3f(__builtin_fmaf(sc[i], inv, c0f), 0.f, (float)(IDX_NBIN - 1)); __hip_atomic_fetch_add(hrow + bin, 1u, __ATOMIC_RELAXED, __HIP_MEMORY_SCOPE_WORKGROUP); }
                }
            } else {
#pragma unroll
                for (int i = 0; i < 16; ++i) { const unsigned bin = (unsigned)__builtin_amdgcn_fmed3f(__builtin_fmaf(sc[i], inv, c0f), 0.f, (float)(IDX_NBIN - 1)); __hip_atomic_fetch_add(hrow + bin, 1u, __ATOMIC_RELAXED, __HIP_MEMORY_SCOPE_WORKGROUP); }
            }
            kf = kn;
        }
    }
    __syncthreads();
#pragma unroll 1
    for (int k = 0; k < 4; ++k) {
        const int row = 4 * wave + k;
        const int c0 = (int)((LAS unsigned*)(L + IDX_HIST))[row * 129 + 2 * lane], c1 = (int)((LAS unsigned*)(L + IDX_HIST))[row * 129 + 2 * lane + 1];
        const int SL = suffix_sum(c0 + c1, lane), NT = __builtin_amdgcn_readlane(SL, 0);
        int bstar = -1, need = 0;
        if (NT > 256) {
            const unsigned long long ml = __ballot(SL >= 256); const int lL = 63 - __builtin_clzll(ml); const int sl = __builtin_amdgcn_readlane(SL, lL), t0 = __builtin_amdgcn_readlane(c0, lL), t1 = __builtin_amdgcn_readlane(c1, lL); const int above = sl - t0 - t1;
            if (above + t1 >= 256) { bstar = 2 * lL + 1; need = 256 - above; } else { bstar = 2 * lL; need = 256 - above - t1; }
        }
        if (lane == 0) { ((LAS int*)(L + IDX_INFO))[row * 2] = bstar; ((LAS int*)(L + IDX_INFO))[row * 2 + 1] = need; }
    }
    __syncthreads();
    float lo_f, hi_f;
    { const int bstar = ((LAS int*)(L + IDX_INFO))[r * 2];
      hi_f = bstar < 0 ? -__builtin_inff() : (bstar >= IDX_NBIN - 1 ? __builtin_inff() : (float)(bstar + 1));
      lo_f = bstar <= 0 ? -__builtin_inff() : (float)bstar; }
    {
        KFrag kf = idx_load_k(KI + (size_t)(ks_row0(wave <= g ? wave : 0) + r) * 128, h);
#pragma unroll 1
        for (int ks = wave; ks <= g; ks += 8) {
            const KFrag kn = idx_load_k(KI + (size_t)(ks_row0(ks + 8 <= g ? ks + 8 : ks) + r) * 128, h);
            f32x16 sc; idx_scores(qf, w, kf, sc);
            unsigned part = 0u;
            const bool special = (ks == 0 || ks == g);
#pragma unroll
            for (int i = 0; i < 16; ++i) {
                const int kidx = crow(i, h);
                bool ok = true;
                if (special) ok = qvalid && (ks == 0 ? kidx < NMETA && (g > 0 || kidx <= r) : kidx <= r);
                const float x = __builtin_fmaf(sc[i], inv, c0f);
                const bool sure = ok && (x >= hi_f), cand = ok && !(x >= hi_f) && (x >= lo_f);
                part |= sure ? (1u << kidx) : 0u;
                if (cand) { const unsigned slot = __hip_atomic_fetch_add((LAS unsigned*)(L + IDX_CCNT) + r, 1u, __ATOMIC_RELAXED, __HIP_MEMORY_SCOPE_WORKGROUP);
                    if (slot < IDX_CAP) { LAS float* cp = (LAS float*)(L + IDX_CAND) + (r * IDX_CAP + slot) * 2; cp[0] = sc[i]; ((LAS int*)cp)[1] = ks * 32 + kidx; } }
            }
            part = hor32(part, lane);
            if (h == 0) ((LAS unsigned*)(L + IDX_MASK))[ks * 32 + r] = part;
            kf = kn;
        }
    }
    __syncthreads();
#pragma unroll 1
    for (int k = 0; k < 4; ++k) {
        const int row = 4 * wave + k;
        const int need = ((LAS int*)(L + IDX_INFO))[row * 2 + 1];
        int nc = (int)((LAS unsigned*)(L + IDX_CCNT))[row]; nc = nc < IDX_CAP ? nc : IDX_CAP;
        const LAS float* cb = (const LAS float*)(L + IDX_CAND) + row * IDX_CAP * 2;
#pragma unroll 1
        for (int ci = lane; ci < nc; ci += 64) {
            const float sv = cb[ci * 2]; const int kv = ((const LAS int*)cb)[ci * 2 + 1];
            int rank = 0;
            if (need < nc) { for (int j = 0; j < nc; ++j) { const float sj = cb[j * 2]; const int kj = ((const LAS int*)cb)[j * 2 + 1]; rank += (sj > sv || (sj == sv && kj < kv)) ? 1 : 0; } }
            if (rank < need) __hip_atomic_fetch_or((LAS unsigned*)(L + IDX_MASK) + (kv >> 5) * 32 + row, 1u << (kv & 31), __ATOMIC_RELAXED, __HIP_MEMORY_SCOPE_WORKGROUP);
        }
    }
    __syncthreads();
    unsigned* MK = (unsigned*)(F.ws + WS_MASK) + (size_t)b * NKS * TLEN;
    for (int i = tid; i < (g + 1) * 32; i += NTHREADS) { const int ks = i >> 5, rr = i & 31; if (rr < nq) MK[(size_t)ks * TLEN + tq0 + rr] = ((LAS unsigned*)(L + IDX_MASK))[i]; }
}
__device__ __forceinline__ void mixA_index_phase(const Frame& F) {
#pragma unroll 1
    for (int c = F.bid; c < 256; c += F.G) {
#pragma unroll 1
        for (int k = 0; k < 5; ++k) {
            int u; if (k == 0) u = c; else if (k == 1) u = 511 - c; else if (k == 2) u = 512 + c; else if (k == 3) u = 1023 - c; else { if (c >= 2) break; u = 1024 + c; }
            mixA_index_unit(F, u & 1, 512 - (u >> 1));
        }
    }
}

__device__ __forceinline__ void mixA3_unit(const Frame& F, int l, int b, int ha, int qblk) {
    LAS unsigned char* L = F.lds + LDS_GEN;
    const int tid = F.tid, lane = F.lane, wave = F.wave, r = lane & 31, h = lane >> 5;
    const unsigned char* proj = F.ws + WS_PROJ;
    const _Float16* QA = (const _Float16*)(proj + PJ_QA); const unsigned char* KA = proj + PJ_KA; const unsigned char* VA = proj + PJ_VA;
    const unsigned* kmax = (const unsigned*)(F.ws + WS_CTL) + CW_KMAX + 32 * l;
    const unsigned* MK = (const unsigned*)(F.ws + WS_MASK) + (size_t)b * NKS * TLEN;
    const bool meta_u = qblk < 0;
    const int qrow0 = meta_u ? MR + b * NMETA : b * SEQ + qblk * 256;
    const int qpos0 = meta_u ? 0 : NMETA + qblk * 256;
    const int nreal = meta_u ? 0 : 4 * qblk + 4;
    const int wq0 = 32 * wave;
    const bool wave_on = meta_u ? (wave == 0) : true;
    const int my_row = wave_on ? qrow0 + wq0 + r : qrow0, my_pos = wave_on ? qpos0 + wq0 + r : 0;
    __syncthreads();
    if (tid < 128) ((LAS float*)(L + B_LUT))[tid] = F.rel_bias[BUCKET_LUT[tid] * 12 + ha] * LOG2E;
    float bmax = (lane < 32) ? F.rel_bias[lane * 12 + ha] * LOG2E : -1e30f;
    bmax = fmaxf(bmax, sx<16>(bmax, lane)); bmax = fmaxf(bmax, sx<8>(bmax, lane)); bmax = fmaxf(bmax, sx<4>(bmax, lane)); bmax = fmaxf(bmax, sx<2>(bmax, lane)); bmax = fmaxf(bmax, sx<1>(bmax, lane));
    bmax = bcast0(bmax);
    const float bfar = F.rel_bias[31 * 12 + ha] * LOG2E;
    h8 qf[4]; float mq;
    { float n2 = 0.f;
#pragma unroll
      for (int s = 0; s < 4; ++s) { qf[s] = *(const h8*)(QA + (size_t)my_row * 512 + ha * 64 + 16 * s + 8 * h);
#pragma unroll
          for (int j = 0; j < 8; ++j) { const float v = (float)qf[s][j]; n2 += v * v; } }
      n2 = hsum32(n2, lane);
      mq = sqrtf(n2 * (__uint_as_float(kmax[ha * 2]) + __uint_as_float(kmax[ha * 2 + 1]))) * 1.002f + bmax; }
    f32x16 cfar;
#pragma unroll
    for (int i = 0; i < 16; ++i) cfar[i] = bfar - mq;
    f32x16 O[2]; float lsum = 0.f;
#pragma unroll
    for (int d = 0; d < 2; ++d)
#pragma unroll
        for (int i = 0; i < 16; ++i) O[d][i] = 0.f;
    const int skey = tid >> 3, sch = tid & 7;
    const unsigned kdst = skey * KS_PITCH + sch * 16, vdst = (sch >> 2) * 4096 + skey * 64 + (sch & 3) * 16;
    const int ntiles = 1 + nreal;
    auto tile_row0 = [&](int t) -> int { return t == 0 ? MR + b * NMETA : b * SEQ + (t - 1) * 64; };
    u32x4 kreg, vreg;
    { const size_t rr = (size_t)(tile_row0(0) + skey); kreg = *(const u32x4*)(KA + rr * 1024 + ha * 128 + sch * 16); vreg = *(const u32x4*)(VA + rr * 1024 + ha * 128 + sch * 16); }
    *(LAS u32x4*)(L + B_KS + kdst) = kreg; *(LAS u32x4*)(L + B_VS + vdst) = vreg;
    __syncthreads();
    unsigned mw[2], mwn[2] = {0u, 0u};
    mw[0] = MK[my_pos]; mw[1] = 0u;
#pragma unroll 1
    for (int t = 0; t < ntiles; ++t) {
        const int buf = t & 1;
        if (t + 1 < ntiles) { const size_t rr = (size_t)(tile_row0(t + 1) + skey); kreg = *(const u32x4*)(KA + rr * 1024 + ha * 128 + sch * 16); vreg = *(const u32x4*)(VA + rr * 1024 + ha * 128 + sch * 16);
            mwn[0] = MK[(size_t)(1 + 2 * t) * TLEN + my_pos]; mwn[1] = MK[(size_t)(2 + 2 * t) * TLEN + my_pos]; }
        const int kpos0 = (t == 0) ? 0 : NMETA + (t - 1) * 64, nvalid = (t == 0) ? NMETA : 64;
        const int wpos0 = qpos0 + wq0;
        if (wave_on && kpos0 <= wpos0 + 31) {
            LAS unsigned char* Kb = L + B_KS + buf * (64 * KS_PITCH); LAS unsigned char* Vb = L + B_VS + buf * 8192;
            const bool slow = (t == 0) || (kpos0 + 63 > wpos0 - 128);
#pragma unroll
            for (int sub = 0; sub < 2; ++sub) {
                if (sub * 32 >= nvalid || kpos0 + sub * 32 > wpos0 + 31) continue;
                const unsigned mword = mw[sub] >> (4 * h);
                f32x16 S;
                h8 kfr[4]; bf16x8v vfr[2][2];
#pragma unroll
                for (int s = 0; s < 4; ++s) kfr[s] = *(const LAS h8*)(Kb + (sub * 32 + r) * KS_PITCH + (16 * s + 8 * h) * 2);
#pragma unroll
                for (int d = 0; d < 2; ++d)
#pragma unroll
                    for (int s = 0; s < 2; ++s) vfr[d][s] = vt_frag(Vb, d, sub * 32, s, lane);
                __builtin_amdgcn_sched_barrier(0);
                if (slow) {
#pragma unroll
                    for (int i = 0; i < 16; ++i) S[i] = 0.f; } else S = cfar;
#pragma unroll
                for (int s = 0; s < 4; ++s) S = __builtin_amdgcn_mfma_f32_32x32x16_f16(kfr[s], qf[s], S, 0, 0, 0);
                if (slow) {
#pragma unroll
                    for (int i = 0; i < 16; ++i) {
                        const int kidx = sub * 32 + crow(i, h), dist = my_pos - (kpos0 + kidx);
                        const bool ok = ((mword >> ((i & 3) + 8 * (i >> 2))) & 1u) != 0u && dist >= 0 && kidx < nvalid;
                        const float bias = ((const LAS float*)(L + B_LUT))[min(max(dist, 0), 127)];
                        S[i] = ok ? __builtin_amdgcn_exp2f(S[i] + bias - mq) : 0.f;
                    }
                } else {
#pragma unroll
                    for (int i = 0; i < 16; ++i) S[i] = ((mword >> ((i & 3) + 8 * (i >> 2))) & 1u) ? __builtin_amdgcn_exp2f(S[i]) : 0.f;
                }
                { float a0 = S[0], a1 = S[1], a2 = S[2], a3 = S[3];
#pragma unroll
                  for (int i = 4; i < 16; i += 4) { a0 += S[i]; a1 += S[i + 1]; a2 += S[i + 2]; a3 += S[i + 3]; }
                  lsum += (a0 + a1) + (a2 + a3); }
                bf16x8v pf[2]; pf[0] = pack_p(S, 0); pf[1] = pack_p(S, 1);
#pragma unroll
                for (int d = 0; d < 2; ++d)
#pragma unroll
                    for (int s = 0; s < 2; ++s) O[d] = __builtin_amdgcn_mfma_f32_32x32x16_bf16(vfr[d][s], pf[s], O[d], 0, 0, 0);
            }
        }
        if (t + 1 < ntiles) { *(LAS u32x4*)(L + B_KS + (buf ^ 1) * (64 * KS_PITCH) + kdst) = kreg; *(LAS u32x4*)(L + B_VS + (buf ^ 1) * 8192 + vdst) = vreg; }
        mw[0] = mwn[0]; mw[1] = mwn[1];
        __syncthreads();
    }
    if (wave_on) {
        const float lt = hsum32(lsum, lane), il = 1.0f / lt;
        if (!meta_u || r < NMETA) {
            _Float16* dst = (_Float16*)(F.ws + WS_ABUF) + (size_t)my_row * DM + ha * 64;
#pragma unroll
            for (int d = 0; d < 2; ++d)
#pragma unroll
                for (int g4 = 0; g4 < 4; ++g4) { const int d0 = 32 * d + 8 * g4 + 4 * h;
                    u32x2 w; w.x = cvt_pk_f16(O[d][4 * g4 + 0] * il, O[d][4 * g4 + 1] * il); w.y = cvt_pk_f16(O[d][4 * g4 + 2] * il, O[d][4 * g4 + 3] * il);
                    *(u32x2*)(dst + d0) = w; }
        }
    }
}
__device__ __forceinline__ void mixA3_phase(const Frame& F, int l) {
#pragma unroll 1
    for (int c = F.bid; c < 256; c += F.G) { const int bh = c & 15, i1 = c >> 4, i2 = 31 - i1;
#pragma unroll 1
        for (int k = 0; k < 5; ++k) { if (k == 4 && c >= 16) break;
            const int qb = k == 0 ? 63 - i1 : (k == 1 ? 32 + i1 : (k == 2 ? i2 : (k == 3 ? i1 : -1)));
            mixA3_unit(F, l, bh >> 3, bh & 7, qb); }
    }
}
constexpr int NPHASES = 19;
__global__ void __launch_bounds__(NTHREADS, 2) fwd(Args args) {
    extern __shared__ __attribute__((aligned(16))) unsigned char lds_raw[];
    Frame F;
    F.x = args.in[0]; F.meta = args.in[1]; F.rel_bias = args.in[2]; F.w_in = args.in[3]; F.norm_mix = args.in[4]; F.diff_lambda = args.in[5]; F.diff_norm = args.in[6];
    F.ret_norm = args.in[7]; F.w_out = args.in[8]; F.norm_ff = args.in[9]; F.w_ff1 = args.in[10]; F.w_ff2 = args.in[11]; F.final_norm = args.in[12];
    F.out = args.out; F.ws = args.ws; F.lds = (LAS unsigned char*)lds_raw;
    F.bid = blockIdx.x; F.G = gridDim.x; F.tid = threadIdx.x; F.lane = F.tid & 63; F.wave = __builtin_amdgcn_readfirstlane(F.tid >> 6);
    if (F.tid < 64) ((LAS unsigned*)(F.lds + LDS_MISC))[F.tid] = 0u;
    __syncthreads();
    unsigned* ctl = (unsigned*)(F.ws + WS_CTL);
    XcdBarrier bar = xcd_barrier_post(ctl + CW_BAR, (volatile LAS unsigned*)(F.lds + LDS_MISC));
    const int lo = args.ph_lo, hi = args.ph_hi;
#define IN(k) (lo <= (k) && (k) < hi)
#ifndef PROBE_REP
#define PROBE_REP 0
#endif
#define RETID() do { unsigned z0_ = 0u; asm volatile("" : "+s"(z0_)); int t_ = (int)__builtin_amdgcn_mbcnt_hi(~0u, __builtin_amdgcn_mbcnt_lo(~0u, z0_)); asm volatile("" : "+v"(t_)); F.lane = t_; F.tid = F.wave * 64 + t_; } while (0)
#define REP(k) _Pragma("unroll 1") for (int rep_ = 0; rep_ < ((PROBE_REP == (k)) ? 2 : 1); ++rep_)
#define SEAM(k) do { if (IN(k) && IN((k) + 1)) xcd_barrier(bar, F.wave == 0 && F.lane == 0); } while (0)
    LAS unsigned char* stage = F.lds + LDS_GEN;
    if (IN(0)) { REP(10) prologue(F); SEAM(0); }
#pragma unroll 1
    for (int l = 0; l < DEPTH; ++l) {
        const int pb = 1 + 9 * l;
        { RETID();
          size_t z_ = 0; int b_ = blockIdx.x, g_ = gridDim.x; asm volatile("" : "+s"(z_), "+s"(b_), "+s"(g_)); F.ws = args.ws + z_; F.out = args.out + z_; F.bid = b_; F.G = g_; }
        unsigned char* wl = F.ws + WS_W + (size_t)l * W_LAYER;
        unsigned char* proj = F.ws + WS_PROJ;
        if (IN(pb + 0)) {
            pg8::Gemm g{(const pg8::bf16_t*)(F.ws + WS_ABUF), (const pg8::bf16_t*)(wl + W_IN_OFF), MP, NPAD, DM}; pg8::StaticOrder S; S.init(MP, NPAD, F.G, F.bid);
            EpiInProj E{proj, (const f32x2*)(F.ws + WS_ROPE), ctl + CW_KMAX + 32 * l};
            REP(7) pg8::gemm_phase<EpiInProj, pg8::StaticOrder>(stage, g, S, E, nullptr, F.tid);
            SEAM(pb + 0);
        }
        if (IN(pb + 1)) { RETID(); REP(1) mixA_index_phase(F); RETID(); REP(2) mixC1_phase(F); SEAM(pb + 1); }
        if (IN(pb + 2)) { RETID(); REP(3) mixC_scan(F); RETID(); REP(4) mixB_phase(F, l); SEAM(pb + 2); }
        if (IN(pb + 3)) { RETID(); REP(5) mixA3_phase(F, l); RETID(); REP(6) mixC2_phase(F, l); SEAM(pb + 3); }
        if (IN(pb + 4)) { RETID();
            pg8::Gemm g{(const pg8::bf16_t*)(F.ws + WS_ABUF), (const pg8::bf16_t*)(wl + W_OUT_OFF), MP, DM, DM}; pg8::StaticOrder S; S.init(MP, DM, F.G, F.bid);
            EpiRes E{l == 0 ? F.x : F.out, F.out, (float*)(F.ws + WS_HMETA)};
            pg8::gemm_phase<EpiRes, pg8::StaticOrder>(stage, g, S, E, nullptr, F.tid);
            SEAM(pb + 4);
        }
        if (IN(pb + 5)) { RETID(); REP(8) norm_to_abuf<1>(F, F.norm_ff + (size_t)l * DM); SEAM(pb + 5); }
        if (IN(pb + 6)) { RETID();
            pg8::Gemm g{(const pg8::bf16_t*)(F.ws + WS_ABUF), (const pg8::bf16_t*)(wl + W_FF1_OFF), MP, DFF, DM}; pg8::StaticOrder S; S.init(MP, DFF, F.G, F.bid);
            EpiRelu2 E{proj};
            REP(9) pg8::gemm_phase<EpiRelu2, pg8::StaticOrder>(stage, g, S, E, nullptr, F.tid);
            SEAM(pb + 6);
        }
        if (IN(pb + 7)) { RETID();
            pg8::Gemm g{(const pg8::bf16_t*)proj, (const pg8::bf16_t*)(wl + W_FF2_OFF), MP, DM, DFF}; pg8::StaticOrder S; S.init(MP, DM, F.G, F.bid);
            EpiRes E{F.out, F.out, (float*)(F.ws + WS_HMETA)};
            pg8::gemm_phase<EpiRes, pg8::StaticOrder>(stage, g, S, E, nullptr, F.tid);
            SEAM(pb + 7);
        }
        if (IN(pb + 8)) { RETID();
            if (l + 1 < DEPTH) { norm_to_abuf<1>(F, F.norm_mix + (size_t)(l + 1) * DM); SEAM(pb + 8); }
            else final_norm(F);
        }
    }
#undef IN
#undef SEAM
}

#ifndef MK_SPLIT
#define MK_SPLIT 0
#endif
extern "C" void kernel_launch(void* const* d_in, const int* in_sizes, int n_in, void* d_out, int out_size, void* d_ws, size_t ws_size, hipStream_t stream) {
    static int grid = 0;
    if (grid == 0) {
        if (n_in != 13 || ws_size < WS_END) { fprintf(stderr, "kernel_launch: need 13 inputs and %zu bytes of workspace; got %d, %zu\n", (size_t)WS_END, n_in, ws_size); grid = -1; return; }
        int dev = 0, cus = 0, per_cu = 0;
        if (hipGetDevice(&dev) != hipSuccess || hipDeviceGetAttribute(&cus, hipDeviceAttributeMultiprocessorCount, dev) != hipSuccess) { grid = -1; return; }
        if (hipFuncSetAttribute((const void*)fwd, hipFuncAttributeMaxDynamicSharedMemorySize, LDS_BYTES) != hipSuccess) { fprintf(stderr, "kernel_launch: hipFuncSetAttribute failed\n"); grid = -1; return; }
        if (hipOccupancyMaxActiveBlocksPerMultiprocessor(&per_cu, (const void*)fwd, NTHREADS, LDS_BYTES) != hipSuccess || per_cu < 1) { fprintf(stderr, "kernel_launch: occupancy query says %d\n", per_cu); }
        (void)hipGetLastError();
        grid = cus;
    }
    if (grid < 0) return;
    (void)hipMemsetAsync((char*)d_ws + WS_CTL, 0, CTL_BYTES, stream);
    Args a{};
    for (int i = 0; i < 13; ++i) a.in[i] = (const float*)d_in[i];
    a.out = (float*)d_out; a.ws = (unsigned char*)d_ws;
#if MK_SPLIT
    for (int p = 0; p < NPHASES; ++p) { a.ph_lo = p; a.ph_hi = p + 1; hipLaunchKernelGGL(fwd, dim3(grid), dim3(NTHREADS), LDS_BYTES, stream, a); }
#else
    a.ph_lo = 0; a.ph_hi = NPHASES; hipLaunchKernelGGL(fwd, dim3(grid), dim3(NTHREADS), LDS_BYTES, stream, a);
#endif
}
```

```cpp
#include <hip/hip_runtime.h>
#include <cstdio>
#include <cstdint>
typedef _Float16 h8 __attribute__((ext_vector_type(8)));
typedef _Float16 h4 __attribute__((ext_vector_type(4)));
typedef _Float16 h2 __attribute__((ext_vector_type(2)));
typedef short s16x8 __attribute__((ext_vector_type(8)));
typedef short s16x4 __attribute__((ext_vector_type(4)));
typedef float f32x16 __attribute__((ext_vector_type(16)));
typedef float f32x2 __attribute__((ext_vector_type(2)));
typedef unsigned u32x2 __attribute__((ext_vector_type(2)));
namespace pg8 {
#define PG8_LAS __attribute__((address_space(3)))
typedef unsigned short bf16_t;
typedef short bf16x8 __attribute__((ext_vector_type(8)));
typedef float f32x4 __attribute__((ext_vector_type(4)));
typedef unsigned u32x4 __attribute__((ext_vector_type(4)));
constexpr int BM = 256, BK = 64, HALF = 128, HTB = HALF * BK * 2  , STAGE_BYTES = 8 * HTB, NXCD = 8, WGM = 8;

__host__ __device__ __forceinline__ int lds_byte(int r, int c) { const int st = (r >> 4) * 2 + (c >> 5), rr = r & 15, cc = c & 31, ob = rr * 64 + cc * 2; return st * 1024 + (ob ^ (((ob >> 9) & 1) << 5)); }
__host__ __device__ __forceinline__ void stage_rc(int b, int& R, int& C) { const int st = b / 1024, sb = b % 1024, swz = sb ^ (((sb >> 9) & 1) << 5); R = (st >> 1) * 16 + swz / 64; C = (st & 1) * 32 + (swz % 64) / 2; }
__host__ __device__ __forceinline__ int perm32(int rho) { const int n = rho >> 4, i = rho & 15; return 8 * (i >> 2) + 4 * n + (i & 3); }

struct Unit { int pm, pn; };
struct Gemm { const bf16_t* A; const bf16_t* Bt; int M, N, K; };

struct StaticOrder {
    int nM, nN, nwg, G, c;
    __host__ __device__ void init(int M, int N, int G_, int c_) { nM = M / BM; nN = N / BM; nwg = nM * nN; G = G_; c = c_; }
    __host__ __device__ bool next(int i, Unit& u) const {
        const long L = (long)i * G + c; if (L >= nwg) return false;
        int wgid = (int)L; { const int q = nwg / NXCD, r = nwg % NXCD, xcd = wgid % NXCD, off = wgid / NXCD; wgid = (xcd < r ? xcd * (q + 1) : r * (q + 1) + (xcd - r) * q) + off; }
        const int nig = WGM * nN, gid = wgid / nig, fm = gid * WGM, gsz = (nM - fm) < WGM ? (nM - fm) : WGM;
        u.pm = fm + ((wgid % nig) % gsz); u.pn = (wgid % nig) / gsz; return true;
    }
    __device__ __forceinline__ void a_ready(const Unit&) const {}
    __device__ __forceinline__ void done(const Unit&) const {}
};

template <class Epi, class Sched, bool STAMP = false>
__device__ __forceinline__ void gemm_phase(PG8_LAS unsigned char* lds, const Gemm g, const Sched& S, const Epi& E, unsigned long long* stamps, int tid_in) {
    int tid_ = tid_in; asm volatile("" : "+v"(tid_));
    const int tid = tid_, wid = __builtin_amdgcn_readfirstlane(tid >> 6), lane = tid & 63, wr = wid >> 2, wc = wid & 3, fr = lane & 15, fq = lane >> 4;
    const int K = g.K, nt = K / BK;
    int ts_lo = 0, ts_hi = 0, nts = 0; const unsigned long long rt_entry = STAMP ? (unsigned long long)wall_clock64() : 0ull;
#define PG8_STAMP() do { if (STAMP && wid == 0 && nts < 64) { const unsigned long long _c = (unsigned long long)clock64(); \
        ts_lo = (lane == nts) ? (int)(unsigned)_c : ts_lo; ts_hi = (lane == nts) ? (int)(unsigned)(_c >> 32) : ts_hi; ++nts; } } while (0)
    PG8_STAMP();
    unsigned voffA[2], voffB[2];
#pragma unroll
    for (int i = 0; i < 2; ++i) { int R, C; stage_rc(tid * 16 + i * 8192, R, C); const int Rb = Epi::PERM ? ((R & ~31) + perm32(R & 31)) : R;
        voffA[i] = (unsigned)(R * K + C) * 2u; voffB[i] = (unsigned)(Rb * K + C) * 2u; }
    const size_t kstep = (size_t)(BK * 2);
    const size_t hstep = (size_t)HALF * K * 2;
    const size_t tstep = 2 * hstep;
    const unsigned ldsw = (unsigned)wid * 1024u;
    const int aoff = lds_byte(wr * 64 + fr, fq * 8), boff = lds_byte(wc * 32 + fr, fq * 8);
#define PG8_SA(b, h) (((b) * 2 + (h)) * HTB)
#define PG8_SB(b, h) ((4 + (b) * 2 + (h)) * HTB)
#define PG8_STAGE(bufoff, gbase, voff) do { _Pragma("unroll") for (int _i = 0; _i < 2; ++_i) \
        __builtin_amdgcn_global_load_lds((const unsigned*)((const char*)(gbase) + (voff)[_i]), (PG8_LAS unsigned*)(lds + (bufoff) + ldsw + _i * 8192), 16, 0, 0); } while (0)
#define PG8_LDA(dst, b, h) do { _Pragma("unroll") for (int m = 0; m < 4; ++m) _Pragma("unroll") for (int k = 0; k < 2; ++k) dst[m][k] = *(const PG8_LAS bf16x8*)(lds + PG8_SA(b, h) + aoff + m * 2048 + k * 1024); } while (0)
#define PG8_LDB(dst, b, h) do { _Pragma("unroll") for (int n = 0; n < 2; ++n) _Pragma("unroll") for (int k = 0; k < 2; ++k) dst[n][k] = *(const PG8_LAS bf16x8*)(lds + PG8_SB(b, h) + boff + n * 2048 + k * 1024); } while (0)
#define PG8_MMA(ai, bj, At, Bt) do { __builtin_amdgcn_s_setprio(1); _Pragma("unroll") for (int m = 0; m < 4; ++m) _Pragma("unroll") for (int n = 0; n < 2; ++n) _Pragma("unroll") for (int k = 0; k < 2; ++k) \
        acc[ai][bj][m][n] = __builtin_amdgcn_mfma_f32_16x16x32_f16(__builtin_bit_cast(h8, Bt[n][k]), __builtin_bit_cast(h8, At[m][k]), acc[ai][bj][m][n], 0, 0, 0); __builtin_amdgcn_s_setprio(0); } while (0)
#define PG8_WAIT_V(n) asm volatile("s_waitcnt vmcnt(" #n ")" ::: "memory")
#define PG8_WAIT_L(n) asm volatile("s_waitcnt lgkmcnt(" #n ")" ::: "memory")
#define PG8_BAR __builtin_amdgcn_s_barrier()
#define PG8_SCHED __builtin_amdgcn_sched_barrier(0)
    Unit cur, nxt; int ui = 0;
    if (!S.next(0, cur)) return;
    f32x4 acc[2][2][4][2];
#pragma unroll
    for (int a = 0; a < 2; ++a)
#pragma unroll
        for (int b = 0; b < 2; ++b)
#pragma unroll
            for (int m = 0; m < 4; ++m)
#pragma unroll
                for (int n = 0; n < 2; ++n) acc[a][b][m][n] = (f32x4){0.f, 0.f, 0.f, 0.f};
    bf16x8 At[4][2], B0[2][2], B1[2][2];
    const char* cA = (const char*)g.A + (size_t)cur.pm * tstep; const char* cB = (const char*)g.Bt + (size_t)cur.pn * tstep;
    S.a_ready(cur);
    PG8_STAGE(PG8_SB(0, 0), cB, voffB); PG8_STAGE(PG8_SA(0, 0), cA, voffA); PG8_STAGE(PG8_SB(0, 1), cB + hstep, voffB); PG8_STAGE(PG8_SA(0, 1), cA + hstep, voffA);
    if (wr == 1) PG8_BAR;
    PG8_WAIT_V(4); PG8_BAR;
    PG8_STAGE(PG8_SB(1, 0), cB + kstep, voffB); PG8_STAGE(PG8_SA(1, 0), cA + kstep, voffA); PG8_STAGE(PG8_SB(1, 1), cB + hstep + kstep, voffB);
    PG8_WAIT_V(6); PG8_BAR;
    PG8_STAMP();
    for (;;) {
        const bool has_next = S.next(ui + 1, nxt);
        const char* nA = has_next ? (const char*)g.A + (size_t)nxt.pm * tstep : cA; const char* nB = has_next ? (const char*)g.Bt + (size_t)nxt.pn * tstep : cB;
        for (int t = 0; t < nt; t += 2) {
            const bool last = (t == nt - 2);
            const char* a1 = cA + (size_t)(t + 1) * kstep;
            const char* a2 = last ? nA : cA + (size_t)(t + 2) * kstep; const char* b2 = last ? nB : cB + (size_t)(t + 2) * kstep;
            const char* a3 = a2 + kstep; const char* b3 = b2 + kstep;
            if (last && has_next) S.a_ready(nxt);
            PG8_LDB(B0, 0, 0); PG8_SCHED; PG8_LDA(At, 0, 0); PG8_STAGE(PG8_SA(1, 1), a1 + hstep, voffA);
            PG8_WAIT_L(8); PG8_BAR; PG8_WAIT_L(0); PG8_MMA(0, 0, At, B0); PG8_BAR; PG8_SCHED;
            PG8_LDB(B1, 0, 1); PG8_STAGE(PG8_SB(0, 0), b2, voffB);
            PG8_BAR; PG8_WAIT_L(0); PG8_MMA(0, 1, At, B1); PG8_BAR;
            PG8_LDA(At, 0, 1); PG8_STAGE(PG8_SA(0, 0), a2, voffA);
            PG8_BAR; PG8_WAIT_L(0); PG8_MMA(1, 0, At, B0); PG8_BAR; PG8_SCHED;
            PG8_STAGE(PG8_SB(0, 1), b2 + hstep, voffB);
            PG8_WAIT_V(6); PG8_BAR; PG8_MMA(1, 1, At, B1); PG8_BAR;
            PG8_LDB(B0, 1, 0); PG8_SCHED; PG8_LDA(At, 1, 0); PG8_STAGE(PG8_SA(0, 1), a2 + hstep, voffA);
            PG8_WAIT_L(8); PG8_BAR; PG8_WAIT_L(0); PG8_MMA(0, 0, At, B0); PG8_BAR; PG8_SCHED;
            PG8_LDB(B1, 1, 1); PG8_STAGE(PG8_SB(1, 0), b3, voffB);
            PG8_BAR; PG8_WAIT_L(0); PG8_MMA(0, 1, At, B1); PG8_BAR;
            PG8_LDA(At, 1, 1); PG8_STAGE(PG8_SA(1, 0), a3, voffA);
            PG8_BAR; PG8_WAIT_L(0); PG8_MMA(1, 0, At, B0); PG8_BAR; PG8_SCHED;
            PG8_STAGE(PG8_SB(1, 1), b3 + hstep, voffB);
            PG8_WAIT_V(6); PG8_BAR; PG8_MMA(1, 1, At, B1); PG8_BAR;
        }
        PG8_STAMP();
        if constexpr (!Epi::AFTER_DRAIN) { E(acc, cur, wr, wc, fr, fq); S.done(cur); }
        PG8_STAMP();
        if (!has_next) break;
#pragma unroll
        for (int a = 0; a < 2; ++a)
#pragma unroll
            for (int b = 0; b < 2; ++b)
#pragma unroll
                for (int m = 0; m < 4; ++m)
#pragma unroll
                    for (int n = 0; n < 2; ++n) acc[a][b][m][n] = (f32x4){0.f, 0.f, 0.f, 0.f};
        cur = nxt; cA = nA; cB = nB; ++ui;
    }
    PG8_WAIT_V(0);
    if (wr == 0) PG8_BAR;
    PG8_BAR;
    if constexpr (Epi::AFTER_DRAIN) { E.fused(acc, cur, wr, wc, fr, fq, lds, wid, lane); S.done(cur); }
    PG8_STAMP();
    if (STAMP && wid == 0) { stamps[lane] = lane < nts ? (((unsigned long long)(unsigned)ts_hi << 32) | (unsigned)ts_lo) : 0ull;
        if (lane == 62) stamps[62] = rt_entry; if (lane == 63) stamps[63] = (unsigned long long)wall_clock64(); }
#undef PG8_STAMP
#undef PG8_SA
#undef PG8_SB
#undef PG8_STAGE
#undef PG8_LDA
#undef PG8_LDB
#undef PG8_MMA
#undef PG8_WAIT_V
#undef PG8_WAIT_L
#undef PG8_BAR
#undef PG8_SCHED
}
}

#define XB_TMO      128
#define XB_XCNT(j)  (256  + 64 * (j))
#define XB_XSUB(j)  (1280 + 64 * (j))
#define XB_XGEN(j)  (2304 + 64 * (j))
#define XB_TOP      3328
#define XB_TOPGEN   3392
#define XCD_BAR_WORDS 3456
#define XB_SPIN_CAP (1u << 18)
#define LAS __attribute__((address_space(3)))

__device__ __forceinline__ unsigned xb_ld(unsigned* p)              { return __hip_atomic_load(p, __ATOMIC_RELAXED, __HIP_MEMORY_SCOPE_AGENT); }
__device__ __forceinline__ unsigned xb_add(unsigned* p, unsigned v) { return __hip_atomic_fetch_add(p, v, __ATOMIC_RELAXED, __HIP_MEMORY_SCOPE_AGENT); }
__device__ __forceinline__ unsigned xb_xcc_id() { return (unsigned)__builtin_amdgcn_s_getreg((3 << 11) | 20) & 0xFu; }
#define XB_SPIN(cond, bar) do { unsigned _sp = 0; while (cond) { __builtin_amdgcn_s_sleep(1); \
    if ((++_sp & 255u) == 0u) { if (xb_ld(&(bar)[XB_TMO])) break; if (_sp > XB_SPIN_CAP) { atomicAdd(&(bar)[XB_TMO], 1u); break; } } } } while (0)

struct XcdBarrier {
    unsigned* bar; unsigned x;
    volatile LAS unsigned* st;
};

__device__ __forceinline__ XcdBarrier xcd_barrier_post(unsigned* bar, volatile LAS unsigned* st) {
    XcdBarrier b; b.bar = bar; b.x = xb_xcc_id(); b.st = st;
    if (threadIdx.x == 0) (void)xb_add(&bar[XB_XCNT(b.x)], 1u);
    return b;
}
__device__ __forceinline__ void xcd_barrier_complete(unsigned* bar, unsigned x, unsigned& nloc, unsigned& nx) {
    const unsigned G = gridDim.x * gridDim.y * gridDim.z;
    unsigned sum, cnt, mine, sp = 0u;
    for (;;) {
        sum = 0u; cnt = 0u; mine = 0u;
#pragma unroll
        for (unsigned j = 0; j < 16; ++j) { const unsigned c = xb_ld(&bar[XB_XCNT(j)]); sum += c; cnt += (c > 0u) ? 1u : 0u; mine = (j == x) ? c : mine; }
        if (sum == G) break;
        __builtin_amdgcn_s_sleep(1);
        if ((++sp & 255u) == 0u) { if (xb_ld(&bar[XB_TMO])) break; if (sp > XB_SPIN_CAP) { atomicAdd(&bar[XB_TMO], 1u); break; } }
    }
    nloc = mine > 0u ? mine : 1u; nx = cnt > 0u ? cnt : 1u;
}

__device__ __forceinline__ void xcd_barrier(const XcdBarrier& b, const bool leader_thread) {
    asm volatile("s_waitcnt vmcnt(0)" ::: "memory");
    __syncthreads();
    if (leader_thread) {
        unsigned* bar = b.bar;
        __builtin_amdgcn_s_waitcnt(0);
        unsigned nloc = b.st[0], nx = b.st[1];
        if (nloc == 0u) { xcd_barrier_complete(bar, b.x, nloc, nx); b.st[0] = nloc; b.st[1] = nx; }
        const unsigned old = xb_add(&bar[XB_XSUB(b.x)], 1u);
        const unsigned gen = old / nloc;
        if (old + 1u == (gen + 1u) * nloc) {
            __builtin_amdgcn_fence(__ATOMIC_RELEASE, "agent");
            asm volatile("s_waitcnt vmcnt(0)" ::: "memory");
            const unsigned og = xb_add(&bar[XB_TOP], 1u);
            const unsigned tg = og / nx;
            if (og + 1u == (tg + 1u) * nx) xb_add(&bar[XB_TOPGEN], 1u);
            else XB_SPIN(xb_ld(&bar[XB_TOPGEN]) == tg, bar);
            __builtin_amdgcn_fence(__ATOMIC_ACQUIRE, "agent");
            xb_add(&bar[XB_XGEN(b.x)], 1u);
            asm volatile("s_waitcnt vmcnt(0)" ::: "memory");
        } else {
            XB_SPIN(xb_ld(&bar[XB_XGEN(b.x)]) == gen, bar);
            __builtin_amdgcn_fence(__ATOMIC_ACQUIRE, "agent");
            asm volatile("s_waitcnt vmcnt(0)" ::: "memory");
        }
    }
    __syncthreads();
}

constexpr int NB = 2, SEQ = 16384, TLEN = 16400, DM = 1024, NMETA = 16, DEPTH = 2;
constexpr int MR = NB * SEQ;
constexpr int MV = MR + NB * NMETA;
constexpr int MP = 33024;
constexpr int INCOLS = 3912, NPAD = 4096, DFF = 4096;
constexpr int NTHREADS = 512;
constexpr float LOG2E = 1.4426950408889634f;
constexpr float QA_SCALE = 0.125f * LOG2E;
constexpr float QB_SCALE = 0.17677669529663687f * LOG2E;
constexpr float WI_SCALE = 0.044194173824159216f;
constexpr int NKS = 513;

constexpr size_t al256(size_t x) { return (x + 255) & ~(size_t)255; }
constexpr size_t WS_CTL   = 0;
constexpr size_t CTL_BYTES = 65536;
constexpr size_t WS_HMETA = CTL_BYTES;
constexpr size_t WS_ROPE  = WS_HMETA + (size_t)256 * DM * 4;
constexpr size_t WS_W     = al256(WS_ROPE + (size_t)TLEN * 32 * 8);
constexpr size_t W_IN_OFF = 0, W_OUT_OFF = (size_t)NPAD * DM * 2, W_FF1_OFF = W_OUT_OFF + (size_t)DM * DM * 2,
                 W_FF2_OFF = W_FF1_OFF + (size_t)DFF * DM * 2, W_LAYER = W_FF2_OFF + (size_t)DM * DFF * 2;
constexpr size_t WS_ABUF  = al256(WS_W + DEPTH * W_LAYER);
constexpr size_t WS_MASK  = WS_ABUF + (size_t)MP * DM * 2;
constexpr size_t WS_U     = al256(WS_MASK + (size_t)NB * NKS * TLEN * 4);
constexpr size_t WS_S     = WS_U + (size_t)NB * 4 * 129 * 4096 * 4;
constexpr size_t WS_PROJ  = WS_S + (size_t)NB * 4 * 129 * 4096 * 4;
constexpr size_t P512 = (size_t)MP * 512 * 2, P256 = (size_t)MP * 256 * 2;
constexpr size_t PJ_QA = 0, PJ_KA = P512, PJ_VA = 2 * P512, PJ_QI = 3 * P512, PJ_256 = 4 * P512;
constexpr size_t PJ_QB = PJ_256, PJ_KB = PJ_256 + P256, PJ_VB = PJ_256 + 2 * P256, PJ_QC = PJ_256 + 3 * P256, PJ_KC = PJ_256 + 4 * P256,
                 PJ_VC = PJ_256 + 5 * P256, PJ_GC = PJ_256 + 6 * P256, PJ_KI = PJ_256 + 7 * P256, PJ_WI = PJ_KI + (size_t)MP * 64 * 2,
                 PJ_END = PJ_WI + (size_t)MP * 8 * 4;
constexpr size_t ACT_BYTES = (size_t)MP * DFF * 2;
constexpr size_t WS_END = WS_PROJ + (ACT_BYTES > PJ_END ? ACT_BYTES : PJ_END);
constexpr int CW_BAR = 0;
constexpr int CW_KMAX = 4096;

constexpr int LDS_BYTES = 156 * 1024;
constexpr int LDS_MISC = 0, LDS_GEN = 256;

struct Args { const float* in[13]; float* out; unsigned char* ws; int ph_lo, ph_hi; };

struct Frame {
    const float *x, *meta, *rel_bias, *w_in, *norm_mix, *diff_lambda, *diff_norm, *ret_norm, *w_out, *norm_ff, *w_ff1, *w_ff2, *final_norm;
    float* out; unsigned char* ws; LAS unsigned char* lds; int tid, lane, wave, bid, G;
};

__device__ __forceinline__ float shx(float v, int m, int lane) { return __builtin_bit_cast(float, __builtin_amdgcn_ds_bpermute((lane ^ m) << 2, __builtin_bit_cast(int, v))); }
template <int M> __device__ __forceinline__ float sx(float v, int lane) { return shx(v, M, lane); }
__device__ __forceinline__ float hsum32(float v, int lane) { return v + shx(v, 32, lane); }
__device__ __forceinline__ unsigned hor32(unsigned v, int lane) { return v | (unsigned)__builtin_amdgcn_ds_bpermute((lane ^ 32) << 2, (int)v); }
__device__ __forceinline__ float bcast0(float v) { return __builtin_bit_cast(float, __builtin_amdgcn_ds_bpermute(0, __builtin_bit_cast(int, v))); }
__device__ __forceinline__ float wave_sum(float v, int lane) { v = hsum32(v, lane); v += sx<16>(v, lane); v += sx<8>(v, lane); v += sx<4>(v, lane); v += sx<2>(v, lane); v += sx<1>(v, lane); return v; }
__device__ __forceinline__ unsigned cvt_pk_bf16(float lo, float hi) { unsigned r; asm volatile("v_cvt_pk_bf16_f32 %0, %1, %2" : "=v"(r) : "v"(lo), "v"(hi)); return r; }
__device__ __forceinline__ unsigned cvt_pk_f16(float lo, float hi) { h2 p; p.x = (_Float16)lo; p.y = (_Float16)hi; return __builtin_bit_cast(unsigned, p); }
typedef unsigned u32x4 __attribute__((ext_vector_type(4)));
typedef float f32x4 __attribute__((ext_vector_type(4)));
__device__ __forceinline__ u32x4 pack8(const f32x4& a, const f32x4& b, bool bf) {
    u32x4 w;
    if (bf) { w.x = cvt_pk_bf16(a[0], a[1]); w.y = cvt_pk_bf16(a[2], a[3]); w.z = cvt_pk_bf16(b[0], b[1]); w.w = cvt_pk_bf16(b[2], b[3]); }
    else    { w.x = cvt_pk_f16(a[0], a[1]);  w.y = cvt_pk_f16(a[2], a[3]);  w.z = cvt_pk_f16(b[0], b[1]);  w.w = cvt_pk_f16(b[2], b[3]); }
    return w;
}
__device__ __forceinline__ int row_pos(int r) { return r < MR ? (r & (SEQ - 1)) + NMETA : ((r - MR) & 15); }

__device__ __forceinline__ int incol_map(int n) {
    if (n < 2048) return n;
    if (n < 2816) return n - 2048 + 2120;
    if (n < 3328) {
        const int seg = (n - 2816) >> 8, c = (n - 2816) & 255, head = c >> 6, p = c & 63;
        const int g = p >> 3, nn = (p >> 2) & 1, i = p & 3, d = 32 * nn + 4 * g + i;
        return (seg ? 3144 : 2888) + head * 64 + d;
    }
    if (n < 3840) return n - 3328 + 3400;
    if (n < 3904) return n - 3840 + 2048;
    if (n < 3912) return n - 3904 + 2112;
    return -1;
}

__constant__ double ROPE_REV[32] = {0.15915494309189535, 0.11934937021124886, 0.08949940160889101, 0.06711508300522726, 0.050329212104487035, 0.03774158471741977, 0.0283021958306234, 0.02122365276477766, 0.015915494309189534, 0.011934937021124886, 0.008949940160889102, 0.006711508300522725, 0.005032921210448704, 0.003774158471741977, 0.00283021958306234, 0.0021223652764777662, 0.0015915494309189536, 0.0011934937021124885, 0.0008949940160889102, 0.0006711508300522726, 0.0005032921210448703, 0.00037741584717419774, 0.00028302195830623395, 0.0002122365276477766, 0.00015915494309189535, 0.00011934937021124886, 8.949940160889102e-05, 6.711508300522725e-05, 5.0329212104487035e-05, 3.774158471741978e-05, 2.8302195830623396e-05, 2.122365276477766e-05};

struct EpiInProj {
    static constexpr bool PERM = true, AFTER_DRAIN = false;
    unsigned char* proj; const f32x2* rope; unsigned* kmax;
    __device__ __forceinline__ void kmax_update(const pg8::f32x4 (&acc)[2][2][4][2], int bj, unsigned* word, int fr, int fq) const {
        float mx = 0.f; const int LN = fq * 16 + fr;
#pragma unroll
        for (int ai = 0; ai < 2; ++ai)
#pragma unroll
            for (int m = 0; m < 4; ++m) {
                const pg8::f32x4 a = acc[ai][bj][m][0], b = acc[ai][bj][m][1];
                float s = (a[0] * a[0] + a[1] * a[1]) + (a[2] * a[2] + a[3] * a[3]) + (b[0] * b[0] + b[1] * b[1]) + (b[2] * b[2] + b[3] * b[3]);
                s += sx<16>(s, LN); s = hsum32(s, LN);
                mx = fmaxf(mx, s);
            }
        mx = fmaxf(mx, sx<1>(mx, LN)); mx = fmaxf(mx, sx<2>(mx, LN)); mx = fmaxf(mx, sx<4>(mx, LN)); mx = fmaxf(mx, sx<8>(mx, LN));
        if (fr == 0 && fq == 0) atomicMax(word, __float_as_uint(mx));
    }
    __device__ __forceinline__ void operator()(const pg8::f32x4 (&acc)[2][2][4][2], const pg8::Unit& u, int wr, int wc, int fr, int fq) const {
        const int pn = u.pn, rbase = u.pm * 256 + wr * 64 + fr, cw = wc * 32 + 8 * fq;
        if (pn <= 7 || (pn <= 14 && pn != 11 && pn != 12)) {
            unsigned char* base; int ld, colt; float scale = 1.f; bool bf = false;
            if (pn <= 7) { const int arr = pn >> 1; base = proj + (size_t)arr * P512; ld = 512; colt = (pn & 1) * 256; if (arr == 0) scale = QA_SCALE; bf = (arr == 2); }
            else { const int arr = pn - 8; base = proj + PJ_256 + (size_t)arr * P256; ld = 256; colt = 0; if (arr == 0) scale = QB_SCALE; bf = (arr == 2); }
#pragma unroll
            for (int ai = 0; ai < 2; ++ai)
#pragma unroll
                for (int m = 0; m < 4; ++m) {
                    const int row = rbase + ai * 128 + m * 16;
#pragma unroll
                    for (int bj = 0; bj < 2; ++bj) {
                        const pg8::f32x4 v0 = acc[ai][bj][m][0] * scale, v1 = acc[ai][bj][m][1] * scale;
                        *(u32x4*)(base + ((size_t)row * ld + colt + bj * 128 + cw) * 2) = pack8(v0, v1, bf);
                    }
                }
            if (pn == 2 || pn == 3) {
#pragma unroll
                for (int bj = 0; bj < 2; ++bj) { const int head = ((pn & 1) * 256 + bj * 128 + wc * 32) >> 6; kmax_update(acc, bj, kmax + head * 2 + (wc & 1), fr, fq); }
            }
            if (pn == 9) {
#pragma unroll
                for (int bj = 0; bj < 2; ++bj) { const int head = 2 * bj + (wc >> 1); kmax_update(acc, bj, kmax + 16 + head * 2 + (wc & 1), fr, fq); }
            }
        } else if (pn == 11 || pn == 12) {
            unsigned char* base = proj + PJ_256 + (size_t)(pn - 8) * P256;
            const float sc = (pn == 12) ? 0.125f : 1.f;
            const int g = 4 * (wc & 1) + fq;
#pragma unroll
            for (int ai = 0; ai < 2; ++ai)
#pragma unroll
                for (int m = 0; m < 4; ++m) {
                    const int row = rbase + ai * 128 + m * 16, t = row_pos(row);
                    const pg8::f32x4 cs0 = *(const pg8::f32x4*)(rope + (size_t)t * 32 + 4 * g), cs1 = *(const pg8::f32x4*)(rope + (size_t)t * 32 + 4 * g + 2);
                    const float c[4] = {cs0[0], cs0[2], cs1[0], cs1[2]}, s[4] = {cs0[1], cs0[3], cs1[1], cs1[3]};
#pragma unroll
                    for (int bj = 0; bj < 2; ++bj) {
                        const pg8::f32x4 x1 = acc[ai][bj][m][0], x2 = acc[ai][bj][m][1];
                        float o1[4], o2[4];
#pragma unroll
                        for (int i = 0; i < 4; ++i) { o1[i] = (x1[i] * c[i] - x2[i] * s[i]) * sc; o2[i] = (x1[i] * s[i] + x2[i] * c[i]) * sc; }
                        const int head = 2 * bj + (wc >> 1);
                        unsigned char* rp = base + ((size_t)row * 256 + head * 64 + 4 * g) * 2;
                        u32x2 w1, w2; w1.x = cvt_pk_f16(o1[0], o1[1]); w1.y = cvt_pk_f16(o1[2], o1[3]); w2.x = cvt_pk_f16(o2[0], o2[1]); w2.y = cvt_pk_f16(o2[2], o2[3]);
                        *(u32x2*)rp = w1; *(u32x2*)(rp + 64) = w2;
                    }
                }
        } else {
#pragma unroll
            for (int ai = 0; ai < 2; ++ai)
#pragma unroll
                for (int m = 0; m < 4; ++m) {
                    const int row = rbase + ai * 128 + m * 16;
                    const pg8::f32x4 v0 = acc[ai][0][m][0], v1 = acc[ai][0][m][1];
                    if (wc < 2) *(u32x4*)(proj + PJ_KI + ((size_t)row * 64 + cw) * 2) = pack8(v0, v1, false);
                    else if (wc == 2 && fq == 0) { float* wp = (float*)(proj + PJ_WI) + (size_t)row * 8; *(pg8::f32x4*)wp = v0 * WI_SCALE; *(pg8::f32x4*)(wp + 4) = v1 * WI_SCALE; }
                }
        }
    }
};
struct EpiRes {
    static constexpr bool PERM = false, AFTER_DRAIN = false;
    const float* res_main; float* out_main; float* hmeta;
    __device__ __forceinline__ void operator()(const pg8::f32x4 (&acc)[2][2][4][2], const pg8::Unit& u, int wr, int wc, int fr, int fq) const {
        const bool mt = (u.pm * 256 >= MR);
        const float* rb = mt ? hmeta : res_main; float* ob = mt ? hmeta : out_main;
        const int row0 = (mt ? u.pm * 256 - MR : u.pm * 256) + wr * 64 + fr, col0 = u.pn * 256 + wc * 32 + 4 * fq;
#pragma unroll
        for (int ai = 0; ai < 2; ++ai)
#pragma unroll
            for (int m = 0; m < 4; ++m) {
                const size_t ro = (size_t)(row0 + ai * 128 + m * 16) * DM + col0;
#pragma unroll
                for (int bj = 0; bj < 2; ++bj)
#pragma unroll
                    for (int n = 0; n < 2; ++n) { const pg8::f32x4 v = *(const pg8::f32x4*)(rb + ro + bj * 128 + n * 16) + acc[ai][bj][m][n]; *(pg8::f32x4*)(ob + ro + bj * 128 + n * 16) = v; }
            }
    }
};
struct EpiRelu2 {
    static constexpr bool PERM = true, AFTER_DRAIN = false;
    unsigned char* act;
    __device__ __forceinline__ void operator()(const pg8::f32x4 (&acc)[2][2][4][2], const pg8::Unit& u, int wr, int wc, int fr, int fq) const {
        const int rbase = u.pm * 256 + wr * 64 + fr, col0 = u.pn * 256 + wc * 32 + 8 * fq;
#pragma unroll
        for (int ai = 0; ai < 2; ++ai)
#pragma unroll
            for (int m = 0; m < 4; ++m) {
                const int row = rbase + ai * 128 + m * 16;
#pragma unroll
                for (int bj = 0; bj < 2; ++bj) {
                    pg8::f32x4 v0 = acc[ai][bj][m][0], v1 = acc[ai][bj][m][1];
#pragma unroll
                    for (int i = 0; i < 4; ++i) { const float a = fmaxf(v0[i], 0.f), b = fmaxf(v1[i], 0.f); v0[i] = a * a; v1[i] = b * b; }
                    *(u32x4*)(act + ((size_t)row * DFF + col0 + bj * 128) * 2) = pack8(v0, v1, false);
                }
            }
    }
};

struct WTile { const float* src; _Float16* dst; int ld, K, k0, n0, mapped; };
constexpr int WT_PER_LAYER = 16 * 64 + 16 * 16 + 16 * 64 + 64 * 16, WT_TOTAL = DEPTH * WT_PER_LAYER;
__device__ __forceinline__ WTile wt_desc(const Frame& F, int t) {
    WTile d; const int l = t / WT_PER_LAYER; int r = t - l * WT_PER_LAYER;
    unsigned char* wl = F.ws + WS_W + (size_t)l * W_LAYER;
    if (r < 1024)      { d.src = F.w_in + (size_t)l * DM * INCOLS; d.dst = (_Float16*)(wl + W_IN_OFF);  d.ld = INCOLS; d.K = DM;  d.mapped = 1; d.k0 = (r & 15) * 64; d.n0 = (r >> 4) * 64; }
    else if (r < 1280) { r -= 1024; d.src = F.w_out + (size_t)l * DM * DM;  d.dst = (_Float16*)(wl + W_OUT_OFF); d.ld = DM;  d.K = DM;  d.mapped = 0; d.k0 = (r & 15) * 64; d.n0 = (r >> 4) * 64; }
    else if (r < 2304) { r -= 1280; d.src = F.w_ff1 + (size_t)l * DM * DFF; d.dst = (_Float16*)(wl + W_FF1_OFF); d.ld = DFF; d.K = DM;  d.mapped = 0; d.k0 = (r & 15) * 64; d.n0 = (r >> 4) * 64; }
    else               { r -= 2304; d.src = F.w_ff2 + (size_t)l * DFF * DM; d.dst = (_Float16*)(wl + W_FF2_OFF); d.ld = DM;  d.K = DFF; d.mapped = 0; d.k0 = (r & 63) * 64; d.n0 = (r >> 6) * 64; }
    return d;
}
__device__ __forceinline__ void wt_load(const WTile& d, int tid, f32x4& v0, f32x4& v1) {
    const int kk = tid >> 4, n4 = (tid & 15) * 4; const int sc = d.mapped ? incol_map(d.n0 + n4) : d.n0 + n4;
    v0 = (f32x4){0.f, 0.f, 0.f, 0.f}; v1 = v0;
    if (sc >= 0) { v0 = *(const f32x4*)(d.src + (size_t)(d.k0 + kk) * d.ld + sc); v1 = *(const f32x4*)(d.src + (size_t)(d.k0 + kk + 32) * d.ld + sc); }
}
__device__ __forceinline__ void wtrans_all(const Frame& F) {
    LAS float* tile = (LAS float*)(F.lds + LDS_GEN); const int tid = F.tid;
    int t = F.bid; if (t >= WT_TOTAL) return;
    WTile d = wt_desc(F, t); f32x4 v0, v1; wt_load(d, tid, v0, v1);
#pragma unroll 1
    for (;;) {
        const int tn = t + F.G; WTile dn = d; f32x4 n0 = v0, n1 = v1;
        if (tn < WT_TOTAL) { dn = wt_desc(F, tn); wt_load(dn, tid, n0, n1); }
        { const int kk = tid >> 4, n4 = (tid & 15) * 4;
#pragma unroll
          for (int e = 0; e < 4; ++e) { tile[kk * 65 + n4 + e] = v0[e]; tile[(kk + 32) * 65 + n4 + e] = v1[e]; } }
        __syncthreads();
        { const int nn = tid >> 3, k8 = (tid & 7) * 8; h8 o;
#pragma unroll
          for (int e = 0; e < 8; ++e) o[e] = (_Float16)tile[(k8 + e) * 65 + nn];
          *(h8*)(d.dst + (size_t)(d.n0 + nn) * d.K + d.k0 + k8) = o; }
        __syncthreads();
        if (tn >= WT_TOTAL) break;
        t = tn; d = dn; v0 = n0; v1 = n1;
    }
}
template <int MODE> __device__ __forceinline__ void norm_to_abuf(const Frame& F, const float* gain) {
    _Float16* abuf = (_Float16*)(F.ws + WS_ABUF); const float* hmeta = (const float*)(F.ws + WS_HMETA);
    const int nw = F.G * 8;
    for (int r = F.bid * 8 + F.wave; r < MP; r += nw) {
        _Float16* dst = abuf + (size_t)r * DM;
        if (r >= MV) { const h4 z = {(_Float16)0.f, (_Float16)0.f, (_Float16)0.f, (_Float16)0.f};
#pragma unroll
            for (int j = 0; j < 4; ++j) *(h4*)(dst + j * 256 + F.lane * 4) = z; continue; }
        const float* src = MODE == 0 ? (r < MR ? F.x + (size_t)r * DM : F.meta + (size_t)((r - MR) & 15) * DM) : (r < MR ? F.out + (size_t)r * DM : hmeta + (size_t)(r - MR) * DM);
        f32x4 v[4]; float ss = 0.f;
#pragma unroll
        for (int j = 0; j < 4; ++j) { v[j] = *(const f32x4*)(src + j * 256 + F.lane * 4); ss += (v[j][0] * v[j][0] + v[j][1] * v[j][1]) + (v[j][2] * v[j][2] + v[j][3] * v[j][3]); }
        ss = wave_sum(ss, F.lane); const float rstd = rsqrtf(ss * (1.0f / DM) + 1e-6f);
#pragma unroll
        for (int j = 0; j < 4; ++j) { const f32x4 g = *(const f32x4*)(gain + j * 256 + F.lane * 4); h4 o;
#pragma unroll
            for (int e = 0; e < 4; ++e) o[e] = (_Float16)(v[j][e] * rstd * g[e]);
            *(h4*)(dst + j * 256 + F.lane * 4) = o; }
    }
}
__device__ __forceinline__ void final_norm(const Frame& F) {
    const int nw = F.G * 8;
    for (int r = F.bid * 8 + F.wave; r < MR; r += nw) {
        float* p = F.out + (size_t)r * DM; f32x4 v[4]; float ss = 0.f;
#pragma unroll
        for (int j = 0; j < 4; ++j) { v[j] = *(const f32x4*)(p + j * 256 + F.lane * 4); ss += (v[j][0] * v[j][0] + v[j][1] * v[j][1]) + (v[j][2] * v[j][2] + v[j][3] * v[j][3]); }
        ss = wave_sum(ss, F.lane); const float rstd = rsqrtf(ss * (1.0f / DM) + 1e-6f);
#pragma unroll
        for (int j = 0; j < 4; ++j) { const f32x4 g = *(const f32x4*)(F.final_norm + j * 256 + F.lane * 4); *(f32x4*)(p + j * 256 + F.lane * 4) = v[j] * rstd * g; }
    }
}
__device__ __forceinline__ void prologue(const Frame& F) {
    const int gtid = F.bid * NTHREADS + F.tid, gsz = F.G * NTHREADS;
    float* hmeta = (float*)(F.ws + WS_HMETA);
    for (int i = gtid; i < 256 * DM / 4; i += gsz) { const int row = i / (DM / 4), c4 = i % (DM / 4); f32x4 v = {0.f, 0.f, 0.f, 0.f}; if (row < NB * NMETA) v = *(const f32x4*)(F.meta + (size_t)(row & 15) * DM + c4 * 4); *(f32x4*)(hmeta + (size_t)row * DM + c4 * 4) = v; }
    f32x2* rope = (f32x2*)(F.ws + WS_ROPE);
    for (int i = gtid; i < TLEN * 32; i += gsz) { const int t = i >> 5, d = i & 31; const double rev = (double)t * ROPE_REV[d]; const float fr = (float)(rev - __builtin_floor(rev)); f32x2 cs; cs.x = __builtin_amdgcn_cosf(fr); cs.y = __builtin_amdgcn_sinf(fr); rope[i] = cs; }
    wtrans_all(F);
    norm_to_abuf<0>(F, F.norm_mix);
}
__device__ __forceinline__ void zero_abuf(const Frame& F) {
    u32x4* p = (u32x4*)(F.ws + WS_ABUF); const u32x4 z = {0u, 0u, 0u, 0u};
    for (size_t i = (size_t)F.bid * NTHREADS + F.tid; i < (size_t)MP * DM * 2 / 16; i += (size_t)F.G * NTHREADS) p[i] = z;
}

typedef short bf16x8v __attribute__((ext_vector_type(8)));
__constant__ unsigned char BUCKET_LUT[128] = {0, 1, 2, 3, 4, 5, 6, 7, 8, 9, 10, 11, 12, 13, 14, 15, 16, 16, 16, 17, 17, 18, 18, 18, 19, 19, 19, 20, 20, 20, 20, 21, 21, 21, 21, 22, 22, 22, 22, 22, 23, 23, 23, 23, 23, 23, 24, 24, 24, 24, 24, 24, 25, 25, 25, 25, 25, 25, 25, 26, 26, 26, 26, 26, 26, 26, 26, 27, 27, 27, 27, 27, 27, 27, 27, 27, 27, 28, 28, 28, 28, 28, 28, 28, 28, 28, 28, 29, 29, 29, 29, 29, 29, 29, 29, 29, 29, 29, 29, 30, 30, 30, 30, 30, 30, 30, 30, 30, 30, 30, 30, 30, 30, 31, 31, 31, 31, 31, 31, 31, 31, 31, 31, 31, 31, 31, 31, 31};
__device__ __forceinline__ int crow(int i, int h) { return (i & 3) + 8 * (i >> 2) + 4 * h; }
__device__ __forceinline__ bf16x8v pack_p(const f32x16& x, int s) {
    u32x4 p; p.x = cvt_pk_bf16(x[8 * s + 0], x[8 * s + 1]); p.y = cvt_pk_bf16(x[8 * s + 2], x[8 * s + 3]); p.z = cvt_pk_bf16(x[8 * s + 4], x[8 * s + 5]); p.w = cvt_pk_bf16(x[8 * s + 6], x[8 * s + 7]);
    return __builtin_bit_cast(bf16x8v, p);
}
__device__ __forceinline__ bf16x8v vt_frag(LAS unsigned char* vimg, int dblk, int keybase, int s, int lane) {
    const int h = lane >> 5, blk = (lane >> 4) & 1, i16 = lane & 15, q = i16 >> 2, p = i16 & 3;
    LAS unsigned char* a = vimg + dblk * 4096 + (keybase + 16 * s + 4 * h + q) * 64 + (16 * blk + 4 * p) * 2;
    const s16x4 lo = __builtin_amdgcn_ds_read_tr16_b64_v4i16((LAS s16x4*)a);
    const s16x4 hi = __builtin_amdgcn_ds_read_tr16_b64_v4i16((LAS s16x4*)(a + 8 * 64));
    return __builtin_shufflevector(lo, hi, 0, 1, 2, 3, 4, 5, 6, 7);
}

constexpr int KS_PITCH = 144;
constexpr int B_KS = 0, B_VS = 2 * 64 * KS_PITCH, B_LUT = B_VS + 2 * 8192, B_END = B_LUT + 512;
__device__ __forceinline__ void mixB_unit(const Frame& F, int l, int b, int hh, int qblk, float lam, float oscale) {
    LAS unsigned char* L = F.lds + LDS_GEN;
    const int tid = F.tid, lane = F.lane, wave = F.wave, r = lane & 31, h = lane >> 5;
    const unsigned char* proj = F.ws + WS_PROJ;
    const _Float16* QB = (const _Float16*)(proj + PJ_QB); const unsigned char* KB = proj + PJ_KB; const unsigned char* VB = proj + PJ_VB;
    const unsigned* kmax = (const unsigned*)(F.ws + WS_CTL) + CW_KMAX + 32 * l + 16;
    const bool meta_u = qblk < 0;
    const int qrow0 = meta_u ? MR + b * NMETA : b * SEQ + qblk * 256;
    const int qpos0 = meta_u ? 0 : NMETA + qblk * 256;
    const int nreal = meta_u ? 0 : 4 * qblk + 4;
    const int wq0 = 32 * wave;
    const bool wave_on = meta_u ? (wave == 0) : true;
    const int my_row = wave_on ? qrow0 + wq0 + r : qrow0, my_pos = qpos0 + wq0 + r;
    __syncthreads();
    if (tid < 128) ((LAS float*)(L + B_LUT))[tid] = F.rel_bias[BUCKET_LUT[tid] * 12 + 8 + hh] * LOG2E;
    float bmax = (lane < 32) ? F.rel_bias[lane * 12 + 8 + hh] * LOG2E : -1e30f;
    bmax = fmaxf(bmax, sx<16>(bmax, lane)); bmax = fmaxf(bmax, sx<8>(bmax, lane)); bmax = fmaxf(bmax, sx<4>(bmax, lane)); bmax = fmaxf(bmax, sx<2>(bmax, lane)); bmax = fmaxf(bmax, sx<1>(bmax, lane));
    bmax = bcast0(bmax);
    const float bfar = F.rel_bias[31 * 12 + 8 + hh] * LOG2E;
    h8 qf[2][2]; float mref[2]; bool safe = true;
#pragma unroll
    for (int c = 0; c < 2; ++c) {
        float n2 = 0.f;
#pragma unroll
        for (int s = 0; s < 2; ++s) { qf[c][s] = *(const h8*)(QB + (size_t)my_row * 256 + hh * 64 + c * 32 + 16 * s + 8 * h);
#pragma unroll
            for (int j = 0; j < 8; ++j) { const float v = (float)qf[c][s][j]; n2 += v * v; } }
        n2 = hsum32(n2, lane);
        mref[c] = sqrtf(n2 * __uint_as_float(kmax[hh * 2 + c])) * 1.002f + bmax;
        safe = safe && (mref[c] - bfar < 60.0f);
    }
    safe = __all(safe);
    if (safe) { mref[0] = bfar; mref[1] = bfar; }
    f32x16 O[2][2]; float lsum[2] = {0.f, 0.f};
#pragma unroll
    for (int c = 0; c < 2; ++c)
#pragma unroll
        for (int d = 0; d < 2; ++d)
#pragma unroll
            for (int i = 0; i < 16; ++i) O[c][d][i] = 0.f;
    const int skey = tid >> 3, sch = tid & 7;
    const unsigned kdst = skey * KS_PITCH + sch * 16, vdst = (sch >> 2) * 4096 + skey * 64 + (sch & 3) * 16;
    const int ntiles = 1 + nreal;
    auto tile_row0 = [&](int t) -> int { return t == 0 ? MR + b * NMETA : b * SEQ + (t - 1) * 64; };
    u32x4 kreg, vreg;
    { const size_t rr = (size_t)(tile_row0(0) + skey); kreg = *(const u32x4*)(KB + rr * 512 + hh * 128 + sch * 16); vreg = *(const u32x4*)(VB + rr * 512 + hh * 128 + sch * 16); }
    *(LAS u32x4*)(L + B_KS + kdst) = kreg; *(LAS u32x4*)(L + B_VS + vdst) = vreg;
    __syncthreads();
    const int wpos0 = qpos0 + wq0;
#pragma unroll 1
    for (int t = 0; t < ntiles; ++t) {
        const int buf = t & 1;
        if (t + 1 < ntiles) { const size_t rr = (size_t)(tile_row0(t + 1) + skey); kreg = *(const u32x4*)(KB + rr * 512 + hh * 128 + sch * 16); vreg = *(const u32x4*)(VB + rr * 512 + hh * 128 + sch * 16); }
        const int kpos0 = (t == 0) ? 0 : NMETA + (t - 1) * 64, nvalid = (t == 0) ? NMETA : 64;
        if (wave_on && kpos0 <= wpos0 + 31) {
            LAS unsigned char* Kb = L + B_KS + buf * (64 * KS_PITCH); LAS unsigned char* Vb = L + B_VS + buf * 8192;
            const bool slow = !safe || (t == 0) || (kpos0 + 63 > wpos0 - 128);
#pragma unroll
            for (int sub = 0; sub < 2; ++sub) {
                if (sub * 32 >= nvalid || kpos0 + sub * 32 > wpos0 + 31) continue;
                h8 kfr[2][2]; bf16x8v vfr[2][2];
#pragma unroll
                for (int c = 0; c < 2; ++c)
#pragma unroll
                    for (int s = 0; s < 2; ++s) kfr[c][s] = *(const LAS h8*)(Kb + (sub * 32 + r) * KS_PITCH + (c * 32 + 16 * s + 8 * h) * 2);
#pragma unroll
                for (int d = 0; d < 2; ++d)
#pragma unroll
                    for (int s = 0; s < 2; ++s) vfr[d][s] = vt_frag(Vb, d, sub * 32, s, lane);
                __builtin_amdgcn_sched_barrier(0);
                f32x16 S[2];
#pragma unroll
                for (int c = 0; c < 2; ++c) {
#pragma unroll
                    for (int i = 0; i < 16; ++i) S[c][i] = 0.f;
#pragma unroll
                    for (int s = 0; s < 2; ++s) S[c] = __builtin_amdgcn_mfma_f32_32x32x16_f16(kfr[c][s], qf[c][s], S[c], 0, 0, 0);
                }
                if (slow) {
#pragma unroll
                    for (int i = 0; i < 16; ++i) {
                        const int kidx = sub * 32 + crow(i, h), dist = my_pos - (kpos0 + kidx);
                        const bool ok = dist >= 0 && kidx < nvalid;
                        const float bias = ((const LAS float*)(L + B_LUT))[min(max(dist, 0), 127)];
#pragma unroll
                        for (int c = 0; c < 2; ++c) S[c][i] = ok ? __builtin_amdgcn_exp2f(S[c][i] + (bias - mref[c])) : 0.f;
                    }
                } else {
#pragma unroll
                    for (int c = 0; c < 2; ++c)
#pragma unroll
                        for (int i = 0; i < 16; ++i) S[c][i] = __builtin_amdgcn_exp2f(S[c][i]);
                }
#pragma unroll
                for (int c = 0; c < 2; ++c) {
                    const float a0 = (S[c][0] + S[c][1]) + (S[c][2] + S[c][3]), a1 = (S[c][4] + S[c][5]) + (S[c][6] + S[c][7]);
                    const float a2 = (S[c][8] + S[c][9]) + (S[c][10] + S[c][11]), a3 = (S[c][12] + S[c][13]) + (S[c][14] + S[c][15]);
                    lsum[c] += (a0 + a1) + (a2 + a3); }
                bf16x8v pf[2][2];
#pragma unroll
                for (int c = 0; c < 2; ++c) { pf[c][0] = pack_p(S[c], 0); pf[c][1] = pack_p(S[c], 1); }
#pragma unroll
                for (int d = 0; d < 2; ++d)
#pragma unroll
                    for (int s = 0; s < 2; ++s) {
#pragma unroll
                        for (int c = 0; c < 2; ++c) O[c][d] = __builtin_amdgcn_mfma_f32_32x32x16_bf16(vfr[d][s], pf[c][s], O[c][d], 0, 0, 0); }
            }
        }
        if (t + 1 < ntiles) { *(LAS u32x4*)(L + B_KS + (buf ^ 1) * (64 * KS_PITCH) + kdst) = kreg; *(LAS u32x4*)(L + B_VS + (buf ^ 1) * 8192 + vdst) = vreg; }
        __syncthreads();
    }
    if (wave_on) {
        const float l0 = hsum32(lsum[0], lane), l1 = hsum32(lsum[1], lane);
        const float i0 = 1.0f / l0, i1 = lam / l1;
        float o[2][16], ss = 0.f;
#pragma unroll
        for (int d = 0; d < 2; ++d)
#pragma unroll
            for (int i = 0; i < 16; ++i) { o[d][i] = O[0][d][i] * i0 - O[1][d][i] * i1; ss += o[d][i] * o[d][i]; }
        ss = hsum32(ss, lane);
        const float rstd = rsqrtf(ss * (1.0f / 64.0f) + 1e-6f) * oscale;
        const float* gn = F.diff_norm + l * 64;
        if (!meta_u || r < NMETA) {
            _Float16* dst = (_Float16*)(F.ws + WS_ABUF) + (size_t)my_row * DM + 512 + hh * 64;
#pragma unroll
            for (int d = 0; d < 2; ++d)
#pragma unroll
                for (int g4 = 0; g4 < 4; ++g4) { const int d0 = 32 * d + 8 * g4 + 4 * h; const f32x4 gv = *(const f32x4*)(gn + d0);
                    u32x2 w; w.x = cvt_pk_f16(o[d][4 * g4 + 0] * rstd * gv[0], o[d][4 * g4 + 1] * rstd * gv[1]); w.y = cvt_pk_f16(o[d][4 * g4 + 2] * rstd * gv[2], o[d][4 * g4 + 3] * rstd * gv[3]);
                    *(u32x2*)(dst + d0) = w; }
        }
    }
}
__device__ __forceinline__ void mixB_phase(const Frame& F, int l) {
    const float* lp = F.diff_lambda + l * 128;
    float a = (F.lane < 32) ? lp[F.lane] * lp[32 + F.lane] : 0.f, c = (F.lane < 32) ? lp[64 + F.lane] * lp[96 + F.lane] : 0.f;
    a = wave_sum(a, F.lane); c = wave_sum(c, F.lane);
    const float linit = 0.8f - 0.6f * expf(-0.3f * (float)l);
    const float lam = expf(a) - expf(c) + linit, oscale = 1.0f - linit;
#pragma unroll 1
    for (int cidx = F.bid; cidx < 256; cidx += F.G) { const int bh = cidx & 7, i = cidx >> 3;
#pragma unroll 1
        for (int k = 0; k < 3; ++k) { if (k == 2 && cidx >= 8) break; mixB_unit(F, l, bh >> 2, bh & 3, k == 0 ? 63 - i : (k == 1 ? i : -1), lam, oscale); }
    }
}
__device__ __forceinline__ h8 tr_frag_nat(LAS unsigned char* img_blk, int rowbase, int s, int lane) {
    const int h = lane >> 5, blk = (lane >> 4) & 1, i16 = lane & 15, q = i16 >> 2, p = i16 & 3;
    LAS unsigned char* a = img_blk + (rowbase + 16 * s + 8 * h + q) * 64 + (16 * blk + 4 * p) * 2;
    const s16x4 lo = __builtin_amdgcn_ds_read_tr16_b64_v4i16((LAS s16x4*)a);
    const s16x4 hi = __builtin_amdgcn_ds_read_tr16_b64_v4i16((LAS s16x4*)(a + 4 * 64));
    return __builtin_bit_cast(h8, __builtin_shufflevector(lo, hi, 0, 1, 2, 3, 4, 5, 6, 7));
}
__device__ __forceinline__ h8 tr_frag_krow(LAS unsigned char* img_blk, int rowbase, int s, int lane) {
    const int h = lane >> 5, blk = (lane >> 4) & 1, i16 = lane & 15, q = i16 >> 2, p = i16 & 3;
    LAS unsigned char* a = img_blk + (rowbase + 16 * s + 4 * h + q) * 64 + (16 * blk + 4 * p) * 2;
    const s16x4 lo = __builtin_amdgcn_ds_read_tr16_b64_v4i16((LAS s16x4*)a);
    const s16x4 hi = __builtin_amdgcn_ds_read_tr16_b64_v4i16((LAS s16x4*)(a + 8 * 64));
    return __builtin_bit_cast(h8, __builtin_shufflevector(lo, hi, 0, 1, 2, 3, 4, 5, 6, 7));
}
__device__ __forceinline__ float ret_log2gamma(int hc) { return log2f(1.0f - exp2f(-5.0f - (float)hc)); }
__device__ __forceinline__ h8 scale_h8(const h8& v, float sc) { h8 o;
#pragma unroll
    for (int e = 0; e < 8; ++e) o[e] = (_Float16)((float)v[e] * sc);
    return o; }

__device__ __forceinline__ void mixC1_unit(const Frame& F, int b, int hp, int c) {
    LAS unsigned char* L = F.lds + LDS_GEN;
    const int tid = F.tid, lane = F.lane, wave = F.wave;
    const unsigned char* proj = F.ws + WS_PROJ;
    const int row0 = c == 0 ? MR + b * NMETA : b * SEQ + 128 * (c - 1), Lc = c == 0 ? NMETA : 128;
    __syncthreads();
#pragma unroll 1
    for (int idx = tid; idx < 4096; idx += NTHREADS) {
        const int head = idx >> 11, arr = (idx >> 10) & 1, j = (idx >> 3) & 127, ch = idx & 7, hc = 2 * hp + head;
        h8 v;
#pragma unroll
        for (int e = 0; e < 8; ++e) v[e] = (_Float16)0.f;
        if (j < Lc) { v = *(const h8*)(proj + (arr ? PJ_VC : PJ_KC) + (size_t)(row0 + j) * 512 + hc * 128 + ch * 16);
            if (arr) v = scale_h8(v, exp2f((float)(Lc - 1 - j) * ret_log2gamma(hc))); }
        *(LAS h8*)(L + head * 32768 + arr * 16384 + (ch >> 2) * 8192 + j * 64 + (ch & 3) * 16) = v;
    }
    __syncthreads();
    const int head = wave >> 2, mb = (wave >> 1) & 1, nb = wave & 1, r = lane & 31, h = lane >> 5;
    f32x16 acc;
#pragma unroll
    for (int i = 0; i < 16; ++i) acc[i] = 0.f;
#pragma unroll
    for (int s = 0; s < 8; ++s) { const h8 a = tr_frag_nat(L + head * 32768 + mb * 8192, 0, s, lane), bb = tr_frag_nat(L + head * 32768 + 16384 + nb * 8192, 0, s, lane);
        acc = __builtin_amdgcn_mfma_f32_32x32x16_f16(a, bb, acc, 0, 0, 0); }
    float* U = (float*)(F.ws + WS_U) + ((size_t)((b * 4 + 2 * hp + head) * 129 + c)) * 4096;
#pragma unroll
    for (int i = 0; i < 16; ++i) U[(32 * mb + crow(i, h)) * 64 + 32 * nb + r] = acc[i];
}
__device__ __forceinline__ void mixC1_phase(const Frame& F) {
#pragma unroll 1
    for (int u = F.bid; u < NB * 2 * 129; u += F.G) { const int c = u % 129, bh = u / 129; mixC1_unit(F, bh >> 1, bh & 1, c); }
}
__device__ __forceinline__ void mixC_scan(const Frame& F) {
    if (F.tid >= 128) return;
    const int e = F.bid * 128 + F.tid;
    if (e >= NB * 4 * 4096) return;
    const int bh = e >> 12, el = e & 4095, hc = bh & 3;
    const float lg = ret_log2gamma(hc), g128 = exp2f(128.f * lg), g16 = exp2f(16.f * lg);
    const float* U = (const float*)(F.ws + WS_U) + (size_t)bh * 129 * 4096 + el; float* S = (float*)(F.ws + WS_S) + (size_t)bh * 129 * 4096 + el;
    float st = U[0];
    S[4096] = st;
#pragma unroll 1
    for (int c0 = 1; c0 < 128; c0 += 16) {
        float u[16];
#pragma unroll
        for (int k = 0; k < 16; ++k) u[k] = (c0 + k < 128) ? U[(size_t)(c0 + k) * 4096] : 0.f;
#pragma unroll
        for (int k = 0; k < 16; ++k) if (c0 + k < 128) { st = st * g128 + u[k]; S[(size_t)(c0 + k + 1) * 4096] = st; }
    }
    (void)g16;
}
constexpr int C2_KI = 0, C2_VI = 128 * KS_PITCH, C2_ST = C2_VI + 16384, C2_HEAD = C2_ST + 64 * KS_PITCH;
__device__ __forceinline__ void mixC2_unit(const Frame& F, int l, int b, int hp, int c) {
    LAS unsigned char* L = F.lds + LDS_GEN;
    const int tid = F.tid, lane = F.lane, wave = F.wave, r = lane & 31, h = lane >> 5;
    const unsigned char* proj = F.ws + WS_PROJ;
    const int row0 = c == 0 ? MR + b * NMETA : b * SEQ + 128 * (c - 1), Lc = c == 0 ? NMETA : 128;
    __syncthreads();
#pragma unroll 1
    for (int idx = tid; idx < 4096; idx += NTHREADS) {
        const int head = idx >> 11, arr = (idx >> 10) & 1, j = (idx >> 3) & 127, ch = idx & 7, hc = 2 * hp + head;
        h8 v;
#pragma unroll
        for (int e = 0; e < 8; ++e) v[e] = (_Float16)0.f;
        if (j < Lc) v = *(const h8*)(proj + (arr ? PJ_VC : PJ_KC) + (size_t)(row0 + j) * 512 + hc * 128 + ch * 16);
        if (arr) *(LAS h8*)(L + head * C2_HEAD + C2_VI + (ch >> 2) * 8192 + j * 64 + (ch & 3) * 16) = v;
        else     *(LAS h8*)(L + head * C2_HEAD + C2_KI + j * KS_PITCH + ch * 16) = v;
    }
    if (c > 0) {
#pragma unroll 1
        for (int idx = tid; idx < 2 * 4096; idx += NTHREADS) { const int head = idx >> 12, el = idx & 4095, dk = el >> 6, dv = el & 63;
            const float v = ((const float*)(F.ws + WS_S))[((size_t)((b * 4 + 2 * hp + head) * 129 + c)) * 4096 + el];
            *(LAS _Float16*)(L + head * C2_HEAD + C2_ST + dv * KS_PITCH + dk * 2) = (_Float16)v; }
    }
    __syncthreads();
    const int head = wave >> 2, wq = wave & 3, hc = 2 * hp + head;
    if (wq * 32 < Lc) {
        LAS unsigned char* Hb = L + head * C2_HEAD;
        const int qi = wq * 32 + r, my_row = row0 + qi;
        const float lg = ret_log2gamma(hc);
        h8 qf[4];
#pragma unroll
        for (int s = 0; s < 4; ++s) qf[s] = *(const h8*)(proj + PJ_QC + (size_t)my_row * 512 + hc * 128 + (16 * s + 8 * h) * 2);
        f32x16 O[2];
#pragma unroll
        for (int d = 0; d < 2; ++d)
#pragma unroll
            for (int i = 0; i < 16; ++i) O[d][i] = 0.f;
        if (c > 0) {
#pragma unroll
            for (int d = 0; d < 2; ++d)
#pragma unroll
                for (int s = 0; s < 4; ++s) { const h8 a = *(const LAS h8*)(Hb + C2_ST + (32 * d + r) * KS_PITCH + (16 * s + 8 * h) * 2);
                    O[d] = __builtin_amdgcn_mfma_f32_32x32x16_f16(a, qf[s], O[d], 0, 0, 0); }
            const float qd = exp2f((float)(qi + 1) * lg);
#pragma unroll
            for (int d = 0; d < 2; ++d)
#pragma unroll
                for (int i = 0; i < 16; ++i) O[d][i] *= qd;
        }
#pragma unroll 1
        for (int jb = 0; jb <= wq; ++jb) {
            f32x16 S;
#pragma unroll
            for (int i = 0; i < 16; ++i) S[i] = 0.f;
#pragma unroll
            for (int s = 0; s < 4; ++s) { const h8 kf = *(const LAS h8*)(Hb + C2_KI + (32 * jb + r) * KS_PITCH + (16 * s + 8 * h) * 2);
                S = __builtin_amdgcn_mfma_f32_32x32x16_f16(kf, qf[s], S, 0, 0, 0); }
#pragma unroll
            for (int i = 0; i < 16; ++i) { const int dd = qi - (32 * jb + crow(i, h)); S[i] = dd >= 0 ? S[i] * exp2f((float)dd * lg) : 0.f; }
            h8 pf[2];
#pragma unroll
            for (int s = 0; s < 2; ++s) { u32x4 p; p.x = cvt_pk_f16(S[8 * s + 0], S[8 * s + 1]); p.y = cvt_pk_f16(S[8 * s + 2], S[8 * s + 3]); p.z = cvt_pk_f16(S[8 * s + 4], S[8 * s + 5]); p.w = cvt_pk_f16(S[8 * s + 6], S[8 * s + 7]); pf[s] = __builtin_bit_cast(h8, p); }
#pragma unroll
            for (int d = 0; d < 2; ++d)
#pragma unroll
                for (int s = 0; s < 2; ++s) { const h8 vf = tr_frag_krow(Hb + C2_VI + d * 8192, 32 * jb, s, lane);
                    O[d] = __builtin_amdgcn_mfma_f32_32x32x16_f16(vf, pf[s], O[d], 0, 0, 0); }
        }
        float ss = 0.f;
#pragma unroll
        for (int d = 0; d < 2; ++d)
#pragma unroll
            for (int i = 0; i < 16; ++i) ss += O[d][i] * O[d][i];
        ss = hsum32(ss, lane);
        const float rstd = rsqrtf(ss * (1.0f / 64.0f) + 1e-6f);
        if (qi < Lc) {
            const float* gn = F.ret_norm + l * 256 + hc * 64;
            const _Float16* gc = (const _Float16*)(proj + PJ_GC) + (size_t)my_row * 256 + hc * 64;
            _Float16* dst = (_Float16*)(F.ws + WS_ABUF) + (size_t)my_row * DM + 768 + hc * 64;
#pragma unroll
            for (int d = 0; d < 2; ++d)
#pragma unroll
                for (int g4 = 0; g4 < 4; ++g4) { const int d0 = 32 * d + 8 * g4 + 4 * h; const f32x4 gv = *(const f32x4*)(gn + d0); const h4 gg = *(const h4*)(gc + d0);
                    float o[4];
#pragma unroll
                    for (int e = 0; e < 4; ++e) { const float g = (float)gg[e]; o[e] = O[d][4 * g4 + e] * rstd * gv[e] * (g / (1.0f + __expf(-g))); }
                    u32x2 w; w.x = cvt_pk_f16(o[0], o[1]); w.y = cvt_pk_f16(o[2], o[3]); *(u32x2*)(dst + d0) = w; }
        }
    }
}
__device__ __forceinline__ void mixC2_phase(const Frame& F, int l) {
#pragma unroll 1
    for (int u = F.bid; u < NB * 2 * 129; u += F.G) { const int c = u % 129, bh = u / 129; mixC2_unit(F, l, bh >> 1, bh & 1, c); }
}
constexpr int IDX_HIST = 0, IDX_STATS = 16512, IDX_INFO = 18816, IDX_CCNT = 19072, IDX_MASK = 19456, IDX_CAND = 85248, IDX_Q = IDX_CAND + 32 * 128 * 8, IDX_QPITCH = 1168, IDX_END = IDX_Q + 32 * IDX_QPITCH;
#ifndef PROBE_REP
#define PROBE_REP 0
#endif
constexpr int IDX_CAP = 128, IDX_NBIN = 128;
static_assert(IDX_END + LDS_GEN <= LDS_BYTES, "indexer LDS");
struct KFrag { h8 v[4]; };
__device__ __forceinline__ KFrag idx_load_k(const unsigned char* krow_ptr, int h) { KFrag k;
#pragma unroll
    for (int s = 0; s < 4; ++s) k.v[s] = *(const h8*)(krow_ptr + (16 * s + 8 * h) * 2);
    return k; }
#define IDX_LOADQ(dst, hd) do { _Pragma("unroll") for (int s_ = 0; s_ < 4; ++s_) dst[s_] = *(const LAS h8*)(qimg_lane + ((hd) * 64 + 16 * s_) * 2); } while (0)
#define IDX_MFMA4(acc, q) do { _Pragma("unroll") for (int s_ = 0; s_ < 4; ++s_) acc = __builtin_amdgcn_mfma_f32_32x32x16_f16(kf.v[s_], q[s_], acc, 0, 0, 0); } while (0)
#define IDX_FMA(hd, S) do { _Pragma("unroll") for (int i_ = 0; i_ < 16; ++i_) sc[i_] = __builtin_fmaf(w[hd], __builtin_fabsf(S[i_]), sc[i_]); } while (0)
#define IDX_SB __builtin_amdgcn_sched_barrier(0)
__device__ __forceinline__ void idx_scores(const LAS unsigned char* qimg_lane, const float (&w)[8], const KFrag& kf, f32x16& sc) {
    h8 q[2][4]; f32x16 S[2];
    IDX_LOADQ(q[0], 8); IDX_SB;
#pragma unroll
    for (int i = 0; i < 16; ++i) sc[i] = 0.f;
    IDX_MFMA4(sc, q[0]); IDX_LOADQ(q[1], 0); IDX_SB;
#pragma unroll
    for (int hd = 0; hd < 8; ++hd) {
#pragma unroll
        for (int i = 0; i < 16; ++i) S[hd & 1][i] = 0.f;
        IDX_MFMA4(S[hd & 1], q[(hd + 1) & 1]);
        if (hd < 7) IDX_LOADQ(q[hd & 1], hd + 1);
        if (hd > 0) IDX_FMA(hd - 1, S[(hd - 1) & 1]);
        IDX_SB;
    }
    IDX_FMA(7, S[1]);
}
__device__ __forceinline__ int suffix_sum(int v, int lane) {
#pragma unroll
    for (int off = 1; off < 64; off <<= 1) { const int t = __builtin_amdgcn_ds_bpermute((lane + off) << 2, v); if (lane + off < 64) v += t; }
    return v;
}
__device__ __forceinline__ void mixA_index_unit(const Frame& F, int b, int g) {
    LAS unsigned char* L = F.lds + LDS_GEN;
    int tid_ = F.tid; asm volatile("" : "+v"(tid_));
    const int tid = tid_, lane = F.lane, wave = F.wave, r = lane & 31, h = lane >> 5;
    const unsigned char* proj = F.ws + WS_PROJ;
    const unsigned char* KI = proj + PJ_KI;
    const int nq = g == 0 ? NMETA : 32;
    const int qrow = g == 0 ? MR + b * NMETA + (r & 15) : b * SEQ + 32 * (g - 1) + r;
    const int tq0 = g == 0 ? 0 : NMETA + 32 * (g - 1);
    const bool qvalid = r < nq;
    auto ks_row0 = [&](int ks) -> int { return ks == 0 ? MR + b * NMETA : b * SEQ + 32 * (ks - 1); };
    __syncthreads();
    for (int i = tid; i < 32 * 129; i += NTHREADS) ((LAS unsigned*)(L + IDX_HIST))[i] = 0u;
    if (tid < 32) ((LAS unsigned*)(L + IDX_CCNT))[tid] = 0u;
    float w[8];
    const LAS unsigned char* qf = L + IDX_Q + r * IDX_QPITCH + 8 * h * 2;
    { for (int i = tid; i < 32 * 64; i += NTHREADS) { const int qq = i >> 6, ch = i & 63; const int qr = g == 0 ? MR + b * NMETA + (qq & 15) : b * SEQ + 32 * (g - 1) + qq;
          *(LAS u32x4*)(L + IDX_Q + qq * IDX_QPITCH + ch * 16) = *(const u32x4*)(proj + PJ_QI + (size_t)qr * 1024 + ch * 16); }
      const float* WI = (const float*)(proj + PJ_WI) + (size_t)qrow * 8; const f32x4 w0 = *(const f32x4*)WI, w1 = *(const f32x4*)(WI + 4);
      w[0] = w0[0]; w[1] = w0[1]; w[2] = w0[2]; w[3] = w0[3]; w[4] = w1[0]; w[5] = w1[1]; w[6] = w1[2]; w[7] = w1[3]; }
    __syncthreads();
    if (tid < 256) { const int qq = tid >> 3, dc = tid & 7; const int qr = g == 0 ? MR + b * NMETA + (qq & 15) : b * SEQ + 32 * (g - 1) + qq;
        const float* WI = (const float*)(proj + PJ_WI) + (size_t)qr * 8; float a[8] = {0.f, 0.f, 0.f, 0.f, 0.f, 0.f, 0.f, 0.f};
#pragma unroll
        for (int hd = 0; hd < 8; ++hd) { const float wv = WI[hd]; const h8 q = *(const LAS h8*)(L + IDX_Q + qq * IDX_QPITCH + (hd * 64 + dc * 8) * 2);
#pragma unroll
            for (int e = 0; e < 8; ++e) a[e] += wv * (float)q[e]; }
        h8 o;
#pragma unroll
        for (int e = 0; e < 8; ++e) o[e] = (_Float16)a[e];
        *(LAS h8*)(L + IDX_Q + qq * IDX_QPITCH + (512 + dc * 8) * 2) = o; }
    __syncthreads();
    if (wave < 4) {
        const KFrag kf = idx_load_k(KI + (size_t)(b * SEQ + 32 * wave + r) * 128, h);
        f32x16 sc; idx_scores(qf, w, kf, sc);
        float s1 = 0.f, s2 = 0.f;
#pragma unroll
        for (int i = 0; i < 16; ++i) { s1 += sc[i]; s2 += sc[i] * sc[i]; }
        s1 = hsum32(s1, lane); s2 = hsum32(s2, lane);
        if (h == 0) { ((LAS float*)(L + IDX_STATS))[(wave * 32 + r) * 2] = s1; ((LAS float*)(L + IDX_STATS))[(wave * 32 + r) * 2 + 1] = s2; }
    }
    __syncthreads();
    float c0f, inv;
    { float s1 = 0.f, s2 = 0.f;
#pragma unroll
      for (int k = 0; k < 4; ++k) { s1 += ((LAS float*)(L + IDX_STATS))[(k * 32 + r) * 2]; s2 += ((LAS float*)(L + IDX_STATS))[(k * 32 + r) * 2 + 1]; }
      const float mean = s1 * (1.0f / 128.0f), var = fmaxf(s2 * (1.0f / 128.0f) - mean * mean, 0.f), sd = fmaxf(sqrtf(var), 1e-12f);
      inv = (float)IDX_NBIN / (10.0f * sd); c0f = -(mean - 3.0f * sd) * inv; }
    LAS unsigned* hrow = (LAS unsigned*)(L + IDX_HIST) + r * 129;
#if PROBE_REP == 12
    for (int rep12 = 0; rep12 < 2; ++rep12) { __syncthreads(); for (int i = tid; i < 32 * 129; i += NTHREADS) ((LAS unsigned*)(L + IDX_HIST))[i] = 0u; __syncthreads();
#else
    {
#endif
        KFrag kf = idx_load_k(KI + (size_t)(ks_row0(wave <= g ? wave : 0) + r) * 128, h);
#pragma unroll 1
        for (int ks = wave; ks <= g; ks += 8) {
            const KFrag kn = idx_load_k(KI + (size_t)(ks_row0(ks + 8 <= g ? ks + 8 : ks) + r) * 128, h);
            f32x16 sc; idx_scores(qf, w, kf, sc);
#if PROBE_REP == 11
            { f32x16 sc2; idx_scores(qf, w, kn, sc2); if (sc2[0] == 1.2345e30f) inv = 0.f; }
#endif
            if (ks == 0 || ks == g) {
#pragma unroll
                for (int i = 0; i < 16; ++i) {
                    const int kidx = crow(i, h);
                    const bool ok = qvalid && (ks == 0 ? kidx < NMETA && (g > 0 || kidx <= r) : kidx <= r);
                    if (ok) { const unsigned bin = (unsigned)__builtin_amdgcn_fmed3f(__builtin_fmaf(sc[i], inv, c0f), 0.f, (float)(IDX_NBIN - 1)); __hip_atomic_fetch_add(hrow + bin, 1u, __ATOMIC_RELAXED, __HIP_MEMORY_SCOPE_WORKGROUP); }
                }
            } else {
#pragma unroll
                for (int i = 0; i < 16; ++i) { const unsigned bin = (unsigned)__builtin_amdgcn_fmed3f(__builtin_fmaf(sc[i], inv, c0f), 0.f, (float)(IDX_NBIN - 1)); __hip_atomic_fetch_add(hrow + bin, 1u, __ATOMIC_RELAXED, __HIP_MEMORY_SCOPE_WORKGROUP); }
            }
            kf = kn;
        }
    }
    __syncthreads();
#pragma unroll 1
    for (int k = 0; k < 4; ++k) {
        const int row = 4 * wave + k;
        const int c0 = (int)((LAS unsigned*)(L + IDX_HIST))[row * 129 + 2 * lane], c1 = (int)((LAS unsigned*)(L + IDX_HIST))[row * 129 + 2 * lane + 1];
        const int SL = suffix_sum(c0 + c1, lane), NT = __builtin_amdgcn_readlane(SL, 0);
        int bstar = -1, need = 0;
        if (NT > 256) {
            const unsigned long long ml = __ballot(SL >= 256); const int lL = 63 - __builtin_clzll(ml); const int sl = __builtin_amdgcn_readlane(SL, lL), t0 = __builtin_amdgcn_readlane(c0, lL), t1 = __builtin_amdgcn_readlane(c1, lL); const int above = sl - t0 - t1;
            if (above + t1 >= 256) { bstar = 2 * lL + 1; need = 256 - above; } else { bstar = 2 * lL; need = 256 - above - t1; }
        }
        if (lane == 0) { ((LAS int*)(L + IDX_INFO))[row * 2] = bstar; ((LAS int*)(L + IDX_INFO))[row * 2 + 1] = need; }
    }
    __syncthreads();
    float lo_f, hi_f;
    { const int bstar = ((LAS int*)(L + IDX_INFO))[r * 2];
      hi_f = bstar < 0 ? -__builtin_inff() : (bstar >= IDX_NBIN - 1 ? __builtin_inff() : (float)(bstar + 1));
      lo_f = bstar <= 0 ? -__builtin_inff() : (float)bstar; }
    {
        KFrag kf = idx_load_k(KI + (size_t)(ks_row0(wave <= g ? wave : 0) + r) * 128, h);
#pragma unroll 1
        for (int ks = wave; ks <= g; ks += 8) {
            const KFrag kn = idx_load_k(KI + (size_t)(ks_row0(ks + 8 <= g ? ks + 8 : ks) + r) * 128, h);
            f32x16 sc; idx_scores(qf, w, kf, sc);
            unsigned part = 0u;
            const bool special = (ks == 0 || ks == g);
#pragma unroll
            for (int i = 0; i < 16; ++i) {
                const int kidx = crow(i, h);
                bool ok = true;
                if (special) ok = qvalid && (ks == 0 ? kidx < NMETA && (g > 0 || kidx <= r) : kidx <= r);
                const float x = __builtin_fmaf(sc[i], inv, c0f);
                const bool sure = ok && (x >= hi_f), cand = ok && !(x >= hi_f) && (x >= lo_f);
                part |= sure ? (1u << kidx) : 0u;
                if (cand) { const unsigned slot = __hip_atomic_fetch_add((LAS unsigned*)(L + IDX_CCNT) + r, 1u, __ATOMIC_RELAXED, __HIP_MEMORY_SCOPE_WORKGROUP);
                    if (slot < IDX_CAP) { LAS float* cp = (LAS float*)(L + IDX_CAND) + (r * IDX_CAP + slot) * 2; cp[0] = sc[i]; ((LAS int*)cp)[1] = ks * 32 + kidx; } }
            }
            part = hor32(part, lane);
            if (h == 0) ((LAS unsigned*)(L + IDX_MASK))[ks * 32 + r] = part;
            kf = kn;
        }
    }
    __syncthreads();
#pragma unroll 1
    for (int k = 0; k < 4; ++k) {
        const int row = 4 * wave + k;
        const int need = ((LAS int*)(L + IDX_INFO))[row * 2 + 1];
        int nc = (int)((LAS unsigned*)(L + IDX_CCNT))[row]; nc = nc < IDX_CAP ? nc : IDX_CAP;
        const LAS float* cb = (const LAS float*)(L + IDX_CAND) + row * IDX_CAP * 2;
#pragma unroll 1
        for (int ci = lane; ci < nc; ci += 64) {
            const float sv = cb[ci * 2]; const int kv = ((const LAS int*)cb)[ci * 2 + 1];
            int rank = 0;
            if (need < nc) { for (int j = 0; j < nc; ++j) { const float sj = cb[j * 2]; const int kj = ((const LAS int*)cb)[j * 2 + 1]; rank += (sj > sv || (sj == sv && kj < kv)) ? 1 : 0; } }
            if (rank < need) __hip_atomic_fetch_or((LAS unsigned*)(L + IDX_MASK) + (kv >> 5) * 32 + row, 1u << (kv & 31), __ATOMIC_RELAXED, __HIP_MEMORY_SCOPE_WORKGROUP);
        }
    }
    __syncthreads();
    unsigned* MK = (unsigned*)(F.ws + WS_MASK) + (size_t)b * NKS * TLEN;
    for (int i = tid; i < (g + 1) * 32; i += NTHREADS) { const int ks = i >> 5, rr = i & 31; if (rr < nq) MK[(size_t)ks * TLEN + tq0 + rr] = ((LAS unsigned*)(L + IDX_MASK))[i]; }
}
__device__ __forceinline__ void mixA_index_phase(const Frame& F) {
#pragma unroll 1
    for (int c = F.bid; c < 256; c += F.G) {
#pragma unroll 1
        for (int k = 0; k < 5; ++k) {
            int u; if (k == 0) u = c; else if (k == 1) u = 511 - c; else if (k == 2) u = 512 + c; else if (k == 3) u = 1023 - c; else { if (c >= 2) break; u = 1024 + c; }
            mixA_index_unit(F, u & 1, 512 - (u >> 1));
        }
    }
}

__device__ __forceinline__ void mixA3_unit(const Frame& F, int l, int b, int ha, int qblk) {
    LAS unsigned char* L = F.lds + LDS_GEN;
    const int tid = F.tid, lane = F.lane, wave = F.wave, r = lane & 31, h = lane >> 5;
    const unsigned char* proj = F.ws + WS_PROJ;
    const _Float16* QA = (const _Float16*)(proj + PJ_QA); const unsigned char* KA = proj + PJ_KA; const unsigned char* VA = proj + PJ_VA;
    const unsigned* kmax = (const unsigned*)(F.ws + WS_CTL) + CW_KMAX + 32 * l;
    const unsigned* MK = (const unsigned*)(F.ws + WS_MASK) + (size_t)b * NKS * TLEN;
    const bool meta_u = qblk < 0;
    const int qrow0 = meta_u ? MR + b * NMETA : b * SEQ + qblk * 256;
    const int qpos0 = meta_u ? 0 : NMETA + qblk * 256;
    const int nreal = meta_u ? 0 : 4 * qblk + 4;
    const int wq0 = 32 * wave;
    const bool wave_on = meta_u ? (wave == 0) : true;
    const int my_row = wave_on ? qrow0 + wq0 + r : qrow0, my_pos = wave_on ? qpos0 + wq0 + r : 0;
    __syncthreads();
    if (tid < 128) ((LAS float*)(L + B_LUT))[tid] = F.rel_bias[BUCKET_LUT[tid] * 12 + ha] * LOG2E;
    float bmax = (lane < 32) ? F.rel_bias[lane * 12 + ha] * LOG2E : -1e30f;
    bmax = fmaxf(bmax, sx<16>(bmax, lane)); bmax = fmaxf(bmax, sx<8>(bmax, lane)); bmax = fmaxf(bmax, sx<4>(bmax, lane)); bmax = fmaxf(bmax, sx<2>(bmax, lane)); bmax = fmaxf(bmax, sx<1>(bmax, lane));
    bmax = bcast0(bmax);
    const float bfar = F.rel_bias[31 * 12 + ha] * LOG2E;
    h8 qf[4]; float mref; bool safe;
    { float n2 = 0.f;
#pragma unroll
      for (int s = 0; s < 4; ++s) { qf[s] = *(const h8*)(QA + (size_t)my_row * 512 + ha * 64 + 16 * s + 8 * h);
#pragma unroll
          for (int j = 0; j < 8; ++j) { const float v = (float)qf[s][j]; n2 += v * v; } }
      n2 = hsum32(n2, lane);
      mref = sqrtf(n2 * (__uint_as_float(kmax[ha * 2]) + __uint_as_float(kmax[ha * 2 + 1]))) * 1.002f + bmax;
      safe = __all(mref - bfar < 60.0f); if (safe) mref = bfar; }
    f32x16 O[2], Lacc;
#pragma unroll
    for (int i = 0; i < 16; ++i) { O[0][i] = 0.f; O[1][i] = 0.f; Lacc[i] = 0.f; }
    bf16x8v ones; { const u32x4 o = {0x3F803F80u, 0x3F803F80u, 0x3F803F80u, 0x3F803F80u}; ones = __builtin_bit_cast(bf16x8v, o); }
    const int skey = tid >> 3, sch = tid & 7;
    const unsigned kdst = skey * KS_PITCH + sch * 16, vdst = (sch >> 2) * 4096 + skey * 64 + (sch & 3) * 16;
    const int ntiles = 1 + nreal;
    auto tile_row0 = [&](int t) -> int { return t == 0 ? MR + b * NMETA : b * SEQ + (t - 1) * 64; };
    u32x4 kreg, vreg;
    { const size_t rr = (size_t)(tile_row0(0) + skey); kreg = *(const u32x4*)(KA + rr * 1024 + ha * 128 + sch * 16); vreg = *(const u32x4*)(VA + rr * 1024 + ha * 128 + sch * 16); }
    *(LAS u32x4*)(L + B_KS + kdst) = kreg; *(LAS u32x4*)(L + B_VS + vdst) = vreg;
    __syncthreads();
    unsigned mw[2], mwn[2] = {0u, 0u};
    mw[0] = MK[my_pos]; mw[1] = 0u;
    const int wpos0 = qpos0 + wq0;
#pragma unroll 1
    for (int t = 0; t < ntiles; ++t) {
        const int buf = t & 1;
        if (t + 1 < ntiles) { const size_t rr = (size_t)(tile_row0(t + 1) + skey); kreg = *(const u32x4*)(KA + rr * 1024 + ha * 128 + sch * 16); vreg = *(const u32x4*)(VA + rr * 1024 + ha * 128 + sch * 16);
            mwn[0] = MK[(size_t)(1 + 2 * t) * TLEN + my_pos]; mwn[1] = MK[(size_t)(2 + 2 * t) * TLEN + my_pos]; }
        const int kpos0 = (t == 0) ? 0 : NMETA + (t - 1) * 64, nvalid = (t == 0) ? NMETA : 64;
        if (wave_on && kpos0 <= wpos0 + 31) {
            LAS unsigned char* Kb = L + B_KS + buf * (64 * KS_PITCH); LAS unsigned char* Vb = L + B_VS + buf * 8192;
            const bool slow = !safe || (t == 0) || (kpos0 + 63 > wpos0 - 128);
#pragma unroll
            for (int sub = 0; sub < 2; ++sub) {
                if (sub * 32 >= nvalid || kpos0 + sub * 32 > wpos0 + 31) continue;
                const unsigned mword = mw[sub] >> (4 * h);
                f32x16 S;
                h8 kfr[4]; bf16x8v vfr[2][2];
#pragma unroll
                for (int s = 0; s < 4; ++s) kfr[s] = *(const LAS h8*)(Kb + (sub * 32 + r) * KS_PITCH + (16 * s + 8 * h) * 2);
#pragma unroll
                for (int d = 0; d < 2; ++d)
#pragma unroll
                    for (int s = 0; s < 2; ++s) vfr[d][s] = vt_frag(Vb, d, sub * 32, s, lane);
                __builtin_amdgcn_sched_barrier(0);
#pragma unroll
                for (int i = 0; i < 16; ++i) S[i] = 0.f;
#pragma unroll
                for (int s = 0; s < 4; ++s) S = __builtin_amdgcn_mfma_f32_32x32x16_f16(kfr[s], qf[s], S, 0, 0, 0);
                bf16x8v pf[2];
                if (slow) {
#pragma unroll
                    for (int i = 0; i < 16; ++i) {
                        const int kidx = sub * 32 + crow(i, h), dist = my_pos - (kpos0 + kidx);
                        const bool ok = ((mword >> ((i & 3) + 8 * (i >> 2))) & 1u) != 0u && dist >= 0 && kidx < nvalid;
                        const float bias = ((const LAS float*)(L + B_LUT))[min(max(dist, 0), 127)];
                        S[i] = ok ? __builtin_amdgcn_exp2f(S[i] + (bias - mref)) : 0.f;
                    }
                    pf[0] = pack_p(S, 0); pf[1] = pack_p(S, 1);
                } else {
#pragma unroll
                    for (int i = 0; i < 16; ++i) S[i] = ((mword >> ((i & 3) + 8 * (i >> 2))) & 1u) ? __builtin_amdgcn_exp2f(S[i]) : 0.f;
                    pf[0] = pack_p(S, 0); pf[1] = pack_p(S, 1);
                }
#pragma unroll
                for (int s = 0; s < 2; ++s) { Lacc = __builtin_amdgcn_mfma_f32_32x32x16_bf16(ones, pf[s], Lacc, 0, 0, 0);
#pragma unroll
                    for (int d = 0; d < 2; ++d) O[d] = __builtin_amdgcn_mfma_f32_32x32x16_bf16(vfr[d][s], pf[s], O[d], 0, 0, 0); }
            }
        }
        if (t + 1 < ntiles) { *(LAS u32x4*)(L + B_KS + (buf ^ 1) * (64 * KS_PITCH) + kdst) = kreg; *(LAS u32x4*)(L + B_VS + (buf ^ 1) * 8192 + vdst) = vreg; }
        mw[0] = mwn[0]; mw[1] = mwn[1];
        __syncthreads();
    }
    if (wave_on) {
        const float il = 1.0f / Lacc[0];
        if (!meta_u || r < NMETA) {
            _Float16* dst = (_Float16*)(F.ws + WS_ABUF) + (size_t)my_row * DM + ha * 64;
#pragma unroll
            for (int d = 0; d < 2; ++d)
#pragma unroll
                for (int g4 = 0; g4 < 4; ++g4) { const int d0 = 32 * d + 8 * g4 + 4 * h;
                    u32x2 w; w.x = cvt_pk_f16(O[d][4 * g4 + 0] * il, O[d][4 * g4 + 1] * il); w.y = cvt_pk_f16(O[d][4 * g4 + 2] * il, O[d][4 * g4 + 3] * il);
                    *(u32x2*)(dst + d0) = w; }
        }
    }
}
__device__ __forceinline__ void mixA3_phase(const Frame& F, int l) {
#pragma unroll 1
    for (int c = F.bid; c < 256; c += F.G) { const int bh = c & 15, i1 = c >> 4, i2 = 31 - i1;
#pragma unroll 1
        for (int k = 0; k < 5; ++k) { if (k == 4 && c >= 16) break;
            const int qb = k == 0 ? 63 - i1 : (k == 1 ? 32 + i1 : (k == 2 ? i2 : (k == 3 ? i1 : -1)));
            mixA3_unit(F, l, bh >> 3, bh & 7, qb); }
    }
}
constexpr int NPHASES = 19;
__global__ void __launch_bounds__(NTHREADS, 2) fwd(Args args) {
    extern __shared__ __attribute__((aligned(16))) unsigned char lds_raw[];
    Frame F;
    F.x = args.in[0]; F.meta = args.in[1]; F.rel_bias = args.in[2]; F.w_in = args.in[3]; F.norm_mix = args.in[4]; F.diff_lambda = args.in[5]; F.diff_norm = args.in[6];
    F.ret_norm = args.in[7]; F.w_out = args.in[8]; F.norm_ff = args.in[9]; F.w_ff1 = args.in[10]; F.w_ff2 = args.in[11]; F.final_norm = args.in[12];
    F.out = args.out; F.ws = args.ws; F.lds = (LAS unsigned char*)lds_raw;
    F.bid = blockIdx.x; F.G = gridDim.x; F.tid = threadIdx.x; F.lane = F.tid & 63; F.wave = __builtin_amdgcn_readfirstlane(F.tid >> 6);
    if (F.tid < 64) ((LAS unsigned*)(F.lds + LDS_MISC))[F.tid] = 0u;
    __syncthreads();
    unsigned* ctl = (unsigned*)(F.ws + WS_CTL);
    XcdBarrier bar = xcd_barrier_post(ctl + CW_BAR, (volatile LAS unsigned*)(F.lds + LDS_MISC));
    const int lo = args.ph_lo, hi = args.ph_hi;
#define IN(k) (lo <= (k) && (k) < hi)
#ifndef PROBE_REP
#define PROBE_REP 0
#endif
#define RETID() do { unsigned z0_ = 0u; asm volatile("" : "+s"(z0_)); int t_ = (int)__builtin_amdgcn_mbcnt_hi(~0u, __builtin_amdgcn_mbcnt_lo(~0u, z0_)); asm volatile("" : "+v"(t_)); F.lane = t_; F.tid = F.wave * 64 + t_; } while (0)
#define REP(k) _Pragma("unroll 1") for (int rep_ = 0; rep_ < ((PROBE_REP == (k)) ? 2 : 1); ++rep_)
#define SEAM(k) do { if (IN(k) && IN((k) + 1)) xcd_barrier(bar, F.wave == 0 && F.lane == 0); } while (0)
    LAS unsigned char* stage = F.lds + LDS_GEN;
    if (IN(0)) { REP(10) prologue(F); SEAM(0); }
#pragma unroll 1
    for (int l = 0; l < DEPTH; ++l) {
        const int pb = 1 + 9 * l;
        { RETID();
          size_t z_ = 0; int b_ = blockIdx.x, g_ = gridDim.x; asm volatile("" : "+s"(z_), "+s"(b_), "+s"(g_)); F.ws = args.ws + z_; F.out = args.out + z_; F.bid = b_; F.G = g_; }
        unsigned char* wl = F.ws + WS_W + (size_t)l * W_LAYER;
        unsigned char* proj = F.ws + WS_PROJ;
        if (IN(pb + 0)) {
            pg8::Gemm g{(const pg8::bf16_t*)(F.ws + WS_ABUF), (const pg8::bf16_t*)(wl + W_IN_OFF), MP, NPAD, DM}; pg8::StaticOrder S; S.init(MP, NPAD, F.G, F.bid);
            EpiInProj E{proj, (const f32x2*)(F.ws + WS_ROPE), ctl + CW_KMAX + 32 * l};
            pg8::gemm_phase<EpiInProj, pg8::StaticOrder>(stage, g, S, E, nullptr, F.tid);
#if PROBE_REP == 7
            RETID(); pg8::gemm_phase<EpiInProj, pg8::StaticOrder>(stage, g, S, E, nullptr, F.tid);
#endif
            SEAM(pb + 0);
        }
        if (IN(pb + 1)) { RETID(); REP(1) mixA_index_phase(F); RETID(); REP(2) mixC1_phase(F); SEAM(pb + 1); }
        if (IN(pb + 2)) { RETID(); REP(3) mixC_scan(F); RETID(); REP(4) mixB_phase(F, l); SEAM(pb + 2); }
        if (IN(pb + 3)) { RETID(); REP(5) mixA3_phase(F, l); RETID(); REP(6) mixC2_phase(F, l); SEAM(pb + 3); }
        if (IN(pb + 4)) { RETID();
            pg8::Gemm g{(const pg8::bf16_t*)(F.ws + WS_ABUF), (const pg8::bf16_t*)(wl + W_OUT_OFF), MP, DM, DM}; pg8::StaticOrder S; S.init(MP, DM, F.G, F.bid);
            EpiRes E{l == 0 ? F.x : F.out, F.out, (float*)(F.ws + WS_HMETA)};
            pg8::gemm_phase<EpiRes, pg8::StaticOrder>(stage, g, S, E, nullptr, F.tid);
            SEAM(pb + 4);
        }
        if (IN(pb + 5)) { RETID(); REP(8) norm_to_abuf<1>(F, F.norm_ff + (size_t)l * DM); SEAM(pb + 5); }
        if (IN(pb + 6)) { RETID();
            pg8::Gemm g{(const pg8::bf16_t*)(F.ws + WS_ABUF), (const pg8::bf16_t*)(wl + W_FF1_OFF), MP, DFF, DM}; pg8::StaticOrder S; S.init(MP, DFF, F.G, F.bid);
            EpiRelu2 E{proj};
            pg8::gemm_phase<EpiRelu2, pg8::StaticOrder>(stage, g, S, E, nullptr, F.tid);
#if PROBE_REP == 9
            RETID(); pg8::gemm_phase<EpiRelu2, pg8::StaticOrder>(stage, g, S, E, nullptr, F.tid);
#endif
            SEAM(pb + 6);
        }
        if (IN(pb + 7)) { RETID();
            pg8::Gemm g{(const pg8::bf16_t*)proj, (const pg8::bf16_t*)(wl + W_FF2_OFF), MP, DM, DFF}; pg8::StaticOrder S; S.init(MP, DM, F.G, F.bid);
            EpiRes E{F.out, F.out, (float*)(F.ws + WS_HMETA)};
#if PROBE_REP == 14
            { EpiRes E2{F.out, (float*)(F.ws + WS_ABUF), (float*)(F.ws + WS_U)}; pg8::gemm_phase<EpiRes, pg8::StaticOrder>(stage, g, S, E2, nullptr, F.tid); RETID(); }
#endif
            pg8::gemm_phase<EpiRes, pg8::StaticOrder>(stage, g, S, E, nullptr, F.tid);
            SEAM(pb + 7);
        }
        if (IN(pb + 8)) { RETID();
            if (l + 1 < DEPTH) { norm_to_abuf<1>(F, F.norm_mix + (size_t)(l + 1) * DM); SEAM(pb + 8); }
            else final_norm(F);
        }
    }
#undef IN
#undef SEAM
}

#ifndef MK_SPLIT
#define MK_SPLIT 0
#endif
extern "C" void kernel_launch(void* const* d_in, const int* in_sizes, int n_in, void* d_out, int out_size, void* d_ws, size_t ws_size, hipStream_t stream) {
    static int grid = 0;
    if (grid == 0) {
        if (n_in != 13 || ws_size < WS_END) { fprintf(stderr, "kernel_launch: need 13 inputs and %zu bytes of workspace; got %d, %zu\n", (size_t)WS_END, n_in, ws_size); grid = -1; return; }
        int dev = 0, cus = 0, per_cu = 0;
        if (hipGetDevice(&dev) != hipSuccess || hipDeviceGetAttribute(&cus, hipDeviceAttributeMultiprocessorCount, dev) != hipSuccess) { grid = -1; return; }
        if (hipFuncSetAttribute((const void*)fwd, hipFuncAttributeMaxDynamicSharedMemorySize, LDS_BYTES) != hipSuccess) { fprintf(stderr, "kernel_launch: hipFuncSetAttribute failed\n"); grid = -1; return; }
        if (hipOccupancyMaxActiveBlocksPerMultiprocessor(&per_cu, (const void*)fwd, NTHREADS, LDS_BYTES) != hipSuccess || per_cu < 1) { fprintf(stderr, "kernel_launch: occupancy query says %d\n", per_cu); }
        (void)hipGetLastError();
        grid = cus;
    }
    if (grid < 0) return;
    (void)hipMemsetAsync((char*)d_ws + WS_CTL, 0, CTL_BYTES, stream);
    Args a{};
    for (int i = 0; i < 13; ++i) a.in[i] = (const float*)d_in[i];
    a.out = (float*)d_out; a.ws = (unsigned char*)d_ws;
#if MK_SPLIT
    for (int p = 0; p < NPHASES; ++p) { a.ph_lo = p; a.ph_hi = p + 1; hipLaunchKernelGGL(fwd, dim3(grid), dim3(NTHREADS), LDS_BYTES, stream, a); }
#else
    a.ph_lo = 0; a.ph_hi = NPHASES; hipLaunchKernelGGL(fwd, dim3(grid), dim3(NTHREADS), LDS_BYTES, stream, a);
#endif
}
```

```cpp
#include <hip/hip_runtime.h>
#include <cstdio>
#include <cstdint>
typedef _Float16 h8 __attribute__((ext_vector_type(8)));
typedef _Float16 h4 __attribute__((ext_vector_type(4)));
typedef _Float16 h2 __attribute__((ext_vector_type(2)));
typedef short s16x8 __attribute__((ext_vector_type(8)));
typedef short s16x4 __attribute__((ext_vector_type(4)));
typedef float f32x16 __attribute__((ext_vector_type(16)));
typedef float f32x2 __attribute__((ext_vector_type(2)));
typedef unsigned u32x2 __attribute__((ext_vector_type(2)));
namespace pg8 {
#define PG8_LAS __attribute__((address_space(3)))
typedef unsigned short bf16_t;
typedef short bf16x8 __attribute__((ext_vector_type(8)));
typedef float f32x4 __attribute__((ext_vector_type(4)));
typedef unsigned u32x4 __attribute__((ext_vector_type(4)));
constexpr int BM = 256, BK = 64, HALF = 128, HTB = HALF * BK * 2  , STAGE_BYTES = 8 * HTB, NXCD = 8, WGM = 8;

__host__ __device__ __forceinline__ int lds_byte(int r, int c) { const int st = (r >> 4) * 2 + (c >> 5), rr = r & 15, cc = c & 31, ob = rr * 64 + cc * 2; return st * 1024 + (ob ^ (((ob >> 9) & 1) << 5)); }
__host__ __device__ __forceinline__ void stage_rc(int b, int& R, int& C) { const int st = b / 1024, sb = b % 1024, swz = sb ^ (((sb >> 9) & 1) << 5); R = (st >> 1) * 16 + swz / 64; C = (st & 1) * 32 + (swz % 64) / 2; }
__host__ __device__ __forceinline__ int perm32(int rho) { const int n = rho >> 4, i = rho & 15; return 8 * (i >> 2) + 4 * n + (i & 3); }

struct Unit { int pm, pn; };
struct Gemm { const bf16_t* A; const bf16_t* Bt; int M, N, K; };

struct StaticOrder {
    int nM, nN, nwg, G, c;
    __host__ __device__ void init(int M, int N, int G_, int c_) { nM = M / BM; nN = N / BM; nwg = nM * nN; G = G_; c = c_; }
    __host__ __device__ bool next(int i, Unit& u) const {
        const long L = (long)i * G + c; if (L >= nwg) return false;
        int wgid = (int)L; { const int q = nwg / NXCD, r = nwg % NXCD, xcd = wgid % NXCD, off = wgid / NXCD; wgid = (xcd < r ? xcd * (q + 1) : r * (q + 1) + (xcd - r) * q) + off; }
        const int nig = WGM * nN, gid = wgid / nig, fm = gid * WGM, gsz = (nM - fm) < WGM ? (nM - fm) : WGM;
        u.pm = fm + ((wgid % nig) % gsz); u.pn = (wgid % nig) / gsz; return true;
    }
    __device__ __forceinline__ void a_ready(const Unit&) const {}
    __device__ __forceinline__ void done(const Unit&) const {}
};

template <class Epi, class Sched, bool ALIGN_EPI = false, bool SP2 = false>
__device__ __forceinline__ void gemm_phase(PG8_LAS unsigned char* lds, const Gemm g, const Sched& S, const Epi& E, int tid_in) {
    int tid_ = tid_in; asm volatile("" : "+v"(tid_));
    const int tid = tid_, wid = __builtin_amdgcn_readfirstlane(tid >> 6), lane = tid & 63, wr = wid >> 2, wc = wid & 3, fr = lane & 15, fq = lane >> 4;
    const int K = g.K, nt = K / BK;
    unsigned voffA[2], voffB[2];
#pragma unroll
    for (int i = 0; i < 2; ++i) { int R, C; stage_rc(tid * 16 + i * 8192, R, C); const int Rb = Epi::PERM ? ((R & ~31) + perm32(R & 31)) : R;
        voffA[i] = (unsigned)(R * K + C) * 2u; voffB[i] = (unsigned)(Rb * K + C) * 2u; }
    const size_t kstep = (size_t)(BK * 2);
    const size_t hstep = (size_t)HALF * K * 2;
    const size_t tstep = 2 * hstep;
    const unsigned ldsw = (unsigned)wid * 1024u;
    const int aoff = lds_byte(wr * 64 + fr, fq * 8), boff = lds_byte(wc * 32 + fr, fq * 8);
#define PG8_SA(b, h) (((b) * 2 + (h)) * HTB)
#define PG8_SB(b, h) ((4 + (b) * 2 + (h)) * HTB)
#define PG8_STAGE(bufoff, gbase, voff) do { _Pragma("unroll") for (int _i = 0; _i < 2; ++_i) \
        __builtin_amdgcn_global_load_lds((const unsigned*)((const char*)(gbase) + (voff)[_i]), (PG8_LAS unsigned*)(lds + (bufoff) + ldsw + _i * 8192), 16, 0, 0); } while (0)
#define PG8_LDA(dst, b, h) do { _Pragma("unroll") for (int m = 0; m < 4; ++m) _Pragma("unroll") for (int k = 0; k < 2; ++k) dst[m][k] = *(const PG8_LAS bf16x8*)(lds + PG8_SA(b, h) + aoff + m * 2048 + k * 1024); } while (0)
#define PG8_LDB(dst, b, h) do { _Pragma("unroll") for (int n = 0; n < 2; ++n) _Pragma("unroll") for (int k = 0; k < 2; ++k) dst[n][k] = *(const PG8_LAS bf16x8*)(lds + PG8_SB(b, h) + boff + n * 2048 + k * 1024); } while (0)
#define PG8_MMA(ai, bj, At, Bt) do { __builtin_amdgcn_s_setprio(1); _Pragma("unroll") for (int m = 0; m < 4; ++m) _Pragma("unroll") for (int n = 0; n < 2; ++n) _Pragma("unroll") for (int k = 0; k < 2; ++k) \
        acc[ai][bj][m][n] = __builtin_amdgcn_mfma_f32_16x16x32_f16(__builtin_bit_cast(h8, Bt[n][k]), __builtin_bit_cast(h8, At[m][k]), acc[ai][bj][m][n], 0, 0, 0); __builtin_amdgcn_s_setprio(0); } while (0)
#define PG8_WAIT_V(n) asm volatile("s_waitcnt vmcnt(" #n ")" ::: "memory")
#define PG8_WAIT_L(n) asm volatile("s_waitcnt lgkmcnt(" #n ")" ::: "memory")
#define PG8_BAR __builtin_amdgcn_s_barrier()
#define PG8_SCHED __builtin_amdgcn_sched_barrier(0)
    Unit cur, nxt; int ui = 0;
    if (!S.next(0, cur)) return;
    f32x4 acc[2][2][4][2];
#pragma unroll
    for (int a = 0; a < 2; ++a)
#pragma unroll
        for (int b = 0; b < 2; ++b)
#pragma unroll
            for (int m = 0; m < 4; ++m)
#pragma unroll
                for (int n = 0; n < 2; ++n) acc[a][b][m][n] = (f32x4){0.f, 0.f, 0.f, 0.f};
    bf16x8 At[4][2], B0[2][2], B1[2][2];
    const char* cA = (const char*)g.A + (size_t)cur.pm * tstep; const char* cB = (const char*)g.Bt + (size_t)cur.pn * tstep;
    S.a_ready(cur);
    if constexpr (SP2) {
        PG8_STAGE(PG8_SB(0, 0), cB, voffB); PG8_STAGE(PG8_SB(0, 1), cB + hstep, voffB); PG8_STAGE(PG8_SA(0, 0), cA, voffA); PG8_STAGE(PG8_SA(0, 1), cA + hstep, voffA);
        if (wr == 1) PG8_BAR;
        PG8_WAIT_V(2); PG8_BAR;
        PG8_STAGE(PG8_SB(1, 0), cB + kstep, voffB); PG8_STAGE(PG8_SA(1, 0), cA + kstep, voffA); PG8_STAGE(PG8_SB(1, 1), cB + hstep + kstep, voffB);
        PG8_WAIT_V(6); PG8_BAR;
    } else {
        PG8_STAGE(PG8_SB(0, 0), cB, voffB); PG8_STAGE(PG8_SA(0, 0), cA, voffA); PG8_STAGE(PG8_SB(0, 1), cB + hstep, voffB); PG8_STAGE(PG8_SA(0, 1), cA + hstep, voffA);
        if (wr == 1) PG8_BAR;
        PG8_WAIT_V(4); PG8_BAR;
        PG8_STAGE(PG8_SB(1, 0), cB + kstep, voffB); PG8_STAGE(PG8_SA(1, 0), cA + kstep, voffA); PG8_STAGE(PG8_SB(1, 1), cB + hstep + kstep, voffB);
        PG8_WAIT_V(6); PG8_BAR;
    }
    for (;;) {
        const bool has_next = S.next(ui + 1, nxt);
        const char* nA = has_next ? (const char*)g.A + (size_t)nxt.pm * tstep : cA; const char* nB = has_next ? (const char*)g.Bt + (size_t)nxt.pn * tstep : cB;
        for (int t = 0; t < nt; t += 2) {
            const bool last = (t == nt - 2);
            const char* a1 = cA + (size_t)(t + 1) * kstep;
            const char* a2 = last ? nA : cA + (size_t)(t + 2) * kstep; const char* b2 = last ? nB : cB + (size_t)(t + 2) * kstep;
            const char* a3 = a2 + kstep; const char* b3 = b2 + kstep;
            if (last && has_next) S.a_ready(nxt);
            if constexpr (SP2) {
            PG8_LDB(B0, 0, 0); PG8_LDB(B1, 0, 1); PG8_SCHED; PG8_LDA(At, 0, 0); PG8_STAGE(PG8_SA(1, 1), a1 + hstep, voffA);
            PG8_WAIT_V(8); PG8_WAIT_L(0); PG8_BAR; PG8_MMA(0, 0, At, B0); PG8_MMA(0, 1, At, B1); PG8_BAR; PG8_SCHED;
            PG8_LDA(At, 0, 1); PG8_STAGE(PG8_SB(0, 0), b2, voffB); PG8_STAGE(PG8_SB(0, 1), b2 + hstep, voffB); PG8_STAGE(PG8_SA(0, 0), a2, voffA);
            PG8_WAIT_V(8); PG8_WAIT_L(0); PG8_BAR; PG8_MMA(1, 0, At, B0); PG8_MMA(1, 1, At, B1); PG8_BAR; PG8_SCHED;
            PG8_LDB(B0, 1, 0); PG8_LDB(B1, 1, 1); PG8_SCHED; PG8_LDA(At, 1, 0); PG8_STAGE(PG8_SA(0, 1), a2 + hstep, voffA);
            PG8_WAIT_V(8); PG8_WAIT_L(0); PG8_BAR; PG8_MMA(0, 0, At, B0); PG8_MMA(0, 1, At, B1); PG8_BAR; PG8_SCHED;
            PG8_LDA(At, 1, 1); PG8_STAGE(PG8_SB(1, 0), b3, voffB); PG8_STAGE(PG8_SB(1, 1), b3 + hstep, voffB); PG8_STAGE(PG8_SA(1, 0), a3, voffA);
            PG8_WAIT_V(8); PG8_WAIT_L(0); PG8_BAR; PG8_MMA(1, 0, At, B0); PG8_MMA(1, 1, At, B1); PG8_BAR; PG8_SCHED;
            } else {
            PG8_LDB(B0, 0, 0); PG8_SCHED; PG8_LDA(At, 0, 0); PG8_STAGE(PG8_SA(1, 1), a1 + hstep, voffA);
            PG8_WAIT_L(8); PG8_BAR; PG8_WAIT_L(0); PG8_MMA(0, 0, At, B0); PG8_BAR; PG8_SCHED;
            PG8_LDB(B1, 0, 1); PG8_STAGE(PG8_SB(0, 0), b2, voffB);
            PG8_BAR; PG8_WAIT_L(0); PG8_MMA(0, 1, At, B1); PG8_BAR;
            PG8_LDA(At, 0, 1); PG8_STAGE(PG8_SA(0, 0), a2, voffA);
            PG8_BAR; PG8_WAIT_L(0); PG8_MMA(1, 0, At, B0); PG8_BAR; PG8_SCHED;
            PG8_STAGE(PG8_SB(0, 1), b2 + hstep, voffB);
            PG8_WAIT_V(6); PG8_BAR; PG8_MMA(1, 1, At, B1); PG8_BAR;
            PG8_LDB(B0, 1, 0); PG8_SCHED; PG8_LDA(At, 1, 0); PG8_STAGE(PG8_SA(0, 1), a2 + hstep, voffA);
            PG8_WAIT_L(8); PG8_BAR; PG8_WAIT_L(0); PG8_MMA(0, 0, At, B0); PG8_BAR; PG8_SCHED;
            PG8_LDB(B1, 1, 1); PG8_STAGE(PG8_SB(1, 0), b3, voffB);
            PG8_BAR; PG8_WAIT_L(0); PG8_MMA(0, 1, At, B1); PG8_BAR;
            PG8_LDA(At, 1, 1); PG8_STAGE(PG8_SA(1, 0), a3, voffA);
            PG8_BAR; PG8_WAIT_L(0); PG8_MMA(1, 0, At, B0); PG8_BAR; PG8_SCHED;
            PG8_STAGE(PG8_SB(1, 1), b3 + hstep, voffB);
            PG8_WAIT_V(6); PG8_BAR; PG8_MMA(1, 1, At, B1); PG8_BAR;
            }
        }
        if constexpr (ALIGN_EPI) { if (wr == 0) PG8_BAR; }
        if constexpr (!Epi::AFTER_DRAIN) { E(acc, cur, wr, wc, fr, fq); S.done(cur); }
        if (!has_next) break;
#pragma unroll
        for (int a = 0; a < 2; ++a)
#pragma unroll
            for (int b = 0; b < 2; ++b)
#pragma unroll
                for (int m = 0; m < 4; ++m)
#pragma unroll
                    for (int n = 0; n < 2; ++n) acc[a][b][m][n] = (f32x4){0.f, 0.f, 0.f, 0.f};
        cur = nxt; cA = nA; cB = nB; ++ui;
        if constexpr (ALIGN_EPI) { if (wr == 1) PG8_BAR; }
    }
    PG8_WAIT_V(0);
    if constexpr (!ALIGN_EPI) { if (wr == 0) PG8_BAR; }
    PG8_BAR;
    if constexpr (Epi::AFTER_DRAIN) { E.fused(acc, cur, wr, wc, fr, fq, lds, wid, lane); S.done(cur); }
#undef PG8_SA
#undef PG8_SB
#undef PG8_STAGE
#undef PG8_LDA
#undef PG8_LDB
#undef PG8_MMA
#undef PG8_WAIT_V
#undef PG8_WAIT_L
#undef PG8_BAR
#undef PG8_SCHED
}
}

#define XB_TMO      128
#define XB_XCNT(j)  (256  + 64 * (j))
#define XB_XSUB(j)  (1280 + 64 * (j))
#define XB_XGEN(j)  (2304 + 64 * (j))
#define XB_TOP      3328
#define XB_TOPGEN   3392
#define XCD_BAR_WORDS 3456
#define XB_SPIN_CAP (1u << 18)
#define LAS __attribute__((address_space(3)))

__device__ __forceinline__ unsigned xb_ld(unsigned* p)              { return __hip_atomic_load(p, __ATOMIC_RELAXED, __HIP_MEMORY_SCOPE_AGENT); }
__device__ __forceinline__ unsigned xb_add(unsigned* p, unsigned v) { return __hip_atomic_fetch_add(p, v, __ATOMIC_RELAXED, __HIP_MEMORY_SCOPE_AGENT); }
__device__ __forceinline__ unsigned xb_xcc_id() { return (unsigned)__builtin_amdgcn_s_getreg((3 << 11) | 20) & 0xFu; }
#define XB_SPIN(cond, bar) do { unsigned _sp = 0; while (cond) { __builtin_amdgcn_s_sleep(1); \
    if ((++_sp & 255u) == 0u) { if (xb_ld(&(bar)[XB_TMO])) break; if (_sp > XB_SPIN_CAP) { atomicAdd(&(bar)[XB_TMO], 1u); break; } } } } while (0)

struct XcdBarrier {
    unsigned* bar; unsigned x;
    volatile LAS unsigned* st;
};

__device__ __forceinline__ XcdBarrier xcd_barrier_post(unsigned* bar, volatile LAS unsigned* st) {
    XcdBarrier b; b.bar = bar; b.x = xb_xcc_id(); b.st = st;
    if (threadIdx.x == 0) (void)xb_add(&bar[XB_XCNT(b.x)], 1u);
    return b;
}
__device__ __forceinline__ void xcd_barrier_complete(unsigned* bar, unsigned x, unsigned& nloc, unsigned& nx) {
    const unsigned G = gridDim.x * gridDim.y * gridDim.z;
    unsigned sum, cnt, mine, sp = 0u;
    for (;;) {
        sum = 0u; cnt = 0u; mine = 0u;
#pragma unroll
        for (unsigned j = 0; j < 16; ++j) { const unsigned c = xb_ld(&bar[XB_XCNT(j)]); sum += c; cnt += (c > 0u) ? 1u : 0u; mine = (j == x) ? c : mine; }
        if (sum == G) break;
        __builtin_amdgcn_s_sleep(1);
        if ((++sp & 255u) == 0u) { if (xb_ld(&bar[XB_TMO])) break; if (sp > XB_SPIN_CAP) { atomicAdd(&bar[XB_TMO], 1u); break; } }
    }
    nloc = mine > 0u ? mine : 1u; nx = cnt > 0u ? cnt : 1u;
}

__device__ __forceinline__ void xcd_barrier(const XcdBarrier& b, const bool leader_thread) {
    asm volatile("s_waitcnt vmcnt(0)" ::: "memory");
    __syncthreads();
    if (leader_thread) {
        unsigned* bar = b.bar;
        __builtin_amdgcn_s_waitcnt(0);
        unsigned nloc = b.st[0], nx = b.st[1];
        if (nloc == 0u) { xcd_barrier_complete(bar, b.x, nloc, nx); b.st[0] = nloc; b.st[1] = nx; }
        const unsigned old = xb_add(&bar[XB_XSUB(b.x)], 1u);
        const unsigned gen = old / nloc;
        if (old + 1u == (gen + 1u) * nloc) {
            __builtin_amdgcn_fence(__ATOMIC_RELEASE, "agent");
            asm volatile("s_waitcnt vmcnt(0)" ::: "memory");
            const unsigned og = xb_add(&bar[XB_TOP], 1u);
            const unsigned tg = og / nx;
            if (og + 1u == (tg + 1u) * nx) xb_add(&bar[XB_TOPGEN], 1u);
            else XB_SPIN(xb_ld(&bar[XB_TOPGEN]) == tg, bar);
            __builtin_amdgcn_fence(__ATOMIC_ACQUIRE, "agent");
            xb_add(&bar[XB_XGEN(b.x)], 1u);
            asm volatile("s_waitcnt vmcnt(0)" ::: "memory");
        } else {
            XB_SPIN(xb_ld(&bar[XB_XGEN(b.x)]) == gen, bar);
            __builtin_amdgcn_fence(__ATOMIC_ACQUIRE, "agent");
            asm volatile("s_waitcnt vmcnt(0)" ::: "memory");
        }
    }
    __syncthreads();
}

constexpr int NB = 2, SEQ = 16384, TLEN = 16400, DM = 1024, NMETA = 16, DEPTH = 2;
constexpr int MR = NB * SEQ;
constexpr int MV = MR + NB * NMETA;
constexpr int MP = 33024;
constexpr int INCOLS = 3912, NPAD = 4096, DFF = 4096;
constexpr int NTHREADS = 512;
constexpr float LOG2E = 1.4426950408889634f;
constexpr float QA_SCALE = 0.125f * LOG2E;
constexpr float QB_SCALE = 0.17677669529663687f * LOG2E;
constexpr float WI_SCALE = 0.044194173824159216f;
constexpr int NKS = 513;

constexpr size_t al256(size_t x) { return (x + 255) & ~(size_t)255; }
constexpr size_t WS_CTL   = 0;
constexpr size_t CTL_BYTES = 65536;
constexpr size_t WS_HMETA = CTL_BYTES;
constexpr size_t WS_ROPE  = WS_HMETA + (size_t)256 * DM * 4;
constexpr size_t WS_W     = al256(WS_ROPE + (size_t)TLEN * 32 * 8);
constexpr size_t W_IN_OFF = 0, W_OUT_OFF = (size_t)NPAD * DM * 2, W_FF1_OFF = W_OUT_OFF + (size_t)DM * DM * 2,
                 W_FF2_OFF = W_FF1_OFF + (size_t)DFF * DM * 2, W_LAYER = W_FF2_OFF + (size_t)DM * DFF * 2;
constexpr size_t WS_ABUF  = al256(WS_W + DEPTH * W_LAYER);
constexpr size_t WS_MASK  = WS_ABUF + (size_t)MP * DM * 2;
constexpr size_t WS_U     = al256(WS_MASK + (size_t)NB * NKS * TLEN * 4);
constexpr size_t WS_S     = WS_U + (size_t)NB * 4 * 129 * 4096 * 4;
constexpr size_t WS_PROJ  = WS_S + (size_t)NB * 4 * 129 * 4096 * 4;
constexpr size_t P512 = (size_t)MP * 512 * 2, P256 = (size_t)MP * 256 * 2;
constexpr size_t PJ_QA = 0, PJ_KA = P512, PJ_VA = 2 * P512, PJ_QI = 3 * P512, PJ_256 = 4 * P512;
constexpr size_t PJ_QB = PJ_256, PJ_KB = PJ_256 + P256, PJ_VB = PJ_256 + 2 * P256, PJ_QC = PJ_256 + 3 * P256, PJ_KC = PJ_256 + 4 * P256,
                 PJ_VC = PJ_256 + 5 * P256, PJ_GC = PJ_256 + 6 * P256, PJ_KI = PJ_256 + 7 * P256, PJ_WI = PJ_KI + (size_t)MP * 64 * 2,
                 PJ_END = PJ_WI + (size_t)MP * 8 * 4;
constexpr size_t ACT_BYTES = (size_t)MP * DFF * 2;
constexpr size_t WS_END = WS_PROJ + (ACT_BYTES > PJ_END ? ACT_BYTES : PJ_END);
constexpr int CW_BAR = 0;
constexpr int CW_KMAX = 4096;

constexpr int LDS_BYTES = 156 * 1024;
constexpr int LDS_MISC = 0, LDS_GEN = 256;

struct Args { const float* in[13]; float* out; unsigned char* ws; int ph_lo, ph_hi; };

struct Frame {
    const float *x, *meta, *rel_bias, *w_in, *norm_mix, *diff_lambda, *diff_norm, *ret_norm, *w_out, *norm_ff, *w_ff1, *w_ff2, *final_norm;
    float* out; unsigned char* ws; LAS unsigned char* lds; int tid, lane, wave, bid, G;
};

__device__ __forceinline__ float shx(float v, int m, int lane) { return __builtin_bit_cast(float, __builtin_amdgcn_ds_bpermute((lane ^ m) << 2, __builtin_bit_cast(int, v))); }
template <int M> __device__ __forceinline__ float sx(float v, int lane) { return shx(v, M, lane); }
__device__ __forceinline__ float hsum32(float v, int lane) { return v + shx(v, 32, lane); }
__device__ __forceinline__ unsigned hor32(unsigned v, int lane) { return v | (unsigned)__builtin_amdgcn_ds_bpermute((lane ^ 32) << 2, (int)v); }
__device__ __forceinline__ float bcast0(float v) { return __builtin_bit_cast(float, __builtin_amdgcn_ds_bpermute(0, __builtin_bit_cast(int, v))); }
__device__ __forceinline__ float wave_sum(float v, int lane) { v = hsum32(v, lane); v += sx<16>(v, lane); v += sx<8>(v, lane); v += sx<4>(v, lane); v += sx<2>(v, lane); v += sx<1>(v, lane); return v; }
__device__ __forceinline__ unsigned cvt_pk_bf16(float lo, float hi) { unsigned r; asm volatile("v_cvt_pk_bf16_f32 %0, %1, %2" : "=v"(r) : "v"(lo), "v"(hi)); return r; }
__device__ __forceinline__ unsigned cvt_pk_f16(float lo, float hi) { h2 p; p.x = (_Float16)lo; p.y = (_Float16)hi; return __builtin_bit_cast(unsigned, p); }
typedef unsigned u32x4 __attribute__((ext_vector_type(4)));
typedef float f32x4 __attribute__((ext_vector_type(4)));
__device__ __forceinline__ u32x4 pack8(const f32x4& a, const f32x4& b, bool bf) {
    u32x4 w;
    if (bf) { w.x = cvt_pk_bf16(a[0], a[1]); w.y = cvt_pk_bf16(a[2], a[3]); w.z = cvt_pk_bf16(b[0], b[1]); w.w = cvt_pk_bf16(b[2], b[3]); }
    else    { w.x = cvt_pk_f16(a[0], a[1]);  w.y = cvt_pk_f16(a[2], a[3]);  w.z = cvt_pk_f16(b[0], b[1]);  w.w = cvt_pk_f16(b[2], b[3]); }
    return w;
}
__device__ __forceinline__ int row_pos(int r) { return r < MR ? (r & (SEQ - 1)) + NMETA : ((r - MR) & 15); }

__device__ __forceinline__ int incol_map(int n) {
    if (n < 2048) return n;
    if (n < 2816) return n - 2048 + 2120;
    if (n < 3328) {
        const int seg = (n - 2816) >> 8, c = (n - 2816) & 255, head = c >> 6, p = c & 63;
        const int g = p >> 3, nn = (p >> 2) & 1, i = p & 3, d = 32 * nn + 4 * g + i;
        return (seg ? 3144 : 2888) + head * 64 + d;
    }
    if (n < 3840) return n - 3328 + 3400;
    if (n < 3904) return n - 3840 + 2048;
    if (n < 3912) return n - 3904 + 2112;
    return -1;
}

__constant__ double ROPE_REV[32] = {0.15915494309189535, 0.11934937021124886, 0.08949940160889101, 0.06711508300522726, 0.050329212104487035, 0.03774158471741977, 0.0283021958306234, 0.02122365276477766, 0.015915494309189534, 0.011934937021124886, 0.008949940160889102, 0.006711508300522725, 0.005032921210448704, 0.003774158471741977, 0.00283021958306234, 0.0021223652764777662, 0.0015915494309189536, 0.0011934937021124885, 0.0008949940160889102, 0.0006711508300522726, 0.0005032921210448703, 0.00037741584717419774, 0.00028302195830623395, 0.0002122365276477766, 0.00015915494309189535, 0.00011934937021124886, 8.949940160889102e-05, 6.711508300522725e-05, 5.0329212104487035e-05, 3.774158471741978e-05, 2.8302195830623396e-05, 2.122365276477766e-05};

struct EpiInProj {
    static constexpr bool PERM = true, AFTER_DRAIN = false;
    unsigned char* proj; const f32x2* rope; unsigned* kmax;
    __device__ __forceinline__ void kmax_update(const pg8::f32x4 (&acc)[2][2][4][2], int bj, unsigned* word, int fr, int fq) const {
        float mx = 0.f; const int LN = fq * 16 + fr;
#pragma unroll
        for (int ai = 0; ai < 2; ++ai)
#pragma unroll
            for (int m = 0; m < 4; ++m) {
                const pg8::f32x4 a = acc[ai][bj][m][0], b = acc[ai][bj][m][1];
                float s = (a[0] * a[0] + a[1] * a[1]) + (a[2] * a[2] + a[3] * a[3]) + (b[0] * b[0] + b[1] * b[1]) + (b[2] * b[2] + b[3] * b[3]);
                s += sx<16>(s, LN); s = hsum32(s, LN);
                mx = fmaxf(mx, s);
            }
        mx = fmaxf(mx, sx<1>(mx, LN)); mx = fmaxf(mx, sx<2>(mx, LN)); mx = fmaxf(mx, sx<4>(mx, LN)); mx = fmaxf(mx, sx<8>(mx, LN));
        if (fr == 0 && fq == 0) atomicMax(word, __float_as_uint(mx));
    }
    __device__ __forceinline__ void operator()(const pg8::f32x4 (&acc)[2][2][4][2], const pg8::Unit& u, int wr, int wc, int fr, int fq) const {
        const int pn = u.pn, rbase = u.pm * 256 + wr * 64 + fr, cw = wc * 32 + 8 * fq;
        if (pn <= 7 || (pn <= 14 && pn != 11 && pn != 12)) {
            unsigned char* base; int ld, colt; float scale = 1.f; bool bf = false;
            if (pn <= 7) { const int arr = pn >> 1; base = proj + (size_t)arr * P512; ld = 512; colt = (pn & 1) * 256; if (arr == 0) scale = QA_SCALE; bf = (arr == 2); }
            else { const int arr = pn - 8; base = proj + PJ_256 + (size_t)arr * P256; ld = 256; colt = 0; if (arr == 0) scale = QB_SCALE; bf = (arr == 2); }
#pragma unroll
            for (int ai = 0; ai < 2; ++ai)
#pragma unroll
                for (int m = 0; m < 4; ++m) {
                    const int row = rbase + ai * 128 + m * 16;
#pragma unroll
                    for (int bj = 0; bj < 2; ++bj) {
                        const pg8::f32x4 v0 = acc[ai][bj][m][0] * scale, v1 = acc[ai][bj][m][1] * scale;
                        *(u32x4*)(base + ((size_t)row * ld + colt + bj * 128 + cw) * 2) = pack8(v0, v1, bf);
                    }
                }
            if (pn == 2 || pn == 3) {
#pragma unroll
                for (int bj = 0; bj < 2; ++bj) { const int head = ((pn & 1) * 256 + bj * 128 + wc * 32) >> 6; kmax_update(acc, bj, kmax + head * 2 + (wc & 1), fr, fq); }
            }
            if (pn == 9) {
#pragma unroll
                for (int bj = 0; bj < 2; ++bj) { const int head = 2 * bj + (wc >> 1); kmax_update(acc, bj, kmax + 16 + head * 2 + (wc & 1), fr, fq); }
            }
        } else if (pn == 11 || pn == 12) {
            unsigned char* base = proj + PJ_256 + (size_t)(pn - 8) * P256;
            const float sc = (pn == 12) ? 0.125f : 1.f;
            const int g = 4 * (wc & 1) + fq;
#pragma unroll
            for (int ai = 0; ai < 2; ++ai)
#pragma unroll
                for (int m = 0; m < 4; ++m) {
                    const int row = rbase + ai * 128 + m * 16, t = row_pos(row);
                    const pg8::f32x4 cs0 = *(const pg8::f32x4*)(rope + (size_t)t * 32 + 4 * g), cs1 = *(const pg8::f32x4*)(rope + (size_t)t * 32 + 4 * g + 2);
                    const float c[4] = {cs0[0], cs0[2], cs1[0], cs1[2]}, s[4] = {cs0[1], cs0[3], cs1[1], cs1[3]};
#pragma unroll
                    for (int bj = 0; bj < 2; ++bj) {
                        const pg8::f32x4 x1 = acc[ai][bj][m][0], x2 = acc[ai][bj][m][1];
                        float o1[4], o2[4];
#pragma unroll
                        for (int i = 0; i < 4; ++i) { o1[i] = (x1[i] * c[i] - x2[i] * s[i]) * sc; o2[i] = (x1[i] * s[i] + x2[i] * c[i]) * sc; }
                        const int head = 2 * bj + (wc >> 1);
                        unsigned char* rp = base + ((size_t)row * 256 + head * 64 + 4 * g) * 2;
                        u32x2 w1, w2; w1.x = cvt_pk_f16(o1[0], o1[1]); w1.y = cvt_pk_f16(o1[2], o1[3]); w2.x = cvt_pk_f16(o2[0], o2[1]); w2.y = cvt_pk_f16(o2[2], o2[3]);
                        *(u32x2*)rp = w1; *(u32x2*)(rp + 64) = w2;
                    }
                }
        } else {
#pragma unroll
            for (int ai = 0; ai < 2; ++ai)
#pragma unroll
                for (int m = 0; m < 4; ++m) {
                    const int row = rbase + ai * 128 + m * 16;
                    const pg8::f32x4 v0 = acc[ai][0][m][0], v1 = acc[ai][0][m][1];
                    if (wc < 2) *(u32x4*)(proj + PJ_KI + ((size_t)row * 64 + cw) * 2) = pack8(v0, v1, false);
                    else if (wc == 2 && fq == 0) { float* wp = (float*)(proj + PJ_WI) + (size_t)row * 8; *(pg8::f32x4*)wp = v0 * WI_SCALE; *(pg8::f32x4*)(wp + 4) = v1 * WI_SCALE; }
                }
        }
    }
};
struct EpiRes {
    static constexpr bool PERM = false, AFTER_DRAIN = false;
    const float* res_main; float* out_main; float* hmeta;
    __device__ __forceinline__ void operator()(const pg8::f32x4 (&acc)[2][2][4][2], const pg8::Unit& u, int wr, int wc, int fr, int fq) const {
        const bool mt = (u.pm * 256 >= MR);
        const float* rb = mt ? hmeta : res_main; float* ob = mt ? hmeta : out_main;
        const int row0 = (mt ? u.pm * 256 - MR : u.pm * 256) + wr * 64 + fr, col0 = u.pn * 256 + wc * 32 + 4 * fq;
#pragma unroll
        for (int ai = 0; ai < 2; ++ai)
#pragma unroll
            for (int m = 0; m < 4; ++m) {
                const size_t ro = (size_t)(row0 + ai * 128 + m * 16) * DM + col0;
#pragma unroll
                for (int bj = 0; bj < 2; ++bj)
#pragma unroll
                    for (int n = 0; n < 2; ++n) { const pg8::f32x4 v = *(const pg8::f32x4*)(rb + ro + bj * 128 + n * 16) + acc[ai][bj][m][n]; *(pg8::f32x4*)(ob + ro + bj * 128 + n * 16) = v; }
            }
    }
};
struct EpiRelu2 {
    static constexpr bool PERM = true, AFTER_DRAIN = false;
    unsigned char* act;
    __device__ __forceinline__ void operator()(const pg8::f32x4 (&acc)[2][2][4][2], const pg8::Unit& u, int wr, int wc, int fr, int fq) const {
        const int rbase = u.pm * 256 + wr * 64 + fr, col0 = u.pn * 256 + wc * 32 + 8 * fq;
#pragma unroll
        for (int ai = 0; ai < 2; ++ai)
#pragma unroll
            for (int m = 0; m < 4; ++m) {
                const int row = rbase + ai * 128 + m * 16;
#pragma unroll
                for (int bj = 0; bj < 2; ++bj) {
                    pg8::f32x4 v0 = acc[ai][bj][m][0], v1 = acc[ai][bj][m][1];
#pragma unroll
                    for (int i = 0; i < 4; ++i) { const float a = fmaxf(v0[i], 0.f), b = fmaxf(v1[i], 0.f); v0[i] = a * a; v1[i] = b * b; }
                    *(u32x4*)(act + ((size_t)row * DFF + col0 + bj * 128) * 2) = pack8(v0, v1, false);
                }
            }
    }
};

struct WTile { const float* src; _Float16* dst; int ld, K, k0, n0, mapped; };
constexpr int WT_PER_LAYER = 16 * 64 + 16 * 16 + 16 * 64 + 64 * 16, WT_TOTAL = DEPTH * WT_PER_LAYER;
__device__ __forceinline__ WTile wt_desc(const Frame& F, int t) {
    WTile d; const int l = t / WT_PER_LAYER; int r = t - l * WT_PER_LAYER;
    unsigned char* wl = F.ws + WS_W + (size_t)l * W_LAYER;
    if (r < 1024)      { d.src = F.w_in + (size_t)l * DM * INCOLS; d.dst = (_Float16*)(wl + W_IN_OFF);  d.ld = INCOLS; d.K = DM;  d.mapped = 1; d.k0 = (r & 15) * 64; d.n0 = (r >> 4) * 64; }
    else if (r < 1280) { r -= 1024; d.src = F.w_out + (size_t)l * DM * DM;  d.dst = (_Float16*)(wl + W_OUT_OFF); d.ld = DM;  d.K = DM;  d.mapped = 0; d.k0 = (r & 15) * 64; d.n0 = (r >> 4) * 64; }
    else if (r < 2304) { r -= 1280; d.src = F.w_ff1 + (size_t)l * DM * DFF; d.dst = (_Float16*)(wl + W_FF1_OFF); d.ld = DFF; d.K = DM;  d.mapped = 0; d.k0 = (r & 15) * 64; d.n0 = (r >> 4) * 64; }
    else               { r -= 2304; d.src = F.w_ff2 + (size_t)l * DFF * DM; d.dst = (_Float16*)(wl + W_FF2_OFF); d.ld = DM;  d.K = DFF; d.mapped = 0; d.k0 = (r & 63) * 64; d.n0 = (r >> 6) * 64; }
    return d;
}
__device__ __forceinline__ void wt_load(const WTile& d, int tid, f32x4& v0, f32x4& v1) {
    const int kk = tid >> 4, n4 = (tid & 15) * 4; const int sc = d.mapped ? incol_map(d.n0 + n4) : d.n0 + n4;
    v0 = (f32x4){0.f, 0.f, 0.f, 0.f}; v1 = v0;
    if (sc >= 0) { v0 = *(const f32x4*)(d.src + (size_t)(d.k0 + kk) * d.ld + sc); v1 = *(const f32x4*)(d.src + (size_t)(d.k0 + kk + 32) * d.ld + sc); }
}
__device__ __forceinline__ void wtrans_all(const Frame& F) {
    LAS float* tile = (LAS float*)(F.lds + LDS_GEN); const int tid = F.tid;
    int t = F.bid; if (t >= WT_TOTAL) return;
    WTile d = wt_desc(F, t); f32x4 v0, v1; wt_load(d, tid, v0, v1);
#pragma unroll 1
    for (;;) {
        const int tn = t + F.G; WTile dn = d; f32x4 n0 = v0, n1 = v1;
        if (tn < WT_TOTAL) { dn = wt_desc(F, tn); wt_load(dn, tid, n0, n1); }
        { const int kk = tid >> 4, n4 = (tid & 15) * 4;
#pragma unroll
          for (int e = 0; e < 4; ++e) { tile[kk * 65 + n4 + e] = v0[e]; tile[(kk + 32) * 65 + n4 + e] = v1[e]; } }
        __syncthreads();
        { const int nn = tid >> 3, k8 = (tid & 7) * 8; h8 o;
#pragma unroll
          for (int e = 0; e < 8; ++e) o[e] = (_Float16)tile[(k8 + e) * 65 + nn];
          *(h8*)(d.dst + (size_t)(d.n0 + nn) * d.K + d.k0 + k8) = o; }
        __syncthreads();
        if (tn >= WT_TOTAL) break;
        t = tn; d = dn; v0 = n0; v1 = n1;
    }
}
template <int MODE> __device__ __forceinline__ void norm_to_abuf(const Frame& F, const float* gain) {
    _Float16* abuf = (_Float16*)(F.ws + WS_ABUF); const float* hmeta = (const float*)(F.ws + WS_HMETA);
    const int nw = F.G * 8;
    for (int r = F.bid * 8 + F.wave; r < MP; r += nw) {
        _Float16* dst = abuf + (size_t)r * DM;
        if (r >= MV) { const h4 z = {(_Float16)0.f, (_Float16)0.f, (_Float16)0.f, (_Float16)0.f};
#pragma unroll
            for (int j = 0; j < 4; ++j) *(h4*)(dst + j * 256 + F.lane * 4) = z; continue; }
        const float* src = MODE == 0 ? (r < MR ? F.x + (size_t)r * DM : F.meta + (size_t)((r - MR) & 15) * DM) : (r < MR ? F.out + (size_t)r * DM : hmeta + (size_t)(r - MR) * DM);
        f32x4 v[4]; float ss = 0.f;
#pragma unroll
        for (int j = 0; j < 4; ++j) { v[j] = *(const f32x4*)(src + j * 256 + F.lane * 4); ss += (v[j][0] * v[j][0] + v[j][1] * v[j][1]) + (v[j][2] * v[j][2] + v[j][3] * v[j][3]); }
        ss = wave_sum(ss, F.lane); const float rstd = rsqrtf(ss * (1.0f / DM) + 1e-6f);
#pragma unroll
        for (int j = 0; j < 4; ++j) { const f32x4 g = *(const f32x4*)(gain + j * 256 + F.lane * 4); h4 o;
#pragma unroll
            for (int e = 0; e < 4; ++e) o[e] = (_Float16)(v[j][e] * rstd * g[e]);
            *(h4*)(dst + j * 256 + F.lane * 4) = o; }
    }
}
__device__ __forceinline__ void final_norm(const Frame& F) {
    const int nw = F.G * 8;
    for (int r = F.bid * 8 + F.wave; r < MR; r += nw) {
        float* p = F.out + (size_t)r * DM; f32x4 v[4]; float ss = 0.f;
#pragma unroll
        for (int j = 0; j < 4; ++j) { v[j] = *(const f32x4*)(p + j * 256 + F.lane * 4); ss += (v[j][0] * v[j][0] + v[j][1] * v[j][1]) + (v[j][2] * v[j][2] + v[j][3] * v[j][3]); }
        ss = wave_sum(ss, F.lane); const float rstd = rsqrtf(ss * (1.0f / DM) + 1e-6f);
#pragma unroll
        for (int j = 0; j < 4; ++j) { const f32x4 g = *(const f32x4*)(F.final_norm + j * 256 + F.lane * 4); *(f32x4*)(p + j * 256 + F.lane * 4) = v[j] * rstd * g; }
    }
}
__device__ __forceinline__ void prologue(const Frame& F) {
    const int gtid = F.bid * NTHREADS + F.tid, gsz = F.G * NTHREADS;
    float* hmeta = (float*)(F.ws + WS_HMETA);
    for (int i = gtid; i < 256 * DM / 4; i += gsz) { const int row = i / (DM / 4), c4 = i % (DM / 4); f32x4 v = {0.f, 0.f, 0.f, 0.f}; if (row < NB * NMETA) v = *(const f32x4*)(F.meta + (size_t)(row & 15) * DM + c4 * 4); *(f32x4*)(hmeta + (size_t)row * DM + c4 * 4) = v; }
    f32x2* rope = (f32x2*)(F.ws + WS_ROPE);
    for (int i = gtid; i < TLEN * 32; i += gsz) { const int t = i >> 5, d = i & 31; const double rev = (double)t * ROPE_REV[d]; const float fr = (float)(rev - __builtin_floor(rev)); f32x2 cs; cs.x = __builtin_amdgcn_cosf(fr); cs.y = __builtin_amdgcn_sinf(fr); rope[i] = cs; }
    wtrans_all(F);
    norm_to_abuf<0>(F, F.norm_mix);
}
__device__ __forceinline__ int crow(int i, int h) { return (i & 3) + 8 * (i >> 2) + 4 * h; }
constexpr size_t WS_SCR = WS_U;
template <bool FROM_SCR> __device__ __forceinline__ void skinny_task(const unsigned char* A, int lda_bytes, const float* scr, const _Float16* Bt, int K, int n0, int k0, float* dst, int ldd, int lane) {
    const int r = lane & 31, h = lane >> 5;
    f32x16 acc;
#pragma unroll
    for (int i = 0; i < 16; ++i) acc[i] = 0.f;
#pragma unroll 1
    for (int kc = 0; kc < 4; ++kc) {
    h8 a[4], bb[4];
#pragma unroll
    for (int s = 0; s < 4; ++s) {
        const int k = k0 + 64 * kc + 16 * s + 8 * h;
        if (FROM_SCR) { const f32x4 x0 = *(const f32x4*)(scr + (size_t)r * DFF + k), x1 = *(const f32x4*)(scr + (size_t)r * DFF + k + 4);
#pragma unroll
            for (int e = 0; e < 4; ++e) { const float u = fmaxf(x0[e], 0.f), v = fmaxf(x1[e], 0.f); a[s][e] = (_Float16)(u * u); a[s][4 + e] = (_Float16)(v * v); } }
        else a[s] = *(const h8*)(A + (size_t)(MR + r) * lda_bytes + (size_t)k * 2);
        bb[s] = *(const h8*)(Bt + (size_t)(n0 + r) * K + k);
    }
#pragma unroll
    for (int s = 0; s < 4; ++s) acc = __builtin_amdgcn_mfma_f32_32x32x16_f16(a[s], bb[s], acc, 0, 0, 0);
    }
#pragma unroll
    for (int i = 0; i < 16; ++i) atomicAdd(dst + (size_t)crow(i, h) * ldd + n0 + r, acc[i]);
}
template <int MODE> __device__ __forceinline__ void skinny_meta(const Frame& F, const unsigned char* wl) {
    const int ntn = MODE == 1 ? 128 : 32, nks = MODE == 2 ? 16 : 4, ntask = ntn * nks;
    float* hmeta = (float*)(F.ws + WS_HMETA); float* scr = (float*)(F.ws + WS_SCR);
#pragma unroll 1
    for (int task = F.bid * 8 + F.wave; task < ntask; task += F.G * 8) {
        const int nt = task % ntn, ks = task / ntn;
        if (MODE == 0) skinny_task<false>(F.ws + WS_ABUF, DM * 2, nullptr, (const _Float16*)(wl + W_OUT_OFF), DM, nt * 32, ks * 256, hmeta, DM, F.lane);
        if (MODE == 1) skinny_task<false>(F.ws + WS_ABUF, DM * 2, nullptr, (const _Float16*)(wl + W_FF1_OFF), DM, nt * 32, ks * 256, scr, DFF, F.lane);
        if (MODE == 2) skinny_task<true>(nullptr, 0, scr, (const _Float16*)(wl + W_FF2_OFF), DFF, nt * 32, ks * 256, hmeta, DM, F.lane);
    }
}
__device__ __forceinline__ void zero_scr(const Frame& F) {
    f32x4* p = (f32x4*)(F.ws + WS_SCR); float z0 = 0.f; asm volatile("" : "+v"(z0)); const f32x4 z = {z0, z0, z0, z0};
    for (int i = F.bid * NTHREADS + F.tid; i < 32 * DFF / 4; i += F.G * NTHREADS) p[i] = z;
}
__device__ __forceinline__ void zero_abuf(const Frame& F) {
    u32x4* p = (u32x4*)(F.ws + WS_ABUF); const u32x4 z = {0u, 0u, 0u, 0u};
    for (size_t i = (size_t)F.bid * NTHREADS + F.tid; i < (size_t)MP * DM * 2 / 16; i += (size_t)F.G * NTHREADS) p[i] = z;
}

typedef short bf16x8v __attribute__((ext_vector_type(8)));
__constant__ unsigned char BUCKET_LUT[128] = {0, 1, 2, 3, 4, 5, 6, 7, 8, 9, 10, 11, 12, 13, 14, 15, 16, 16, 16, 17, 17, 18, 18, 18, 19, 19, 19, 20, 20, 20, 20, 21, 21, 21, 21, 22, 22, 22, 22, 22, 23, 23, 23, 23, 23, 23, 24, 24, 24, 24, 24, 24, 25, 25, 25, 25, 25, 25, 25, 26, 26, 26, 26, 26, 26, 26, 26, 27, 27, 27, 27, 27, 27, 27, 27, 27, 27, 28, 28, 28, 28, 28, 28, 28, 28, 28, 28, 29, 29, 29, 29, 29, 29, 29, 29, 29, 29, 29, 29, 30, 30, 30, 30, 30, 30, 30, 30, 30, 30, 30, 30, 30, 30, 31, 31, 31, 31, 31, 31, 31, 31, 31, 31, 31, 31, 31, 31, 31};
__device__ __forceinline__ bf16x8v pack_p(const f32x16& x, int s) {
    u32x4 p; p.x = cvt_pk_bf16(x[8 * s + 0], x[8 * s + 1]); p.y = cvt_pk_bf16(x[8 * s + 2], x[8 * s + 3]); p.z = cvt_pk_bf16(x[8 * s + 4], x[8 * s + 5]); p.w = cvt_pk_bf16(x[8 * s + 6], x[8 * s + 7]);
    return __builtin_bit_cast(bf16x8v, p);
}
constexpr int TK = 128;
__device__ __forceinline__ bf16x8v vt_frag(LAS unsigned char* vimg, int dblk, int keybase, int s, int lane) {
    const int h = lane >> 5, blk = (lane >> 4) & 1, i16 = lane & 15, q = i16 >> 2, p = i16 & 3;
    LAS unsigned char* a = vimg + dblk * (TK * 64) + (keybase + 16 * s + 4 * h + q) * 64 + (16 * blk + 4 * p) * 2;
    const s16x4 lo = __builtin_amdgcn_ds_read_tr16_b64_v4i16((LAS s16x4*)a);
    const s16x4 hi = __builtin_amdgcn_ds_read_tr16_b64_v4i16((LAS s16x4*)(a + 8 * 64));
    return __builtin_shufflevector(lo, hi, 0, 1, 2, 3, 4, 5, 6, 7);
}

constexpr int KS_PITCH = 144;
constexpr int KBUF = TK * KS_PITCH, VBUF = 2 * TK * 64, B_KS = 0, B_VS = 2 * KBUF, B_LUT = B_VS + 2 * VBUF, B_END = B_LUT + 512;
__device__ __forceinline__ void mixB_unit(const Frame& F, int l, int b, int hh, int qblk, float lam, float oscale) {
    LAS unsigned char* L = F.lds + LDS_GEN;
    const int tid = F.tid, lane = F.lane, wave = F.wave, r = lane & 31, h = lane >> 5;
    const unsigned char* proj = F.ws + WS_PROJ;
    const _Float16* QB = (const _Float16*)(proj + PJ_QB); const unsigned char* KB = proj + PJ_KB; const unsigned char* VB = proj + PJ_VB;
    const unsigned* kmax = (const unsigned*)(F.ws + WS_CTL) + CW_KMAX + 32 * l + 16;
    const bool meta_u = qblk < 0;
    const int qrow0 = meta_u ? MR + b * NMETA : b * SEQ + qblk * 256;
    const int qpos0 = meta_u ? 0 : NMETA + qblk * 256;
    const int nreal = meta_u ? 0 : 2 * qblk + 2;
    const int wq0 = 32 * wave;
    const bool wave_on = meta_u ? (wave == 0) : true;
    const int my_row = wave_on ? qrow0 + wq0 + r : qrow0, my_pos = qpos0 + wq0 + r;
    __syncthreads();
    if (tid < 128) ((LAS float*)(L + B_LUT))[tid] = F.rel_bias[BUCKET_LUT[tid] * 12 + 8 + hh] * LOG2E;
    float bmax = (lane < 32) ? F.rel_bias[lane * 12 + 8 + hh] * LOG2E : -1e30f;
    bmax = fmaxf(bmax, sx<16>(bmax, lane)); bmax = fmaxf(bmax, sx<8>(bmax, lane)); bmax = fmaxf(bmax, sx<4>(bmax, lane)); bmax = fmaxf(bmax, sx<2>(bmax, lane)); bmax = fmaxf(bmax, sx<1>(bmax, lane));
    bmax = bcast0(bmax);
    const float bfar = F.rel_bias[31 * 12 + 8 + hh] * LOG2E;
    h8 qf[2][2]; float mref[2]; bool safe = true;
#pragma unroll
    for (int c = 0; c < 2; ++c) {
        float n2 = 0.f;
#pragma unroll
        for (int s = 0; s < 2; ++s) { qf[c][s] = *(const h8*)(QB + (size_t)my_row * 256 + hh * 64 + c * 32 + 16 * s + 8 * h);
#pragma unroll
            for (int j = 0; j < 8; ++j) { const float v = (float)qf[c][s][j]; n2 += v * v; } }
        n2 = hsum32(n2, lane);
        mref[c] = sqrtf(n2 * __uint_as_float(kmax[hh * 2 + c])) * 1.002f + bmax;
        safe = safe && (mref[c] - bfar < 60.0f);
    }
    safe = __all(safe);
    if (safe) { mref[0] = bfar; mref[1] = bfar; }
    f32x16 O[2][2]; float lsum[2] = {0.f, 0.f};
#pragma unroll
    for (int c = 0; c < 2; ++c)
#pragma unroll
        for (int d = 0; d < 2; ++d)
#pragma unroll
            for (int i = 0; i < 16; ++i) O[c][d][i] = 0.f;
    const int skey = tid >> 3, sch = tid & 7;
    const unsigned kdst = skey * KS_PITCH + sch * 16, vdst = (sch >> 2) * (TK * 64) + skey * 64 + (sch & 3) * 16;
    const int ntiles = 1 + nreal;
    auto tile_row0 = [&](int t) -> int { return t == 0 ? MR + b * NMETA : b * SEQ + (t - 1) * TK; };
    u32x4 kreg[2], vreg[2];
#pragma unroll
    for (int j = 0; j < 2; ++j) { const size_t rr = (size_t)(tile_row0(0) + skey + 64 * j); kreg[j] = *(const u32x4*)(KB + rr * 512 + hh * 128 + sch * 16); vreg[j] = *(const u32x4*)(VB + rr * 512 + hh * 128 + sch * 16); }
#pragma unroll
    for (int j = 0; j < 2; ++j) { *(LAS u32x4*)(L + B_KS + kdst + j * 64 * KS_PITCH) = kreg[j]; *(LAS u32x4*)(L + B_VS + vdst + j * 64 * 64) = vreg[j]; }
    __syncthreads();
    const int wpos0 = qpos0 + wq0;
#pragma unroll 1
    for (int t = 0; t < ntiles; ++t) {
        const int buf = t & 1;
        if (t + 1 < ntiles) {
#pragma unroll
            for (int j = 0; j < 2; ++j) { const size_t rr = (size_t)(tile_row0(t + 1) + skey + 64 * j); kreg[j] = *(const u32x4*)(KB + rr * 512 + hh * 128 + sch * 16); vreg[j] = *(const u32x4*)(VB + rr * 512 + hh * 128 + sch * 16); } }
        const int kpos0 = (t == 0) ? 0 : NMETA + (t - 1) * TK, nvalid = (t == 0) ? NMETA : TK;
        if (wave_on && kpos0 <= wpos0 + 31) {
            LAS unsigned char* Kb = L + B_KS + buf * KBUF; LAS unsigned char* Vb = L + B_VS + buf * VBUF;
#pragma unroll
            for (int sub = 0; sub < 4; ++sub) {
                if (sub * 32 >= nvalid || kpos0 + sub * 32 > wpos0 + 31) continue;
                const bool slow = !safe || (t == 0) || (kpos0 + sub * 32 + 31 > wpos0 - 128);
                h8 kfr[2][2]; bf16x8v vfr[2][2];
#pragma unroll
                for (int c = 0; c < 2; ++c)
#pragma unroll
                    for (int s = 0; s < 2; ++s) kfr[c][s] = *(const LAS h8*)(Kb + (sub * 32 + r) * KS_PITCH + (c * 32 + 16 * s + 8 * h) * 2);
#pragma unroll
                for (int d = 0; d < 2; ++d)
#pragma unroll
                    for (int s = 0; s < 2; ++s) vfr[d][s] = vt_frag(Vb, d, sub * 32, s, lane);
                __builtin_amdgcn_sched_barrier(0);
                f32x16 S[2];
#pragma unroll
                for (int c = 0; c < 2; ++c) {
#pragma unroll
                    for (int i = 0; i < 16; ++i) S[c][i] = 0.f;
#pragma unroll
                    for (int s = 0; s < 2; ++s) S[c] = __builtin_amdgcn_mfma_f32_32x32x16_f16(kfr[c][s], qf[c][s], S[c], 0, 0, 0);
                }
                if (slow) {
                    float bs[16];
#pragma unroll
                    for (int i = 0; i < 16; ++i) { const int dist = my_pos - (kpos0 + sub * 32 + crow(i, h)); bs[i] = ((const LAS float*)(L + B_LUT))[min(max(dist, 0), 127)]; }
#pragma unroll
                    for (int i = 0; i < 16; ++i) {
                        const int kidx = sub * 32 + crow(i, h), dist = my_pos - (kpos0 + kidx);
                        const bool ok = dist >= 0 && kidx < nvalid;
#pragma unroll
                        for (int c = 0; c < 2; ++c) { const float e = __builtin_amdgcn_exp2f(fminf(S[c][i] + (bs[i] - mref[c]), 80.f)); S[c][i] = ok ? e : 0.f; }
                    }
                }
#pragma unroll
                for (int c = 0; c < 2; ++c) {
                    __builtin_amdgcn_sched_barrier(0);
                    if (!slow) {
#pragma unroll
                        for (int i = 0; i < 16; ++i) S[c][i] = __builtin_amdgcn_exp2f(S[c][i]); }
                    const float a0 = (S[c][0] + S[c][1]) + (S[c][2] + S[c][3]), a1 = (S[c][4] + S[c][5]) + (S[c][6] + S[c][7]);
                    const float a2 = (S[c][8] + S[c][9]) + (S[c][10] + S[c][11]), a3 = (S[c][12] + S[c][13]) + (S[c][14] + S[c][15]);
                    lsum[c] += (a0 + a1) + (a2 + a3);
                    bf16x8v pf[2]; pf[0] = pack_p(S[c], 0); pf[1] = pack_p(S[c], 1);
                    __builtin_amdgcn_sched_barrier(0);
#pragma unroll
                    for (int d = 0; d < 2; ++d)
#pragma unroll
                        for (int s = 0; s < 2; ++s) O[c][d] = __builtin_amdgcn_mfma_f32_32x32x16_bf16(vfr[d][s], pf[s], O[c][d], 0, 0, 0);
                }
            }
        }
        if (t + 1 < ntiles) {
#pragma unroll
            for (int j = 0; j < 2; ++j) { *(LAS u32x4*)(L + B_KS + (buf ^ 1) * KBUF + kdst + j * 64 * KS_PITCH) = kreg[j]; *(LAS u32x4*)(L + B_VS + (buf ^ 1) * VBUF + vdst + j * 64 * 64) = vreg[j]; } }
        __syncthreads();
    }
    if (wave_on) {
        const float l0 = hsum32(lsum[0], lane), l1 = hsum32(lsum[1], lane);
        const float i0 = 1.0f / l0, i1 = lam / l1;
        float o[2][16], ss = 0.f;
#pragma unroll
        for (int d = 0; d < 2; ++d)
#pragma unroll
            for (int i = 0; i < 16; ++i) { o[d][i] = O[0][d][i] * i0 - O[1][d][i] * i1; ss += o[d][i] * o[d][i]; }
        ss = hsum32(ss, lane);
        const float rstd = rsqrtf(ss * (1.0f / 64.0f) + 1e-6f) * oscale;
        const float* gn = F.diff_norm + l * 64;
        if (!meta_u || r < NMETA) {
            _Float16* dst = (_Float16*)(F.ws + WS_ABUF) + (size_t)my_row * DM + 512 + hh * 64;
#pragma unroll
            for (int d = 0; d < 2; ++d)
#pragma unroll
                for (int g4 = 0; g4 < 4; ++g4) { const int d0 = 32 * d + 8 * g4 + 4 * h; const f32x4 gv = *(const f32x4*)(gn + d0);
                    u32x2 w; w.x = cvt_pk_f16(o[d][4 * g4 + 0] * rstd * gv[0], o[d][4 * g4 + 1] * rstd * gv[1]); w.y = cvt_pk_f16(o[d][4 * g4 + 2] * rstd * gv[2], o[d][4 * g4 + 3] * rstd * gv[3]);
                    *(u32x2*)(dst + d0) = w; }
        }
    }
}
__device__ __forceinline__ void mixB_phase(const Frame& F, int l) {
    const float* lp = F.diff_lambda + l * 128;
    float a = (F.lane < 32) ? lp[F.lane] * lp[32 + F.lane] : 0.f, c = (F.lane < 32) ? lp[64 + F.lane] * lp[96 + F.lane] : 0.f;
    a = wave_sum(a, F.lane); c = wave_sum(c, F.lane);
    const float linit = 0.8f - 0.6f * expf(-0.3f * (float)l);
    const float lam = expf(a) - expf(c) + linit, oscale = 1.0f - linit;
#pragma unroll 1
    for (int cidx = F.bid; cidx < 256; cidx += F.G) { const int bh = cidx & 7, i = cidx >> 3;
#pragma unroll 1
        for (int k = 0; k < 3; ++k) { if (k == 2 && cidx >= 8) break; mixB_unit(F, l, bh >> 2, bh & 3, k == 0 ? 63 - i : (k == 1 ? i : -1), lam, oscale); }
    }
}
__device__ __forceinline__ h8 tr_frag_nat(LAS unsigned char* img_blk, int rowbase, int s, int lane) {
    const int h = lane >> 5, blk = (lane >> 4) & 1, i16 = lane & 15, q = i16 >> 2, p = i16 & 3;
    LAS unsigned char* a = img_blk + (rowbase + 16 * s + 8 * h + q) * 64 + (16 * blk + 4 * p) * 2;
    const s16x4 lo = __builtin_amdgcn_ds_read_tr16_b64_v4i16((LAS s16x4*)a);
    const s16x4 hi = __builtin_amdgcn_ds_read_tr16_b64_v4i16((LAS s16x4*)(a + 4 * 64));
    return __builtin_bit_cast(h8, __builtin_shufflevector(lo, hi, 0, 1, 2, 3, 4, 5, 6, 7));
}
__device__ __forceinline__ h8 tr_frag_krow(LAS unsigned char* img_blk, int rowbase, int s, int lane) {
    const int h = lane >> 5, blk = (lane >> 4) & 1, i16 = lane & 15, q = i16 >> 2, p = i16 & 3;
    LAS unsigned char* a = img_blk + (rowbase + 16 * s + 4 * h + q) * 64 + (16 * blk + 4 * p) * 2;
    const s16x4 lo = __builtin_amdgcn_ds_read_tr16_b64_v4i16((LAS s16x4*)a);
    const s16x4 hi = __builtin_amdgcn_ds_read_tr16_b64_v4i16((LAS s16x4*)(a + 8 * 64));
    return __builtin_bit_cast(h8, __builtin_shufflevector(lo, hi, 0, 1, 2, 3, 4, 5, 6, 7));
}
__device__ __forceinline__ float ret_log2gamma(int hc) { return log2f(1.0f - exp2f(-5.0f - (float)hc)); }
__device__ __forceinline__ h8 scale_h8(const h8& v, float sc) { h8 o;
#pragma unroll
    for (int e = 0; e < 8; ++e) o[e] = (_Float16)((float)v[e] * sc);
    return o; }

__device__ __forceinline__ void mixC1_unit(const Frame& F, int b, int hp, int c) {
    LAS unsigned char* L = F.lds + LDS_GEN;
    const int tid = F.tid, lane = F.lane, wave = F.wave;
    const unsigned char* proj = F.ws + WS_PROJ;
    const int row0 = c == 0 ? MR + b * NMETA : b * SEQ + 128 * (c - 1), Lc = c == 0 ? NMETA : 128;
    __syncthreads();
#pragma unroll 1
    for (int idx = tid; idx < 4096; idx += NTHREADS) {
        const int head = idx >> 11, arr = (idx >> 10) & 1, j = (idx >> 3) & 127, ch = idx & 7, hc = 2 * hp + head;
        h8 v;
#pragma unroll
        for (int e = 0; e < 8; ++e) v[e] = (_Float16)0.f;
        if (j < Lc) { v = *(const h8*)(proj + (arr ? PJ_VC : PJ_KC) + (size_t)(row0 + j) * 512 + hc * 128 + ch * 16);
            if (arr) v = scale_h8(v, exp2f((float)(Lc - 1 - j) * ret_log2gamma(hc))); }
        *(LAS h8*)(L + head * 32768 + arr * 16384 + (ch >> 2) * 8192 + j * 64 + (ch & 3) * 16) = v;
    }
    __syncthreads();
    const int head = wave >> 2, mb = (wave >> 1) & 1, nb = wave & 1, r = lane & 31, h = lane >> 5;
    f32x16 acc;
#pragma unroll
    for (int i = 0; i < 16; ++i) acc[i] = 0.f;
#pragma unroll
    for (int s = 0; s < 8; ++s) { const h8 a = tr_frag_nat(L + head * 32768 + mb * 8192, 0, s, lane), bb = tr_frag_nat(L + head * 32768 + 16384 + nb * 8192, 0, s, lane);
        acc = __builtin_amdgcn_mfma_f32_32x32x16_f16(a, bb, acc, 0, 0, 0); }
    float* U = (float*)(F.ws + WS_U) + ((size_t)((b * 4 + 2 * hp + head) * 129 + c)) * 4096;
#pragma unroll
    for (int i = 0; i < 16; ++i) U[(32 * mb + crow(i, h)) * 64 + 32 * nb + r] = acc[i];
}
__device__ __forceinline__ void mixC1_phase(const Frame& F) {
#pragma unroll 1
    for (int u = F.bid; u < NB * 2 * 129; u += F.G) { const int c = u % 129, bh = u / 129; mixC1_unit(F, bh >> 1, bh & 1, c); }
}
__device__ __forceinline__ void mixC_scan(const Frame& F) {
    if (F.tid >= 128) return;
    const int e = F.bid * 128 + F.tid;
    if (e >= NB * 4 * 4096) return;
    const int bh = e >> 12, el = e & 4095, hc = bh & 3;
    const float lg = ret_log2gamma(hc), g128 = exp2f(128.f * lg), g16 = exp2f(16.f * lg);
    const float* U = (const float*)(F.ws + WS_U) + (size_t)bh * 129 * 4096 + el; float* S = (float*)(F.ws + WS_S) + (size_t)bh * 129 * 4096 + el;
    float st = U[0];
    S[4096] = st;
#pragma unroll 1
    for (int c0 = 1; c0 < 128; c0 += 16) {
        float u[16];
#pragma unroll
        for (int k = 0; k < 16; ++k) u[k] = (c0 + k < 128) ? U[(size_t)(c0 + k) * 4096] : 0.f;
#pragma unroll
        for (int k = 0; k < 16; ++k) if (c0 + k < 128) { st = st * g128 + u[k]; S[(size_t)(c0 + k + 1) * 4096] = st; }
    }
    (void)g16;
}
constexpr int C2_KI = 0, C2_VI = 128 * KS_PITCH, C2_ST = C2_VI + 16384, C2_HEAD = C2_ST + 64 * KS_PITCH;
__device__ __forceinline__ void mixC2_unit(const Frame& F, int l, int b, int hp, int c) {
    LAS unsigned char* L = F.lds + LDS_GEN;
    const int tid = F.tid, lane = F.lane, wave = F.wave, r = lane & 31, h = lane >> 5;
    const unsigned char* proj = F.ws + WS_PROJ;
    const int row0 = c == 0 ? MR + b * NMETA : b * SEQ + 128 * (c - 1), Lc = c == 0 ? NMETA : 128;
    __syncthreads();
#pragma unroll 1
    for (int idx = tid; idx < 4096; idx += NTHREADS) {
        const int head = idx >> 11, arr = (idx >> 10) & 1, j = (idx >> 3) & 127, ch = idx & 7, hc = 2 * hp + head;
        h8 v;
#pragma unroll
        for (int e = 0; e < 8; ++e) v[e] = (_Float16)0.f;
        if (j < Lc) v = *(const h8*)(proj + (arr ? PJ_VC : PJ_KC) + (size_t)(row0 + j) * 512 + hc * 128 + ch * 16);
        if (arr) *(LAS h8*)(L + head * C2_HEAD + C2_VI + (ch >> 2) * 8192 + j * 64 + (ch & 3) * 16) = v;
        else     *(LAS h8*)(L + head * C2_HEAD + C2_KI + j * KS_PITCH + ch * 16) = v;
    }
    if (c > 0) {
#pragma unroll 1
        for (int idx = tid; idx < 2 * 4096; idx += NTHREADS) { const int head = idx >> 12, el = idx & 4095, dk = el >> 6, dv = el & 63;
            const float v = ((const float*)(F.ws + WS_S))[((size_t)((b * 4 + 2 * hp + head) * 129 + c)) * 4096 + el];
            *(LAS _Float16*)(L + head * C2_HEAD + C2_ST + dv * KS_PITCH + dk * 2) = (_Float16)v; }
    }
    __syncthreads();
    const int head = wave >> 2, wq = wave & 3, hc = 2 * hp + head;
    if (wq * 32 < Lc) {
        LAS unsigned char* Hb = L + head * C2_HEAD;
        const int qi = wq * 32 + r, my_row = row0 + qi;
        const float lg = ret_log2gamma(hc);
        h8 qf[4];
#pragma unroll
        for (int s = 0; s < 4; ++s) qf[s] = *(const h8*)(proj + PJ_QC + (size_t)my_row * 512 + hc * 128 + (16 * s + 8 * h) * 2);
        f32x16 O[2];
#pragma unroll
        for (int d = 0; d < 2; ++d)
#pragma unroll
            for (int i = 0; i < 16; ++i) O[d][i] = 0.f;
        if (c > 0) {
#pragma unroll
            for (int d = 0; d < 2; ++d)
#pragma unroll
                for (int s = 0; s < 4; ++s) { const h8 a = *(const LAS h8*)(Hb + C2_ST + (32 * d + r) * KS_PITCH + (16 * s + 8 * h) * 2);
                    O[d] = __builtin_amdgcn_mfma_f32_32x32x16_f16(a, qf[s], O[d], 0, 0, 0); }
            const float qd = exp2f((float)(qi + 1) * lg);
#pragma unroll
            for (int d = 0; d < 2; ++d)
#pragma unroll
                for (int i = 0; i < 16; ++i) O[d][i] *= qd;
        }
#pragma unroll 1
        for (int jb = 0; jb <= wq; ++jb) {
            f32x16 S;
#pragma unroll
            for (int i = 0; i < 16; ++i) S[i] = 0.f;
#pragma unroll
            for (int s = 0; s < 4; ++s) { const h8 kf = *(const LAS h8*)(Hb + C2_KI + (32 * jb + r) * KS_PITCH + (16 * s + 8 * h) * 2);
                S = __builtin_amdgcn_mfma_f32_32x32x16_f16(kf, qf[s], S, 0, 0, 0); }
#pragma unroll
            for (int i = 0; i < 16; ++i) { const int dd = qi - (32 * jb + crow(i, h)); S[i] = dd >= 0 ? S[i] * exp2f((float)dd * lg) : 0.f; }
            h8 pf[2];
#pragma unroll
            for (int s = 0; s < 2; ++s) { u32x4 p; p.x = cvt_pk_f16(S[8 * s + 0], S[8 * s + 1]); p.y = cvt_pk_f16(S[8 * s + 2], S[8 * s + 3]); p.z = cvt_pk_f16(S[8 * s + 4], S[8 * s + 5]); p.w = cvt_pk_f16(S[8 * s + 6], S[8 * s + 7]); pf[s] = __builtin_bit_cast(h8, p); }
#pragma unroll
            for (int d = 0; d < 2; ++d)
#pragma unroll
                for (int s = 0; s < 2; ++s) { const h8 vf = tr_frag_krow(Hb + C2_VI + d * 8192, 32 * jb, s, lane);
                    O[d] = __builtin_amdgcn_mfma_f32_32x32x16_f16(vf, pf[s], O[d], 0, 0, 0); }
        }
        float ss = 0.f;
#pragma unroll
        for (int d = 0; d < 2; ++d)
#pragma unroll
            for (int i = 0; i < 16; ++i) ss += O[d][i] * O[d][i];
        ss = hsum32(ss, lane);
        const float rstd = rsqrtf(ss * (1.0f / 64.0f) + 1e-6f);
        if (qi < Lc) {
            const float* gn = F.ret_norm + l * 256 + hc * 64;
            const _Float16* gc = (const _Float16*)(proj + PJ_GC) + (size_t)my_row * 256 + hc * 64;
            _Float16* dst = (_Float16*)(F.ws + WS_ABUF) + (size_t)my_row * DM + 768 + hc * 64;
#pragma unroll
            for (int d = 0; d < 2; ++d)
#pragma unroll
                for (int g4 = 0; g4 < 4; ++g4) { const int d0 = 32 * d + 8 * g4 + 4 * h; const f32x4 gv = *(const f32x4*)(gn + d0); const h4 gg = *(const h4*)(gc + d0);
                    float o[4];
#pragma unroll
                    for (int e = 0; e < 4; ++e) { const float g = (float)gg[e]; o[e] = O[d][4 * g4 + e] * rstd * gv[e] * (g / (1.0f + __expf(-g))); }
                    u32x2 w; w.x = cvt_pk_f16(o[0], o[1]); w.y = cvt_pk_f16(o[2], o[3]); *(u32x2*)(dst + d0) = w; }
        }
    }
}
__device__ __forceinline__ void mixC2_phase(const Frame& F, int l) {
#pragma unroll 1
    for (int u = F.bid; u < NB * 2 * 129; u += F.G) { const int c = u % 129, bh = u / 129; mixC2_unit(F, l, bh >> 1, bh & 1, c); }
}
constexpr int IDX_HIST = 0, IDX_STATS = 16512, IDX_INFO = 18816, IDX_CCNT = 19072, IDX_MASK = 19456, IDX_CAND = 85248, IDX_Q = IDX_CAND + 32 * 128 * 8, IDX_QPITCH = 1168, IDX_END = IDX_Q + 32 * IDX_QPITCH;
#ifndef PROBE_REP
#define PROBE_REP 0
#endif
constexpr int IDX_CAP = 128, IDX_NBIN = 128;
static_assert(IDX_END + LDS_GEN <= LDS_BYTES, "indexer LDS");
struct KFrag { h8 v[4]; };
__device__ __forceinline__ KFrag idx_load_k(const unsigned char* krow_ptr, int h) { KFrag k;
#pragma unroll
    for (int s = 0; s < 4; ++s) k.v[s] = *(const h8*)(krow_ptr + (16 * s + 8 * h) * 2);
    return k; }
#define IDX_LOADQ(dst, hd) do { _Pragma("unroll") for (int s_ = 0; s_ < 4; ++s_) dst[s_] = *(const LAS h8*)(qimg_lane + ((hd) * 64 + 16 * s_) * 2); } while (0)
#define IDX_MFMA4(acc, q) do { _Pragma("unroll") for (int s_ = 0; s_ < 4; ++s_) acc = __builtin_amdgcn_mfma_f32_32x32x16_f16(kf.v[s_], q[s_], acc, 0, 0, 0); } while (0)
#define IDX_FMA(hd, S) do { _Pragma("unroll") for (int i_ = 0; i_ < 16; ++i_) sc[i_] = __builtin_fmaf(w[hd], __builtin_fabsf(S[i_]), sc[i_]); } while (0)
#define IDX_SB __builtin_amdgcn_sched_barrier(0)
__device__ __forceinline__ void idx_scores(const LAS unsigned char* qimg_lane, const float (&w)[8], const KFrag& kf, f32x16& sc) {
    h8 q[2][4]; f32x16 S[2];
    IDX_LOADQ(q[0], 8); IDX_SB;
#pragma unroll
    for (int i = 0; i < 16; ++i) sc[i] = 0.f;
    IDX_MFMA4(sc, q[0]); IDX_LOADQ(q[1], 0); IDX_SB;
#pragma unroll
    for (int hd = 0; hd < 8; ++hd) {
#pragma unroll
        for (int i = 0; i < 16; ++i) S[hd & 1][i] = 0.f;
        IDX_MFMA4(S[hd & 1], q[(hd + 1) & 1]);
        if (hd < 7) IDX_LOADQ(q[hd & 1], hd + 1);
        if (hd > 0) IDX_FMA(hd - 1, S[(hd - 1) & 1]);
        IDX_SB;
    }
    IDX_FMA(7, S[1]);
}
__device__ __forceinline__ int suffix_sum(int v, int lane) {
#pragma unroll
    for (int off = 1; off < 64; off <<= 1) { const int t = __builtin_amdgcn_ds_bpermute((lane + off) << 2, v); if (lane + off < 64) v += t; }
    return v;
}
__device__ __forceinline__ void mixA_index_unit(const Frame& F, int b, int g) {
    LAS unsigned char* L = F.lds + LDS_GEN;
    int tid_ = F.tid, lane_ = F.lane; asm volatile("" : "+v"(tid_), "+v"(lane_));
    const int tid = tid_, lane = lane_, wave = F.wave, r = lane & 31, h = lane >> 5;
    const unsigned char* proj = F.ws + WS_PROJ;
    const unsigned char* KI = proj + PJ_KI;
    const int nq = g == 0 ? NMETA : 32;
    const int qrow = g == 0 ? MR + b * NMETA + (r & 15) : b * SEQ + 32 * (g - 1) + r;
    const int tq0 = g == 0 ? 0 : NMETA + 32 * (g - 1);
    const bool qvalid = r < nq;
    auto ks_row0 = [&](int ks) -> int { return ks == 0 ? MR + b * NMETA : b * SEQ + 32 * (ks - 1); };
    __syncthreads();
    for (int i = tid; i < 32 * 129; i += NTHREADS) ((LAS unsigned*)(L + IDX_HIST))[i] = 0u;
    if (tid < 32) ((LAS unsigned*)(L + IDX_CCNT))[tid] = 0u;
    for (int i = tid; i < (g + 1) * 32; i += NTHREADS) ((LAS unsigned*)(L + IDX_MASK))[i] = 0u;
    float w[8];
    const LAS unsigned char* qf = L + IDX_Q + r * IDX_QPITCH + 8 * h * 2;
    { const float* WI = (const float*)(proj + PJ_WI) + (size_t)qrow * 8; const f32x4 w0 = *(const f32x4*)WI, w1 = *(const f32x4*)(WI + 4);
      w[0] = w0[0]; w[1] = w0[1]; w[2] = w0[2]; w[3] = w0[3]; w[4] = w1[0]; w[5] = w1[1]; w[6] = w1[2]; w[7] = w1[3]; }
    { const int qq = tid >> 4, dc = tid & 15; const int qr = g == 0 ? MR + b * NMETA + (qq & 15) : b * SEQ + 32 * (g - 1) + qq;
      const unsigned char* qsrc = proj + PJ_QI + (size_t)qr * 1024 + dc * 8; u32x2 qv[8];
#pragma unroll
      for (int hd = 0; hd < 8; ++hd) qv[hd] = *(const u32x2*)(qsrc + hd * 128);
      const float* WQ = (const float*)(proj + PJ_WI) + (size_t)qr * 8; const f32x4 wa = *(const f32x4*)WQ, wb = *(const f32x4*)(WQ + 4);
      const float wq[8] = {wa[0], wa[1], wa[2], wa[3], wb[0], wb[1], wb[2], wb[3]};
      float a4[4] = {0.f, 0.f, 0.f, 0.f};
#pragma unroll
      for (int hd = 0; hd < 8; ++hd) { const h4 q = __builtin_bit_cast(h4, qv[hd]);
#pragma unroll
          for (int e = 0; e < 4; ++e) a4[e] += wq[hd] * (float)q[e];
          *(LAS u32x2*)(L + IDX_Q + qq * IDX_QPITCH + hd * 128 + dc * 8) = qv[hd]; }
      u32x2 o; o.x = cvt_pk_f16(a4[0], a4[1]); o.y = cvt_pk_f16(a4[2], a4[3]);
      *(LAS u32x2*)(L + IDX_Q + qq * IDX_QPITCH + 1024 + dc * 8) = o; }
    __syncthreads();
    if (wave < 4) {
        const KFrag kf = idx_load_k(KI + (size_t)(b * SEQ + 32 * wave + r) * 128, h);
        f32x16 sc; idx_scores(qf, w, kf, sc);
        float s1 = 0.f, s2 = 0.f;
#pragma unroll
        for (int i = 0; i < 16; ++i) { s1 += sc[i]; s2 += sc[i] * sc[i]; }
        s1 = hsum32(s1, lane); s2 = hsum32(s2, lane);
        if (h == 0) { ((LAS float*)(L + IDX_STATS))[(wave * 32 + r) * 2] = s1; ((LAS float*)(L + IDX_STATS))[(wave * 32 + r) * 2 + 1] = s2; }
    }
    __syncthreads();
    float c0f, inv;
    { float s1 = 0.f, s2 = 0.f;
#pragma unroll
      for (int k = 0; k < 4; ++k) { s1 += ((LAS float*)(L + IDX_STATS))[(k * 32 + r) * 2]; s2 += ((LAS float*)(L + IDX_STATS))[(k * 32 + r) * 2 + 1]; }
      const float mean = s1 * (1.0f / 128.0f), var = fmaxf(s2 * (1.0f / 128.0f) - mean * mean, 0.f), sd = fmaxf(sqrtf(var), 1e-12f);
      inv = (float)IDX_NBIN / (10.0f * sd); c0f = -(mean - 3.0f * sd) * inv; }
    LAS unsigned* hrow = (LAS unsigned*)(L + IDX_HIST) + r * 129;
#if PROBE_REP == 12
    for (int rep12 = 0; rep12 < 2; ++rep12) { __syncthreads(); for (int i = tid; i < 32 * 129; i += NTHREADS) ((LAS unsigned*)(L + IDX_HIST))[i] = 0u; __syncthreads();
#else
    {
#endif
        KFrag kf = idx_load_k(KI + (size_t)(ks_row0(wave <= g ? wave : 0) + r) * 128, h);
#pragma unroll 1
        for (int ks = wave; ks <= g; ks += 8) {
            const KFrag kn = idx_load_k(KI + (size_t)(ks_row0(ks + 8 <= g ? ks + 8 : ks) + r) * 128, h);
            f32x16 sc; idx_scores(qf, w, kf, sc);
#if PROBE_REP == 11
            { f32x16 sc2; idx_scores(qf, w, kn, sc2); if (sc2[0] == 1.2345e30f) inv = 0.f; }
#endif
            if (ks == 0 || ks == g) {
#pragma unroll
                for (int i = 0; i < 16; ++i) {
                    const int kidx = crow(i, h);
                    const bool ok = qvalid && (ks == 0 ? kidx < NMETA && (g > 0 || kidx <= r) : kidx <= r);
                    if (ok) { const unsigned bin = (unsigned)__builtin_amdgcn_fmed3f(__builtin_fmaf(sc[i], inv, c0f), 0.f, (float)(IDX_NBIN - 1)); __hip_atomic_fetch_add(hrow + bin, 1u, __ATOMIC_RELAXED, __HIP_MEMORY_SCOPE_WORKGROUP); }
                }
            } else {
#pragma unroll
                for (int i = 0; i < 16; ++i) { const unsigned bin = (unsigned)__builtin_amdgcn_fmed3f(__builtin_fmaf(sc[i], inv, c0f), 0.f, (float)(IDX_NBIN - 1)); __hip_atomic_fetch_add(hrow + bin, 1u, __ATOMIC_RELAXED, __HIP_MEMORY_SCOPE_WORKGROUP); }
            }
            kf = kn;
        }
    }
    __syncthreads();
#pragma unroll 1
    for (int k = 0; k < 4; ++k) {
        const int row = 4 * wave + k;
        const int c0 = (int)((LAS unsigned*)(L + IDX_HIST))[row * 129 + 2 * lane], c1 = (int)((LAS unsigned*)(L + IDX_HIST))[row * 129 + 2 * lane + 1];
        const int SL = suffix_sum(c0 + c1, lane), NT = __builtin_amdgcn_readlane(SL, 0);
        int bstar = -1, need = 0;
        if (NT > 256) {
            const unsigned long long ml = __ballot(SL >= 256); const int lL = 63 - __builtin_clzll(ml); const int sl = __builtin_amdgcn_readlane(SL, lL), t0 = __builtin_amdgcn_readlane(c0, lL), t1 = __builtin_amdgcn_readlane(c1, lL); const int above = sl - t0 - t1;
            if (above + t1 >= 256) { bstar = 2 * lL + 1; need = 256 - above; } else { bstar = 2 * lL; need = 256 - above - t1; }
        }
        if (lane == 0) { ((LAS int*)(L + IDX_INFO))[row * 2] = bstar; ((LAS int*)(L + IDX_INFO))[row * 2 + 1] = need; }
    }
    __syncthreads();
    float lo_f, hi_f;
    { const int bstar = ((LAS int*)(L + IDX_INFO))[r * 2];
      hi_f = bstar < 0 ? -__builtin_inff() : (bstar >= IDX_NBIN - 1 ? __builtin_inff() : (float)(bstar + 1));
      lo_f = bstar <= 0 ? -__builtin_inff() : (float)bstar; }
    {
        KFrag kf = idx_load_k(KI + (size_t)(ks_row0(wave <= g ? wave : 0) + r) * 128, h);
#pragma unroll 1
        for (int ks = wave; ks <= g; ks += 8) {
            const KFrag kn = idx_load_k(KI + (size_t)(ks_row0(ks + 8 <= g ? ks + 8 : ks) + r) * 128, h);
            f32x16 sc; idx_scores(qf, w, kf, sc);
            unsigned part = 0u;
            const bool special = (ks == 0 || ks == g);
#pragma unroll
            for (int i = 0; i < 16; ++i) {
                const int kidx = crow(i, h);
                bool ok = true;
                if (special) ok = qvalid && (ks == 0 ? kidx < NMETA && (g > 0 || kidx <= r) : kidx <= r);
                const float x = __builtin_fmaf(sc[i], inv, c0f);
                const bool sure = ok && (x >= hi_f), cand = ok && !(x >= hi_f) && (x >= lo_f);
                part |= sure ? (1u << kidx) : 0u;
                if (cand) { const unsigned slot = __hip_atomic_fetch_add((LAS unsigned*)(L + IDX_CCNT) + r, 1u, __ATOMIC_RELAXED, __HIP_MEMORY_SCOPE_WORKGROUP);
                    if (slot < IDX_CAP) { LAS float* cp = (LAS float*)(L + IDX_CAND) + (r * IDX_CAP + slot) * 2; cp[0] = sc[i]; ((LAS int*)cp)[1] = ks * 32 + kidx; } }
            }
            __hip_atomic_fetch_or((LAS unsigned*)(L + IDX_MASK) + ks * 32 + r, part, __ATOMIC_RELAXED, __HIP_MEMORY_SCOPE_WORKGROUP);
            kf = kn;
        }
    }
    __syncthreads();
#pragma unroll 1
    for (int k = 0; k < 4; ++k) {
        const int row = 4 * wave + k;
        const int need = ((LAS int*)(L + IDX_INFO))[row * 2 + 1];
        int nc = (int)((LAS unsigned*)(L + IDX_CCNT))[row]; nc = nc < IDX_CAP ? nc : IDX_CAP;
        nc = __builtin_amdgcn_readfirstlane(nc);
        if (nc == 0) continue;
        const LAS float* cb = (const LAS float*)(L + IDX_CAND) + row * IDX_CAP * 2;
        const bool v0 = lane < nc, v1 = lane + 64 < nc;
        const float s0 = v0 ? cb[lane * 2] : 0.f, s1 = v1 ? cb[(lane + 64) * 2] : 0.f;
        const int k0 = v0 ? ((const LAS int*)cb)[lane * 2 + 1] : 0, k1 = v1 ? ((const LAS int*)cb)[(lane + 64) * 2 + 1] : 0;
        int r0 = 0, r1 = 0;
        if (__builtin_amdgcn_readfirstlane(need) < nc) {
            const int n0 = nc < 64 ? nc : 64;
#pragma unroll 1
            for (int j = 0; j < n0; ++j) { const float sj = __builtin_bit_cast(float, __builtin_amdgcn_readlane(__builtin_bit_cast(int, s0), j)); const int kj = __builtin_amdgcn_readlane(k0, j);
                r0 += (sj > s0 || (sj == s0 && kj < k0)) ? 1 : 0; r1 += (sj > s1 || (sj == s1 && kj < k1)) ? 1 : 0; }
#pragma unroll 1
            for (int j = 64; j < nc; ++j) { const float sj = __builtin_bit_cast(float, __builtin_amdgcn_readlane(__builtin_bit_cast(int, s1), j - 64)); const int kj = __builtin_amdgcn_readlane(k1, j - 64);
                r0 += (sj > s0 || (sj == s0 && kj < k0)) ? 1 : 0; r1 += (sj > s1 || (sj == s1 && kj < k1)) ? 1 : 0; }
        }
        if (v0 && r0 < need) __hip_atomic_fetch_or((LAS unsigned*)(L + IDX_MASK) + (k0 >> 5) * 32 + row, 1u << (k0 & 31), __ATOMIC_RELAXED, __HIP_MEMORY_SCOPE_WORKGROUP);
        if (v1 && r1 < need) __hip_atomic_fetch_or((LAS unsigned*)(L + IDX_MASK) + (k1 >> 5) * 32 + row, 1u << (k1 & 31), __ATOMIC_RELAXED, __HIP_MEMORY_SCOPE_WORKGROUP);
    }
    __syncthreads();
    unsigned* MK = (unsigned*)(F.ws + WS_MASK) + (size_t)b * NKS * TLEN;
    for (int i = tid; i < (g + 1) * 32; i += NTHREADS) { const int ks = i >> 5, rr = i & 31; if (rr < nq) MK[(size_t)ks * TLEN + tq0 + rr] = ((LAS unsigned*)(L + IDX_MASK))[i]; }
}
__device__ __forceinline__ void mixA_index_phase(const Frame& F) {
#pragma unroll 1
    for (int c = F.bid; c < 256; c += F.G) {
#pragma unroll 1
        for (int k = 0; k < 5; ++k) {
            int u; if (k == 0) u = c; else if (k == 1) u = 511 - c; else if (k == 2) u = 512 + c; else if (k == 3) u = 1023 - c; else { if (c >= 2) break; u = 1024 + c; }
            mixA_index_unit(F, u & 1, 512 - (u >> 1));
        }
    }
}

__device__ __forceinline__ void mixA3_unit(const Frame& F, int l, int b, int ha, int qblk) {
    LAS unsigned char* L = F.lds + LDS_GEN;
    const int tid = F.tid, lane = F.lane, wave = F.wave, r = lane & 31, h = lane >> 5;
    const unsigned char* proj = F.ws + WS_PROJ;
    const _Float16* QA = (const _Float16*)(proj + PJ_QA); const unsigned char* KA = proj + PJ_KA; const unsigned char* VA = proj + PJ_VA;
    const unsigned* kmax = (const unsigned*)(F.ws + WS_CTL) + CW_KMAX + 32 * l;
    const unsigned* MK = (const unsigned*)(F.ws + WS_MASK) + (size_t)b * NKS * TLEN;
    const bool meta_u = qblk < 0;
    const int qrow0 = meta_u ? MR + b * NMETA : b * SEQ + qblk * 256;
    const int qpos0 = meta_u ? 0 : NMETA + qblk * 256;
    const int nreal = meta_u ? 0 : 2 * qblk + 2;
    const int wq0 = 32 * wave;
    const bool wave_on = meta_u ? (wave == 0) : true;
    const int my_row = wave_on ? qrow0 + wq0 + r : qrow0, my_pos = wave_on ? qpos0 + wq0 + r : 0;
    __syncthreads();
    if (tid < 128) ((LAS float*)(L + B_LUT))[tid] = F.rel_bias[BUCKET_LUT[tid] * 12 + ha] * LOG2E;
    float bmax = (lane < 32) ? F.rel_bias[lane * 12 + ha] * LOG2E : -1e30f;
    bmax = fmaxf(bmax, sx<16>(bmax, lane)); bmax = fmaxf(bmax, sx<8>(bmax, lane)); bmax = fmaxf(bmax, sx<4>(bmax, lane)); bmax = fmaxf(bmax, sx<2>(bmax, lane)); bmax = fmaxf(bmax, sx<1>(bmax, lane));
    bmax = bcast0(bmax);
    const float bfar = F.rel_bias[31 * 12 + ha] * LOG2E;
    h8 qf[4]; float mref; bool safe;
    { float n2 = 0.f;
#pragma unroll
      for (int s = 0; s < 4; ++s) { qf[s] = *(const h8*)(QA + (size_t)my_row * 512 + ha * 64 + 16 * s + 8 * h);
#pragma unroll
          for (int j = 0; j < 8; ++j) { const float v = (float)qf[s][j]; n2 += v * v; } }
      n2 = hsum32(n2, lane);
      mref = sqrtf(n2 * (__uint_as_float(kmax[ha * 2]) + __uint_as_float(kmax[ha * 2 + 1]))) * 1.002f + bmax;
      safe = __all(mref - bfar < 60.0f); if (safe) mref = bfar; }
    f32x16 O[2], Lacc;
#pragma unroll
    for (int i = 0; i < 16; ++i) { O[0][i] = 0.f; O[1][i] = 0.f; Lacc[i] = 0.f; }
    bf16x8v ones; { const u32x4 o = {0x3F803F80u, 0x3F803F80u, 0x3F803F80u, 0x3F803F80u}; ones = __builtin_bit_cast(bf16x8v, o); }
    const int skey = tid >> 3, sch = tid & 7;
    const unsigned kdst = skey * KS_PITCH + sch * 16, vdst = (sch >> 2) * (TK * 64) + skey * 64 + (sch & 3) * 16;
    const int ntiles = 1 + nreal;
    auto tile_row0 = [&](int t) -> int { return t == 0 ? MR + b * NMETA : b * SEQ + (t - 1) * TK; };
    u32x4 kreg[2], vreg[2];
#pragma unroll
    for (int j = 0; j < 2; ++j) { const size_t rr = (size_t)(tile_row0(0) + skey + 64 * j); kreg[j] = *(const u32x4*)(KA + rr * 1024 + ha * 128 + sch * 16); vreg[j] = *(const u32x4*)(VA + rr * 1024 + ha * 128 + sch * 16); }
#pragma unroll
    for (int j = 0; j < 2; ++j) { *(LAS u32x4*)(L + B_KS + kdst + j * 64 * KS_PITCH) = kreg[j]; *(LAS u32x4*)(L + B_VS + vdst + j * 64 * 64) = vreg[j]; }
    __syncthreads();
    unsigned mw[4], mwn[4] = {0u, 0u, 0u, 0u};
    mw[0] = MK[my_pos]; mw[1] = 0u; mw[2] = 0u; mw[3] = 0u;
    const int wpos0 = qpos0 + wq0;
#pragma unroll 1
    for (int t = 0; t < ntiles; ++t) {
        const int buf = t & 1;
        if (t + 1 < ntiles) {
#pragma unroll
            for (int j = 0; j < 2; ++j) { const size_t rr = (size_t)(tile_row0(t + 1) + skey + 64 * j); kreg[j] = *(const u32x4*)(KA + rr * 1024 + ha * 128 + sch * 16); vreg[j] = *(const u32x4*)(VA + rr * 1024 + ha * 128 + sch * 16); }
#pragma unroll
            for (int j = 0; j < 4; ++j) mwn[j] = MK[(size_t)(1 + 4 * t + j) * TLEN + my_pos]; }
        const int kpos0 = (t == 0) ? 0 : NMETA + (t - 1) * TK, nvalid = (t == 0) ? NMETA : TK;
        if (wave_on && kpos0 <= wpos0 + 31) {
            LAS unsigned char* Kb = L + B_KS + buf * KBUF; LAS unsigned char* Vb = L + B_VS + buf * VBUF;
#pragma unroll
            for (int sub = 0; sub < 4; ++sub) {
                if (sub * 32 >= nvalid || kpos0 + sub * 32 > wpos0 + 31) continue;
                const bool slow = !safe || (t == 0) || (kpos0 + sub * 32 + 31 > wpos0 - 128);
                const unsigned mword = mw[sub] >> (4 * h);
                f32x16 S;
                h8 kfr[4]; bf16x8v vfr[2][2];
#pragma unroll
                for (int s = 0; s < 4; ++s) kfr[s] = *(const LAS h8*)(Kb + (sub * 32 + r) * KS_PITCH + (16 * s + 8 * h) * 2);
#pragma unroll
                for (int d = 0; d < 2; ++d)
#pragma unroll
                    for (int s = 0; s < 2; ++s) vfr[d][s] = vt_frag(Vb, d, sub * 32, s, lane);
                __builtin_amdgcn_sched_barrier(0);
#pragma unroll
                for (int i = 0; i < 16; ++i) S[i] = 0.f;
#pragma unroll
                for (int s = 0; s < 4; ++s) S = __builtin_amdgcn_mfma_f32_32x32x16_f16(kfr[s], qf[s], S, 0, 0, 0);
                bf16x8v pf[2];
                if (slow) {
                    float bs[16];
#pragma unroll
                    for (int i = 0; i < 16; ++i) { const int dist = my_pos - (kpos0 + sub * 32 + crow(i, h)); bs[i] = ((const LAS float*)(L + B_LUT))[min(max(dist, 0), 127)]; }
#pragma unroll
                    for (int i = 0; i < 16; ++i) {
                        const int kidx = sub * 32 + crow(i, h), dist = my_pos - (kpos0 + kidx);
                        const bool ok = ((mword >> ((i & 3) + 8 * (i >> 2))) & 1u) != 0u && dist >= 0 && kidx < nvalid;
                        const float e = __builtin_amdgcn_exp2f(fminf(S[i] + (bs[i] - mref), 80.f));
                        S[i] = ok ? e : 0.f;
                    }
                    pf[0] = pack_p(S, 0); pf[1] = pack_p(S, 1);
                } else {
#pragma unroll
                    for (int i = 0; i < 16; ++i) S[i] = __uint_as_float(__float_as_uint(__builtin_amdgcn_exp2f(S[i])) & (unsigned)__builtin_amdgcn_sbfe((int)mword, (i & 3) + 8 * (i >> 2), 1));
                    pf[0] = pack_p(S, 0); pf[1] = pack_p(S, 1);
                }
#pragma unroll
                for (int s = 0; s < 2; ++s) { Lacc = __builtin_amdgcn_mfma_f32_32x32x16_bf16(ones, pf[s], Lacc, 0, 0, 0);
#pragma unroll
                    for (int d = 0; d < 2; ++d) O[d] = __builtin_amdgcn_mfma_f32_32x32x16_bf16(vfr[d][s], pf[s], O[d], 0, 0, 0); }
            }
        }
        if (t + 1 < ntiles) {
#pragma unroll
            for (int j = 0; j < 2; ++j) { *(LAS u32x4*)(L + B_KS + (buf ^ 1) * KBUF + kdst + j * 64 * KS_PITCH) = kreg[j]; *(LAS u32x4*)(L + B_VS + (buf ^ 1) * VBUF + vdst + j * 64 * 64) = vreg[j]; } }
#pragma unroll
        for (int j = 0; j < 4; ++j) mw[j] = mwn[j];
        __syncthreads();
    }
    if (wave_on) {
        const float il = 1.0f / Lacc[0];
        if (!meta_u || r < NMETA) {
            _Float16* dst = (_Float16*)(F.ws + WS_ABUF) + (size_t)my_row * DM + ha * 64;
#pragma unroll
            for (int d = 0; d < 2; ++d)
#pragma unroll
                for (int g4 = 0; g4 < 4; ++g4) { const int d0 = 32 * d + 8 * g4 + 4 * h;
                    u32x2 w; w.x = cvt_pk_f16(O[d][4 * g4 + 0] * il, O[d][4 * g4 + 1] * il); w.y = cvt_pk_f16(O[d][4 * g4 + 2] * il, O[d][4 * g4 + 3] * il);
                    *(u32x2*)(dst + d0) = w; }
        }
    }
}
__device__ __forceinline__ void mixA3_phase(const Frame& F, int l) {
#pragma unroll 1
    for (int c = F.bid; c < 256; c += F.G) { const int bh = c & 15, i1 = c >> 4, i2 = 31 - i1;
#pragma unroll 1
        for (int k = 0; k < 5; ++k) { if (k == 4 && c >= 16) break;
            const int qb = k == 0 ? 63 - i1 : (k == 1 ? 32 + i1 : (k == 2 ? i2 : (k == 3 ? i1 : -1)));
            mixA3_unit(F, l, bh >> 3, bh & 7, qb); }
    }
}
constexpr int NPHASES = 19;
__global__ void __launch_bounds__(NTHREADS, 2) fwd(Args args) {
    extern __shared__ __attribute__((aligned(16))) unsigned char lds_raw[];
    Frame F;
    F.x = args.in[0]; F.meta = args.in[1]; F.rel_bias = args.in[2]; F.w_in = args.in[3]; F.norm_mix = args.in[4]; F.diff_lambda = args.in[5]; F.diff_norm = args.in[6];
    F.ret_norm = args.in[7]; F.w_out = args.in[8]; F.norm_ff = args.in[9]; F.w_ff1 = args.in[10]; F.w_ff2 = args.in[11]; F.final_norm = args.in[12];
    F.out = args.out; F.ws = args.ws; F.lds = (LAS unsigned char*)lds_raw;
    F.bid = blockIdx.x; F.G = gridDim.x; F.tid = threadIdx.x; F.lane = F.tid & 63; F.wave = __builtin_amdgcn_readfirstlane(F.tid >> 6);
    if (F.tid < 64) ((LAS unsigned*)(F.lds + LDS_MISC))[F.tid] = 0u;
    __syncthreads();
    unsigned* ctl = (unsigned*)(F.ws + WS_CTL);
    XcdBarrier bar = xcd_barrier_post(ctl + CW_BAR, (volatile LAS unsigned*)(F.lds + LDS_MISC));
    const int lo = args.ph_lo, hi = args.ph_hi;
#define IN(k) (lo <= (k) && (k) < hi)
#ifndef PROBE_REP
#define PROBE_REP 0
#endif
#define RETID() do { unsigned z0_ = 0u; asm volatile("" : "+s"(z0_)); int t_ = (int)__builtin_amdgcn_mbcnt_hi(~0u, __builtin_amdgcn_mbcnt_lo(~0u, z0_)); asm volatile("" : "+v"(t_)); F.lane = t_; F.tid = F.wave * 64 + t_; } while (0)
#define REP(k) _Pragma("unroll 1") for (int rep_ = 0; rep_ < ((PROBE_REP == (k)) ? 2 : 1); ++rep_)
#define SEAM(k) do { if (IN(k) && IN((k) + 1)) xcd_barrier(bar, F.wave == 0 && F.lane == 0); } while (0)
    LAS unsigned char* stage = F.lds + LDS_GEN;
    if (IN(0)) { REP(10) prologue(F); SEAM(0);
#if PROBE_REP == 20
        for (int xb = 0; xb < 20; ++xb) xcd_barrier(bar, F.wave == 0 && F.lane == 0);
#endif
    }
#pragma unroll 1
    for (int l = 0; l < DEPTH; ++l) {
        const int pb = 1 + 9 * l;
        { RETID();
          size_t z_ = 0; int b_ = blockIdx.x, g_ = gridDim.x; asm volatile("" : "+s"(z_), "+s"(b_), "+s"(g_)); F.ws = args.ws + z_; F.out = args.out + z_; F.bid = b_; F.G = g_; }
        unsigned char* wl = F.ws + WS_W + (size_t)l * W_LAYER;
        unsigned char* proj = F.ws + WS_PROJ;
        if (IN(pb + 0)) {
            pg8::Gemm g{(const pg8::bf16_t*)(F.ws + WS_ABUF), (const pg8::bf16_t*)(wl + W_IN_OFF), MP, NPAD, DM}; pg8::StaticOrder S; S.init(MP, NPAD, F.G, F.bid);
            EpiInProj E{proj, (const f32x2*)(F.ws + WS_ROPE), ctl + CW_KMAX + 32 * l};
            pg8::gemm_phase<EpiInProj, pg8::StaticOrder, true, true>(stage, g, S, E, F.tid);
#if PROBE_REP == 7
            RETID(); pg8::gemm_phase<EpiInProj, pg8::StaticOrder, true, true>(stage, g, S, E, F.tid);
#endif
            SEAM(pb + 0);
        }
        if (IN(pb + 1)) { RETID(); REP(1) mixA_index_phase(F); RETID(); REP(2) mixC1_phase(F); SEAM(pb + 1); }
        if (IN(pb + 2)) { RETID(); REP(3) mixC_scan(F); RETID(); REP(4) mixB_phase(F, l); SEAM(pb + 2); }
        if (IN(pb + 3)) { RETID(); REP(5) mixA3_phase(F, l); RETID(); REP(6) mixC2_phase(F, l); SEAM(pb + 3); }
        if (IN(pb + 4)) { RETID();
            skinny_meta<0>(F, wl); RETID();
            pg8::Gemm g{(const pg8::bf16_t*)(F.ws + WS_ABUF), (const pg8::bf16_t*)(wl + W_OUT_OFF), MR, DM, DM}; pg8::StaticOrder S; S.init(MR, DM, F.G, F.bid);
            EpiRes E{l == 0 ? F.x : F.out, F.out, (float*)(F.ws + WS_HMETA)};
            pg8::gemm_phase<EpiRes, pg8::StaticOrder, true, true>(stage, g, S, E, F.tid);
            SEAM(pb + 4);
        }
        if (IN(pb + 5)) { RETID(); zero_scr(F); REP(8) norm_to_abuf<1>(F, F.norm_ff + (size_t)l * DM); SEAM(pb + 5); }
        if (IN(pb + 6)) { RETID();
            skinny_meta<1>(F, wl); RETID();
            pg8::Gemm g{(const pg8::bf16_t*)(F.ws + WS_ABUF), (const pg8::bf16_t*)(wl + W_FF1_OFF), MR, DFF, DM}; pg8::StaticOrder S; S.init(MR, DFF, F.G, F.bid);
            EpiRelu2 E{proj};
            pg8::gemm_phase<EpiRelu2, pg8::StaticOrder, true, true>(stage, g, S, E, F.tid);
#if PROBE_REP == 9
            RETID(); pg8::gemm_phase<EpiRelu2, pg8::StaticOrder, true, true>(stage, g, S, E, F.tid);
#endif
            SEAM(pb + 6);
        }
        if (IN(pb + 7)) { RETID();
            skinny_meta<2>(F, wl); RETID();
            pg8::Gemm g{(const pg8::bf16_t*)proj, (const pg8::bf16_t*)(wl + W_FF2_OFF), MR, DM, DFF}; pg8::StaticOrder S; S.init(MR, DM, F.G, F.bid);
            EpiRes E{F.out, F.out, (float*)(F.ws + WS_HMETA)};
#if PROBE_REP == 14
            { EpiRes E2{F.out, (float*)(F.ws + WS_ABUF), (float*)(F.ws + WS_U)}; pg8::gemm_phase<EpiRes, pg8::StaticOrder, true, true>(stage, g, S, E2, F.tid); RETID(); }
#endif
            pg8::gemm_phase<EpiRes, pg8::StaticOrder, true, true>(stage, g, S, E, F.tid);
            SEAM(pb + 7);
        }
        if (IN(pb + 8)) { RETID();
            if (l + 1 < DEPTH) { norm_to_abuf<1>(F, F.norm_mix + (size_t)(l + 1) * DM); SEAM(pb + 8); }
            else final_norm(F);
        }
    }
#undef IN
#undef SEAM
}

#ifndef MK_SPLIT
#define MK_SPLIT 0
#endif
extern "C" void kernel_launch(void* const* d_in, const int* in_sizes, int n_in, void* d_out, int out_size, void* d_ws, size_t ws_size, hipStream_t stream) {
    static int grid = 0;
    if (grid == 0) {
        if (n_in != 13 || ws_size < WS_END) { fprintf(stderr, "kernel_launch: need 13 inputs and %zu bytes of workspace; got %d, %zu\n", (size_t)WS_END, n_in, ws_size); grid = -1; return; }
        int dev = 0, cus = 0, per_cu = 0;
        if (hipGetDevice(&dev) != hipSuccess || hipDeviceGetAttribute(&cus, hipDeviceAttributeMultiprocessorCount, dev) != hipSuccess) { grid = -1; return; }
        if (hipFuncSetAttribute((const void*)fwd, hipFuncAttributeMaxDynamicSharedMemorySize, LDS_BYTES) != hipSuccess) { fprintf(stderr, "kernel_launch: hipFuncSetAttribute failed\n"); grid = -1; return; }
        if (hipOccupancyMaxActiveBlocksPerMultiprocessor(&per_cu, (const void*)fwd, NTHREADS, LDS_BYTES) != hipSuccess || per_cu < 1) { fprintf(stderr, "kernel_launch: occupancy query says %d\n", per_cu); }
        (void)hipGetLastError();
        grid = cus;
    }
    if (grid < 0) return;
    (void)hipMemsetAsync((char*)d_ws + WS_CTL, 0, CTL_BYTES, stream);
    Args a{};
    for (int i = 0; i < 13; ++i) a.in[i] = (const float*)d_in[i];
    a.out = (float*)d_out; a.ws = (unsigned char*)d_ws;
#if MK_SPLIT
    for (int p = 0; p < NPHASES; ++p) { a.ph_lo = p; a.ph_hi = p + 1; hipLaunchKernelGGL(fwd, dim3(grid), dim3(NTHREADS), LDS_BYTES, stream, a); }
#else
    a.ph_lo = 0; a.ph_hi = NPHASES; hipLaunchKernelGGL(fwd, dim3(grid), dim3(NTHREADS), LDS_BYTES, stream, a);
#endif
}
```

```cpp
#include <hip/hip_runtime.h>
#include <cstdio>
#include <cstdint>
typedef _Float16 h8 __attribute__((ext_vector_type(8)));
typedef _Float16 h4 __attribute__((ext_vector_type(4)));
typedef _Float16 h2 __attribute__((ext_vector_type(2)));
typedef short s16x8 __attribute__((ext_vector_type(8)));
typedef short s16x4 __attribute__((ext_vector_type(4)));
typedef float f32x16 __attribute__((ext_vector_type(16)));
typedef float f32x2 __attribute__((ext_vector_type(2)));
typedef unsigned u32x2 __attribute__((ext_vector_type(2)));
namespace pg8 {
#define PG8_LAS __attribute__((address_space(3)))
typedef unsigned short bf16_t;
typedef short bf16x8 __attribute__((ext_vector_type(8)));
typedef float f32x4 __attribute__((ext_vector_type(4)));
typedef unsigned u32x4 __attribute__((ext_vector_type(4)));
constexpr int BM = 256, BK = 64, HALF = 128, HTB = HALF * BK * 2  , STAGE_BYTES = 8 * HTB, NXCD = 8, WGM = 8;

__host__ __device__ __forceinline__ int lds_byte(int r, int c) { const int st = (r >> 4) * 2 + (c >> 5), rr = r & 15, cc = c & 31, ob = rr * 64 + cc * 2; return st * 1024 + (ob ^ (((ob >> 9) & 1) << 5)); }
__host__ __device__ __forceinline__ void stage_rc(int b, int& R, int& C) { const int st = b / 1024, sb = b % 1024, swz = sb ^ (((sb >> 9) & 1) << 5); R = (st >> 1) * 16 + swz / 64; C = (st & 1) * 32 + (swz % 64) / 2; }
__host__ __device__ __forceinline__ int perm32(int rho) { const int n = rho >> 4, i = rho & 15; return 8 * (i >> 2) + 4 * n + (i & 3); }

struct Unit { int pm, pn; };
struct Gemm { const bf16_t* A; const bf16_t* Bt; int M, N, K; };

struct StaticOrder {
    int nM, nN, nwg, G, c;
    __host__ __device__ void init(int M, int N, int G_, int c_) { nM = M / BM; nN = N / BM; nwg = nM * nN; G = G_; c = c_; }
    __host__ __device__ bool next(int i, Unit& u) const {
        const long L = (long)i * G + c; if (L >= nwg) return false;
        int wgid = (int)L; { const int q = nwg / NXCD, r = nwg % NXCD, xcd = wgid % NXCD, off = wgid / NXCD; wgid = (xcd < r ? xcd * (q + 1) : r * (q + 1) + (xcd - r) * q) + off; }
        const int nig = WGM * nN, gid = wgid / nig, fm = gid * WGM, gsz = (nM - fm) < WGM ? (nM - fm) : WGM;
        u.pm = fm + ((wgid % nig) % gsz); u.pn = (wgid % nig) / gsz; return true;
    }
    __device__ __forceinline__ void a_ready(const Unit&) const {}
    __device__ __forceinline__ void done(const Unit&) const {}
};

template <class Epi, class Sched, bool ALIGN_EPI = false, bool SP2 = false>
__device__ __forceinline__ void gemm_phase(PG8_LAS unsigned char* lds, const Gemm g, const Sched& S, const Epi& E, int tid_in) {
    int tid_ = tid_in; asm volatile("" : "+v"(tid_));
    const int tid = tid_, wid = __builtin_amdgcn_readfirstlane(tid >> 6), lane = tid & 63, wr = wid >> 2, wc = wid & 3, fr = lane & 15, fq = lane >> 4;
    const int K = g.K, nt = K / BK;
    unsigned voffA[2], voffB[2];
#pragma unroll
    for (int i = 0; i < 2; ++i) { int R, C; stage_rc(tid * 16 + i * 8192, R, C); const int Rb = Epi::PERM ? ((R & ~31) + perm32(R & 31)) : R;
        voffA[i] = (unsigned)(R * K + C) * 2u; voffB[i] = (unsigned)(Rb * K + C) * 2u; }
    const size_t kstep = (size_t)(BK * 2);
    const size_t hstep = (size_t)HALF * K * 2;
    const size_t tstep = 2 * hstep;
    const unsigned ldsw = (unsigned)wid * 1024u;
    const int aoff = lds_byte(wr * 64 + fr, fq * 8), boff = lds_byte(wc * 32 + fr, fq * 8);
#define PG8_SA(b, h) (((b) * 2 + (h)) * HTB)
#define PG8_SB(b, h) ((4 + (b) * 2 + (h)) * HTB)
#define PG8_STAGE(bufoff, gbase, voff) do { _Pragma("unroll") for (int _i = 0; _i < 2; ++_i) \
        __builtin_amdgcn_global_load_lds((const unsigned*)((const char*)(gbase) + (voff)[_i]), (PG8_LAS unsigned*)(lds + (bufoff) + ldsw + _i * 8192), 16, 0, 0); } while (0)
#define PG8_LDA(dst, b, h) do { _Pragma("unroll") for (int m = 0; m < 4; ++m) _Pragma("unroll") for (int k = 0; k < 2; ++k) dst[m][k] = *(const PG8_LAS bf16x8*)(lds + PG8_SA(b, h) + aoff + m * 2048 + k * 1024); } while (0)
#define PG8_LDB(dst, b, h) do { _Pragma("unroll") for (int n = 0; n < 2; ++n) _Pragma("unroll") for (int k = 0; k < 2; ++k) dst[n][k] = *(const PG8_LAS bf16x8*)(lds + PG8_SB(b, h) + boff + n * 2048 + k * 1024); } while (0)
#define PG8_MMA(ai, bj, At, Bt) do { __builtin_amdgcn_s_setprio(1); _Pragma("unroll") for (int m = 0; m < 4; ++m) _Pragma("unroll") for (int n = 0; n < 2; ++n) _Pragma("unroll") for (int k = 0; k < 2; ++k) \
        acc[ai][bj][m][n] = __builtin_amdgcn_mfma_f32_16x16x32_f16(__builtin_bit_cast(h8, Bt[n][k]), __builtin_bit_cast(h8, At[m][k]), acc[ai][bj][m][n], 0, 0, 0); __builtin_amdgcn_s_setprio(0); } while (0)
#define PG8_WAIT_V(n) asm volatile("s_waitcnt vmcnt(" #n ")" ::: "memory")
#define PG8_WAIT_L(n) asm volatile("s_waitcnt lgkmcnt(" #n ")" ::: "memory")
#define PG8_BAR __builtin_amdgcn_s_barrier()
#define PG8_SCHED __builtin_amdgcn_sched_barrier(0)
    Unit cur, nxt; int ui = 0;
    if (!S.next(0, cur)) return;
    f32x4 acc[2][2][4][2];
#pragma unroll
    for (int a = 0; a < 2; ++a)
#pragma unroll
        for (int b = 0; b < 2; ++b)
#pragma unroll
            for (int m = 0; m < 4; ++m)
#pragma unroll
                for (int n = 0; n < 2; ++n) acc[a][b][m][n] = (f32x4){0.f, 0.f, 0.f, 0.f};
    bf16x8 At[4][2], B0[2][2], B1[2][2];
    const char* cA = (const char*)g.A + (size_t)cur.pm * tstep; const char* cB = (const char*)g.Bt + (size_t)cur.pn * tstep;
    S.a_ready(cur);
    if constexpr (SP2) {
        PG8_STAGE(PG8_SB(0, 0), cB, voffB); PG8_STAGE(PG8_SB(0, 1), cB + hstep, voffB); PG8_STAGE(PG8_SA(0, 0), cA, voffA); PG8_STAGE(PG8_SA(0, 1), cA + hstep, voffA);
        if (wr == 1) PG8_BAR;
        PG8_WAIT_V(2); PG8_BAR;
        PG8_STAGE(PG8_SB(1, 0), cB + kstep, voffB); PG8_STAGE(PG8_SA(1, 0), cA + kstep, voffA); PG8_STAGE(PG8_SB(1, 1), cB + hstep + kstep, voffB);
        PG8_WAIT_V(6); PG8_BAR;
    } else {
        PG8_STAGE(PG8_SB(0, 0), cB, voffB); PG8_STAGE(PG8_SA(0, 0), cA, voffA); PG8_STAGE(PG8_SB(0, 1), cB + hstep, voffB); PG8_STAGE(PG8_SA(0, 1), cA + hstep, voffA);
        if (wr == 1) PG8_BAR;
        PG8_WAIT_V(4); PG8_BAR;
        PG8_STAGE(PG8_SB(1, 0), cB + kstep, voffB); PG8_STAGE(PG8_SA(1, 0), cA + kstep, voffA); PG8_STAGE(PG8_SB(1, 1), cB + hstep + kstep, voffB);
        PG8_WAIT_V(6); PG8_BAR;
    }
    for (;;) {
        const bool has_next = S.next(ui + 1, nxt);
        const char* nA = has_next ? (const char*)g.A + (size_t)nxt.pm * tstep : cA; const char* nB = has_next ? (const char*)g.Bt + (size_t)nxt.pn * tstep : cB;
        for (int t = 0; t < nt; t += 2) {
            const bool last = (t == nt - 2);
            const char* a1 = cA + (size_t)(t + 1) * kstep;
            const char* a2 = last ? nA : cA + (size_t)(t + 2) * kstep; const char* b2 = last ? nB : cB + (size_t)(t + 2) * kstep;
            const char* a3 = a2 + kstep; const char* b3 = b2 + kstep;
            if (last && has_next) S.a_ready(nxt);
            if constexpr (SP2) {
            PG8_LDB(B0, 0, 0); PG8_LDB(B1, 0, 1); PG8_SCHED; PG8_LDA(At, 0, 0); PG8_STAGE(PG8_SA(1, 1), a1 + hstep, voffA);
            PG8_WAIT_V(8); PG8_WAIT_L(0); PG8_BAR; PG8_MMA(0, 0, At, B0); PG8_MMA(0, 1, At, B1); PG8_BAR; PG8_SCHED;
            PG8_LDA(At, 0, 1); PG8_STAGE(PG8_SB(0, 0), b2, voffB); PG8_STAGE(PG8_SB(0, 1), b2 + hstep, voffB); PG8_STAGE(PG8_SA(0, 0), a2, voffA);
            PG8_WAIT_V(8); PG8_WAIT_L(0); PG8_BAR; PG8_MMA(1, 0, At, B0); PG8_MMA(1, 1, At, B1); PG8_BAR; PG8_SCHED;
            PG8_LDB(B0, 1, 0); PG8_LDB(B1, 1, 1); PG8_SCHED; PG8_LDA(At, 1, 0); PG8_STAGE(PG8_SA(0, 1), a2 + hstep, voffA);
            PG8_WAIT_V(8); PG8_WAIT_L(0); PG8_BAR; PG8_MMA(0, 0, At, B0); PG8_MMA(0, 1, At, B1); PG8_BAR; PG8_SCHED;
            PG8_LDA(At, 1, 1); PG8_STAGE(PG8_SB(1, 0), b3, voffB); PG8_STAGE(PG8_SB(1, 1), b3 + hstep, voffB); PG8_STAGE(PG8_SA(1, 0), a3, voffA);
            PG8_WAIT_V(8); PG8_WAIT_L(0); PG8_BAR; PG8_MMA(1, 0, At, B0); PG8_MMA(1, 1, At, B1); PG8_BAR; PG8_SCHED;
            } else {
            PG8_LDB(B0, 0, 0); PG8_SCHED; PG8_LDA(At, 0, 0); PG8_STAGE(PG8_SA(1, 1), a1 + hstep, voffA);
            PG8_WAIT_L(8); PG8_BAR; PG8_WAIT_L(0); PG8_MMA(0, 0, At, B0); PG8_BAR; PG8_SCHED;
            PG8_LDB(B1, 0, 1); PG8_STAGE(PG8_SB(0, 0), b2, voffB);
            PG8_BAR; PG8_WAIT_L(0); PG8_MMA(0, 1, At, B1); PG8_BAR;
            PG8_LDA(At, 0, 1); PG8_STAGE(PG8_SA(0, 0), a2, voffA);
            PG8_BAR; PG8_WAIT_L(0); PG8_MMA(1, 0, At, B0); PG8_BAR; PG8_SCHED;
            PG8_STAGE(PG8_SB(0, 1), b2 + hstep, voffB);
            PG8_WAIT_V(6); PG8_BAR; PG8_MMA(1, 1, At, B1); PG8_BAR;
            PG8_LDB(B0, 1, 0); PG8_SCHED; PG8_LDA(At, 1, 0); PG8_STAGE(PG8_SA(0, 1), a2 + hstep, voffA);
            PG8_WAIT_L(8); PG8_BAR; PG8_WAIT_L(0); PG8_MMA(0, 0, At, B0); PG8_BAR; PG8_SCHED;
            PG8_LDB(B1, 1, 1); PG8_STAGE(PG8_SB(1, 0), b3, voffB);
            PG8_BAR; PG8_WAIT_L(0); PG8_MMA(0, 1, At, B1); PG8_BAR;
            PG8_LDA(At, 1, 1); PG8_STAGE(PG8_SA(1, 0), a3, voffA);
            PG8_BAR; PG8_WAIT_L(0); PG8_MMA(1, 0, At, B0); PG8_BAR; PG8_SCHED;
            PG8_STAGE(PG8_SB(1, 1), b3 + hstep, voffB);
            PG8_WAIT_V(6); PG8_BAR; PG8_MMA(1, 1, At, B1); PG8_BAR;
            }
        }
        if constexpr (ALIGN_EPI) { if (wr == 0) PG8_BAR; }
        if constexpr (!Epi::AFTER_DRAIN) { E(acc, cur, wr, wc, fr, fq); S.done(cur); }
        if (!has_next) break;
#pragma unroll
        for (int a = 0; a < 2; ++a)
#pragma unroll
            for (int b = 0; b < 2; ++b)
#pragma unroll
                for (int m = 0; m < 4; ++m)
#pragma unroll
                    for (int n = 0; n < 2; ++n) acc[a][b][m][n] = (f32x4){0.f, 0.f, 0.f, 0.f};
        cur = nxt; cA = nA; cB = nB; ++ui;
        if constexpr (ALIGN_EPI) { if (wr == 1) PG8_BAR; }
    }
    PG8_WAIT_V(0);
    if constexpr (!ALIGN_EPI) { if (wr == 0) PG8_BAR; }
    PG8_BAR;
    if constexpr (Epi::AFTER_DRAIN) { E.fused(acc, cur, wr, wc, fr, fq, lds, wid, lane); S.done(cur); }
#undef PG8_SA
#undef PG8_SB
#undef PG8_STAGE
#undef PG8_LDA
#undef PG8_LDB
#undef PG8_MMA
#undef PG8_WAIT_V
#undef PG8_WAIT_L
#undef PG8_BAR
#undef PG8_SCHED
}
}

#define XB_TMO      128
#define XB_XCNT(j)  (256  + 64 * (j))
#define XB_XSUB(j)  (1280 + 64 * (j))
#define XB_XGEN(j)  (2304 + 64 * (j))
#define XB_TOP      3328
#define XB_TOPGEN   3392
#define XCD_BAR_WORDS 3456
#define XB_SPIN_CAP (1u << 18)
#define LAS __attribute__((address_space(3)))

__device__ __forceinline__ unsigned xb_ld(unsigned* p)              { return __hip_atomic_load(p, __ATOMIC_RELAXED, __HIP_MEMORY_SCOPE_AGENT); }
__device__ __forceinline__ unsigned xb_add(unsigned* p, unsigned v) { return __hip_atomic_fetch_add(p, v, __ATOMIC_RELAXED, __HIP_MEMORY_SCOPE_AGENT); }
__device__ __forceinline__ unsigned xb_xcc_id() { return (unsigned)__builtin_amdgcn_s_getreg((3 << 11) | 20) & 0xFu; }
#define XB_SPIN(cond, bar) do { unsigned _sp = 0; while (cond) { __builtin_amdgcn_s_sleep(1); \
    if ((++_sp & 255u) == 0u) { if (xb_ld(&(bar)[XB_TMO])) break; if (_sp > XB_SPIN_CAP) { atomicAdd(&(bar)[XB_TMO], 1u); break; } } } } while (0)

struct XcdBarrier {
    unsigned* bar; unsigned x;
    volatile LAS unsigned* st;
};

__device__ __forceinline__ XcdBarrier xcd_barrier_post(unsigned* bar, volatile LAS unsigned* st) {
    XcdBarrier b; b.bar = bar; b.x = xb_xcc_id(); b.st = st;
    if (threadIdx.x == 0) (void)xb_add(&bar[XB_XCNT(b.x)], 1u);
    return b;
}
__device__ __forceinline__ void xcd_barrier_complete(unsigned* bar, unsigned x, unsigned& nloc, unsigned& nx) {
    const unsigned G = gridDim.x * gridDim.y * gridDim.z;
    unsigned sum, cnt, mine, sp = 0u;
    for (;;) {
        sum = 0u; cnt = 0u; mine = 0u;
#pragma unroll
        for (unsigned j = 0; j < 16; ++j) { const unsigned c = xb_ld(&bar[XB_XCNT(j)]); sum += c; cnt += (c > 0u) ? 1u : 0u; mine = (j == x) ? c : mine; }
        if (sum == G) break;
        __builtin_amdgcn_s_sleep(1);
        if ((++sp & 255u) == 0u) { if (xb_ld(&bar[XB_TMO])) break; if (sp > XB_SPIN_CAP) { atomicAdd(&bar[XB_TMO], 1u); break; } }
    }
    nloc = mine > 0u ? mine : 1u; nx = cnt > 0u ? cnt : 1u;
}

__device__ __forceinline__ void xcd_barrier(const XcdBarrier& b, const bool leader_thread) {
    asm volatile("s_waitcnt vmcnt(0)" ::: "memory");
    __syncthreads();
    if (leader_thread) {
        unsigned* bar = b.bar;
        __builtin_amdgcn_s_waitcnt(0);
        unsigned nloc = b.st[0], nx = b.st[1];
        if (nloc == 0u) { xcd_barrier_complete(bar, b.x, nloc, nx); b.st[0] = nloc; b.st[1] = nx; }
        const unsigned old = xb_add(&bar[XB_XSUB(b.x)], 1u);
        const unsigned gen = old / nloc;
        if (old + 1u == (gen + 1u) * nloc) {
            __builtin_amdgcn_fence(__ATOMIC_RELEASE, "agent");
            asm volatile("s_waitcnt vmcnt(0)" ::: "memory");
            const unsigned og = xb_add(&bar[XB_TOP], 1u);
            const unsigned tg = og / nx;
            if (og + 1u == (tg + 1u) * nx) xb_add(&bar[XB_TOPGEN], 1u);
            else XB_SPIN(xb_ld(&bar[XB_TOPGEN]) == tg, bar);
            __builtin_amdgcn_fence(__ATOMIC_ACQUIRE, "agent");
            xb_add(&bar[XB_XGEN(b.x)], 1u);
            asm volatile("s_waitcnt vmcnt(0)" ::: "memory");
        } else {
            XB_SPIN(xb_ld(&bar[XB_XGEN(b.x)]) == gen, bar);
            __builtin_amdgcn_fence(__ATOMIC_ACQUIRE, "agent");
            asm volatile("s_waitcnt vmcnt(0)" ::: "memory");
        }
    }
    __syncthreads();
}

constexpr int NB = 2, SEQ = 16384, TLEN = 16400, DM = 1024, NMETA = 16, DEPTH = 2;
constexpr int MR = NB * SEQ;
constexpr int MV = MR + NB * NMETA;
constexpr int MP = 33024;
constexpr int INCOLS = 3912, NPAD = 4096, DFF = 4096;
constexpr int NTHREADS = 512;
constexpr float LOG2E = 1.4426950408889634f;
constexpr float QA_SCALE = 0.125f * LOG2E;
constexpr float QB_SCALE = 0.17677669529663687f * LOG2E;
constexpr float WI_SCALE = 0.044194173824159216f;
constexpr int NKS = 513;

constexpr size_t al256(size_t x) { return (x + 255) & ~(size_t)255; }
constexpr size_t WS_CTL   = 0;
constexpr size_t CTL_BYTES = 65536;
constexpr size_t WS_HMETA = CTL_BYTES;
constexpr size_t WS_ROPE  = WS_HMETA + (size_t)256 * DM * 4;
constexpr size_t WS_W     = al256(WS_ROPE + (size_t)TLEN * 32 * 8);
constexpr size_t W_IN_OFF = 0, W_OUT_OFF = (size_t)NPAD * DM * 2, W_FF1_OFF = W_OUT_OFF + (size_t)DM * DM * 2,
                 W_FF2_OFF = W_FF1_OFF + (size_t)DFF * DM * 2, W_LAYER = W_FF2_OFF + (size_t)DM * DFF * 2;
constexpr size_t WS_ABUF  = al256(WS_W + DEPTH * W_LAYER);
constexpr size_t WS_MASK  = WS_ABUF + (size_t)MP * DM * 2;
constexpr size_t WS_U     = al256(WS_MASK + (size_t)NB * NKS * TLEN * 4);
constexpr size_t WS_S     = WS_U + (size_t)NB * 4 * 129 * 4096 * 4;
constexpr size_t WS_PROJ  = WS_S + (size_t)NB * 4 * 129 * 4096 * 4;
constexpr size_t P512 = (size_t)MP * 512 * 2, P256 = (size_t)MP * 256 * 2;
constexpr size_t PJ_QA = 0, PJ_KA = P512, PJ_VA = 2 * P512, PJ_QI = 3 * P512, PJ_256 = 4 * P512;
constexpr size_t PJ_QB = PJ_256, PJ_KB = PJ_256 + P256, PJ_VB = PJ_256 + 2 * P256, PJ_QC = PJ_256 + 3 * P256, PJ_KC = PJ_256 + 4 * P256,
                 PJ_VC = PJ_256 + 5 * P256, PJ_GC = PJ_256 + 6 * P256, PJ_KI = PJ_256 + 7 * P256, PJ_WI = PJ_KI + (size_t)MP * 64 * 2,
                 PJ_END = PJ_WI + (size_t)MP * 8 * 4;
constexpr size_t ACT_BYTES = (size_t)MP * DFF * 2;
constexpr size_t WS_END = WS_PROJ + (ACT_BYTES > PJ_END ? ACT_BYTES : PJ_END);
constexpr int CW_BAR = 0;
constexpr int CW_KMAX = 4096;

constexpr int LDS_BYTES = 156 * 1024;
constexpr int LDS_MISC = 0, LDS_GEN = 256;

struct Args { const float* in[13]; float* out; unsigned char* ws; int ph_lo, ph_hi; };

struct Frame {
    const float *x, *meta, *rel_bias, *w_in, *norm_mix, *diff_lambda, *diff_norm, *ret_norm, *w_out, *norm_ff, *w_ff1, *w_ff2, *final_norm;
    float* out; unsigned char* ws; LAS unsigned char* lds; int tid, lane, wave, bid, G;
};

__device__ __forceinline__ float shx(float v, int m, int lane) { return __builtin_bit_cast(float, __builtin_amdgcn_ds_bpermute((lane ^ m) << 2, __builtin_bit_cast(int, v))); }
template <int M> __device__ __forceinline__ float sx(float v, int lane) { return shx(v, M, lane); }
__device__ __forceinline__ float hsum32(float v, int lane) { return v + shx(v, 32, lane); }
__device__ __forceinline__ unsigned hor32(unsigned v, int lane) { return v | (unsigned)__builtin_amdgcn_ds_bpermute((lane ^ 32) << 2, (int)v); }
__device__ __forceinline__ float bcast0(float v) { return __builtin_bit_cast(float, __builtin_amdgcn_ds_bpermute(0, __builtin_bit_cast(int, v))); }
__device__ __forceinline__ float wave_sum(float v, int lane) { v = hsum32(v, lane); v += sx<16>(v, lane); v += sx<8>(v, lane); v += sx<4>(v, lane); v += sx<2>(v, lane); v += sx<1>(v, lane); return v; }
__device__ __forceinline__ unsigned cvt_pk_bf16(float lo, float hi) { unsigned r; asm volatile("v_cvt_pk_bf16_f32 %0, %1, %2" : "=v"(r) : "v"(lo), "v"(hi)); return r; }
__device__ __forceinline__ unsigned cvt_pk_f16(float lo, float hi) { h2 p; p.x = (_Float16)lo; p.y = (_Float16)hi; return __builtin_bit_cast(unsigned, p); }
typedef unsigned u32x4 __attribute__((ext_vector_type(4)));
typedef float f32x4 __attribute__((ext_vector_type(4)));
__device__ __forceinline__ u32x4 pack8(const f32x4& a, const f32x4& b, bool bf) {
    u32x4 w;
    if (bf) { w.x = cvt_pk_bf16(a[0], a[1]); w.y = cvt_pk_bf16(a[2], a[3]); w.z = cvt_pk_bf16(b[0], b[1]); w.w = cvt_pk_bf16(b[2], b[3]); }
    else    { w.x = cvt_pk_f16(a[0], a[1]);  w.y = cvt_pk_f16(a[2], a[3]);  w.z = cvt_pk_f16(b[0], b[1]);  w.w = cvt_pk_f16(b[2], b[3]); }
    return w;
}
__device__ __forceinline__ int row_pos(int r) { return r < MR ? (r & (SEQ - 1)) + NMETA : ((r - MR) & 15); }

__device__ __forceinline__ int incol_map(int n) {
    if (n < 2048) return n;
    if (n < 2816) return n - 2048 + 2120;
    if (n < 3328) {
        const int seg = (n - 2816) >> 8, c = (n - 2816) & 255, head = c >> 6, p = c & 63;
        const int g = p >> 3, nn = (p >> 2) & 1, i = p & 3, d = 32 * nn + 4 * g + i;
        return (seg ? 3144 : 2888) + head * 64 + d;
    }
    if (n < 3840) return n - 3328 + 3400;
    if (n < 3904) return n - 3840 + 2048;
    if (n < 3912) return n - 3904 + 2112;
    return -1;
}

__constant__ double ROPE_REV[32] = {0.15915494309189535, 0.11934937021124886, 0.08949940160889101, 0.06711508300522726, 0.050329212104487035, 0.03774158471741977, 0.0283021958306234, 0.02122365276477766, 0.015915494309189534, 0.011934937021124886, 0.008949940160889102, 0.006711508300522725, 0.005032921210448704, 0.003774158471741977, 0.00283021958306234, 0.0021223652764777662, 0.0015915494309189536, 0.0011934937021124885, 0.0008949940160889102, 0.0006711508300522726, 0.0005032921210448703, 0.00037741584717419774, 0.00028302195830623395, 0.0002122365276477766, 0.00015915494309189535, 0.00011934937021124886, 8.949940160889102e-05, 6.711508300522725e-05, 5.0329212104487035e-05, 3.774158471741978e-05, 2.8302195830623396e-05, 2.122365276477766e-05};

struct EpiInProj {
    static constexpr bool PERM = true, AFTER_DRAIN = false;
    unsigned char* proj; const f32x2* rope; unsigned* kmax;
    __device__ __forceinline__ void kmax_update(const pg8::f32x4 (&acc)[2][2][4][2], int bj, unsigned* word, int fr, int fq) const {
        float mx = 0.f; const int LN = fq * 16 + fr;
#pragma unroll
        for (int ai = 0; ai < 2; ++ai)
#pragma unroll
            for (int m = 0; m < 4; ++m) {
                const pg8::f32x4 a = acc[ai][bj][m][0], b = acc[ai][bj][m][1];
                float s = (a[0] * a[0] + a[1] * a[1]) + (a[2] * a[2] + a[3] * a[3]) + (b[0] * b[0] + b[1] * b[1]) + (b[2] * b[2] + b[3] * b[3]);
                s += sx<16>(s, LN); s = hsum32(s, LN);
                mx = fmaxf(mx, s);
            }
        mx = fmaxf(mx, sx<1>(mx, LN)); mx = fmaxf(mx, sx<2>(mx, LN)); mx = fmaxf(mx, sx<4>(mx, LN)); mx = fmaxf(mx, sx<8>(mx, LN));
        if (fr == 0 && fq == 0) atomicMax(word, __float_as_uint(mx));
    }
    __device__ __forceinline__ void operator()(const pg8::f32x4 (&acc)[2][2][4][2], const pg8::Unit& u, int wr, int wc, int fr, int fq) const {
        const int pn = u.pn, rbase = u.pm * 256 + wr * 64 + fr, cw = wc * 32 + 8 * fq;
        if (pn <= 7 || (pn <= 14 && pn != 11 && pn != 12)) {
            unsigned char* base; int ld, colt; float scale = 1.f; bool bf = false;
            if (pn <= 7) { const int arr = pn >> 1; base = proj + (size_t)arr * P512; ld = 512; colt = (pn & 1) * 256; if (arr == 0) scale = QA_SCALE; bf = (arr == 2); }
            else { const int arr = pn - 8; base = proj + PJ_256 + (size_t)arr * P256; ld = 256; colt = 0; if (arr == 0) scale = QB_SCALE; bf = (arr == 2); }
#pragma unroll
            for (int ai = 0; ai < 2; ++ai)
#pragma unroll
                for (int m = 0; m < 4; ++m) {
                    const int row = rbase + ai * 128 + m * 16;
#pragma unroll
                    for (int bj = 0; bj < 2; ++bj) {
                        const pg8::f32x4 v0 = acc[ai][bj][m][0] * scale, v1 = acc[ai][bj][m][1] * scale;
                        *(u32x4*)(base + ((size_t)row * ld + colt + bj * 128 + cw) * 2) = pack8(v0, v1, bf);
                    }
                }
            if (pn == 2 || pn == 3) {
#pragma unroll
                for (int bj = 0; bj < 2; ++bj) { const int head = ((pn & 1) * 256 + bj * 128 + wc * 32) >> 6; kmax_update(acc, bj, kmax + head * 2 + (wc & 1), fr, fq); }
            }
            if (pn == 9) {
#pragma unroll
                for (int bj = 0; bj < 2; ++bj) { const int head = 2 * bj + (wc >> 1); kmax_update(acc, bj, kmax + 16 + head * 2 + (wc & 1), fr, fq); }
            }
        } else if (pn == 11 || pn == 12) {
            unsigned char* base = proj + PJ_256 + (size_t)(pn - 8) * P256;
            const float sc = (pn == 12) ? 0.125f : 1.f;
            const int g = 4 * (wc & 1) + fq;
#pragma unroll
            for (int ai = 0; ai < 2; ++ai)
#pragma unroll
                for (int m = 0; m < 4; ++m) {
                    const int row = rbase + ai * 128 + m * 16, t = row_pos(row);
                    const pg8::f32x4 cs0 = *(const pg8::f32x4*)(rope + (size_t)t * 32 + 4 * g), cs1 = *(const pg8::f32x4*)(rope + (size_t)t * 32 + 4 * g + 2);
                    const float c[4] = {cs0[0], cs0[2], cs1[0], cs1[2]}, s[4] = {cs0[1], cs0[3], cs1[1], cs1[3]};
#pragma unroll
                    for (int bj = 0; bj < 2; ++bj) {
                        const pg8::f32x4 x1 = acc[ai][bj][m][0], x2 = acc[ai][bj][m][1];
                        float o1[4], o2[4];
#pragma unroll
                        for (int i = 0; i < 4; ++i) { o1[i] = (x1[i] * c[i] - x2[i] * s[i]) * sc; o2[i] = (x1[i] * s[i] + x2[i] * c[i]) * sc; }
                        const int head = 2 * bj + (wc >> 1);
                        unsigned char* rp = base + ((size_t)row * 256 + head * 64 + 4 * g) * 2;
                        u32x2 w1, w2; w1.x = cvt_pk_f16(o1[0], o1[1]); w1.y = cvt_pk_f16(o1[2], o1[3]); w2.x = cvt_pk_f16(o2[0], o2[1]); w2.y = cvt_pk_f16(o2[2], o2[3]);
                        *(u32x2*)rp = w1; *(u32x2*)(rp + 64) = w2;
                    }
                }
        } else {
#pragma unroll
            for (int ai = 0; ai < 2; ++ai)
#pragma unroll
                for (int m = 0; m < 4; ++m) {
                    const int row = rbase + ai * 128 + m * 16;
                    const pg8::f32x4 v0 = acc[ai][0][m][0], v1 = acc[ai][0][m][1];
                    if (wc < 2) *(u32x4*)(proj + PJ_KI + ((size_t)row * 64 + cw) * 2) = pack8(v0, v1, false);
                    else if (wc == 2 && fq == 0) { float* wp = (float*)(proj + PJ_WI) + (size_t)row * 8; *(pg8::f32x4*)wp = v0 * WI_SCALE; *(pg8::f32x4*)(wp + 4) = v1 * WI_SCALE; }
                }
        }
    }
};
struct EpiRes {
    static constexpr bool PERM = false, AFTER_DRAIN = false;
    const float* res_main; float* out_main; float* hmeta;
    __device__ __forceinline__ void operator()(const pg8::f32x4 (&acc)[2][2][4][2], const pg8::Unit& u, int wr, int wc, int fr, int fq) const {
        const bool mt = (u.pm * 256 >= MR);
        const float* rb = mt ? hmeta : res_main; float* ob = mt ? hmeta : out_main;
        const int row0 = (mt ? u.pm * 256 - MR : u.pm * 256) + wr * 64 + fr, col0 = u.pn * 256 + wc * 32 + 4 * fq;
#pragma unroll
        for (int ai = 0; ai < 2; ++ai)
#pragma unroll
            for (int m = 0; m < 4; ++m) {
                const size_t ro = (size_t)(row0 + ai * 128 + m * 16) * DM + col0;
#pragma unroll
                for (int bj = 0; bj < 2; ++bj)
#pragma unroll
                    for (int n = 0; n < 2; ++n) { const pg8::f32x4 v = *(const pg8::f32x4*)(rb + ro + bj * 128 + n * 16) + acc[ai][bj][m][n]; *(pg8::f32x4*)(ob + ro + bj * 128 + n * 16) = v; }
            }
    }
};
struct EpiRelu2 {
    static constexpr bool PERM = true, AFTER_DRAIN = false;
    unsigned char* act;
    __device__ __forceinline__ void operator()(const pg8::f32x4 (&acc)[2][2][4][2], const pg8::Unit& u, int wr, int wc, int fr, int fq) const {
        const int rbase = u.pm * 256 + wr * 64 + fr, col0 = u.pn * 256 + wc * 32 + 8 * fq;
#pragma unroll
        for (int ai = 0; ai < 2; ++ai)
#pragma unroll
            for (int m = 0; m < 4; ++m) {
                const int row = rbase + ai * 128 + m * 16;
#pragma unroll
                for (int bj = 0; bj < 2; ++bj) {
                    pg8::f32x4 v0 = acc[ai][bj][m][0], v1 = acc[ai][bj][m][1];
#pragma unroll
                    for (int i = 0; i < 4; ++i) { const float a = fmaxf(v0[i], 0.f), b = fmaxf(v1[i], 0.f); v0[i] = a * a; v1[i] = b * b; }
                    *(u32x4*)(act + ((size_t)row * DFF + col0 + bj * 128) * 2) = pack8(v0, v1, false);
                }
            }
    }
};

struct WTile { const float* src; _Float16* dst; int ld, K, k0, n0, mapped; };
constexpr int WT_PER_LAYER = 16 * 64 + 16 * 16 + 16 * 64 + 64 * 16, WT_TOTAL = DEPTH * WT_PER_LAYER;
__device__ __forceinline__ WTile wt_desc(const Frame& F, int t) {
    WTile d; const int l = t / WT_PER_LAYER; int r = t - l * WT_PER_LAYER;
    unsigned char* wl = F.ws + WS_W + (size_t)l * W_LAYER;
    if (r < 1024)      { d.src = F.w_in + (size_t)l * DM * INCOLS; d.dst = (_Float16*)(wl + W_IN_OFF);  d.ld = INCOLS; d.K = DM;  d.mapped = 1; d.k0 = (r & 15) * 64; d.n0 = (r >> 4) * 64; }
    else if (r < 1280) { r -= 1024; d.src = F.w_out + (size_t)l * DM * DM;  d.dst = (_Float16*)(wl + W_OUT_OFF); d.ld = DM;  d.K = DM;  d.mapped = 0; d.k0 = (r & 15) * 64; d.n0 = (r >> 4) * 64; }
    else if (r < 2304) { r -= 1280; d.src = F.w_ff1 + (size_t)l * DM * DFF; d.dst = (_Float16*)(wl + W_FF1_OFF); d.ld = DFF; d.K = DM;  d.mapped = 0; d.k0 = (r & 15) * 64; d.n0 = (r >> 4) * 64; }
    else               { r -= 2304; d.src = F.w_ff2 + (size_t)l * DFF * DM; d.dst = (_Float16*)(wl + W_FF2_OFF); d.ld = DM;  d.K = DFF; d.mapped = 0; d.k0 = (r & 63) * 64; d.n0 = (r >> 6) * 64; }
    return d;
}
__device__ __forceinline__ void wt_load(const WTile& d, int tid, f32x4& v0, f32x4& v1) {
    const int kk = tid >> 4, n4 = (tid & 15) * 4; const int sc = d.mapped ? incol_map(d.n0 + n4) : d.n0 + n4;
    v0 = (f32x4){0.f, 0.f, 0.f, 0.f}; v1 = v0;
    if (sc >= 0) { v0 = *(const f32x4*)(d.src + (size_t)(d.k0 + kk) * d.ld + sc); v1 = *(const f32x4*)(d.src + (size_t)(d.k0 + kk + 32) * d.ld + sc); }
}
__device__ __forceinline__ void wtrans_all(const Frame& F) {
    LAS float* tile = (LAS float*)(F.lds + LDS_GEN); const int tid = F.tid;
    int t = F.bid; if (t >= WT_TOTAL) return;
    WTile d = wt_desc(F, t); f32x4 v0, v1; wt_load(d, tid, v0, v1);
#pragma unroll 1
    for (;;) {
        const int tn = t + F.G; WTile dn = d; f32x4 n0 = v0, n1 = v1;
        if (tn < WT_TOTAL) { dn = wt_desc(F, tn); wt_load(dn, tid, n0, n1); }
        { const int kk = tid >> 4, n4 = (tid & 15) * 4;
#pragma unroll
          for (int e = 0; e < 4; ++e) { tile[kk * 65 + n4 + e] = v0[e]; tile[(kk + 32) * 65 + n4 + e] = v1[e]; } }
        __syncthreads();
        { const int nn = tid >> 3, k8 = (tid & 7) * 8; h8 o;
#pragma unroll
          for (int e = 0; e < 8; ++e) o[e] = (_Float16)tile[(k8 + e) * 65 + nn];
          *(h8*)(d.dst + (size_t)(d.n0 + nn) * d.K + d.k0 + k8) = o; }
        __syncthreads();
        if (tn >= WT_TOTAL) break;
        t = tn; d = dn; v0 = n0; v1 = n1;
    }
}
template <int MODE> __device__ __forceinline__ void norm_to_abuf(const Frame& F, const float* gain) {
    _Float16* abuf = (_Float16*)(F.ws + WS_ABUF); const float* hmeta = (const float*)(F.ws + WS_HMETA);
    const int nw = F.G * 8;
    for (int r = F.bid * 8 + F.wave; r < MP; r += nw) {
        _Float16* dst = abuf + (size_t)r * DM;
        if (r >= MV) { const h4 z = {(_Float16)0.f, (_Float16)0.f, (_Float16)0.f, (_Float16)0.f};
#pragma unroll
            for (int j = 0; j < 4; ++j) *(h4*)(dst + j * 256 + F.lane * 4) = z; continue; }
        const float* src = MODE == 0 ? (r < MR ? F.x + (size_t)r * DM : F.meta + (size_t)((r - MR) & 15) * DM) : (r < MR ? F.out + (size_t)r * DM : hmeta + (size_t)(r - MR) * DM);
        f32x4 v[4]; float ss = 0.f;
#pragma unroll
        for (int j = 0; j < 4; ++j) { v[j] = *(const f32x4*)(src + j * 256 + F.lane * 4); ss += (v[j][0] * v[j][0] + v[j][1] * v[j][1]) + (v[j][2] * v[j][2] + v[j][3] * v[j][3]); }
        ss = wave_sum(ss, F.lane); const float rstd = rsqrtf(ss * (1.0f / DM) + 1e-6f);
#pragma unroll
        for (int j = 0; j < 4; ++j) { const f32x4 g = *(const f32x4*)(gain + j * 256 + F.lane * 4); h4 o;
#pragma unroll
            for (int e = 0; e < 4; ++e) o[e] = (_Float16)(v[j][e] * rstd * g[e]);
            *(h4*)(dst + j * 256 + F.lane * 4) = o; }
    }
}
__device__ __forceinline__ void final_norm(const Frame& F) {
    const int nw = F.G * 8;
    for (int r = F.bid * 8 + F.wave; r < MR; r += nw) {
        float* p = F.out + (size_t)r * DM; f32x4 v[4]; float ss = 0.f;
#pragma unroll
        for (int j = 0; j < 4; ++j) { v[j] = *(const f32x4*)(p + j * 256 + F.lane * 4); ss += (v[j][0] * v[j][0] + v[j][1] * v[j][1]) + (v[j][2] * v[j][2] + v[j][3] * v[j][3]); }
        ss = wave_sum(ss, F.lane); const float rstd = rsqrtf(ss * (1.0f / DM) + 1e-6f);
#pragma unroll
        for (int j = 0; j < 4; ++j) { const f32x4 g = *(const f32x4*)(F.final_norm + j * 256 + F.lane * 4); *(f32x4*)(p + j * 256 + F.lane * 4) = v[j] * rstd * g; }
    }
}
__device__ __forceinline__ void prologue(const Frame& F) {
    const int gtid = F.bid * NTHREADS + F.tid, gsz = F.G * NTHREADS;
    float* hmeta = (float*)(F.ws + WS_HMETA);
    for (int i = gtid; i < 256 * DM / 4; i += gsz) { const int row = i / (DM / 4), c4 = i % (DM / 4); f32x4 v = {0.f, 0.f, 0.f, 0.f}; if (row < NB * NMETA) v = *(const f32x4*)(F.meta + (size_t)(row & 15) * DM + c4 * 4); *(f32x4*)(hmeta + (size_t)row * DM + c4 * 4) = v; }
    f32x2* rope = (f32x2*)(F.ws + WS_ROPE);
    for (int i = gtid; i < TLEN * 32; i += gsz) { const int t = i >> 5, d = i & 31; const double rev = (double)t * ROPE_REV[d]; const float fr = (float)(rev - __builtin_floor(rev)); f32x2 cs; cs.x = __builtin_amdgcn_cosf(fr); cs.y = __builtin_amdgcn_sinf(fr); rope[i] = cs; }
    wtrans_all(F);
    norm_to_abuf<0>(F, F.norm_mix);
}
__device__ __forceinline__ int crow(int i, int h) { return (i & 3) + 8 * (i >> 2) + 4 * h; }
constexpr size_t WS_SCR = WS_U;
template <bool FROM_SCR> __device__ __forceinline__ void skinny_task(const unsigned char* A, int lda_bytes, const float* scr, const _Float16* Bt, int K, int n0, int k0, float* dst, int ldd, int lane) {
    const int r = lane & 31, h = lane >> 5;
    f32x16 acc;
#pragma unroll
    for (int i = 0; i < 16; ++i) acc[i] = 0.f;
#pragma unroll 1
    for (int kc = 0; kc < 4; ++kc) {
    h8 a[4], bb[4];
#pragma unroll
    for (int s = 0; s < 4; ++s) {
        const int k = k0 + 64 * kc + 16 * s + 8 * h;
        if (FROM_SCR) { const f32x4 x0 = *(const f32x4*)(scr + (size_t)r * DFF + k), x1 = *(const f32x4*)(scr + (size_t)r * DFF + k + 4);
#pragma unroll
            for (int e = 0; e < 4; ++e) { const float u = fmaxf(x0[e], 0.f), v = fmaxf(x1[e], 0.f); a[s][e] = (_Float16)(u * u); a[s][4 + e] = (_Float16)(v * v); } }
        else a[s] = *(const h8*)(A + (size_t)(MR + r) * lda_bytes + (size_t)k * 2);
        bb[s] = *(const h8*)(Bt + (size_t)(n0 + r) * K + k);
    }
#pragma unroll
    for (int s = 0; s < 4; ++s) acc = __builtin_amdgcn_mfma_f32_32x32x16_f16(a[s], bb[s], acc, 0, 0, 0);
    }
#pragma unroll
    for (int i = 0; i < 16; ++i) atomicAdd(dst + (size_t)crow(i, h) * ldd + n0 + r, acc[i]);
}
template <int MODE> __device__ __forceinline__ void skinny_meta(const Frame& F, const unsigned char* wl) {
    const int ntn = MODE == 1 ? 128 : 32, nks = MODE == 2 ? 16 : 4, ntask = ntn * nks;
    float* hmeta = (float*)(F.ws + WS_HMETA); float* scr = (float*)(F.ws + WS_SCR);
#pragma unroll 1
    for (int task = F.bid * 8 + F.wave; task < ntask; task += F.G * 8) {
        const int nt = task % ntn, ks = task / ntn;
        if (MODE == 0) skinny_task<false>(F.ws + WS_ABUF, DM * 2, nullptr, (const _Float16*)(wl + W_OUT_OFF), DM, nt * 32, ks * 256, hmeta, DM, F.lane);
        if (MODE == 1) skinny_task<false>(F.ws + WS_ABUF, DM * 2, nullptr, (const _Float16*)(wl + W_FF1_OFF), DM, nt * 32, ks * 256, scr, DFF, F.lane);
        if (MODE == 2) skinny_task<true>(nullptr, 0, scr, (const _Float16*)(wl + W_FF2_OFF), DFF, nt * 32, ks * 256, hmeta, DM, F.lane);
    }
}
__device__ __forceinline__ void zero_scr(const Frame& F) {
    f32x4* p = (f32x4*)(F.ws + WS_SCR); float z0 = 0.f; asm volatile("" : "+v"(z0)); const f32x4 z = {z0, z0, z0, z0};
    for (int i = F.bid * NTHREADS + F.tid; i < 32 * DFF / 4; i += F.G * NTHREADS) p[i] = z;
}
__device__ __forceinline__ void zero_abuf(const Frame& F) {
    u32x4* p = (u32x4*)(F.ws + WS_ABUF); const u32x4 z = {0u, 0u, 0u, 0u};
    for (size_t i = (size_t)F.bid * NTHREADS + F.tid; i < (size_t)MP * DM * 2 / 16; i += (size_t)F.G * NTHREADS) p[i] = z;
}

typedef short bf16x8v __attribute__((ext_vector_type(8)));
__constant__ unsigned char BUCKET_LUT[128] = {0, 1, 2, 3, 4, 5, 6, 7, 8, 9, 10, 11, 12, 13, 14, 15, 16, 16, 16, 17, 17, 18, 18, 18, 19, 19, 19, 20, 20, 20, 20, 21, 21, 21, 21, 22, 22, 22, 22, 22, 23, 23, 23, 23, 23, 23, 24, 24, 24, 24, 24, 24, 25, 25, 25, 25, 25, 25, 25, 26, 26, 26, 26, 26, 26, 26, 26, 27, 27, 27, 27, 27, 27, 27, 27, 27, 27, 28, 28, 28, 28, 28, 28, 28, 28, 28, 28, 29, 29, 29, 29, 29, 29, 29, 29, 29, 29, 29, 29, 30, 30, 30, 30, 30, 30, 30, 30, 30, 30, 30, 30, 30, 30, 31, 31, 31, 31, 31, 31, 31, 31, 31, 31, 31, 31, 31, 31, 31};
__device__ __forceinline__ bf16x8v pack_p(const f32x16& x, int s) {
    u32x4 p; p.x = cvt_pk_bf16(x[8 * s + 0], x[8 * s + 1]); p.y = cvt_pk_bf16(x[8 * s + 2], x[8 * s + 3]); p.z = cvt_pk_bf16(x[8 * s + 4], x[8 * s + 5]); p.w = cvt_pk_bf16(x[8 * s + 6], x[8 * s + 7]);
    return __builtin_bit_cast(bf16x8v, p);
}
constexpr int TK = 128;
__device__ __forceinline__ bf16x8v vt_frag(LAS unsigned char* vimg, int dblk, int keybase, int s, int lane) {
    const int h = lane >> 5, blk = (lane >> 4) & 1, i16 = lane & 15, q = i16 >> 2, p = i16 & 3;
    LAS unsigned char* a = vimg + dblk * (TK * 64) + (keybase + 16 * s + 4 * h + q) * 64 + (16 * blk + 4 * p) * 2;
    const s16x4 lo = __builtin_amdgcn_ds_read_tr16_b64_v4i16((LAS s16x4*)a);
    const s16x4 hi = __builtin_amdgcn_ds_read_tr16_b64_v4i16((LAS s16x4*)(a + 8 * 64));
    return __builtin_shufflevector(lo, hi, 0, 1, 2, 3, 4, 5, 6, 7);
}

constexpr int KS_PITCH = 144;
constexpr int KBUF = TK * KS_PITCH, VBUF = 2 * TK * 64, B_KS = 0, B_VS = 2 * KBUF, B_LUT = B_VS + 2 * VBUF, B_END = B_LUT + 512;
__device__ __forceinline__ void mixB_unit(const Frame& F, int l, int b, int hh, int qblk, float lam, float oscale) {
    LAS unsigned char* L = F.lds + LDS_GEN;
    const int tid = F.tid, lane = F.lane, wave = F.wave, r = lane & 31, h = lane >> 5;
    const unsigned char* proj = F.ws + WS_PROJ;
    const _Float16* QB = (const _Float16*)(proj + PJ_QB); const unsigned char* KB = proj + PJ_KB; const unsigned char* VB = proj + PJ_VB;
    const unsigned* kmax = (const unsigned*)(F.ws + WS_CTL) + CW_KMAX + 32 * l + 16;
    const bool meta_u = qblk < 0;
    const int qrow0 = meta_u ? MR + b * NMETA : b * SEQ + qblk * 256;
    const int qpos0 = meta_u ? 0 : NMETA + qblk * 256;
    const int nreal = meta_u ? 0 : 2 * qblk + 2;
    const int wq0 = 32 * wave;
    const bool wave_on = meta_u ? (wave == 0) : true;
    const int my_row = wave_on ? qrow0 + wq0 + r : qrow0, my_pos = qpos0 + wq0 + r;
    __syncthreads();
    if (tid < 128) ((LAS float*)(L + B_LUT))[tid] = F.rel_bias[BUCKET_LUT[tid] * 12 + 8 + hh] * LOG2E;
    float bmax = (lane < 32) ? F.rel_bias[lane * 12 + 8 + hh] * LOG2E : -1e30f;
    bmax = fmaxf(bmax, sx<16>(bmax, lane)); bmax = fmaxf(bmax, sx<8>(bmax, lane)); bmax = fmaxf(bmax, sx<4>(bmax, lane)); bmax = fmaxf(bmax, sx<2>(bmax, lane)); bmax = fmaxf(bmax, sx<1>(bmax, lane));
    bmax = bcast0(bmax);
    const float bfar = F.rel_bias[31 * 12 + 8 + hh] * LOG2E;
    h8 qf[2][2]; float mref[2]; bool safe = true;
#pragma unroll
    for (int c = 0; c < 2; ++c) {
        float n2 = 0.f;
#pragma unroll
        for (int s = 0; s < 2; ++s) { qf[c][s] = *(const h8*)(QB + (size_t)my_row * 256 + hh * 64 + c * 32 + 16 * s + 8 * h);
#pragma unroll
            for (int j = 0; j < 8; ++j) { const float v = (float)qf[c][s][j]; n2 += v * v; } }
        n2 = hsum32(n2, lane);
        mref[c] = sqrtf(n2 * __uint_as_float(kmax[hh * 2 + c])) * 1.002f + bmax;
        safe = safe && (mref[c] - bfar < 60.0f);
    }
    safe = __all(safe);
    if (safe) { mref[0] = bfar; mref[1] = bfar; }
    f32x16 O[2][2]; float lsum[2] = {0.f, 0.f};
#pragma unroll
    for (int c = 0; c < 2; ++c)
#pragma unroll
        for (int d = 0; d < 2; ++d)
#pragma unroll
            for (int i = 0; i < 16; ++i) O[c][d][i] = 0.f;
    const int skey = tid >> 3, sch = tid & 7;
    const unsigned kdst = skey * KS_PITCH + sch * 16, vdst = (sch >> 2) * (TK * 64) + skey * 64 + (sch & 3) * 16;
    const int ntiles = 1 + nreal;
    auto tile_row0 = [&](int t) -> int { return t == 0 ? MR + b * NMETA : b * SEQ + (t - 1) * TK; };
    u32x4 kreg[2], vreg[2];
#pragma unroll
    for (int j = 0; j < 2; ++j) { const size_t rr = (size_t)(tile_row0(0) + skey + 64 * j); kreg[j] = *(const u32x4*)(KB + rr * 512 + hh * 128 + sch * 16); vreg[j] = *(const u32x4*)(VB + rr * 512 + hh * 128 + sch * 16); }
#pragma unroll
    for (int j = 0; j < 2; ++j) { *(LAS u32x4*)(L + B_KS + kdst + j * 64 * KS_PITCH) = kreg[j]; *(LAS u32x4*)(L + B_VS + vdst + j * 64 * 64) = vreg[j]; }
    __syncthreads();
    const int wpos0 = qpos0 + wq0;
#pragma unroll 1
    for (int t = 0; t < ntiles; ++t) {
        const int buf = t & 1;
        if (t + 1 < ntiles) {
#pragma unroll
            for (int j = 0; j < 2; ++j) { const size_t rr = (size_t)(tile_row0(t + 1) + skey + 64 * j); kreg[j] = *(const u32x4*)(KB + rr * 512 + hh * 128 + sch * 16); vreg[j] = *(const u32x4*)(VB + rr * 512 + hh * 128 + sch * 16); } }
        const int kpos0 = (t == 0) ? 0 : NMETA + (t - 1) * TK, nvalid = (t == 0) ? NMETA : TK;
        if (wave_on && kpos0 <= wpos0 + 31) {
            LAS unsigned char* Kb = L + B_KS + buf * KBUF; LAS unsigned char* Vb = L + B_VS + buf * VBUF;
#pragma unroll
            for (int sub = 0; sub < 4; ++sub) {
                if (sub * 32 >= nvalid || kpos0 + sub * 32 > wpos0 + 31) continue;
                const bool slow = !safe || (t == 0) || (kpos0 + sub * 32 + 31 > wpos0 - 128);
                h8 kfr[2][2]; bf16x8v vfr[2][2];
#pragma unroll
                for (int c = 0; c < 2; ++c)
#pragma unroll
                    for (int s = 0; s < 2; ++s) kfr[c][s] = *(const LAS h8*)(Kb + (sub * 32 + r) * KS_PITCH + (c * 32 + 16 * s + 8 * h) * 2);
#pragma unroll
                for (int d = 0; d < 2; ++d)
#pragma unroll
                    for (int s = 0; s < 2; ++s) vfr[d][s] = vt_frag(Vb, d, sub * 32, s, lane);
                __builtin_amdgcn_sched_barrier(0);
                f32x16 S[2];
#pragma unroll
                for (int c = 0; c < 2; ++c) {
#pragma unroll
                    for (int i = 0; i < 16; ++i) S[c][i] = 0.f;
#pragma unroll
                    for (int s = 0; s < 2; ++s) S[c] = __builtin_amdgcn_mfma_f32_32x32x16_f16(kfr[c][s], qf[c][s], S[c], 0, 0, 0);
                }
                if (slow) {
                    float bs[16];
#pragma unroll
                    for (int i = 0; i < 16; ++i) { const int dist = my_pos - (kpos0 + sub * 32 + crow(i, h)); bs[i] = ((const LAS float*)(L + B_LUT))[min(max(dist, 0), 127)]; }
#pragma unroll
                    for (int i = 0; i < 16; ++i) {
                        const int kidx = sub * 32 + crow(i, h), dist = my_pos - (kpos0 + kidx);
                        const bool ok = dist >= 0 && kidx < nvalid;
#pragma unroll
                        for (int c = 0; c < 2; ++c) { const float e = __builtin_amdgcn_exp2f(fminf(S[c][i] + (bs[i] - mref[c]), 80.f)); S[c][i] = ok ? e : 0.f; }
                    }
                }
#pragma unroll
                for (int c = 0; c < 2; ++c) {
                    __builtin_amdgcn_sched_barrier(0);
                    if (!slow) {
#pragma unroll
                        for (int i = 0; i < 16; ++i) S[c][i] = __builtin_amdgcn_exp2f(S[c][i]); }
                    const float a0 = (S[c][0] + S[c][1]) + (S[c][2] + S[c][3]), a1 = (S[c][4] + S[c][5]) + (S[c][6] + S[c][7]);
                    const float a2 = (S[c][8] + S[c][9]) + (S[c][10] + S[c][11]), a3 = (S[c][12] + S[c][13]) + (S[c][14] + S[c][15]);
                    lsum[c] += (a0 + a1) + (a2 + a3);
                    bf16x8v pf[2]; pf[0] = pack_p(S[c], 0); pf[1] = pack_p(S[c], 1);
                    __builtin_amdgcn_sched_barrier(0);
#pragma unroll
                    for (int d = 0; d < 2; ++d)
#pragma unroll
                        for (int s = 0; s < 2; ++s) O[c][d] = __builtin_amdgcn_mfma_f32_32x32x16_bf16(vfr[d][s], pf[s], O[c][d], 0, 0, 0);
                }
            }
        }
        if (t + 1 < ntiles) {
#pragma unroll
            for (int j = 0; j < 2; ++j) { *(LAS u32x4*)(L + B_KS + (buf ^ 1) * KBUF + kdst + j * 64 * KS_PITCH) = kreg[j]; *(LAS u32x4*)(L + B_VS + (buf ^ 1) * VBUF + vdst + j * 64 * 64) = vreg[j]; } }
        __syncthreads();
    }
    if (wave_on) {
        const float l0 = hsum32(lsum[0], lane), l1 = hsum32(lsum[1], lane);
        const float i0 = 1.0f / l0, i1 = lam / l1;
        float o[2][16], ss = 0.f;
#pragma unroll
        for (int d = 0; d < 2; ++d)
#pragma unroll
            for (int i = 0; i < 16; ++i) { o[d][i] = O[0][d][i] * i0 - O[1][d][i] * i1; ss += o[d][i] * o[d][i]; }
        ss = hsum32(ss, lane);
        const float rstd = rsqrtf(ss * (1.0f / 64.0f) + 1e-6f) * oscale;
        const float* gn = F.diff_norm + l * 64;
        if (!meta_u || r < NMETA) {
            _Float16* dst = (_Float16*)(F.ws + WS_ABUF) + (size_t)my_row * DM + 512 + hh * 64;
#pragma unroll
            for (int d = 0; d < 2; ++d)
#pragma unroll
                for (int g4 = 0; g4 < 4; ++g4) { const int d0 = 32 * d + 8 * g4 + 4 * h; const f32x4 gv = *(const f32x4*)(gn + d0);
                    u32x2 w; w.x = cvt_pk_f16(o[d][4 * g4 + 0] * rstd * gv[0], o[d][4 * g4 + 1] * rstd * gv[1]); w.y = cvt_pk_f16(o[d][4 * g4 + 2] * rstd * gv[2], o[d][4 * g4 + 3] * rstd * gv[3]);
                    *(u32x2*)(dst + d0) = w; }
        }
    }
}
__device__ __forceinline__ void mixB_phase(const Frame& F, int l) {
    const float* lp = F.diff_lambda + l * 128;
    float a = (F.lane < 32) ? lp[F.lane] * lp[32 + F.lane] : 0.f, c = (F.lane < 32) ? lp[64 + F.lane] * lp[96 + F.lane] : 0.f;
    a = wave_sum(a, F.lane); c = wave_sum(c, F.lane);
    const float linit = 0.8f - 0.6f * expf(-0.3f * (float)l);
    const float lam = expf(a) - expf(c) + linit, oscale = 1.0f - linit;
#pragma unroll 1
    for (int cidx = F.bid; cidx < 256; cidx += F.G) { const int bh = cidx & 7, i = cidx >> 3;
#pragma unroll 1
        for (int k = 0; k < 3; ++k) { if (k == 2 && cidx >= 8) break; mixB_unit(F, l, bh >> 2, bh & 3, k == 0 ? 63 - i : (k == 1 ? i : -1), lam, oscale); }
    }
}
__device__ __forceinline__ h8 tr_frag_nat(LAS unsigned char* img_blk, int rowbase, int s, int lane) {
    const int h = lane >> 5, blk = (lane >> 4) & 1, i16 = lane & 15, q = i16 >> 2, p = i16 & 3;
    LAS unsigned char* a = img_blk + (rowbase + 16 * s + 8 * h + q) * 64 + (16 * blk + 4 * p) * 2;
    const s16x4 lo = __builtin_amdgcn_ds_read_tr16_b64_v4i16((LAS s16x4*)a);
    const s16x4 hi = __builtin_amdgcn_ds_read_tr16_b64_v4i16((LAS s16x4*)(a + 4 * 64));
    return __builtin_bit_cast(h8, __builtin_shufflevector(lo, hi, 0, 1, 2, 3, 4, 5, 6, 7));
}
__device__ __forceinline__ h8 tr_frag_krow(LAS unsigned char* img_blk, int rowbase, int s, int lane) {
    const int h = lane >> 5, blk = (lane >> 4) & 1, i16 = lane & 15, q = i16 >> 2, p = i16 & 3;
    LAS unsigned char* a = img_blk + (rowbase + 16 * s + 4 * h + q) * 64 + (16 * blk + 4 * p) * 2;
    const s16x4 lo = __builtin_amdgcn_ds_read_tr16_b64_v4i16((LAS s16x4*)a);
    const s16x4 hi = __builtin_amdgcn_ds_read_tr16_b64_v4i16((LAS s16x4*)(a + 8 * 64));
    return __builtin_bit_cast(h8, __builtin_shufflevector(lo, hi, 0, 1, 2, 3, 4, 5, 6, 7));
}
__device__ __forceinline__ float ret_log2gamma(int hc) { return log2f(1.0f - exp2f(-5.0f - (float)hc)); }
__device__ __forceinline__ h8 scale_h8(const h8& v, float sc) { h8 o;
#pragma unroll
    for (int e = 0; e < 8; ++e) o[e] = (_Float16)((float)v[e] * sc);
    return o; }

__device__ __forceinline__ void mixC1_unit(const Frame& F, int b, int hp, int c) {
    LAS unsigned char* L = F.lds + LDS_GEN;
    const int tid = F.tid, lane = F.lane, wave = F.wave;
    const unsigned char* proj = F.ws + WS_PROJ;
    const int row0 = c == 0 ? MR + b * NMETA : b * SEQ + 128 * (c - 1), Lc = c == 0 ? NMETA : 128;
    __syncthreads();
#pragma unroll 1
    for (int idx = tid; idx < 4096; idx += NTHREADS) {
        const int head = idx >> 11, arr = (idx >> 10) & 1, j = (idx >> 3) & 127, ch = idx & 7, hc = 2 * hp + head;
        h8 v;
#pragma unroll
        for (int e = 0; e < 8; ++e) v[e] = (_Float16)0.f;
        if (j < Lc) { v = *(const h8*)(proj + (arr ? PJ_VC : PJ_KC) + (size_t)(row0 + j) * 512 + hc * 128 + ch * 16);
            if (arr) v = scale_h8(v, exp2f((float)(Lc - 1 - j) * ret_log2gamma(hc))); }
        *(LAS h8*)(L + head * 32768 + arr * 16384 + (ch >> 2) * 8192 + j * 64 + (ch & 3) * 16) = v;
    }
    __syncthreads();
    const int head = wave >> 2, mb = (wave >> 1) & 1, nb = wave & 1, r = lane & 31, h = lane >> 5;
    f32x16 acc;
#pragma unroll
    for (int i = 0; i < 16; ++i) acc[i] = 0.f;
#pragma unroll
    for (int s = 0; s < 8; ++s) { const h8 a = tr_frag_nat(L + head * 32768 + mb * 8192, 0, s, lane), bb = tr_frag_nat(L + head * 32768 + 16384 + nb * 8192, 0, s, lane);
        acc = __builtin_amdgcn_mfma_f32_32x32x16_f16(a, bb, acc, 0, 0, 0); }
    float* U = (float*)(F.ws + WS_U) + ((size_t)((b * 4 + 2 * hp + head) * 129 + c)) * 4096;
#pragma unroll
    for (int i = 0; i < 16; ++i) U[(32 * mb + crow(i, h)) * 64 + 32 * nb + r] = acc[i];
}
__device__ __forceinline__ void mixC1_phase(const Frame& F) {
#pragma unroll 1
    for (int u = F.bid; u < NB * 2 * 129; u += F.G) { const int c = u % 129, bh = u / 129; mixC1_unit(F, bh >> 1, bh & 1, c); }
}
__device__ __forceinline__ void mixC_scan(const Frame& F) {
    if (F.tid >= 128) return;
    const int e = F.bid * 128 + F.tid;
    if (e >= NB * 4 * 4096) return;
    const int bh = e >> 12, el = e & 4095, hc = bh & 3;
    const float lg = ret_log2gamma(hc), g128 = exp2f(128.f * lg), g16 = exp2f(16.f * lg);
    const float* U = (const float*)(F.ws + WS_U) + (size_t)bh * 129 * 4096 + el; float* S = (float*)(F.ws + WS_S) + (size_t)bh * 129 * 4096 + el;
    float st = U[0];
    S[4096] = st;
#pragma unroll 1
    for (int c0 = 1; c0 < 128; c0 += 16) {
        float u[16];
#pragma unroll
        for (int k = 0; k < 16; ++k) u[k] = (c0 + k < 128) ? U[(size_t)(c0 + k) * 4096] : 0.f;
#pragma unroll
        for (int k = 0; k < 16; ++k) if (c0 + k < 128) { st = st * g128 + u[k]; S[(size_t)(c0 + k + 1) * 4096] = st; }
    }
    (void)g16;
}
constexpr int C2_KI = 0, C2_VI = 128 * KS_PITCH, C2_ST = C2_VI + 16384, C2_HEAD = C2_ST + 64 * KS_PITCH;
__device__ __forceinline__ void mixC2_unit(const Frame& F, int l, int b, int hp, int c) {
    LAS unsigned char* L = F.lds + LDS_GEN;
    const int tid = F.tid, lane = F.lane, wave = F.wave, r = lane & 31, h = lane >> 5;
    const unsigned char* proj = F.ws + WS_PROJ;
    const int row0 = c == 0 ? MR + b * NMETA : b * SEQ + 128 * (c - 1), Lc = c == 0 ? NMETA : 128;
    __syncthreads();
#pragma unroll 1
    for (int idx = tid; idx < 4096; idx += NTHREADS) {
        const int head = idx >> 11, arr = (idx >> 10) & 1, j = (idx >> 3) & 127, ch = idx & 7, hc = 2 * hp + head;
        h8 v;
#pragma unroll
        for (int e = 0; e < 8; ++e) v[e] = (_Float16)0.f;
        if (j < Lc) v = *(const h8*)(proj + (arr ? PJ_VC : PJ_KC) + (size_t)(row0 + j) * 512 + hc * 128 + ch * 16);
        if (arr) *(LAS h8*)(L + head * C2_HEAD + C2_VI + (ch >> 2) * 8192 + j * 64 + (ch & 3) * 16) = v;
        else     *(LAS h8*)(L + head * C2_HEAD + C2_KI + j * KS_PITCH + ch * 16) = v;
    }
    if (c > 0) {
#pragma unroll 1
        for (int idx = tid; idx < 2 * 4096; idx += NTHREADS) { const int head = idx >> 12, el = idx & 4095, dk = el >> 6, dv = el & 63;
            const float v = ((const float*)(F.ws + WS_S))[((size_t)((b * 4 + 2 * hp + head) * 129 + c)) * 4096 + el];
            *(LAS _Float16*)(L + head * C2_HEAD + C2_ST + dv * KS_PITCH + dk * 2) = (_Float16)v; }
    }
    __syncthreads();
    const int head = wave >> 2, wq = wave & 3, hc = 2 * hp + head;
    if (wq * 32 < Lc) {
        LAS unsigned char* Hb = L + head * C2_HEAD;
        const int qi = wq * 32 + r, my_row = row0 + qi;
        const float lg = ret_log2gamma(hc);
        h8 qf[4];
#pragma unroll
        for (int s = 0; s < 4; ++s) qf[s] = *(const h8*)(proj + PJ_QC + (size_t)my_row * 512 + hc * 128 + (16 * s + 8 * h) * 2);
        f32x16 O[2];
#pragma unroll
        for (int d = 0; d < 2; ++d)
#pragma unroll
            for (int i = 0; i < 16; ++i) O[d][i] = 0.f;
        if (c > 0) {
#pragma unroll
            for (int d = 0; d < 2; ++d)
#pragma unroll
                for (int s = 0; s < 4; ++s) { const h8 a = *(const LAS h8*)(Hb + C2_ST + (32 * d + r) * KS_PITCH + (16 * s + 8 * h) * 2);
                    O[d] = __builtin_amdgcn_mfma_f32_32x32x16_f16(a, qf[s], O[d], 0, 0, 0); }
            const float qd = exp2f((float)(qi + 1) * lg);
#pragma unroll
            for (int d = 0; d < 2; ++d)
#pragma unroll
                for (int i = 0; i < 16; ++i) O[d][i] *= qd;
        }
#pragma unroll 1
        for (int jb = 0; jb <= wq; ++jb) {
            f32x16 S;
#pragma unroll
            for (int i = 0; i < 16; ++i) S[i] = 0.f;
#pragma unroll
            for (int s = 0; s < 4; ++s) { const h8 kf = *(const LAS h8*)(Hb + C2_KI + (32 * jb + r) * KS_PITCH + (16 * s + 8 * h) * 2);
                S = __builtin_amdgcn_mfma_f32_32x32x16_f16(kf, qf[s], S, 0, 0, 0); }
#pragma unroll
            for (int i = 0; i < 16; ++i) { const int dd = qi - (32 * jb + crow(i, h)); S[i] = dd >= 0 ? S[i] * exp2f((float)dd * lg) : 0.f; }
            h8 pf[2];
#pragma unroll
            for (int s = 0; s < 2; ++s) { u32x4 p; p.x = cvt_pk_f16(S[8 * s + 0], S[8 * s + 1]); p.y = cvt_pk_f16(S[8 * s + 2], S[8 * s + 3]); p.z = cvt_pk_f16(S[8 * s + 4], S[8 * s + 5]); p.w = cvt_pk_f16(S[8 * s + 6], S[8 * s + 7]); pf[s] = __builtin_bit_cast(h8, p); }
#pragma unroll
            for (int d = 0; d < 2; ++d)
#pragma unroll
                for (int s = 0; s < 2; ++s) { const h8 vf = tr_frag_krow(Hb + C2_VI + d * 8192, 32 * jb, s, lane);
                    O[d] = __builtin_amdgcn_mfma_f32_32x32x16_f16(vf, pf[s], O[d], 0, 0, 0); }
        }
        float ss = 0.f;
#pragma unroll
        for (int d = 0; d < 2; ++d)
#pragma unroll
            for (int i = 0; i < 16; ++i) ss += O[d][i] * O[d][i];
        ss = hsum32(ss, lane);
        const float rstd = rsqrtf(ss * (1.0f / 64.0f) + 1e-6f);
        if (qi < Lc) {
            const float* gn = F.ret_norm + l * 256 + hc * 64;
            const _Float16* gc = (const _Float16*)(proj + PJ_GC) + (size_t)my_row * 256 + hc * 64;
            _Float16* dst = (_Float16*)(F.ws + WS_ABUF) + (size_t)my_row * DM + 768 + hc * 64;
#pragma unroll
            for (int d = 0; d < 2; ++d)
#pragma unroll
                for (int g4 = 0; g4 < 4; ++g4) { const int d0 = 32 * d + 8 * g4 + 4 * h; const f32x4 gv = *(const f32x4*)(gn + d0); const h4 gg = *(const h4*)(gc + d0);
                    float o[4];
#pragma unroll
                    for (int e = 0; e < 4; ++e) { const float g = (float)gg[e]; o[e] = O[d][4 * g4 + e] * rstd * gv[e] * (g / (1.0f + __expf(-g))); }
                    u32x2 w; w.x = cvt_pk_f16(o[0], o[1]); w.y = cvt_pk_f16(o[2], o[3]); *(u32x2*)(dst + d0) = w; }
        }
    }
}
__device__ __forceinline__ void mixC2_phase(const Frame& F, int l) {
#pragma unroll 1
    for (int u = F.bid; u < NB * 2 * 129; u += F.G) { const int c = u % 129, bh = u / 129; mixC2_unit(F, l, bh >> 1, bh & 1, c); }
}
constexpr int IDX_HIST = 0, IDX_STATS = 16512, IDX_INFO = 18816, IDX_CCNT = 19072, IDX_MASK = 19456, IDX_CAND = 85248, IDX_Q = IDX_CAND + 32 * 128 * 8, IDX_QPITCH = 1168, IDX_END = IDX_Q + 32 * IDX_QPITCH;
#ifndef PROBE_REP
#define PROBE_REP 0
#endif
constexpr int IDX_CAP = 128, IDX_NBIN = 128;
static_assert(IDX_END + LDS_GEN <= LDS_BYTES, "indexer LDS");
struct KFrag { h8 v[4]; };
__device__ __forceinline__ KFrag idx_load_k(const unsigned char* krow_ptr, int h) { KFrag k;
#pragma unroll
    for (int s = 0; s < 4; ++s) k.v[s] = *(const h8*)(krow_ptr + (16 * s + 8 * h) * 2);
    return k; }
#define IDX_LOADQ(dst, hd) do { _Pragma("unroll") for (int s_ = 0; s_ < 4; ++s_) dst[s_] = *(const LAS h8*)(qimg_lane + ((hd) * 64 + 16 * s_) * 2); } while (0)
#define IDX_MFMA4(acc, q) do { _Pragma("unroll") for (int s_ = 0; s_ < 4; ++s_) acc = __builtin_amdgcn_mfma_f32_32x32x16_f16(kf.v[s_], q[s_], acc, 0, 0, 0); } while (0)
#define IDX_FMA(hd, S) do { _Pragma("unroll") for (int i_ = 0; i_ < 16; ++i_) sc[i_] = __builtin_fmaf(w[hd], __builtin_fabsf(S[i_]), sc[i_]); } while (0)
#define IDX_SB __builtin_amdgcn_sched_barrier(0)
__device__ __forceinline__ void idx_scores(const LAS unsigned char* qimg_lane, const float (&w)[8], const KFrag& kf, f32x16& sc) {
    h8 q[2][4]; f32x16 S[2];
    IDX_LOADQ(q[0], 8); IDX_SB;
#pragma unroll
    for (int i = 0; i < 16; ++i) sc[i] = 0.f;
    IDX_MFMA4(sc, q[0]); IDX_LOADQ(q[1], 0); IDX_SB;
#pragma unroll
    for (int hd = 0; hd < 8; ++hd) {
#pragma unroll
        for (int i = 0; i < 16; ++i) S[hd & 1][i] = 0.f;
        IDX_MFMA4(S[hd & 1], q[(hd + 1) & 1]);
        if (hd < 7) IDX_LOADQ(q[hd & 1], hd + 1);
        if (hd > 0) IDX_FMA(hd - 1, S[(hd - 1) & 1]);
        IDX_SB;
    }
    IDX_FMA(7, S[1]);
}
#define IDX_PIN(V) asm volatile("" : "+v"(V[0]), "+v"(V[1]), "+v"(V[2]), "+v"(V[3]), "+v"(V[4]), "+v"(V[5]), "+v"(V[6]), "+v"(V[7]), "+v"(V[8]), "+v"(V[9]), "+v"(V[10]), "+v"(V[11]), "+v"(V[12]), "+v"(V[13]), "+v"(V[14]), "+v"(V[15]))
#define IDX_MFMA4K(acc, q, KF) do { _Pragma("unroll") for (int s_ = 0; s_ < 4; ++s_) acc = __builtin_amdgcn_mfma_f32_32x32x16_f16(KF.v[s_], q[s_], acc, 0, 0, 0); } while (0)
#define IDX_FMA2(SC, hd, S) do { _Pragma("unroll") for (int i_ = 0; i_ < 16; ++i_) SC[i_] = __builtin_fmaf(w[hd], __builtin_fabsf(S[i_]), SC[i_]); } while (0)
__device__ __forceinline__ void idx_scores2(const LAS unsigned char* qimg_lane, const float (&w)[8], const KFrag& kfA, const KFrag& kfB, f32x16& scA, f32x16& scB) {
    h8 q[2][4]; f32x16 SA, SB;
    IDX_LOADQ(q[0], 8); IDX_SB;
#pragma unroll
    for (int i = 0; i < 16; ++i) { scA[i] = 0.f; scB[i] = 0.f; }
    IDX_MFMA4K(scA, q[0], kfA); IDX_MFMA4K(scB, q[0], kfB); IDX_LOADQ(q[1], 0); IDX_SB;
#pragma unroll
    for (int hd = 0; hd < 8; ++hd) {
#pragma unroll
        for (int i = 0; i < 16; ++i) SA[i] = 0.f;
        IDX_MFMA4K(SA, q[(hd + 1) & 1], kfA);
        if (hd > 0) { IDX_FMA2(scB, hd - 1, SB); IDX_PIN(scB); }
        IDX_SB;
#pragma unroll
        for (int i = 0; i < 16; ++i) SB[i] = 0.f;
        IDX_MFMA4K(SB, q[(hd + 1) & 1], kfB);
        if (hd < 7) IDX_LOADQ(q[hd & 1], hd + 1);
        IDX_FMA2(scA, hd, SA); IDX_PIN(scA);
        IDX_SB;
    }
    IDX_FMA2(scB, 7, SB);
}
__device__ __forceinline__ int suffix_sum(int v, int lane) {
#pragma unroll
    for (int off = 1; off < 64; off <<= 1) { const int t = __builtin_amdgcn_ds_bpermute((lane + off) << 2, v); if (lane + off < 64) v += t; }
    return v;
}
__device__ __forceinline__ void mixA_index_unit(const Frame& F, int b, int g) {
    LAS unsigned char* L = F.lds + LDS_GEN;
    int tid_ = F.tid, lane_ = F.lane; asm volatile("" : "+v"(tid_), "+v"(lane_));
    const int tid = tid_, lane = lane_, wave = F.wave, r = lane & 31, h = lane >> 5;
    const unsigned char* proj = F.ws + WS_PROJ;
    const unsigned char* KI = proj + PJ_KI;
    const int nq = g == 0 ? NMETA : 32;
    const int qrow = g == 0 ? MR + b * NMETA + (r & 15) : b * SEQ + 32 * (g - 1) + r;
    const int tq0 = g == 0 ? 0 : NMETA + 32 * (g - 1);
    const bool qvalid = r < nq;
    auto ks_row0 = [&](int ks) -> int { return ks == 0 ? MR + b * NMETA : b * SEQ + 32 * (ks - 1); };
    __syncthreads();
    for (int i = tid; i < 32 * 129; i += NTHREADS) ((LAS unsigned*)(L + IDX_HIST))[i] = 0u;
    if (tid < 32) ((LAS unsigned*)(L + IDX_CCNT))[tid] = 0u;
    for (int i = tid; i < (g + 1) * 32; i += NTHREADS) ((LAS unsigned*)(L + IDX_MASK))[i] = 0u;
    float w[8];
    const LAS unsigned char* qf = L + IDX_Q + r * IDX_QPITCH + 8 * h * 2;
    { const float* WI = (const float*)(proj + PJ_WI) + (size_t)qrow * 8; const f32x4 w0 = *(const f32x4*)WI, w1 = *(const f32x4*)(WI + 4);
      w[0] = w0[0]; w[1] = w0[1]; w[2] = w0[2]; w[3] = w0[3]; w[4] = w1[0]; w[5] = w1[1]; w[6] = w1[2]; w[7] = w1[3]; }
    { const int qq = tid >> 4, dc = tid & 15; const int qr = g == 0 ? MR + b * NMETA + (qq & 15) : b * SEQ + 32 * (g - 1) + qq;
      const unsigned char* qsrc = proj + PJ_QI + (size_t)qr * 1024 + dc * 8; u32x2 qv[8];
#pragma unroll
      for (int hd = 0; hd < 8; ++hd) qv[hd] = *(const u32x2*)(qsrc + hd * 128);
      const float* WQ = (const float*)(proj + PJ_WI) + (size_t)qr * 8; const f32x4 wa = *(const f32x4*)WQ, wb = *(const f32x4*)(WQ + 4);
      const float wq[8] = {wa[0], wa[1], wa[2], wa[3], wb[0], wb[1], wb[2], wb[3]};
      float a4[4] = {0.f, 0.f, 0.f, 0.f};
#pragma unroll
      for (int hd = 0; hd < 8; ++hd) { const h4 q = __builtin_bit_cast(h4, qv[hd]);
#pragma unroll
          for (int e = 0; e < 4; ++e) a4[e] += wq[hd] * (float)q[e];
          *(LAS u32x2*)(L + IDX_Q + qq * IDX_QPITCH + hd * 128 + dc * 8) = qv[hd]; }
      u32x2 o; o.x = cvt_pk_f16(a4[0], a4[1]); o.y = cvt_pk_f16(a4[2], a4[3]);
      *(LAS u32x2*)(L + IDX_Q + qq * IDX_QPITCH + 1024 + dc * 8) = o; }
    __syncthreads();
    if (wave < 4) {
        const KFrag kf = idx_load_k(KI + (size_t)(b * SEQ + 32 * wave + r) * 128, h);
        f32x16 sc; idx_scores(qf, w, kf, sc);
        float s1 = 0.f, s2 = 0.f;
#pragma unroll
        for (int i = 0; i < 16; ++i) { s1 += sc[i]; s2 += sc[i] * sc[i]; }
        s1 = hsum32(s1, lane); s2 = hsum32(s2, lane);
        if (h == 0) { ((LAS float*)(L + IDX_STATS))[(wave * 32 + r) * 2] = s1; ((LAS float*)(L + IDX_STATS))[(wave * 32 + r) * 2 + 1] = s2; }
    }
    __syncthreads();
    float c0f, inv;
    { float s1 = 0.f, s2 = 0.f;
#pragma unroll
      for (int k = 0; k < 4; ++k) { s1 += ((LAS float*)(L + IDX_STATS))[(k * 32 + r) * 2]; s2 += ((LAS float*)(L + IDX_STATS))[(k * 32 + r) * 2 + 1]; }
      const float mean = s1 * (1.0f / 128.0f), var = fmaxf(s2 * (1.0f / 128.0f) - mean * mean, 0.f), sd = fmaxf(sqrtf(var), 1e-12f);
      inv = (float)IDX_NBIN / (10.0f * sd); c0f = -(mean - 3.0f * sd) * inv; }
    LAS unsigned* hrow = (LAS unsigned*)(L + IDX_HIST) + r * 129;
#if PROBE_REP == 12
    for (int rep12 = 0; rep12 < 2; ++rep12) { __syncthreads(); for (int i = tid; i < 32 * 129; i += NTHREADS) ((LAS unsigned*)(L + IDX_HIST))[i] = 0u; __syncthreads();
#else
    {
#endif
        auto krow = [&](int ks) -> const unsigned char* { return KI + (size_t)(ks_row0(ks <= g ? ks : g) + r) * 128; };
        KFrag kfA = idx_load_k(krow(2 * wave), h), kfB = idx_load_k(krow(2 * wave + 1), h);
#pragma unroll 1
        for (int ks = 2 * wave; ks <= g; ks += 16) {
            const KFrag knA = idx_load_k(krow(ks + 16), h), knB = idx_load_k(krow(ks + 17), h);
            f32x16 scv[2]; idx_scores2(qf, w, kfA, kfB, scv[0], scv[1]);
#pragma unroll
            for (int u2 = 0; u2 < 2; ++u2) {
                const int kss = ks + u2; if (kss > g) continue;
                if (kss == 0 || kss == g) {
#pragma unroll
                    for (int i = 0; i < 16; ++i) {
                        const int kidx = crow(i, h);
                        const bool ok = qvalid && (kss == 0 ? kidx < NMETA && (g > 0 || kidx <= r) : kidx <= r);
                        if (ok) { const unsigned bin = (unsigned)__builtin_amdgcn_fmed3f(__builtin_fmaf(scv[u2][i], inv, c0f), 0.f, (float)(IDX_NBIN - 1)); __hip_atomic_fetch_add(hrow + bin, 1u, __ATOMIC_RELAXED, __HIP_MEMORY_SCOPE_WORKGROUP); }
                    }
                } else {
#pragma unroll
                    for (int i = 0; i < 16; ++i) { const unsigned bin = (unsigned)__builtin_amdgcn_fmed3f(__builtin_fmaf(scv[u2][i], inv, c0f), 0.f, (float)(IDX_NBIN - 1)); __hip_atomic_fetch_add(hrow + bin, 1u, __ATOMIC_RELAXED, __HIP_MEMORY_SCOPE_WORKGROUP); }
                }
            }
            kfA = knA; kfB = knB;
        }
    }
    __syncthreads();
#pragma unroll 1
    for (int k = 0; k < 4; ++k) {
        const int row = 4 * wave + k;
        const int c0 = (int)((LAS unsigned*)(L + IDX_HIST))[row * 129 + 2 * lane], c1 = (int)((LAS unsigned*)(L + IDX_HIST))[row * 129 + 2 * lane + 1];
        const int SL = suffix_sum(c0 + c1, lane), NT = __builtin_amdgcn_readlane(SL, 0);
        int bstar = -1, need = 0;
        if (NT > 256) {
            const unsigned long long ml = __ballot(SL >= 256); const int lL = 63 - __builtin_clzll(ml); const int sl = __builtin_amdgcn_readlane(SL, lL), t0 = __builtin_amdgcn_readlane(c0, lL), t1 = __builtin_amdgcn_readlane(c1, lL); const int above = sl - t0 - t1;
            if (above + t1 >= 256) { bstar = 2 * lL + 1; need = 256 - above; } else { bstar = 2 * lL; need = 256 - above - t1; }
        }
        if (lane == 0) { ((LAS int*)(L + IDX_INFO))[row * 2] = bstar; ((LAS int*)(L + IDX_INFO))[row * 2 + 1] = need; }
    }
    __syncthreads();
    float lo_f, hi_f;
    { const int bstar = ((LAS int*)(L + IDX_INFO))[r * 2];
      hi_f = bstar < 0 ? -__builtin_inff() : (bstar >= IDX_NBIN - 1 ? __builtin_inff() : (float)(bstar + 1));
      lo_f = bstar <= 0 ? -__builtin_inff() : (float)bstar; }
    {
        auto krow = [&](int ks) -> const unsigned char* { return KI + (size_t)(ks_row0(ks <= g ? ks : g) + r) * 128; };
        KFrag kfA = idx_load_k(krow(2 * wave), h), kfB = idx_load_k(krow(2 * wave + 1), h);
#pragma unroll 1
        for (int ks = 2 * wave; ks <= g; ks += 16) {
            const KFrag knA = idx_load_k(krow(ks + 16), h), knB = idx_load_k(krow(ks + 17), h);
            f32x16 scv[2]; idx_scores2(qf, w, kfA, kfB, scv[0], scv[1]);
#pragma unroll
            for (int u2 = 0; u2 < 2; ++u2) {
                const int kss = ks + u2; if (kss > g) continue;
                unsigned part = 0u;
                const bool special = (kss == 0 || kss == g);
#pragma unroll
                for (int i = 0; i < 16; ++i) {
                    const int kidx = crow(i, h);
                    bool ok = true;
                    if (special) ok = qvalid && (kss == 0 ? kidx < NMETA && (g > 0 || kidx <= r) : kidx <= r);
                    const float x = __builtin_fmaf(scv[u2][i], inv, c0f);
                    const bool sure = ok && (x >= hi_f), cand = ok && !(x >= hi_f) && (x >= lo_f);
                    part |= sure ? (1u << kidx) : 0u;
                    if (cand) { const unsigned slot = __hip_atomic_fetch_add((LAS unsigned*)(L + IDX_CCNT) + r, 1u, __ATOMIC_RELAXED, __HIP_MEMORY_SCOPE_WORKGROUP);
                        if (slot < IDX_CAP) { LAS float* cp = (LAS float*)(L + IDX_CAND) + (r * IDX_CAP + slot) * 2; cp[0] = scv[u2][i]; ((LAS int*)cp)[1] = kss * 32 + kidx; } }
                }
                __hip_atomic_fetch_or((LAS unsigned*)(L + IDX_MASK) + kss * 32 + r, part, __ATOMIC_RELAXED, __HIP_MEMORY_SCOPE_WORKGROUP);
            }
            kfA = knA; kfB = knB;
        }
    }
    __syncthreads();
#pragma unroll 1
    for (int k = 0; k < 4; ++k) {
        const int row = 4 * wave + k;
        const int need = ((LAS int*)(L + IDX_INFO))[row * 2 + 1];
        int nc = (int)((LAS unsigned*)(L + IDX_CCNT))[row]; nc = nc < IDX_CAP ? nc : IDX_CAP;
        nc = __builtin_amdgcn_readfirstlane(nc);
        if (nc == 0) continue;
        const LAS float* cb = (const LAS float*)(L + IDX_CAND) + row * IDX_CAP * 2;
        const bool v0 = lane < nc, v1 = lane + 64 < nc;
        const float s0 = v0 ? cb[lane * 2] : 0.f, s1 = v1 ? cb[(lane + 64) * 2] : 0.f;
        const int k0 = v0 ? ((const LAS int*)cb)[lane * 2 + 1] : 0, k1 = v1 ? ((const LAS int*)cb)[(lane + 64) * 2 + 1] : 0;
        int r0 = 0, r1 = 0;
        if (__builtin_amdgcn_readfirstlane(need) < nc) {
            const int n0 = nc < 64 ? nc : 64;
#pragma unroll 1
            for (int j = 0; j < n0; ++j) { const float sj = __builtin_bit_cast(float, __builtin_amdgcn_readlane(__builtin_bit_cast(int, s0), j)); const int kj = __builtin_amdgcn_readlane(k0, j);
                r0 += (sj > s0 || (sj == s0 && kj < k0)) ? 1 : 0; r1 += (sj > s1 || (sj == s1 && kj < k1)) ? 1 : 0; }
#pragma unroll 1
            for (int j = 64; j < nc; ++j) { const float sj = __builtin_bit_cast(float, __builtin_amdgcn_readlane(__builtin_bit_cast(int, s1), j - 64)); const int kj = __builtin_amdgcn_readlane(k1, j - 64);
                r0 += (sj > s0 || (sj == s0 && kj < k0)) ? 1 : 0; r1 += (sj > s1 || (sj == s1 && kj < k1)) ? 1 : 0; }
        }
        if (v0 && r0 < need) __hip_atomic_fetch_or((LAS unsigned*)(L + IDX_MASK) + (k0 >> 5) * 32 + row, 1u << (k0 & 31), __ATOMIC_RELAXED, __HIP_MEMORY_SCOPE_WORKGROUP);
        if (v1 && r1 < need) __hip_atomic_fetch_or((LAS unsigned*)(L + IDX_MASK) + (k1 >> 5) * 32 + row, 1u << (k1 & 31), __ATOMIC_RELAXED, __HIP_MEMORY_SCOPE_WORKGROUP);
    }
    __syncthreads();
    unsigned* MK = (unsigned*)(F.ws + WS_MASK) + (size_t)b * NKS * TLEN;
    for (int i = tid; i < (g + 1) * 32; i += NTHREADS) { const int ks = i >> 5, rr = i & 31; if (rr < nq) MK[(size_t)ks * TLEN + tq0 + rr] = ((LAS unsigned*)(L + IDX_MASK))[i]; }
}
__device__ __forceinline__ void mixA_index_phase(const Frame& F) {
#pragma unroll 1
    for (int c = F.bid; c < 256; c += F.G) {
#pragma unroll 1
        for (int k = 0; k < 5; ++k) {
            int u; if (k == 0) u = c; else if (k == 1) u = 511 - c; else if (k == 2) u = 512 + c; else if (k == 3) u = 1023 - c; else { if (c >= 2) break; u = 1024 + c; }
            mixA_index_unit(F, u & 1, 512 - (u >> 1));
        }
    }
}

__device__ __forceinline__ void mixA3_unit(const Frame& F, int l, int b, int ha, int qblk) {
    LAS unsigned char* L = F.lds + LDS_GEN;
    const int tid = F.tid, lane = F.lane, wave = F.wave, r = lane & 31, h = lane >> 5;
    const unsigned char* proj = F.ws + WS_PROJ;
    const _Float16* QA = (const _Float16*)(proj + PJ_QA); const unsigned char* KA = proj + PJ_KA; const unsigned char* VA = proj + PJ_VA;
    const unsigned* kmax = (const unsigned*)(F.ws + WS_CTL) + CW_KMAX + 32 * l;
    const unsigned* MK = (const unsigned*)(F.ws + WS_MASK) + (size_t)b * NKS * TLEN;
    const bool meta_u = qblk < 0;
    const int qrow0 = meta_u ? MR + b * NMETA : b * SEQ + qblk * 256;
    const int qpos0 = meta_u ? 0 : NMETA + qblk * 256;
    const int nreal = meta_u ? 0 : 2 * qblk + 2;
    const int wq0 = 32 * wave;
    const bool wave_on = meta_u ? (wave == 0) : true;
    const int my_row = wave_on ? qrow0 + wq0 + r : qrow0, my_pos = wave_on ? qpos0 + wq0 + r : 0;
    __syncthreads();
    if (tid < 128) ((LAS float*)(L + B_LUT))[tid] = F.rel_bias[BUCKET_LUT[tid] * 12 + ha] * LOG2E;
    float bmax = (lane < 32) ? F.rel_bias[lane * 12 + ha] * LOG2E : -1e30f;
    bmax = fmaxf(bmax, sx<16>(bmax, lane)); bmax = fmaxf(bmax, sx<8>(bmax, lane)); bmax = fmaxf(bmax, sx<4>(bmax, lane)); bmax = fmaxf(bmax, sx<2>(bmax, lane)); bmax = fmaxf(bmax, sx<1>(bmax, lane));
    bmax = bcast0(bmax);
    const float bfar = F.rel_bias[31 * 12 + ha] * LOG2E;
    h8 qf[4]; float mref; bool safe;
    { float n2 = 0.f;
#pragma unroll
      for (int s = 0; s < 4; ++s) { qf[s] = *(const h8*)(QA + (size_t)my_row * 512 + ha * 64 + 16 * s + 8 * h);
#pragma unroll
          for (int j = 0; j < 8; ++j) { const float v = (float)qf[s][j]; n2 += v * v; } }
      n2 = hsum32(n2, lane);
      mref = sqrtf(n2 * (__uint_as_float(kmax[ha * 2]) + __uint_as_float(kmax[ha * 2 + 1]))) * 1.002f + bmax;
      safe = __all(mref - bfar < 60.0f); if (safe) mref = bfar; }
    f32x16 O[2], Lacc;
#pragma unroll
    for (int i = 0; i < 16; ++i) { O[0][i] = 0.f; O[1][i] = 0.f; Lacc[i] = 0.f; }
    bf16x8v ones; { const u32x4 o = {0x3F803F80u, 0x3F803F80u, 0x3F803F80u, 0x3F803F80u}; ones = __builtin_bit_cast(bf16x8v, o); }
    const int skey = tid >> 3, sch = tid & 7;
    const unsigned kdst = skey * KS_PITCH + sch * 16, vdst = (sch >> 2) * (TK * 64) + skey * 64 + (sch & 3) * 16;
    const int ntiles = 1 + nreal;
    auto tile_row0 = [&](int t) -> int { return t == 0 ? MR + b * NMETA : b * SEQ + (t - 1) * TK; };
    u32x4 kreg[2], vreg[2];
#pragma unroll
    for (int j = 0; j < 2; ++j) { const size_t rr = (size_t)(tile_row0(0) + skey + 64 * j); kreg[j] = *(const u32x4*)(KA + rr * 1024 + ha * 128 + sch * 16); vreg[j] = *(const u32x4*)(VA + rr * 1024 + ha * 128 + sch * 16); }
#pragma unroll
    for (int j = 0; j < 2; ++j) { *(LAS u32x4*)(L + B_KS + kdst + j * 64 * KS_PITCH) = kreg[j]; *(LAS u32x4*)(L + B_VS + vdst + j * 64 * 64) = vreg[j]; }
    __syncthreads();
    unsigned mw[4], mwn[4] = {0u, 0u, 0u, 0u};
    mw[0] = MK[my_pos]; mw[1] = 0u; mw[2] = 0u; mw[3] = 0u;
    const int wpos0 = qpos0 + wq0;
#pragma unroll 1
    for (int t = 0; t < ntiles; ++t) {
        const int buf = t & 1;
        if (t + 1 < ntiles) {
#pragma unroll
            for (int j = 0; j < 2; ++j) { const size_t rr = (size_t)(tile_row0(t + 1) + skey + 64 * j); kreg[j] = *(const u32x4*)(KA + rr * 1024 + ha * 128 + sch * 16); vreg[j] = *(const u32x4*)(VA + rr * 1024 + ha * 128 + sch * 16); }
#pragma unroll
            for (int j = 0; j < 4; ++j) mwn[j] = MK[(size_t)(1 + 4 * t + j) * TLEN + my_pos]; }
        const int kpos0 = (t == 0) ? 0 : NMETA + (t - 1) * TK, nvalid = (t == 0) ? NMETA : TK;
        if (wave_on && kpos0 <= wpos0 + 31) {
            LAS unsigned char* Kb = L + B_KS + buf * KBUF; LAS unsigned char* Vb = L + B_VS + buf * VBUF;
#pragma unroll
            for (int sub = 0; sub < 4; ++sub) {
                if (sub * 32 >= nvalid || kpos0 + sub * 32 > wpos0 + 31) continue;
                const bool slow = !safe || (t == 0) || (kpos0 + sub * 32 + 31 > wpos0 - 128);
                const unsigned mword = mw[sub] >> (4 * h);
                f32x16 S;
                h8 kfr[4]; bf16x8v vfr[2][2];
#pragma unroll
                for (int s = 0; s < 4; ++s) kfr[s] = *(const LAS h8*)(Kb + (sub * 32 + r) * KS_PITCH + (16 * s + 8 * h) * 2);
#pragma unroll
                for (int d = 0; d < 2; ++d)
#pragma unroll
                    for (int s = 0; s < 2; ++s) vfr[d][s] = vt_frag(Vb, d, sub * 32, s, lane);
                __builtin_amdgcn_sched_barrier(0);
#pragma unroll
                for (int i = 0; i < 16; ++i) S[i] = 0.f;
#pragma unroll
                for (int s = 0; s < 4; ++s) S = __builtin_amdgcn_mfma_f32_32x32x16_f16(kfr[s], qf[s], S, 0, 0, 0);
                bf16x8v pf[2];
                if (slow) {
                    float bs[16];
#pragma unroll
                    for (int i = 0; i < 16; ++i) { const int dist = my_pos - (kpos0 + sub * 32 + crow(i, h)); bs[i] = ((const LAS float*)(L + B_LUT))[min(max(dist, 0), 127)]; }
#pragma unroll
                    for (int i = 0; i < 16; ++i) {
                        const int kidx = sub * 32 + crow(i, h), dist = my_pos - (kpos0 + kidx);
                        const bool ok = ((mword >> ((i & 3) + 8 * (i >> 2))) & 1u) != 0u && dist >= 0 && kidx < nvalid;
                        const float e = __builtin_amdgcn_exp2f(fminf(S[i] + (bs[i] - mref), 80.f));
                        S[i] = ok ? e : 0.f;
                    }
                    pf[0] = pack_p(S, 0); pf[1] = pack_p(S, 1);
                } else {
#pragma unroll
                    for (int i = 0; i < 16; ++i) S[i] = __uint_as_float(__float_as_uint(__builtin_amdgcn_exp2f(S[i])) & (unsigned)__builtin_amdgcn_sbfe((int)mword, (i & 3) + 8 * (i >> 2), 1));
                    pf[0] = pack_p(S, 0); pf[1] = pack_p(S, 1);
                }
#pragma unroll
                for (int s = 0; s < 2; ++s) { Lacc = __builtin_amdgcn_mfma_f32_32x32x16_bf16(ones, pf[s], Lacc, 0, 0, 0);
#pragma unroll
                    for (int d = 0; d < 2; ++d) O[d] = __builtin_amdgcn_mfma_f32_32x32x16_bf16(vfr[d][s], pf[s], O[d], 0, 0, 0); }
            }
        }
        if (t + 1 < ntiles) {
#pragma unroll
            for (int j = 0; j < 2; ++j) { *(LAS u32x4*)(L + B_KS + (buf ^ 1) * KBUF + kdst + j * 64 * KS_PITCH) = kreg[j]; *(LAS u32x4*)(L + B_VS + (buf ^ 1) * VBUF + vdst + j * 64 * 64) = vreg[j]; } }
#pragma unroll
        for (int j = 0; j < 4; ++j) mw[j] = mwn[j];
        __syncthreads();
    }
    if (wave_on) {
        const float il = 1.0f / Lacc[0];
        if (!meta_u || r < NMETA) {
            _Float16* dst = (_Float16*)(F.ws + WS_ABUF) + (size_t)my_row * DM + ha * 64;
#pragma unroll
            for (int d = 0; d < 2; ++d)
#pragma unroll
                for (int g4 = 0; g4 < 4; ++g4) { const int d0 = 32 * d + 8 * g4 + 4 * h;
                    u32x2 w; w.x = cvt_pk_f16(O[d][4 * g4 + 0] * il, O[d][4 * g4 + 1] * il); w.y = cvt_pk_f16(O[d][4 * g4 + 2] * il, O[d][4 * g4 + 3] * il);
                    *(u32x2*)(dst + d0) = w; }
        }
    }
}
__device__ __forceinline__ void mixA3_phase(const Frame& F, int l) {
#pragma unroll 1
    for (int c = F.bid; c < 256; c += F.G) { const int bh = c & 15, i1 = c >> 4, i2 = 31 - i1;
#pragma unroll 1
        for (int k = 0; k < 5; ++k) { if (k == 4 && c >= 16) break;
            const int qb = k == 0 ? 63 - i1 : (k == 1 ? 32 + i1 : (k == 2 ? i2 : (k == 3 ? i1 : -1)));
            mixA3_unit(F, l, bh >> 3, bh & 7, qb); }
    }
}
constexpr int NPHASES = 19;
__global__ void __launch_bounds__(NTHREADS, 2) fwd(Args args) {
    extern __shared__ __attribute__((aligned(16))) unsigned char lds_raw[];
    Frame F;
    F.x = args.in[0]; F.meta = args.in[1]; F.rel_bias = args.in[2]; F.w_in = args.in[3]; F.norm_mix = args.in[4]; F.diff_lambda = args.in[5]; F.diff_norm = args.in[6];
    F.ret_norm = args.in[7]; F.w_out = args.in[8]; F.norm_ff = args.in[9]; F.w_ff1 = args.in[10]; F.w_ff2 = args.in[11]; F.final_norm = args.in[12];
    F.out = args.out; F.ws = args.ws; F.lds = (LAS unsigned char*)lds_raw;
    F.bid = blockIdx.x; F.G = gridDim.x; F.tid = threadIdx.x; F.lane = F.tid & 63; F.wave = __builtin_amdgcn_readfirstlane(F.tid >> 6);
    if (F.tid < 64) ((LAS unsigned*)(F.lds + LDS_MISC))[F.tid] = 0u;
    __syncthreads();
    unsigned* ctl = (unsigned*)(F.ws + WS_CTL);
    XcdBarrier bar = xcd_barrier_post(ctl + CW_BAR, (volatile LAS unsigned*)(F.lds + LDS_MISC));
    const int lo = args.ph_lo, hi = args.ph_hi;
#define IN(k) (lo <= (k) && (k) < hi)
#ifndef PROBE_REP
#define PROBE_REP 0
#endif
#define RETID() do { unsigned z0_ = 0u; asm volatile("" : "+s"(z0_)); int t_ = (int)__builtin_amdgcn_mbcnt_hi(~0u, __builtin_amdgcn_mbcnt_lo(~0u, z0_)); asm volatile("" : "+v"(t_)); F.lane = t_; F.tid = F.wave * 64 + t_; } while (0)
#define REP(k) _Pragma("unroll 1") for (int rep_ = 0; rep_ < ((PROBE_REP == (k)) ? 2 : 1); ++rep_)
#define SEAM(k) do { if (IN(k) && IN((k) + 1)) xcd_barrier(bar, F.wave == 0 && F.lane == 0); } while (0)
    LAS unsigned char* stage = F.lds + LDS_GEN;
    if (IN(0)) { REP(10) prologue(F); SEAM(0);
#if PROBE_REP == 20
        for (int xb = 0; xb < 20; ++xb) xcd_barrier(bar, F.wave == 0 && F.lane == 0);
#endif
    }
#pragma unroll 1
    for (int l = 0; l < DEPTH; ++l) {
        const int pb = 1 + 9 * l;
        { RETID();
          size_t z_ = 0; int b_ = blockIdx.x, g_ = gridDim.x; asm volatile("" : "+s"(z_), "+s"(b_), "+s"(g_)); F.ws = args.ws + z_; F.out = args.out + z_; F.bid = b_; F.G = g_; }
        unsigned char* wl = F.ws + WS_W + (size_t)l * W_LAYER;
        unsigned char* proj = F.ws + WS_PROJ;
        if (IN(pb + 0)) {
            pg8::Gemm g{(const pg8::bf16_t*)(F.ws + WS_ABUF), (const pg8::bf16_t*)(wl + W_IN_OFF), MP, NPAD, DM}; pg8::StaticOrder S; S.init(MP, NPAD, F.G, F.bid);
            EpiInProj E{proj, (const f32x2*)(F.ws + WS_ROPE), ctl + CW_KMAX + 32 * l};
            pg8::gemm_phase<EpiInProj, pg8::StaticOrder, true, true>(stage, g, S, E, F.tid);
#if PROBE_REP == 7
            RETID(); pg8::gemm_phase<EpiInProj, pg8::StaticOrder, true, true>(stage, g, S, E, F.tid);
#endif
            SEAM(pb + 0);
        }
        if (IN(pb + 1)) { RETID(); REP(1) mixA_index_phase(F); RETID(); REP(2) mixC1_phase(F); SEAM(pb + 1); }
        if (IN(pb + 2)) { RETID(); REP(3) mixC_scan(F); RETID(); REP(4) mixB_phase(F, l); SEAM(pb + 2); }
        if (IN(pb + 3)) { RETID(); REP(5) mixA3_phase(F, l); RETID(); REP(6) mixC2_phase(F, l); SEAM(pb + 3); }
        if (IN(pb + 4)) { RETID();
            skinny_meta<0>(F, wl); RETID();
            pg8::Gemm g{(const pg8::bf16_t*)(F.ws + WS_ABUF), (const pg8::bf16_t*)(wl + W_OUT_OFF), MR, DM, DM}; pg8::StaticOrder S; S.init(MR, DM, F.G, F.bid);
            EpiRes E{l == 0 ? F.x : F.out, F.out, (float*)(F.ws + WS_HMETA)};
            pg8::gemm_phase<EpiRes, pg8::StaticOrder, true, true>(stage, g, S, E, F.tid);
            SEAM(pb + 4);
        }
        if (IN(pb + 5)) { RETID(); zero_scr(F); REP(8) norm_to_abuf<1>(F, F.norm_ff + (size_t)l * DM); SEAM(pb + 5); }
        if (IN(pb + 6)) { RETID();
            skinny_meta<1>(F, wl); RETID();
            pg8::Gemm g{(const pg8::bf16_t*)(F.ws + WS_ABUF), (const pg8::bf16_t*)(wl + W_FF1_OFF), MR, DFF, DM}; pg8::StaticOrder S; S.init(MR, DFF, F.G, F.bid);
            EpiRelu2 E{proj};
            pg8::gemm_phase<EpiRelu2, pg8::StaticOrder, true, true>(stage, g, S, E, F.tid);
#if PROBE_REP == 9
            RETID(); pg8::gemm_phase<EpiRelu2, pg8::StaticOrder, true, true>(stage, g, S, E, F.tid);
#endif
            SEAM(pb + 6);
        }
        if (IN(pb + 7)) { RETID();
            skinny_meta<2>(F, wl); RETID();
            pg8::Gemm g{(const pg8::bf16_t*)proj, (const pg8::bf16_t*)(wl + W_FF2_OFF), MR, DM, DFF}; pg8::StaticOrder S; S.init(MR, DM, F.G, F.bid);
            EpiRes E{F.out, F.out, (float*)(F.ws + WS_HMETA)};
#if PROBE_REP == 14
            { EpiRes E2{F.out, (float*)(F.ws + WS_ABUF), (float*)(F.ws + WS_U)}; pg8::gemm_phase<EpiRes, pg8::StaticOrder, true, true>(stage, g, S, E2, F.tid); RETID(); }
#endif
            pg8::gemm_phase<EpiRes, pg8::StaticOrder, true, true>(stage, g, S, E, F.tid);
            SEAM(pb + 7);
        }
        if (IN(pb + 8)) { RETID();
            if (l + 1 < DEPTH) { norm_to_abuf<1>(F, F.norm_mix + (size_t)(l + 1) * DM); SEAM(pb + 8); }
            else final_norm(F);
        }
    }
#undef IN
#undef SEAM
}

#ifndef MK_SPLIT
#define MK_SPLIT 0
#endif
extern "C" void kernel_launch(void* const* d_in, const int* in_sizes, int n_in, void* d_out, int out_size, void* d_ws, size_t ws_size, hipStream_t stream) {
    static int grid = 0;
    if (grid == 0) {
        if (n_in != 13 || ws_size < WS_END) { fprintf(stderr, "kernel_launch: need 13 inputs and %zu bytes of workspace; got %d, %zu\n", (size_t)WS_END, n_in, ws_size); grid = -1; return; }
        int dev = 0, cus = 0, per_cu = 0;
        if (hipGetDevice(&dev) != hipSuccess || hipDeviceGetAttribute(&cus, hipDeviceAttributeMultiprocessorCount, dev) != hipSuccess) { grid = -1; return; }
        if (hipFuncSetAttribute((const void*)fwd, hipFuncAttributeMaxDynamicSharedMemorySize, LDS_BYTES) != hipSuccess) { fprintf(stderr, "kernel_launch: hipFuncSetAttribute failed\n"); grid = -1; return; }
        if (hipOccupancyMaxActiveBlocksPerMultiprocessor(&per_cu, (const void*)fwd, NTHREADS, LDS_BYTES) != hipSuccess || per_cu < 1) { fprintf(stderr, "kernel_launch: occupancy query says %d\n", per_cu); }
        (void)hipGetLastError();
        grid = cus;
    }
    if (grid < 0) return;
    (void)hipMemsetAsync((char*)d_ws + WS_CTL, 0, CTL_BYTES, stream);
    Args a{};
    for (int i = 0; i < 13; ++i) a.in[i] = (const float*)d_in[i];
    a.out = (float*)d_out; a.ws = (unsigned char*)d_ws;
#if MK_SPLIT
    for (int p = 0; p < NPHASES; ++p) { a.ph_lo = p; a.ph_hi = p + 1; hipLaunchKernelGGL(fwd, dim3(grid), dim3(NTHREADS), LDS_BYTES, stream, a); }
#else
    a.ph_lo = 0; a.ph_hi = NPHASES; hipLaunchKernelGGL(fwd, dim3(grid), dim3(NTHREADS), LDS_BYTES, stream, a);
#endif
}
```

```cpp
#include <hip/hip_runtime.h>
#include <cstdio>
#include <cstdint>
typedef _Float16 h8 __attribute__((ext_vector_type(8)));
typedef _Float16 h4 __attribute__((ext_vector_type(4)));
typedef _Float16 h2 __attribute__((ext_vector_type(2)));
typedef short s16x8 __attribute__((ext_vector_type(8)));
typedef short s16x4 __attribute__((ext_vector_type(4)));
typedef float f32x16 __attribute__((ext_vector_type(16)));
typedef float f32x2 __attribute__((ext_vector_type(2)));
typedef unsigned u32x2 __attribute__((ext_vector_type(2)));
namespace pg8 {
#define PG8_LAS __attribute__((address_space(3)))
typedef unsigned short bf16_t;
typedef short bf16x8 __attribute__((ext_vector_type(8)));
typedef float f32x4 __attribute__((ext_vector_type(4)));
typedef unsigned u32x4 __attribute__((ext_vector_type(4)));
constexpr int BM = 256, BK = 64, HALF = 128, HTB = HALF * BK * 2  , STAGE_BYTES = 8 * HTB, NXCD = 8, WGM = 8;

__host__ __device__ __forceinline__ int lds_byte(int r, int c) { const int st = (r >> 4) * 2 + (c >> 5), rr = r & 15, cc = c & 31, ob = rr * 64 + cc * 2; return st * 1024 + (ob ^ (((ob >> 9) & 1) << 5)); }
__host__ __device__ __forceinline__ void stage_rc(int b, int& R, int& C) { const int st = b / 1024, sb = b % 1024, swz = sb ^ (((sb >> 9) & 1) << 5); R = (st >> 1) * 16 + swz / 64; C = (st & 1) * 32 + (swz % 64) / 2; }
__host__ __device__ __forceinline__ int perm32(int rho) { const int n = rho >> 4, i = rho & 15; return 8 * (i >> 2) + 4 * n + (i & 3); }

struct Unit { int pm, pn; };
struct Gemm { const bf16_t* A; const bf16_t* Bt; int M, N, K; };

struct StaticOrder {
    int nM, nN, nwg, G, c;
    __host__ __device__ void init(int M, int N, int G_, int c_) { nM = M / BM; nN = N / BM; nwg = nM * nN; G = G_; c = c_; }
    __host__ __device__ bool next(int i, Unit& u) const {
        const long L = (long)i * G + c; if (L >= nwg) return false;
        int wgid = (int)L; { const int q = nwg / NXCD, r = nwg % NXCD, xcd = wgid % NXCD, off = wgid / NXCD; wgid = (xcd < r ? xcd * (q + 1) : r * (q + 1) + (xcd - r) * q) + off; }
        const int nig = WGM * nN, gid = wgid / nig, fm = gid * WGM, gsz = (nM - fm) < WGM ? (nM - fm) : WGM;
        u.pm = fm + ((wgid % nig) % gsz); u.pn = (wgid % nig) / gsz; return true;
    }
    __device__ __forceinline__ void a_ready(const Unit&) const {}
    __device__ __forceinline__ void done(const Unit&) const {}
};

template <class Epi, class Sched, bool ALIGN_EPI = false, bool SP2 = false>
__device__ __forceinline__ void gemm_phase(PG8_LAS unsigned char* lds, const Gemm g, const Sched& S, const Epi& E, int tid_in) {
    int tid_ = tid_in; asm volatile("" : "+v"(tid_));
    const int tid = tid_, wid = __builtin_amdgcn_readfirstlane(tid >> 6), lane = tid & 63, wr = wid >> 2, wc = wid & 3, fr = lane & 15, fq = lane >> 4;
    const int K = g.K, nt = K / BK;
    unsigned voffA[2], voffB[2];
#pragma unroll
    for (int i = 0; i < 2; ++i) { int R, C; stage_rc(tid * 16 + i * 8192, R, C); const int Rb = Epi::PERM ? ((R & ~31) + perm32(R & 31)) : R;
        voffA[i] = (unsigned)(R * K + C) * 2u; voffB[i] = (unsigned)(Rb * K + C) * 2u; }
    const size_t kstep = (size_t)(BK * 2);
    const size_t hstep = (size_t)HALF * K * 2;
    const size_t tstep = 2 * hstep;
    const unsigned ldsw = (unsigned)wid * 1024u;
    const int aoff = lds_byte(wr * 64 + fr, fq * 8), boff = lds_byte(wc * 32 + fr, fq * 8);
#define PG8_SA(b, h) (((b) * 2 + (h)) * HTB)
#define PG8_SB(b, h) ((4 + (b) * 2 + (h)) * HTB)
#define PG8_STAGE(bufoff, gbase, voff) do { _Pragma("unroll") for (int _i = 0; _i < 2; ++_i) \
        __builtin_amdgcn_global_load_lds((const unsigned*)((const char*)(gbase) + (voff)[_i]), (PG8_LAS unsigned*)(lds + (bufoff) + ldsw + _i * 8192), 16, 0, 0); } while (0)
#define PG8_LDA(dst, b, h) do { _Pragma("unroll") for (int m = 0; m < 4; ++m) _Pragma("unroll") for (int k = 0; k < 2; ++k) dst[m][k] = *(const PG8_LAS bf16x8*)(lds + PG8_SA(b, h) + aoff + m * 2048 + k * 1024); } while (0)
#define PG8_LDB(dst, b, h) do { _Pragma("unroll") for (int n = 0; n < 2; ++n) _Pragma("unroll") for (int k = 0; k < 2; ++k) dst[n][k] = *(const PG8_LAS bf16x8*)(lds + PG8_SB(b, h) + boff + n * 2048 + k * 1024); } while (0)
#define PG8_MMA(ai, bj, At, Bt) do { __builtin_amdgcn_s_setprio(1); _Pragma("unroll") for (int m = 0; m < 4; ++m) _Pragma("unroll") for (int n = 0; n < 2; ++n) _Pragma("unroll") for (int k = 0; k < 2; ++k) \
        acc[ai][bj][m][n] = __builtin_amdgcn_mfma_f32_16x16x32_f16(__builtin_bit_cast(h8, Bt[n][k]), __builtin_bit_cast(h8, At[m][k]), acc[ai][bj][m][n], 0, 0, 0); __builtin_amdgcn_s_setprio(0); } while (0)
#define PG8_WAIT_V(n) asm volatile("s_waitcnt vmcnt(" #n ")" ::: "memory")
#define PG8_WAIT_L(n) asm volatile("s_waitcnt lgkmcnt(" #n ")" ::: "memory")
#define PG8_BAR __builtin_amdgcn_s_barrier()
#define PG8_SCHED __builtin_amdgcn_sched_barrier(0)
    Unit cur, nxt; int ui = 0;
    if (!S.next(0, cur)) return;
    f32x4 acc[2][2][4][2];
#pragma unroll
    for (int a = 0; a < 2; ++a)
#pragma unroll
        for (int b = 0; b < 2; ++b)
#pragma unroll
            for (int m = 0; m < 4; ++m)
#pragma unroll
                for (int n = 0; n < 2; ++n) acc[a][b][m][n] = (f32x4){0.f, 0.f, 0.f, 0.f};
    bf16x8 At[4][2], B0[2][2], B1[2][2];
    const char* cA = (const char*)g.A + (size_t)cur.pm * tstep; const char* cB = (const char*)g.Bt + (size_t)cur.pn * tstep;
    S.a_ready(cur);
    if constexpr (SP2) {
        PG8_STAGE(PG8_SB(0, 0), cB, voffB); PG8_STAGE(PG8_SB(0, 1), cB + hstep, voffB); PG8_STAGE(PG8_SA(0, 0), cA, voffA); PG8_STAGE(PG8_SA(0, 1), cA + hstep, voffA);
        if (wr == 1) PG8_BAR;
        PG8_WAIT_V(2); PG8_BAR;
        PG8_STAGE(PG8_SB(1, 0), cB + kstep, voffB); PG8_STAGE(PG8_SA(1, 0), cA + kstep, voffA); PG8_STAGE(PG8_SB(1, 1), cB + hstep + kstep, voffB);
        PG8_WAIT_V(6); PG8_BAR;
    } else {
        PG8_STAGE(PG8_SB(0, 0), cB, voffB); PG8_STAGE(PG8_SA(0, 0), cA, voffA); PG8_STAGE(PG8_SB(0, 1), cB + hstep, voffB); PG8_STAGE(PG8_SA(0, 1), cA + hstep, voffA);
        if (wr == 1) PG8_BAR;
        PG8_WAIT_V(4); PG8_BAR;
        PG8_STAGE(PG8_SB(1, 0), cB + kstep, voffB); PG8_STAGE(PG8_SA(1, 0), cA + kstep, voffA); PG8_STAGE(PG8_SB(1, 1), cB + hstep + kstep, voffB);
        PG8_WAIT_V(6); PG8_BAR;
    }
    for (;;) {
        const bool has_next = S.next(ui + 1, nxt);
        const char* nA = has_next ? (const char*)g.A + (size_t)nxt.pm * tstep : cA; const char* nB = has_next ? (const char*)g.Bt + (size_t)nxt.pn * tstep : cB;
        for (int t = 0; t < nt; t += 2) {
            const bool last = (t == nt - 2);
            const char* a1 = cA + (size_t)(t + 1) * kstep;
            const char* a2 = last ? nA : cA + (size_t)(t + 2) * kstep; const char* b2 = last ? nB : cB + (size_t)(t + 2) * kstep;
            const char* a3 = a2 + kstep; const char* b3 = b2 + kstep;
            if (last && has_next) S.a_ready(nxt);
            if constexpr (SP2) {
            PG8_LDB(B0, 0, 0); PG8_LDB(B1, 0, 1); PG8_SCHED; PG8_LDA(At, 0, 0); PG8_STAGE(PG8_SA(1, 1), a1 + hstep, voffA);
            PG8_WAIT_V(8); PG8_WAIT_L(0); PG8_BAR; PG8_MMA(0, 0, At, B0); PG8_MMA(0, 1, At, B1); PG8_BAR; PG8_SCHED;
            PG8_LDA(At, 0, 1); PG8_STAGE(PG8_SB(0, 0), b2, voffB); PG8_STAGE(PG8_SB(0, 1), b2 + hstep, voffB); PG8_STAGE(PG8_SA(0, 0), a2, voffA);
            PG8_WAIT_V(8); PG8_WAIT_L(0); PG8_BAR; PG8_MMA(1, 0, At, B0); PG8_MMA(1, 1, At, B1); PG8_BAR; PG8_SCHED;
            PG8_LDB(B0, 1, 0); PG8_LDB(B1, 1, 1); PG8_SCHED; PG8_LDA(At, 1, 0); PG8_STAGE(PG8_SA(0, 1), a2 + hstep, voffA);
            PG8_WAIT_V(8); PG8_WAIT_L(0); PG8_BAR; PG8_MMA(0, 0, At, B0); PG8_MMA(0, 1, At, B1); PG8_BAR; PG8_SCHED;
            PG8_LDA(At, 1, 1); PG8_STAGE(PG8_SB(1, 0), b3, voffB); PG8_STAGE(PG8_SB(1, 1), b3 + hstep, voffB); PG8_STAGE(PG8_SA(1, 0), a3, voffA);
            PG8_WAIT_V(8); PG8_WAIT_L(0); PG8_BAR; PG8_MMA(1, 0, At, B0); PG8_MMA(1, 1, At, B1); PG8_BAR; PG8_SCHED;
            } else {
            PG8_LDB(B0, 0, 0); PG8_SCHED; PG8_LDA(At, 0, 0); PG8_STAGE(PG8_SA(1, 1), a1 + hstep, voffA);
            PG8_WAIT_L(8); PG8_BAR; PG8_WAIT_L(0); PG8_MMA(0, 0, At, B0); PG8_BAR; PG8_SCHED;
            PG8_LDB(B1, 0, 1); PG8_STAGE(PG8_SB(0, 0), b2, voffB);
            PG8_BAR; PG8_WAIT_L(0); PG8_MMA(0, 1, At, B1); PG8_BAR;
            PG8_LDA(At, 0, 1); PG8_STAGE(PG8_SA(0, 0), a2, voffA);
            PG8_BAR; PG8_WAIT_L(0); PG8_MMA(1, 0, At, B0); PG8_BAR; PG8_SCHED;
            PG8_STAGE(PG8_SB(0, 1), b2 + hstep, voffB);
            PG8_WAIT_V(6); PG8_BAR; PG8_MMA(1, 1, At, B1); PG8_BAR;
            PG8_LDB(B0, 1, 0); PG8_SCHED; PG8_LDA(At, 1, 0); PG8_STAGE(PG8_SA(0, 1), a2 + hstep, voffA);
            PG8_WAIT_L(8); PG8_BAR; PG8_WAIT_L(0); PG8_MMA(0, 0, At, B0); PG8_BAR; PG8_SCHED;
            PG8_LDB(B1, 1, 1); PG8_STAGE(PG8_SB(1, 0), b3, voffB);
            PG8_BAR; PG8_WAIT_L(0); PG8_MMA(0, 1, At, B1); PG8_BAR;
            PG8_LDA(At, 1, 1); PG8_STAGE(PG8_SA(1, 0), a3, voffA);
            PG8_BAR; PG8_WAIT_L(0); PG8_MMA(1, 0, At, B0); PG8_BAR; PG8_SCHED;
            PG8_STAGE(PG8_SB(1, 1), b3 + hstep, voffB);
            PG8_WAIT_V(6); PG8_BAR; PG8_MMA(1, 1, At, B1); PG8_BAR;
            }
        }
        if constexpr (ALIGN_EPI) { if (wr == 0) PG8_BAR; }
        if constexpr (!Epi::AFTER_DRAIN) { E(acc, cur, wr, wc, fr, fq); S.done(cur); }
        if (!has_next) break;
#pragma unroll
        for (int a = 0; a < 2; ++a)
#pragma unroll
            for (int b = 0; b < 2; ++b)
#pragma unroll
                for (int m = 0; m < 4; ++m)
#pragma unroll
                    for (int n = 0; n < 2; ++n) acc[a][b][m][n] = (f32x4){0.f, 0.f, 0.f, 0.f};
        cur = nxt; cA = nA; cB = nB; ++ui;
        if constexpr (ALIGN_EPI) { if (wr == 1) PG8_BAR; }
    }
    PG8_WAIT_V(0);
    if constexpr (!ALIGN_EPI) { if (wr == 0) PG8_BAR; }
    PG8_BAR;
    if constexpr (Epi::AFTER_DRAIN) { E.fused(acc, cur, wr, wc, fr, fq, lds, wid, lane); S.done(cur); }
#undef PG8_SA
#undef PG8_SB
#undef PG8_STAGE
#undef PG8_LDA
#undef PG8_LDB
#undef PG8_MMA
#undef PG8_WAIT_V
#undef PG8_WAIT_L
#undef PG8_BAR
#undef PG8_SCHED
}
}

#define XB_TMO      128
#define XB_XCNT(j)  (256  + 64 * (j))
#define XB_XSUB(j)  (1280 + 64 * (j))
#define XB_XGEN(j)  (2304 + 64 * (j))
#define XB_TOP      3328
#define XB_TOPGEN   3392
#define XCD_BAR_WORDS 3456
#define XB_SPIN_CAP (1u << 18)
#define LAS __attribute__((address_space(3)))

__device__ __forceinline__ unsigned xb_ld(unsigned* p)              { return __hip_atomic_load(p, __ATOMIC_RELAXED, __HIP_MEMORY_SCOPE_AGENT); }
__device__ __forceinline__ unsigned xb_add(unsigned* p, unsigned v) { return __hip_atomic_fetch_add(p, v, __ATOMIC_RELAXED, __HIP_MEMORY_SCOPE_AGENT); }
__device__ __forceinline__ unsigned xb_xcc_id() { return (unsigned)__builtin_amdgcn_s_getreg((3 << 11) | 20) & 0xFu; }
#define XB_SPIN(cond, bar) do { unsigned _sp = 0; while (cond) { __builtin_amdgcn_s_sleep(1); \
    if ((++_sp & 255u) == 0u) { if (xb_ld(&(bar)[XB_TMO])) break; if (_sp > XB_SPIN_CAP) { atomicAdd(&(bar)[XB_TMO], 1u); break; } } } } while (0)

struct XcdBarrier {
    unsigned* bar; unsigned x;
    volatile LAS unsigned* st;
};

__device__ __forceinline__ XcdBarrier xcd_barrier_post(unsigned* bar, volatile LAS unsigned* st) {
    XcdBarrier b; b.bar = bar; b.x = xb_xcc_id(); b.st = st;
    if (threadIdx.x == 0) (void)xb_add(&bar[XB_XCNT(b.x)], 1u);
    return b;
}
__device__ __forceinline__ void xcd_barrier_complete(unsigned* bar, unsigned x, unsigned& nloc, unsigned& nx) {
    const unsigned G = gridDim.x * gridDim.y * gridDim.z;
    unsigned sum, cnt, mine, sp = 0u;
    for (;;) {
        sum = 0u; cnt = 0u; mine = 0u;
#pragma unroll
        for (unsigned j = 0; j < 16; ++j) { const unsigned c = xb_ld(&bar[XB_XCNT(j)]); sum += c; cnt += (c > 0u) ? 1u : 0u; mine = (j == x) ? c : mine; }
        if (sum == G) break;
        __builtin_amdgcn_s_sleep(1);
        if ((++sp & 255u) == 0u) { if (xb_ld(&bar[XB_TMO])) break; if (sp > XB_SPIN_CAP) { atomicAdd(&bar[XB_TMO], 1u); break; } }
    }
    nloc = mine > 0u ? mine : 1u; nx = cnt > 0u ? cnt : 1u;
}

__device__ __forceinline__ void xcd_barrier(const XcdBarrier& b, const bool leader_thread) {
    asm volatile("s_waitcnt vmcnt(0)" ::: "memory");
    __syncthreads();
    if (leader_thread) {
        unsigned* bar = b.bar;
        __builtin_amdgcn_s_waitcnt(0);
        unsigned nloc = b.st[0], nx = b.st[1];
        if (nloc == 0u) { xcd_barrier_complete(bar, b.x, nloc, nx); b.st[0] = nloc; b.st[1] = nx; }
        const unsigned old = xb_add(&bar[XB_XSUB(b.x)], 1u);
        const unsigned gen = old / nloc;
        if (old + 1u == (gen + 1u) * nloc) {
            __builtin_amdgcn_fence(__ATOMIC_RELEASE, "agent");
            asm volatile("s_waitcnt vmcnt(0)" ::: "memory");
            const unsigned og = xb_add(&bar[XB_TOP], 1u);
            const unsigned tg = og / nx;
            if (og + 1u == (tg + 1u) * nx) xb_add(&bar[XB_TOPGEN], 1u);
            else XB_SPIN(xb_ld(&bar[XB_TOPGEN]) == tg, bar);
            __builtin_amdgcn_fence(__ATOMIC_ACQUIRE, "agent");
            xb_add(&bar[XB_XGEN(b.x)], 1u);
            asm volatile("s_waitcnt vmcnt(0)" ::: "memory");
        } else {
            XB_SPIN(xb_ld(&bar[XB_XGEN(b.x)]) == gen, bar);
            __builtin_amdgcn_fence(__ATOMIC_ACQUIRE, "agent");
            asm volatile("s_waitcnt vmcnt(0)" ::: "memory");
        }
    }
    __syncthreads();
}

constexpr int NB = 2, SEQ = 16384, TLEN = 16400, DM = 1024, NMETA = 16, DEPTH = 2;
constexpr int MR = NB * SEQ;
constexpr int MV = MR + NB * NMETA;
constexpr int MP = 33024;
constexpr int INCOLS = 3912, NPAD = 4096, DFF = 4096;
constexpr int NTHREADS = 512;
constexpr float LOG2E = 1.4426950408889634f;
constexpr float QA_SCALE = 0.125f * LOG2E;
constexpr float QB_SCALE = 0.17677669529663687f * LOG2E;
constexpr float WI_SCALE = 0.044194173824159216f;
constexpr int NKS = 513;

constexpr size_t al256(size_t x) { return (x + 255) & ~(size_t)255; }
constexpr size_t WS_CTL   = 0;
constexpr size_t CTL_BYTES = 65536;
constexpr size_t WS_HMETA = CTL_BYTES;
constexpr size_t WS_ROPE  = WS_HMETA + (size_t)256 * DM * 4;
constexpr size_t WS_W     = al256(WS_ROPE + (size_t)TLEN * 32 * 8);
constexpr size_t W_IN_OFF = 0, W_OUT_OFF = (size_t)NPAD * DM * 2, W_FF1_OFF = W_OUT_OFF + (size_t)DM * DM * 2,
                 W_FF2_OFF = W_FF1_OFF + (size_t)DFF * DM * 2, W_LAYER = W_FF2_OFF + (size_t)DM * DFF * 2;
constexpr size_t WS_ABUF  = al256(WS_W + DEPTH * W_LAYER);
constexpr size_t WS_MASK  = WS_ABUF + (size_t)MP * DM * 2;
constexpr size_t WS_U     = al256(WS_MASK + (size_t)NB * NKS * TLEN * 4);
constexpr size_t WS_S     = WS_U + (size_t)NB * 4 * 129 * 4096 * 4;
constexpr size_t WS_PROJ  = WS_S + (size_t)NB * 4 * 129 * 4096 * 4;
constexpr size_t P512 = (size_t)MP * 512 * 2, P256 = (size_t)MP * 256 * 2;
constexpr size_t PJ_QA = 0, PJ_KA = P512, PJ_VA = 2 * P512, PJ_QI = 3 * P512, PJ_256 = 4 * P512;
constexpr size_t PJ_QB = PJ_256, PJ_KB = PJ_256 + P256, PJ_VB = PJ_256 + 2 * P256, PJ_QC = PJ_256 + 3 * P256, PJ_KC = PJ_256 + 4 * P256,
                 PJ_VC = PJ_256 + 5 * P256, PJ_GC = PJ_256 + 6 * P256, PJ_KI = PJ_256 + 7 * P256, PJ_WI = PJ_KI + (size_t)MP * 64 * 2,
                 PJ_END = PJ_WI + (size_t)MP * 8 * 4;
constexpr size_t ACT_BYTES = (size_t)MP * DFF * 2;
constexpr size_t WS_END = WS_PROJ + (ACT_BYTES > PJ_END ? ACT_BYTES : PJ_END);
constexpr int CW_BAR = 0;
constexpr int CW_KMAX = 4096;

constexpr int LDS_BYTES = 156 * 1024;
constexpr int LDS_MISC = 0, LDS_GEN = 256;

struct Args { const float* in[13]; float* out; unsigned char* ws; int ph_lo, ph_hi; };

struct Frame {
    const float *x, *meta, *rel_bias, *w_in, *norm_mix, *diff_lambda, *diff_norm, *ret_norm, *w_out, *norm_ff, *w_ff1, *w_ff2, *final_norm;
    float* out; unsigned char* ws; LAS unsigned char* lds; int tid, lane, wave, bid, G;
};

__device__ __forceinline__ float shx(float v, int m, int lane) { return __builtin_bit_cast(float, __builtin_amdgcn_ds_bpermute((lane ^ m) << 2, __builtin_bit_cast(int, v))); }
template <int M> __device__ __forceinline__ float sx(float v, int lane) { return shx(v, M, lane); }
__device__ __forceinline__ float hsum32(float v, int lane) { return v + shx(v, 32, lane); }
__device__ __forceinline__ unsigned hor32(unsigned v, int lane) { return v | (unsigned)__builtin_amdgcn_ds_bpermute((lane ^ 32) << 2, (int)v); }
__device__ __forceinline__ float bcast0(float v) { return __builtin_bit_cast(float, __builtin_amdgcn_ds_bpermute(0, __builtin_bit_cast(int, v))); }
__device__ __forceinline__ float wave_sum(float v, int lane) { v = hsum32(v, lane); v += sx<16>(v, lane); v += sx<8>(v, lane); v += sx<4>(v, lane); v += sx<2>(v, lane); v += sx<1>(v, lane); return v; }
__device__ __forceinline__ unsigned cvt_pk_bf16(float lo, float hi) { unsigned r; asm volatile("v_cvt_pk_bf16_f32 %0, %1, %2" : "=v"(r) : "v"(lo), "v"(hi)); return r; }
__device__ __forceinline__ unsigned cvt_pk_f16(float lo, float hi) { h2 p; p.x = (_Float16)lo; p.y = (_Float16)hi; return __builtin_bit_cast(unsigned, p); }
typedef unsigned u32x4 __attribute__((ext_vector_type(4)));
typedef float f32x4 __attribute__((ext_vector_type(4)));
__device__ __forceinline__ u32x4 pack8(const f32x4& a, const f32x4& b, bool bf) {
    u32x4 w;
    if (bf) { w.x = cvt_pk_bf16(a[0], a[1]); w.y = cvt_pk_bf16(a[2], a[3]); w.z = cvt_pk_bf16(b[0], b[1]); w.w = cvt_pk_bf16(b[2], b[3]); }
    else    { w.x = cvt_pk_f16(a[0], a[1]);  w.y = cvt_pk_f16(a[2], a[3]);  w.z = cvt_pk_f16(b[0], b[1]);  w.w = cvt_pk_f16(b[2], b[3]); }
    return w;
}
__device__ __forceinline__ int row_pos(int r) { return r < MR ? (r & (SEQ - 1)) + NMETA : ((r - MR) & 15); }

__device__ __forceinline__ int incol_map(int n) {
    if (n < 2048) return n;
    if (n < 2816) return n - 2048 + 2120;
    if (n < 3328) {
        const int seg = (n - 2816) >> 8, c = (n - 2816) & 255, head = c >> 6, p = c & 63;
        const int g = p >> 3, nn = (p >> 2) & 1, i = p & 3, d = 32 * nn + 4 * g + i;
        return (seg ? 3144 : 2888) + head * 64 + d;
    }
    if (n < 3840) return n - 3328 + 3400;
    if (n < 3904) return n - 3840 + 2048;
    if (n < 3912) return n - 3904 + 2112;
    return -1;
}

__constant__ double ROPE_REV[32] = {0.15915494309189535, 0.11934937021124886, 0.08949940160889101, 0.06711508300522726, 0.050329212104487035, 0.03774158471741977, 0.0283021958306234, 0.02122365276477766, 0.015915494309189534, 0.011934937021124886, 0.008949940160889102, 0.006711508300522725, 0.005032921210448704, 0.003774158471741977, 0.00283021958306234, 0.0021223652764777662, 0.0015915494309189536, 0.0011934937021124885, 0.0008949940160889102, 0.0006711508300522726, 0.0005032921210448703, 0.00037741584717419774, 0.00028302195830623395, 0.0002122365276477766, 0.00015915494309189535, 0.00011934937021124886, 8.949940160889102e-05, 6.711508300522725e-05, 5.0329212104487035e-05, 3.774158471741978e-05, 2.8302195830623396e-05, 2.122365276477766e-05};

struct EpiInProj {
    static constexpr bool PERM = true, AFTER_DRAIN = false;
    unsigned char* proj; const f32x2* rope; unsigned* kmax;
    __device__ __forceinline__ void kmax_update(const pg8::f32x4 (&acc)[2][2][4][2], int bj, unsigned* word, int fr, int fq) const {
        float mx = 0.f; const int LN = fq * 16 + fr;
#pragma unroll
        for (int ai = 0; ai < 2; ++ai)
#pragma unroll
            for (int m = 0; m < 4; ++m) {
                const pg8::f32x4 a = acc[ai][bj][m][0], b = acc[ai][bj][m][1];
                float s = (a[0] * a[0] + a[1] * a[1]) + (a[2] * a[2] + a[3] * a[3]) + (b[0] * b[0] + b[1] * b[1]) + (b[2] * b[2] + b[3] * b[3]);
                s += sx<16>(s, LN); s = hsum32(s, LN);
                mx = fmaxf(mx, s);
            }
        mx = fmaxf(mx, sx<1>(mx, LN)); mx = fmaxf(mx, sx<2>(mx, LN)); mx = fmaxf(mx, sx<4>(mx, LN)); mx = fmaxf(mx, sx<8>(mx, LN));
        if (fr == 0 && fq == 0) atomicMax(word, __float_as_uint(mx));
    }
    __device__ __forceinline__ void operator()(const pg8::f32x4 (&acc)[2][2][4][2], const pg8::Unit& u, int wr, int wc, int fr, int fq) const {
        const int pn = u.pn, rbase = u.pm * 256 + wr * 64 + fr, cw = wc * 32 + 8 * fq;
        if (pn <= 7 || (pn <= 14 && pn != 11 && pn != 12)) {
            unsigned char* base; int ld, colt; float scale = 1.f; bool bf = false;
            if (pn <= 7) { const int arr = pn >> 1; base = proj + (size_t)arr * P512; ld = 512; colt = (pn & 1) * 256; if (arr == 0) scale = QA_SCALE; bf = (arr == 2); }
            else { const int arr = pn - 8; base = proj + PJ_256 + (size_t)arr * P256; ld = 256; colt = 0; if (arr == 0) scale = QB_SCALE; bf = (arr == 2); }
#pragma unroll
            for (int ai = 0; ai < 2; ++ai)
#pragma unroll
                for (int m = 0; m < 4; ++m) {
                    const int row = rbase + ai * 128 + m * 16;
#pragma unroll
                    for (int bj = 0; bj < 2; ++bj) {
                        const pg8::f32x4 v0 = acc[ai][bj][m][0] * scale, v1 = acc[ai][bj][m][1] * scale;
                        *(u32x4*)(base + ((size_t)row * ld + colt + bj * 128 + cw) * 2) = pack8(v0, v1, bf);
                    }
                }
            if (pn == 2 || pn == 3) {
#pragma unroll
                for (int bj = 0; bj < 2; ++bj) { const int head = ((pn & 1) * 256 + bj * 128 + wc * 32) >> 6; kmax_update(acc, bj, kmax + head * 2 + (wc & 1), fr, fq); }
            }
            if (pn == 9) {
#pragma unroll
                for (int bj = 0; bj < 2; ++bj) { const int head = 2 * bj + (wc >> 1); kmax_update(acc, bj, kmax + 16 + head * 2 + (wc & 1), fr, fq); }
            }
        } else if (pn == 11 || pn == 12) {
            unsigned char* base = proj + PJ_256 + (size_t)(pn - 8) * P256;
            const float sc = (pn == 12) ? 0.125f : 1.f;
            const int g = 4 * (wc & 1) + fq;
#pragma unroll
            for (int ai = 0; ai < 2; ++ai)
#pragma unroll
                for (int m = 0; m < 4; ++m) {
                    const int row = rbase + ai * 128 + m * 16, t = row_pos(row);
                    const pg8::f32x4 cs0 = *(const pg8::f32x4*)(rope + (size_t)t * 32 + 4 * g), cs1 = *(const pg8::f32x4*)(rope + (size_t)t * 32 + 4 * g + 2);
                    const float c[4] = {cs0[0], cs0[2], cs1[0], cs1[2]}, s[4] = {cs0[1], cs0[3], cs1[1], cs1[3]};
#pragma unroll
                    for (int bj = 0; bj < 2; ++bj) {
                        const pg8::f32x4 x1 = acc[ai][bj][m][0], x2 = acc[ai][bj][m][1];
                        float o1[4], o2[4];
#pragma unroll
                        for (int i = 0; i < 4; ++i) { o1[i] = (x1[i] * c[i] - x2[i] * s[i]) * sc; o2[i] = (x1[i] * s[i] + x2[i] * c[i]) * sc; }
                        const int head = 2 * bj + (wc >> 1);
                        unsigned char* rp = base + ((size_t)row * 256 + head * 64 + 4 * g) * 2;
                        u32x2 w1, w2; w1.x = cvt_pk_f16(o1[0], o1[1]); w1.y = cvt_pk_f16(o1[2], o1[3]); w2.x = cvt_pk_f16(o2[0], o2[1]); w2.y = cvt_pk_f16(o2[2], o2[3]);
                        *(u32x2*)rp = w1; *(u32x2*)(rp + 64) = w2;
                    }
                }
        } else {
#pragma unroll
            for (int ai = 0; ai < 2; ++ai)
#pragma unroll
                for (int m = 0; m < 4; ++m) {
                    const int row = rbase + ai * 128 + m * 16;
                    const pg8::f32x4 v0 = acc[ai][0][m][0], v1 = acc[ai][0][m][1];
                    if (wc < 2) *(u32x4*)(proj + PJ_KI + ((size_t)row * 64 + cw) * 2) = pack8(v0, v1, false);
                    else if (wc == 2 && fq == 0) { float* wp = (float*)(proj + PJ_WI) + (size_t)row * 8; *(pg8::f32x4*)wp = v0 * WI_SCALE; *(pg8::f32x4*)(wp + 4) = v1 * WI_SCALE; }
                }
        }
    }
};
struct EpiRes {
    static constexpr bool PERM = false, AFTER_DRAIN = false;
    const float* res_main; float* out_main; float* hmeta;
    __device__ __forceinline__ void operator()(const pg8::f32x4 (&acc)[2][2][4][2], const pg8::Unit& u, int wr, int wc, int fr, int fq) const {
        const bool mt = (u.pm * 256 >= MR);
        const float* rb = mt ? hmeta : res_main; float* ob = mt ? hmeta : out_main;
        const int row0 = (mt ? u.pm * 256 - MR : u.pm * 256) + wr * 64 + fr, col0 = u.pn * 256 + wc * 32 + 4 * fq;
#pragma unroll
        for (int ai = 0; ai < 2; ++ai)
#pragma unroll
            for (int m = 0; m < 4; ++m) {
                const size_t ro = (size_t)(row0 + ai * 128 + m * 16) * DM + col0;
#pragma unroll
                for (int bj = 0; bj < 2; ++bj)
#pragma unroll
                    for (int n = 0; n < 2; ++n) { const pg8::f32x4 v = *(const pg8::f32x4*)(rb + ro + bj * 128 + n * 16) + acc[ai][bj][m][n]; *(pg8::f32x4*)(ob + ro + bj * 128 + n * 16) = v; }
            }
    }
};
struct EpiRelu2 {
    static constexpr bool PERM = true, AFTER_DRAIN = false;
    unsigned char* act;
    __device__ __forceinline__ void operator()(const pg8::f32x4 (&acc)[2][2][4][2], const pg8::Unit& u, int wr, int wc, int fr, int fq) const {
        const int rbase = u.pm * 256 + wr * 64 + fr, col0 = u.pn * 256 + wc * 32 + 8 * fq;
#pragma unroll
        for (int ai = 0; ai < 2; ++ai)
#pragma unroll
            for (int m = 0; m < 4; ++m) {
                const int row = rbase + ai * 128 + m * 16;
#pragma unroll
                for (int bj = 0; bj < 2; ++bj) {
                    pg8::f32x4 v0 = acc[ai][bj][m][0], v1 = acc[ai][bj][m][1];
#pragma unroll
                    for (int i = 0; i < 4; ++i) { const float a = fmaxf(v0[i], 0.f), b = fmaxf(v1[i], 0.f); v0[i] = a * a; v1[i] = b * b; }
                    *(u32x4*)(act + ((size_t)row * DFF + col0 + bj * 128) * 2) = pack8(v0, v1, false);
                }
            }
    }
};

struct WTile { const float* src; _Float16* dst; int ld, K, k0, n0, mapped; };
constexpr int WT_PER_LAYER = 16 * 64 + 16 * 16 + 16 * 64 + 64 * 16, WT_TOTAL = DEPTH * WT_PER_LAYER;
__device__ __forceinline__ WTile wt_desc(const Frame& F, int t) {
    WTile d; const int l = t / WT_PER_LAYER; int r = t - l * WT_PER_LAYER;
    unsigned char* wl = F.ws + WS_W + (size_t)l * W_LAYER;
    if (r < 1024)      { d.src = F.w_in + (size_t)l * DM * INCOLS; d.dst = (_Float16*)(wl + W_IN_OFF);  d.ld = INCOLS; d.K = DM;  d.mapped = 1; d.k0 = (r & 15) * 64; d.n0 = (r >> 4) * 64; }
    else if (r < 1280) { r -= 1024; d.src = F.w_out + (size_t)l * DM * DM;  d.dst = (_Float16*)(wl + W_OUT_OFF); d.ld = DM;  d.K = DM;  d.mapped = 0; d.k0 = (r & 15) * 64; d.n0 = (r >> 4) * 64; }
    else if (r < 2304) { r -= 1280; d.src = F.w_ff1 + (size_t)l * DM * DFF; d.dst = (_Float16*)(wl + W_FF1_OFF); d.ld = DFF; d.K = DM;  d.mapped = 0; d.k0 = (r & 15) * 64; d.n0 = (r >> 4) * 64; }
    else               { r -= 2304; d.src = F.w_ff2 + (size_t)l * DFF * DM; d.dst = (_Float16*)(wl + W_FF2_OFF); d.ld = DM;  d.K = DFF; d.mapped = 0; d.k0 = (r & 63) * 64; d.n0 = (r >> 6) * 64; }
    return d;
}
__device__ __forceinline__ void wt_load(const WTile& d, int tid, f32x4& v0, f32x4& v1) {
    const int kk = tid >> 4, n4 = (tid & 15) * 4; const int sc = d.mapped ? incol_map(d.n0 + n4) : d.n0 + n4;
    v0 = (f32x4){0.f, 0.f, 0.f, 0.f}; v1 = v0;
    if (sc >= 0) { v0 = *(const f32x4*)(d.src + (size_t)(d.k0 + kk) * d.ld + sc); v1 = *(const f32x4*)(d.src + (size_t)(d.k0 + kk + 32) * d.ld + sc); }
}
__device__ __forceinline__ void wtrans_all(const Frame& F) {
    LAS float* tile = (LAS float*)(F.lds + LDS_GEN); const int tid = F.tid;
    int t = F.bid; if (t >= WT_TOTAL) return;
    WTile d = wt_desc(F, t); f32x4 v0, v1; wt_load(d, tid, v0, v1);
#pragma unroll 1
    for (;;) {
        const int tn = t + F.G; WTile dn = d; f32x4 n0 = v0, n1 = v1;
        if (tn < WT_TOTAL) { dn = wt_desc(F, tn); wt_load(dn, tid, n0, n1); }
        { const int kk = tid >> 4, n4 = (tid & 15) * 4;
#pragma unroll
          for (int e = 0; e < 4; ++e) { tile[kk * 65 + n4 + e] = v0[e]; tile[(kk + 32) * 65 + n4 + e] = v1[e]; } }
        __syncthreads();
        { const int nn = tid >> 3, k8 = (tid & 7) * 8; h8 o;
#pragma unroll
          for (int e = 0; e < 8; ++e) o[e] = (_Float16)tile[(k8 + e) * 65 + nn];
          *(h8*)(d.dst + (size_t)(d.n0 + nn) * d.K + d.k0 + k8) = o; }
        __syncthreads();
        if (tn >= WT_TOTAL) break;
        t = tn; d = dn; v0 = n0; v1 = n1;
    }
}
template <int MODE> __device__ __forceinline__ void norm_to_abuf(const Frame& F, const float* gain) {
    _Float16* abuf = (_Float16*)(F.ws + WS_ABUF); const float* hmeta = (const float*)(F.ws + WS_HMETA);
    const int nw = F.G * 8;
    for (int r = F.bid * 8 + F.wave; r < MP; r += nw) {
        _Float16* dst = abuf + (size_t)r * DM;
        if (r >= MV) { const h4 z = {(_Float16)0.f, (_Float16)0.f, (_Float16)0.f, (_Float16)0.f};
#pragma unroll
            for (int j = 0; j < 4; ++j) *(h4*)(dst + j * 256 + F.lane * 4) = z; continue; }
        const float* src = MODE == 0 ? (r < MR ? F.x + (size_t)r * DM : F.meta + (size_t)((r - MR) & 15) * DM) : (r < MR ? F.out + (size_t)r * DM : hmeta + (size_t)(r - MR) * DM);
        f32x4 v[4]; float ss = 0.f;
#pragma unroll
        for (int j = 0; j < 4; ++j) { v[j] = *(const f32x4*)(src + j * 256 + F.lane * 4); ss += (v[j][0] * v[j][0] + v[j][1] * v[j][1]) + (v[j][2] * v[j][2] + v[j][3] * v[j][3]); }
        ss = wave_sum(ss, F.lane); const float rstd = rsqrtf(ss * (1.0f / DM) + 1e-6f);
#pragma unroll
        for (int j = 0; j < 4; ++j) { const f32x4 g = *(const f32x4*)(gain + j * 256 + F.lane * 4); h4 o;
#pragma unroll
            for (int e = 0; e < 4; ++e) o[e] = (_Float16)(v[j][e] * rstd * g[e]);
            *(h4*)(dst + j * 256 + F.lane * 4) = o; }
    }
}
__device__ __forceinline__ void final_norm(const Frame& F) {
    const int nw = F.G * 8;
    for (int r = F.bid * 8 + F.wave; r < MR; r += nw) {
        float* p = F.out + (size_t)r * DM; f32x4 v[4]; float ss = 0.f;
#pragma unroll
        for (int j = 0; j < 4; ++j) { v[j] = *(const f32x4*)(p + j * 256 + F.lane * 4); ss += (v[j][0] * v[j][0] + v[j][1] * v[j][1]) + (v[j][2] * v[j][2] + v[j][3] * v[j][3]); }
        ss = wave_sum(ss, F.lane); const float rstd = rsqrtf(ss * (1.0f / DM) + 1e-6f);
#pragma unroll
        for (int j = 0; j < 4; ++j) { const f32x4 g = *(const f32x4*)(F.final_norm + j * 256 + F.lane * 4); *(f32x4*)(p + j * 256 + F.lane * 4) = v[j] * rstd * g; }
    }
}
__device__ __forceinline__ void prologue(const Frame& F) {
    const int gtid = F.bid * NTHREADS + F.tid, gsz = F.G * NTHREADS;
    float* hmeta = (float*)(F.ws + WS_HMETA);
    for (int i = gtid; i < 256 * DM / 4; i += gsz) { const int row = i / (DM / 4), c4 = i % (DM / 4); f32x4 v = {0.f, 0.f, 0.f, 0.f}; if (row < NB * NMETA) v = *(const f32x4*)(F.meta + (size_t)(row & 15) * DM + c4 * 4); *(f32x4*)(hmeta + (size_t)row * DM + c4 * 4) = v; }
    f32x2* rope = (f32x2*)(F.ws + WS_ROPE);
    for (int i = gtid; i < TLEN * 32; i += gsz) { const int t = i >> 5, d = i & 31; const double rev = (double)t * ROPE_REV[d]; const float fr = (float)(rev - __builtin_floor(rev)); f32x2 cs; cs.x = __builtin_amdgcn_cosf(fr); cs.y = __builtin_amdgcn_sinf(fr); rope[i] = cs; }
    wtrans_all(F);
    norm_to_abuf<0>(F, F.norm_mix);
}
__device__ __forceinline__ int crow(int i, int h) { return (i & 3) + 8 * (i >> 2) + 4 * h; }
constexpr size_t WS_SCR = WS_U;
template <bool FROM_SCR> __device__ __forceinline__ void skinny_task(const unsigned char* A, int lda_bytes, const float* scr, const _Float16* Bt, int K, int n0, int k0, float* dst, int ldd, int lane) {
    const int r = lane & 31, h = lane >> 5;
    f32x16 acc;
#pragma unroll
    for (int i = 0; i < 16; ++i) acc[i] = 0.f;
#pragma unroll 1
    for (int kc = 0; kc < 4; ++kc) {
    h8 a[4], bb[4];
#pragma unroll
    for (int s = 0; s < 4; ++s) {
        const int k = k0 + 64 * kc + 16 * s + 8 * h;
        if (FROM_SCR) { const f32x4 x0 = *(const f32x4*)(scr + (size_t)r * DFF + k), x1 = *(const f32x4*)(scr + (size_t)r * DFF + k + 4);
#pragma unroll
            for (int e = 0; e < 4; ++e) { const float u = fmaxf(x0[e], 0.f), v = fmaxf(x1[e], 0.f); a[s][e] = (_Float16)(u * u); a[s][4 + e] = (_Float16)(v * v); } }
        else a[s] = *(const h8*)(A + (size_t)(MR + r) * lda_bytes + (size_t)k * 2);
        bb[s] = *(const h8*)(Bt + (size_t)(n0 + r) * K + k);
    }
#pragma unroll
    for (int s = 0; s < 4; ++s) acc = __builtin_amdgcn_mfma_f32_32x32x16_f16(a[s], bb[s], acc, 0, 0, 0);
    }
#pragma unroll
    for (int i = 0; i < 16; ++i) atomicAdd(dst + (size_t)crow(i, h) * ldd + n0 + r, acc[i]);
}
template <int MODE> __device__ __forceinline__ void skinny_meta(const Frame& F, const unsigned char* wl) {
    const int ntn = MODE == 1 ? 128 : 32, nks = MODE == 2 ? 16 : 4, ntask = ntn * nks;
    float* hmeta = (float*)(F.ws + WS_HMETA); float* scr = (float*)(F.ws + WS_SCR);
#pragma unroll 1
    for (int task = F.bid * 8 + F.wave; task < ntask; task += F.G * 8) {
        const int nt = task % ntn, ks = task / ntn;
        if (MODE == 0) skinny_task<false>(F.ws + WS_ABUF, DM * 2, nullptr, (const _Float16*)(wl + W_OUT_OFF), DM, nt * 32, ks * 256, hmeta, DM, F.lane);
        if (MODE == 1) skinny_task<false>(F.ws + WS_ABUF, DM * 2, nullptr, (const _Float16*)(wl + W_FF1_OFF), DM, nt * 32, ks * 256, scr, DFF, F.lane);
        if (MODE == 2) skinny_task<true>(nullptr, 0, scr, (const _Float16*)(wl + W_FF2_OFF), DFF, nt * 32, ks * 256, hmeta, DM, F.lane);
    }
}
__device__ __forceinline__ void zero_scr(const Frame& F) {
    f32x4* p = (f32x4*)(F.ws + WS_SCR); float z0 = 0.f; asm volatile("" : "+v"(z0)); const f32x4 z = {z0, z0, z0, z0};
    for (int i = F.bid * NTHREADS + F.tid; i < 32 * DFF / 4; i += F.G * NTHREADS) p[i] = z;
}
__device__ __forceinline__ void zero_abuf(const Frame& F) {
    u32x4* p = (u32x4*)(F.ws + WS_ABUF); const u32x4 z = {0u, 0u, 0u, 0u};
    for (size_t i = (size_t)F.bid * NTHREADS + F.tid; i < (size_t)MP * DM * 2 / 16; i += (size_t)F.G * NTHREADS) p[i] = z;
}

typedef short bf16x8v __attribute__((ext_vector_type(8)));
__constant__ unsigned char BUCKET_LUT[128] = {0, 1, 2, 3, 4, 5, 6, 7, 8, 9, 10, 11, 12, 13, 14, 15, 16, 16, 16, 17, 17, 18, 18, 18, 19, 19, 19, 20, 20, 20, 20, 21, 21, 21, 21, 22, 22, 22, 22, 22, 23, 23, 23, 23, 23, 23, 24, 24, 24, 24, 24, 24, 25, 25, 25, 25, 25, 25, 25, 26, 26, 26, 26, 26, 26, 26, 26, 27, 27, 27, 27, 27, 27, 27, 27, 27, 27, 28, 28, 28, 28, 28, 28, 28, 28, 28, 28, 29, 29, 29, 29, 29, 29, 29, 29, 29, 29, 29, 29, 30, 30, 30, 30, 30, 30, 30, 30, 30, 30, 30, 30, 30, 30, 31, 31, 31, 31, 31, 31, 31, 31, 31, 31, 31, 31, 31, 31, 31};
__device__ __forceinline__ bf16x8v pack_p(const f32x16& x, int s) {
    u32x4 p; p.x = cvt_pk_bf16(x[8 * s + 0], x[8 * s + 1]); p.y = cvt_pk_bf16(x[8 * s + 2], x[8 * s + 3]); p.z = cvt_pk_bf16(x[8 * s + 4], x[8 * s + 5]); p.w = cvt_pk_bf16(x[8 * s + 6], x[8 * s + 7]);
    return __builtin_bit_cast(bf16x8v, p);
}
constexpr int TK = 128;
__device__ __forceinline__ bf16x8v vt_frag(LAS unsigned char* vimg, int dblk, int keybase, int s, int lane) {
    const int h = lane >> 5, blk = (lane >> 4) & 1, i16 = lane & 15, q = i16 >> 2, p = i16 & 3;
    LAS unsigned char* a = vimg + dblk * (TK * 64) + (keybase + 16 * s + 4 * h + q) * 64 + (16 * blk + 4 * p) * 2;
    const s16x4 lo = __builtin_amdgcn_ds_read_tr16_b64_v4i16((LAS s16x4*)a);
    const s16x4 hi = __builtin_amdgcn_ds_read_tr16_b64_v4i16((LAS s16x4*)(a + 8 * 64));
    return __builtin_shufflevector(lo, hi, 0, 1, 2, 3, 4, 5, 6, 7);
}

constexpr int KS_PITCH = 144;
constexpr int KBUF = TK * KS_PITCH, VBUF = 2 * TK * 64, B_KS = 0, B_VS = 2 * KBUF, B_LUT = B_VS + 2 * VBUF, B_END = B_LUT + 512;
__device__ __forceinline__ void mixB_unit(const Frame& F, int l, int b, int hh, int qblk, float lam, float oscale) {
    LAS unsigned char* L = F.lds + LDS_GEN;
    const int tid = F.tid, lane = F.lane, wave = F.wave, r = lane & 31, h = lane >> 5;
    const unsigned char* proj = F.ws + WS_PROJ;
    const _Float16* QB = (const _Float16*)(proj + PJ_QB); const unsigned char* KB = proj + PJ_KB; const unsigned char* VB = proj + PJ_VB;
    const unsigned* kmax = (const unsigned*)(F.ws + WS_CTL) + CW_KMAX + 32 * l + 16;
    const bool meta_u = qblk < 0;
    const int qrow0 = meta_u ? MR + b * NMETA : b * SEQ + qblk * 256;
    const int qpos0 = meta_u ? 0 : NMETA + qblk * 256;
    const int nreal = meta_u ? 0 : 2 * qblk + 2;
    const int wq0 = 32 * wave;
    const bool wave_on = meta_u ? (wave == 0) : true;
    const int my_row = wave_on ? qrow0 + wq0 + r : qrow0, my_pos = qpos0 + wq0 + r;
    __syncthreads();
    if (tid < 128) ((LAS float*)(L + B_LUT))[tid] = F.rel_bias[BUCKET_LUT[tid] * 12 + 8 + hh] * LOG2E;
    float bmax = (lane < 32) ? F.rel_bias[lane * 12 + 8 + hh] * LOG2E : -1e30f;
    bmax = fmaxf(bmax, sx<16>(bmax, lane)); bmax = fmaxf(bmax, sx<8>(bmax, lane)); bmax = fmaxf(bmax, sx<4>(bmax, lane)); bmax = fmaxf(bmax, sx<2>(bmax, lane)); bmax = fmaxf(bmax, sx<1>(bmax, lane));
    bmax = bcast0(bmax);
    const float bfar = F.rel_bias[31 * 12 + 8 + hh] * LOG2E;
    h8 qf[2][2]; float mref[2]; bool safe = true;
#pragma unroll
    for (int c = 0; c < 2; ++c) {
        float n2 = 0.f;
#pragma unroll
        for (int s = 0; s < 2; ++s) { qf[c][s] = *(const h8*)(QB + (size_t)my_row * 256 + hh * 64 + c * 32 + 16 * s + 8 * h);
#pragma unroll
            for (int j = 0; j < 8; ++j) { const float v = (float)qf[c][s][j]; n2 += v * v; } }
        n2 = hsum32(n2, lane);
        mref[c] = sqrtf(n2 * __uint_as_float(kmax[hh * 2 + c])) * 1.002f + bmax;
        safe = safe && (mref[c] - bfar < 60.0f);
    }
    safe = __all(safe);
    if (safe) { mref[0] = bfar; mref[1] = bfar; }
    f32x16 O[2][2]; float lsum[2] = {0.f, 0.f};
#pragma unroll
    for (int c = 0; c < 2; ++c)
#pragma unroll
        for (int d = 0; d < 2; ++d)
#pragma unroll
            for (int i = 0; i < 16; ++i) O[c][d][i] = 0.f;
    const int skey = tid >> 3, sch = tid & 7;
    const unsigned kdst = skey * KS_PITCH + sch * 16, vdst = (sch >> 2) * (TK * 64) + skey * 64 + (sch & 3) * 16;
    const int ntiles = 1 + nreal;
    auto tile_row0 = [&](int t) -> int { return t == 0 ? MR + b * NMETA : b * SEQ + (t - 1) * TK; };
    u32x4 kreg[2], vreg[2];
#pragma unroll
    for (int j = 0; j < 2; ++j) { const size_t rr = (size_t)(tile_row0(0) + skey + 64 * j); kreg[j] = *(const u32x4*)(KB + rr * 512 + hh * 128 + sch * 16); vreg[j] = *(const u32x4*)(VB + rr * 512 + hh * 128 + sch * 16); }
#pragma unroll
    for (int j = 0; j < 2; ++j) { *(LAS u32x4*)(L + B_KS + kdst + j * 64 * KS_PITCH) = kreg[j]; *(LAS u32x4*)(L + B_VS + vdst + j * 64 * 64) = vreg[j]; }
    __syncthreads();
    const int wpos0 = qpos0 + wq0;
#pragma unroll 1
    for (int t = 0; t < ntiles; ++t) {
        const int buf = t & 1;
        if (t + 1 < ntiles) {
#pragma unroll
            for (int j = 0; j < 2; ++j) { const size_t rr = (size_t)(tile_row0(t + 1) + skey + 64 * j); kreg[j] = *(const u32x4*)(KB + rr * 512 + hh * 128 + sch * 16); vreg[j] = *(const u32x4*)(VB + rr * 512 + hh * 128 + sch * 16); } }
        const int kpos0 = (t == 0) ? 0 : NMETA + (t - 1) * TK, nvalid = (t == 0) ? NMETA : TK;
        if (wave_on && kpos0 <= wpos0 + 31) {
            LAS unsigned char* Kb = L + B_KS + buf * KBUF; LAS unsigned char* Vb = L + B_VS + buf * VBUF;
#pragma unroll
            for (int sub = 0; sub < 4; ++sub) {
                if (sub * 32 >= nvalid || kpos0 + sub * 32 > wpos0 + 31) continue;
                const bool slow = !safe || (t == 0) || (kpos0 + sub * 32 + 31 > wpos0 - 128);
                h8 kfr[2][2]; bf16x8v vfr[2][2];
#pragma unroll
                for (int c = 0; c < 2; ++c)
#pragma unroll
                    for (int s = 0; s < 2; ++s) kfr[c][s] = *(const LAS h8*)(Kb + (sub * 32 + r) * KS_PITCH + (c * 32 + 16 * s + 8 * h) * 2);
#pragma unroll
                for (int d = 0; d < 2; ++d)
#pragma unroll
                    for (int s = 0; s < 2; ++s) vfr[d][s] = vt_frag(Vb, d, sub * 32, s, lane);
                __builtin_amdgcn_sched_barrier(0);
                f32x16 S[2];
#pragma unroll
                for (int c = 0; c < 2; ++c) {
#pragma unroll
                    for (int i = 0; i < 16; ++i) S[c][i] = 0.f;
#pragma unroll
                    for (int s = 0; s < 2; ++s) S[c] = __builtin_amdgcn_mfma_f32_32x32x16_f16(kfr[c][s], qf[c][s], S[c], 0, 0, 0);
                }
                if (slow) {
                    float bs[16];
#pragma unroll
                    for (int i = 0; i < 16; ++i) { const int dist = my_pos - (kpos0 + sub * 32 + crow(i, h)); bs[i] = ((const LAS float*)(L + B_LUT))[min(max(dist, 0), 127)]; }
#pragma unroll
                    for (int i = 0; i < 16; ++i) {
                        const int kidx = sub * 32 + crow(i, h), dist = my_pos - (kpos0 + kidx);
                        const bool ok = dist >= 0 && kidx < nvalid;
#pragma unroll
                        for (int c = 0; c < 2; ++c) { const float e = __builtin_amdgcn_exp2f(fminf(S[c][i] + (bs[i] - mref[c]), 80.f)); S[c][i] = ok ? e : 0.f; }
                    }
                }
#pragma unroll
                for (int c = 0; c < 2; ++c) {
                    __builtin_amdgcn_sched_barrier(0);
                    if (!slow) {
#pragma unroll
                        for (int i = 0; i < 16; ++i) S[c][i] = __builtin_amdgcn_exp2f(S[c][i]); }
                    const float a0 = (S[c][0] + S[c][1]) + (S[c][2] + S[c][3]), a1 = (S[c][4] + S[c][5]) + (S[c][6] + S[c][7]);
                    const float a2 = (S[c][8] + S[c][9]) + (S[c][10] + S[c][11]), a3 = (S[c][12] + S[c][13]) + (S[c][14] + S[c][15]);
                    lsum[c] += (a0 + a1) + (a2 + a3);
                    bf16x8v pf[2]; pf[0] = pack_p(S[c], 0); pf[1] = pack_p(S[c], 1);
                    __builtin_amdgcn_sched_barrier(0);
#pragma unroll
                    for (int d = 0; d < 2; ++d)
#pragma unroll
                        for (int s = 0; s < 2; ++s) O[c][d] = __builtin_amdgcn_mfma_f32_32x32x16_bf16(vfr[d][s], pf[s], O[c][d], 0, 0, 0);
                }
            }
        }
        if (t + 1 < ntiles) {
#pragma unroll
            for (int j = 0; j < 2; ++j) { *(LAS u32x4*)(L + B_KS + (buf ^ 1) * KBUF + kdst + j * 64 * KS_PITCH) = kreg[j]; *(LAS u32x4*)(L + B_VS + (buf ^ 1) * VBUF + vdst + j * 64 * 64) = vreg[j]; } }
        __syncthreads();
    }
    if (wave_on) {
        const float l0 = hsum32(lsum[0], lane), l1 = hsum32(lsum[1], lane);
        const float i0 = 1.0f / l0, i1 = lam / l1;
        float o[2][16], ss = 0.f;
#pragma unroll
        for (int d = 0; d < 2; ++d)
#pragma unroll
            for (int i = 0; i < 16; ++i) { o[d][i] = O[0][d][i] * i0 - O[1][d][i] * i1; ss += o[d][i] * o[d][i]; }
        ss = hsum32(ss, lane);
        const float rstd = rsqrtf(ss * (1.0f / 64.0f) + 1e-6f) * oscale;
        const float* gn = F.diff_norm + l * 64;
        if (!meta_u || r < NMETA) {
            _Float16* dst = (_Float16*)(F.ws + WS_ABUF) + (size_t)my_row * DM + 512 + hh * 64;
#pragma unroll
            for (int d = 0; d < 2; ++d)
#pragma unroll
                for (int g4 = 0; g4 < 4; ++g4) { const int d0 = 32 * d + 8 * g4 + 4 * h; const f32x4 gv = *(const f32x4*)(gn + d0);
                    u32x2 w; w.x = cvt_pk_f16(o[d][4 * g4 + 0] * rstd * gv[0], o[d][4 * g4 + 1] * rstd * gv[1]); w.y = cvt_pk_f16(o[d][4 * g4 + 2] * rstd * gv[2], o[d][4 * g4 + 3] * rstd * gv[3]);
                    *(u32x2*)(dst + d0) = w; }
        }
    }
}
__device__ __forceinline__ void mixB_phase(const Frame& F, int l) {
    const float* lp = F.diff_lambda + l * 128;
    float a = (F.lane < 32) ? lp[F.lane] * lp[32 + F.lane] : 0.f, c = (F.lane < 32) ? lp[64 + F.lane] * lp[96 + F.lane] : 0.f;
    a = wave_sum(a, F.lane); c = wave_sum(c, F.lane);
    const float linit = 0.8f - 0.6f * expf(-0.3f * (float)l);
    const float lam = expf(a) - expf(c) + linit, oscale = 1.0f - linit;
#pragma unroll 1
    for (int cidx = F.bid; cidx < 256; cidx += F.G) { const int bh = cidx & 7, i = cidx >> 3;
#pragma unroll 1
        for (int k = 0; k < 3; ++k) { if (k == 2 && cidx >= 8) break; mixB_unit(F, l, bh >> 2, bh & 3, k == 0 ? 63 - i : (k == 1 ? i : -1), lam, oscale); }
    }
}
__device__ __forceinline__ h8 tr_frag_nat(LAS unsigned char* img_blk, int rowbase, int s, int lane) {
    const int h = lane >> 5, blk = (lane >> 4) & 1, i16 = lane & 15, q = i16 >> 2, p = i16 & 3;
    LAS unsigned char* a = img_blk + (rowbase + 16 * s + 8 * h + q) * 64 + (16 * blk + 4 * p) * 2;
    const s16x4 lo = __builtin_amdgcn_ds_read_tr16_b64_v4i16((LAS s16x4*)a);
    const s16x4 hi = __builtin_amdgcn_ds_read_tr16_b64_v4i16((LAS s16x4*)(a + 4 * 64));
    return __builtin_bit_cast(h8, __builtin_shufflevector(lo, hi, 0, 1, 2, 3, 4, 5, 6, 7));
}
__device__ __forceinline__ h8 tr_frag_krow(LAS unsigned char* img_blk, int rowbase, int s, int lane) {
    const int h = lane >> 5, blk = (lane >> 4) & 1, i16 = lane & 15, q = i16 >> 2, p = i16 & 3;
    LAS unsigned char* a = img_blk + (rowbase + 16 * s + 4 * h + q) * 64 + (16 * blk + 4 * p) * 2;
    const s16x4 lo = __builtin_amdgcn_ds_read_tr16_b64_v4i16((LAS s16x4*)a);
    const s16x4 hi = __builtin_amdgcn_ds_read_tr16_b64_v4i16((LAS s16x4*)(a + 8 * 64));
    return __builtin_bit_cast(h8, __builtin_shufflevector(lo, hi, 0, 1, 2, 3, 4, 5, 6, 7));
}
__device__ __forceinline__ float ret_log2gamma(int hc) { return log2f(1.0f - exp2f(-5.0f - (float)hc)); }
__device__ __forceinline__ h8 scale_h8(const h8& v, float sc) { h8 o;
#pragma unroll
    for (int e = 0; e < 8; ++e) o[e] = (_Float16)((float)v[e] * sc);
    return o; }

__device__ __forceinline__ void mixC1_unit(const Frame& F, int b, int hp, int c) {
    LAS unsigned char* L = F.lds + LDS_GEN;
    const int tid = F.tid, lane = F.lane, wave = F.wave;
    const unsigned char* proj = F.ws + WS_PROJ;
    const int row0 = c == 0 ? MR + b * NMETA : b * SEQ + 128 * (c - 1), Lc = c == 0 ? NMETA : 128;
    __syncthreads();
#pragma unroll 1
    for (int idx = tid; idx < 4096; idx += NTHREADS) {
        const int head = idx >> 11, arr = (idx >> 10) & 1, j = (idx >> 3) & 127, ch = idx & 7, hc = 2 * hp + head;
        h8 v;
#pragma unroll
        for (int e = 0; e < 8; ++e) v[e] = (_Float16)0.f;
        if (j < Lc) { v = *(const h8*)(proj + (arr ? PJ_VC : PJ_KC) + (size_t)(row0 + j) * 512 + hc * 128 + ch * 16);
            if (arr) v = scale_h8(v, exp2f((float)(Lc - 1 - j) * ret_log2gamma(hc))); }
        *(LAS h8*)(L + head * 32768 + arr * 16384 + (ch >> 2) * 8192 + j * 64 + (ch & 3) * 16) = v;
    }
    __syncthreads();
    const int head = wave >> 2, mb = (wave >> 1) & 1, nb = wave & 1, r = lane & 31, h = lane >> 5;
    f32x16 acc;
#pragma unroll
    for (int i = 0; i < 16; ++i) acc[i] = 0.f;
#pragma unroll
    for (int s = 0; s < 8; ++s) { const h8 a = tr_frag_nat(L + head * 32768 + mb * 8192, 0, s, lane), bb = tr_frag_nat(L + head * 32768 + 16384 + nb * 8192, 0, s, lane);
        acc = __builtin_amdgcn_mfma_f32_32x32x16_f16(a, bb, acc, 0, 0, 0); }
    float* U = (float*)(F.ws + WS_U) + ((size_t)((b * 4 + 2 * hp + head) * 129 + c)) * 4096;
#pragma unroll
    for (int i = 0; i < 16; ++i) U[(32 * mb + crow(i, h)) * 64 + 32 * nb + r] = acc[i];
}
__device__ __forceinline__ void mixC1_phase(const Frame& F) {
#pragma unroll 1
    for (int u = F.bid; u < NB * 2 * 129; u += F.G) { const int c = u % 129, bh = u / 129; mixC1_unit(F, bh >> 1, bh & 1, c); }
}
__device__ __forceinline__ void mixC_scan(const Frame& F) {
    if (F.tid >= 128) return;
    const int e = F.bid * 128 + F.tid;
    if (e >= NB * 4 * 4096) return;
    const int bh = e >> 12, el = e & 4095, hc = bh & 3;
    const float lg = ret_log2gamma(hc), g128 = exp2f(128.f * lg), g16 = exp2f(16.f * lg);
    const float* U = (const float*)(F.ws + WS_U) + (size_t)bh * 129 * 4096 + el; float* S = (float*)(F.ws + WS_S) + (size_t)bh * 129 * 4096 + el;
    float st = U[0];
    S[4096] = st;
#pragma unroll 1
    for (int c0 = 1; c0 < 128; c0 += 16) {
        float u[16];
#pragma unroll
        for (int k = 0; k < 16; ++k) u[k] = (c0 + k < 128) ? U[(size_t)(c0 + k) * 4096] : 0.f;
#pragma unroll
        for (int k = 0; k < 16; ++k) if (c0 + k < 128) { st = st * g128 + u[k]; S[(size_t)(c0 + k + 1) * 4096] = st; }
    }
    (void)g16;
}
constexpr int C2_KI = 0, C2_VI = 128 * KS_PITCH, C2_ST = C2_VI + 16384, C2_HEAD = C2_ST + 64 * KS_PITCH;
__device__ __forceinline__ void mixC2_unit(const Frame& F, int l, int b, int hp, int c) {
    LAS unsigned char* L = F.lds + LDS_GEN;
    const int tid = F.tid, lane = F.lane, wave = F.wave, r = lane & 31, h = lane >> 5;
    const unsigned char* proj = F.ws + WS_PROJ;
    const int row0 = c == 0 ? MR + b * NMETA : b * SEQ + 128 * (c - 1), Lc = c == 0 ? NMETA : 128;
    __syncthreads();
#pragma unroll 1
    for (int idx = tid; idx < 4096; idx += NTHREADS) {
        const int head = idx >> 11, arr = (idx >> 10) & 1, j = (idx >> 3) & 127, ch = idx & 7, hc = 2 * hp + head;
        h8 v;
#pragma unroll
        for (int e = 0; e < 8; ++e) v[e] = (_Float16)0.f;
        if (j < Lc) v = *(const h8*)(proj + (arr ? PJ_VC : PJ_KC) + (size_t)(row0 + j) * 512 + hc * 128 + ch * 16);
        if (arr) *(LAS h8*)(L + head * C2_HEAD + C2_VI + (ch >> 2) * 8192 + j * 64 + (ch & 3) * 16) = v;
        else     *(LAS h8*)(L + head * C2_HEAD + C2_KI + j * KS_PITCH + ch * 16) = v;
    }
    if (c > 0) {
#pragma unroll 1
        for (int idx = tid; idx < 2 * 4096; idx += NTHREADS) { const int head = idx >> 12, el = idx & 4095, dk = el >> 6, dv = el & 63;
            const float v = ((const float*)(F.ws + WS_S))[((size_t)((b * 4 + 2 * hp + head) * 129 + c)) * 4096 + el];
            *(LAS _Float16*)(L + head * C2_HEAD + C2_ST + dv * KS_PITCH + dk * 2) = (_Float16)v; }
    }
    __syncthreads();
    const int head = wave >> 2, wq = wave & 3, hc = 2 * hp + head;
    if (wq * 32 < Lc) {
        LAS unsigned char* Hb = L + head * C2_HEAD;
        const int qi = wq * 32 + r, my_row = row0 + qi;
        const float lg = ret_log2gamma(hc);
        h8 qf[4];
#pragma unroll
        for (int s = 0; s < 4; ++s) qf[s] = *(const h8*)(proj + PJ_QC + (size_t)my_row * 512 + hc * 128 + (16 * s + 8 * h) * 2);
        f32x16 O[2];
#pragma unroll
        for (int d = 0; d < 2; ++d)
#pragma unroll
            for (int i = 0; i < 16; ++i) O[d][i] = 0.f;
        if (c > 0) {
#pragma unroll
            for (int d = 0; d < 2; ++d)
#pragma unroll
                for (int s = 0; s < 4; ++s) { const h8 a = *(const LAS h8*)(Hb + C2_ST + (32 * d + r) * KS_PITCH + (16 * s + 8 * h) * 2);
                    O[d] = __builtin_amdgcn_mfma_f32_32x32x16_f16(a, qf[s], O[d], 0, 0, 0); }
            const float qd = exp2f((float)(qi + 1) * lg);
#pragma unroll
            for (int d = 0; d < 2; ++d)
#pragma unroll
                for (int i = 0; i < 16; ++i) O[d][i] *= qd;
        }
#pragma unroll 1
        for (int jb = 0; jb <= wq; ++jb) {
            f32x16 S;
#pragma unroll
            for (int i = 0; i < 16; ++i) S[i] = 0.f;
#pragma unroll
            for (int s = 0; s < 4; ++s) { const h8 kf = *(const LAS h8*)(Hb + C2_KI + (32 * jb + r) * KS_PITCH + (16 * s + 8 * h) * 2);
                S = __builtin_amdgcn_mfma_f32_32x32x16_f16(kf, qf[s], S, 0, 0, 0); }
#pragma unroll
            for (int i = 0; i < 16; ++i) { const int dd = qi - (32 * jb + crow(i, h)); S[i] = dd >= 0 ? S[i] * exp2f((float)dd * lg) : 0.f; }
            h8 pf[2];
#pragma unroll
            for (int s = 0; s < 2; ++s) { u32x4 p; p.x = cvt_pk_f16(S[8 * s + 0], S[8 * s + 1]); p.y = cvt_pk_f16(S[8 * s + 2], S[8 * s + 3]); p.z = cvt_pk_f16(S[8 * s + 4], S[8 * s + 5]); p.w = cvt_pk_f16(S[8 * s + 6], S[8 * s + 7]); pf[s] = __builtin_bit_cast(h8, p); }
#pragma unroll
            for (int d = 0; d < 2; ++d)
#pragma unroll
                for (int s = 0; s < 2; ++s) { const h8 vf = tr_frag_krow(Hb + C2_VI + d * 8192, 32 * jb, s, lane);
                    O[d] = __builtin_amdgcn_mfma_f32_32x32x16_f16(vf, pf[s], O[d], 0, 0, 0); }
        }
        float ss = 0.f;
#pragma unroll
        for (int d = 0; d < 2; ++d)
#pragma unroll
            for (int i = 0; i < 16; ++i) ss += O[d][i] * O[d][i];
        ss = hsum32(ss, lane);
        const float rstd = rsqrtf(ss * (1.0f / 64.0f) + 1e-6f);
        if (qi < Lc) {
            const float* gn = F.ret_norm + l * 256 + hc * 64;
            const _Float16* gc = (const _Float16*)(proj + PJ_GC) + (size_t)my_row * 256 + hc * 64;
            _Float16* dst = (_Float16*)(F.ws + WS_ABUF) + (size_t)my_row * DM + 768 + hc * 64;
#pragma unroll
            for (int d = 0; d < 2; ++d)
#pragma unroll
                for (int g4 = 0; g4 < 4; ++g4) { const int d0 = 32 * d + 8 * g4 + 4 * h; const f32x4 gv = *(const f32x4*)(gn + d0); const h4 gg = *(const h4*)(gc + d0);
                    float o[4];
#pragma unroll
                    for (int e = 0; e < 4; ++e) { const float g = (float)gg[e]; o[e] = O[d][4 * g4 + e] * rstd * gv[e] * (g / (1.0f + __expf(-g))); }
                    u32x2 w; w.x = cvt_pk_f16(o[0], o[1]); w.y = cvt_pk_f16(o[2], o[3]); *(u32x2*)(dst + d0) = w; }
        }
    }
}
__device__ __forceinline__ void mixC2_phase(const Frame& F, int l) {
#pragma unroll 1
    for (int u = F.bid; u < NB * 2 * 129; u += F.G) { const int c = u % 129, bh = u / 129; mixC2_unit(F, l, bh >> 1, bh & 1, c); }
}
constexpr int IDX_HIST = 0, IDX_STATS = 16512, IDX_INFO = 18816, IDX_CCNT = 19072, IDX_MASK = 19456, IDX_CAND = 85248, IDX_Q = IDX_CAND + 32 * 128 * 8, IDX_QPITCH = 1168, IDX_END = IDX_Q + 32 * IDX_QPITCH;
#ifndef PROBE_REP
#define PROBE_REP 0
#endif
constexpr int IDX_CAP = 128, IDX_NBIN = 128, NSUB = 3;
static_assert(IDX_END + LDS_GEN <= LDS_BYTES, "indexer LDS");
struct KFrag { h8 v[4]; };
__device__ __forceinline__ KFrag idx_load_k(const unsigned char* krow_ptr, int h) { KFrag k;
#pragma unroll
    for (int s = 0; s < 4; ++s) k.v[s] = *(const h8*)(krow_ptr + (16 * s + 8 * h) * 2);
    return k; }
#define IDX_LOADQ(dst, hd) do { _Pragma("unroll") for (int s_ = 0; s_ < 4; ++s_) dst[s_] = *(const LAS h8*)(qimg_lane + ((hd) * 64 + 16 * s_) * 2); } while (0)
#define IDX_MFMA4(acc, q) do { _Pragma("unroll") for (int s_ = 0; s_ < 4; ++s_) acc = __builtin_amdgcn_mfma_f32_32x32x16_f16(kf.v[s_], q[s_], acc, 0, 0, 0); } while (0)
#define IDX_FMA(hd, S) do { _Pragma("unroll") for (int i_ = 0; i_ < 16; ++i_) sc[i_] = __builtin_fmaf(w[hd], __builtin_fabsf(S[i_]), sc[i_]); } while (0)
#define IDX_SB __builtin_amdgcn_sched_barrier(0)
__device__ __forceinline__ void idx_scores(const LAS unsigned char* qimg_lane, const float (&w)[8], const KFrag& kf, f32x16& sc) {
    h8 q[2][4]; f32x16 S[2];
    IDX_LOADQ(q[0], 8); IDX_SB;
#pragma unroll
    for (int i = 0; i < 16; ++i) sc[i] = 0.f;
    IDX_MFMA4(sc, q[0]); IDX_LOADQ(q[1], 0); IDX_SB;
#pragma unroll
    for (int hd = 0; hd < 8; ++hd) {
#pragma unroll
        for (int i = 0; i < 16; ++i) S[hd & 1][i] = 0.f;
        IDX_MFMA4(S[hd & 1], q[(hd + 1) & 1]);
        if (hd < 7) IDX_LOADQ(q[hd & 1], hd + 1);
        if (hd > 0) IDX_FMA(hd - 1, S[(hd - 1) & 1]);
        IDX_SB;
    }
    IDX_FMA(7, S[1]);
}
#define IDX_PIN(V) asm volatile("" : "+v"(V[0]), "+v"(V[1]), "+v"(V[2]), "+v"(V[3]), "+v"(V[4]), "+v"(V[5]), "+v"(V[6]), "+v"(V[7]), "+v"(V[8]), "+v"(V[9]), "+v"(V[10]), "+v"(V[11]), "+v"(V[12]), "+v"(V[13]), "+v"(V[14]), "+v"(V[15]))
#define IDX_MFMA4K(acc, q, KF) do { _Pragma("unroll") for (int s_ = 0; s_ < 4; ++s_) acc = __builtin_amdgcn_mfma_f32_32x32x16_f16(KF.v[s_], q[s_], acc, 0, 0, 0); } while (0)
#define IDX_FMA2(SC, hd, S) do { _Pragma("unroll") for (int i_ = 0; i_ < 16; ++i_) SC[i_] = __builtin_fmaf(w[hd], __builtin_fabsf(S[i_]), SC[i_]); } while (0)
__device__ __forceinline__ void idx_scores2(const LAS unsigned char* qimg_lane, const float (&w)[8], const KFrag& kfA, const KFrag& kfB, f32x16& scA, f32x16& scB) {
    h8 q[2][4]; f32x16 SA, SB;
    IDX_LOADQ(q[0], 8); IDX_SB;
#pragma unroll
    for (int i = 0; i < 16; ++i) { scA[i] = 0.f; scB[i] = 0.f; }
    IDX_MFMA4K(scA, q[0], kfA); IDX_MFMA4K(scB, q[0], kfB); IDX_LOADQ(q[1], 0); IDX_SB;
#pragma unroll
    for (int hd = 0; hd < 8; ++hd) {
#pragma unroll
        for (int i = 0; i < 16; ++i) SA[i] = 0.f;
        IDX_MFMA4K(SA, q[(hd + 1) & 1], kfA);
        if (hd > 0) { IDX_FMA2(scB, hd - 1, SB); IDX_PIN(scB); }
        IDX_SB;
#pragma unroll
        for (int i = 0; i < 16; ++i) SB[i] = 0.f;
        IDX_MFMA4K(SB, q[(hd + 1) & 1], kfB);
        if (hd < 7) IDX_LOADQ(q[hd & 1], hd + 1);
        IDX_FMA2(scA, hd, SA); IDX_PIN(scA);
        IDX_SB;
    }
    IDX_FMA2(scB, 7, SB);
}
template <int NS> __device__ __forceinline__ void idx_scoresN(const LAS unsigned char* qimg_lane, const float (&w)[8], KFrag (&kf)[NS], const unsigned char* const (&nextp)[NS], int h, f32x16 (&sc)[NS]) {
    h8 q[2][4]; f32x16 S[NS];
    IDX_LOADQ(q[0], 8); IDX_SB;
#pragma unroll
    for (int t = 0; t < NS; ++t) {
#pragma unroll
        for (int i = 0; i < 16; ++i) sc[t][i] = 0.f;
        IDX_MFMA4K(sc[t], q[0], kf[t]); }
    IDX_LOADQ(q[1], 0); IDX_SB;
#pragma unroll
    for (int hd = 0; hd < 8; ++hd) {
#pragma unroll
        for (int t = 0; t < NS; ++t) {
#pragma unroll
            for (int i = 0; i < 16; ++i) S[t][i] = 0.f;
            IDX_MFMA4K(S[t], q[(hd + 1) & 1], kf[t]);
            if (t == NS - 1) { if (hd < 7) IDX_LOADQ(q[hd & 1], hd + 1); else {
#pragma unroll
                for (int u = 0; u < NS; ++u) kf[u] = idx_load_k(nextp[u], h); } }
            if (t > 0) { IDX_FMA2(sc[t - 1], hd, S[t - 1]); IDX_PIN(sc[t - 1]); }
            else if (hd > 0) { IDX_FMA2(sc[NS - 1], hd - 1, S[NS - 1]); IDX_PIN(sc[NS - 1]); }
            IDX_SB;
        }
    }
    IDX_FMA2(sc[NS - 1], 7, S[NS - 1]);
}
__device__ __forceinline__ int suffix_sum(int v, int lane) {
#pragma unroll
    for (int off = 1; off < 64; off <<= 1) { const int t = __builtin_amdgcn_ds_bpermute((lane + off) << 2, v); if (lane + off < 64) v += t; }
    return v;
}
__device__ __forceinline__ void mixA_index_unit(const Frame& F, int b, int g) {
    LAS unsigned char* L = F.lds + LDS_GEN;
    int tid_ = F.tid, lane_ = F.lane; asm volatile("" : "+v"(tid_), "+v"(lane_));
    const int tid = tid_, lane = lane_, wave = F.wave, r = lane & 31, h = lane >> 5;
    const unsigned char* proj = F.ws + WS_PROJ;
    const unsigned char* KI = proj + PJ_KI;
    const int nq = g == 0 ? NMETA : 32;
    const int qrow = g == 0 ? MR + b * NMETA + (r & 15) : b * SEQ + 32 * (g - 1) + r;
    const int tq0 = g == 0 ? 0 : NMETA + 32 * (g - 1);
    const bool qvalid = r < nq;
    auto ks_row0 = [&](int ks) -> int { return ks == 0 ? MR + b * NMETA : b * SEQ + 32 * (ks - 1); };
    __syncthreads();
    for (int i = tid; i < 32 * 129; i += NTHREADS) ((LAS unsigned*)(L + IDX_HIST))[i] = 0u;
    if (tid < 32) ((LAS unsigned*)(L + IDX_CCNT))[tid] = 0u;
    for (int i = tid; i < (g + 1) * 32; i += NTHREADS) ((LAS unsigned*)(L + IDX_MASK))[i] = 0u;
    float w[8];
    const LAS unsigned char* qf = L + IDX_Q + r * IDX_QPITCH + 8 * h * 2;
    { const float* WI = (const float*)(proj + PJ_WI) + (size_t)qrow * 8; const f32x4 w0 = *(const f32x4*)WI, w1 = *(const f32x4*)(WI + 4);
      w[0] = w0[0]; w[1] = w0[1]; w[2] = w0[2]; w[3] = w0[3]; w[4] = w1[0]; w[5] = w1[1]; w[6] = w1[2]; w[7] = w1[3]; }
    { const int qq = tid >> 4, dc = tid & 15; const int qr = g == 0 ? MR + b * NMETA + (qq & 15) : b * SEQ + 32 * (g - 1) + qq;
      const unsigned char* qsrc = proj + PJ_QI + (size_t)qr * 1024 + dc * 8; u32x2 qv[8];
#pragma unroll
      for (int hd = 0; hd < 8; ++hd) qv[hd] = *(const u32x2*)(qsrc + hd * 128);
      const float* WQ = (const float*)(proj + PJ_WI) + (size_t)qr * 8; const f32x4 wa = *(const f32x4*)WQ, wb = *(const f32x4*)(WQ + 4);
      const float wq[8] = {wa[0], wa[1], wa[2], wa[3], wb[0], wb[1], wb[2], wb[3]};
      float a4[4] = {0.f, 0.f, 0.f, 0.f};
#pragma unroll
      for (int hd = 0; hd < 8; ++hd) { const h4 q = __builtin_bit_cast(h4, qv[hd]);
#pragma unroll
          for (int e = 0; e < 4; ++e) a4[e] += wq[hd] * (float)q[e];
          *(LAS u32x2*)(L + IDX_Q + qq * IDX_QPITCH + hd * 128 + dc * 8) = qv[hd]; }
      u32x2 o; o.x = cvt_pk_f16(a4[0], a4[1]); o.y = cvt_pk_f16(a4[2], a4[3]);
      *(LAS u32x2*)(L + IDX_Q + qq * IDX_QPITCH + 1024 + dc * 8) = o; }
    __syncthreads();
    if (wave < 4) {
        const KFrag kf = idx_load_k(KI + (size_t)(b * SEQ + 32 * wave + r) * 128, h);
        f32x16 sc; idx_scores(qf, w, kf, sc);
        float s1 = 0.f, s2 = 0.f;
#pragma unroll
        for (int i = 0; i < 16; ++i) { s1 += sc[i]; s2 += sc[i] * sc[i]; }
        s1 = hsum32(s1, lane); s2 = hsum32(s2, lane);
        if (h == 0) { ((LAS float*)(L + IDX_STATS))[(wave * 32 + r) * 2] = s1; ((LAS float*)(L + IDX_STATS))[(wave * 32 + r) * 2 + 1] = s2; }
    }
    __syncthreads();
    float c0f, inv;
    { float s1 = 0.f, s2 = 0.f;
#pragma unroll
      for (int k = 0; k < 4; ++k) { s1 += ((LAS float*)(L + IDX_STATS))[(k * 32 + r) * 2]; s2 += ((LAS float*)(L + IDX_STATS))[(k * 32 + r) * 2 + 1]; }
      const float mean = s1 * (1.0f / 128.0f), var = fmaxf(s2 * (1.0f / 128.0f) - mean * mean, 0.f), sd = fmaxf(sqrtf(var), 1e-12f);
      inv = (float)IDX_NBIN / (10.0f * sd); c0f = -(mean - 3.0f * sd) * inv; }
    LAS unsigned* hrow = (LAS unsigned*)(L + IDX_HIST) + r * 129;
#if PROBE_REP == 12
    for (int rep12 = 0; rep12 < 2; ++rep12) { __syncthreads(); for (int i = tid; i < 32 * 129; i += NTHREADS) ((LAS unsigned*)(L + IDX_HIST))[i] = 0u; __syncthreads();
#else
    {
#endif
        auto krow = [&](int ks) -> const unsigned char* { return KI + (size_t)(ks_row0(ks <= g ? ks : g) + r) * 128; };
        KFrag kf[NSUB];
#pragma unroll
        for (int u = 0; u < NSUB; ++u) kf[u] = idx_load_k(krow(NSUB * wave + u), h);
#pragma unroll 1
        for (int ks = NSUB * wave; ks <= g; ks += 8 * NSUB) {
            const unsigned char* nextp[NSUB];
#pragma unroll
            for (int u = 0; u < NSUB; ++u) nextp[u] = krow(ks + 8 * NSUB + u);
            f32x16 scv[NSUB]; idx_scoresN<NSUB>(qf, w, kf, nextp, h, scv);
#pragma unroll
            for (int u2 = 0; u2 < NSUB; ++u2) {
                const int kss = ks + u2; if (kss > g) continue;
                if (kss == 0 || kss == g) {
#pragma unroll
                    for (int i = 0; i < 16; ++i) {
                        const int kidx = crow(i, h);
                        const bool ok = qvalid && (kss == 0 ? kidx < NMETA && (g > 0 || kidx <= r) : kidx <= r);
                        if (ok) { const unsigned bin = (unsigned)__builtin_amdgcn_fmed3f(__builtin_fmaf(scv[u2][i], inv, c0f), 0.f, (float)(IDX_NBIN - 1)); __hip_atomic_fetch_add(hrow + bin, 1u, __ATOMIC_RELAXED, __HIP_MEMORY_SCOPE_WORKGROUP); }
                    }
                } else {
#pragma unroll
                    for (int i = 0; i < 16; ++i) { const unsigned bin = (unsigned)__builtin_amdgcn_fmed3f(__builtin_fmaf(scv[u2][i], inv, c0f), 0.f, (float)(IDX_NBIN - 1)); __hip_atomic_fetch_add(hrow + bin, 1u, __ATOMIC_RELAXED, __HIP_MEMORY_SCOPE_WORKGROUP); }
                }
            }
        }
    }
    __syncthreads();
#pragma unroll 1
    for (int k = 0; k < 4; ++k) {
        const int row = 4 * wave + k;
        const int c0 = (int)((LAS unsigned*)(L + IDX_HIST))[row * 129 + 2 * lane], c1 = (int)((LAS unsigned*)(L + IDX_HIST))[row * 129 + 2 * lane + 1];
        const int SL = suffix_sum(c0 + c1, lane), NT = __builtin_amdgcn_readlane(SL, 0);
        int bstar = -1, need = 0;
        if (NT > 256) {
            const unsigned long long ml = __ballot(SL >= 256); const int lL = 63 - __builtin_clzll(ml); const int sl = __builtin_amdgcn_readlane(SL, lL), t0 = __builtin_amdgcn_readlane(c0, lL), t1 = __builtin_amdgcn_readlane(c1, lL); const int above = sl - t0 - t1;
            if (above + t1 >= 256) { bstar = 2 * lL + 1; need = 256 - above; } else { bstar = 2 * lL; need = 256 - above - t1; }
        }
        if (lane == 0) { ((LAS int*)(L + IDX_INFO))[row * 2] = bstar; ((LAS int*)(L + IDX_INFO))[row * 2 + 1] = need; }
    }
    __syncthreads();
    float lo_f, hi_f;
    { const int bstar = ((LAS int*)(L + IDX_INFO))[r * 2];
      hi_f = bstar < 0 ? -__builtin_inff() : (bstar >= IDX_NBIN - 1 ? __builtin_inff() : (float)(bstar + 1));
      lo_f = bstar <= 0 ? -__builtin_inff() : (float)bstar; }
    {
        auto krow = [&](int ks) -> const unsigned char* { return KI + (size_t)(ks_row0(ks <= g ? ks : g) + r) * 128; };
        KFrag kf[NSUB];
#pragma unroll
        for (int u = 0; u < NSUB; ++u) kf[u] = idx_load_k(krow(NSUB * wave + u), h);
#pragma unroll 1
        for (int ks = NSUB * wave; ks <= g; ks += 8 * NSUB) {
            const unsigned char* nextp[NSUB];
#pragma unroll
            for (int u = 0; u < NSUB; ++u) nextp[u] = krow(ks + 8 * NSUB + u);
            f32x16 scv[NSUB]; idx_scoresN<NSUB>(qf, w, kf, nextp, h, scv);
#pragma unroll
            for (int u2 = 0; u2 < NSUB; ++u2) {
                const int kss = ks + u2; if (kss > g) continue;
                unsigned part = 0u;
                const bool special = (kss == 0 || kss == g);
#pragma unroll
                for (int i = 0; i < 16; ++i) {
                    const int kidx = crow(i, h);
                    bool ok = true;
                    if (special) ok = qvalid && (kss == 0 ? kidx < NMETA && (g > 0 || kidx <= r) : kidx <= r);
                    const float x = __builtin_fmaf(scv[u2][i], inv, c0f);
                    const bool sure = ok && (x >= hi_f), cand = ok && !(x >= hi_f) && (x >= lo_f);
                    part |= sure ? (1u << kidx) : 0u;
                    if (cand) { const unsigned slot = __hip_atomic_fetch_add((LAS unsigned*)(L + IDX_CCNT) + r, 1u, __ATOMIC_RELAXED, __HIP_MEMORY_SCOPE_WORKGROUP);
                        if (slot < IDX_CAP) { LAS float* cp = (LAS float*)(L + IDX_CAND) + (r * IDX_CAP + slot) * 2; cp[0] = scv[u2][i]; ((LAS int*)cp)[1] = kss * 32 + kidx; } }
                }
                __hip_atomic_fetch_or((LAS unsigned*)(L + IDX_MASK) + kss * 32 + r, part, __ATOMIC_RELAXED, __HIP_MEMORY_SCOPE_WORKGROUP);
            }
        }
    }
    __syncthreads();
#pragma unroll 1
    for (int k = 0; k < 4; ++k) {
        const int row = 4 * wave + k;
        const int need = ((LAS int*)(L + IDX_INFO))[row * 2 + 1];
        int nc = (int)((LAS unsigned*)(L + IDX_CCNT))[row]; nc = nc < IDX_CAP ? nc : IDX_CAP;
        nc = __builtin_amdgcn_readfirstlane(nc);
        if (nc == 0) continue;
        const LAS float* cb = (const LAS float*)(L + IDX_CAND) + row * IDX_CAP * 2;
        const bool v0 = lane < nc, v1 = lane + 64 < nc;
        const float s0 = v0 ? cb[lane * 2] : 0.f, s1 = v1 ? cb[(lane + 64) * 2] : 0.f;
        const int k0 = v0 ? ((const LAS int*)cb)[lane * 2 + 1] : 0, k1 = v1 ? ((const LAS int*)cb)[(lane + 64) * 2 + 1] : 0;
        int r0 = 0, r1 = 0;
        if (__builtin_amdgcn_readfirstlane(need) < nc) {
            const int n0 = nc < 64 ? nc : 64;
#pragma unroll 1
            for (int j = 0; j < n0; ++j) { const float sj = __builtin_bit_cast(float, __builtin_amdgcn_readlane(__builtin_bit_cast(int, s0), j)); const int kj = __builtin_amdgcn_readlane(k0, j);
                r0 += (sj > s0 || (sj == s0 && kj < k0)) ? 1 : 0; r1 += (sj > s1 || (sj == s1 && kj < k1)) ? 1 : 0; }
#pragma unroll 1
            for (int j = 64; j < nc; ++j) { const float sj = __builtin_bit_cast(float, __builtin_amdgcn_readlane(__builtin_bit_cast(int, s1), j - 64)); const int kj = __builtin_amdgcn_readlane(k1, j - 64);
                r0 += (sj > s0 || (sj == s0 && kj < k0)) ? 1 : 0; r1 += (sj > s1 || (sj == s1 && kj < k1)) ? 1 : 0; }
        }
        if (v0 && r0 < need) __hip_atomic_fetch_or((LAS unsigned*)(L + IDX_MASK) + (k0 >> 5) * 32 + row, 1u << (k0 & 31), __ATOMIC_RELAXED, __HIP_MEMORY_SCOPE_WORKGROUP);
        if (v1 && r1 < need) __hip_atomic_fetch_or((LAS unsigned*)(L + IDX_MASK) + (k1 >> 5) * 32 + row, 1u << (k1 & 31), __ATOMIC_RELAXED, __HIP_MEMORY_SCOPE_WORKGROUP);
    }
    __syncthreads();
    unsigned* MK = (unsigned*)(F.ws + WS_MASK) + (size_t)b * NKS * TLEN;
    for (int i = tid; i < (g + 1) * 32; i += NTHREADS) { const int ks = i >> 5, rr = i & 31; if (rr < nq) MK[(size_t)ks * TLEN + tq0 + rr] = ((LAS unsigned*)(L + IDX_MASK))[i]; }
}
__device__ __forceinline__ void mixA_index_phase(const Frame& F) {
#pragma unroll 1
    for (int c = F.bid; c < 256; c += F.G) {
#pragma unroll 1
        for (int k = 0; k < 5; ++k) {
            int u; if (k == 0) u = c; else if (k == 1) u = 511 - c; else if (k == 2) u = 512 + c; else if (k == 3) u = 1023 - c; else { if (c >= 2) break; u = 1024 + c; }
            mixA_index_unit(F, u & 1, 512 - (u >> 1));
        }
    }
}

__device__ __forceinline__ void mixA3_unit(const Frame& F, int l, int b, int ha, int qblk) {
    LAS unsigned char* L = F.lds + LDS_GEN;
    const int tid = F.tid, lane = F.lane, wave = F.wave, r = lane & 31, h = lane >> 5;
    const unsigned char* proj = F.ws + WS_PROJ;
    const _Float16* QA = (const _Float16*)(proj + PJ_QA); const unsigned char* KA = proj + PJ_KA; const unsigned char* VA = proj + PJ_VA;
    const unsigned* kmax = (const unsigned*)(F.ws + WS_CTL) + CW_KMAX + 32 * l;
    const unsigned* MK = (const unsigned*)(F.ws + WS_MASK) + (size_t)b * NKS * TLEN;
    const bool meta_u = qblk < 0;
    const int qrow0 = meta_u ? MR + b * NMETA : b * SEQ + qblk * 256;
    const int qpos0 = meta_u ? 0 : NMETA + qblk * 256;
    const int nreal = meta_u ? 0 : 2 * qblk + 2;
    const int wq0 = 32 * wave;
    const bool wave_on = meta_u ? (wave == 0) : true;
    const int my_row = wave_on ? qrow0 + wq0 + r : qrow0, my_pos = wave_on ? qpos0 + wq0 + r : 0;
    __syncthreads();
    if (tid < 128) ((LAS float*)(L + B_LUT))[tid] = F.rel_bias[BUCKET_LUT[tid] * 12 + ha] * LOG2E;
    float bmax = (lane < 32) ? F.rel_bias[lane * 12 + ha] * LOG2E : -1e30f;
    bmax = fmaxf(bmax, sx<16>(bmax, lane)); bmax = fmaxf(bmax, sx<8>(bmax, lane)); bmax = fmaxf(bmax, sx<4>(bmax, lane)); bmax = fmaxf(bmax, sx<2>(bmax, lane)); bmax = fmaxf(bmax, sx<1>(bmax, lane));
    bmax = bcast0(bmax);
    const float bfar = F.rel_bias[31 * 12 + ha] * LOG2E;
    h8 qf[4]; float mref; bool safe;
    { float n2 = 0.f;
#pragma unroll
      for (int s = 0; s < 4; ++s) { qf[s] = *(const h8*)(QA + (size_t)my_row * 512 + ha * 64 + 16 * s + 8 * h);
#pragma unroll
          for (int j = 0; j < 8; ++j) { const float v = (float)qf[s][j]; n2 += v * v; } }
      n2 = hsum32(n2, lane);
      mref = sqrtf(n2 * (__uint_as_float(kmax[ha * 2]) + __uint_as_float(kmax[ha * 2 + 1]))) * 1.002f + bmax;
      safe = __all(mref - bfar < 60.0f); if (safe) mref = bfar; }
    f32x16 O[2], Lacc;
#pragma unroll
    for (int i = 0; i < 16; ++i) { O[0][i] = 0.f; O[1][i] = 0.f; Lacc[i] = 0.f; }
    bf16x8v ones; { const u32x4 o = {0x3F803F80u, 0x3F803F80u, 0x3F803F80u, 0x3F803F80u}; ones = __builtin_bit_cast(bf16x8v, o); }
    const int skey = tid >> 3, sch = tid & 7;
    const unsigned kdst = skey * KS_PITCH + sch * 16, vdst = (sch >> 2) * (TK * 64) + skey * 64 + (sch & 3) * 16;
    const int ntiles = 1 + nreal;
    auto tile_row0 = [&](int t) -> int { return t == 0 ? MR + b * NMETA : b * SEQ + (t - 1) * TK; };
    u32x4 kreg[2], vreg[2];
#pragma unroll
    for (int j = 0; j < 2; ++j) { const size_t rr = (size_t)(tile_row0(0) + skey + 64 * j); kreg[j] = *(const u32x4*)(KA + rr * 1024 + ha * 128 + sch * 16); vreg[j] = *(const u32x4*)(VA + rr * 1024 + ha * 128 + sch * 16); }
#pragma unroll
    for (int j = 0; j < 2; ++j) { *(LAS u32x4*)(L + B_KS + kdst + j * 64 * KS_PITCH) = kreg[j]; *(LAS u32x4*)(L + B_VS + vdst + j * 64 * 64) = vreg[j]; }
    __syncthreads();
    unsigned mw[4], mwn[4] = {0u, 0u, 0u, 0u};
    mw[0] = MK[my_pos]; mw[1] = 0u; mw[2] = 0u; mw[3] = 0u;
    const int wpos0 = qpos0 + wq0;
#pragma unroll 1
    for (int t = 0; t < ntiles; ++t) {
        const int buf = t & 1;
        if (t + 1 < ntiles) {
#pragma unroll
            for (int j = 0; j < 2; ++j) { const size_t rr = (size_t)(tile_row0(t + 1) + skey + 64 * j); kreg[j] = *(const u32x4*)(KA + rr * 1024 + ha * 128 + sch * 16); vreg[j] = *(const u32x4*)(VA + rr * 1024 + ha * 128 + sch * 16); }
#pragma unroll
            for (int j = 0; j < 4; ++j) mwn[j] = MK[(size_t)(1 + 4 * t + j) * TLEN + my_pos]; }
        const int kpos0 = (t == 0) ? 0 : NMETA + (t - 1) * TK, nvalid = (t == 0) ? NMETA : TK;
        if (wave_on && kpos0 <= wpos0 + 31) {
            LAS unsigned char* Kb = L + B_KS + buf * KBUF; LAS unsigned char* Vb = L + B_VS + buf * VBUF;
#pragma unroll
            for (int sub = 0; sub < 4; ++sub) {
                if (sub * 32 >= nvalid || kpos0 + sub * 32 > wpos0 + 31) continue;
                const bool slow = !safe || (t == 0) || (kpos0 + sub * 32 + 31 > wpos0 - 128);
                const unsigned mword = mw[sub] >> (4 * h);
                f32x16 S;
                h8 kfr[4]; bf16x8v vfr[2][2];
#pragma unroll
                for (int s = 0; s < 4; ++s) kfr[s] = *(const LAS h8*)(Kb + (sub * 32 + r) * KS_PITCH + (16 * s + 8 * h) * 2);
#pragma unroll
                for (int d = 0; d < 2; ++d)
#pragma unroll
                    for (int s = 0; s < 2; ++s) vfr[d][s] = vt_frag(Vb, d, sub * 32, s, lane);
                __builtin_amdgcn_sched_barrier(0);
#pragma unroll
                for (int i = 0; i < 16; ++i) S[i] = 0.f;
#pragma unroll
                for (int s = 0; s < 4; ++s) S = __builtin_amdgcn_mfma_f32_32x32x16_f16(kfr[s], qf[s], S, 0, 0, 0);
                bf16x8v pf[2];
                if (slow) {
                    float bs[16];
#pragma unroll
                    for (int i = 0; i < 16; ++i) { const int dist = my_pos - (kpos0 + sub * 32 + crow(i, h)); bs[i] = ((const LAS float*)(L + B_LUT))[min(max(dist, 0), 127)]; }
#pragma unroll
                    for (int i = 0; i < 16; ++i) {
                        const int kidx = sub * 32 + crow(i, h), dist = my_pos - (kpos0 + kidx);
                        const bool ok = ((mword >> ((i & 3) + 8 * (i >> 2))) & 1u) != 0u && dist >= 0 && kidx < nvalid;
                        const float e = __builtin_amdgcn_exp2f(fminf(S[i] + (bs[i] - mref), 80.f));
                        S[i] = ok ? e : 0.f;
                    }
                    pf[0] = pack_p(S, 0); pf[1] = pack_p(S, 1);
                } else {
#pragma unroll
                    for (int i = 0; i < 16; ++i) S[i] = __uint_as_float(__float_as_uint(__builtin_amdgcn_exp2f(S[i])) & (unsigned)__builtin_amdgcn_sbfe((int)mword, (i & 3) + 8 * (i >> 2), 1));
                    pf[0] = pack_p(S, 0); pf[1] = pack_p(S, 1);
                }
#pragma unroll
                for (int s = 0; s < 2; ++s) { Lacc = __builtin_amdgcn_mfma_f32_32x32x16_bf16(ones, pf[s], Lacc, 0, 0, 0);
#pragma unroll
                    for (int d = 0; d < 2; ++d) O[d] = __builtin_amdgcn_mfma_f32_32x32x16_bf16(vfr[d][s], pf[s], O[d], 0, 0, 0); }
            }
        }
        if (t + 1 < ntiles) {
#pragma unroll
            for (int j = 0; j < 2; ++j) { *(LAS u32x4*)(L + B_KS + (buf ^ 1) * KBUF + kdst + j * 64 * KS_PITCH) = kreg[j]; *(LAS u32x4*)(L + B_VS + (buf ^ 1) * VBUF + vdst + j * 64 * 64) = vreg[j]; } }
#pragma unroll
        for (int j = 0; j < 4; ++j) mw[j] = mwn[j];
        __syncthreads();
    }
    if (wave_on) {
        const float il = 1.0f / Lacc[0];
        if (!meta_u || r < NMETA) {
            _Float16* dst = (_Float16*)(F.ws + WS_ABUF) + (size_t)my_row * DM + ha * 64;
#pragma unroll
            for (int d = 0; d < 2; ++d)
#pragma unroll
                for (int g4 = 0; g4 < 4; ++g4) { const int d0 = 32 * d + 8 * g4 + 4 * h;
                    u32x2 w; w.x = cvt_pk_f16(O[d][4 * g4 + 0] * il, O[d][4 * g4 + 1] * il); w.y = cvt_pk_f16(O[d][4 * g4 + 2] * il, O[d][4 * g4 + 3] * il);
                    *(u32x2*)(dst + d0) = w; }
        }
    }
}
__device__ __forceinline__ void mixA3_phase(const Frame& F, int l) {
#pragma unroll 1
    for (int c = F.bid; c < 256; c += F.G) { const int bh = c & 15, i1 = c >> 4, i2 = 31 - i1;
#pragma unroll 1
        for (int k = 0; k < 5; ++k) { if (k == 4 && c >= 16) break;
            const int qb = k == 0 ? 63 - i1 : (k == 1 ? 32 + i1 : (k == 2 ? i2 : (k == 3 ? i1 : -1)));
            mixA3_unit(F, l, bh >> 3, bh & 7, qb); }
    }
}
constexpr int NPHASES = 19;
__global__ void __launch_bounds__(NTHREADS, 2) fwd(Args args) {
    extern __shared__ __attribute__((aligned(16))) unsigned char lds_raw[];
    Frame F;
    F.x = args.in[0]; F.meta = args.in[1]; F.rel_bias = args.in[2]; F.w_in = args.in[3]; F.norm_mix = args.in[4]; F.diff_lambda = args.in[5]; F.diff_norm = args.in[6];
    F.ret_norm = args.in[7]; F.w_out = args.in[8]; F.norm_ff = args.in[9]; F.w_ff1 = args.in[10]; F.w_ff2 = args.in[11]; F.final_norm = args.in[12];
    F.out = args.out; F.ws = args.ws; F.lds = (LAS unsigned char*)lds_raw;
    F.bid = blockIdx.x; F.G = gridDim.x; F.tid = threadIdx.x; F.lane = F.tid & 63; F.wave = __builtin_amdgcn_readfirstlane(F.tid >> 6);
    if (F.tid < 64) ((LAS unsigned*)(F.lds + LDS_MISC))[F.tid] = 0u;
    __syncthreads();
    unsigned* ctl = (unsigned*)(F.ws + WS_CTL);
    XcdBarrier bar = xcd_barrier_post(ctl + CW_BAR, (volatile LAS unsigned*)(F.lds + LDS_MISC));
    const int lo = args.ph_lo, hi = args.ph_hi;
#define IN(k) (lo <= (k) && (k) < hi)
#ifndef PROBE_REP
#define PROBE_REP 0
#endif
#define RETID() do { unsigned z0_ = 0u; asm volatile("" : "+s"(z0_)); int t_ = (int)__builtin_amdgcn_mbcnt_hi(~0u, __builtin_amdgcn_mbcnt_lo(~0u, z0_)); asm volatile("" : "+v"(t_)); F.lane = t_; F.tid = F.wave * 64 + t_; } while (0)
#define REP(k) _Pragma("unroll 1") for (int rep_ = 0; rep_ < ((PROBE_REP == (k)) ? 2 : 1); ++rep_)
#define SEAM(k) do { if (IN(k) && IN((k) + 1)) xcd_barrier(bar, F.wave == 0 && F.lane == 0); } while (0)
    LAS unsigned char* stage = F.lds + LDS_GEN;
    if (IN(0)) { REP(10) prologue(F); SEAM(0);
#if PROBE_REP == 20
        for (int xb = 0; xb < 20; ++xb) xcd_barrier(bar, F.wave == 0 && F.lane == 0);
#endif
    }
#pragma unroll 1
    for (int l = 0; l < DEPTH; ++l) {
        const int pb = 1 + 9 * l;
        { RETID();
          size_t z_ = 0; int b_ = blockIdx.x, g_ = gridDim.x; asm volatile("" : "+s"(z_), "+s"(b_), "+s"(g_)); F.ws = args.ws + z_; F.out = args.out + z_; F.bid = b_; F.G = g_; }
        unsigned char* wl = F.ws + WS_W + (size_t)l * W_LAYER;
        unsigned char* proj = F.ws + WS_PROJ;
        if (IN(pb + 0)) {
            pg8::Gemm g{(const pg8::bf16_t*)(F.ws + WS_ABUF), (const pg8::bf16_t*)(wl + W_IN_OFF), MP, NPAD, DM}; pg8::StaticOrder S; S.init(MP, NPAD, F.G, F.bid);
            EpiInProj E{proj, (const f32x2*)(F.ws + WS_ROPE), ctl + CW_KMAX + 32 * l};
            pg8::gemm_phase<EpiInProj, pg8::StaticOrder, true, true>(stage, g, S, E, F.tid);
#if PROBE_REP == 7
            RETID(); pg8::gemm_phase<EpiInProj, pg8::StaticOrder, true, true>(stage, g, S, E, F.tid);
#endif
            SEAM(pb + 0);
        }
        if (IN(pb + 1)) { RETID(); REP(1) mixA_index_phase(F); RETID(); REP(2) mixC1_phase(F); SEAM(pb + 1); }
        if (IN(pb + 2)) { RETID(); REP(3) mixC_scan(F); RETID(); REP(4) mixB_phase(F, l); SEAM(pb + 2); }
        if (IN(pb + 3)) { RETID(); REP(5) mixA3_phase(F, l); RETID(); REP(6) mixC2_phase(F, l); SEAM(pb + 3); }
        if (IN(pb + 4)) { RETID();
            skinny_meta<0>(F, wl); RETID();
            pg8::Gemm g{(const pg8::bf16_t*)(F.ws + WS_ABUF), (const pg8::bf16_t*)(wl + W_OUT_OFF), MR, DM, DM}; pg8::StaticOrder S; S.init(MR, DM, F.G, F.bid);
            EpiRes E{l == 0 ? F.x : F.out, F.out, (float*)(F.ws + WS_HMETA)};
            pg8::gemm_phase<EpiRes, pg8::StaticOrder, true, true>(stage, g, S, E, F.tid);
            SEAM(pb + 4);
        }
        if (IN(pb + 5)) { RETID(); zero_scr(F); REP(8) norm_to_abuf<1>(F, F.norm_ff + (size_t)l * DM); SEAM(pb + 5); }
        if (IN(pb + 6)) { RETID();
            skinny_meta<1>(F, wl); RETID();
            pg8::Gemm g{(const pg8::bf16_t*)(F.ws + WS_ABUF), (const pg8::bf16_t*)(wl + W_FF1_OFF), MR, DFF, DM}; pg8::StaticOrder S; S.init(MR, DFF, F.G, F.bid);
            EpiRelu2 E{proj};
            pg8::gemm_phase<EpiRelu2, pg8::StaticOrder, true, true>(stage, g, S, E, F.tid);
#if PROBE_REP == 9
            RETID(); pg8::gemm_phase<EpiRelu2, pg8::StaticOrder, true, true>(stage, g, S, E, F.tid);
#endif
            SEAM(pb + 6);
        }
        if (IN(pb + 7)) { RETID();
            skinny_meta<2>(F, wl); RETID();
            pg8::Gemm g{(const pg8::bf16_t*)proj, (const pg8::bf16_t*)(wl + W_FF2_OFF), MR, DM, DFF}; pg8::StaticOrder S; S.init(MR, DM, F.G, F.bid);
            EpiRes E{F.out, F.out, (float*)(F.ws + WS_HMETA)};
#if PROBE_REP == 14
            { EpiRes E2{F.out, (float*)(F.ws + WS_ABUF), (float*)(F.ws + WS_U)}; pg8::gemm_phase<EpiRes, pg8::StaticOrder, true, true>(stage, g, S, E2, F.tid); RETID(); }
#endif
            pg8::gemm_phase<EpiRes, pg8::StaticOrder, true, true>(stage, g, S, E, F.tid);
            SEAM(pb + 7);
        }
        if (IN(pb + 8)) { RETID();
            if (l + 1 < DEPTH) { norm_to_abuf<1>(F, F.norm_mix + (size_t)(l + 1) * DM); SEAM(pb + 8); }
            else final_norm(F);
        }
    }
#undef IN
#undef SEAM
}

#ifndef MK_SPLIT
#define MK_SPLIT 0
#endif
extern "C" void kernel_launch(void* const* d_in, const int* in_sizes, int n_in, void* d_out, int out_size, void* d_ws, size_t ws_size, hipStream_t stream) {
    static int grid = 0;
    if (grid == 0) {
        if (n_in != 13 || ws_size < WS_END) { fprintf(stderr, "kernel_launch: need 13 inputs and %zu bytes of workspace; got %d, %zu\n", (size_t)WS_END, n_in, ws_size); grid = -1; return; }
        int dev = 0, cus = 0, per_cu = 0;
        if (hipGetDevice(&dev) != hipSuccess || hipDeviceGetAttribute(&cus, hipDeviceAttributeMultiprocessorCount, dev) != hipSuccess) { grid = -1; return; }
        if (hipFuncSetAttribute((const void*)fwd, hipFuncAttributeMaxDynamicSharedMemorySize, LDS_BYTES) != hipSuccess) { fprintf(stderr, "kernel_launch: hipFuncSetAttribute failed\n"); grid = -1; return; }
        if (hipOccupancyMaxActiveBlocksPerMultiprocessor(&per_cu, (const void*)fwd, NTHREADS, LDS_BYTES) != hipSuccess || per_cu < 1) { fprintf(stderr, "kernel_launch: occupancy query says %d\n", per_cu); }
        (void)hipGetLastError();
        grid = cus;
    }
    if (grid < 0) return;
    (void)hipMemsetAsync((char*)d_ws + WS_CTL, 0, CTL_BYTES, stream);
    Args a{};
    for (int i = 0; i < 13; ++i) a.in[i] = (const float*)d_in[i];
    a.out = (float*)d_out; a.ws = (unsigned char*)d_ws;
#if MK_SPLIT
    for (int p = 0; p < NPHASES; ++p) { a.ph_lo = p; a.ph_hi = p + 1; hipLaunchKernelGGL(fwd, dim3(grid), dim3(NTHREADS), LDS_BYTES, stream, a); }
#else
    a.ph_lo = 0; a.ph_hi = NPHASES; hipLaunchKernelGGL(fwd, dim3(grid), dim3(NTHREADS), LDS_BYTES, stream, a);
#endif
}
```

```cpp
#include <hip/hip_runtime.h>
#include <cstdio>
#include <cstdint>
typedef _Float16 h8 __attribute__((ext_vector_type(8)));
typedef _Float16 h4 __attribute__((ext_vector_type(4)));
typedef _Float16 h2 __attribute__((ext_vector_type(2)));
typedef short s16x8 __attribute__((ext_vector_type(8)));
typedef short s16x4 __attribute__((ext_vector_type(4)));
typedef float f32x16 __attribute__((ext_vector_type(16)));
typedef float f32x2 __attribute__((ext_vector_type(2)));
typedef unsigned u32x2 __attribute__((ext_vector_type(2)));
namespace pg8 {
#define PG8_LAS __attribute__((address_space(3)))
typedef unsigned short bf16_t;
typedef short bf16x8 __attribute__((ext_vector_type(8)));
typedef float f32x4 __attribute__((ext_vector_type(4)));
typedef unsigned u32x4 __attribute__((ext_vector_type(4)));
constexpr int BM = 256, BK = 64, HALF = 128, HTB = HALF * BK * 2  , STAGE_BYTES = 8 * HTB, NXCD = 8, WGM = 8;

__host__ __device__ __forceinline__ int lds_byte(int r, int c) { const int st = (r >> 4) * 2 + (c >> 5), rr = r & 15, cc = c & 31, ob = rr * 64 + cc * 2; return st * 1024 + (ob ^ (((ob >> 9) & 1) << 5)); }
__host__ __device__ __forceinline__ void stage_rc(int b, int& R, int& C) { const int st = b / 1024, sb = b % 1024, swz = sb ^ (((sb >> 9) & 1) << 5); R = (st >> 1) * 16 + swz / 64; C = (st & 1) * 32 + (swz % 64) / 2; }
__host__ __device__ __forceinline__ int perm32(int rho) { const int n = rho >> 4, i = rho & 15; return 8 * (i >> 2) + 4 * n + (i & 3); }

struct Unit { int pm, pn; };
struct Gemm { const bf16_t* A; const bf16_t* Bt; int M, N, K; };

struct StaticOrder {
    int nM, nN, nwg, G, c;
    __host__ __device__ void init(int M, int N, int G_, int c_) { nM = M / BM; nN = N / BM; nwg = nM * nN; G = G_; c = c_; }
    __host__ __device__ bool next(int i, Unit& u) const {
        const long L = (long)i * G + c; if (L >= nwg) return false;
        int wgid = (int)L; { const int q = nwg / NXCD, r = nwg % NXCD, xcd = wgid % NXCD, off = wgid / NXCD; wgid = (xcd < r ? xcd * (q + 1) : r * (q + 1) + (xcd - r) * q) + off; }
        const int nig = WGM * nN, gid = wgid / nig, fm = gid * WGM, gsz = (nM - fm) < WGM ? (nM - fm) : WGM;
        u.pm = fm + ((wgid % nig) % gsz); u.pn = (wgid % nig) / gsz; return true;
    }
    __device__ __forceinline__ void a_ready(const Unit&) const {}
    __device__ __forceinline__ void done(const Unit&) const {}
};

template <class Epi, class Sched, bool ALIGN_EPI = false, bool SP2 = false>
__device__ __forceinline__ void gemm_phase(PG8_LAS unsigned char* lds, const Gemm g, const Sched& S, const Epi& E, int tid_in) {
    int tid_ = tid_in; asm volatile("" : "+v"(tid_));
    const int tid = tid_, wid = __builtin_amdgcn_readfirstlane(tid >> 6), lane = tid & 63, wr = wid >> 2, wc = wid & 3, fr = lane & 15, fq = lane >> 4;
    const int K = g.K, nt = K / BK;
    unsigned voffA[2], voffB[2];
#pragma unroll
    for (int i = 0; i < 2; ++i) { int R, C; stage_rc(tid * 16 + i * 8192, R, C); const int Rb = Epi::PERM ? ((R & ~31) + perm32(R & 31)) : R;
        voffA[i] = (unsigned)(R * K + C) * 2u; voffB[i] = (unsigned)(Rb * K + C) * 2u; }
    const size_t kstep = (size_t)(BK * 2);
    const size_t hstep = (size_t)HALF * K * 2;
    const size_t tstep = 2 * hstep;
    const unsigned ldsw = (unsigned)wid * 1024u;
    const int aoff = lds_byte(wr * 64 + fr, fq * 8), boff = lds_byte(wc * 32 + fr, fq * 8);
#define PG8_SA(b, h) (((b) * 2 + (h)) * HTB)
#define PG8_SB(b, h) ((4 + (b) * 2 + (h)) * HTB)
#define PG8_STAGE(bufoff, gbase, voff) do { _Pragma("unroll") for (int _i = 0; _i < 2; ++_i) \
        __builtin_amdgcn_global_load_lds((const unsigned*)((const char*)(gbase) + (voff)[_i]), (PG8_LAS unsigned*)(lds + (bufoff) + ldsw + _i * 8192), 16, 0, 0); } while (0)
#define PG8_LDA(dst, b, h) do { _Pragma("unroll") for (int m = 0; m < 4; ++m) _Pragma("unroll") for (int k = 0; k < 2; ++k) dst[m][k] = *(const PG8_LAS bf16x8*)(lds + PG8_SA(b, h) + aoff + m * 2048 + k * 1024); } while (0)
#define PG8_LDB(dst, b, h) do { _Pragma("unroll") for (int n = 0; n < 2; ++n) _Pragma("unroll") for (int k = 0; k < 2; ++k) dst[n][k] = *(const PG8_LAS bf16x8*)(lds + PG8_SB(b, h) + boff + n * 2048 + k * 1024); } while (0)
#define PG8_MMA(ai, bj, At, Bt) do { __builtin_amdgcn_s_setprio(1); _Pragma("unroll") for (int m = 0; m < 4; ++m) _Pragma("unroll") for (int n = 0; n < 2; ++n) _Pragma("unroll") for (int k = 0; k < 2; ++k) \
        acc[ai][bj][m][n] = __builtin_amdgcn_mfma_f32_16x16x32_f16(__builtin_bit_cast(h8, Bt[n][k]), __builtin_bit_cast(h8, At[m][k]), acc[ai][bj][m][n], 0, 0, 0); __builtin_amdgcn_s_setprio(0); } while (0)
#define PG8_WAIT_V(n) asm volatile("s_waitcnt vmcnt(" #n ")" ::: "memory")
#define PG8_WAIT_L(n) asm volatile("s_waitcnt lgkmcnt(" #n ")" ::: "memory")
#define PG8_BAR __builtin_amdgcn_s_barrier()
#define PG8_SCHED __builtin_amdgcn_sched_barrier(0)
    Unit cur, nxt; int ui = 0;
    if (!S.next(0, cur)) return;
    f32x4 acc[2][2][4][2];
#pragma unroll
    for (int a = 0; a < 2; ++a)
#pragma unroll
        for (int b = 0; b < 2; ++b)
#pragma unroll
            for (int m = 0; m < 4; ++m)
#pragma unroll
                for (int n = 0; n < 2; ++n) acc[a][b][m][n] = (f32x4){0.f, 0.f, 0.f, 0.f};
    bf16x8 At[4][2], B0[2][2], B1[2][2];
    const char* cA = (const char*)g.A + (size_t)cur.pm * tstep; const char* cB = (const char*)g.Bt + (size_t)cur.pn * tstep;
    S.a_ready(cur);
    if constexpr (SP2) {
        PG8_STAGE(PG8_SB(0, 0), cB, voffB); PG8_STAGE(PG8_SB(0, 1), cB + hstep, voffB); PG8_STAGE(PG8_SA(0, 0), cA, voffA); PG8_STAGE(PG8_SA(0, 1), cA + hstep, voffA);
        if (wr == 1) PG8_BAR;
        PG8_WAIT_V(2); PG8_BAR;
        PG8_STAGE(PG8_SB(1, 0), cB + kstep, voffB); PG8_STAGE(PG8_SA(1, 0), cA + kstep, voffA); PG8_STAGE(PG8_SB(1, 1), cB + hstep + kstep, voffB);
        PG8_WAIT_V(6); PG8_BAR;
    } else {
        PG8_STAGE(PG8_SB(0, 0), cB, voffB); PG8_STAGE(PG8_SA(0, 0), cA, voffA); PG8_STAGE(PG8_SB(0, 1), cB + hstep, voffB); PG8_STAGE(PG8_SA(0, 1), cA + hstep, voffA);
        if (wr == 1) PG8_BAR;
        PG8_WAIT_V(4); PG8_BAR;
        PG8_STAGE(PG8_SB(1, 0), cB + kstep, voffB); PG8_STAGE(PG8_SA(1, 0), cA + kstep, voffA); PG8_STAGE(PG8_SB(1, 1), cB + hstep + kstep, voffB);
        PG8_WAIT_V(6); PG8_BAR;
    }
    for (;;) {
        const bool has_next = S.next(ui + 1, nxt);
        const char* nA = has_next ? (const char*)g.A + (size_t)nxt.pm * tstep : cA; const char* nB = has_next ? (const char*)g.Bt + (size_t)nxt.pn * tstep : cB;
        for (int t = 0; t < nt; t += 2) {
            const bool last = (t == nt - 2);
            const char* a1 = cA + (size_t)(t + 1) * kstep;
            const char* a2 = last ? nA : cA + (size_t)(t + 2) * kstep; const char* b2 = last ? nB : cB + (size_t)(t + 2) * kstep;
            const char* a3 = a2 + kstep; const char* b3 = b2 + kstep;
            if (last && has_next) S.a_ready(nxt);
            if constexpr (SP2) {
            PG8_LDB(B0, 0, 0); PG8_LDB(B1, 0, 1); PG8_SCHED; PG8_LDA(At, 0, 0); PG8_STAGE(PG8_SA(1, 1), a1 + hstep, voffA);
            PG8_WAIT_V(8); PG8_WAIT_L(0); PG8_BAR; PG8_MMA(0, 0, At, B0); PG8_MMA(0, 1, At, B1); PG8_BAR; PG8_SCHED;
            PG8_LDA(At, 0, 1); PG8_STAGE(PG8_SB(0, 0), b2, voffB); PG8_STAGE(PG8_SB(0, 1), b2 + hstep, voffB); PG8_STAGE(PG8_SA(0, 0), a2, voffA);
            PG8_WAIT_V(8); PG8_WAIT_L(0); PG8_BAR; PG8_MMA(1, 0, At, B0); PG8_MMA(1, 1, At, B1); PG8_BAR; PG8_SCHED;
            PG8_LDB(B0, 1, 0); PG8_LDB(B1, 1, 1); PG8_SCHED; PG8_LDA(At, 1, 0); PG8_STAGE(PG8_SA(0, 1), a2 + hstep, voffA);
            PG8_WAIT_V(8); PG8_WAIT_L(0); PG8_BAR; PG8_MMA(0, 0, At, B0); PG8_MMA(0, 1, At, B1); PG8_BAR; PG8_SCHED;
            PG8_LDA(At, 1, 1); PG8_STAGE(PG8_SB(1, 0), b3, voffB); PG8_STAGE(PG8_SB(1, 1), b3 + hstep, voffB); PG8_STAGE(PG8_SA(1, 0), a3, voffA);
            PG8_WAIT_V(8); PG8_WAIT_L(0); PG8_BAR; PG8_MMA(1, 0, At, B0); PG8_MMA(1, 1, At, B1); PG8_BAR; PG8_SCHED;
            } else {
            PG8_LDB(B0, 0, 0); PG8_SCHED; PG8_LDA(At, 0, 0); PG8_STAGE(PG8_SA(1, 1), a1 + hstep, voffA);
            PG8_WAIT_L(8); PG8_BAR; PG8_WAIT_L(0); PG8_MMA(0, 0, At, B0); PG8_BAR; PG8_SCHED;
            PG8_LDB(B1, 0, 1); PG8_STAGE(PG8_SB(0, 0), b2, voffB);
            PG8_BAR; PG8_WAIT_L(0); PG8_MMA(0, 1, At, B1); PG8_BAR;
            PG8_LDA(At, 0, 1); PG8_STAGE(PG8_SA(0, 0), a2, voffA);
            PG8_BAR; PG8_WAIT_L(0); PG8_MMA(1, 0, At, B0); PG8_BAR; PG8_SCHED;
            PG8_STAGE(PG8_SB(0, 1), b2 + hstep, voffB);
            PG8_WAIT_V(6); PG8_BAR; PG8_MMA(1, 1, At, B1); PG8_BAR;
            PG8_LDB(B0, 1, 0); PG8_SCHED; PG8_LDA(At, 1, 0); PG8_STAGE(PG8_SA(0, 1), a2 + hstep, voffA);
            PG8_WAIT_L(8); PG8_BAR; PG8_WAIT_L(0); PG8_MMA(0, 0, At, B0); PG8_BAR; PG8_SCHED;
            PG8_LDB(B1, 1, 1); PG8_STAGE(PG8_SB(1, 0), b3, voffB);
            PG8_BAR; PG8_WAIT_L(0); PG8_MMA(0, 1, At, B1); PG8_BAR;
            PG8_LDA(At, 1, 1); PG8_STAGE(PG8_SA(1, 0), a3, voffA);
            PG8_BAR; PG8_WAIT_L(0); PG8_MMA(1, 0, At, B0); PG8_BAR; PG8_SCHED;
            PG8_STAGE(PG8_SB(1, 1), b3 + hstep, voffB);
            PG8_WAIT_V(6); PG8_BAR; PG8_MMA(1, 1, At, B1); PG8_BAR;
            }
        }
        if constexpr (ALIGN_EPI) { if (wr == 0) PG8_BAR; }
        if constexpr (!Epi::AFTER_DRAIN) { E(acc, cur, wr, wc, fr, fq); S.done(cur); }
        if (!has_next) break;
#pragma unroll
        for (int a = 0; a < 2; ++a)
#pragma unroll
            for (int b = 0; b < 2; ++b)
#pragma unroll
                for (int m = 0; m < 4; ++m)
#pragma unroll
                    for (int n = 0; n < 2; ++n) acc[a][b][m][n] = (f32x4){0.f, 0.f, 0.f, 0.f};
        cur = nxt; cA = nA; cB = nB; ++ui;
        if constexpr (ALIGN_EPI) { if (wr == 1) PG8_BAR; }
    }
    PG8_WAIT_V(0);
    if constexpr (!ALIGN_EPI) { if (wr == 0) PG8_BAR; }
    PG8_BAR;
    if constexpr (Epi::AFTER_DRAIN) { E.fused(acc, cur, wr, wc, fr, fq, lds, wid, lane); S.done(cur); }
#undef PG8_SA
#undef PG8_SB
#undef PG8_STAGE
#undef PG8_LDA
#undef PG8_LDB
#undef PG8_MMA
#undef PG8_WAIT_V
#undef PG8_WAIT_L
#undef PG8_BAR
#undef PG8_SCHED
}
}

#define XB_TMO      128
#define XB_XCNT(j)  (256  + 64 * (j))
#define XB_XSUB(j)  (1280 + 64 * (j))
#define XB_XGEN(j)  (2304 + 64 * (j))
#define XB_TOP      3328
#define XB_TOPGEN   3392
#define XCD_BAR_WORDS 3456
#define XB_SPIN_CAP (1u << 18)
#define LAS __attribute__((address_space(3)))

__device__ __forceinline__ unsigned xb_ld(unsigned* p)              { return __hip_atomic_load(p, __ATOMIC_RELAXED, __HIP_MEMORY_SCOPE_AGENT); }
__device__ __forceinline__ unsigned xb_add(unsigned* p, unsigned v) { return __hip_atomic_fetch_add(p, v, __ATOMIC_RELAXED, __HIP_MEMORY_SCOPE_AGENT); }
__device__ __forceinline__ unsigned xb_xcc_id() { return (unsigned)__builtin_amdgcn_s_getreg((3 << 11) | 20) & 0xFu; }
#define XB_SPIN(cond, bar) do { unsigned _sp = 0; while (cond) { __builtin_amdgcn_s_sleep(1); \
    if ((++_sp & 255u) == 0u) { if (xb_ld(&(bar)[XB_TMO])) break; if (_sp > XB_SPIN_CAP) { atomicAdd(&(bar)[XB_TMO], 1u); break; } } } } while (0)

struct XcdBarrier {
    unsigned* bar; unsigned x;
    volatile LAS unsigned* st;
};

__device__ __forceinline__ XcdBarrier xcd_barrier_post(unsigned* bar, volatile LAS unsigned* st) {
    XcdBarrier b; b.bar = bar; b.x = xb_xcc_id(); b.st = st;
    if (threadIdx.x == 0) (void)xb_add(&bar[XB_XCNT(b.x)], 1u);
    return b;
}
__device__ __forceinline__ void xcd_barrier_complete(unsigned* bar, unsigned x, unsigned& nloc, unsigned& nx) {
    const unsigned G = gridDim.x * gridDim.y * gridDim.z;
    unsigned sum, cnt, mine, sp = 0u;
    for (;;) {
        sum = 0u; cnt = 0u; mine = 0u;
#pragma unroll
        for (unsigned j = 0; j < 16; ++j) { const unsigned c = xb_ld(&bar[XB_XCNT(j)]); sum += c; cnt += (c > 0u) ? 1u : 0u; mine = (j == x) ? c : mine; }
        if (sum == G) break;
        __builtin_amdgcn_s_sleep(1);
        if ((++sp & 255u) == 0u) { if (xb_ld(&bar[XB_TMO])) break; if (sp > XB_SPIN_CAP) { atomicAdd(&bar[XB_TMO], 1u); break; } }
    }
    nloc = mine > 0u ? mine : 1u; nx = cnt > 0u ? cnt : 1u;
}

__device__ __forceinline__ void xcd_barrier(const XcdBarrier& b, const bool leader_thread) {
    asm volatile("s_waitcnt vmcnt(0)" ::: "memory");
    __syncthreads();
    if (leader_thread) {
        unsigned* bar = b.bar;
        __builtin_amdgcn_s_waitcnt(0);
        unsigned nloc = b.st[0], nx = b.st[1];
        if (nloc == 0u) { xcd_barrier_complete(bar, b.x, nloc, nx); b.st[0] = nloc; b.st[1] = nx; }
        const unsigned old = xb_add(&bar[XB_XSUB(b.x)], 1u);
        const unsigned gen = old / nloc;
        if (old + 1u == (gen + 1u) * nloc) {
            __builtin_amdgcn_fence(__ATOMIC_RELEASE, "agent");
            asm volatile("s_waitcnt vmcnt(0)" ::: "memory");
            const unsigned og = xb_add(&bar[XB_TOP], 1u);
            const unsigned tg = og / nx;
            if (og + 1u == (tg + 1u) * nx) xb_add(&bar[XB_TOPGEN], 1u);
            else XB_SPIN(xb_ld(&bar[XB_TOPGEN]) == tg, bar);
            __builtin_amdgcn_fence(__ATOMIC_ACQUIRE, "agent");
            xb_add(&bar[XB_XGEN(b.x)], 1u);
            asm volatile("s_waitcnt vmcnt(0)" ::: "memory");
        } else {
            XB_SPIN(xb_ld(&bar[XB_XGEN(b.x)]) == gen, bar);
            __builtin_amdgcn_fence(__ATOMIC_ACQUIRE, "agent");
            asm volatile("s_waitcnt vmcnt(0)" ::: "memory");
        }
    }
    __syncthreads();
}

constexpr int NB = 2, SEQ = 16384, TLEN = 16400, DM = 1024, NMETA = 16, DEPTH = 2;
constexpr int MR = NB * SEQ;
constexpr int MV = MR + NB * NMETA;
constexpr int MP = 33024;
constexpr int INCOLS = 3912, NPAD = 4096, DFF = 4096;
constexpr int NTHREADS = 512;
constexpr float LOG2E = 1.4426950408889634f;
constexpr float QA_SCALE = 0.125f * LOG2E;
constexpr float QB_SCALE = 0.17677669529663687f * LOG2E;
constexpr float WI_SCALE = 0.044194173824159216f;
constexpr int NKS = 513;

constexpr size_t al256(size_t x) { return (x + 255) & ~(size_t)255; }
constexpr size_t WS_CTL   = 0;
constexpr size_t CTL_BYTES = 65536;
constexpr size_t WS_HMETA = CTL_BYTES;
constexpr size_t WS_ROPE  = WS_HMETA + (size_t)256 * DM * 4;
constexpr size_t WS_W     = al256(WS_ROPE + (size_t)TLEN * 32 * 8);
constexpr size_t W_IN_OFF = 0, W_OUT_OFF = (size_t)NPAD * DM * 2, W_FF1_OFF = W_OUT_OFF + (size_t)DM * DM * 2,
                 W_FF2_OFF = W_FF1_OFF + (size_t)DFF * DM * 2, W_LAYER = W_FF2_OFF + (size_t)DM * DFF * 2;
constexpr size_t WS_ABUF  = al256(WS_W + DEPTH * W_LAYER);
constexpr size_t WS_MASK  = WS_ABUF + (size_t)MP * DM * 2;
constexpr size_t WS_U     = al256(WS_MASK + (size_t)NB * NKS * TLEN * 4);
constexpr size_t WS_S     = WS_U + (size_t)NB * 4 * 129 * 4096 * 4;
constexpr size_t WS_PROJ  = WS_S + (size_t)NB * 4 * 129 * 4096 * 4;
constexpr size_t P512 = (size_t)MP * 512 * 2, P256 = (size_t)MP * 256 * 2;
constexpr size_t PJ_QA = 0, PJ_KA = P512, PJ_VA = 2 * P512, PJ_QI = 3 * P512, PJ_256 = 4 * P512;
constexpr size_t PJ_QB = PJ_256, PJ_KB = PJ_256 + P256, PJ_VB = PJ_256 + 2 * P256, PJ_QC = PJ_256 + 3 * P256, PJ_KC = PJ_256 + 4 * P256,
                 PJ_VC = PJ_256 + 5 * P256, PJ_GC = PJ_256 + 6 * P256, PJ_KI = PJ_256 + 7 * P256, PJ_WI = PJ_KI + (size_t)MP * 64 * 2,
                 PJ_END = PJ_WI + (size_t)MP * 8 * 4;
constexpr size_t ACT_BYTES = (size_t)MP * DFF * 2;
constexpr size_t WS_END = WS_PROJ + (ACT_BYTES > PJ_END ? ACT_BYTES : PJ_END);
constexpr int CW_BAR = 0;
constexpr int CW_KMAX = 4096;

constexpr int LDS_BYTES = 156 * 1024;
constexpr int LDS_MISC = 0, LDS_GEN = 256;

struct Args { const float* in[13]; float* out; unsigned char* ws; int ph_lo, ph_hi; };

struct Frame {
    const float *x, *meta, *rel_bias, *w_in, *norm_mix, *diff_lambda, *diff_norm, *ret_norm, *w_out, *norm_ff, *w_ff1, *w_ff2, *final_norm;
    float* out; unsigned char* ws; LAS unsigned char* lds; int tid, lane, wave, bid, G;
};

__device__ __forceinline__ float shx(float v, int m, int lane) { return __builtin_bit_cast(float, __builtin_amdgcn_ds_bpermute((lane ^ m) << 2, __builtin_bit_cast(int, v))); }
template <int M> __device__ __forceinline__ float sx(float v, int lane) { return shx(v, M, lane); }
__device__ __forceinline__ float hsum32(float v, int lane) { return v + shx(v, 32, lane); }
__device__ __forceinline__ unsigned hor32(unsigned v, int lane) { return v | (unsigned)__builtin_amdgcn_ds_bpermute((lane ^ 32) << 2, (int)v); }
__device__ __forceinline__ float bcast0(float v) { return __builtin_bit_cast(float, __builtin_amdgcn_ds_bpermute(0, __builtin_bit_cast(int, v))); }
__device__ __forceinline__ float wave_sum(float v, int lane) { v = hsum32(v, lane); v += sx<16>(v, lane); v += sx<8>(v, lane); v += sx<4>(v, lane); v += sx<2>(v, lane); v += sx<1>(v, lane); return v; }
__device__ __forceinline__ unsigned cvt_pk_bf16(float lo, float hi) { unsigned r; asm volatile("v_cvt_pk_bf16_f32 %0, %1, %2" : "=v"(r) : "v"(lo), "v"(hi)); return r; }
__device__ __forceinline__ unsigned cvt_pk_f16(float lo, float hi) { h2 p; p.x = (_Float16)lo; p.y = (_Float16)hi; return __builtin_bit_cast(unsigned, p); }
typedef unsigned u32x4 __attribute__((ext_vector_type(4)));
typedef float f32x4 __attribute__((ext_vector_type(4)));
__device__ __forceinline__ u32x4 pack8(const f32x4& a, const f32x4& b, bool bf) {
    u32x4 w;
    if (bf) { w.x = cvt_pk_bf16(a[0], a[1]); w.y = cvt_pk_bf16(a[2], a[3]); w.z = cvt_pk_bf16(b[0], b[1]); w.w = cvt_pk_bf16(b[2], b[3]); }
    else    { w.x = cvt_pk_f16(a[0], a[1]);  w.y = cvt_pk_f16(a[2], a[3]);  w.z = cvt_pk_f16(b[0], b[1]);  w.w = cvt_pk_f16(b[2], b[3]); }
    return w;
}
__device__ __forceinline__ int row_pos(int r) { return r < MR ? (r & (SEQ - 1)) + NMETA : ((r - MR) & 15); }

__device__ __forceinline__ int incol_map(int n) {
    if (n < 2048) return n;
    if (n < 2816) return n - 2048 + 2120;
    if (n < 3328) {
        const int seg = (n - 2816) >> 8, c = (n - 2816) & 255, head = c >> 6, p = c & 63;
        const int g = p >> 3, nn = (p >> 2) & 1, i = p & 3, d = 32 * nn + 4 * g + i;
        return (seg ? 3144 : 2888) + head * 64 + d;
    }
    if (n < 3840) return n - 3328 + 3400;
    if (n < 3904) return n - 3840 + 2048;
    if (n < 3912) return n - 3904 + 2112;
    return -1;
}

__constant__ double ROPE_REV[32] = {0.15915494309189535, 0.11934937021124886, 0.08949940160889101, 0.06711508300522726, 0.050329212104487035, 0.03774158471741977, 0.0283021958306234, 0.02122365276477766, 0.015915494309189534, 0.011934937021124886, 0.008949940160889102, 0.006711508300522725, 0.005032921210448704, 0.003774158471741977, 0.00283021958306234, 0.0021223652764777662, 0.0015915494309189536, 0.0011934937021124885, 0.0008949940160889102, 0.0006711508300522726, 0.0005032921210448703, 0.00037741584717419774, 0.00028302195830623395, 0.0002122365276477766, 0.00015915494309189535, 0.00011934937021124886, 8.949940160889102e-05, 6.711508300522725e-05, 5.0329212104487035e-05, 3.774158471741978e-05, 2.8302195830623396e-05, 2.122365276477766e-05};

struct EpiInProj {
    static constexpr bool PERM = true, AFTER_DRAIN = false;
    unsigned char* proj; const f32x2* rope; unsigned* kmax;
    __device__ __forceinline__ void kmax_update(const pg8::f32x4 (&acc)[2][2][4][2], int bj, unsigned* word, int fr, int fq) const {
        float mx = 0.f; const int LN = fq * 16 + fr;
#pragma unroll
        for (int ai = 0; ai < 2; ++ai)
#pragma unroll
            for (int m = 0; m < 4; ++m) {
                const pg8::f32x4 a = acc[ai][bj][m][0], b = acc[ai][bj][m][1];
                float s = (a[0] * a[0] + a[1] * a[1]) + (a[2] * a[2] + a[3] * a[3]) + (b[0] * b[0] + b[1] * b[1]) + (b[2] * b[2] + b[3] * b[3]);
                s += sx<16>(s, LN); s = hsum32(s, LN);
                mx = fmaxf(mx, s);
            }
        mx = fmaxf(mx, sx<1>(mx, LN)); mx = fmaxf(mx, sx<2>(mx, LN)); mx = fmaxf(mx, sx<4>(mx, LN)); mx = fmaxf(mx, sx<8>(mx, LN));
        if (fr == 0 && fq == 0) atomicMax(word, __float_as_uint(mx));
    }
    __device__ __forceinline__ void operator()(const pg8::f32x4 (&acc)[2][2][4][2], const pg8::Unit& u, int wr, int wc, int fr, int fq) const {
        const int pn = u.pn, rbase = u.pm * 256 + wr * 64 + fr, cw = wc * 32 + 8 * fq;
        if (pn <= 7 || (pn <= 14 && pn != 11 && pn != 12)) {
            unsigned char* base; int ld, colt; float scale = 1.f; bool bf = false;
            if (pn <= 7) { const int arr = pn >> 1; base = proj + (size_t)arr * P512; ld = 512; colt = (pn & 1) * 256; if (arr == 0) scale = QA_SCALE; bf = (arr == 2); }
            else { const int arr = pn - 8; base = proj + PJ_256 + (size_t)arr * P256; ld = 256; colt = 0; if (arr == 0) scale = QB_SCALE; bf = (arr == 2); }
#pragma unroll
            for (int ai = 0; ai < 2; ++ai)
#pragma unroll
                for (int m = 0; m < 4; ++m) {
                    const int row = rbase + ai * 128 + m * 16;
#pragma unroll
                    for (int bj = 0; bj < 2; ++bj) {
                        const pg8::f32x4 v0 = acc[ai][bj][m][0] * scale, v1 = acc[ai][bj][m][1] * scale;
                        *(u32x4*)(base + ((size_t)row * ld + colt + bj * 128 + cw) * 2) = pack8(v0, v1, bf);
                    }
                }
            if (pn == 2 || pn == 3) {
#pragma unroll
                for (int bj = 0; bj < 2; ++bj) { const int head = ((pn & 1) * 256 + bj * 128 + wc * 32) >> 6; kmax_update(acc, bj, kmax + head * 2 + (wc & 1), fr, fq); }
            }
            if (pn == 9) {
#pragma unroll
                for (int bj = 0; bj < 2; ++bj) { const int head = 2 * bj + (wc >> 1); kmax_update(acc, bj, kmax + 16 + head * 2 + (wc & 1), fr, fq); }
            }
        } else if (pn == 11 || pn == 12) {
            unsigned char* base = proj + PJ_256 + (size_t)(pn - 8) * P256;
            const float sc = (pn == 12) ? 0.125f : 1.f;
            const int g = 4 * (wc & 1) + fq;
#pragma unroll
            for (int ai = 0; ai < 2; ++ai)
#pragma unroll
                for (int m = 0; m < 4; ++m) {
                    const int row = rbase + ai * 128 + m * 16, t = row_pos(row);
                    const pg8::f32x4 cs0 = *(const pg8::f32x4*)(rope + (size_t)t * 32 + 4 * g), cs1 = *(const pg8::f32x4*)(rope + (size_t)t * 32 + 4 * g + 2);
                    const float c[4] = {cs0[0], cs0[2], cs1[0], cs1[2]}, s[4] = {cs0[1], cs0[3], cs1[1], cs1[3]};
#pragma unroll
                    for (int bj = 0; bj < 2; ++bj) {
                        const pg8::f32x4 x1 = acc[ai][bj][m][0], x2 = acc[ai][bj][m][1];
                        float o1[4], o2[4];
#pragma unroll
                        for (int i = 0; i < 4; ++i) { o1[i] = (x1[i] * c[i] - x2[i] * s[i]) * sc; o2[i] = (x1[i] * s[i] + x2[i] * c[i]) * sc; }
                        const int head = 2 * bj + (wc >> 1);
                        unsigned char* rp = base + ((size_t)row * 256 + head * 64 + 4 * g) * 2;
                        u32x2 w1, w2; w1.x = cvt_pk_f16(o1[0], o1[1]); w1.y = cvt_pk_f16(o1[2], o1[3]); w2.x = cvt_pk_f16(o2[0], o2[1]); w2.y = cvt_pk_f16(o2[2], o2[3]);
                        *(u32x2*)rp = w1; *(u32x2*)(rp + 64) = w2;
                    }
                }
        } else {
#pragma unroll
            for (int ai = 0; ai < 2; ++ai)
#pragma unroll
                for (int m = 0; m < 4; ++m) {
                    const int row = rbase + ai * 128 + m * 16;
                    const pg8::f32x4 v0 = acc[ai][0][m][0], v1 = acc[ai][0][m][1];
                    if (wc < 2) *(u32x4*)(proj + PJ_KI + ((size_t)row * 64 + cw) * 2) = pack8(v0, v1, false);
                    else if (wc == 2 && fq == 0) { float* wp = (float*)(proj + PJ_WI) + (size_t)row * 8; *(pg8::f32x4*)wp = v0 * WI_SCALE; *(pg8::f32x4*)(wp + 4) = v1 * WI_SCALE; }
                }
        }
    }
};
struct EpiRes {
    static constexpr bool PERM = false, AFTER_DRAIN = false;
    const float* res_main; float* out_main; float* hmeta;
    __device__ __forceinline__ void operator()(const pg8::f32x4 (&acc)[2][2][4][2], const pg8::Unit& u, int wr, int wc, int fr, int fq) const {
        const bool mt = (u.pm * 256 >= MR);
        const float* rb = mt ? hmeta : res_main; float* ob = mt ? hmeta : out_main;
        const int row0 = (mt ? u.pm * 256 - MR : u.pm * 256) + wr * 64 + fr, col0 = u.pn * 256 + wc * 32 + 4 * fq;
#pragma unroll
        for (int ai = 0; ai < 2; ++ai)
#pragma unroll
            for (int m = 0; m < 4; ++m) {
                const size_t ro = (size_t)(row0 + ai * 128 + m * 16) * DM + col0;
#pragma unroll
                for (int bj = 0; bj < 2; ++bj)
#pragma unroll
                    for (int n = 0; n < 2; ++n) { const pg8::f32x4 v = *(const pg8::f32x4*)(rb + ro + bj * 128 + n * 16) + acc[ai][bj][m][n]; *(pg8::f32x4*)(ob + ro + bj * 128 + n * 16) = v; }
            }
    }
};
struct EpiRelu2 {
    static constexpr bool PERM = true, AFTER_DRAIN = false;
    unsigned char* act;
    __device__ __forceinline__ void operator()(const pg8::f32x4 (&acc)[2][2][4][2], const pg8::Unit& u, int wr, int wc, int fr, int fq) const {
        const int rbase = u.pm * 256 + wr * 64 + fr, col0 = u.pn * 256 + wc * 32 + 8 * fq;
#pragma unroll
        for (int ai = 0; ai < 2; ++ai)
#pragma unroll
            for (int m = 0; m < 4; ++m) {
                const int row = rbase + ai * 128 + m * 16;
#pragma unroll
                for (int bj = 0; bj < 2; ++bj) {
                    pg8::f32x4 v0 = acc[ai][bj][m][0], v1 = acc[ai][bj][m][1];
#pragma unroll
                    for (int i = 0; i < 4; ++i) { const float a = fmaxf(v0[i], 0.f), b = fmaxf(v1[i], 0.f); v0[i] = a * a; v1[i] = b * b; }
                    *(u32x4*)(act + ((size_t)row * DFF + col0 + bj * 128) * 2) = pack8(v0, v1, false);
                }
            }
    }
};

struct WTile { const float* src; _Float16* dst; int ld, K, k0, n0, mapped; };
constexpr int WT_PER_LAYER = 16 * 64 + 16 * 16 + 16 * 64 + 64 * 16, WT_TOTAL = DEPTH * WT_PER_LAYER;
__device__ __forceinline__ WTile wt_desc(const Frame& F, int t) {
    WTile d; const int l = t / WT_PER_LAYER; int r = t - l * WT_PER_LAYER;
    unsigned char* wl = F.ws + WS_W + (size_t)l * W_LAYER;
    if (r < 1024)      { d.src = F.w_in + (size_t)l * DM * INCOLS; d.dst = (_Float16*)(wl + W_IN_OFF);  d.ld = INCOLS; d.K = DM;  d.mapped = 1; d.k0 = (r & 15) * 64; d.n0 = (r >> 4) * 64; }
    else if (r < 1280) { r -= 1024; d.src = F.w_out + (size_t)l * DM * DM;  d.dst = (_Float16*)(wl + W_OUT_OFF); d.ld = DM;  d.K = DM;  d.mapped = 0; d.k0 = (r & 15) * 64; d.n0 = (r >> 4) * 64; }
    else if (r < 2304) { r -= 1280; d.src = F.w_ff1 + (size_t)l * DM * DFF; d.dst = (_Float16*)(wl + W_FF1_OFF); d.ld = DFF; d.K = DM;  d.mapped = 0; d.k0 = (r & 15) * 64; d.n0 = (r >> 4) * 64; }
    else               { r -= 2304; d.src = F.w_ff2 + (size_t)l * DFF * DM; d.dst = (_Float16*)(wl + W_FF2_OFF); d.ld = DM;  d.K = DFF; d.mapped = 0; d.k0 = (r & 63) * 64; d.n0 = (r >> 6) * 64; }
    return d;
}
__device__ __forceinline__ void wt_load(const WTile& d, int tid, f32x4& v0, f32x4& v1) {
    const int kk = tid >> 4, n4 = (tid & 15) * 4; const int sc = d.mapped ? incol_map(d.n0 + n4) : d.n0 + n4;
    v0 = (f32x4){0.f, 0.f, 0.f, 0.f}; v1 = v0;
    if (sc >= 0) { v0 = *(const f32x4*)(d.src + (size_t)(d.k0 + kk) * d.ld + sc); v1 = *(const f32x4*)(d.src + (size_t)(d.k0 + kk + 32) * d.ld + sc); }
}
__device__ __forceinline__ void wtrans_all(const Frame& F) {
    LAS float* tile = (LAS float*)(F.lds + LDS_GEN); const int tid = F.tid;
    int t = F.bid; if (t >= WT_TOTAL) return;
    WTile d = wt_desc(F, t); f32x4 v0, v1; wt_load(d, tid, v0, v1);
#pragma unroll 1
    for (;;) {
        const int tn = t + F.G; WTile dn = d; f32x4 n0 = v0, n1 = v1;
        if (tn < WT_TOTAL) { dn = wt_desc(F, tn); wt_load(dn, tid, n0, n1); }
        { const int kk = tid >> 4, n4 = (tid & 15) * 4;
#pragma unroll
          for (int e = 0; e < 4; ++e) { tile[kk * 65 + n4 + e] = v0[e]; tile[(kk + 32) * 65 + n4 + e] = v1[e]; } }
        __syncthreads();
        { const int nn = tid >> 3, k8 = (tid & 7) * 8; h8 o;
#pragma unroll
          for (int e = 0; e < 8; ++e) o[e] = (_Float16)tile[(k8 + e) * 65 + nn];
          *(h8*)(d.dst + (size_t)(d.n0 + nn) * d.K + d.k0 + k8) = o; }
        __syncthreads();
        if (tn >= WT_TOTAL) break;
        t = tn; d = dn; v0 = n0; v1 = n1;
    }
}
template <int MODE> __device__ __forceinline__ void norm_to_abuf(const Frame& F, const float* gain) {
    _Float16* abuf = (_Float16*)(F.ws + WS_ABUF); const float* hmeta = (const float*)(F.ws + WS_HMETA);
    const int nw = F.G * 8;
    for (int r = F.bid * 8 + F.wave; r < MP; r += nw) {
        _Float16* dst = abuf + (size_t)r * DM;
        if (r >= MV) { const h4 z = {(_Float16)0.f, (_Float16)0.f, (_Float16)0.f, (_Float16)0.f};
#pragma unroll
            for (int j = 0; j < 4; ++j) *(h4*)(dst + j * 256 + F.lane * 4) = z; continue; }
        const float* src = MODE == 0 ? (r < MR ? F.x + (size_t)r * DM : F.meta + (size_t)((r - MR) & 15) * DM) : (r < MR ? F.out + (size_t)r * DM : hmeta + (size_t)(r - MR) * DM);
        f32x4 v[4]; float ss = 0.f;
#pragma unroll
        for (int j = 0; j < 4; ++j) { v[j] = *(const f32x4*)(src + j * 256 + F.lane * 4); ss += (v[j][0] * v[j][0] + v[j][1] * v[j][1]) + (v[j][2] * v[j][2] + v[j][3] * v[j][3]); }
        ss = wave_sum(ss, F.lane); const float rstd = rsqrtf(ss * (1.0f / DM) + 1e-6f);
#pragma unroll
        for (int j = 0; j < 4; ++j) { const f32x4 g = *(const f32x4*)(gain + j * 256 + F.lane * 4); h4 o;
#pragma unroll
            for (int e = 0; e < 4; ++e) o[e] = (_Float16)(v[j][e] * rstd * g[e]);
            *(h4*)(dst + j * 256 + F.lane * 4) = o; }
    }
}
__device__ __forceinline__ void final_norm(const Frame& F) {
    const int nw = F.G * 8;
    for (int r = F.bid * 8 + F.wave; r < MR; r += nw) {
        float* p = F.out + (size_t)r * DM; f32x4 v[4]; float ss = 0.f;
#pragma unroll
        for (int j = 0; j < 4; ++j) { v[j] = *(const f32x4*)(p + j * 256 + F.lane * 4); ss += (v[j][0] * v[j][0] + v[j][1] * v[j][1]) + (v[j][2] * v[j][2] + v[j][3] * v[j][3]); }
        ss = wave_sum(ss, F.lane); const float rstd = rsqrtf(ss * (1.0f / DM) + 1e-6f);
#pragma unroll
        for (int j = 0; j < 4; ++j) { const f32x4 g = *(const f32x4*)(F.final_norm + j * 256 + F.lane * 4); *(f32x4*)(p + j * 256 + F.lane * 4) = v[j] * rstd * g; }
    }
}
__device__ __forceinline__ void prologue(const Frame& F) {
    const int gtid = F.bid * NTHREADS + F.tid, gsz = F.G * NTHREADS;
    float* hmeta = (float*)(F.ws + WS_HMETA);
    for (int i = gtid; i < 256 * DM / 4; i += gsz) { const int row = i / (DM / 4), c4 = i % (DM / 4); f32x4 v = {0.f, 0.f, 0.f, 0.f}; if (row < NB * NMETA) v = *(const f32x4*)(F.meta + (size_t)(row & 15) * DM + c4 * 4); *(f32x4*)(hmeta + (size_t)row * DM + c4 * 4) = v; }
    f32x2* rope = (f32x2*)(F.ws + WS_ROPE);
    for (int i = gtid; i < TLEN * 32; i += gsz) { const int t = i >> 5, d = i & 31; const double rev = (double)t * ROPE_REV[d]; const float fr = (float)(rev - __builtin_floor(rev)); f32x2 cs; cs.x = __builtin_amdgcn_cosf(fr); cs.y = __builtin_amdgcn_sinf(fr); rope[i] = cs; }
    wtrans_all(F);
    norm_to_abuf<0>(F, F.norm_mix);
}
__device__ __forceinline__ int crow(int i, int h) { return (i & 3) + 8 * (i >> 2) + 4 * h; }
constexpr size_t WS_SCR = WS_U;
template <bool FROM_SCR> __device__ __forceinline__ void skinny_task(const unsigned char* A, int lda_bytes, const float* scr, const _Float16* Bt, int K, int n0, int k0, float* dst, int ldd, int lane) {
    const int r = lane & 31, h = lane >> 5;
    f32x16 acc;
#pragma unroll
    for (int i = 0; i < 16; ++i) acc[i] = 0.f;
#pragma unroll 1
    for (int kc = 0; kc < 4; ++kc) {
    h8 a[4], bb[4];
#pragma unroll
    for (int s = 0; s < 4; ++s) {
        const int k = k0 + 64 * kc + 16 * s + 8 * h;
        if (FROM_SCR) { const f32x4 x0 = *(const f32x4*)(scr + (size_t)r * DFF + k), x1 = *(const f32x4*)(scr + (size_t)r * DFF + k + 4);
#pragma unroll
            for (int e = 0; e < 4; ++e) { const float u = fmaxf(x0[e], 0.f), v = fmaxf(x1[e], 0.f); a[s][e] = (_Float16)(u * u); a[s][4 + e] = (_Float16)(v * v); } }
        else a[s] = *(const h8*)(A + (size_t)(MR + r) * lda_bytes + (size_t)k * 2);
        bb[s] = *(const h8*)(Bt + (size_t)(n0 + r) * K + k);
    }
#pragma unroll
    for (int s = 0; s < 4; ++s) acc = __builtin_amdgcn_mfma_f32_32x32x16_f16(a[s], bb[s], acc, 0, 0, 0);
    }
#pragma unroll
    for (int i = 0; i < 16; ++i) atomicAdd(dst + (size_t)crow(i, h) * ldd + n0 + r, acc[i]);
}
template <int MODE> __device__ __forceinline__ void skinny_meta(const Frame& F, const unsigned char* wl) {
    const int ntn = MODE == 1 ? 128 : 32, nks = MODE == 2 ? 16 : 4, ntask = ntn * nks;
    float* hmeta = (float*)(F.ws + WS_HMETA); float* scr = (float*)(F.ws + WS_SCR);
#pragma unroll 1
    for (int task = F.bid * 8 + F.wave; task < ntask; task += F.G * 8) {
        const int nt = task % ntn, ks = task / ntn;
        if (MODE == 0) skinny_task<false>(F.ws + WS_ABUF, DM * 2, nullptr, (const _Float16*)(wl + W_OUT_OFF), DM, nt * 32, ks * 256, hmeta, DM, F.lane);
        if (MODE == 1) skinny_task<false>(F.ws + WS_ABUF, DM * 2, nullptr, (const _Float16*)(wl + W_FF1_OFF), DM, nt * 32, ks * 256, scr, DFF, F.lane);
        if (MODE == 2) skinny_task<true>(nullptr, 0, scr, (const _Float16*)(wl + W_FF2_OFF), DFF, nt * 32, ks * 256, hmeta, DM, F.lane);
    }
}
__device__ __forceinline__ void zero_scr(const Frame& F) {
    f32x4* p = (f32x4*)(F.ws + WS_SCR); float z0 = 0.f; asm volatile("" : "+v"(z0)); const f32x4 z = {z0, z0, z0, z0};
    for (int i = F.bid * NTHREADS + F.tid; i < 32 * DFF / 4; i += F.G * NTHREADS) p[i] = z;
}
__device__ __forceinline__ void zero_abuf(const Frame& F) {
    u32x4* p = (u32x4*)(F.ws + WS_ABUF); const u32x4 z = {0u, 0u, 0u, 0u};
    for (size_t i = (size_t)F.bid * NTHREADS + F.tid; i < (size_t)MP * DM * 2 / 16; i += (size_t)F.G * NTHREADS) p[i] = z;
}

typedef short bf16x8v __attribute__((ext_vector_type(8)));
__constant__ unsigned char BUCKET_LUT[128] = {0, 1, 2, 3, 4, 5, 6, 7, 8, 9, 10, 11, 12, 13, 14, 15, 16, 16, 16, 17, 17, 18, 18, 18, 19, 19, 19, 20, 20, 20, 20, 21, 21, 21, 21, 22, 22, 22, 22, 22, 23, 23, 23, 23, 23, 23, 24, 24, 24, 24, 24, 24, 25, 25, 25, 25, 25, 25, 25, 26, 26, 26, 26, 26, 26, 26, 26, 27, 27, 27, 27, 27, 27, 27, 27, 27, 27, 28, 28, 28, 28, 28, 28, 28, 28, 28, 28, 29, 29, 29, 29, 29, 29, 29, 29, 29, 29, 29, 29, 30, 30, 30, 30, 30, 30, 30, 30, 30, 30, 30, 30, 30, 30, 31, 31, 31, 31, 31, 31, 31, 31, 31, 31, 31, 31, 31, 31, 31};
__device__ __forceinline__ bf16x8v pack_p(const f32x16& x, int s) {
    u32x4 p; p.x = cvt_pk_bf16(x[8 * s + 0], x[8 * s + 1]); p.y = cvt_pk_bf16(x[8 * s + 2], x[8 * s + 3]); p.z = cvt_pk_bf16(x[8 * s + 4], x[8 * s + 5]); p.w = cvt_pk_bf16(x[8 * s + 6], x[8 * s + 7]);
    return __builtin_bit_cast(bf16x8v, p);
}
#ifndef STAGGER
#define STAGGER 0
#endif
constexpr int TK = 128;
__device__ __forceinline__ bf16x8v vt_frag(LAS unsigned char* vimg, int dblk, int keybase, int s, int lane) {
    const int h = lane >> 5, blk = (lane >> 4) & 1, i16 = lane & 15, q = i16 >> 2, p = i16 & 3;
    LAS unsigned char* a = vimg + dblk * (TK * 64) + (keybase + 16 * s + 4 * h + q) * 64 + (16 * blk + 4 * p) * 2;
    const s16x4 lo = __builtin_amdgcn_ds_read_tr16_b64_v4i16((LAS s16x4*)a);
    const s16x4 hi = __builtin_amdgcn_ds_read_tr16_b64_v4i16((LAS s16x4*)(a + 8 * 64));
    return __builtin_shufflevector(lo, hi, 0, 1, 2, 3, 4, 5, 6, 7);
}

constexpr int KS_PITCH = 144;
constexpr int KBUF = TK * KS_PITCH, VBUF = 2 * TK * 64, B_KS = 0, B_VS = 4 * KBUF, B_LUT = B_VS + 4 * VBUF, B_END = B_LUT + 512;
__device__ __forceinline__ void mixB_unit(const Frame& F, int l, int b, int hh, int qblk, float lam, float oscale) {
    LAS unsigned char* L = F.lds + LDS_GEN;
    int lane_; { unsigned z0_ = 0u; asm volatile("" : "+s"(z0_)); lane_ = (int)__builtin_amdgcn_mbcnt_hi(~0u, __builtin_amdgcn_mbcnt_lo(~0u, z0_)); asm volatile("" : "+v"(lane_)); }
    const int lane = lane_, wave = F.wave, tid = wave * 64 + lane, r = lane & 31, h = lane >> 5;
    const unsigned char* proj = F.ws + WS_PROJ;
    const _Float16* QB = (const _Float16*)(proj + PJ_QB); const unsigned char* KB = proj + PJ_KB; const unsigned char* VB = proj + PJ_VB;
    const unsigned* kmax = (const unsigned*)(F.ws + WS_CTL) + CW_KMAX + 32 * l + 16;
    const bool meta_u = qblk < 0;
    const int qrow0 = meta_u ? MR + b * NMETA : b * SEQ + qblk * 256;
    const int qpos0 = meta_u ? 0 : NMETA + qblk * 256;
    const int nreal = meta_u ? 0 : 2 * qblk + 2;
    const int wq0 = 32 * wave;
    const bool wave_on = meta_u ? (wave == 0) : true;
    const int my_row = wave_on ? qrow0 + wq0 + r : qrow0, my_pos = qpos0 + wq0 + r;
    __syncthreads();
    if (tid < 128) ((LAS float*)(L + B_LUT))[tid] = F.rel_bias[BUCKET_LUT[tid] * 12 + 8 + hh] * LOG2E;
    float bmax = (lane < 32) ? F.rel_bias[lane * 12 + 8 + hh] * LOG2E : -1e30f;
    bmax = fmaxf(bmax, sx<16>(bmax, lane)); bmax = fmaxf(bmax, sx<8>(bmax, lane)); bmax = fmaxf(bmax, sx<4>(bmax, lane)); bmax = fmaxf(bmax, sx<2>(bmax, lane)); bmax = fmaxf(bmax, sx<1>(bmax, lane));
    bmax = bcast0(bmax);
    const float bfar = F.rel_bias[31 * 12 + 8 + hh] * LOG2E;
    h8 qf[2][2]; float mref[2]; bool safe = true;
#pragma unroll
    for (int c = 0; c < 2; ++c) {
        float n2 = 0.f;
#pragma unroll
        for (int s = 0; s < 2; ++s) { qf[c][s] = *(const h8*)(QB + (size_t)my_row * 256 + hh * 64 + c * 32 + 16 * s + 8 * h);
#pragma unroll
            for (int j = 0; j < 8; ++j) { const float v = (float)qf[c][s][j]; n2 += v * v; } }
        n2 = hsum32(n2, lane);
        mref[c] = sqrtf(n2 * __uint_as_float(kmax[hh * 2 + c])) * 1.002f + bmax;
        safe = safe && (mref[c] - bfar < 60.0f);
    }
    safe = __all(safe);
    if (safe) { mref[0] = bfar; mref[1] = bfar; }
    f32x16 O[2][2]; float lsum[2] = {0.f, 0.f};
#pragma unroll
    for (int c = 0; c < 2; ++c)
#pragma unroll
        for (int d = 0; d < 2; ++d)
#pragma unroll
            for (int i = 0; i < 16; ++i) O[c][d][i] = 0.f;
    const int skey = tid >> 3, sch = tid & 7;
    const unsigned kdst = skey * KS_PITCH + sch * 16, vdst = (sch >> 2) * (TK * 64) + skey * 64 + (sch & 3) * 16;
    const int ntiles = 1 + nreal;
    auto tile_row0 = [&](int t) -> int { return t == 0 ? MR + b * NMETA : b * SEQ + (t - 1) * TK; };
    u32x4 kreg[2], vreg[2];
#pragma unroll
    for (int j = 0; j < 2; ++j) { const size_t rr = (size_t)(tile_row0(0) + skey + 64 * j); kreg[j] = *(const u32x4*)(KB + rr * 512 + hh * 128 + sch * 16); vreg[j] = *(const u32x4*)(VB + rr * 512 + hh * 128 + sch * 16); }
#pragma unroll
    for (int j = 0; j < 2; ++j) { *(LAS u32x4*)(L + B_KS + kdst + j * 64 * KS_PITCH) = kreg[j]; *(LAS u32x4*)(L + B_VS + vdst + j * 64 * 64) = vreg[j]; }
    if (ntiles > 1) {
#pragma unroll
        for (int j = 0; j < 2; ++j) { const size_t rr = (size_t)(tile_row0(1) + skey + 64 * j); kreg[j] = *(const u32x4*)(KB + rr * 512 + hh * 128 + sch * 16); vreg[j] = *(const u32x4*)(VB + rr * 512 + hh * 128 + sch * 16); }
#pragma unroll
        for (int j = 0; j < 2; ++j) { *(LAS u32x4*)(L + B_KS + KBUF + kdst + j * 64 * KS_PITCH) = kreg[j]; *(LAS u32x4*)(L + B_VS + VBUF + vdst + j * 64 * 64) = vreg[j]; }
    }
    __syncthreads();
    const int wpos0 = qpos0 + wq0;
    if (wave >= 4) __builtin_amdgcn_s_setprio(1);
#pragma unroll 1
    for (int t = 0; t < ntiles; ++t) {
        const int buf = t & 3;
        if (STAGGER > 0 && wave >= 4 && (t & 1) == 0) __builtin_amdgcn_s_sleep(STAGGER);
        if (t + 2 < ntiles) {
#pragma unroll
            for (int j = 0; j < 2; ++j) { const size_t rr = (size_t)(tile_row0(t + 2) + skey + 64 * j); kreg[j] = *(const u32x4*)(KB + rr * 512 + hh * 128 + sch * 16); vreg[j] = *(const u32x4*)(VB + rr * 512 + hh * 128 + sch * 16); } }
        const int kpos0 = (t == 0) ? 0 : NMETA + (t - 1) * TK, nvalid = (t == 0) ? NMETA : TK;
        if (wave_on && kpos0 <= wpos0 + 31) {
            LAS unsigned char* Kb = L + B_KS + buf * KBUF; LAS unsigned char* Vb = L + B_VS + buf * VBUF;
#pragma unroll
            for (int sub = 0; sub < 4; ++sub) {
                if (sub * 32 >= nvalid || kpos0 + sub * 32 > wpos0 + 31) continue;
                const bool slow = !safe || (t == 0) || (kpos0 + sub * 32 + 31 > wpos0 - 128);
                h8 kfr[2][2]; bf16x8v vfr[2][2];
#pragma unroll
                for (int c = 0; c < 2; ++c)
#pragma unroll
                    for (int s = 0; s < 2; ++s) kfr[c][s] = *(const LAS h8*)(Kb + (sub * 32 + r) * KS_PITCH + (c * 32 + 16 * s + 8 * h) * 2);
#pragma unroll
                for (int d = 0; d < 2; ++d)
#pragma unroll
                    for (int s = 0; s < 2; ++s) vfr[d][s] = vt_frag(Vb, d, sub * 32, s, lane);
                __builtin_amdgcn_sched_barrier(0);
                f32x16 S[2];
#pragma unroll
                for (int c = 0; c < 2; ++c) {
#pragma unroll
                    for (int i = 0; i < 16; ++i) S[c][i] = 0.f;
#pragma unroll
                    for (int s = 0; s < 2; ++s) S[c] = __builtin_amdgcn_mfma_f32_32x32x16_f16(kfr[c][s], qf[c][s], S[c], 0, 0, 0);
                }
                if (slow) {
                    float bs[16];
#pragma unroll
                    for (int i = 0; i < 16; ++i) { const int dist = my_pos - (kpos0 + sub * 32 + crow(i, h)); bs[i] = ((const LAS float*)(L + B_LUT))[min(max(dist, 0), 127)]; }
#pragma unroll
                    for (int i = 0; i < 16; ++i) {
                        const int kidx = sub * 32 + crow(i, h), dist = my_pos - (kpos0 + kidx);
                        const bool ok = dist >= 0 && kidx < nvalid;
#pragma unroll
                        for (int c = 0; c < 2; ++c) { const float e = __builtin_amdgcn_exp2f(fminf(S[c][i] + (bs[i] - mref[c]), 80.f)); S[c][i] = ok ? e : 0.f; }
                    }
                }
#pragma unroll
                for (int c = 0; c < 2; ++c) {
                    __builtin_amdgcn_sched_barrier(0);
                    if (!slow) {
#pragma unroll
                        for (int i = 0; i < 16; ++i) S[c][i] = __builtin_amdgcn_exp2f(S[c][i]); }
                    const float a0 = (S[c][0] + S[c][1]) + (S[c][2] + S[c][3]), a1 = (S[c][4] + S[c][5]) + (S[c][6] + S[c][7]);
                    const float a2 = (S[c][8] + S[c][9]) + (S[c][10] + S[c][11]), a3 = (S[c][12] + S[c][13]) + (S[c][14] + S[c][15]);
                    lsum[c] += (a0 + a1) + (a2 + a3);
                    bf16x8v pf[2]; pf[0] = pack_p(S[c], 0); pf[1] = pack_p(S[c], 1);
                    __builtin_amdgcn_sched_barrier(0);
#pragma unroll
                    for (int d = 0; d < 2; ++d)
#pragma unroll
                        for (int s = 0; s < 2; ++s) O[c][d] = __builtin_amdgcn_mfma_f32_32x32x16_bf16(vfr[d][s], pf[s], O[c][d], 0, 0, 0);
                }
            }
        }
        if (t + 2 < ntiles) {
#pragma unroll
            for (int j = 0; j < 2; ++j) { *(LAS u32x4*)(L + B_KS + (buf ^ 2) * KBUF + kdst + j * 64 * KS_PITCH) = kreg[j]; *(LAS u32x4*)(L + B_VS + (buf ^ 2) * VBUF + vdst + j * 64 * 64) = vreg[j]; } }
        if (t & 1) { if (STAGGER > 0 && wave < 4) __builtin_amdgcn_s_sleep(STAGGER); __syncthreads(); }
    }
    __builtin_amdgcn_s_setprio(0);
    if (wave_on) {
        const float l0 = hsum32(lsum[0], lane), l1 = hsum32(lsum[1], lane);
        const float i0 = 1.0f / l0, i1 = lam / l1;
        float o[2][16], ss = 0.f;
#pragma unroll
        for (int d = 0; d < 2; ++d)
#pragma unroll
            for (int i = 0; i < 16; ++i) { o[d][i] = O[0][d][i] * i0 - O[1][d][i] * i1; ss += o[d][i] * o[d][i]; }
        ss = hsum32(ss, lane);
        const float rstd = rsqrtf(ss * (1.0f / 64.0f) + 1e-6f) * oscale;
        const float* gn = F.diff_norm + l * 64;
        if (!meta_u || r < NMETA) {
            _Float16* dst = (_Float16*)(F.ws + WS_ABUF) + (size_t)my_row * DM + 512 + hh * 64;
#pragma unroll
            for (int d = 0; d < 2; ++d)
#pragma unroll
                for (int g4 = 0; g4 < 4; ++g4) { const int d0 = 32 * d + 8 * g4 + 4 * h; const f32x4 gv = *(const f32x4*)(gn + d0);
                    u32x2 w; w.x = cvt_pk_f16(o[d][4 * g4 + 0] * rstd * gv[0], o[d][4 * g4 + 1] * rstd * gv[1]); w.y = cvt_pk_f16(o[d][4 * g4 + 2] * rstd * gv[2], o[d][4 * g4 + 3] * rstd * gv[3]);
                    *(u32x2*)(dst + d0) = w; }
        }
    }
}
__device__ __forceinline__ void mixB_phase(const Frame& F, int l) {
    const float* lp = F.diff_lambda + l * 128;
    float a = (F.lane < 32) ? lp[F.lane] * lp[32 + F.lane] : 0.f, c = (F.lane < 32) ? lp[64 + F.lane] * lp[96 + F.lane] : 0.f;
    a = wave_sum(a, F.lane); c = wave_sum(c, F.lane);
    const float linit = 0.8f - 0.6f * expf(-0.3f * (float)l);
    const float lam = expf(a) - expf(c) + linit, oscale = 1.0f - linit;
#pragma unroll 1
    for (int cidx = F.bid; cidx < 256; cidx += F.G) { const int bh = cidx & 7, i = cidx >> 3;
#pragma unroll 1
        for (int k = 0; k < 3; ++k) { if (k == 2 && cidx >= 8) break; mixB_unit(F, l, bh >> 2, bh & 3, k == 0 ? 63 - i : (k == 1 ? i : -1), lam, oscale); }
    }
}
__device__ __forceinline__ h8 tr_frag_nat(LAS unsigned char* img_blk, int rowbase, int s, int lane) {
    const int h = lane >> 5, blk = (lane >> 4) & 1, i16 = lane & 15, q = i16 >> 2, p = i16 & 3;
    LAS unsigned char* a = img_blk + (rowbase + 16 * s + 8 * h + q) * 64 + (16 * blk + 4 * p) * 2;
    const s16x4 lo = __builtin_amdgcn_ds_read_tr16_b64_v4i16((LAS s16x4*)a);
    const s16x4 hi = __builtin_amdgcn_ds_read_tr16_b64_v4i16((LAS s16x4*)(a + 4 * 64));
    return __builtin_bit_cast(h8, __builtin_shufflevector(lo, hi, 0, 1, 2, 3, 4, 5, 6, 7));
}
__device__ __forceinline__ h8 tr_frag_krow(LAS unsigned char* img_blk, int rowbase, int s, int lane) {
    const int h = lane >> 5, blk = (lane >> 4) & 1, i16 = lane & 15, q = i16 >> 2, p = i16 & 3;
    LAS unsigned char* a = img_blk + (rowbase + 16 * s + 4 * h + q) * 64 + (16 * blk + 4 * p) * 2;
    const s16x4 lo = __builtin_amdgcn_ds_read_tr16_b64_v4i16((LAS s16x4*)a);
    const s16x4 hi = __builtin_amdgcn_ds_read_tr16_b64_v4i16((LAS s16x4*)(a + 8 * 64));
    return __builtin_bit_cast(h8, __builtin_shufflevector(lo, hi, 0, 1, 2, 3, 4, 5, 6, 7));
}
__device__ __forceinline__ float ret_log2gamma(int hc) { return log2f(1.0f - exp2f(-5.0f - (float)hc)); }
__device__ __forceinline__ h8 scale_h8(const h8& v, float sc) { h8 o;
#pragma unroll
    for (int e = 0; e < 8; ++e) o[e] = (_Float16)((float)v[e] * sc);
    return o; }

__device__ __forceinline__ void mixC1_unit(const Frame& F, int b, int hp, int c) {
    LAS unsigned char* L = F.lds + LDS_GEN;
    const int tid = F.tid, lane = F.lane, wave = F.wave;
    const unsigned char* proj = F.ws + WS_PROJ;
    const int row0 = c == 0 ? MR + b * NMETA : b * SEQ + 128 * (c - 1), Lc = c == 0 ? NMETA : 128;
    __syncthreads();
#pragma unroll 1
    for (int idx = tid; idx < 4096; idx += NTHREADS) {
        const int head = idx >> 11, arr = (idx >> 10) & 1, j = (idx >> 3) & 127, ch = idx & 7, hc = 2 * hp + head;
        h8 v;
#pragma unroll
        for (int e = 0; e < 8; ++e) v[e] = (_Float16)0.f;
        if (j < Lc) { v = *(const h8*)(proj + (arr ? PJ_VC : PJ_KC) + (size_t)(row0 + j) * 512 + hc * 128 + ch * 16);
            if (arr) v = scale_h8(v, exp2f((float)(Lc - 1 - j) * ret_log2gamma(hc))); }
        *(LAS h8*)(L + head * 32768 + arr * 16384 + (ch >> 2) * 8192 + j * 64 + (ch & 3) * 16) = v;
    }
    __syncthreads();
    const int head = wave >> 2, mb = (wave >> 1) & 1, nb = wave & 1, r = lane & 31, h = lane >> 5;
    f32x16 acc;
#pragma unroll
    for (int i = 0; i < 16; ++i) acc[i] = 0.f;
#pragma unroll
    for (int s = 0; s < 8; ++s) { const h8 a = tr_frag_nat(L + head * 32768 + mb * 8192, 0, s, lane), bb = tr_frag_nat(L + head * 32768 + 16384 + nb * 8192, 0, s, lane);
        acc = __builtin_amdgcn_mfma_f32_32x32x16_f16(a, bb, acc, 0, 0, 0); }
    float* U = (float*)(F.ws + WS_U) + ((size_t)((b * 4 + 2 * hp + head) * 129 + c)) * 4096;
#pragma unroll
    for (int i = 0; i < 16; ++i) U[(32 * mb + crow(i, h)) * 64 + 32 * nb + r] = acc[i];
}
__device__ __forceinline__ void mixC1_phase(const Frame& F) {
#pragma unroll 1
    for (int u = F.bid; u < NB * 2 * 129; u += F.G) { const int c = u % 129, bh = u / 129; mixC1_unit(F, bh >> 1, bh & 1, c); }
}
__device__ __forceinline__ void mixC_scan(const Frame& F) {
    if (F.tid >= 128) return;
    const int e = F.bid * 128 + F.tid;
    if (e >= NB * 4 * 4096) return;
    const int bh = e >> 12, el = e & 4095, hc = bh & 3;
    const float lg = ret_log2gamma(hc), g128 = exp2f(128.f * lg), g16 = exp2f(16.f * lg);
    const float* U = (const float*)(F.ws + WS_U) + (size_t)bh * 129 * 4096 + el; float* S = (float*)(F.ws + WS_S) + (size_t)bh * 129 * 4096 + el;
    float st = U[0];
    S[4096] = st;
#pragma unroll 1
    for (int c0 = 1; c0 < 128; c0 += 16) {
        float u[16];
#pragma unroll
        for (int k = 0; k < 16; ++k) u[k] = (c0 + k < 128) ? U[(size_t)(c0 + k) * 4096] : 0.f;
#pragma unroll
        for (int k = 0; k < 16; ++k) if (c0 + k < 128) { st = st * g128 + u[k]; S[(size_t)(c0 + k + 1) * 4096] = st; }
    }
    (void)g16;
}
constexpr int C2_KI = 0, C2_VI = 128 * KS_PITCH, C2_ST = C2_VI + 16384, C2_HEAD = C2_ST + 64 * KS_PITCH;
__device__ __forceinline__ void mixC2_unit(const Frame& F, int l, int b, int hp, int c) {
    LAS unsigned char* L = F.lds + LDS_GEN;
    const int tid = F.tid, lane = F.lane, wave = F.wave, r = lane & 31, h = lane >> 5;
    const unsigned char* proj = F.ws + WS_PROJ;
    const int row0 = c == 0 ? MR + b * NMETA : b * SEQ + 128 * (c - 1), Lc = c == 0 ? NMETA : 128;
    __syncthreads();
#pragma unroll 1
    for (int idx = tid; idx < 4096; idx += NTHREADS) {
        const int head = idx >> 11, arr = (idx >> 10) & 1, j = (idx >> 3) & 127, ch = idx & 7, hc = 2 * hp + head;
        h8 v;
#pragma unroll
        for (int e = 0; e < 8; ++e) v[e] = (_Float16)0.f;
        if (j < Lc) v = *(const h8*)(proj + (arr ? PJ_VC : PJ_KC) + (size_t)(row0 + j) * 512 + hc * 128 + ch * 16);
        if (arr) *(LAS h8*)(L + head * C2_HEAD + C2_VI + (ch >> 2) * 8192 + j * 64 + (ch & 3) * 16) = v;
        else     *(LAS h8*)(L + head * C2_HEAD + C2_KI + j * KS_PITCH + ch * 16) = v;
    }
    if (c > 0) {
#pragma unroll 1
        for (int idx = tid; idx < 2 * 4096; idx += NTHREADS) { const int head = idx >> 12, el = idx & 4095, dk = el >> 6, dv = el & 63;
            const float v = ((const float*)(F.ws + WS_S))[((size_t)((b * 4 + 2 * hp + head) * 129 + c)) * 4096 + el];
            *(LAS _Float16*)(L + head * C2_HEAD + C2_ST + dv * KS_PITCH + dk * 2) = (_Float16)v; }
    }
    __syncthreads();
    const int head = wave >> 2, wq = wave & 3, hc = 2 * hp + head;
    if (wq * 32 < Lc) {
        LAS unsigned char* Hb = L + head * C2_HEAD;
        const int qi = wq * 32 + r, my_row = row0 + qi;
        const float lg = ret_log2gamma(hc);
        h8 qf[4];
#pragma unroll
        for (int s = 0; s < 4; ++s) qf[s] = *(const h8*)(proj + PJ_QC + (size_t)my_row * 512 + hc * 128 + (16 * s + 8 * h) * 2);
        f32x16 O[2];
#pragma unroll
        for (int d = 0; d < 2; ++d)
#pragma unroll
            for (int i = 0; i < 16; ++i) O[d][i] = 0.f;
        if (c > 0) {
#pragma unroll
            for (int d = 0; d < 2; ++d)
#pragma unroll
                for (int s = 0; s < 4; ++s) { const h8 a = *(const LAS h8*)(Hb + C2_ST + (32 * d + r) * KS_PITCH + (16 * s + 8 * h) * 2);
                    O[d] = __builtin_amdgcn_mfma_f32_32x32x16_f16(a, qf[s], O[d], 0, 0, 0); }
            const float qd = exp2f((float)(qi + 1) * lg);
#pragma unroll
            for (int d = 0; d < 2; ++d)
#pragma unroll
                for (int i = 0; i < 16; ++i) O[d][i] *= qd;
        }
#pragma unroll 1
        for (int jb = 0; jb <= wq; ++jb) {
            f32x16 S;
#pragma unroll
            for (int i = 0; i < 16; ++i) S[i] = 0.f;
#pragma unroll
            for (int s = 0; s < 4; ++s) { const h8 kf = *(const LAS h8*)(Hb + C2_KI + (32 * jb + r) * KS_PITCH + (16 * s + 8 * h) * 2);
                S = __builtin_amdgcn_mfma_f32_32x32x16_f16(kf, qf[s], S, 0, 0, 0); }
#pragma unroll
            for (int i = 0; i < 16; ++i) { const int dd = qi - (32 * jb + crow(i, h)); S[i] = dd >= 0 ? S[i] * exp2f((float)dd * lg) : 0.f; }
            h8 pf[2];
#pragma unroll
            for (int s = 0; s < 2; ++s) { u32x4 p; p.x = cvt_pk_f16(S[8 * s + 0], S[8 * s + 1]); p.y = cvt_pk_f16(S[8 * s + 2], S[8 * s + 3]); p.z = cvt_pk_f16(S[8 * s + 4], S[8 * s + 5]); p.w = cvt_pk_f16(S[8 * s + 6], S[8 * s + 7]); pf[s] = __builtin_bit_cast(h8, p); }
#pragma unroll
            for (int d = 0; d < 2; ++d)
#pragma unroll
                for (int s = 0; s < 2; ++s) { const h8 vf = tr_frag_krow(Hb + C2_VI + d * 8192, 32 * jb, s, lane);
                    O[d] = __builtin_amdgcn_mfma_f32_32x32x16_f16(vf, pf[s], O[d], 0, 0, 0); }
        }
        float ss = 0.f;
#pragma unroll
        for (int d = 0; d < 2; ++d)
#pragma unroll
            for (int i = 0; i < 16; ++i) ss += O[d][i] * O[d][i];
        ss = hsum32(ss, lane);
        const float rstd = rsqrtf(ss * (1.0f / 64.0f) + 1e-6f);
        if (qi < Lc) {
            const float* gn = F.ret_norm + l * 256 + hc * 64;
            const _Float16* gc = (const _Float16*)(proj + PJ_GC) + (size_t)my_row * 256 + hc * 64;
            _Float16* dst = (_Float16*)(F.ws + WS_ABUF) + (size_t)my_row * DM + 768 + hc * 64;
#pragma unroll
            for (int d = 0; d < 2; ++d)
#pragma unroll
                for (int g4 = 0; g4 < 4; ++g4) { const int d0 = 32 * d + 8 * g4 + 4 * h; const f32x4 gv = *(const f32x4*)(gn + d0); const h4 gg = *(const h4*)(gc + d0);
                    float o[4];
#pragma unroll
                    for (int e = 0; e < 4; ++e) { const float g = (float)gg[e]; o[e] = O[d][4 * g4 + e] * rstd * gv[e] * (g / (1.0f + __expf(-g))); }
                    u32x2 w; w.x = cvt_pk_f16(o[0], o[1]); w.y = cvt_pk_f16(o[2], o[3]); *(u32x2*)(dst + d0) = w; }
        }
    }
}
__device__ __forceinline__ void mixC2_phase(const Frame& F, int l) {
#pragma unroll 1
    for (int u = F.bid; u < NB * 2 * 129; u += F.G) { const int c = u % 129, bh = u / 129; mixC2_unit(F, l, bh >> 1, bh & 1, c); }
}
constexpr int IDX_HIST = 0, IDX_STATS = 16512, IDX_INFO = 18816, IDX_CCNT = 19072, IDX_MASK = 19456, IDX_CAND = 85248, IDX_Q = IDX_CAND + 32 * 128 * 8, IDX_QPITCH = 1168, IDX_END = IDX_Q + 32 * IDX_QPITCH;
#ifndef PROBE_REP
#define PROBE_REP 0
#endif
#if PROBE_REP >= 40
#define PTS(v) do { __builtin_amdgcn_sched_barrier(0); v = (unsigned)__builtin_amdgcn_s_memtime(); __builtin_amdgcn_sched_barrier(0); } while (0)
#else
#define PTS(v) do {} while (0)
#endif
#if PROBE_REP >= 40 && PROBE_REP < 60
#define IPTS(v) PTS(v)
#else
#define IPTS(v) do {} while (0)
#endif
constexpr int IDX_CAP = 128, IDX_NBIN = 128, NSUB = 3;
static_assert(IDX_END + LDS_GEN <= LDS_BYTES, "indexer LDS");
struct KFrag { h8 v[4]; };
__device__ __forceinline__ KFrag idx_load_k(const unsigned char* krow_ptr, int h) { KFrag k;
#pragma unroll
    for (int s = 0; s < 4; ++s) k.v[s] = *(const h8*)(krow_ptr + (16 * s + 8 * h) * 2);
    return k; }
#define IDX_LOADQ(dst, hd) do { _Pragma("unroll") for (int s_ = 0; s_ < 4; ++s_) dst[s_] = *(const LAS h8*)(qimg_lane + ((hd) * 64 + 16 * s_) * 2); } while (0)
#define IDX_MFMA4(acc, q) do { _Pragma("unroll") for (int s_ = 0; s_ < 4; ++s_) acc = __builtin_amdgcn_mfma_f32_32x32x16_f16(kf.v[s_], q[s_], acc, 0, 0, 0); } while (0)
#define IDX_FMA(hd, S) do { _Pragma("unroll") for (int i_ = 0; i_ < 16; ++i_) sc[i_] = __builtin_fmaf(w[hd], __builtin_fabsf(S[i_]), sc[i_]); } while (0)
#define IDX_SB __builtin_amdgcn_sched_barrier(0)
__device__ __forceinline__ void idx_scores(const LAS unsigned char* qimg_lane, const float (&w)[8], const KFrag& kf, f32x16& sc) {
    h8 q[2][4]; f32x16 S[2];
    IDX_LOADQ(q[0], 8); IDX_SB;
#pragma unroll
    for (int i = 0; i < 16; ++i) sc[i] = 0.f;
    IDX_MFMA4(sc, q[0]); IDX_LOADQ(q[1], 0); IDX_SB;
#pragma unroll
    for (int hd = 0; hd < 8; ++hd) {
#pragma unroll
        for (int i = 0; i < 16; ++i) S[hd & 1][i] = 0.f;
        IDX_MFMA4(S[hd & 1], q[(hd + 1) & 1]);
        if (hd < 7) IDX_LOADQ(q[hd & 1], hd + 1);
        if (hd > 0) IDX_FMA(hd - 1, S[(hd - 1) & 1]);
        IDX_SB;
    }
    IDX_FMA(7, S[1]);
}
#define IDX_PIN(V) asm volatile("" : "+v"(V[0]), "+v"(V[1]), "+v"(V[2]), "+v"(V[3]), "+v"(V[4]), "+v"(V[5]), "+v"(V[6]), "+v"(V[7]), "+v"(V[8]), "+v"(V[9]), "+v"(V[10]), "+v"(V[11]), "+v"(V[12]), "+v"(V[13]), "+v"(V[14]), "+v"(V[15]))
#define IDX_MFMA4K(acc, q, KF) do { _Pragma("unroll") for (int s_ = 0; s_ < 4; ++s_) acc = __builtin_amdgcn_mfma_f32_32x32x16_f16(KF.v[s_], q[s_], acc, 0, 0, 0); } while (0)
#define IDX_FMA2(SC, hd, S) do { _Pragma("unroll") for (int i_ = 0; i_ < 16; ++i_) SC[i_] = __builtin_fmaf(w[hd], __builtin_fabsf(S[i_]), SC[i_]); } while (0)
__device__ __forceinline__ void idx_scores2(const LAS unsigned char* qimg_lane, const float (&w)[8], const KFrag& kfA, const KFrag& kfB, f32x16& scA, f32x16& scB) {
    h8 q[2][4]; f32x16 SA, SB;
    IDX_LOADQ(q[0], 8); IDX_SB;
#pragma unroll
    for (int i = 0; i < 16; ++i) { scA[i] = 0.f; scB[i] = 0.f; }
    IDX_MFMA4K(scA, q[0], kfA); IDX_MFMA4K(scB, q[0], kfB); IDX_LOADQ(q[1], 0); IDX_SB;
#pragma unroll
    for (int hd = 0; hd < 8; ++hd) {
#pragma unroll
        for (int i = 0; i < 16; ++i) SA[i] = 0.f;
        IDX_MFMA4K(SA, q[(hd + 1) & 1], kfA);
        if (hd > 0) { IDX_FMA2(scB, hd - 1, SB); IDX_PIN(scB); }
        IDX_SB;
#pragma unroll
        for (int i = 0; i < 16; ++i) SB[i] = 0.f;
        IDX_MFMA4K(SB, q[(hd + 1) & 1], kfB);
        if (hd < 7) IDX_LOADQ(q[hd & 1], hd + 1);
        IDX_FMA2(scA, hd, SA); IDX_PIN(scA);
        IDX_SB;
    }
    IDX_FMA2(scB, 7, SB);
}
template <int NS> __device__ __forceinline__ void idx_scoresN(const LAS unsigned char* qimg_lane, const float (&w)[8], KFrag (&kf)[NS], const unsigned char* const (&nextp)[NS], int h, f32x16 (&sc)[NS]) {
    h8 q[2][4]; f32x16 S[NS];
#if PROBE_REP == 30
    h8 zk = {0, 0, 0, 0, 0, 0, 0, 0}; asm volatile("" : "+v"(zk));
#endif
#if PROBE_REP == 31
    float wz = 0.f; asm volatile("" : "+v"(wz));
#define IDX_FMAZ(SC, S) do { _Pragma("unroll") for (int i_ = 0; i_ < 16; ++i_) SC[i_] = __builtin_fmaf(wz, __builtin_fabsf(S[i_]), SC[i_]); } while (0)
#else
#define IDX_FMAZ(SC, S) do {} while (0)
#endif
    IDX_LOADQ(q[0], 8); IDX_SB;
#pragma unroll
    for (int t = 0; t < NS; ++t) {
#pragma unroll
        for (int i = 0; i < 16; ++i) sc[t][i] = 0.f;
        IDX_MFMA4K(sc[t], q[0], kf[t]); }
    IDX_LOADQ(q[1], 0); IDX_SB;
#pragma unroll
    for (int hd = 0; hd < 8; ++hd) {
#pragma unroll
        for (int t = 0; t < NS; ++t) {
#pragma unroll
            for (int i = 0; i < 16; ++i) S[t][i] = 0.f;
            IDX_MFMA4K(S[t], q[(hd + 1) & 1], kf[t]);
#if PROBE_REP == 30
#pragma unroll
            for (int s_ = 0; s_ < 4; ++s_) S[t] = __builtin_amdgcn_mfma_f32_32x32x16_f16(zk, q[(hd + 1) & 1][s_], S[t], 0, 0, 0);
#endif
            if (t == 0 && hd < 7) IDX_LOADQ(q[hd & 1], hd + 1);
            if (hd == 7) kf[t] = idx_load_k(nextp[t], h);
            if (t > 0) { IDX_FMA2(sc[t - 1], hd, S[t - 1]); IDX_FMAZ(sc[t - 1], S[t - 1]); IDX_PIN(sc[t - 1]); }
            else if (hd > 0) { IDX_FMA2(sc[NS - 1], hd - 1, S[NS - 1]); IDX_FMAZ(sc[NS - 1], S[NS - 1]); IDX_PIN(sc[NS - 1]); }
            IDX_SB;
        }
    }
    IDX_FMA2(sc[NS - 1], 7, S[NS - 1]);
}
__device__ __forceinline__ int f_ord(float v) { const int i = __float_as_int(v); return i >= 0 ? i : (int)(0x80000000u - (unsigned)i); }
__device__ __forceinline__ float f_unord(int o) { return __int_as_float(o >= 0 ? o : (int)(0x80000000u - (unsigned)o)); }
__device__ __forceinline__ float idx_raw_edge(float B, float inv, float c0f) {
    if (!(B > -3.0e38f)) return -__builtin_inff();
    if (!(B < 3.0e38f)) return __builtin_inff();
    int lo = f_ord(-3.0e38f), hi = f_ord(3.0e38f);
#pragma unroll 1
    for (int it = 0; it < 34; ++it) { const int mid = lo + (int)(((unsigned)hi - (unsigned)lo) >> 1); if (__builtin_fmaf(f_unord(mid), inv, c0f) >= B) hi = mid; else lo = mid; }
    return f_unord(hi);
}
#define IDX_ACCBIT(m, s, t) asm("v_cmp_ge_f32 vcc, %1, %2\n\tv_addc_co_u32 %0, vcc, %0, %0, vcc" : "+v"(m) : "v"(s), "v"(t) : "vcc")
__device__ __forceinline__ int suffix_sum(int v, int lane) {
#pragma unroll
    for (int off = 1; off < 64; off <<= 1) { const int t = __builtin_amdgcn_ds_bpermute((lane + off) << 2, v); if (lane + off < 64) v += t; }
    return v;
}
__device__ __forceinline__ void mixA_index_unit(const Frame& F, int b, int g) {
    LAS unsigned char* L = F.lds + LDS_GEN;
    int lane_; { unsigned z0_ = 0u; asm volatile("" : "+s"(z0_)); lane_ = (int)__builtin_amdgcn_mbcnt_hi(~0u, __builtin_amdgcn_mbcnt_lo(~0u, z0_)); asm volatile("" : "+v"(lane_)); }
    int tid_ = F.wave * 64 + lane_; asm volatile("" : "+v"(tid_));
    const int tid = tid_, lane = lane_, wave = F.wave, r = lane & 31, h = lane >> 5;
    const unsigned char* proj = F.ws + WS_PROJ;
    const unsigned char* KI = proj + PJ_KI;
    const int nq = g == 0 ? NMETA : 32;
    const int qrow = g == 0 ? MR + b * NMETA + (r & 15) : b * SEQ + 32 * (g - 1) + r;
    const int tq0 = g == 0 ? 0 : NMETA + 32 * (g - 1);
    const bool qvalid = r < nq;
    auto ks_row0 = [&](int ks) -> int { return ks == 0 ? MR + b * NMETA : b * SEQ + 32 * (ks - 1); };
#if PROBE_REP >= 40 && PROBE_REP < 60
    unsigned accS = 0, accP = 0, accP2 = 0, accNC = 0, accNR = 0, tU0, tx0, tx1, tx2, tx3, tx4, tx5, tx6; IPTS(tU0);
#else
    unsigned tx0, tx1, tx2, tx3, tx4, tx5, tx6;
#endif
    __syncthreads();
    for (int i = tid; i < 32 * 129; i += NTHREADS) ((LAS unsigned*)(L + IDX_HIST))[i] = 0u;
    if (tid < 32) ((LAS unsigned*)(L + IDX_CCNT))[tid] = 0u;
    for (int i = tid; i < (g + 1) * 32; i += NTHREADS) ((LAS unsigned*)(L + IDX_MASK))[i] = 0u;
    auto krow = [&](int ks) -> const unsigned char* { return KI + (size_t)(ks_row0(ks <= g ? ks : g) + r) * 128; };
    const KFrag kf0 = idx_load_k(KI + (size_t)(b * SEQ + 32 * (wave & 3) + r) * 128, h);
    KFrag kf[NSUB];
#pragma unroll
    for (int u = 0; u < NSUB; ++u) kf[u] = idx_load_k(krow(NSUB * wave + u), h);
    float w[8];
    const LAS unsigned char* qf = L + IDX_Q + r * IDX_QPITCH + 8 * h * 2;
    { const float* WI = (const float*)(proj + PJ_WI) + (size_t)qrow * 8; const f32x4 w0 = *(const f32x4*)WI, w1 = *(const f32x4*)(WI + 4);
      w[0] = w0[0]; w[1] = w0[1]; w[2] = w0[2]; w[3] = w0[3]; w[4] = w1[0]; w[5] = w1[1]; w[6] = w1[2]; w[7] = w1[3]; }
    { const int qq = tid >> 4, dc = tid & 15; const int qr = g == 0 ? MR + b * NMETA + (qq & 15) : b * SEQ + 32 * (g - 1) + qq;
      const unsigned char* qsrc = proj + PJ_QI + (size_t)qr * 1024 + dc * 8; u32x2 qv[8];
#pragma unroll
      for (int hd = 0; hd < 8; ++hd) qv[hd] = *(const u32x2*)(qsrc + hd * 128);
      const float* WQ = (const float*)(proj + PJ_WI) + (size_t)qr * 8; const f32x4 wa = *(const f32x4*)WQ, wb = *(const f32x4*)(WQ + 4);
      const float wq[8] = {wa[0], wa[1], wa[2], wa[3], wb[0], wb[1], wb[2], wb[3]};
      float a4[4] = {0.f, 0.f, 0.f, 0.f};
#pragma unroll
      for (int hd = 0; hd < 8; ++hd) { const h4 q = __builtin_bit_cast(h4, qv[hd]);
#pragma unroll
          for (int e = 0; e < 4; ++e) a4[e] += wq[hd] * (float)q[e];
          *(LAS u32x2*)(L + IDX_Q + qq * IDX_QPITCH + hd * 128 + dc * 8) = qv[hd]; }
      u32x2 o; o.x = cvt_pk_f16(a4[0], a4[1]); o.y = cvt_pk_f16(a4[2], a4[3]);
      *(LAS u32x2*)(L + IDX_Q + qq * IDX_QPITCH + 1024 + dc * 8) = o; }
    __syncthreads();
    if (wave < 4) {
        f32x16 sc; idx_scores(qf, w, kf0, sc);
        float s1 = 0.f, s2 = 0.f;
#pragma unroll
        for (int i = 0; i < 16; ++i) { s1 += sc[i]; s2 += sc[i] * sc[i]; }
        s1 = hsum32(s1, lane); s2 = hsum32(s2, lane);
        if (h == 0) { ((LAS float*)(L + IDX_STATS))[(wave * 32 + r) * 2] = s1; ((LAS float*)(L + IDX_STATS))[(wave * 32 + r) * 2 + 1] = s2; }
    }
    __syncthreads();
    float c0f, inv;
    { float s1 = 0.f, s2 = 0.f;
#pragma unroll
      for (int k = 0; k < 4; ++k) { s1 += ((LAS float*)(L + IDX_STATS))[(k * 32 + r) * 2]; s2 += ((LAS float*)(L + IDX_STATS))[(k * 32 + r) * 2 + 1]; }
      const float mean = s1 * (1.0f / 128.0f), var = fmaxf(s2 * (1.0f / 128.0f) - mean * mean, 0.f), sd = fmaxf(sqrtf(var), 1e-12f);
      inv = (float)IDX_NBIN / (10.0f * sd); c0f = -(mean - 3.0f * sd) * inv; }
    LAS unsigned* hrow = (LAS unsigned*)(L + IDX_HIST) + r * 129;
    IPTS(tx0);
#if PROBE_REP == 12
    for (int rep12 = 0; rep12 < 2; ++rep12) { __syncthreads(); for (int i = tid; i < 32 * 129; i += NTHREADS) ((LAS unsigned*)(L + IDX_HIST))[i] = 0u; __syncthreads();
#else
    {
#endif
#pragma unroll 1
        for (int ks = NSUB * wave; ks <= g; ks += 8 * NSUB) {
            const unsigned char* nextp[NSUB];
#pragma unroll
            for (int u = 0; u < NSUB; ++u) nextp[u] = krow((ks + 8 * NSUB <= g ? ks + 8 * NSUB : NSUB * wave) + u);
#if PROBE_REP >= 40 && PROBE_REP < 60
            unsigned tb, tc, td; IPTS(tb);
#endif
            f32x16 scv[NSUB]; idx_scoresN<NSUB>(qf, w, kf, nextp, h, scv);
#if PROBE_REP >= 40 && PROBE_REP < 60
            IDX_PIN(scv[NSUB - 1]); IPTS(tc); accS += tc - tb;
#endif
#pragma unroll
            for (int u2 = 0; u2 < NSUB; ++u2) {
                const int kss = ks + u2; if (kss > g) continue;
                if (kss == 0 || kss == g) {
#pragma unroll
                    for (int i = 0; i < 16; ++i) {
                        const int kidx = crow(i, h);
                        const bool ok = qvalid && (kss == 0 ? kidx < NMETA && (g > 0 || kidx <= r) : kidx <= r);
                        if (ok) { const unsigned bin = (unsigned)__builtin_amdgcn_fmed3f(__builtin_fmaf(scv[u2][i], inv, c0f), 0.f, (float)(IDX_NBIN - 1)); __hip_atomic_fetch_add(hrow + bin, 1u, __ATOMIC_RELAXED, __HIP_MEMORY_SCOPE_WORKGROUP); }
                    }
                } else {
#pragma unroll
                    for (int i = 0; i < 16; ++i) { const unsigned bin = (unsigned)__builtin_amdgcn_fmed3f(__builtin_fmaf(scv[u2][i], inv, c0f), 0.f, (float)(IDX_NBIN - 1)); __hip_atomic_fetch_add(hrow + bin, 1u, __ATOMIC_RELAXED, __HIP_MEMORY_SCOPE_WORKGROUP); }
                }
            }
#if PROBE_REP >= 40 && PROBE_REP < 60
            IPTS(td); accP += td - tc;
#endif
        }
    }
    IPTS(tx1);
    __syncthreads();
    IPTS(tx2);
#pragma unroll 1
    for (int k = 0; k < 4; ++k) {
        const int row = 4 * wave + k;
        const int c0 = (int)((LAS unsigned*)(L + IDX_HIST))[row * 129 + 2 * lane], c1 = (int)((LAS unsigned*)(L + IDX_HIST))[row * 129 + 2 * lane + 1];
        const int SL = suffix_sum(c0 + c1, lane), NT = __builtin_amdgcn_readlane(SL, 0);
        int bstar = -1, need = 0;
        if (NT > 256) {
            const unsigned long long ml = __ballot(SL >= 256); const int lL = 63 - __builtin_clzll(ml); const int sl = __builtin_amdgcn_readlane(SL, lL), t0 = __builtin_amdgcn_readlane(c0, lL), t1 = __builtin_amdgcn_readlane(c1, lL); const int above = sl - t0 - t1;
            if (above + t1 >= 256) { bstar = 2 * lL + 1; need = 256 - above; } else { bstar = 2 * lL; need = 256 - above - t1; }
        }
        if (lane == 0) { ((LAS int*)(L + IDX_INFO))[row * 2] = bstar; ((LAS int*)(L + IDX_INFO))[row * 2 + 1] = need; }
    }
    __syncthreads();
    float lo_f, hi_f;
    { const int bstar = ((LAS int*)(L + IDX_INFO))[r * 2];
      hi_f = bstar < 0 ? -__builtin_inff() : (bstar >= IDX_NBIN - 1 ? __builtin_inff() : (float)(bstar + 1));
      lo_f = bstar <= 0 ? -__builtin_inff() : (float)bstar; }
    const float hi_raw = idx_raw_edge(hi_f, inv, c0f), lo_raw = idx_raw_edge(lo_f, inv, c0f);
    const float lo_base = fmaxf(lo_f, 0.f);
    auto append = [&](float sv, int kb, int ci) {
        const unsigned slot = __hip_atomic_fetch_add((LAS unsigned*)(L + IDX_CCNT) + r, 1u, __ATOMIC_RELAXED, __HIP_MEMORY_SCOPE_WORKGROUP);
        if (slot < IDX_CAP) { const float fr = (__builtin_fmaf(sv, inv, c0f) - lo_base) * 131072.0f; const unsigned q = (unsigned)__builtin_amdgcn_fmed3f(fr, 0.f, 131071.0f);
            asm volatile("" : "+v"(kb));
            ((LAS unsigned*)(L + IDX_CAND))[r * IDX_CAP + slot] = (q << 15) | (unsigned)(kb - ci); } };
    {
#pragma unroll 1
        for (int ks = NSUB * wave; ks <= g; ks += 8 * NSUB) {
            const unsigned char* nextp[NSUB];
#pragma unroll
            for (int u = 0; u < NSUB; ++u) nextp[u] = krow((ks + 8 * NSUB <= g ? ks + 8 * NSUB : NSUB * wave) + u);
#if PROBE_REP >= 40 && PROBE_REP < 60
            unsigned tb, tc, td; IPTS(tb);
#endif
            f32x16 scv[NSUB]; idx_scoresN<NSUB>(qf, w, kf, nextp, h, scv);
#if PROBE_REP >= 40 && PROBE_REP < 60
            IDX_PIN(scv[NSUB - 1]); IPTS(tc); accS += tc - tb;
#endif
#pragma unroll
            for (int u2 = 0; u2 < NSUB; ++u2) {
                const int kss = ks + u2; if (kss > g) continue;
                unsigned part = 0u;
                if (kss == 0 || kss == g) {
#pragma unroll
                    for (int i = 0; i < 16; ++i) {
                        const int kidx = crow(i, h);
                        const bool ok = qvalid && (kss == 0 ? kidx < NMETA && (g > 0 || kidx <= r) : kidx <= r);
                        const bool ghi = scv[u2][i] >= hi_raw, glo = scv[u2][i] >= lo_raw;
                        part |= (ok && ghi) ? (1u << kidx) : 0u;
                        if (ok && glo && !ghi) append(scv[u2][i], 32767 - kss * 32 - 4 * h, (i & 3) + 8 * (i >> 2));
                    }
                } else {
                    unsigned mhi = 0u, mlo = 0u;
#pragma unroll
                    for (int i = 15; i >= 0; --i) { IDX_ACCBIT(mhi, scv[u2][i], hi_raw); IDX_ACCBIT(mlo, scv[u2][i], lo_raw); }
                    part = ((mhi & 0xFu) | ((mhi & 0xF0u) << 4) | ((mhi & 0xF00u) << 8) | ((mhi & 0xF000u) << 12)) << (4 * h);
                    const unsigned cm = mlo & ~mhi;
                    if (__ballot(cm != 0u) != 0ull) {
#pragma unroll
                        for (int i = 0; i < 16; ++i) if (cm & (1u << i)) append(scv[u2][i], 32767 - kss * 32 - 4 * h, (i & 3) + 8 * (i >> 2));
                    }
                }
                __hip_atomic_fetch_or((LAS unsigned*)(L + IDX_MASK) + kss * 32 + r, part, __ATOMIC_RELAXED, __HIP_MEMORY_SCOPE_WORKGROUP);
            }
#if PROBE_REP >= 40 && PROBE_REP < 60
            IPTS(td); accP2 += td - tc;
#endif
        }
    }
    IPTS(tx3);
    __syncthreads();
    IPTS(tx4);
#pragma unroll 1
    for (int k = 0; k < 4; ++k) {
        const int row = 4 * wave + k;
        const int need = ((LAS int*)(L + IDX_INFO))[row * 2 + 1];
        int nc = (int)((LAS unsigned*)(L + IDX_CCNT))[row]; nc = nc < IDX_CAP ? nc : IDX_CAP;
        nc = __builtin_amdgcn_readfirstlane(nc);
#if PROBE_REP == 48
        accNC += (unsigned)nc; accNR += 128u;
#endif
        if (nc == 0) continue;
        const LAS unsigned* cb = (const LAS unsigned*)(L + IDX_CAND) + row * IDX_CAP;
        const bool v0 = lane < nc, v1 = lane + 64 < nc;
        const unsigned c0 = v0 ? cb[lane] : 0u, c1 = v1 ? cb[lane + 64] : 0u;
        int r0 = 0, r1 = 0;
        if (__builtin_amdgcn_readfirstlane(need) < nc) {
            const int n0 = nc < 64 ? nc : 64;
#pragma unroll 1
            for (int j = 0; j < n0; ++j) { const unsigned cj = (unsigned)__builtin_amdgcn_readlane((int)c0, j); r0 += cj > c0 ? 1 : 0; r1 += cj > c1 ? 1 : 0; }
#pragma unroll 1
            for (int j = 64; j < nc; ++j) { const unsigned cj = (unsigned)__builtin_amdgcn_readlane((int)c1, j - 64); r0 += cj > c0 ? 1 : 0; r1 += cj > c1 ? 1 : 0; }
        }
        const int k0 = 32767 - (int)(c0 & 32767u), k1 = 32767 - (int)(c1 & 32767u);
        if (v0 && r0 < need) __hip_atomic_fetch_or((LAS unsigned*)(L + IDX_MASK) + (k0 >> 5) * 32 + row, 1u << (k0 & 31), __ATOMIC_RELAXED, __HIP_MEMORY_SCOPE_WORKGROUP);
        if (v1 && r1 < need) __hip_atomic_fetch_or((LAS unsigned*)(L + IDX_MASK) + (k1 >> 5) * 32 + row, 1u << (k1 & 31), __ATOMIC_RELAXED, __HIP_MEMORY_SCOPE_WORKGROUP);
    }
    IPTS(tx5);
    __syncthreads();
    IPTS(tx6);
    unsigned* MK = (unsigned*)(F.ws + WS_MASK) + (size_t)b * NKS * TLEN;
    for (int i = tid; i < (g + 1) * 32; i += NTHREADS) { const int ks = i >> 5, rr = i & 31; if (rr < nq) MK[(size_t)ks * TLEN + tq0 + rr] = ((LAS unsigned*)(L + IDX_MASK))[i]; }
#if PROBE_REP >= 40 && PROBE_REP < 60
    { unsigned tU1; IPTS(tU1); if (lane == 0) { unsigned long long* pc = (unsigned long long*)(F.ws + WS_CTL) + 4096;
        const unsigned vals[12] = {tx0 - tU0, accS, accP, tU1 - tU0, accP2, tx2 - tx1, tx4 - tx3, tU1 - tx4, accNC, tx5 - tx4, tx6 - tx5, tU1 - tx6};
        atomicAdd(pc + (PROBE_REP - 40), (unsigned long long)vals[PROBE_REP - 40]); atomicAdd(pc + 3, (unsigned long long)(PROBE_REP == 48 ? accNR : tU1 - tU0)); } }
#endif
}
__device__ __forceinline__ void mixA_index_phase(const Frame& F) {
#pragma unroll 1
    for (int c = F.bid; c < 256; c += F.G) {
#pragma unroll 1
        for (int k = 0; k < 5; ++k) {
            int u; if (k == 0) u = c; else if (k == 1) u = 511 - c; else if (k == 2) u = 512 + c; else if (k == 3) u = 1023 - c; else { if (c >= 2) break; u = 1024 + c; }
            mixA_index_unit(F, u & 1, 512 - (u >> 1));
        }
    }
}

__device__ __forceinline__ void mixA3_unit(const Frame& F, int l, int b, int ha, int qblk) {
    LAS unsigned char* L = F.lds + LDS_GEN;
    int lane_; { unsigned z0_ = 0u; asm volatile("" : "+s"(z0_)); lane_ = (int)__builtin_amdgcn_mbcnt_hi(~0u, __builtin_amdgcn_mbcnt_lo(~0u, z0_)); asm volatile("" : "+v"(lane_)); }
    const int lane = lane_, wave = F.wave, tid = wave * 64 + lane, r = lane & 31, h = lane >> 5;
    const unsigned char* proj = F.ws + WS_PROJ;
    const _Float16* QA = (const _Float16*)(proj + PJ_QA); const unsigned char* KA = proj + PJ_KA; const unsigned char* VA = proj + PJ_VA;
    const unsigned* kmax = (const unsigned*)(F.ws + WS_CTL) + CW_KMAX + 32 * l;
    const unsigned* MK = (const unsigned*)(F.ws + WS_MASK) + (size_t)b * NKS * TLEN;
    const bool meta_u = qblk < 0;
    const int qrow0 = meta_u ? MR + b * NMETA : b * SEQ + qblk * 256;
    const int qpos0 = meta_u ? 0 : NMETA + qblk * 256;
    const int nreal = meta_u ? 0 : 2 * qblk + 2;
    const int wq0 = 32 * wave;
    const bool wave_on = meta_u ? (wave == 0) : true;
    const int my_row = wave_on ? qrow0 + wq0 + r : qrow0, my_pos = wave_on ? qpos0 + wq0 + r : 0;
    __syncthreads();
    if (tid < 128) ((LAS float*)(L + B_LUT))[tid] = F.rel_bias[BUCKET_LUT[tid] * 12 + ha] * LOG2E;
    float bmax = (lane < 32) ? F.rel_bias[lane * 12 + ha] * LOG2E : -1e30f;
    bmax = fmaxf(bmax, sx<16>(bmax, lane)); bmax = fmaxf(bmax, sx<8>(bmax, lane)); bmax = fmaxf(bmax, sx<4>(bmax, lane)); bmax = fmaxf(bmax, sx<2>(bmax, lane)); bmax = fmaxf(bmax, sx<1>(bmax, lane));
    bmax = bcast0(bmax);
    const float bfar = F.rel_bias[31 * 12 + ha] * LOG2E;
    h8 qf[4]; float mref; bool safe;
    { float n2 = 0.f;
#pragma unroll
      for (int s = 0; s < 4; ++s) { qf[s] = *(const h8*)(QA + (size_t)my_row * 512 + ha * 64 + 16 * s + 8 * h);
#pragma unroll
          for (int j = 0; j < 8; ++j) { const float v = (float)qf[s][j]; n2 += v * v; } }
      n2 = hsum32(n2, lane);
      mref = sqrtf(n2 * (__uint_as_float(kmax[ha * 2]) + __uint_as_float(kmax[ha * 2 + 1]))) * 1.002f + bmax;
      safe = __all(mref - bfar < 60.0f); if (safe) mref = bfar; }
    f32x16 O[2], Lacc;
#if PROBE_REP >= 60 && PROBE_REP < 70
    unsigned a3C = 0, a3S = 0, a3W = 0, a3t0, a3t1, a3t2, a3t3, a3U0; PTS(a3U0);
#endif
#pragma unroll
    for (int i = 0; i < 16; ++i) { O[0][i] = 0.f; O[1][i] = 0.f; Lacc[i] = 0.f; }
    bf16x8v ones; { const u32x4 o = {0x3F803F80u, 0x3F803F80u, 0x3F803F80u, 0x3F803F80u}; ones = __builtin_bit_cast(bf16x8v, o); }
    const int skey = tid >> 3, sch = tid & 7;
    const unsigned kdst = skey * KS_PITCH + sch * 16, vdst = (sch >> 2) * (TK * 64) + skey * 64 + (sch & 3) * 16;
    const int ntiles = 1 + nreal;
    auto tile_row0 = [&](int t) -> int { return t == 0 ? MR + b * NMETA : b * SEQ + (t - 1) * TK; };
    u32x4 kreg[2], vreg[2];
#pragma unroll
    for (int j = 0; j < 2; ++j) { const size_t rr = (size_t)(tile_row0(0) + skey + 64 * j); kreg[j] = *(const u32x4*)(KA + rr * 1024 + ha * 128 + sch * 16); vreg[j] = *(const u32x4*)(VA + rr * 1024 + ha * 128 + sch * 16); }
#pragma unroll
    for (int j = 0; j < 2; ++j) { *(LAS u32x4*)(L + B_KS + kdst + j * 64 * KS_PITCH) = kreg[j]; *(LAS u32x4*)(L + B_VS + vdst + j * 64 * 64) = vreg[j]; }
    if (ntiles > 1) {
#pragma unroll
        for (int j = 0; j < 2; ++j) { const size_t rr = (size_t)(tile_row0(1) + skey + 64 * j); kreg[j] = *(const u32x4*)(KA + rr * 1024 + ha * 128 + sch * 16); vreg[j] = *(const u32x4*)(VA + rr * 1024 + ha * 128 + sch * 16); }
#pragma unroll
        for (int j = 0; j < 2; ++j) { *(LAS u32x4*)(L + B_KS + KBUF + kdst + j * 64 * KS_PITCH) = kreg[j]; *(LAS u32x4*)(L + B_VS + VBUF + vdst + j * 64 * 64) = vreg[j]; }
    }
    __syncthreads();
    unsigned mw[4], mwn[4] = {0u, 0u, 0u, 0u};
    mw[0] = MK[my_pos]; mw[1] = 0u; mw[2] = 0u; mw[3] = 0u;
    const int wpos0 = qpos0 + wq0;
    if (wave >= 4) __builtin_amdgcn_s_setprio(1);
#pragma unroll 1
    for (int t = 0; t < ntiles; ++t) {
        const int buf = t & 3;
        if (STAGGER > 0 && wave >= 4 && (t & 1) == 0) __builtin_amdgcn_s_sleep(STAGGER);
        if (t + 2 < ntiles) {
#pragma unroll
            for (int j = 0; j < 2; ++j) { const size_t rr = (size_t)(tile_row0(t + 2) + skey + 64 * j); kreg[j] = *(const u32x4*)(KA + rr * 1024 + ha * 128 + sch * 16); vreg[j] = *(const u32x4*)(VA + rr * 1024 + ha * 128 + sch * 16); } }
        if (t + 1 < ntiles) {
#pragma unroll
            for (int j = 0; j < 4; ++j) mwn[j] = MK[(size_t)(1 + 4 * t + j) * TLEN + my_pos]; }
        const int kpos0 = (t == 0) ? 0 : NMETA + (t - 1) * TK, nvalid = (t == 0) ? NMETA : TK;
#if PROBE_REP >= 60 && PROBE_REP < 70
        PTS(a3t0);
#endif
        if (wave_on && kpos0 <= wpos0 + 31) {
            LAS unsigned char* Kb = L + B_KS + buf * KBUF; LAS unsigned char* Vb = L + B_VS + buf * VBUF;
#pragma unroll
            for (int sub = 0; sub < 4; ++sub) {
                if (sub * 32 >= nvalid || kpos0 + sub * 32 > wpos0 + 31) continue;
                const bool slow = !safe || (t == 0) || (kpos0 + sub * 32 + 31 > wpos0 - 128);
                const unsigned mword = mw[sub] >> (4 * h);
                f32x16 S;
                h8 kfr[4]; bf16x8v vfr[2][2];
#pragma unroll
                for (int s = 0; s < 4; ++s) kfr[s] = *(const LAS h8*)(Kb + (sub * 32 + r) * KS_PITCH + (16 * s + 8 * h) * 2);
#pragma unroll
                for (int d = 0; d < 2; ++d)
#pragma unroll
                    for (int s = 0; s < 2; ++s) vfr[d][s] = vt_frag(Vb, d, sub * 32, s, lane);
                __builtin_amdgcn_sched_barrier(0);
#pragma unroll
                for (int i = 0; i < 16; ++i) S[i] = 0.f;
#pragma unroll
                for (int s = 0; s < 4; ++s) S = __builtin_amdgcn_mfma_f32_32x32x16_f16(kfr[s], qf[s], S, 0, 0, 0);
                bf16x8v pf[2];
                if (slow) {
                    float bs[16];
#pragma unroll
                    for (int i = 0; i < 16; ++i) { const int dist = my_pos - (kpos0 + sub * 32 + crow(i, h)); bs[i] = ((const LAS float*)(L + B_LUT))[min(max(dist, 0), 127)]; }
#pragma unroll
                    for (int i = 0; i < 16; ++i) {
                        const int kidx = sub * 32 + crow(i, h), dist = my_pos - (kpos0 + kidx);
                        const bool ok = ((mword >> ((i & 3) + 8 * (i >> 2))) & 1u) != 0u && dist >= 0 && kidx < nvalid;
                        const float e = __builtin_amdgcn_exp2f(fminf(S[i] + (bs[i] - mref), 80.f));
                        S[i] = ok ? e : 0.f;
                    }
                    pf[0] = pack_p(S, 0); pf[1] = pack_p(S, 1);
                } else {
#pragma unroll
                    for (int i = 0; i < 16; ++i) S[i] = __uint_as_float(__float_as_uint(__builtin_amdgcn_exp2f(S[i])) & (unsigned)__builtin_amdgcn_sbfe((int)mword, (i & 3) + 8 * (i >> 2), 1));
                    pf[0] = pack_p(S, 0); pf[1] = pack_p(S, 1);
                }
#pragma unroll
                for (int s = 0; s < 2; ++s) { Lacc = __builtin_amdgcn_mfma_f32_32x32x16_bf16(ones, pf[s], Lacc, 0, 0, 0);
#pragma unroll
                    for (int d = 0; d < 2; ++d) O[d] = __builtin_amdgcn_mfma_f32_32x32x16_bf16(vfr[d][s], pf[s], O[d], 0, 0, 0); }
            }
        }
#if PROBE_REP >= 60 && PROBE_REP < 70
        asm volatile("" : "+v"(O[0][0]), "+v"(O[1][0]), "+v"(Lacc[0])); PTS(a3t1);
#endif
        if (t + 2 < ntiles) {
#pragma unroll
            for (int j = 0; j < 2; ++j) { *(LAS u32x4*)(L + B_KS + (buf ^ 2) * KBUF + kdst + j * 64 * KS_PITCH) = kreg[j]; *(LAS u32x4*)(L + B_VS + (buf ^ 2) * VBUF + vdst + j * 64 * 64) = vreg[j]; } }
#pragma unroll
        for (int j = 0; j < 4; ++j) mw[j] = mwn[j];
#if PROBE_REP >= 60 && PROBE_REP < 70
        PTS(a3t2);
#endif
        if (t & 1) { if (STAGGER > 0 && wave < 4) __builtin_amdgcn_s_sleep(STAGGER); __syncthreads(); }
#if PROBE_REP >= 60 && PROBE_REP < 70
        PTS(a3t3); a3C += a3t1 - a3t0; a3S += a3t2 - a3t1; a3W += a3t3 - a3t2;
#endif
    }
#if PROBE_REP >= 60 && PROBE_REP < 70
    { unsigned a3U1; PTS(a3U1); if (lane == 0) { unsigned long long* pc = (unsigned long long*)(F.ws + WS_CTL) + 4096;
        const unsigned vals[4] = {a3C, a3S, a3W, a3U1 - a3U0};
        atomicAdd(pc + (PROBE_REP - 40), (unsigned long long)vals[PROBE_REP - 60]); atomicAdd(pc + 23, (unsigned long long)(a3U1 - a3U0)); } }
#endif
    __builtin_amdgcn_s_setprio(0);
    if (wave_on) {
        const float il = 1.0f / Lacc[0];
        if (!meta_u || r < NMETA) {
            _Float16* dst = (_Float16*)(F.ws + WS_ABUF) + (size_t)my_row * DM + ha * 64;
#pragma unroll
            for (int d = 0; d < 2; ++d)
#pragma unroll
                for (int g4 = 0; g4 < 4; ++g4) { const int d0 = 32 * d + 8 * g4 + 4 * h;
                    u32x2 w; w.x = cvt_pk_f16(O[d][4 * g4 + 0] * il, O[d][4 * g4 + 1] * il); w.y = cvt_pk_f16(O[d][4 * g4 + 2] * il, O[d][4 * g4 + 3] * il);
                    *(u32x2*)(dst + d0) = w; }
        }
    }
}
__device__ __forceinline__ void mixA3_phase(const Frame& F, int l) {
#pragma unroll 1
    for (int c = F.bid; c < 256; c += F.G) { const int bh = c & 15, i1 = c >> 4, i2 = 31 - i1;
#pragma unroll 1
        for (int k = 0; k < 5; ++k) { if (k == 4 && c >= 16) break;
            const int qb = k == 0 ? 63 - i1 : (k == 1 ? 32 + i1 : (k == 2 ? i2 : (k == 3 ? i1 : -1)));
            mixA3_unit(F, l, bh >> 3, bh & 7, qb); }
    }
}
constexpr int NPHASES = 19;
__global__ void __launch_bounds__(NTHREADS, 2) fwd(Args args) {
    extern __shared__ __attribute__((aligned(16))) unsigned char lds_raw[];
    Frame F;
    F.x = args.in[0]; F.meta = args.in[1]; F.rel_bias = args.in[2]; F.w_in = args.in[3]; F.norm_mix = args.in[4]; F.diff_lambda = args.in[5]; F.diff_norm = args.in[6];
    F.ret_norm = args.in[7]; F.w_out = args.in[8]; F.norm_ff = args.in[9]; F.w_ff1 = args.in[10]; F.w_ff2 = args.in[11]; F.final_norm = args.in[12];
    F.out = args.out; F.ws = args.ws; F.lds = (LAS unsigned char*)lds_raw;
    F.bid = blockIdx.x; F.G = gridDim.x; F.tid = threadIdx.x; F.lane = F.tid & 63; F.wave = __builtin_amdgcn_readfirstlane(F.tid >> 6);
    if (F.tid < 64) ((LAS unsigned*)(F.lds + LDS_MISC))[F.tid] = 0u;
    __syncthreads();
    unsigned* ctl = (unsigned*)(F.ws + WS_CTL);
    XcdBarrier bar = xcd_barrier_post(ctl + CW_BAR, (volatile LAS unsigned*)(F.lds + LDS_MISC));
    const int lo = args.ph_lo, hi = args.ph_hi;
#define IN(k) (lo <= (k) && (k) < hi)
#ifndef PROBE_REP
#define PROBE_REP 0
#endif
#define RETID() do { unsigned z0_ = 0u; asm volatile("" : "+s"(z0_)); int t_ = (int)__builtin_amdgcn_mbcnt_hi(~0u, __builtin_amdgcn_mbcnt_lo(~0u, z0_)); asm volatile("" : "+v"(t_)); F.lane = t_; F.tid = F.wave * 64 + t_; } while (0)
#define REP(k) _Pragma("unroll 1") for (int rep_ = 0; rep_ < ((PROBE_REP == (k)) ? 2 : 1); ++rep_)
#define SEAM(k) do { if (IN(k) && IN((k) + 1)) xcd_barrier(bar, F.wave == 0 && F.lane == 0); } while (0)
    LAS unsigned char* stage = F.lds + LDS_GEN;
    if (IN(0)) { REP(10) prologue(F); SEAM(0);
#if PROBE_REP == 20
        for (int xb = 0; xb < 20; ++xb) xcd_barrier(bar, F.wave == 0 && F.lane == 0);
#endif
    }
#pragma unroll 1
    for (int l = 0; l < DEPTH; ++l) {
        const int pb = 1 + 9 * l;
        { RETID();
          size_t z_ = 0; int b_ = blockIdx.x, g_ = gridDim.x; asm volatile("" : "+s"(z_), "+s"(b_), "+s"(g_)); F.ws = args.ws + z_; F.out = args.out + z_; F.bid = b_; F.G = g_; }
        unsigned char* wl = F.ws + WS_W + (size_t)l * W_LAYER;
        unsigned char* proj = F.ws + WS_PROJ;
        if (IN(pb + 0)) {
            pg8::Gemm g{(const pg8::bf16_t*)(F.ws + WS_ABUF), (const pg8::bf16_t*)(wl + W_IN_OFF), MP, NPAD, DM}; pg8::StaticOrder S; S.init(MP, NPAD, F.G, F.bid);
            EpiInProj E{proj, (const f32x2*)(F.ws + WS_ROPE), ctl + CW_KMAX + 32 * l};
            pg8::gemm_phase<EpiInProj, pg8::StaticOrder, true, true>(stage, g, S, E, F.tid);
#if PROBE_REP == 7
            RETID(); pg8::gemm_phase<EpiInProj, pg8::StaticOrder, true, true>(stage, g, S, E, F.tid);
#endif
            SEAM(pb + 0);
        }
        if (IN(pb + 1)) { RETID(); REP(1) mixA_index_phase(F); RETID(); REP(2) mixC1_phase(F); SEAM(pb + 1); }
        if (IN(pb + 2)) { RETID(); REP(3) mixC_scan(F); RETID(); REP(4) mixB_phase(F, l); SEAM(pb + 2); }
        if (IN(pb + 3)) { RETID(); REP(5) mixA3_phase(F, l); RETID(); REP(6) mixC2_phase(F, l); SEAM(pb + 3); }
        if (IN(pb + 4)) { RETID();
            skinny_meta<0>(F, wl); RETID();
            pg8::Gemm g{(const pg8::bf16_t*)(F.ws + WS_ABUF), (const pg8::bf16_t*)(wl + W_OUT_OFF), MR, DM, DM}; pg8::StaticOrder S; S.init(MR, DM, F.G, F.bid);
            EpiRes E{l == 0 ? F.x : F.out, F.out, (float*)(F.ws + WS_HMETA)};
            pg8::gemm_phase<EpiRes, pg8::StaticOrder, true, true>(stage, g, S, E, F.tid);
            SEAM(pb + 4);
        }
        if (IN(pb + 5)) { RETID(); zero_scr(F); REP(8) norm_to_abuf<1>(F, F.norm_ff + (size_t)l * DM); SEAM(pb + 5); }
        if (IN(pb + 6)) { RETID();
            skinny_meta<1>(F, wl); RETID();
            pg8::Gemm g{(const pg8::bf16_t*)(F.ws + WS_ABUF), (const pg8::bf16_t*)(wl + W_FF1_OFF), MR, DFF, DM}; pg8::StaticOrder S; S.init(MR, DFF, F.G, F.bid);
            EpiRelu2 E{proj};
            pg8::gemm_phase<EpiRelu2, pg8::StaticOrder, true, true>(stage, g, S, E, F.tid);
#if PROBE_REP == 9
            RETID(); pg8::gemm_phase<EpiRelu2, pg8::StaticOrder, true, true>(stage, g, S, E, F.tid);
#endif
            SEAM(pb + 6);
        }
        if (IN(pb + 7)) { RETID();
            skinny_meta<2>(F, wl); RETID();
            pg8::Gemm g{(const pg8::bf16_t*)proj, (const pg8::bf16_t*)(wl + W_FF2_OFF), MR, DM, DFF}; pg8::StaticOrder S; S.init(MR, DM, F.G, F.bid);
            EpiRes E{F.out, F.out, (float*)(F.ws + WS_HMETA)};
#if PROBE_REP == 14
            { EpiRes E2{F.out, (float*)(F.ws + WS_ABUF), (float*)(F.ws + WS_U)}; pg8::gemm_phase<EpiRes, pg8::StaticOrder, true, true>(stage, g, S, E2, F.tid); RETID(); }
#endif
            pg8::gemm_phase<EpiRes, pg8::StaticOrder, true, true>(stage, g, S, E, F.tid);
            SEAM(pb + 7);
        }
        if (IN(pb + 8)) { RETID();
            if (l + 1 < DEPTH) { norm_to_abuf<1>(F, F.norm_mix + (size_t)(l + 1) * DM); SEAM(pb + 8); }
            else final_norm(F);
        }
    }
#if PROBE_REP >= 40
    RETID(); if (blockIdx.x == 0 && F.tid == 0) {
        const unsigned long long* pc = (const unsigned long long*)(args.ws + WS_CTL) + 4096;
        const unsigned long long vx = __hip_atomic_load(pc + (PROBE_REP - 40), __ATOMIC_RELAXED, __HIP_MEMORY_SCOPE_AGENT), vt = __hip_atomic_load(pc + (PROBE_REP < 60 ? 3 : (PROBE_REP < 70 ? 23 : 33)), __ATOMIC_RELAXED, __HIP_MEMORY_SCOPE_AGENT);
        const unsigned long long ticks = (unsigned long long)((float)vx / (float)vt * 1.0e6f);
        const unsigned long long t0 = __builtin_amdgcn_s_memrealtime();
        while (__builtin_amdgcn_s_memrealtime() - t0 < ticks) __builtin_amdgcn_s_sleep(16);
    }
#endif
#undef IN
#undef SEAM
}

#ifndef MK_SPLIT
#define MK_SPLIT 0
#endif
extern "C" void kernel_launch(void* const* d_in, const int* in_sizes, int n_in, void* d_out, int out_size, void* d_ws, size_t ws_size, hipStream_t stream) {
    static int grid = 0;
    if (grid == 0) {
        if (n_in != 13 || ws_size < WS_END) { fprintf(stderr, "kernel_launch: need 13 inputs and %zu bytes of workspace; got %d, %zu\n", (size_t)WS_END, n_in, ws_size); grid = -1; return; }
        int dev = 0, cus = 0, per_cu = 0;
        if (hipGetDevice(&dev) != hipSuccess || hipDeviceGetAttribute(&cus, hipDeviceAttributeMultiprocessorCount, dev) != hipSuccess) { grid = -1; return; }
        if (hipFuncSetAttribute((const void*)fwd, hipFuncAttributeMaxDynamicSharedMemorySize, LDS_BYTES) != hipSuccess) { fprintf(stderr, "kernel_launch: hipFuncSetAttribute failed\n"); grid = -1; return; }
        if (hipOccupancyMaxActiveBlocksPerMultiprocessor(&per_cu, (const void*)fwd, NTHREADS, LDS_BYTES) != hipSuccess || per_cu < 1) { fprintf(stderr, "kernel_launch: occupancy query says %d\n", per_cu); }
        (void)hipGetLastError();
        grid = cus;
    }
    if (grid < 0) return;
    (void)hipMemsetAsync((char*)d_ws + WS_CTL, 0, CTL_BYTES, stream);
    Args a{};
    for (int i = 0; i < 13; ++i) a.in[i] = (const float*)d_in[i];
    a.out = (float*)d_out; a.ws = (unsigned char*)d_ws;
#if MK_SPLIT
    for (int p = 0; p < NPHASES; ++p) { a.ph_lo = p; a.ph_hi = p + 1; hipLaunchKernelGGL(fwd, dim3(grid), dim3(NTHREADS), LDS_BYTES, stream, a); }
#else
    a.ph_lo = 0; a.ph_hi = NPHASES; hipLaunchKernelGGL(fwd, dim3(grid), dim3(NTHREADS), LDS_BYTES, stream, a);
#endif
}
```

```cpp
#include <hip/hip_runtime.h>
#include <cstdio>
#include <cstdint>
typedef _Float16 h8 __attribute__((ext_vector_type(8)));
typedef _Float16 h4 __attribute__((ext_vector_type(4)));
typedef _Float16 h2 __attribute__((ext_vector_type(2)));
typedef short s16x8 __attribute__((ext_vector_type(8)));
typedef short s16x4 __attribute__((ext_vector_type(4)));
typedef float f32x16 __attribute__((ext_vector_type(16)));
typedef float f32x2 __attribute__((ext_vector_type(2)));
typedef unsigned u32x2 __attribute__((ext_vector_type(2)));
namespace pg8 {
#define PG8_LAS __attribute__((address_space(3)))
typedef unsigned short bf16_t;
typedef short bf16x8 __attribute__((ext_vector_type(8)));
typedef float f32x4 __attribute__((ext_vector_type(4)));
typedef unsigned u32x4 __attribute__((ext_vector_type(4)));
constexpr int BM = 256, BK = 64, HALF = 128, HTB = HALF * BK * 2  , STAGE_BYTES = 8 * HTB, NXCD = 8, WGM = 8;

__host__ __device__ __forceinline__ int lds_byte(int r, int c) { const int st = (r >> 4) * 2 + (c >> 5), rr = r & 15, cc = c & 31, ob = rr * 64 + cc * 2; return st * 1024 + (ob ^ (((ob >> 9) & 1) << 5)); }
__host__ __device__ __forceinline__ void stage_rc(int b, int& R, int& C) { const int st = b / 1024, sb = b % 1024, swz = sb ^ (((sb >> 9) & 1) << 5); R = (st >> 1) * 16 + swz / 64; C = (st & 1) * 32 + (swz % 64) / 2; }
__host__ __device__ __forceinline__ int perm32(int rho) { const int n = rho >> 4, i = rho & 15; return 8 * (i >> 2) + 4 * n + (i & 3); }

struct Unit { int pm, pn; };
struct Gemm { const bf16_t* A; const bf16_t* Bt; int M, N, K; };

struct StaticOrder {
    int nM, nN, nwg, G, c;
    __host__ __device__ void init(int M, int N, int G_, int c_) { nM = M / BM; nN = N / BM; nwg = nM * nN; G = G_; c = c_; }
    __host__ __device__ bool next(int i, Unit& u) const {
        const long L = (long)i * G + c; if (L >= nwg) return false;
        int wgid = (int)L; { const int q = nwg / NXCD, r = nwg % NXCD, xcd = wgid % NXCD, off = wgid / NXCD; wgid = (xcd < r ? xcd * (q + 1) : r * (q + 1) + (xcd - r) * q) + off; }
        const int nig = WGM * nN, gid = wgid / nig, fm = gid * WGM, gsz = (nM - fm) < WGM ? (nM - fm) : WGM;
        u.pm = fm + ((wgid % nig) % gsz); u.pn = (wgid % nig) / gsz; return true;
    }
    __device__ __forceinline__ void a_ready(const Unit&) const {}
    __device__ __forceinline__ void done(const Unit&) const {}
};

template <class Epi, class Sched, bool ALIGN_EPI = false, bool SP2 = false>
__device__ __forceinline__ void gemm_phase(PG8_LAS unsigned char* lds, const Gemm g, const Sched& S, const Epi& E, int tid_in) {
    int tid_ = tid_in; asm volatile("" : "+v"(tid_));
    const int tid = tid_, wid = __builtin_amdgcn_readfirstlane(tid >> 6), lane = tid & 63, wr = wid >> 2, wc = wid & 3, fr = lane & 15, fq = lane >> 4;
    const int K = g.K, nt = K / BK;
    unsigned voffA[2], voffB[2];
#pragma unroll
    for (int i = 0; i < 2; ++i) { int R, C; stage_rc(tid * 16 + i * 8192, R, C); const int Rb = Epi::PERM ? ((R & ~31) + perm32(R & 31)) : R;
        voffA[i] = (unsigned)(R * K + C) * 2u; voffB[i] = (unsigned)(Rb * K + C) * 2u; }
    const size_t kstep = (size_t)(BK * 2);
    const size_t hstep = (size_t)HALF * K * 2;
    const size_t tstep = 2 * hstep;
    const unsigned ldsw = (unsigned)wid * 1024u;
    const int aoff = lds_byte(wr * 64 + fr, fq * 8), boff = lds_byte(wc * 32 + fr, fq * 8);
#define PG8_SA(b, h) (((b) * 2 + (h)) * HTB)
#define PG8_SB(b, h) ((4 + (b) * 2 + (h)) * HTB)
#define PG8_STAGE(bufoff, gbase, voff) do { _Pragma("unroll") for (int _i = 0; _i < 2; ++_i) \
        __builtin_amdgcn_global_load_lds((const unsigned*)((const char*)(gbase) + (voff)[_i]), (PG8_LAS unsigned*)(lds + (bufoff) + ldsw + _i * 8192), 16, 0, 0); } while (0)
#define PG8_LDA(dst, b, h) do { _Pragma("unroll") for (int m = 0; m < 4; ++m) _Pragma("unroll") for (int k = 0; k < 2; ++k) dst[m][k] = *(const PG8_LAS bf16x8*)(lds + PG8_SA(b, h) + aoff + m * 2048 + k * 1024); } while (0)
#define PG8_LDB(dst, b, h) do { _Pragma("unroll") for (int n = 0; n < 2; ++n) _Pragma("unroll") for (int k = 0; k < 2; ++k) dst[n][k] = *(const PG8_LAS bf16x8*)(lds + PG8_SB(b, h) + boff + n * 2048 + k * 1024); } while (0)
#define PG8_MMA(ai, bj, At, Bt) do { __builtin_amdgcn_s_setprio(1); _Pragma("unroll") for (int m = 0; m < 4; ++m) _Pragma("unroll") for (int n = 0; n < 2; ++n) _Pragma("unroll") for (int k = 0; k < 2; ++k) \
        acc[ai][bj][m][n] = __builtin_amdgcn_mfma_f32_16x16x32_f16(__builtin_bit_cast(h8, Bt[n][k]), __builtin_bit_cast(h8, At[m][k]), acc[ai][bj][m][n], 0, 0, 0); __builtin_amdgcn_s_setprio(0); } while (0)
#define PG8_WAIT_V(n) asm volatile("s_waitcnt vmcnt(" #n ")" ::: "memory")
#define PG8_WAIT_L(n) asm volatile("s_waitcnt lgkmcnt(" #n ")" ::: "memory")
#define PG8_BAR __builtin_amdgcn_s_barrier()
#define PG8_SCHED __builtin_amdgcn_sched_barrier(0)
    Unit cur, nxt; int ui = 0;
    if (!S.next(0, cur)) return;
    f32x4 acc[2][2][4][2];
#pragma unroll
    for (int a = 0; a < 2; ++a)
#pragma unroll
        for (int b = 0; b < 2; ++b)
#pragma unroll
            for (int m = 0; m < 4; ++m)
#pragma unroll
                for (int n = 0; n < 2; ++n) acc[a][b][m][n] = (f32x4){0.f, 0.f, 0.f, 0.f};
    bf16x8 At[4][2], B0[2][2], B1[2][2];
    const char* cA = (const char*)g.A + (size_t)cur.pm * tstep; const char* cB = (const char*)g.Bt + (size_t)cur.pn * tstep;
    S.a_ready(cur);
    if constexpr (SP2) {
        PG8_STAGE(PG8_SB(0, 0), cB, voffB); PG8_STAGE(PG8_SB(0, 1), cB + hstep, voffB); PG8_STAGE(PG8_SA(0, 0), cA, voffA); PG8_STAGE(PG8_SA(0, 1), cA + hstep, voffA);
        if (wr == 1) PG8_BAR;
        PG8_WAIT_V(2); PG8_BAR;
        PG8_STAGE(PG8_SB(1, 0), cB + kstep, voffB); PG8_STAGE(PG8_SA(1, 0), cA + kstep, voffA); PG8_STAGE(PG8_SB(1, 1), cB + hstep + kstep, voffB);
        PG8_WAIT_V(6); PG8_BAR;
    } else {
        PG8_STAGE(PG8_SB(0, 0), cB, voffB); PG8_STAGE(PG8_SA(0, 0), cA, voffA); PG8_STAGE(PG8_SB(0, 1), cB + hstep, voffB); PG8_STAGE(PG8_SA(0, 1), cA + hstep, voffA);
        if (wr == 1) PG8_BAR;
        PG8_WAIT_V(4); PG8_BAR;
        PG8_STAGE(PG8_SB(1, 0), cB + kstep, voffB); PG8_STAGE(PG8_SA(1, 0), cA + kstep, voffA); PG8_STAGE(PG8_SB(1, 1), cB + hstep + kstep, voffB);
        PG8_WAIT_V(6); PG8_BAR;
    }
    for (;;) {
        const bool has_next = S.next(ui + 1, nxt);
        const char* nA = has_next ? (const char*)g.A + (size_t)nxt.pm * tstep : cA; const char* nB = has_next ? (const char*)g.Bt + (size_t)nxt.pn * tstep : cB;
        for (int t = 0; t < nt; t += 2) {
            const bool last = (t == nt - 2);
            const char* a1 = cA + (size_t)(t + 1) * kstep;
            const char* a2 = last ? nA : cA + (size_t)(t + 2) * kstep; const char* b2 = last ? nB : cB + (size_t)(t + 2) * kstep;
            const char* a3 = a2 + kstep; const char* b3 = b2 + kstep;
            if (last && has_next) S.a_ready(nxt);
            if constexpr (SP2) {
            PG8_LDB(B0, 0, 0); PG8_LDB(B1, 0, 1); PG8_SCHED; PG8_LDA(At, 0, 0); PG8_STAGE(PG8_SA(1, 1), a1 + hstep, voffA);
            PG8_WAIT_V(8); PG8_WAIT_L(0); PG8_BAR; PG8_MMA(0, 0, At, B0); PG8_MMA(0, 1, At, B1); PG8_BAR; PG8_SCHED;
            PG8_LDA(At, 0, 1); PG8_STAGE(PG8_SB(0, 0), b2, voffB); PG8_STAGE(PG8_SB(0, 1), b2 + hstep, voffB); PG8_STAGE(PG8_SA(0, 0), a2, voffA);
            PG8_WAIT_V(8); PG8_WAIT_L(0); PG8_BAR; PG8_MMA(1, 0, At, B0); PG8_MMA(1, 1, At, B1); PG8_BAR; PG8_SCHED;
            PG8_LDB(B0, 1, 0); PG8_LDB(B1, 1, 1); PG8_SCHED; PG8_LDA(At, 1, 0); PG8_STAGE(PG8_SA(0, 1), a2 + hstep, voffA);
            PG8_WAIT_V(8); PG8_WAIT_L(0); PG8_BAR; PG8_MMA(0, 0, At, B0); PG8_MMA(0, 1, At, B1); PG8_BAR; PG8_SCHED;
            PG8_LDA(At, 1, 1); PG8_STAGE(PG8_SB(1, 0), b3, voffB); PG8_STAGE(PG8_SB(1, 1), b3 + hstep, voffB); PG8_STAGE(PG8_SA(1, 0), a3, voffA);
            PG8_WAIT_V(8); PG8_WAIT_L(0); PG8_BAR; PG8_MMA(1, 0, At, B0); PG8_MMA(1, 1, At, B1); PG8_BAR; PG8_SCHED;
            } else {
            PG8_LDB(B0, 0, 0); PG8_SCHED; PG8_LDA(At, 0, 0); PG8_STAGE(PG8_SA(1, 1), a1 + hstep, voffA);
            PG8_WAIT_L(8); PG8_BAR; PG8_WAIT_L(0); PG8_MMA(0, 0, At, B0); PG8_BAR; PG8_SCHED;
            PG8_LDB(B1, 0, 1); PG8_STAGE(PG8_SB(0, 0), b2, voffB);
            PG8_BAR; PG8_WAIT_L(0); PG8_MMA(0, 1, At, B1); PG8_BAR;
            PG8_LDA(At, 0, 1); PG8_STAGE(PG8_SA(0, 0), a2, voffA);
            PG8_BAR; PG8_WAIT_L(0); PG8_MMA(1, 0, At, B0); PG8_BAR; PG8_SCHED;
            PG8_STAGE(PG8_SB(0, 1), b2 + hstep, voffB);
            PG8_WAIT_V(6); PG8_BAR; PG8_MMA(1, 1, At, B1); PG8_BAR;
            PG8_LDB(B0, 1, 0); PG8_SCHED; PG8_LDA(At, 1, 0); PG8_STAGE(PG8_SA(0, 1), a2 + hstep, voffA);
            PG8_WAIT_L(8); PG8_BAR; PG8_WAIT_L(0); PG8_MMA(0, 0, At, B0); PG8_BAR; PG8_SCHED;
            PG8_LDB(B1, 1, 1); PG8_STAGE(PG8_SB(1, 0), b3, voffB);
            PG8_BAR; PG8_WAIT_L(0); PG8_MMA(0, 1, At, B1); PG8_BAR;
            PG8_LDA(At, 1, 1); PG8_STAGE(PG8_SA(1, 0), a3, voffA);
            PG8_BAR; PG8_WAIT_L(0); PG8_MMA(1, 0, At, B0); PG8_BAR; PG8_SCHED;
            PG8_STAGE(PG8_SB(1, 1), b3 + hstep, voffB);
            PG8_WAIT_V(6); PG8_BAR; PG8_MMA(1, 1, At, B1); PG8_BAR;
            }
        }
        if constexpr (ALIGN_EPI) { if (wr == 0) PG8_BAR; }
        if constexpr (!Epi::AFTER_DRAIN) { E(acc, cur, wr, wc, fr, fq); S.done(cur); }
        if (!has_next) break;
#pragma unroll
        for (int a = 0; a < 2; ++a)
#pragma unroll
            for (int b = 0; b < 2; ++b)
#pragma unroll
                for (int m = 0; m < 4; ++m)
#pragma unroll
                    for (int n = 0; n < 2; ++n) acc[a][b][m][n] = (f32x4){0.f, 0.f, 0.f, 0.f};
        cur = nxt; cA = nA; cB = nB; ++ui;
        if constexpr (ALIGN_EPI) { if (wr == 1) PG8_BAR; }
    }
    PG8_WAIT_V(0);
    if constexpr (!ALIGN_EPI) { if (wr == 0) PG8_BAR; }
    PG8_BAR;
    if constexpr (Epi::AFTER_DRAIN) { E.fused(acc, cur, wr, wc, fr, fq, lds, wid, lane); S.done(cur); }
#undef PG8_SA
#undef PG8_SB
#undef PG8_STAGE
#undef PG8_LDA
#undef PG8_LDB
#undef PG8_MMA
#undef PG8_WAIT_V
#undef PG8_WAIT_L
#undef PG8_BAR
#undef PG8_SCHED
}
}

#define XB_TMO      128
#define XB_XCNT(j)  (256  + 64 * (j))
#define XB_XSUB(j)  (1280 + 64 * (j))
#define XB_XGEN(j)  (2304 + 64 * (j))
#define XB_TOP      3328
#define XB_TOPGEN   3392
#define XCD_BAR_WORDS 3456
#define XB_SPIN_CAP (1u << 18)
#define LAS __attribute__((address_space(3)))

__device__ __forceinline__ unsigned xb_ld(unsigned* p)              { return __hip_atomic_load(p, __ATOMIC_RELAXED, __HIP_MEMORY_SCOPE_AGENT); }
__device__ __forceinline__ unsigned xb_add(unsigned* p, unsigned v) { return __hip_atomic_fetch_add(p, v, __ATOMIC_RELAXED, __HIP_MEMORY_SCOPE_AGENT); }
__device__ __forceinline__ unsigned xb_xcc_id() { return (unsigned)__builtin_amdgcn_s_getreg((3 << 11) | 20) & 0xFu; }
#define XB_SPIN(cond, bar) do { unsigned _sp = 0; while (cond) { __builtin_amdgcn_s_sleep(1); \
    if ((++_sp & 255u) == 0u) { if (xb_ld(&(bar)[XB_TMO])) break; if (_sp > XB_SPIN_CAP) { atomicAdd(&(bar)[XB_TMO], 1u); break; } } } } while (0)

struct XcdBarrier {
    unsigned* bar; unsigned x;
    volatile LAS unsigned* st;
};

__device__ __forceinline__ XcdBarrier xcd_barrier_post(unsigned* bar, volatile LAS unsigned* st) {
    XcdBarrier b; b.bar = bar; b.x = xb_xcc_id(); b.st = st;
    if (threadIdx.x == 0) (void)xb_add(&bar[XB_XCNT(b.x)], 1u);
    return b;
}
__device__ __forceinline__ void xcd_barrier_complete(unsigned* bar, unsigned x, unsigned& nloc, unsigned& nx) {
    const unsigned G = gridDim.x * gridDim.y * gridDim.z;
    unsigned sum, cnt, mine, sp = 0u;
    for (;;) {
        sum = 0u; cnt = 0u; mine = 0u;
#pragma unroll
        for (unsigned j = 0; j < 16; ++j) { const unsigned c = xb_ld(&bar[XB_XCNT(j)]); sum += c; cnt += (c > 0u) ? 1u : 0u; mine = (j == x) ? c : mine; }
        if (sum == G) break;
        __builtin_amdgcn_s_sleep(1);
        if ((++sp & 255u) == 0u) { if (xb_ld(&bar[XB_TMO])) break; if (sp > XB_SPIN_CAP) { atomicAdd(&bar[XB_TMO], 1u); break; } }
    }
    nloc = mine > 0u ? mine : 1u; nx = cnt > 0u ? cnt : 1u;
}

__device__ __forceinline__ void xcd_barrier(const XcdBarrier& b, const bool leader_thread) {
    asm volatile("s_waitcnt vmcnt(0)" ::: "memory");
    __syncthreads();
    if (leader_thread) {
        unsigned* bar = b.bar;
        __builtin_amdgcn_s_waitcnt(0);
        unsigned nloc = b.st[0], nx = b.st[1];
        if (nloc == 0u) { xcd_barrier_complete(bar, b.x, nloc, nx); b.st[0] = nloc; b.st[1] = nx; }
        const unsigned old = xb_add(&bar[XB_XSUB(b.x)], 1u);
        const unsigned gen = old / nloc;
        if (old + 1u == (gen + 1u) * nloc) {
            __builtin_amdgcn_fence(__ATOMIC_RELEASE, "agent");
            asm volatile("s_waitcnt vmcnt(0)" ::: "memory");
            const unsigned og = xb_add(&bar[XB_TOP], 1u);
            const unsigned tg = og / nx;
            if (og + 1u == (tg + 1u) * nx) xb_add(&bar[XB_TOPGEN], 1u);
            else XB_SPIN(xb_ld(&bar[XB_TOPGEN]) == tg, bar);
            __builtin_amdgcn_fence(__ATOMIC_ACQUIRE, "agent");
            xb_add(&bar[XB_XGEN(b.x)], 1u);
            asm volatile("s_waitcnt vmcnt(0)" ::: "memory");
        } else {
            XB_SPIN(xb_ld(&bar[XB_XGEN(b.x)]) == gen, bar);
            __builtin_amdgcn_fence(__ATOMIC_ACQUIRE, "agent");
            asm volatile("s_waitcnt vmcnt(0)" ::: "memory");
        }
    }
    __syncthreads();
}

constexpr int NB = 2, SEQ = 16384, TLEN = 16400, DM = 1024, NMETA = 16, DEPTH = 2;
constexpr int MR = NB * SEQ;
constexpr int MV = MR + NB * NMETA;
constexpr int MP = 33024;
constexpr int INCOLS = 3912, NPAD = 4096, DFF = 4096;
constexpr int NTHREADS = 512;
constexpr float LOG2E = 1.4426950408889634f;
constexpr float QA_SCALE = 0.125f * LOG2E;
constexpr float QB_SCALE = 0.17677669529663687f * LOG2E;
constexpr float WI_SCALE = 0.044194173824159216f;
constexpr int NKS = 513;

constexpr size_t al256(size_t x) { return (x + 255) & ~(size_t)255; }
constexpr size_t WS_CTL   = 0;
constexpr size_t CTL_BYTES = 65536;
constexpr size_t WS_HMETA = CTL_BYTES;
constexpr size_t WS_ROPE  = WS_HMETA + (size_t)256 * DM * 4;
constexpr size_t WS_W     = al256(WS_ROPE + (size_t)TLEN * 32 * 8);
constexpr size_t W_IN_OFF = 0, W_OUT_OFF = (size_t)NPAD * DM * 2, W_FF1_OFF = W_OUT_OFF + (size_t)DM * DM * 2,
                 W_FF2_OFF = W_FF1_OFF + (size_t)DFF * DM * 2, W_LAYER = W_FF2_OFF + (size_t)DM * DFF * 2;
constexpr size_t WS_ABUF  = al256(WS_W + DEPTH * W_LAYER);
constexpr size_t WS_MASK  = WS_ABUF + (size_t)MP * DM * 2;
constexpr size_t WS_U     = al256(WS_MASK + (size_t)NB * NKS * TLEN * 4);
constexpr size_t WS_S     = WS_U + (size_t)NB * 4 * 129 * 4096 * 4;
constexpr size_t WS_PROJ  = WS_S + (size_t)NB * 4 * 129 * 4096 * 4;
constexpr size_t P512 = (size_t)MP * 512 * 2, P256 = (size_t)MP * 256 * 2;
constexpr size_t PJ_QA = 0, PJ_KA = P512, PJ_VA = 2 * P512, PJ_QI = 3 * P512, PJ_256 = 4 * P512;
constexpr size_t PJ_QB = PJ_256, PJ_KB = PJ_256 + P256, PJ_VB = PJ_256 + 2 * P256, PJ_QC = PJ_256 + 3 * P256, PJ_KC = PJ_256 + 4 * P256,
                 PJ_VC = PJ_256 + 5 * P256, PJ_GC = PJ_256 + 6 * P256, PJ_KI = PJ_256 + 7 * P256, PJ_WI = PJ_KI + (size_t)MP * 64 * 2,
                 PJ_END = PJ_WI + (size_t)MP * 8 * 4;
constexpr size_t ACT_BYTES = (size_t)MP * DFF * 2;
constexpr size_t WS_END = WS_PROJ + (ACT_BYTES > PJ_END ? ACT_BYTES : PJ_END);
constexpr int CW_BAR = 0;
constexpr int CW_KMAX = 4096;

constexpr int LDS_BYTES = 156 * 1024;
constexpr int LDS_MISC = 0, LDS_GEN = 256;

struct Args { const float* in[13]; float* out; unsigned char* ws; int ph_lo, ph_hi; };

struct Frame {
    const float *x, *meta, *rel_bias, *w_in, *norm_mix, *diff_lambda, *diff_norm, *ret_norm, *w_out, *norm_ff, *w_ff1, *w_ff2, *final_norm;
    float* out; unsigned char* ws; LAS unsigned char* lds; int tid, lane, wave, bid, G;
};

__device__ __forceinline__ float shx(float v, int m, int lane) { return __builtin_bit_cast(float, __builtin_amdgcn_ds_bpermute((lane ^ m) << 2, __builtin_bit_cast(int, v))); }
template <int M> __device__ __forceinline__ float sx(float v, int lane) { return shx(v, M, lane); }
__device__ __forceinline__ float hsum32(float v, int lane) { return v + shx(v, 32, lane); }
__device__ __forceinline__ unsigned hor32(unsigned v, int lane) { return v | (unsigned)__builtin_amdgcn_ds_bpermute((lane ^ 32) << 2, (int)v); }
__device__ __forceinline__ float bcast0(float v) { return __builtin_bit_cast(float, __builtin_amdgcn_ds_bpermute(0, __builtin_bit_cast(int, v))); }
__device__ __forceinline__ float wave_sum(float v, int lane) { v = hsum32(v, lane); v += sx<16>(v, lane); v += sx<8>(v, lane); v += sx<4>(v, lane); v += sx<2>(v, lane); v += sx<1>(v, lane); return v; }
__device__ __forceinline__ unsigned cvt_pk_bf16(float lo, float hi) { unsigned r; asm volatile("v_cvt_pk_bf16_f32 %0, %1, %2" : "=v"(r) : "v"(lo), "v"(hi)); return r; }
__device__ __forceinline__ unsigned cvt_pk_f16(float lo, float hi) { h2 p; p.x = (_Float16)lo; p.y = (_Float16)hi; return __builtin_bit_cast(unsigned, p); }
typedef unsigned u32x4 __attribute__((ext_vector_type(4)));
typedef float f32x4 __attribute__((ext_vector_type(4)));
__device__ __forceinline__ u32x4 pack8(const f32x4& a, const f32x4& b, bool bf) {
    u32x4 w;
    if (bf) { w.x = cvt_pk_bf16(a[0], a[1]); w.y = cvt_pk_bf16(a[2], a[3]); w.z = cvt_pk_bf16(b[0], b[1]); w.w = cvt_pk_bf16(b[2], b[3]); }
    else    { w.x = cvt_pk_f16(a[0], a[1]);  w.y = cvt_pk_f16(a[2], a[3]);  w.z = cvt_pk_f16(b[0], b[1]);  w.w = cvt_pk_f16(b[2], b[3]); }
    return w;
}
__device__ __forceinline__ int row_pos(int r) { return r < MR ? (r & (SEQ - 1)) + NMETA : ((r - MR) & 15); }

__device__ __forceinline__ int incol_map(int n) {
    if (n < 2048) return n;
    if (n < 2816) return n - 2048 + 2120;
    if (n < 3328) {
        const int seg = (n - 2816) >> 8, c = (n - 2816) & 255, head = c >> 6, p = c & 63;
        const int g = p >> 3, nn = (p >> 2) & 1, i = p & 3, d = 32 * nn + 4 * g + i;
        return (seg ? 3144 : 2888) + head * 64 + d;
    }
    if (n < 3840) return n - 3328 + 3400;
    if (n < 3904) return n - 3840 + 2048;
    if (n < 3912) return n - 3904 + 2112;
    return -1;
}

__constant__ double ROPE_REV[32] = {0.15915494309189535, 0.11934937021124886, 0.08949940160889101, 0.06711508300522726, 0.050329212104487035, 0.03774158471741977, 0.0283021958306234, 0.02122365276477766, 0.015915494309189534, 0.011934937021124886, 0.008949940160889102, 0.006711508300522725, 0.005032921210448704, 0.003774158471741977, 0.00283021958306234, 0.0021223652764777662, 0.0015915494309189536, 0.0011934937021124885, 0.0008949940160889102, 0.0006711508300522726, 0.0005032921210448703, 0.00037741584717419774, 0.00028302195830623395, 0.0002122365276477766, 0.00015915494309189535, 0.00011934937021124886, 8.949940160889102e-05, 6.711508300522725e-05, 5.0329212104487035e-05, 3.774158471741978e-05, 2.8302195830623396e-05, 2.122365276477766e-05};

struct EpiInProj {
    static constexpr bool PERM = true, AFTER_DRAIN = false;
    unsigned char* proj; const f32x2* rope; unsigned* kmax;
    __device__ __forceinline__ void kmax_update(const pg8::f32x4 (&acc)[2][2][4][2], int bj, unsigned* word, int fr, int fq) const {
        float mx = 0.f; const int LN = fq * 16 + fr;
#pragma unroll
        for (int ai = 0; ai < 2; ++ai)
#pragma unroll
            for (int m = 0; m < 4; ++m) {
                const pg8::f32x4 a = acc[ai][bj][m][0], b = acc[ai][bj][m][1];
                float s = (a[0] * a[0] + a[1] * a[1]) + (a[2] * a[2] + a[3] * a[3]) + (b[0] * b[0] + b[1] * b[1]) + (b[2] * b[2] + b[3] * b[3]);
                s += sx<16>(s, LN); s = hsum32(s, LN);
                mx = fmaxf(mx, s);
            }
        mx = fmaxf(mx, sx<1>(mx, LN)); mx = fmaxf(mx, sx<2>(mx, LN)); mx = fmaxf(mx, sx<4>(mx, LN)); mx = fmaxf(mx, sx<8>(mx, LN));
        if (fr == 0 && fq == 0) atomicMax(word, __float_as_uint(mx));
    }
    __device__ __forceinline__ void operator()(const pg8::f32x4 (&acc)[2][2][4][2], const pg8::Unit& u, int wr, int wc, int fr, int fq) const {
        const int pn = u.pn, rbase = u.pm * 256 + wr * 64 + fr, cw = wc * 32 + 8 * fq;
        if (pn <= 7 || (pn <= 14 && pn != 11 && pn != 12)) {
            unsigned char* base; int ld, colt; float scale = 1.f; bool bf = false;
            if (pn <= 7) { const int arr = pn >> 1; base = proj + (size_t)arr * P512; ld = 512; colt = (pn & 1) * 256; if (arr == 0) scale = QA_SCALE; bf = (arr == 2); }
            else { const int arr = pn - 8; base = proj + PJ_256 + (size_t)arr * P256; ld = 256; colt = 0; if (arr == 0) scale = QB_SCALE; bf = (arr == 2); }
#pragma unroll
            for (int ai = 0; ai < 2; ++ai)
#pragma unroll
                for (int m = 0; m < 4; ++m) {
                    const int row = rbase + ai * 128 + m * 16;
#pragma unroll
                    for (int bj = 0; bj < 2; ++bj) {
                        const pg8::f32x4 v0 = acc[ai][bj][m][0] * scale, v1 = acc[ai][bj][m][1] * scale;
                        *(u32x4*)(base + ((size_t)row * ld + colt + bj * 128 + cw) * 2) = pack8(v0, v1, bf);
                    }
                }
            if (pn == 2 || pn == 3) {
#pragma unroll
                for (int bj = 0; bj < 2; ++bj) { const int head = ((pn & 1) * 256 + bj * 128 + wc * 32) >> 6; kmax_update(acc, bj, kmax + head * 2 + (wc & 1), fr, fq); }
            }
            if (pn == 9) {
#pragma unroll
                for (int bj = 0; bj < 2; ++bj) { const int head = 2 * bj + (wc >> 1); kmax_update(acc, bj, kmax + 16 + head * 2 + (wc & 1), fr, fq); }
            }
        } else if (pn == 11 || pn == 12) {
            unsigned char* base = proj + PJ_256 + (size_t)(pn - 8) * P256;
            const float sc = (pn == 12) ? 0.125f : 1.f;
            const int g = 4 * (wc & 1) + fq;
#pragma unroll
            for (int ai = 0; ai < 2; ++ai)
#pragma unroll
                for (int m = 0; m < 4; ++m) {
                    const int row = rbase + ai * 128 + m * 16, t = row_pos(row);
                    const pg8::f32x4 cs0 = *(const pg8::f32x4*)(rope + (size_t)t * 32 + 4 * g), cs1 = *(const pg8::f32x4*)(rope + (size_t)t * 32 + 4 * g + 2);
                    const float c[4] = {cs0[0], cs0[2], cs1[0], cs1[2]}, s[4] = {cs0[1], cs0[3], cs1[1], cs1[3]};
#pragma unroll
                    for (int bj = 0; bj < 2; ++bj) {
                        const pg8::f32x4 x1 = acc[ai][bj][m][0], x2 = acc[ai][bj][m][1];
                        float o1[4], o2[4];
#pragma unroll
                        for (int i = 0; i < 4; ++i) { o1[i] = (x1[i] * c[i] - x2[i] * s[i]) * sc; o2[i] = (x1[i] * s[i] + x2[i] * c[i]) * sc; }
                        const int head = 2 * bj + (wc >> 1);
                        unsigned char* rp = base + ((size_t)row * 256 + head * 64 + 4 * g) * 2;
                        u32x2 w1, w2; w1.x = cvt_pk_f16(o1[0], o1[1]); w1.y = cvt_pk_f16(o1[2], o1[3]); w2.x = cvt_pk_f16(o2[0], o2[1]); w2.y = cvt_pk_f16(o2[2], o2[3]);
                        *(u32x2*)rp = w1; *(u32x2*)(rp + 64) = w2;
                    }
                }
        } else {
#pragma unroll
            for (int ai = 0; ai < 2; ++ai)
#pragma unroll
                for (int m = 0; m < 4; ++m) {
                    const int row = rbase + ai * 128 + m * 16;
                    const pg8::f32x4 v0 = acc[ai][0][m][0], v1 = acc[ai][0][m][1];
                    if (wc < 2) *(u32x4*)(proj + PJ_KI + ((size_t)row * 64 + cw) * 2) = pack8(v0, v1, false);
                    else if (wc == 2 && fq == 0) { float* wp = (float*)(proj + PJ_WI) + (size_t)row * 8; *(pg8::f32x4*)wp = v0 * WI_SCALE; *(pg8::f32x4*)(wp + 4) = v1 * WI_SCALE; }
                }
        }
    }
};
struct EpiRes {
    static constexpr bool PERM = false, AFTER_DRAIN = false;
    const float* res_main; float* out_main; float* hmeta;
    __device__ __forceinline__ void operator()(const pg8::f32x4 (&acc)[2][2][4][2], const pg8::Unit& u, int wr, int wc, int fr, int fq) const {
        const bool mt = (u.pm * 256 >= MR);
        const float* rb = mt ? hmeta : res_main; float* ob = mt ? hmeta : out_main;
        const int row0 = (mt ? u.pm * 256 - MR : u.pm * 256) + wr * 64 + fr, col0 = u.pn * 256 + wc * 32 + 4 * fq;
#pragma unroll
        for (int ai = 0; ai < 2; ++ai)
#pragma unroll
            for (int m = 0; m < 4; ++m) {
                const size_t ro = (size_t)(row0 + ai * 128 + m * 16) * DM + col0;
#pragma unroll
                for (int bj = 0; bj < 2; ++bj)
#pragma unroll
                    for (int n = 0; n < 2; ++n) { const pg8::f32x4 v = *(const pg8::f32x4*)(rb + ro + bj * 128 + n * 16) + acc[ai][bj][m][n]; *(pg8::f32x4*)(ob + ro + bj * 128 + n * 16) = v; }
            }
    }
};
struct EpiRelu2 {
    static constexpr bool PERM = true, AFTER_DRAIN = false;
    unsigned char* act;
    __device__ __forceinline__ void operator()(const pg8::f32x4 (&acc)[2][2][4][2], const pg8::Unit& u, int wr, int wc, int fr, int fq) const {
        const int rbase = u.pm * 256 + wr * 64 + fr, col0 = u.pn * 256 + wc * 32 + 8 * fq;
#pragma unroll
        for (int ai = 0; ai < 2; ++ai)
#pragma unroll
            for (int m = 0; m < 4; ++m) {
                const int row = rbase + ai * 128 + m * 16;
#pragma unroll
                for (int bj = 0; bj < 2; ++bj) {
                    pg8::f32x4 v0 = acc[ai][bj][m][0], v1 = acc[ai][bj][m][1];
#pragma unroll
                    for (int i = 0; i < 4; ++i) { const float a = fmaxf(v0[i], 0.f), b = fmaxf(v1[i], 0.f); v0[i] = a * a; v1[i] = b * b; }
                    *(u32x4*)(act + ((size_t)row * DFF + col0 + bj * 128) * 2) = pack8(v0, v1, false);
                }
            }
    }
};

struct WTile { const float* src; _Float16* dst; int ld, K, k0, n0, mapped; };
constexpr int WT_PER_LAYER = 16 * 64 + 16 * 16 + 16 * 64 + 64 * 16, WT_TOTAL = DEPTH * WT_PER_LAYER;
__device__ __forceinline__ WTile wt_desc(const Frame& F, int t) {
    WTile d; const int l = t / WT_PER_LAYER; int r = t - l * WT_PER_LAYER;
    unsigned char* wl = F.ws + WS_W + (size_t)l * W_LAYER;
    if (r < 1024)      { d.src = F.w_in + (size_t)l * DM * INCOLS; d.dst = (_Float16*)(wl + W_IN_OFF);  d.ld = INCOLS; d.K = DM;  d.mapped = 1; d.k0 = (r & 15) * 64; d.n0 = (r >> 4) * 64; }
    else if (r < 1280) { r -= 1024; d.src = F.w_out + (size_t)l * DM * DM;  d.dst = (_Float16*)(wl + W_OUT_OFF); d.ld = DM;  d.K = DM;  d.mapped = 0; d.k0 = (r & 15) * 64; d.n0 = (r >> 4) * 64; }
    else if (r < 2304) { r -= 1280; d.src = F.w_ff1 + (size_t)l * DM * DFF; d.dst = (_Float16*)(wl + W_FF1_OFF); d.ld = DFF; d.K = DM;  d.mapped = 0; d.k0 = (r & 15) * 64; d.n0 = (r >> 4) * 64; }
    else               { r -= 2304; d.src = F.w_ff2 + (size_t)l * DFF * DM; d.dst = (_Float16*)(wl + W_FF2_OFF); d.ld = DM;  d.K = DFF; d.mapped = 0; d.k0 = (r & 63) * 64; d.n0 = (r >> 6) * 64; }
    return d;
}
__device__ __forceinline__ void wt_load(const WTile& d, int tid, f32x4& v0, f32x4& v1) {
    const int kk = tid >> 4, n4 = (tid & 15) * 4; const int sc = d.mapped ? incol_map(d.n0 + n4) : d.n0 + n4;
    v0 = (f32x4){0.f, 0.f, 0.f, 0.f}; v1 = v0;
    if (sc >= 0) { v0 = *(const f32x4*)(d.src + (size_t)(d.k0 + kk) * d.ld + sc); v1 = *(const f32x4*)(d.src + (size_t)(d.k0 + kk + 32) * d.ld + sc); }
}
__device__ __forceinline__ void wtrans_all(const Frame& F) {
    LAS float* tile = (LAS float*)(F.lds + LDS_GEN); const int tid = F.tid;
    int t = F.bid; if (t >= WT_TOTAL) return;
    WTile d = wt_desc(F, t); f32x4 v0, v1; wt_load(d, tid, v0, v1);
#pragma unroll 1
    for (;;) {
        const int tn = t + F.G; WTile dn = d; f32x4 n0 = v0, n1 = v1;
        if (tn < WT_TOTAL) { dn = wt_desc(F, tn); wt_load(dn, tid, n0, n1); }
        { const int kk = tid >> 4, n4 = (tid & 15) * 4;
#pragma unroll
          for (int e = 0; e < 4; ++e) { tile[kk * 65 + n4 + e] = v0[e]; tile[(kk + 32) * 65 + n4 + e] = v1[e]; } }
        __syncthreads();
        { const int nn = tid >> 3, k8 = (tid & 7) * 8; h8 o;
#pragma unroll
          for (int e = 0; e < 8; ++e) o[e] = (_Float16)tile[(k8 + e) * 65 + nn];
          *(h8*)(d.dst + (size_t)(d.n0 + nn) * d.K + d.k0 + k8) = o; }
        __syncthreads();
        if (tn >= WT_TOTAL) break;
        t = tn; d = dn; v0 = n0; v1 = n1;
    }
}
template <int MODE> __device__ __forceinline__ void norm_to_abuf(const Frame& F, const float* gain) {
    _Float16* abuf = (_Float16*)(F.ws + WS_ABUF); const float* hmeta = (const float*)(F.ws + WS_HMETA);
    const int nw = F.G * 8;
    for (int r = F.bid * 8 + F.wave; r < MP; r += nw) {
        _Float16* dst = abuf + (size_t)r * DM;
        if (r >= MV) { const h4 z = {(_Float16)0.f, (_Float16)0.f, (_Float16)0.f, (_Float16)0.f};
#pragma unroll
            for (int j = 0; j < 4; ++j) *(h4*)(dst + j * 256 + F.lane * 4) = z; continue; }
        const float* src = MODE == 0 ? (r < MR ? F.x + (size_t)r * DM : F.meta + (size_t)((r - MR) & 15) * DM) : (r < MR ? F.out + (size_t)r * DM : hmeta + (size_t)(r - MR) * DM);
        f32x4 v[4]; float ss = 0.f;
#pragma unroll
        for (int j = 0; j < 4; ++j) { v[j] = *(const f32x4*)(src + j * 256 + F.lane * 4); ss += (v[j][0] * v[j][0] + v[j][1] * v[j][1]) + (v[j][2] * v[j][2] + v[j][3] * v[j][3]); }
        ss = wave_sum(ss, F.lane); const float rstd = rsqrtf(ss * (1.0f / DM) + 1e-6f);
#pragma unroll
        for (int j = 0; j < 4; ++j) { const f32x4 g = *(const f32x4*)(gain + j * 256 + F.lane * 4); h4 o;
#pragma unroll
            for (int e = 0; e < 4; ++e) o[e] = (_Float16)(v[j][e] * rstd * g[e]);
            *(h4*)(dst + j * 256 + F.lane * 4) = o; }
    }
}
__device__ __forceinline__ void final_norm(const Frame& F) {
    const int nw = F.G * 8;
    for (int r = F.bid * 8 + F.wave; r < MR; r += nw) {
        float* p = F.out + (size_t)r * DM; f32x4 v[4]; float ss = 0.f;
#pragma unroll
        for (int j = 0; j < 4; ++j) { v[j] = *(const f32x4*)(p + j * 256 + F.lane * 4); ss += (v[j][0] * v[j][0] + v[j][1] * v[j][1]) + (v[j][2] * v[j][2] + v[j][3] * v[j][3]); }
        ss = wave_sum(ss, F.lane); const float rstd = rsqrtf(ss * (1.0f / DM) + 1e-6f);
#pragma unroll
        for (int j = 0; j < 4; ++j) { const f32x4 g = *(const f32x4*)(F.final_norm + j * 256 + F.lane * 4); *(f32x4*)(p + j * 256 + F.lane * 4) = v[j] * rstd * g; }
    }
}
__device__ __forceinline__ void prologue(const Frame& F) {
    const int gtid = F.bid * NTHREADS + F.tid, gsz = F.G * NTHREADS;
    float* hmeta = (float*)(F.ws + WS_HMETA);
    for (int i = gtid; i < 256 * DM / 4; i += gsz) { const int row = i / (DM / 4), c4 = i % (DM / 4); f32x4 v = {0.f, 0.f, 0.f, 0.f}; if (row < NB * NMETA) v = *(const f32x4*)(F.meta + (size_t)(row & 15) * DM + c4 * 4); *(f32x4*)(hmeta + (size_t)row * DM + c4 * 4) = v; }
    f32x2* rope = (f32x2*)(F.ws + WS_ROPE);
    for (int i = gtid; i < TLEN * 32; i += gsz) { const int t = i >> 5, d = i & 31; const double rev = (double)t * ROPE_REV[d]; const float fr = (float)(rev - __builtin_floor(rev)); f32x2 cs; cs.x = __builtin_amdgcn_cosf(fr); cs.y = __builtin_amdgcn_sinf(fr); rope[i] = cs; }
    wtrans_all(F);
    norm_to_abuf<0>(F, F.norm_mix);
}
__device__ __forceinline__ int crow(int i, int h) { return (i & 3) + 8 * (i >> 2) + 4 * h; }
constexpr size_t WS_SCR = WS_U;
template <bool FROM_SCR> __device__ __forceinline__ void skinny_task(const unsigned char* A, int lda_bytes, const float* scr, const _Float16* Bt, int K, int n0, int k0, float* dst, int ldd, int lane) {
    const int r = lane & 31, h = lane >> 5;
    f32x16 acc;
#pragma unroll
    for (int i = 0; i < 16; ++i) acc[i] = 0.f;
#pragma unroll 1
    for (int kc = 0; kc < 4; ++kc) {
    h8 a[4], bb[4];
#pragma unroll
    for (int s = 0; s < 4; ++s) {
        const int k = k0 + 64 * kc + 16 * s + 8 * h;
        if (FROM_SCR) { const f32x4 x0 = *(const f32x4*)(scr + (size_t)r * DFF + k), x1 = *(const f32x4*)(scr + (size_t)r * DFF + k + 4);
#pragma unroll
            for (int e = 0; e < 4; ++e) { const float u = fmaxf(x0[e], 0.f), v = fmaxf(x1[e], 0.f); a[s][e] = (_Float16)(u * u); a[s][4 + e] = (_Float16)(v * v); } }
        else a[s] = *(const h8*)(A + (size_t)(MR + r) * lda_bytes + (size_t)k * 2);
        bb[s] = *(const h8*)(Bt + (size_t)(n0 + r) * K + k);
    }
#pragma unroll
    for (int s = 0; s < 4; ++s) acc = __builtin_amdgcn_mfma_f32_32x32x16_f16(a[s], bb[s], acc, 0, 0, 0);
    }
#pragma unroll
    for (int i = 0; i < 16; ++i) atomicAdd(dst + (size_t)crow(i, h) * ldd + n0 + r, acc[i]);
}
template <int MODE> __device__ __forceinline__ void skinny_meta(const Frame& F, const unsigned char* wl) {
    const int ntn = MODE == 1 ? 128 : 32, nks = MODE == 2 ? 16 : 4, ntask = ntn * nks;
    float* hmeta = (float*)(F.ws + WS_HMETA); float* scr = (float*)(F.ws + WS_SCR);
#pragma unroll 1
    for (int task = F.bid * 8 + F.wave; task < ntask; task += F.G * 8) {
        const int nt = task % ntn, ks = task / ntn;
        if (MODE == 0) skinny_task<false>(F.ws + WS_ABUF, DM * 2, nullptr, (const _Float16*)(wl + W_OUT_OFF), DM, nt * 32, ks * 256, hmeta, DM, F.lane);
        if (MODE == 1) skinny_task<false>(F.ws + WS_ABUF, DM * 2, nullptr, (const _Float16*)(wl + W_FF1_OFF), DM, nt * 32, ks * 256, scr, DFF, F.lane);
        if (MODE == 2) skinny_task<true>(nullptr, 0, scr, (const _Float16*)(wl + W_FF2_OFF), DFF, nt * 32, ks * 256, hmeta, DM, F.lane);
    }
}
__device__ __forceinline__ void zero_scr(const Frame& F) {
    f32x4* p = (f32x4*)(F.ws + WS_SCR); float z0 = 0.f; asm volatile("" : "+v"(z0)); const f32x4 z = {z0, z0, z0, z0};
    for (int i = F.bid * NTHREADS + F.tid; i < 32 * DFF / 4; i += F.G * NTHREADS) p[i] = z;
}
__device__ __forceinline__ void zero_abuf(const Frame& F) {
    u32x4* p = (u32x4*)(F.ws + WS_ABUF); const u32x4 z = {0u, 0u, 0u, 0u};
    for (size_t i = (size_t)F.bid * NTHREADS + F.tid; i < (size_t)MP * DM * 2 / 16; i += (size_t)F.G * NTHREADS) p[i] = z;
}

typedef short bf16x8v __attribute__((ext_vector_type(8)));
__constant__ unsigned char BUCKET_LUT[128] = {0, 1, 2, 3, 4, 5, 6, 7, 8, 9, 10, 11, 12, 13, 14, 15, 16, 16, 16, 17, 17, 18, 18, 18, 19, 19, 19, 20, 20, 20, 20, 21, 21, 21, 21, 22, 22, 22, 22, 22, 23, 23, 23, 23, 23, 23, 24, 24, 24, 24, 24, 24, 25, 25, 25, 25, 25, 25, 25, 26, 26, 26, 26, 26, 26, 26, 26, 27, 27, 27, 27, 27, 27, 27, 27, 27, 27, 28, 28, 28, 28, 28, 28, 28, 28, 28, 28, 29, 29, 29, 29, 29, 29, 29, 29, 29, 29, 29, 29, 30, 30, 30, 30, 30, 30, 30, 30, 30, 30, 30, 30, 30, 30, 31, 31, 31, 31, 31, 31, 31, 31, 31, 31, 31, 31, 31, 31, 31};
__device__ __forceinline__ bf16x8v pack_p(const f32x16& x, int s) {
    u32x4 p; p.x = cvt_pk_bf16(x[8 * s + 0], x[8 * s + 1]); p.y = cvt_pk_bf16(x[8 * s + 2], x[8 * s + 3]); p.z = cvt_pk_bf16(x[8 * s + 4], x[8 * s + 5]); p.w = cvt_pk_bf16(x[8 * s + 6], x[8 * s + 7]);
    return __builtin_bit_cast(bf16x8v, p);
}
#ifndef STAGGER
#define STAGGER 0
#endif
constexpr int TK = 128;
__device__ __forceinline__ bf16x8v vt_frag(LAS unsigned char* vimg, int dblk, int keybase, int s, int lane) {
    const int h = lane >> 5, blk = (lane >> 4) & 1, i16 = lane & 15, q = i16 >> 2, p = i16 & 3;
    LAS unsigned char* a = vimg + dblk * (TK * 64) + (keybase + 16 * s + 4 * h + q) * 64 + (16 * blk + 4 * p) * 2;
    const s16x4 lo = __builtin_amdgcn_ds_read_tr16_b64_v4i16((LAS s16x4*)a);
    const s16x4 hi = __builtin_amdgcn_ds_read_tr16_b64_v4i16((LAS s16x4*)(a + 8 * 64));
    return __builtin_shufflevector(lo, hi, 0, 1, 2, 3, 4, 5, 6, 7);
}

constexpr int KS_PITCH = 144;
constexpr int KBUF = TK * KS_PITCH, VBUF = 2 * TK * 64, B_KS = 0, B_VS = 4 * KBUF, B_LUT = B_VS + 4 * VBUF, B_END = B_LUT + 512;
__device__ __forceinline__ void mixB_unit(const Frame& F, int l, int b, int hh, int qblk, float lam, float oscale) {
    LAS unsigned char* L = F.lds + LDS_GEN;
    int lane_; { unsigned z0_ = 0u; asm volatile("" : "+s"(z0_)); lane_ = (int)__builtin_amdgcn_mbcnt_hi(~0u, __builtin_amdgcn_mbcnt_lo(~0u, z0_)); asm volatile("" : "+v"(lane_)); }
    const int lane = lane_, wave = F.wave, tid = wave * 64 + lane, r = lane & 31, h = lane >> 5;
    const unsigned char* proj = F.ws + WS_PROJ;
    const _Float16* QB = (const _Float16*)(proj + PJ_QB); const unsigned char* KB = proj + PJ_KB; const unsigned char* VB = proj + PJ_VB;
    const unsigned* kmax = (const unsigned*)(F.ws + WS_CTL) + CW_KMAX + 32 * l + 16;
    const bool meta_u = qblk < 0;
    const int qrow0 = meta_u ? MR + b * NMETA : b * SEQ + qblk * 256;
    const int qpos0 = meta_u ? 0 : NMETA + qblk * 256;
    const int nreal = meta_u ? 0 : 2 * qblk + 2;
    const int wq0 = 32 * wave;
    const bool wave_on = meta_u ? (wave == 0) : true;
    const int my_row = wave_on ? qrow0 + wq0 + r : qrow0, my_pos = qpos0 + wq0 + r;
    __syncthreads();
    if (tid < 128) ((LAS float*)(L + B_LUT))[tid] = F.rel_bias[BUCKET_LUT[tid] * 12 + 8 + hh] * LOG2E;
    float bmax = (lane < 32) ? F.rel_bias[lane * 12 + 8 + hh] * LOG2E : -1e30f;
    bmax = fmaxf(bmax, sx<16>(bmax, lane)); bmax = fmaxf(bmax, sx<8>(bmax, lane)); bmax = fmaxf(bmax, sx<4>(bmax, lane)); bmax = fmaxf(bmax, sx<2>(bmax, lane)); bmax = fmaxf(bmax, sx<1>(bmax, lane));
    bmax = bcast0(bmax);
    const float bfar = F.rel_bias[31 * 12 + 8 + hh] * LOG2E;
    h8 qf[2][2]; float mref[2]; bool safe = true;
#pragma unroll
    for (int c = 0; c < 2; ++c) {
        float n2 = 0.f;
#pragma unroll
        for (int s = 0; s < 2; ++s) { qf[c][s] = *(const h8*)(QB + (size_t)my_row * 256 + hh * 64 + c * 32 + 16 * s + 8 * h);
#pragma unroll
            for (int j = 0; j < 8; ++j) { const float v = (float)qf[c][s][j]; n2 += v * v; } }
        n2 = hsum32(n2, lane);
        mref[c] = sqrtf(n2 * __uint_as_float(kmax[hh * 2 + c])) * 1.002f + bmax;
        safe = safe && (mref[c] - bfar < 60.0f);
    }
    safe = __all(safe);
    if (safe) { mref[0] = bfar; mref[1] = bfar; }
    f32x16 O[2][2]; float lsum[2] = {0.f, 0.f};
#pragma unroll
    for (int c = 0; c < 2; ++c)
#pragma unroll
        for (int d = 0; d < 2; ++d)
#pragma unroll
            for (int i = 0; i < 16; ++i) O[c][d][i] = 0.f;
    const int skey = tid >> 3, sch = tid & 7;
    const unsigned kdst = skey * KS_PITCH + sch * 16, vdst = (sch >> 2) * (TK * 64) + skey * 64 + (sch & 3) * 16;
    const int ntiles = 1 + nreal;
    auto tile_row0 = [&](int t) -> int { return t == 0 ? MR + b * NMETA : b * SEQ + (t - 1) * TK; };
    u32x4 kreg[2], vreg[2];
#pragma unroll
    for (int j = 0; j < 2; ++j) { const size_t rr = (size_t)(tile_row0(0) + skey + 64 * j); kreg[j] = *(const u32x4*)(KB + rr * 512 + hh * 128 + sch * 16); vreg[j] = *(const u32x4*)(VB + rr * 512 + hh * 128 + sch * 16); }
#pragma unroll
    for (int j = 0; j < 2; ++j) { *(LAS u32x4*)(L + B_KS + kdst + j * 64 * KS_PITCH) = kreg[j]; *(LAS u32x4*)(L + B_VS + vdst + j * 64 * 64) = vreg[j]; }
    if (ntiles > 1) {
#pragma unroll
        for (int j = 0; j < 2; ++j) { const size_t rr = (size_t)(tile_row0(1) + skey + 64 * j); kreg[j] = *(const u32x4*)(KB + rr * 512 + hh * 128 + sch * 16); vreg[j] = *(const u32x4*)(VB + rr * 512 + hh * 128 + sch * 16); }
#pragma unroll
        for (int j = 0; j < 2; ++j) { *(LAS u32x4*)(L + B_KS + KBUF + kdst + j * 64 * KS_PITCH) = kreg[j]; *(LAS u32x4*)(L + B_VS + VBUF + vdst + j * 64 * 64) = vreg[j]; }
    }
    __syncthreads();
    const int wpos0 = qpos0 + wq0;
    if (wave >= 4) __builtin_amdgcn_s_setprio(1);
#pragma unroll 1
    for (int t = 0; t < ntiles; ++t) {
        const int buf = t & 3;
        if (STAGGER > 0 && wave >= 4 && (t & 1) == 0) __builtin_amdgcn_s_sleep(STAGGER);
        if (t + 2 < ntiles) {
#pragma unroll
            for (int j = 0; j < 2; ++j) { const size_t rr = (size_t)(tile_row0(t + 2) + skey + 64 * j); kreg[j] = *(const u32x4*)(KB + rr * 512 + hh * 128 + sch * 16); vreg[j] = *(const u32x4*)(VB + rr * 512 + hh * 128 + sch * 16); } }
        const int kpos0 = (t == 0) ? 0 : NMETA + (t - 1) * TK, nvalid = (t == 0) ? NMETA : TK;
        if (wave_on && kpos0 <= wpos0 + 31) {
            LAS unsigned char* Kb = L + B_KS + buf * KBUF; LAS unsigned char* Vb = L + B_VS + buf * VBUF;
#pragma unroll
            for (int sub = 0; sub < 4; ++sub) {
                if (sub * 32 >= nvalid || kpos0 + sub * 32 > wpos0 + 31) continue;
                const bool slow = !safe || (t == 0) || (kpos0 + sub * 32 + 31 > wpos0 - 128);
                h8 kfr[2][2]; bf16x8v vfr[2][2];
#pragma unroll
                for (int c = 0; c < 2; ++c)
#pragma unroll
                    for (int s = 0; s < 2; ++s) kfr[c][s] = *(const LAS h8*)(Kb + (sub * 32 + r) * KS_PITCH + (c * 32 + 16 * s + 8 * h) * 2);
#pragma unroll
                for (int d = 0; d < 2; ++d)
#pragma unroll
                    for (int s = 0; s < 2; ++s) vfr[d][s] = vt_frag(Vb, d, sub * 32, s, lane);
                __builtin_amdgcn_sched_barrier(0);
                f32x16 S[2];
#pragma unroll
                for (int c = 0; c < 2; ++c) {
#pragma unroll
                    for (int i = 0; i < 16; ++i) S[c][i] = 0.f;
#pragma unroll
                    for (int s = 0; s < 2; ++s) S[c] = __builtin_amdgcn_mfma_f32_32x32x16_f16(kfr[c][s], qf[c][s], S[c], 0, 0, 0);
                }
                if (slow) {
                    float bs[16];
#pragma unroll
                    for (int i = 0; i < 16; ++i) { const int dist = my_pos - (kpos0 + sub * 32 + crow(i, h)); bs[i] = ((const LAS float*)(L + B_LUT))[min(max(dist, 0), 127)]; }
#pragma unroll
                    for (int i = 0; i < 16; ++i) {
                        const int kidx = sub * 32 + crow(i, h), dist = my_pos - (kpos0 + kidx);
                        const bool ok = dist >= 0 && kidx < nvalid;
#pragma unroll
                        for (int c = 0; c < 2; ++c) { const float e = __builtin_amdgcn_exp2f(fminf(S[c][i] + (bs[i] - mref[c]), 80.f)); S[c][i] = ok ? e : 0.f; }
                    }
                }
#pragma unroll
                for (int c = 0; c < 2; ++c) {
                    __builtin_amdgcn_sched_barrier(0);
                    if (!slow) {
#pragma unroll
                        for (int i = 0; i < 16; ++i) S[c][i] = __builtin_amdgcn_exp2f(S[c][i]); }
                    const float a0 = (S[c][0] + S[c][1]) + (S[c][2] + S[c][3]), a1 = (S[c][4] + S[c][5]) + (S[c][6] + S[c][7]);
                    const float a2 = (S[c][8] + S[c][9]) + (S[c][10] + S[c][11]), a3 = (S[c][12] + S[c][13]) + (S[c][14] + S[c][15]);
                    lsum[c] += (a0 + a1) + (a2 + a3);
                    bf16x8v pf[2]; pf[0] = pack_p(S[c], 0); pf[1] = pack_p(S[c], 1);
                    __builtin_amdgcn_sched_barrier(0);
#pragma unroll
                    for (int d = 0; d < 2; ++d)
#pragma unroll
                        for (int s = 0; s < 2; ++s) O[c][d] = __builtin_amdgcn_mfma_f32_32x32x16_bf16(vfr[d][s], pf[s], O[c][d], 0, 0, 0);
                }
            }
        }
        if (t + 2 < ntiles) {
#pragma unroll
            for (int j = 0; j < 2; ++j) { *(LAS u32x4*)(L + B_KS + (buf ^ 2) * KBUF + kdst + j * 64 * KS_PITCH) = kreg[j]; *(LAS u32x4*)(L + B_VS + (buf ^ 2) * VBUF + vdst + j * 64 * 64) = vreg[j]; } }
        if (t & 1) { if (STAGGER > 0 && wave < 4) __builtin_amdgcn_s_sleep(STAGGER); __syncthreads(); }
    }
    __builtin_amdgcn_s_setprio(0);
    if (wave_on) {
        const float l0 = hsum32(lsum[0], lane), l1 = hsum32(lsum[1], lane);
        const float i0 = 1.0f / l0, i1 = lam / l1;
        float o[2][16], ss = 0.f;
#pragma unroll
        for (int d = 0; d < 2; ++d)
#pragma unroll
            for (int i = 0; i < 16; ++i) { o[d][i] = O[0][d][i] * i0 - O[1][d][i] * i1; ss += o[d][i] * o[d][i]; }
        ss = hsum32(ss, lane);
        const float rstd = rsqrtf(ss * (1.0f / 64.0f) + 1e-6f) * oscale;
        const float* gn = F.diff_norm + l * 64;
        if (!meta_u || r < NMETA) {
            _Float16* dst = (_Float16*)(F.ws + WS_ABUF) + (size_t)my_row * DM + 512 + hh * 64;
#pragma unroll
            for (int d = 0; d < 2; ++d)
#pragma unroll
                for (int g4 = 0; g4 < 4; ++g4) { const int d0 = 32 * d + 8 * g4 + 4 * h; const f32x4 gv = *(const f32x4*)(gn + d0);
                    u32x2 w; w.x = cvt_pk_f16(o[d][4 * g4 + 0] * rstd * gv[0], o[d][4 * g4 + 1] * rstd * gv[1]); w.y = cvt_pk_f16(o[d][4 * g4 + 2] * rstd * gv[2], o[d][4 * g4 + 3] * rstd * gv[3]);
                    *(u32x2*)(dst + d0) = w; }
        }
    }
}
__device__ __forceinline__ void mixB_phase(const Frame& F, int l) {
    const float* lp = F.diff_lambda + l * 128;
    float a = (F.lane < 32) ? lp[F.lane] * lp[32 + F.lane] : 0.f, c = (F.lane < 32) ? lp[64 + F.lane] * lp[96 + F.lane] : 0.f;
    a = wave_sum(a, F.lane); c = wave_sum(c, F.lane);
    const float linit = 0.8f - 0.6f * expf(-0.3f * (float)l);
    const float lam = expf(a) - expf(c) + linit, oscale = 1.0f - linit;
#pragma unroll 1
    for (int cidx = F.bid; cidx < 256; cidx += F.G) { const int bh = cidx & 7, i = cidx >> 3;
#pragma unroll 1
        for (int k = 0; k < 3; ++k) { if (k == 2 && cidx >= 8) break; mixB_unit(F, l, bh >> 2, bh & 3, k == 0 ? 63 - i : (k == 1 ? i : -1), lam, oscale); }
    }
}
__device__ __forceinline__ h8 tr_frag_nat(LAS unsigned char* img_blk, int rowbase, int s, int lane) {
    const int h = lane >> 5, blk = (lane >> 4) & 1, i16 = lane & 15, q = i16 >> 2, p = i16 & 3;
    LAS unsigned char* a = img_blk + (rowbase + 16 * s + 8 * h + q) * 64 + (16 * blk + 4 * p) * 2;
    const s16x4 lo = __builtin_amdgcn_ds_read_tr16_b64_v4i16((LAS s16x4*)a);
    const s16x4 hi = __builtin_amdgcn_ds_read_tr16_b64_v4i16((LAS s16x4*)(a + 4 * 64));
    return __builtin_bit_cast(h8, __builtin_shufflevector(lo, hi, 0, 1, 2, 3, 4, 5, 6, 7));
}
__device__ __forceinline__ h8 tr_frag_krow(LAS unsigned char* img_blk, int rowbase, int s, int lane) {
    const int h = lane >> 5, blk = (lane >> 4) & 1, i16 = lane & 15, q = i16 >> 2, p = i16 & 3;
    LAS unsigned char* a = img_blk + (rowbase + 16 * s + 4 * h + q) * 64 + (16 * blk + 4 * p) * 2;
    const s16x4 lo = __builtin_amdgcn_ds_read_tr16_b64_v4i16((LAS s16x4*)a);
    const s16x4 hi = __builtin_amdgcn_ds_read_tr16_b64_v4i16((LAS s16x4*)(a + 8 * 64));
    return __builtin_bit_cast(h8, __builtin_shufflevector(lo, hi, 0, 1, 2, 3, 4, 5, 6, 7));
}
__device__ __forceinline__ float ret_log2gamma(int hc) { return log2f(1.0f - exp2f(-5.0f - (float)hc)); }
__device__ __forceinline__ h8 scale_h8(const h8& v, float sc) { h8 o;
#pragma unroll
    for (int e = 0; e < 8; ++e) o[e] = (_Float16)((float)v[e] * sc);
    return o; }

__device__ __forceinline__ void mixC1_unit(const Frame& F, int b, int hp, int c) {
    LAS unsigned char* L = F.lds + LDS_GEN;
    const int tid = F.tid, lane = F.lane, wave = F.wave;
    const unsigned char* proj = F.ws + WS_PROJ;
    const int row0 = c == 0 ? MR + b * NMETA : b * SEQ + 128 * (c - 1), Lc = c == 0 ? NMETA : 128;
    __syncthreads();
#pragma unroll 1
    for (int idx = tid; idx < 4096; idx += NTHREADS) {
        const int head = idx >> 11, arr = (idx >> 10) & 1, j = (idx >> 3) & 127, ch = idx & 7, hc = 2 * hp + head;
        h8 v;
#pragma unroll
        for (int e = 0; e < 8; ++e) v[e] = (_Float16)0.f;
        if (j < Lc) { v = *(const h8*)(proj + (arr ? PJ_VC : PJ_KC) + (size_t)(row0 + j) * 512 + hc * 128 + ch * 16);
            if (arr) v = scale_h8(v, exp2f((float)(Lc - 1 - j) * ret_log2gamma(hc))); }
        *(LAS h8*)(L + head * 32768 + arr * 16384 + (ch >> 2) * 8192 + j * 64 + (ch & 3) * 16) = v;
    }
    __syncthreads();
    const int head = wave >> 2, mb = (wave >> 1) & 1, nb = wave & 1, r = lane & 31, h = lane >> 5;
    f32x16 acc;
#pragma unroll
    for (int i = 0; i < 16; ++i) acc[i] = 0.f;
#pragma unroll
    for (int s = 0; s < 8; ++s) { const h8 a = tr_frag_nat(L + head * 32768 + mb * 8192, 0, s, lane), bb = tr_frag_nat(L + head * 32768 + 16384 + nb * 8192, 0, s, lane);
        acc = __builtin_amdgcn_mfma_f32_32x32x16_f16(a, bb, acc, 0, 0, 0); }
    float* U = (float*)(F.ws + WS_U) + ((size_t)((b * 4 + 2 * hp + head) * 129 + c)) * 4096;
#pragma unroll
    for (int i = 0; i < 16; ++i) U[(32 * mb + crow(i, h)) * 64 + 32 * nb + r] = acc[i];
}
__device__ __forceinline__ void mixC1_phase(const Frame& F) {
#pragma unroll 1
    for (int u = F.bid; u < NB * 2 * 129; u += F.G) { const int c = u % 129, bh = u / 129; mixC1_unit(F, bh >> 1, bh & 1, c); }
}
__device__ __forceinline__ void mixC_scan(const Frame& F) {
    if (F.tid >= 128) return;
    const int e = F.bid * 128 + F.tid;
    if (e >= NB * 4 * 4096) return;
    const int bh = e >> 12, el = e & 4095, hc = bh & 3;
    const float lg = ret_log2gamma(hc), g128 = exp2f(128.f * lg), g16 = exp2f(16.f * lg);
    const float* U = (const float*)(F.ws + WS_U) + (size_t)bh * 129 * 4096 + el; float* S = (float*)(F.ws + WS_S) + (size_t)bh * 129 * 4096 + el;
    float st = U[0];
    S[4096] = st;
#pragma unroll 1
    for (int c0 = 1; c0 < 128; c0 += 16) {
        float u[16];
#pragma unroll
        for (int k = 0; k < 16; ++k) u[k] = (c0 + k < 128) ? U[(size_t)(c0 + k) * 4096] : 0.f;
#pragma unroll
        for (int k = 0; k < 16; ++k) if (c0 + k < 128) { st = st * g128 + u[k]; S[(size_t)(c0 + k + 1) * 4096] = st; }
    }
    (void)g16;
}
constexpr int C2_KI = 0, C2_VI = 128 * KS_PITCH, C2_ST = C2_VI + 16384, C2_HEAD = C2_ST + 64 * KS_PITCH;
__device__ __forceinline__ void mixC2_unit(const Frame& F, int l, int b, int hp, int c) {
    LAS unsigned char* L = F.lds + LDS_GEN;
    const int tid = F.tid, lane = F.lane, wave = F.wave, r = lane & 31, h = lane >> 5;
    const unsigned char* proj = F.ws + WS_PROJ;
    const int row0 = c == 0 ? MR + b * NMETA : b * SEQ + 128 * (c - 1), Lc = c == 0 ? NMETA : 128;
    __syncthreads();
#pragma unroll 1
    for (int idx = tid; idx < 4096; idx += NTHREADS) {
        const int head = idx >> 11, arr = (idx >> 10) & 1, j = (idx >> 3) & 127, ch = idx & 7, hc = 2 * hp + head;
        h8 v;
#pragma unroll
        for (int e = 0; e < 8; ++e) v[e] = (_Float16)0.f;
        if (j < Lc) v = *(const h8*)(proj + (arr ? PJ_VC : PJ_KC) + (size_t)(row0 + j) * 512 + hc * 128 + ch * 16);
        if (arr) *(LAS h8*)(L + head * C2_HEAD + C2_VI + (ch >> 2) * 8192 + j * 64 + (ch & 3) * 16) = v;
        else     *(LAS h8*)(L + head * C2_HEAD + C2_KI + j * KS_PITCH + ch * 16) = v;
    }
    if (c > 0) {
#pragma unroll 1
        for (int idx = tid; idx < 2 * 4096; idx += NTHREADS) { const int head = idx >> 12, el = idx & 4095, dk = el >> 6, dv = el & 63;
            const float v = ((const float*)(F.ws + WS_S))[((size_t)((b * 4 + 2 * hp + head) * 129 + c)) * 4096 + el];
            *(LAS _Float16*)(L + head * C2_HEAD + C2_ST + dv * KS_PITCH + dk * 2) = (_Float16)v; }
    }
    __syncthreads();
    const int head = wave >> 2, wq = wave & 3, hc = 2 * hp + head;
    if (wq * 32 < Lc) {
        LAS unsigned char* Hb = L + head * C2_HEAD;
        const int qi = wq * 32 + r, my_row = row0 + qi;
        const float lg = ret_log2gamma(hc);
        h8 qf[4];
#pragma unroll
        for (int s = 0; s < 4; ++s) qf[s] = *(const h8*)(proj + PJ_QC + (size_t)my_row * 512 + hc * 128 + (16 * s + 8 * h) * 2);
        f32x16 O[2];
#pragma unroll
        for (int d = 0; d < 2; ++d)
#pragma unroll
            for (int i = 0; i < 16; ++i) O[d][i] = 0.f;
        if (c > 0) {
#pragma unroll
            for (int d = 0; d < 2; ++d)
#pragma unroll
                for (int s = 0; s < 4; ++s) { const h8 a = *(const LAS h8*)(Hb + C2_ST + (32 * d + r) * KS_PITCH + (16 * s + 8 * h) * 2);
                    O[d] = __builtin_amdgcn_mfma_f32_32x32x16_f16(a, qf[s], O[d], 0, 0, 0); }
            const float qd = exp2f((float)(qi + 1) * lg);
#pragma unroll
            for (int d = 0; d < 2; ++d)
#pragma unroll
                for (int i = 0; i < 16; ++i) O[d][i] *= qd;
        }
#pragma unroll 1
        for (int jb = 0; jb <= wq; ++jb) {
            f32x16 S;
#pragma unroll
            for (int i = 0; i < 16; ++i) S[i] = 0.f;
#pragma unroll
            for (int s = 0; s < 4; ++s) { const h8 kf = *(const LAS h8*)(Hb + C2_KI + (32 * jb + r) * KS_PITCH + (16 * s + 8 * h) * 2);
                S = __builtin_amdgcn_mfma_f32_32x32x16_f16(kf, qf[s], S, 0, 0, 0); }
#pragma unroll
            for (int i = 0; i < 16; ++i) { const int dd = qi - (32 * jb + crow(i, h)); S[i] = dd >= 0 ? S[i] * exp2f((float)dd * lg) : 0.f; }
            h8 pf[2];
#pragma unroll
            for (int s = 0; s < 2; ++s) { u32x4 p; p.x = cvt_pk_f16(S[8 * s + 0], S[8 * s + 1]); p.y = cvt_pk_f16(S[8 * s + 2], S[8 * s + 3]); p.z = cvt_pk_f16(S[8 * s + 4], S[8 * s + 5]); p.w = cvt_pk_f16(S[8 * s + 6], S[8 * s + 7]); pf[s] = __builtin_bit_cast(h8, p); }
#pragma unroll
            for (int d = 0; d < 2; ++d)
#pragma unroll
                for (int s = 0; s < 2; ++s) { const h8 vf = tr_frag_krow(Hb + C2_VI + d * 8192, 32 * jb, s, lane);
                    O[d] = __builtin_amdgcn_mfma_f32_32x32x16_f16(vf, pf[s], O[d], 0, 0, 0); }
        }
        float ss = 0.f;
#pragma unroll
        for (int d = 0; d < 2; ++d)
#pragma unroll
            for (int i = 0; i < 16; ++i) ss += O[d][i] * O[d][i];
        ss = hsum32(ss, lane);
        const float rstd = rsqrtf(ss * (1.0f / 64.0f) + 1e-6f);
        if (qi < Lc) {
            const float* gn = F.ret_norm + l * 256 + hc * 64;
            const _Float16* gc = (const _Float16*)(proj + PJ_GC) + (size_t)my_row * 256 + hc * 64;
            _Float16* dst = (_Float16*)(F.ws + WS_ABUF) + (size_t)my_row * DM + 768 + hc * 64;
#pragma unroll
            for (int d = 0; d < 2; ++d)
#pragma unroll
                for (int g4 = 0; g4 < 4; ++g4) { const int d0 = 32 * d + 8 * g4 + 4 * h; const f32x4 gv = *(const f32x4*)(gn + d0); const h4 gg = *(const h4*)(gc + d0);
                    float o[4];
#pragma unroll
                    for (int e = 0; e < 4; ++e) { const float g = (float)gg[e]; o[e] = O[d][4 * g4 + e] * rstd * gv[e] * (g / (1.0f + __expf(-g))); }
                    u32x2 w; w.x = cvt_pk_f16(o[0], o[1]); w.y = cvt_pk_f16(o[2], o[3]); *(u32x2*)(dst + d0) = w; }
        }
    }
}
__device__ __forceinline__ void mixC2_phase(const Frame& F, int l) {
#pragma unroll 1
    for (int u = F.bid; u < NB * 2 * 129; u += F.G) { const int c = u % 129, bh = u / 129; mixC2_unit(F, l, bh >> 1, bh & 1, c); }
}
constexpr int IDX_HIST = 0, IDX_STATS = 16512, IDX_INFO = 18816, IDX_CCNT = 19072, IDX_MASK = 19456, IDX_CAND = 85248, IDX_Q = IDX_CAND + 32 * 128 * 8, IDX_QPITCH = 1168, IDX_END = IDX_Q + 32 * IDX_QPITCH;
#ifndef PROBE_REP
#define PROBE_REP 0
#endif
#if PROBE_REP >= 40
#define PTS(v) do { __builtin_amdgcn_sched_barrier(0); v = (unsigned)__builtin_amdgcn_s_memtime(); __builtin_amdgcn_sched_barrier(0); } while (0)
#else
#define PTS(v) do {} while (0)
#endif
#if PROBE_REP >= 40 && PROBE_REP < 60
#define IPTS(v) PTS(v)
#else
#define IPTS(v) do {} while (0)
#endif
constexpr int IDX_CAP = 128, IDX_NBIN = 128, NSUB = 3;
static_assert(IDX_END + LDS_GEN <= LDS_BYTES, "indexer LDS");
struct KFrag { h8 v[4]; };
__device__ __forceinline__ KFrag idx_load_k(const unsigned char* krow_ptr, int h) { KFrag k;
#pragma unroll
    for (int s = 0; s < 4; ++s) k.v[s] = *(const h8*)(krow_ptr + (16 * s + 8 * h) * 2);
    return k; }
#define IDX_LOADQ(dst, hd) do { _Pragma("unroll") for (int s_ = 0; s_ < 4; ++s_) dst[s_] = *(const LAS h8*)(qimg_lane + ((hd) * 64 + 16 * s_) * 2); } while (0)
#define IDX_MFMA4(acc, q) do { _Pragma("unroll") for (int s_ = 0; s_ < 4; ++s_) acc = __builtin_amdgcn_mfma_f32_32x32x16_f16(kf.v[s_], q[s_], acc, 0, 0, 0); } while (0)
#define IDX_FMA(hd, S) do { _Pragma("unroll") for (int i_ = 0; i_ < 16; ++i_) sc[i_] = __builtin_fmaf(w[hd], __builtin_fabsf(S[i_]), sc[i_]); } while (0)
#define IDX_SB __builtin_amdgcn_sched_barrier(0)
__device__ __forceinline__ void idx_scores(const LAS unsigned char* qimg_lane, const float (&w)[8], const KFrag& kf, f32x16& sc) {
    h8 q[2][4]; f32x16 S[2];
    IDX_LOADQ(q[0], 8); IDX_SB;
#pragma unroll
    for (int i = 0; i < 16; ++i) sc[i] = 0.f;
    IDX_MFMA4(sc, q[0]); IDX_LOADQ(q[1], 0); IDX_SB;
#pragma unroll
    for (int hd = 0; hd < 8; ++hd) {
#pragma unroll
        for (int i = 0; i < 16; ++i) S[hd & 1][i] = 0.f;
        IDX_MFMA4(S[hd & 1], q[(hd + 1) & 1]);
        if (hd < 7) IDX_LOADQ(q[hd & 1], hd + 1);
        if (hd > 0) IDX_FMA(hd - 1, S[(hd - 1) & 1]);
        IDX_SB;
    }
    IDX_FMA(7, S[1]);
}
#define IDX_PIN(V) asm volatile("" : "+v"(V[0]), "+v"(V[1]), "+v"(V[2]), "+v"(V[3]), "+v"(V[4]), "+v"(V[5]), "+v"(V[6]), "+v"(V[7]), "+v"(V[8]), "+v"(V[9]), "+v"(V[10]), "+v"(V[11]), "+v"(V[12]), "+v"(V[13]), "+v"(V[14]), "+v"(V[15]))
#define IDX_MFMA4K(acc, q, KF) do { _Pragma("unroll") for (int s_ = 0; s_ < 4; ++s_) acc = __builtin_amdgcn_mfma_f32_32x32x16_f16(KF.v[s_], q[s_], acc, 0, 0, 0); } while (0)
#define IDX_FMA2(SC, hd, S) do { _Pragma("unroll") for (int i_ = 0; i_ < 16; ++i_) SC[i_] = __builtin_fmaf(w[hd], __builtin_fabsf(S[i_]), SC[i_]); } while (0)
__device__ __forceinline__ void idx_scores2(const LAS unsigned char* qimg_lane, const float (&w)[8], const KFrag& kfA, const KFrag& kfB, f32x16& scA, f32x16& scB) {
    h8 q[2][4]; f32x16 SA, SB;
    IDX_LOADQ(q[0], 8); IDX_SB;
#pragma unroll
    for (int i = 0; i < 16; ++i) { scA[i] = 0.f; scB[i] = 0.f; }
    IDX_MFMA4K(scA, q[0], kfA); IDX_MFMA4K(scB, q[0], kfB); IDX_LOADQ(q[1], 0); IDX_SB;
#pragma unroll
    for (int hd = 0; hd < 8; ++hd) {
#pragma unroll
        for (int i = 0; i < 16; ++i) SA[i] = 0.f;
        IDX_MFMA4K(SA, q[(hd + 1) & 1], kfA);
        if (hd > 0) { IDX_FMA2(scB, hd - 1, SB); IDX_PIN(scB); }
        IDX_SB;
#pragma unroll
        for (int i = 0; i < 16; ++i) SB[i] = 0.f;
        IDX_MFMA4K(SB, q[(hd + 1) & 1], kfB);
        if (hd < 7) IDX_LOADQ(q[hd & 1], hd + 1);
        IDX_FMA2(scA, hd, SA); IDX_PIN(scA);
        IDX_SB;
    }
    IDX_FMA2(scB, 7, SB);
}
template <int NS> __device__ __forceinline__ void idx_scoresN(const LAS unsigned char* qimg_lane, const float (&w)[8], KFrag (&kf)[NS], const unsigned char* const (&nextp)[NS], int h, f32x16 (&sc)[NS]) {
    h8 q[2][4]; f32x16 S[NS];
#if PROBE_REP == 30
    h8 zk = {0, 0, 0, 0, 0, 0, 0, 0}; asm volatile("" : "+v"(zk));
#endif
#if PROBE_REP == 31
    float wz = 0.f; asm volatile("" : "+v"(wz));
#define IDX_FMAZ(SC, S) do { _Pragma("unroll") for (int i_ = 0; i_ < 16; ++i_) SC[i_] = __builtin_fmaf(wz, __builtin_fabsf(S[i_]), SC[i_]); } while (0)
#else
#define IDX_FMAZ(SC, S) do {} while (0)
#endif
    IDX_LOADQ(q[0], 8); IDX_SB;
#pragma unroll
    for (int t = 0; t < NS; ++t) {
#pragma unroll
        for (int i = 0; i < 16; ++i) sc[t][i] = 0.f;
        IDX_MFMA4K(sc[t], q[0], kf[t]); }
    IDX_LOADQ(q[1], 0); IDX_SB;
#pragma unroll
    for (int hd = 0; hd < 8; ++hd) {
#pragma unroll
        for (int t = 0; t < NS; ++t) {
#pragma unroll
            for (int i = 0; i < 16; ++i) S[t][i] = 0.f;
            IDX_MFMA4K(S[t], q[(hd + 1) & 1], kf[t]);
#if PROBE_REP == 30
#pragma unroll
            for (int s_ = 0; s_ < 4; ++s_) S[t] = __builtin_amdgcn_mfma_f32_32x32x16_f16(zk, q[(hd + 1) & 1][s_], S[t], 0, 0, 0);
#endif
            if (t == 0 && hd < 7) IDX_LOADQ(q[hd & 1], hd + 1);
            if (hd == 7) kf[t] = idx_load_k(nextp[t], h);
            if (t > 0) { IDX_FMA2(sc[t - 1], hd, S[t - 1]); IDX_FMAZ(sc[t - 1], S[t - 1]); IDX_PIN(sc[t - 1]); }
            else if (hd > 0) { IDX_FMA2(sc[NS - 1], hd - 1, S[NS - 1]); IDX_FMAZ(sc[NS - 1], S[NS - 1]); IDX_PIN(sc[NS - 1]); }
            IDX_SB;
        }
    }
    IDX_FMA2(sc[NS - 1], 7, S[NS - 1]);
}
__device__ __forceinline__ int f_ord(float v) { const int i = __float_as_int(v); return i >= 0 ? i : (int)(0x80000000u - (unsigned)i); }
__device__ __forceinline__ float f_unord(int o) { return __int_as_float(o >= 0 ? o : (int)(0x80000000u - (unsigned)o)); }
__device__ __forceinline__ float idx_raw_edge(float B, float inv, float c0f) {
    if (!(B > -3.0e38f)) return -__builtin_inff();
    if (!(B < 3.0e38f)) return __builtin_inff();
    int lo = f_ord(-3.0e38f), hi = f_ord(3.0e38f);
#pragma unroll 1
    for (int it = 0; it < 34; ++it) { const int mid = lo + (int)(((unsigned)hi - (unsigned)lo) >> 1); if (__builtin_fmaf(f_unord(mid), inv, c0f) >= B) hi = mid; else lo = mid; }
    return f_unord(hi);
}
#define IDX_ACCBIT(m, s, t) asm("v_cmp_ge_f32 vcc, %1, %2\n\tv_addc_co_u32 %0, vcc, %0, %0, vcc" : "+v"(m) : "v"(s), "v"(t) : "vcc")
__device__ __forceinline__ int suffix_sum(int v, int lane) {
#pragma unroll
    for (int off = 1; off < 64; off <<= 1) { const int t = __builtin_amdgcn_ds_bpermute((lane + off) << 2, v); if (lane + off < 64) v += t; }
    return v;
}
__device__ __forceinline__ void mixA_index_unit(const Frame& F, int b, int g) {
    LAS unsigned char* L = F.lds + LDS_GEN;
    int lane_; { unsigned z0_ = 0u; asm volatile("" : "+s"(z0_)); lane_ = (int)__builtin_amdgcn_mbcnt_hi(~0u, __builtin_amdgcn_mbcnt_lo(~0u, z0_)); asm volatile("" : "+v"(lane_)); }
    int tid_ = F.wave * 64 + lane_; asm volatile("" : "+v"(tid_));
    const int tid = tid_, lane = lane_, wave = F.wave, r = lane & 31, h = lane >> 5;
    const unsigned char* proj = F.ws + WS_PROJ;
    const unsigned char* KI = proj + PJ_KI;
    const int nq = g == 0 ? NMETA : 32;
    const int qrow = g == 0 ? MR + b * NMETA + (r & 15) : b * SEQ + 32 * (g - 1) + r;
    const int tq0 = g == 0 ? 0 : NMETA + 32 * (g - 1);
    const bool qvalid = r < nq;
    auto ks_row0 = [&](int ks) -> int { return ks == 0 ? MR + b * NMETA : b * SEQ + 32 * (ks - 1); };
#if PROBE_REP >= 40 && PROBE_REP < 60
    unsigned accS = 0, accP = 0, accP2 = 0, accNC = 0, accNR = 0, tU0, tx0, tx1, tx2, tx3, tx4, tx5, tx6; IPTS(tU0);
#else
    unsigned tx0, tx1, tx2, tx3, tx4, tx5, tx6;
#endif
    __syncthreads();
    for (int i = tid; i < 32 * 129; i += NTHREADS) ((LAS unsigned*)(L + IDX_HIST))[i] = 0u;
    if (tid < 32) ((LAS unsigned*)(L + IDX_CCNT))[tid] = 0u;
    for (int i = tid; i < (g + 1) * 32; i += NTHREADS) ((LAS unsigned*)(L + IDX_MASK))[i] = 0u;
    auto krow = [&](int ks) -> const unsigned char* { return KI + (size_t)(ks_row0(ks <= g ? ks : g) + r) * 128; };
    const KFrag kf0 = idx_load_k(KI + (size_t)(b * SEQ + 32 * (wave & 3) + r) * 128, h);
    KFrag kf[NSUB];
#pragma unroll
    for (int u = 0; u < NSUB; ++u) kf[u] = idx_load_k(krow(NSUB * wave + u), h);
    float w[8];
    const LAS unsigned char* qf = L + IDX_Q + r * IDX_QPITCH + 8 * h * 2;
    { const float* WI = (const float*)(proj + PJ_WI) + (size_t)qrow * 8; const f32x4 w0 = *(const f32x4*)WI, w1 = *(const f32x4*)(WI + 4);
      w[0] = w0[0]; w[1] = w0[1]; w[2] = w0[2]; w[3] = w0[3]; w[4] = w1[0]; w[5] = w1[1]; w[6] = w1[2]; w[7] = w1[3]; }
    { const int qq = tid >> 4, dc = tid & 15; const int qr = g == 0 ? MR + b * NMETA + (qq & 15) : b * SEQ + 32 * (g - 1) + qq;
      const unsigned char* qsrc = proj + PJ_QI + (size_t)qr * 1024 + dc * 8; u32x2 qv[8];
#pragma unroll
      for (int hd = 0; hd < 8; ++hd) qv[hd] = *(const u32x2*)(qsrc + hd * 128);
      const float* WQ = (const float*)(proj + PJ_WI) + (size_t)qr * 8; const f32x4 wa = *(const f32x4*)WQ, wb = *(const f32x4*)(WQ + 4);
      const float wq[8] = {wa[0], wa[1], wa[2], wa[3], wb[0], wb[1], wb[2], wb[3]};
      float a4[4] = {0.f, 0.f, 0.f, 0.f};
#pragma unroll
      for (int hd = 0; hd < 8; ++hd) { const h4 q = __builtin_bit_cast(h4, qv[hd]);
#pragma unroll
          for (int e = 0; e < 4; ++e) a4[e] += wq[hd] * (float)q[e];
          *(LAS u32x2*)(L + IDX_Q + qq * IDX_QPITCH + hd * 128 + dc * 8) = qv[hd]; }
      u32x2 o; o.x = cvt_pk_f16(a4[0], a4[1]); o.y = cvt_pk_f16(a4[2], a4[3]);
      *(LAS u32x2*)(L + IDX_Q + qq * IDX_QPITCH + 1024 + dc * 8) = o; }
    __syncthreads();
    if (wave < 4) {
        f32x16 sc; idx_scores(qf, w, kf0, sc);
        float s1 = 0.f, s2 = 0.f;
#pragma unroll
        for (int i = 0; i < 16; ++i) { s1 += sc[i]; s2 += sc[i] * sc[i]; }
        s1 = hsum32(s1, lane); s2 = hsum32(s2, lane);
        if (h == 0) { ((LAS float*)(L + IDX_STATS))[(wave * 32 + r) * 2] = s1; ((LAS float*)(L + IDX_STATS))[(wave * 32 + r) * 2 + 1] = s2; }
    }
    __syncthreads();
    float c0f, inv;
    { float s1 = 0.f, s2 = 0.f;
#pragma unroll
      for (int k = 0; k < 4; ++k) { s1 += ((LAS float*)(L + IDX_STATS))[(k * 32 + r) * 2]; s2 += ((LAS float*)(L + IDX_STATS))[(k * 32 + r) * 2 + 1]; }
      const float mean = s1 * (1.0f / 128.0f), var = fmaxf(s2 * (1.0f / 128.0f) - mean * mean, 0.f), sd = fmaxf(sqrtf(var), 1e-12f);
      inv = (float)IDX_NBIN / (10.0f * sd); c0f = -(mean - 3.0f * sd) * inv; }
    LAS unsigned* hrow = (LAS unsigned*)(L + IDX_HIST) + r * 129;
    if (wave >= 4) __builtin_amdgcn_s_setprio(1);
    IPTS(tx0);
#if PROBE_REP == 12
    for (int rep12 = 0; rep12 < 2; ++rep12) { __syncthreads(); for (int i = tid; i < 32 * 129; i += NTHREADS) ((LAS unsigned*)(L + IDX_HIST))[i] = 0u; __syncthreads();
#else
    {
#endif
#pragma unroll 1
        for (int ks = NSUB * wave; ks <= g; ks += 8 * NSUB) {
            const unsigned char* nextp[NSUB];
#pragma unroll
            for (int u = 0; u < NSUB; ++u) nextp[u] = krow((ks + 8 * NSUB <= g ? ks + 8 * NSUB : NSUB * wave) + u);
#if PROBE_REP >= 40 && PROBE_REP < 60
            unsigned tb, tc, td; IPTS(tb);
#endif
            f32x16 scv[NSUB]; idx_scoresN<NSUB>(qf, w, kf, nextp, h, scv);
#if PROBE_REP >= 40 && PROBE_REP < 60
            IDX_PIN(scv[NSUB - 1]); IPTS(tc); accS += tc - tb;
#endif
#pragma unroll
            for (int u2 = 0; u2 < NSUB; ++u2) {
                const int kss = ks + u2; if (kss > g) continue;
                if (kss == 0 || kss == g) {
#pragma unroll
                    for (int i = 0; i < 16; ++i) {
                        const int kidx = crow(i, h);
                        const bool ok = qvalid && (kss == 0 ? kidx < NMETA && (g > 0 || kidx <= r) : kidx <= r);
                        if (ok) { const unsigned bin = (unsigned)__builtin_amdgcn_fmed3f(__builtin_fmaf(scv[u2][i], inv, c0f), 0.f, (float)(IDX_NBIN - 1)); __hip_atomic_fetch_add(hrow + bin, 1u, __ATOMIC_RELAXED, __HIP_MEMORY_SCOPE_WORKGROUP); }
                    }
                } else {
#pragma unroll
                    for (int i = 0; i < 16; ++i) { const unsigned bin = (unsigned)__builtin_amdgcn_fmed3f(__builtin_fmaf(scv[u2][i], inv, c0f), 0.f, (float)(IDX_NBIN - 1)); __hip_atomic_fetch_add(hrow + bin, 1u, __ATOMIC_RELAXED, __HIP_MEMORY_SCOPE_WORKGROUP); }
                }
            }
#if PROBE_REP >= 40 && PROBE_REP < 60
            IPTS(td); accP += td - tc;
#endif
        }
    }
    IPTS(tx1);
    __syncthreads();
    IPTS(tx2);
#pragma unroll 1
    for (int k = 0; k < 4; ++k) {
        const int row = 4 * wave + k;
        const int c0 = (int)((LAS unsigned*)(L + IDX_HIST))[row * 129 + 2 * lane], c1 = (int)((LAS unsigned*)(L + IDX_HIST))[row * 129 + 2 * lane + 1];
        const int SL = suffix_sum(c0 + c1, lane), NT = __builtin_amdgcn_readlane(SL, 0);
        int bstar = -1, need = 0;
        if (NT > 256) {
            const unsigned long long ml = __ballot(SL >= 256); const int lL = 63 - __builtin_clzll(ml); const int sl = __builtin_amdgcn_readlane(SL, lL), t0 = __builtin_amdgcn_readlane(c0, lL), t1 = __builtin_amdgcn_readlane(c1, lL); const int above = sl - t0 - t1;
            if (above + t1 >= 256) { bstar = 2 * lL + 1; need = 256 - above; } else { bstar = 2 * lL; need = 256 - above - t1; }
        }
        if (lane == 0) { ((LAS int*)(L + IDX_INFO))[row * 2] = bstar; ((LAS int*)(L + IDX_INFO))[row * 2 + 1] = need; }
    }
    __syncthreads();
    float lo_f, hi_f;
    { const int bstar = ((LAS int*)(L + IDX_INFO))[r * 2];
      hi_f = bstar < 0 ? -__builtin_inff() : (bstar >= IDX_NBIN - 1 ? __builtin_inff() : (float)(bstar + 1));
      lo_f = bstar <= 0 ? -__builtin_inff() : (float)bstar; }
    const float hi_raw = idx_raw_edge(hi_f, inv, c0f), lo_raw = idx_raw_edge(lo_f, inv, c0f);
    const float lo_base = fmaxf(lo_f, 0.f);
    auto append = [&](float sv, int kb, int ci) {
        const unsigned slot = __hip_atomic_fetch_add((LAS unsigned*)(L + IDX_CCNT) + r, 1u, __ATOMIC_RELAXED, __HIP_MEMORY_SCOPE_WORKGROUP);
        if (slot < IDX_CAP) { const float fr = (__builtin_fmaf(sv, inv, c0f) - lo_base) * 131072.0f; const unsigned q = (unsigned)__builtin_amdgcn_fmed3f(fr, 0.f, 131071.0f);
            asm volatile("" : "+v"(kb));
            ((LAS unsigned*)(L + IDX_CAND))[r * IDX_CAP + slot] = (q << 15) | (unsigned)(kb - ci); } };
    {
#pragma unroll 1
        for (int ks = NSUB * wave; ks <= g; ks += 8 * NSUB) {
            const unsigned char* nextp[NSUB];
#pragma unroll
            for (int u = 0; u < NSUB; ++u) nextp[u] = krow((ks + 8 * NSUB <= g ? ks + 8 * NSUB : NSUB * wave) + u);
#if PROBE_REP >= 40 && PROBE_REP < 60
            unsigned tb, tc, td; IPTS(tb);
#endif
            f32x16 scv[NSUB]; idx_scoresN<NSUB>(qf, w, kf, nextp, h, scv);
#if PROBE_REP >= 40 && PROBE_REP < 60
            IDX_PIN(scv[NSUB - 1]); IPTS(tc); accS += tc - tb;
#endif
#pragma unroll
            for (int u2 = 0; u2 < NSUB; ++u2) {
                const int kss = ks + u2; if (kss > g) continue;
                unsigned part = 0u;
                if (kss == 0 || kss == g) {
#pragma unroll
                    for (int i = 0; i < 16; ++i) {
                        const int kidx = crow(i, h);
                        const bool ok = qvalid && (kss == 0 ? kidx < NMETA && (g > 0 || kidx <= r) : kidx <= r);
                        const bool ghi = scv[u2][i] >= hi_raw, glo = scv[u2][i] >= lo_raw;
                        part |= (ok && ghi) ? (1u << kidx) : 0u;
                        if (ok && glo && !ghi) append(scv[u2][i], 32767 - kss * 32 - 4 * h, (i & 3) + 8 * (i >> 2));
                    }
                } else {
                    unsigned mhi = 0u, mlo = 0u;
#pragma unroll
                    for (int i = 15; i >= 0; --i) { IDX_ACCBIT(mhi, scv[u2][i], hi_raw); IDX_ACCBIT(mlo, scv[u2][i], lo_raw); }
                    part = ((mhi & 0xFu) | ((mhi & 0xF0u) << 4) | ((mhi & 0xF00u) << 8) | ((mhi & 0xF000u) << 12)) << (4 * h);
                    const unsigned cm = mlo & ~mhi;
                    if (__ballot(cm != 0u) != 0ull) {
#pragma unroll
                        for (int i = 0; i < 16; ++i) if (cm & (1u << i)) append(scv[u2][i], 32767 - kss * 32 - 4 * h, (i & 3) + 8 * (i >> 2));
                    }
                }
                __hip_atomic_fetch_or((LAS unsigned*)(L + IDX_MASK) + kss * 32 + r, part, __ATOMIC_RELAXED, __HIP_MEMORY_SCOPE_WORKGROUP);
            }
#if PROBE_REP >= 40 && PROBE_REP < 60
            IPTS(td); accP2 += td - tc;
#endif
        }
    }
    IPTS(tx3);
    __syncthreads();
    IPTS(tx4);
    __builtin_amdgcn_s_setprio(0);
#pragma unroll 1
    for (int k = 0; k < 4; ++k) {
        const int row = 4 * wave + k;
        const int need = ((LAS int*)(L + IDX_INFO))[row * 2 + 1];
        int nc = (int)((LAS unsigned*)(L + IDX_CCNT))[row]; nc = nc < IDX_CAP ? nc : IDX_CAP;
        nc = __builtin_amdgcn_readfirstlane(nc);
#if PROBE_REP == 48
        accNC += (unsigned)nc; accNR += 128u;
#endif
        if (nc == 0) continue;
        const LAS unsigned* cb = (const LAS unsigned*)(L + IDX_CAND) + row * IDX_CAP;
        const bool v0 = lane < nc, v1 = lane + 64 < nc;
        const unsigned c0 = v0 ? cb[lane] : 0u, c1 = v1 ? cb[lane + 64] : 0u;
        int r0 = 0, r1 = 0;
        if (__builtin_amdgcn_readfirstlane(need) < nc) {
            const int n0 = nc < 64 ? nc : 64;
#pragma unroll 1
            for (int j = 0; j < n0; ++j) { const unsigned cj = (unsigned)__builtin_amdgcn_readlane((int)c0, j); r0 += cj > c0 ? 1 : 0; r1 += cj > c1 ? 1 : 0; }
#pragma unroll 1
            for (int j = 64; j < nc; ++j) { const unsigned cj = (unsigned)__builtin_amdgcn_readlane((int)c1, j - 64); r0 += cj > c0 ? 1 : 0; r1 += cj > c1 ? 1 : 0; }
        }
        const int k0 = 32767 - (int)(c0 & 32767u), k1 = 32767 - (int)(c1 & 32767u);
        if (v0 && r0 < need) __hip_atomic_fetch_or((LAS unsigned*)(L + IDX_MASK) + (k0 >> 5) * 32 + row, 1u << (k0 & 31), __ATOMIC_RELAXED, __HIP_MEMORY_SCOPE_WORKGROUP);
        if (v1 && r1 < need) __hip_atomic_fetch_or((LAS unsigned*)(L + IDX_MASK) + (k1 >> 5) * 32 + row, 1u << (k1 & 31), __ATOMIC_RELAXED, __HIP_MEMORY_SCOPE_WORKGROUP);
    }
    IPTS(tx5);
    __syncthreads();
    IPTS(tx6);
    unsigned* MK = (unsigned*)(F.ws + WS_MASK) + (size_t)b * NKS * TLEN;
    for (int i = tid; i < (g + 1) * 32; i += NTHREADS) { const int ks = i >> 5, rr = i & 31; if (rr < nq) MK[(size_t)ks * TLEN + tq0 + rr] = ((LAS unsigned*)(L + IDX_MASK))[i]; }
#if PROBE_REP >= 40 && PROBE_REP < 60
    { unsigned tU1; IPTS(tU1); if (lane == 0) { unsigned long long* pc = (unsigned long long*)(F.ws + WS_CTL) + 4096;
        const unsigned vals[12] = {tx0 - tU0, accS, accP, tU1 - tU0, accP2, tx2 - tx1, tx4 - tx3, tU1 - tx4, accNC, tx5 - tx4, tx6 - tx5, tU1 - tx6};
        atomicAdd(pc + (PROBE_REP - 40), (unsigned long long)vals[PROBE_REP - 40]); atomicAdd(pc + 3, (unsigned long long)(PROBE_REP == 48 ? accNR : tU1 - tU0)); } }
#endif
}
__device__ __forceinline__ void mixA_index_phase(const Frame& F) {
#pragma unroll 1
    for (int c = F.bid; c < 256; c += F.G) {
#pragma unroll 1
        for (int k = 0; k < 5; ++k) {
            int u; if (k == 0) u = c; else if (k == 1) u = 511 - c; else if (k == 2) u = 512 + c; else if (k == 3) u = 1023 - c; else { if (c >= 2) break; u = 1024 + c; }
            mixA_index_unit(F, u & 1, 512 - (u >> 1));
        }
    }
}

__device__ __forceinline__ void mixA3_unit(const Frame& F, int l, int b, int ha, int qblk) {
    LAS unsigned char* L = F.lds + LDS_GEN;
    int lane_; { unsigned z0_ = 0u; asm volatile("" : "+s"(z0_)); lane_ = (int)__builtin_amdgcn_mbcnt_hi(~0u, __builtin_amdgcn_mbcnt_lo(~0u, z0_)); asm volatile("" : "+v"(lane_)); }
    const int lane = lane_, wave = F.wave, tid = wave * 64 + lane, r = lane & 31, h = lane >> 5;
    const unsigned char* proj = F.ws + WS_PROJ;
    const _Float16* QA = (const _Float16*)(proj + PJ_QA); const unsigned char* KA = proj + PJ_KA; const unsigned char* VA = proj + PJ_VA;
    const unsigned* kmax = (const unsigned*)(F.ws + WS_CTL) + CW_KMAX + 32 * l;
    const unsigned* MK = (const unsigned*)(F.ws + WS_MASK) + (size_t)b * NKS * TLEN;
    const bool meta_u = qblk < 0;
    const int qrow0 = meta_u ? MR + b * NMETA : b * SEQ + qblk * 256;
    const int qpos0 = meta_u ? 0 : NMETA + qblk * 256;
    const int nreal = meta_u ? 0 : 2 * qblk + 2;
    const int wq0 = 32 * wave;
    const bool wave_on = meta_u ? (wave == 0) : true;
    const int my_row = wave_on ? qrow0 + wq0 + r : qrow0, my_pos = wave_on ? qpos0 + wq0 + r : 0;
    __syncthreads();
    if (tid < 128) ((LAS float*)(L + B_LUT))[tid] = F.rel_bias[BUCKET_LUT[tid] * 12 + ha] * LOG2E;
    float bmax = (lane < 32) ? F.rel_bias[lane * 12 + ha] * LOG2E : -1e30f;
    bmax = fmaxf(bmax, sx<16>(bmax, lane)); bmax = fmaxf(bmax, sx<8>(bmax, lane)); bmax = fmaxf(bmax, sx<4>(bmax, lane)); bmax = fmaxf(bmax, sx<2>(bmax, lane)); bmax = fmaxf(bmax, sx<1>(bmax, lane));
    bmax = bcast0(bmax);
    const float bfar = F.rel_bias[31 * 12 + ha] * LOG2E;
    h8 qf[4]; float mref; bool safe;
    { float n2 = 0.f;
#pragma unroll
      for (int s = 0; s < 4; ++s) { qf[s] = *(const h8*)(QA + (size_t)my_row * 512 + ha * 64 + 16 * s + 8 * h);
#pragma unroll
          for (int j = 0; j < 8; ++j) { const float v = (float)qf[s][j]; n2 += v * v; } }
      n2 = hsum32(n2, lane);
      mref = sqrtf(n2 * (__uint_as_float(kmax[ha * 2]) + __uint_as_float(kmax[ha * 2 + 1]))) * 1.002f + bmax;
      safe = __all(mref - bfar < 60.0f); if (safe) mref = bfar; }
    f32x16 O[2], Lacc;
#if PROBE_REP >= 60 && PROBE_REP < 70
    unsigned a3C = 0, a3S = 0, a3W = 0, a3t0, a3t1, a3t2, a3t3, a3U0; PTS(a3U0);
#endif
#pragma unroll
    for (int i = 0; i < 16; ++i) { O[0][i] = 0.f; O[1][i] = 0.f; Lacc[i] = 0.f; }
    bf16x8v ones; { const u32x4 o = {0x3F803F80u, 0x3F803F80u, 0x3F803F80u, 0x3F803F80u}; ones = __builtin_bit_cast(bf16x8v, o); }
    const int skey = tid >> 3, sch = tid & 7;
    const unsigned kdst = skey * KS_PITCH + sch * 16, vdst = (sch >> 2) * (TK * 64) + skey * 64 + (sch & 3) * 16;
    const int ntiles = 1 + nreal;
    auto tile_row0 = [&](int t) -> int { return t == 0 ? MR + b * NMETA : b * SEQ + (t - 1) * TK; };
    u32x4 kreg[2], vreg[2];
#pragma unroll
    for (int j = 0; j < 2; ++j) { const size_t rr = (size_t)(tile_row0(0) + skey + 64 * j); kreg[j] = *(const u32x4*)(KA + rr * 1024 + ha * 128 + sch * 16); vreg[j] = *(const u32x4*)(VA + rr * 1024 + ha * 128 + sch * 16); }
#pragma unroll
    for (int j = 0; j < 2; ++j) { *(LAS u32x4*)(L + B_KS + kdst + j * 64 * KS_PITCH) = kreg[j]; *(LAS u32x4*)(L + B_VS + vdst + j * 64 * 64) = vreg[j]; }
    if (ntiles > 1) {
#pragma unroll
        for (int j = 0; j < 2; ++j) { const size_t rr = (size_t)(tile_row0(1) + skey + 64 * j); kreg[j] = *(const u32x4*)(KA + rr * 1024 + ha * 128 + sch * 16); vreg[j] = *(const u32x4*)(VA + rr * 1024 + ha * 128 + sch * 16); }
#pragma unroll
        for (int j = 0; j < 2; ++j) { *(LAS u32x4*)(L + B_KS + KBUF + kdst + j * 64 * KS_PITCH) = kreg[j]; *(LAS u32x4*)(L + B_VS + VBUF + vdst + j * 64 * 64) = vreg[j]; }
    }
    __syncthreads();
    unsigned mw[4], mwn[4] = {0u, 0u, 0u, 0u};
    mw[0] = MK[my_pos]; mw[1] = 0u; mw[2] = 0u; mw[3] = 0u;
    const int wpos0 = qpos0 + wq0;
    if (wave >= 4) __builtin_amdgcn_s_setprio(1);
#pragma unroll 1
    for (int t = 0; t < ntiles; ++t) {
        const int buf = t & 3;
        if (STAGGER > 0 && wave >= 4 && (t & 1) == 0) __builtin_amdgcn_s_sleep(STAGGER);
        if (t + 2 < ntiles) {
#pragma unroll
            for (int j = 0; j < 2; ++j) { const size_t rr = (size_t)(tile_row0(t + 2) + skey + 64 * j); kreg[j] = *(const u32x4*)(KA + rr * 1024 + ha * 128 + sch * 16); vreg[j] = *(const u32x4*)(VA + rr * 1024 + ha * 128 + sch * 16); } }
        if (t + 1 < ntiles) {
#pragma unroll
            for (int j = 0; j < 4; ++j) mwn[j] = MK[(size_t)(1 + 4 * t + j) * TLEN + my_pos]; }
        const int kpos0 = (t == 0) ? 0 : NMETA + (t - 1) * TK, nvalid = (t == 0) ? NMETA : TK;
#if PROBE_REP >= 60 && PROBE_REP < 70
        PTS(a3t0);
#endif
        if (wave_on && kpos0 <= wpos0 + 31) {
            LAS unsigned char* Kb = L + B_KS + buf * KBUF; LAS unsigned char* Vb = L + B_VS + buf * VBUF;
#pragma unroll
            for (int sub = 0; sub < 4; ++sub) {
                if (sub * 32 >= nvalid || kpos0 + sub * 32 > wpos0 + 31) continue;
                const bool slow = !safe || (t == 0) || (kpos0 + sub * 32 + 31 > wpos0 - 128);
                const unsigned mword = mw[sub] >> (4 * h);
                f32x16 S;
                h8 kfr[4]; bf16x8v vfr[2][2];
#pragma unroll
                for (int s = 0; s < 4; ++s) kfr[s] = *(const LAS h8*)(Kb + (sub * 32 + r) * KS_PITCH + (16 * s + 8 * h) * 2);
#pragma unroll
                for (int d = 0; d < 2; ++d)
#pragma unroll
                    for (int s = 0; s < 2; ++s) vfr[d][s] = vt_frag(Vb, d, sub * 32, s, lane);
                __builtin_amdgcn_sched_barrier(0);
#pragma unroll
                for (int i = 0; i < 16; ++i) S[i] = 0.f;
#pragma unroll
                for (int s = 0; s < 4; ++s) S = __builtin_amdgcn_mfma_f32_32x32x16_f16(kfr[s], qf[s], S, 0, 0, 0);
                bf16x8v pf[2];
                if (slow) {
                    float bs[16];
#pragma unroll
                    for (int i = 0; i < 16; ++i) { const int dist = my_pos - (kpos0 + sub * 32 + crow(i, h)); bs[i] = ((const LAS float*)(L + B_LUT))[min(max(dist, 0), 127)]; }
#pragma unroll
                    for (int i = 0; i < 16; ++i) {
                        const int kidx = sub * 32 + crow(i, h), dist = my_pos - (kpos0 + kidx);
                        const bool ok = ((mword >> ((i & 3) + 8 * (i >> 2))) & 1u) != 0u && dist >= 0 && kidx < nvalid;
                        const float e = __builtin_amdgcn_exp2f(fminf(S[i] + (bs[i] - mref), 80.f));
                        S[i] = ok ? e : 0.f;
                    }
                    pf[0] = pack_p(S, 0); pf[1] = pack_p(S, 1);
                } else {
#pragma unroll
                    for (int i = 0; i < 16; ++i) S[i] = __uint_as_float(__float_as_uint(__builtin_amdgcn_exp2f(S[i])) & (unsigned)__builtin_amdgcn_sbfe((int)mword, (i & 3) + 8 * (i >> 2), 1));
                    pf[0] = pack_p(S, 0); pf[1] = pack_p(S, 1);
                }
#pragma unroll
                for (int s = 0; s < 2; ++s) { Lacc = __builtin_amdgcn_mfma_f32_32x32x16_bf16(ones, pf[s], Lacc, 0, 0, 0);
#pragma unroll
                    for (int d = 0; d < 2; ++d) O[d] = __builtin_amdgcn_mfma_f32_32x32x16_bf16(vfr[d][s], pf[s], O[d], 0, 0, 0); }
            }
        }
#if PROBE_REP >= 60 && PROBE_REP < 70
        asm volatile("" : "+v"(O[0][0]), "+v"(O[1][0]), "+v"(Lacc[0])); PTS(a3t1);
#endif
        if (t + 2 < ntiles) {
#pragma unroll
            for (int j = 0; j < 2; ++j) { *(LAS u32x4*)(L + B_KS + (buf ^ 2) * KBUF + kdst + j * 64 * KS_PITCH) = kreg[j]; *(LAS u32x4*)(L + B_VS + (buf ^ 2) * VBUF + vdst + j * 64 * 64) = vreg[j]; } }
#pragma unroll
        for (int j = 0; j < 4; ++j) mw[j] = mwn[j];
#if PROBE_REP >= 60 && PROBE_REP < 70
        PTS(a3t2);
#endif
        if (t & 1) { if (STAGGER > 0 && wave < 4) __builtin_amdgcn_s_sleep(STAGGER); __syncthreads(); }
#if PROBE_REP >= 60 && PROBE_REP < 70
        PTS(a3t3); a3C += a3t1 - a3t0; a3S += a3t2 - a3t1; a3W += a3t3 - a3t2;
#endif
    }
#if PROBE_REP >= 60 && PROBE_REP < 70
    { unsigned a3U1; PTS(a3U1); if (lane == 0) { unsigned long long* pc = (unsigned long long*)(F.ws + WS_CTL) + 4096;
        const unsigned vals[4] = {a3C, a3S, a3W, a3U1 - a3U0};
        atomicAdd(pc + (PROBE_REP - 40), (unsigned long long)vals[PROBE_REP - 60]); atomicAdd(pc + 23, (unsigned long long)(a3U1 - a3U0)); } }
#endif
    __builtin_amdgcn_s_setprio(0);
    if (wave_on) {
        const float il = 1.0f / Lacc[0];
        if (!meta_u || r < NMETA) {
            _Float16* dst = (_Float16*)(F.ws + WS_ABUF) + (size_t)my_row * DM + ha * 64;
#pragma unroll
            for (int d = 0; d < 2; ++d)
#pragma unroll
                for (int g4 = 0; g4 < 4; ++g4) { const int d0 = 32 * d + 8 * g4 + 4 * h;
                    u32x2 w; w.x = cvt_pk_f16(O[d][4 * g4 + 0] * il, O[d][4 * g4 + 1] * il); w.y = cvt_pk_f16(O[d][4 * g4 + 2] * il, O[d][4 * g4 + 3] * il);
                    *(u32x2*)(dst + d0) = w; }
        }
    }
}
__device__ __forceinline__ void mixA3_phase(const Frame& F, int l) {
#pragma unroll 1
    for (int c = F.bid; c < 256; c += F.G) { const int bh = c & 15, i1 = c >> 4, i2 = 31 - i1;
#pragma unroll 1
        for (int k = 0; k < 5; ++k) { if (k == 4 && c >= 16) break;
            const int qb = k == 0 ? 63 - i1 : (k == 1 ? 32 + i1 : (k == 2 ? i2 : (k == 3 ? i1 : -1)));
            mixA3_unit(F, l, bh >> 3, bh & 7, qb); }
    }
}
constexpr int NPHASES = 19;
__global__ void __launch_bounds__(NTHREADS, 2) fwd(Args args) {
    extern __shared__ __attribute__((aligned(16))) unsigned char lds_raw[];
    Frame F;
    F.x = args.in[0]; F.meta = args.in[1]; F.rel_bias = args.in[2]; F.w_in = args.in[3]; F.norm_mix = args.in[4]; F.diff_lambda = args.in[5]; F.diff_norm = args.in[6];
    F.ret_norm = args.in[7]; F.w_out = args.in[8]; F.norm_ff = args.in[9]; F.w_ff1 = args.in[10]; F.w_ff2 = args.in[11]; F.final_norm = args.in[12];
    F.out = args.out; F.ws = args.ws; F.lds = (LAS unsigned char*)lds_raw;
    F.bid = blockIdx.x; F.G = gridDim.x; F.tid = threadIdx.x; F.lane = F.tid & 63; F.wave = __builtin_amdgcn_readfirstlane(F.tid >> 6);
    if (F.tid < 64) ((LAS unsigned*)(F.lds + LDS_MISC))[F.tid] = 0u;
    __syncthreads();
    unsigned* ctl = (unsigned*)(F.ws + WS_CTL);
    XcdBarrier bar = xcd_barrier_post(ctl + CW_BAR, (volatile LAS unsigned*)(F.lds + LDS_MISC));
    const int lo = args.ph_lo, hi = args.ph_hi;
#define IN(k) (lo <= (k) && (k) < hi)
#ifndef PROBE_REP
#define PROBE_REP 0
#endif
#define RETID() do { unsigned z0_ = 0u; asm volatile("" : "+s"(z0_)); int t_ = (int)__builtin_amdgcn_mbcnt_hi(~0u, __builtin_amdgcn_mbcnt_lo(~0u, z0_)); asm volatile("" : "+v"(t_)); F.lane = t_; F.tid = F.wave * 64 + t_; } while (0)
#define REP(k) _Pragma("unroll 1") for (int rep_ = 0; rep_ < ((PROBE_REP == (k)) ? 2 : 1); ++rep_)
#define SEAM(k) do { if (IN(k) && IN((k) + 1)) xcd_barrier(bar, F.wave == 0 && F.lane == 0); } while (0)
    LAS unsigned char* stage = F.lds + LDS_GEN;
    if (IN(0)) { REP(10) prologue(F); SEAM(0);
#if PROBE_REP == 20
        for (int xb = 0; xb < 20; ++xb) xcd_barrier(bar, F.wave == 0 && F.lane == 0);
#endif
    }
#pragma unroll 1
    for (int l = 0; l < DEPTH; ++l) {
        const int pb = 1 + 9 * l;
        { RETID();
          size_t z_ = 0; int b_ = blockIdx.x, g_ = gridDim.x; asm volatile("" : "+s"(z_), "+s"(b_), "+s"(g_)); F.ws = args.ws + z_; F.out = args.out + z_; F.bid = b_; F.G = g_; }
        unsigned char* wl = F.ws + WS_W + (size_t)l * W_LAYER;
        unsigned char* proj = F.ws + WS_PROJ;
        if (IN(pb + 0)) {
            pg8::Gemm g{(const pg8::bf16_t*)(F.ws + WS_ABUF), (const pg8::bf16_t*)(wl + W_IN_OFF), MP, NPAD, DM}; pg8::StaticOrder S; S.init(MP, NPAD, F.G, F.bid);
            EpiInProj E{proj, (const f32x2*)(F.ws + WS_ROPE), ctl + CW_KMAX + 32 * l};
            pg8::gemm_phase<EpiInProj, pg8::StaticOrder, true, true>(stage, g, S, E, F.tid);
#if PROBE_REP == 7
            RETID(); pg8::gemm_phase<EpiInProj, pg8::StaticOrder, true, true>(stage, g, S, E, F.tid);
#endif
            SEAM(pb + 0);
        }
        if (IN(pb + 1)) { RETID(); REP(1) mixA_index_phase(F); RETID(); REP(2) mixC1_phase(F); SEAM(pb + 1); }
        if (IN(pb + 2)) { RETID(); REP(3) mixC_scan(F); RETID(); REP(4) mixB_phase(F, l); SEAM(pb + 2); }
        if (IN(pb + 3)) { RETID(); REP(5) mixA3_phase(F, l); RETID(); REP(6) mixC2_phase(F, l); SEAM(pb + 3); }
        if (IN(pb + 4)) { RETID();
            skinny_meta<0>(F, wl); RETID();
            pg8::Gemm g{(const pg8::bf16_t*)(F.ws + WS_ABUF), (const pg8::bf16_t*)(wl + W_OUT_OFF), MR, DM, DM}; pg8::StaticOrder S; S.init(MR, DM, F.G, F.bid);
            EpiRes E{l == 0 ? F.x : F.out, F.out, (float*)(F.ws + WS_HMETA)};
            pg8::gemm_phase<EpiRes, pg8::StaticOrder, true, true>(stage, g, S, E, F.tid);
            SEAM(pb + 4);
        }
        if (IN(pb + 5)) { RETID(); zero_scr(F); REP(8) norm_to_abuf<1>(F, F.norm_ff + (size_t)l * DM); SEAM(pb + 5); }
        if (IN(pb + 6)) { RETID();
            skinny_meta<1>(F, wl); RETID();
            pg8::Gemm g{(const pg8::bf16_t*)(F.ws + WS_ABUF), (const pg8::bf16_t*)(wl + W_FF1_OFF), MR, DFF, DM}; pg8::StaticOrder S; S.init(MR, DFF, F.G, F.bid);
            EpiRelu2 E{proj};
            pg8::gemm_phase<EpiRelu2, pg8::StaticOrder, true, true>(stage, g, S, E, F.tid);
#if PROBE_REP == 9
            RETID(); pg8::gemm_phase<EpiRelu2, pg8::StaticOrder, true, true>(stage, g, S, E, F.tid);
#endif
            SEAM(pb + 6);
        }
        if (IN(pb + 7)) { RETID();
            skinny_meta<2>(F, wl); RETID();
            pg8::Gemm g{(const pg8::bf16_t*)proj, (const pg8::bf16_t*)(wl + W_FF2_OFF), MR, DM, DFF}; pg8::StaticOrder S; S.init(MR, DM, F.G, F.bid);
            EpiRes E{F.out, F.out, (float*)(F.ws + WS_HMETA)};
#if PROBE_REP == 14
            { EpiRes E2{F.out, (float*)(F.ws + WS_ABUF), (float*)(F.ws + WS_U)}; pg8::gemm_phase<EpiRes, pg8::StaticOrder, true, true>(stage, g, S, E2, F.tid); RETID(); }
#endif
            pg8::gemm_phase<EpiRes, pg8::StaticOrder, true, true>(stage, g, S, E, F.tid);
            SEAM(pb + 7);
        }
        if (IN(pb + 8)) { RETID();
            if (l + 1 < DEPTH) { norm_to_abuf<1>(F, F.norm_mix + (size_t)(l + 1) * DM); SEAM(pb + 8); }
            else final_norm(F);
        }
    }
#if PROBE_REP >= 40
    RETID(); if (blockIdx.x == 0 && F.tid == 0) {
        const unsigned long long* pc = (const unsigned long long*)(args.ws + WS_CTL) + 4096;
        const unsigned long long vx = __hip_atomic_load(pc + (PROBE_REP - 40), __ATOMIC_RELAXED, __HIP_MEMORY_SCOPE_AGENT), vt = __hip_atomic_load(pc + (PROBE_REP < 60 ? 3 : (PROBE_REP < 70 ? 23 : 33)), __ATOMIC_RELAXED, __HIP_MEMORY_SCOPE_AGENT);
        const unsigned long long ticks = (unsigned long long)((float)vx / (float)vt * 1.0e6f);
        const unsigned long long t0 = __builtin_amdgcn_s_memrealtime();
        while (__builtin_amdgcn_s_memrealtime() - t0 < ticks) __builtin_amdgcn_s_sleep(16);
    }
#endif
#undef IN
#undef SEAM
}

#ifndef MK_SPLIT
#define MK_SPLIT 0
#endif
extern "C" void kernel_launch(void* const* d_in, const int* in_sizes, int n_in, void* d_out, int out_size, void* d_ws, size_t ws_size, hipStream_t stream) {
    static int grid = 0;
    if (grid == 0) {
        if (n_in != 13 || ws_size < WS_END) { fprintf(stderr, "kernel_launch: need 13 inputs and %zu bytes of workspace; got %d, %zu\n", (size_t)WS_END, n_in, ws_size); grid = -1; return; }
        int dev = 0, cus = 0, per_cu = 0;
        if (hipGetDevice(&dev) != hipSuccess || hipDeviceGetAttribute(&cus, hipDeviceAttributeMultiprocessorCount, dev) != hipSuccess) { grid = -1; return; }
        if (hipFuncSetAttribute((const void*)fwd, hipFuncAttributeMaxDynamicSharedMemorySize, LDS_BYTES) != hipSuccess) { fprintf(stderr, "kernel_launch: hipFuncSetAttribute failed\n"); grid = -1; return; }
        if (hipOccupancyMaxActiveBlocksPerMultiprocessor(&per_cu, (const void*)fwd, NTHREADS, LDS_BYTES) != hipSuccess || per_cu < 1) { fprintf(stderr, "kernel_launch: occupancy query says %d\n", per_cu); }
        (void)hipGetLastError();
        grid = cus;
    }
    if (grid < 0) return;
    (void)hipMemsetAsync((char*)d_ws + WS_CTL, 0, CTL_BYTES, stream);
    Args a{};
    for (int i = 0; i < 13; ++i) a.in[i] = (const float*)d_in[i];
    a.out = (float*)d_out; a.ws = (unsigned char*)d_ws;
#if MK_SPLIT
    for (int p = 0; p < NPHASES; ++p) { a.ph_lo = p; a.ph_hi = p + 1; hipLaunchKernelGGL(fwd, dim3(grid), dim3(NTHREADS), LDS_BYTES, stream, a); }
#else
    a.ph_lo = 0; a.ph_hi = NPHASES; hipLaunchKernelGGL(fwd, dim3(grid), dim3(NTHREADS), LDS_BYTES, stream, a);
#endif
}
```

```cpp
#include <hip/hip_runtime.h>
#include <cstdio>
#include <cstdint>
typedef _Float16 h8 __attribute__((ext_vector_type(8)));
typedef _Float16 h4 __attribute__((ext_vector_type(4)));
typedef _Float16 h2 __attribute__((ext_vector_type(2)));
typedef short s16x8 __attribute__((ext_vector_type(8)));
typedef short s16x4 __attribute__((ext_vector_type(4)));
typedef float f32x16 __attribute__((ext_vector_type(16)));
typedef float f32x2 __attribute__((ext_vector_type(2)));
typedef unsigned u32x2 __attribute__((ext_vector_type(2)));
namespace pg8 {
#define PG8_LAS __attribute__((address_space(3)))
typedef unsigned short bf16_t;
typedef short bf16x8 __attribute__((ext_vector_type(8)));
typedef float f32x4 __attribute__((ext_vector_type(4)));
typedef unsigned u32x4 __attribute__((ext_vector_type(4)));
constexpr int BM = 256, BK = 64, HALF = 128, HTB = HALF * BK * 2  , STAGE_BYTES = 8 * HTB, NXCD = 8, WGM = 8;

__host__ __device__ __forceinline__ int lds_byte(int r, int c) { const int st = (r >> 4) * 2 + (c >> 5), rr = r & 15, cc = c & 31, ob = rr * 64 + cc * 2; return st * 1024 + (ob ^ (((ob >> 9) & 1) << 5)); }
__host__ __device__ __forceinline__ void stage_rc(int b, int& R, int& C) { const int st = b / 1024, sb = b % 1024, swz = sb ^ (((sb >> 9) & 1) << 5); R = (st >> 1) * 16 + swz / 64; C = (st & 1) * 32 + (swz % 64) / 2; }
__host__ __device__ __forceinline__ int perm32(int rho) { const int n = rho >> 4, i = rho & 15; return 8 * (i >> 2) + 4 * n + (i & 3); }

struct Unit { int pm, pn; };
struct Gemm { const bf16_t* A; const bf16_t* Bt; int M, N, K; };

struct StaticOrder {
    int nM, nN, nwg, G, c;
    __host__ __device__ void init(int M, int N, int G_, int c_) { nM = M / BM; nN = N / BM; nwg = nM * nN; G = G_; c = c_; }
    __host__ __device__ bool next(int i, Unit& u) const {
        const long L = (long)i * G + c; if (L >= nwg) return false;
        int wgid = (int)L; { const int q = nwg / NXCD, r = nwg % NXCD, xcd = wgid % NXCD, off = wgid / NXCD; wgid = (xcd < r ? xcd * (q + 1) : r * (q + 1) + (xcd - r) * q) + off; }
        const int nig = WGM * nN, gid = wgid / nig, fm = gid * WGM, gsz = (nM - fm) < WGM ? (nM - fm) : WGM;
        u.pm = fm + ((wgid % nig) % gsz); u.pn = (wgid % nig) / gsz; return true;
    }
    __device__ __forceinline__ void a_ready(const Unit&) const {}
    __device__ __forceinline__ void done(const Unit&) const {}
};

template <class Epi, class Sched, bool ALIGN_EPI = false, bool SP2 = false>
__device__ __forceinline__ void gemm_phase(PG8_LAS unsigned char* lds, const Gemm g, const Sched& S, const Epi& E, int tid_in) {
    int tid_ = tid_in; asm volatile("" : "+v"(tid_));
    const int tid = tid_, wid = __builtin_amdgcn_readfirstlane(tid >> 6), lane = tid & 63, wr = wid >> 2, wc = wid & 3, fr = lane & 15, fq = lane >> 4;
    const int K = g.K, nt = K / BK;
    unsigned voffA[2], voffB[2];
#pragma unroll
    for (int i = 0; i < 2; ++i) { int R, C; stage_rc(tid * 16 + i * 8192, R, C); const int Rb = Epi::PERM ? ((R & ~31) + perm32(R & 31)) : R;
        voffA[i] = (unsigned)(R * K + C) * 2u; voffB[i] = (unsigned)(Rb * K + C) * 2u; }
    const size_t kstep = (size_t)(BK * 2);
    const size_t hstep = (size_t)HALF * K * 2;
    const size_t tstep = 2 * hstep;
    const unsigned ldsw = (unsigned)wid * 1024u;
    const int aoff = lds_byte(wr * 64 + fr, fq * 8), boff = lds_byte(wc * 32 + fr, fq * 8);
#define PG8_SA(b, h) (((b) * 2 + (h)) * HTB)
#define PG8_SB(b, h) ((4 + (b) * 2 + (h)) * HTB)
#define PG8_STAGE(bufoff, gbase, voff) do { _Pragma("unroll") for (int _i = 0; _i < 2; ++_i) \
        __builtin_amdgcn_global_load_lds((const unsigned*)((const char*)(gbase) + (voff)[_i]), (PG8_LAS unsigned*)(lds + (bufoff) + ldsw + _i * 8192), 16, 0, 0); } while (0)
#define PG8_LDA(dst, b, h) do { _Pragma("unroll") for (int m = 0; m < 4; ++m) _Pragma("unroll") for (int k = 0; k < 2; ++k) dst[m][k] = *(const PG8_LAS bf16x8*)(lds + PG8_SA(b, h) + aoff + m * 2048 + k * 1024); } while (0)
#define PG8_LDB(dst, b, h) do { _Pragma("unroll") for (int n = 0; n < 2; ++n) _Pragma("unroll") for (int k = 0; k < 2; ++k) dst[n][k] = *(const PG8_LAS bf16x8*)(lds + PG8_SB(b, h) + boff + n * 2048 + k * 1024); } while (0)
#define PG8_MMA(ai, bj, At, Bt) do { __builtin_amdgcn_s_setprio(1); _Pragma("unroll") for (int m = 0; m < 4; ++m) _Pragma("unroll") for (int n = 0; n < 2; ++n) _Pragma("unroll") for (int k = 0; k < 2; ++k) \
        acc[ai][bj][m][n] = __builtin_amdgcn_mfma_f32_16x16x32_f16(__builtin_bit_cast(h8, Bt[n][k]), __builtin_bit_cast(h8, At[m][k]), acc[ai][bj][m][n], 0, 0, 0); __builtin_amdgcn_s_setprio(0); } while (0)
#define PG8_WAIT_V(n) asm volatile("s_waitcnt vmcnt(" #n ")" ::: "memory")
#define PG8_WAIT_L(n) asm volatile("s_waitcnt lgkmcnt(" #n ")" ::: "memory")
#define PG8_BAR __builtin_amdgcn_s_barrier()
#define PG8_SCHED __builtin_amdgcn_sched_barrier(0)
    Unit cur, nxt; int ui = 0;
    if (!S.next(0, cur)) return;
    f32x4 acc[2][2][4][2];
#pragma unroll
    for (int a = 0; a < 2; ++a)
#pragma unroll
        for (int b = 0; b < 2; ++b)
#pragma unroll
            for (int m = 0; m < 4; ++m)
#pragma unroll
                for (int n = 0; n < 2; ++n) acc[a][b][m][n] = (f32x4){0.f, 0.f, 0.f, 0.f};
    bf16x8 At[4][2], B0[2][2], B1[2][2];
    const char* cA = (const char*)g.A + (size_t)cur.pm * tstep; const char* cB = (const char*)g.Bt + (size_t)cur.pn * tstep;
    S.a_ready(cur);
    if constexpr (SP2) {
        PG8_STAGE(PG8_SB(0, 0), cB, voffB); PG8_STAGE(PG8_SB(0, 1), cB + hstep, voffB); PG8_STAGE(PG8_SA(0, 0), cA, voffA); PG8_STAGE(PG8_SA(0, 1), cA + hstep, voffA);
        if (wr == 1) PG8_BAR;
        PG8_WAIT_V(2); PG8_BAR;
        PG8_STAGE(PG8_SB(1, 0), cB + kstep, voffB); PG8_STAGE(PG8_SA(1, 0), cA + kstep, voffA); PG8_STAGE(PG8_SB(1, 1), cB + hstep + kstep, voffB);
        PG8_WAIT_V(6); PG8_BAR;
    } else {
        PG8_STAGE(PG8_SB(0, 0), cB, voffB); PG8_STAGE(PG8_SA(0, 0), cA, voffA); PG8_STAGE(PG8_SB(0, 1), cB + hstep, voffB); PG8_STAGE(PG8_SA(0, 1), cA + hstep, voffA);
        if (wr == 1) PG8_BAR;
        PG8_WAIT_V(4); PG8_BAR;
        PG8_STAGE(PG8_SB(1, 0), cB + kstep, voffB); PG8_STAGE(PG8_SA(1, 0), cA + kstep, voffA); PG8_STAGE(PG8_SB(1, 1), cB + hstep + kstep, voffB);
        PG8_WAIT_V(6); PG8_BAR;
    }
    for (;;) {
        const bool has_next = S.next(ui + 1, nxt);
        const char* nA = has_next ? (const char*)g.A + (size_t)nxt.pm * tstep : cA; const char* nB = has_next ? (const char*)g.Bt + (size_t)nxt.pn * tstep : cB;
        for (int t = 0; t < nt; t += 2) {
            const bool last = (t == nt - 2);
            const char* a1 = cA + (size_t)(t + 1) * kstep;
            const char* a2 = last ? nA : cA + (size_t)(t + 2) * kstep; const char* b2 = last ? nB : cB + (size_t)(t + 2) * kstep;
            const char* a3 = a2 + kstep; const char* b3 = b2 + kstep;
            if (last && has_next) S.a_ready(nxt);
            if constexpr (SP2) {
            PG8_LDB(B0, 0, 0); PG8_LDB(B1, 0, 1); PG8_SCHED; PG8_LDA(At, 0, 0); PG8_STAGE(PG8_SA(1, 1), a1 + hstep, voffA);
            PG8_WAIT_V(8); PG8_WAIT_L(0); PG8_BAR; PG8_MMA(0, 0, At, B0); PG8_MMA(0, 1, At, B1); PG8_BAR; PG8_SCHED;
            PG8_LDA(At, 0, 1); PG8_STAGE(PG8_SB(0, 0), b2, voffB); PG8_STAGE(PG8_SB(0, 1), b2 + hstep, voffB); PG8_STAGE(PG8_SA(0, 0), a2, voffA);
            PG8_WAIT_V(8); PG8_WAIT_L(0); PG8_BAR; PG8_MMA(1, 0, At, B0); PG8_MMA(1, 1, At, B1); PG8_BAR; PG8_SCHED;
            PG8_LDB(B0, 1, 0); PG8_LDB(B1, 1, 1); PG8_SCHED; PG8_LDA(At, 1, 0); PG8_STAGE(PG8_SA(0, 1), a2 + hstep, voffA);
            PG8_WAIT_V(8); PG8_WAIT_L(0); PG8_BAR; PG8_MMA(0, 0, At, B0); PG8_MMA(0, 1, At, B1); PG8_BAR; PG8_SCHED;
            PG8_LDA(At, 1, 1); PG8_STAGE(PG8_SB(1, 0), b3, voffB); PG8_STAGE(PG8_SB(1, 1), b3 + hstep, voffB); PG8_STAGE(PG8_SA(1, 0), a3, voffA);
            PG8_WAIT_V(8); PG8_WAIT_L(0); PG8_BAR; PG8_MMA(1, 0, At, B0); PG8_MMA(1, 1, At, B1); PG8_BAR; PG8_SCHED;
            } else {
            PG8_LDB(B0, 0, 0); PG8_SCHED; PG8_LDA(At, 0, 0); PG8_STAGE(PG8_SA(1, 1), a1 + hstep, voffA);
            PG8_WAIT_L(8); PG8_BAR; PG8_WAIT_L(0); PG8_MMA(0, 0, At, B0); PG8_BAR; PG8_SCHED;
            PG8_LDB(B1, 0, 1); PG8_STAGE(PG8_SB(0, 0), b2, voffB);
            PG8_BAR; PG8_WAIT_L(0); PG8_MMA(0, 1, At, B1); PG8_BAR;
            PG8_LDA(At, 0, 1); PG8_STAGE(PG8_SA(0, 0), a2, voffA);
            PG8_BAR; PG8_WAIT_L(0); PG8_MMA(1, 0, At, B0); PG8_BAR; PG8_SCHED;
            PG8_STAGE(PG8_SB(0, 1), b2 + hstep, voffB);
            PG8_WAIT_V(6); PG8_BAR; PG8_MMA(1, 1, At, B1); PG8_BAR;
            PG8_LDB(B0, 1, 0); PG8_SCHED; PG8_LDA(At, 1, 0); PG8_STAGE(PG8_SA(0, 1), a2 + hstep, voffA);
            PG8_WAIT_L(8); PG8_BAR; PG8_WAIT_L(0); PG8_MMA(0, 0, At, B0); PG8_BAR; PG8_SCHED;
            PG8_LDB(B1, 1, 1); PG8_STAGE(PG8_SB(1, 0), b3, voffB);
            PG8_BAR; PG8_WAIT_L(0); PG8_MMA(0, 1, At, B1); PG8_BAR;
            PG8_LDA(At, 1, 1); PG8_STAGE(PG8_SA(1, 0), a3, voffA);
            PG8_BAR; PG8_WAIT_L(0); PG8_MMA(1, 0, At, B0); PG8_BAR; PG8_SCHED;
            PG8_STAGE(PG8_SB(1, 1), b3 + hstep, voffB);
            PG8_WAIT_V(6); PG8_BAR; PG8_MMA(1, 1, At, B1); PG8_BAR;
            }
        }
        if constexpr (ALIGN_EPI) { if (wr == 0) PG8_BAR; }
        if constexpr (!Epi::AFTER_DRAIN) { E(acc, cur, wr, wc, fr, fq); S.done(cur); }
        if (!has_next) break;
#pragma unroll
        for (int a = 0; a < 2; ++a)
#pragma unroll
            for (int b = 0; b < 2; ++b)
#pragma unroll
                for (int m = 0; m < 4; ++m)
#pragma unroll
                    for (int n = 0; n < 2; ++n) acc[a][b][m][n] = (f32x4){0.f, 0.f, 0.f, 0.f};
        cur = nxt; cA = nA; cB = nB; ++ui;
        if constexpr (ALIGN_EPI) { if (wr == 1) PG8_BAR; }
    }
    PG8_WAIT_V(0);
    if constexpr (!ALIGN_EPI) { if (wr == 0) PG8_BAR; }
    PG8_BAR;
    if constexpr (Epi::AFTER_DRAIN) { E.fused(acc, cur, wr, wc, fr, fq, lds, wid, lane); S.done(cur); }
#undef PG8_SA
#undef PG8_SB
#undef PG8_STAGE
#undef PG8_LDA
#undef PG8_LDB
#undef PG8_MMA
#undef PG8_WAIT_V
#undef PG8_WAIT_L
#undef PG8_BAR
#undef PG8_SCHED
}
}

#define XB_TMO      128
#define XB_XCNT(j)  (256  + 64 * (j))
#define XB_XSUB(j)  (1280 + 64 * (j))
#define XB_XGEN(j)  (2304 + 64 * (j))
#define XB_TOP      3328
#define XB_TOPGEN   3392
#define XCD_BAR_WORDS 3456
#define XB_SPIN_CAP (1u << 18)
#define LAS __attribute__((address_space(3)))

__device__ __forceinline__ unsigned xb_ld(unsigned* p)              { return __hip_atomic_load(p, __ATOMIC_RELAXED, __HIP_MEMORY_SCOPE_AGENT); }
__device__ __forceinline__ unsigned xb_add(unsigned* p, unsigned v) { return __hip_atomic_fetch_add(p, v, __ATOMIC_RELAXED, __HIP_MEMORY_SCOPE_AGENT); }
__device__ __forceinline__ unsigned xb_xcc_id() { return (unsigned)__builtin_amdgcn_s_getreg((3 << 11) | 20) & 0xFu; }
#define XB_SPIN(cond, bar) do { unsigned _sp = 0; while (cond) { __builtin_amdgcn_s_sleep(1); \
    if ((++_sp & 255u) == 0u) { if (xb_ld(&(bar)[XB_TMO])) break; if (_sp > XB_SPIN_CAP) { atomicAdd(&(bar)[XB_TMO], 1u); break; } } } } while (0)

struct XcdBarrier {
    unsigned* bar; unsigned x;
    volatile LAS unsigned* st;
};

__device__ __forceinline__ XcdBarrier xcd_barrier_post(unsigned* bar, volatile LAS unsigned* st) {
    XcdBarrier b; b.bar = bar; b.x = xb_xcc_id(); b.st = st;
    if (threadIdx.x == 0) (void)xb_add(&bar[XB_XCNT(b.x)], 1u);
    return b;
}
__device__ __forceinline__ void xcd_barrier_complete(unsigned* bar, unsigned x, unsigned& nloc, unsigned& nx) {
    const unsigned G = gridDim.x * gridDim.y * gridDim.z;
    unsigned sum, cnt, mine, sp = 0u;
    for (;;) {
        sum = 0u; cnt = 0u; mine = 0u;
#pragma unroll
        for (unsigned j = 0; j < 16; ++j) { const unsigned c = xb_ld(&bar[XB_XCNT(j)]); sum += c; cnt += (c > 0u) ? 1u : 0u; mine = (j == x) ? c : mine; }
        if (sum == G) break;
        __builtin_amdgcn_s_sleep(1);
        if ((++sp & 255u) == 0u) { if (xb_ld(&bar[XB_TMO])) break; if (sp > XB_SPIN_CAP) { atomicAdd(&bar[XB_TMO], 1u); break; } }
    }
    nloc = mine > 0u ? mine : 1u; nx = cnt > 0u ? cnt : 1u;
}

__device__ __forceinline__ void xcd_barrier(const XcdBarrier& b, const bool leader_thread) {
    asm volatile("s_waitcnt vmcnt(0)" ::: "memory");
    __syncthreads();
    if (leader_thread) {
        unsigned* bar = b.bar;
        __builtin_amdgcn_s_waitcnt(0);
        unsigned nloc = b.st[0], nx = b.st[1];
        if (nloc == 0u) { xcd_barrier_complete(bar, b.x, nloc, nx); b.st[0] = nloc; b.st[1] = nx; }
        const unsigned old = xb_add(&bar[XB_XSUB(b.x)], 1u);
        const unsigned gen = old / nloc;
        if (old + 1u == (gen + 1u) * nloc) {
            __builtin_amdgcn_fence(__ATOMIC_RELEASE, "agent");
            asm volatile("s_waitcnt vmcnt(0)" ::: "memory");
            const unsigned og = xb_add(&bar[XB_TOP], 1u);
            const unsigned tg = og / nx;
            if (og + 1u == (tg + 1u) * nx) xb_add(&bar[XB_TOPGEN], 1u);
            else XB_SPIN(xb_ld(&bar[XB_TOPGEN]) == tg, bar);
            __builtin_amdgcn_fence(__ATOMIC_ACQUIRE, "agent");
            xb_add(&bar[XB_XGEN(b.x)], 1u);
            asm volatile("s_waitcnt vmcnt(0)" ::: "memory");
        } else {
            XB_SPIN(xb_ld(&bar[XB_XGEN(b.x)]) == gen, bar);
            __builtin_amdgcn_fence(__ATOMIC_ACQUIRE, "agent");
            asm volatile("s_waitcnt vmcnt(0)" ::: "memory");
        }
    }
    __syncthreads();
}

constexpr int NB = 2, SEQ = 16384, TLEN = 16400, DM = 1024, NMETA = 16, DEPTH = 2;
constexpr int MR = NB * SEQ;
constexpr int MV = MR + NB * NMETA;
constexpr int MP = 33024;
constexpr int INCOLS = 3912, NPAD = 4096, DFF = 4096;
constexpr int NTHREADS = 512;
constexpr float LOG2E = 1.4426950408889634f;
constexpr float QA_SCALE = 0.125f * LOG2E;
constexpr float QB_SCALE = 0.17677669529663687f * LOG2E;
constexpr float WI_SCALE = 0.044194173824159216f;
constexpr int NKS = 513;

constexpr size_t al256(size_t x) { return (x + 255) & ~(size_t)255; }
constexpr size_t WS_CTL   = 0;
constexpr size_t CTL_BYTES = 65536;
constexpr size_t WS_HMETA = CTL_BYTES;
constexpr size_t WS_ROPE  = WS_HMETA + (size_t)256 * DM * 4;
constexpr size_t WS_W     = al256(WS_ROPE + (size_t)TLEN * 32 * 8);
constexpr size_t W_IN_OFF = 0, W_OUT_OFF = (size_t)NPAD * DM * 2, W_FF1_OFF = W_OUT_OFF + (size_t)DM * DM * 2,
                 W_FF2_OFF = W_FF1_OFF + (size_t)DFF * DM * 2, W_LAYER = W_FF2_OFF + (size_t)DM * DFF * 2;
constexpr size_t WS_ABUF  = al256(WS_W + DEPTH * W_LAYER);
constexpr size_t WS_MASK  = WS_ABUF + (size_t)MP * DM * 2;
constexpr size_t WS_U     = al256(WS_MASK + (size_t)NB * NKS * TLEN * 4);
constexpr size_t WS_S     = WS_U + (size_t)NB * 4 * 129 * 4096 * 4;
constexpr size_t WS_PROJ  = WS_S + (size_t)NB * 4 * 129 * 4096 * 4;
constexpr size_t P512 = (size_t)MP * 512 * 2, P256 = (size_t)MP * 256 * 2;
constexpr size_t PJ_QA = 0, PJ_KA = P512, PJ_VA = 2 * P512, PJ_QI = 3 * P512, PJ_256 = 4 * P512;
constexpr size_t PJ_QB = PJ_256, PJ_KB = PJ_256 + P256, PJ_VB = PJ_256 + 2 * P256, PJ_QC = PJ_256 + 3 * P256, PJ_KC = PJ_256 + 4 * P256,
                 PJ_VC = PJ_256 + 5 * P256, PJ_GC = PJ_256 + 6 * P256, PJ_KI = PJ_256 + 7 * P256, PJ_WI = PJ_KI + (size_t)MP * 64 * 2,
                 PJ_END = PJ_WI + (size_t)MP * 8 * 4;
constexpr size_t ACT_BYTES = (size_t)MP * DFF * 2;
constexpr size_t WS_END = WS_PROJ + (ACT_BYTES > PJ_END ? ACT_BYTES : PJ_END);
constexpr int CW_BAR = 0;
constexpr int CW_KMAX = 4096;

constexpr int LDS_BYTES = 156 * 1024;
constexpr int LDS_MISC = 0, LDS_GEN = 256;

struct Args { const float* in[13]; float* out; unsigned char* ws; int ph_lo, ph_hi; };

struct Frame {
    const float *x, *meta, *rel_bias, *w_in, *norm_mix, *diff_lambda, *diff_norm, *ret_norm, *w_out, *norm_ff, *w_ff1, *w_ff2, *final_norm;
    float* out; unsigned char* ws; LAS unsigned char* lds; int tid, lane, wave, bid, G;
};

__device__ __forceinline__ float shx(float v, int m, int lane) { return __builtin_bit_cast(float, __builtin_amdgcn_ds_bpermute((lane ^ m) << 2, __builtin_bit_cast(int, v))); }
template <int M> __device__ __forceinline__ float sx(float v, int lane) { return shx(v, M, lane); }
__device__ __forceinline__ float hsum32(float v, int lane) { return v + shx(v, 32, lane); }
__device__ __forceinline__ unsigned hor32(unsigned v, int lane) { return v | (unsigned)__builtin_amdgcn_ds_bpermute((lane ^ 32) << 2, (int)v); }
__device__ __forceinline__ float bcast0(float v) { return __builtin_bit_cast(float, __builtin_amdgcn_ds_bpermute(0, __builtin_bit_cast(int, v))); }
__device__ __forceinline__ float wave_sum(float v, int lane) { v = hsum32(v, lane); v += sx<16>(v, lane); v += sx<8>(v, lane); v += sx<4>(v, lane); v += sx<2>(v, lane); v += sx<1>(v, lane); return v; }
__device__ __forceinline__ unsigned cvt_pk_bf16(float lo, float hi) { unsigned r; asm volatile("v_cvt_pk_bf16_f32 %0, %1, %2" : "=v"(r) : "v"(lo), "v"(hi)); return r; }
__device__ __forceinline__ unsigned cvt_pk_f16(float lo, float hi) { h2 p; p.x = (_Float16)lo; p.y = (_Float16)hi; return __builtin_bit_cast(unsigned, p); }
typedef unsigned u32x4 __attribute__((ext_vector_type(4)));
typedef float f32x4 __attribute__((ext_vector_type(4)));
__device__ __forceinline__ u32x4 pack8(const f32x4& a, const f32x4& b, bool bf) {
    u32x4 w;
    if (bf) { w.x = cvt_pk_bf16(a[0], a[1]); w.y = cvt_pk_bf16(a[2], a[3]); w.z = cvt_pk_bf16(b[0], b[1]); w.w = cvt_pk_bf16(b[2], b[3]); }
    else    { w.x = cvt_pk_f16(a[0], a[1]);  w.y = cvt_pk_f16(a[2], a[3]);  w.z = cvt_pk_f16(b[0], b[1]);  w.w = cvt_pk_f16(b[2], b[3]); }
    return w;
}
__device__ __forceinline__ int row_pos(int r) { return r < MR ? (r & (SEQ - 1)) + NMETA : ((r - MR) & 15); }

__device__ __forceinline__ int incol_map(int n) {
    if (n < 2048) return n;
    if (n < 2816) return n - 2048 + 2120;
    if (n < 3328) {
        const int seg = (n - 2816) >> 8, c = (n - 2816) & 255, head = c >> 6, p = c & 63;
        const int g = p >> 3, nn = (p >> 2) & 1, i = p & 3, d = 32 * nn + 4 * g + i;
        return (seg ? 3144 : 2888) + head * 64 + d;
    }
    if (n < 3840) return n - 3328 + 3400;
    if (n < 3904) return n - 3840 + 2048;
    if (n < 3912) return n - 3904 + 2112;
    return -1;
}

__constant__ double ROPE_REV[32] = {0.15915494309189535, 0.11934937021124886, 0.08949940160889101, 0.06711508300522726, 0.050329212104487035, 0.03774158471741977, 0.0283021958306234, 0.02122365276477766, 0.015915494309189534, 0.011934937021124886, 0.008949940160889102, 0.006711508300522725, 0.005032921210448704, 0.003774158471741977, 0.00283021958306234, 0.0021223652764777662, 0.0015915494309189536, 0.0011934937021124885, 0.0008949940160889102, 0.0006711508300522726, 0.0005032921210448703, 0.00037741584717419774, 0.00028302195830623395, 0.0002122365276477766, 0.00015915494309189535, 0.00011934937021124886, 8.949940160889102e-05, 6.711508300522725e-05, 5.0329212104487035e-05, 3.774158471741978e-05, 2.8302195830623396e-05, 2.122365276477766e-05};

struct EpiInProj {
    static constexpr bool PERM = true, AFTER_DRAIN = false;
    unsigned char* proj; const f32x2* rope; unsigned* kmax;
    __device__ __forceinline__ void kmax_update(const pg8::f32x4 (&acc)[2][2][4][2], int bj, unsigned* word, int fr, int fq) const {
        float mx = 0.f; const int LN = fq * 16 + fr;
#pragma unroll
        for (int ai = 0; ai < 2; ++ai)
#pragma unroll
            for (int m = 0; m < 4; ++m) {
                const pg8::f32x4 a = acc[ai][bj][m][0], b = acc[ai][bj][m][1];
                float s = (a[0] * a[0] + a[1] * a[1]) + (a[2] * a[2] + a[3] * a[3]) + (b[0] * b[0] + b[1] * b[1]) + (b[2] * b[2] + b[3] * b[3]);
                s += sx<16>(s, LN); s = hsum32(s, LN);
                mx = fmaxf(mx, s);
            }
        mx = fmaxf(mx, sx<1>(mx, LN)); mx = fmaxf(mx, sx<2>(mx, LN)); mx = fmaxf(mx, sx<4>(mx, LN)); mx = fmaxf(mx, sx<8>(mx, LN));
        if (fr == 0 && fq == 0) atomicMax(word, __float_as_uint(mx));
    }
    __device__ __forceinline__ void operator()(const pg8::f32x4 (&acc)[2][2][4][2], const pg8::Unit& u, int wr, int wc, int fr, int fq) const {
        const int pn = u.pn, rbase = u.pm * 256 + wr * 64 + fr, cw = wc * 32 + 8 * fq;
        if (pn <= 7 || (pn <= 14 && pn != 11 && pn != 12)) {
            unsigned char* base; int ld, colt; float scale = 1.f; bool bf = false;
            if (pn <= 7) { const int arr = pn >> 1; base = proj + (size_t)arr * P512; ld = 512; colt = (pn & 1) * 256; if (arr == 0) scale = QA_SCALE; bf = (arr == 2); }
            else { const int arr = pn - 8; base = proj + PJ_256 + (size_t)arr * P256; ld = 256; colt = 0; if (arr == 0) scale = QB_SCALE; bf = (arr == 2); }
#pragma unroll
            for (int ai = 0; ai < 2; ++ai)
#pragma unroll
                for (int m = 0; m < 4; ++m) {
                    const int row = rbase + ai * 128 + m * 16;
#pragma unroll
                    for (int bj = 0; bj < 2; ++bj) {
                        const pg8::f32x4 v0 = acc[ai][bj][m][0] * scale, v1 = acc[ai][bj][m][1] * scale;
                        *(u32x4*)(base + ((size_t)row * ld + colt + bj * 128 + cw) * 2) = pack8(v0, v1, bf);
                    }
                }
            if (pn == 2 || pn == 3) {
#pragma unroll
                for (int bj = 0; bj < 2; ++bj) { const int head = ((pn & 1) * 256 + bj * 128 + wc * 32) >> 6; kmax_update(acc, bj, kmax + head * 2 + (wc & 1), fr, fq); }
            }
            if (pn == 9) {
#pragma unroll
                for (int bj = 0; bj < 2; ++bj) { const int head = 2 * bj + (wc >> 1); kmax_update(acc, bj, kmax + 16 + head * 2 + (wc & 1), fr, fq); }
            }
        } else if (pn == 11 || pn == 12) {
            unsigned char* base = proj + PJ_256 + (size_t)(pn - 8) * P256;
            const float sc = (pn == 12) ? 0.125f : 1.f;
            const int g = 4 * (wc & 1) + fq;
#pragma unroll
            for (int ai = 0; ai < 2; ++ai)
#pragma unroll
                for (int m = 0; m < 4; ++m) {
                    const int row = rbase + ai * 128 + m * 16, t = row_pos(row);
                    const pg8::f32x4 cs0 = *(const pg8::f32x4*)(rope + (size_t)t * 32 + 4 * g), cs1 = *(const pg8::f32x4*)(rope + (size_t)t * 32 + 4 * g + 2);
                    const float c[4] = {cs0[0], cs0[2], cs1[0], cs1[2]}, s[4] = {cs0[1], cs0[3], cs1[1], cs1[3]};
#pragma unroll
                    for (int bj = 0; bj < 2; ++bj) {
                        const pg8::f32x4 x1 = acc[ai][bj][m][0], x2 = acc[ai][bj][m][1];
                        float o1[4], o2[4];
#pragma unroll
                        for (int i = 0; i < 4; ++i) { o1[i] = (x1[i] * c[i] - x2[i] * s[i]) * sc; o2[i] = (x1[i] * s[i] + x2[i] * c[i]) * sc; }
                        const int head = 2 * bj + (wc >> 1);
                        unsigned char* rp = base + ((size_t)row * 256 + head * 64 + 4 * g) * 2;
                        u32x2 w1, w2; w1.x = cvt_pk_f16(o1[0], o1[1]); w1.y = cvt_pk_f16(o1[2], o1[3]); w2.x = cvt_pk_f16(o2[0], o2[1]); w2.y = cvt_pk_f16(o2[2], o2[3]);
                        *(u32x2*)rp = w1; *(u32x2*)(rp + 64) = w2;
                    }
                }
        } else {
#pragma unroll
            for (int ai = 0; ai < 2; ++ai)
#pragma unroll
                for (int m = 0; m < 4; ++m) {
                    const int row = rbase + ai * 128 + m * 16;
                    const pg8::f32x4 v0 = acc[ai][0][m][0], v1 = acc[ai][0][m][1];
                    if (wc < 2) *(u32x4*)(proj + PJ_KI + ((size_t)row * 64 + cw) * 2) = pack8(v0, v1, false);
                    else if (wc == 2 && fq == 0) { float* wp = (float*)(proj + PJ_WI) + (size_t)row * 8; *(pg8::f32x4*)wp = v0 * WI_SCALE; *(pg8::f32x4*)(wp + 4) = v1 * WI_SCALE; }
                }
        }
    }
};
struct EpiRes {
    static constexpr bool PERM = false, AFTER_DRAIN = false;
    const float* res_main; float* out_main; float* hmeta;
    __device__ __forceinline__ void operator()(const pg8::f32x4 (&acc)[2][2][4][2], const pg8::Unit& u, int wr, int wc, int fr, int fq) const {
        const bool mt = (u.pm * 256 >= MR);
        const float* rb = mt ? hmeta : res_main; float* ob = mt ? hmeta : out_main;
        const int row0 = (mt ? u.pm * 256 - MR : u.pm * 256) + wr * 64 + fr, col0 = u.pn * 256 + wc * 32 + 4 * fq;
#pragma unroll
        for (int ai = 0; ai < 2; ++ai)
#pragma unroll
            for (int m = 0; m < 4; ++m) {
                const size_t ro = (size_t)(row0 + ai * 128 + m * 16) * DM + col0;
#pragma unroll
                for (int bj = 0; bj < 2; ++bj)
#pragma unroll
                    for (int n = 0; n < 2; ++n) { const pg8::f32x4 v = *(const pg8::f32x4*)(rb + ro + bj * 128 + n * 16) + acc[ai][bj][m][n]; *(pg8::f32x4*)(ob + ro + bj * 128 + n * 16) = v; }
            }
    }
};
struct EpiRelu2 {
    static constexpr bool PERM = true, AFTER_DRAIN = false;
    unsigned char* act;
    __device__ __forceinline__ void operator()(const pg8::f32x4 (&acc)[2][2][4][2], const pg8::Unit& u, int wr, int wc, int fr, int fq) const {
        const int rbase = u.pm * 256 + wr * 64 + fr, col0 = u.pn * 256 + wc * 32 + 8 * fq;
#pragma unroll
        for (int ai = 0; ai < 2; ++ai)
#pragma unroll
            for (int m = 0; m < 4; ++m) {
                const int row = rbase + ai * 128 + m * 16;
#pragma unroll
                for (int bj = 0; bj < 2; ++bj) {
                    pg8::f32x4 v0 = acc[ai][bj][m][0], v1 = acc[ai][bj][m][1];
#pragma unroll
                    for (int i = 0; i < 4; ++i) { const float a = fmaxf(v0[i], 0.f), b = fmaxf(v1[i], 0.f); v0[i] = a * a; v1[i] = b * b; }
                    *(u32x4*)(act + ((size_t)row * DFF + col0 + bj * 128) * 2) = pack8(v0, v1, false);
                }
            }
    }
};

struct WTile { const float* src; _Float16* dst; int ld, K, k0, n0, mapped; };
constexpr int WT_PER_LAYER = 16 * 64 + 16 * 16 + 16 * 64 + 64 * 16, WT_TOTAL = DEPTH * WT_PER_LAYER;
__device__ __forceinline__ WTile wt_desc(const Frame& F, int t) {
    WTile d; const int l = t / WT_PER_LAYER; int r = t - l * WT_PER_LAYER;
    unsigned char* wl = F.ws + WS_W + (size_t)l * W_LAYER;
    if (r < 1024)      { d.src = F.w_in + (size_t)l * DM * INCOLS; d.dst = (_Float16*)(wl + W_IN_OFF);  d.ld = INCOLS; d.K = DM;  d.mapped = 1; d.k0 = (r & 15) * 64; d.n0 = (r >> 4) * 64; }
    else if (r < 1280) { r -= 1024; d.src = F.w_out + (size_t)l * DM * DM;  d.dst = (_Float16*)(wl + W_OUT_OFF); d.ld = DM;  d.K = DM;  d.mapped = 0; d.k0 = (r & 15) * 64; d.n0 = (r >> 4) * 64; }
    else if (r < 2304) { r -= 1280; d.src = F.w_ff1 + (size_t)l * DM * DFF; d.dst = (_Float16*)(wl + W_FF1_OFF); d.ld = DFF; d.K = DM;  d.mapped = 0; d.k0 = (r & 15) * 64; d.n0 = (r >> 4) * 64; }
    else               { r -= 2304; d.src = F.w_ff2 + (size_t)l * DFF * DM; d.dst = (_Float16*)(wl + W_FF2_OFF); d.ld = DM;  d.K = DFF; d.mapped = 0; d.k0 = (r & 63) * 64; d.n0 = (r >> 6) * 64; }
    return d;
}
__device__ __forceinline__ void wt_load(const WTile& d, int tid, f32x4& v0, f32x4& v1) {
    const int kk = tid >> 4, n4 = (tid & 15) * 4; const int sc = d.mapped ? incol_map(d.n0 + n4) : d.n0 + n4;
    v0 = (f32x4){0.f, 0.f, 0.f, 0.f}; v1 = v0;
    if (sc >= 0) { v0 = *(const f32x4*)(d.src + (size_t)(d.k0 + kk) * d.ld + sc); v1 = *(const f32x4*)(d.src + (size_t)(d.k0 + kk + 32) * d.ld + sc); }
}
__device__ __forceinline__ void wtrans_all(const Frame& F) {
    LAS float* tile = (LAS float*)(F.lds + LDS_GEN); const int tid = F.tid;
    int t = F.bid; if (t >= WT_TOTAL) return;
    WTile d = wt_desc(F, t); f32x4 v0, v1; wt_load(d, tid, v0, v1);
#pragma unroll 1
    for (;;) {
        const int tn = t + F.G; WTile dn = d; f32x4 n0 = v0, n1 = v1;
        if (tn < WT_TOTAL) { dn = wt_desc(F, tn); wt_load(dn, tid, n0, n1); }
        { const int kk = tid >> 4, n4 = (tid & 15) * 4;
#pragma unroll
          for (int e = 0; e < 4; ++e) { tile[kk * 65 + n4 + e] = v0[e]; tile[(kk + 32) * 65 + n4 + e] = v1[e]; } }
        __syncthreads();
        { const int nn = tid >> 3, k8 = (tid & 7) * 8; h8 o;
#pragma unroll
          for (int e = 0; e < 8; ++e) o[e] = (_Float16)tile[(k8 + e) * 65 + nn];
          *(h8*)(d.dst + (size_t)(d.n0 + nn) * d.K + d.k0 + k8) = o; }
        __syncthreads();
        if (tn >= WT_TOTAL) break;
        t = tn; d = dn; v0 = n0; v1 = n1;
    }
}
template <int MODE> __device__ __forceinline__ void norm_to_abuf(const Frame& F, const float* gain) {
    _Float16* abuf = (_Float16*)(F.ws + WS_ABUF); const float* hmeta = (const float*)(F.ws + WS_HMETA);
    const int nw = F.G * 8;
    for (int r = F.bid * 8 + F.wave; r < MP; r += nw) {
        _Float16* dst = abuf + (size_t)r * DM;
        if (r >= MV) { const h4 z = {(_Float16)0.f, (_Float16)0.f, (_Float16)0.f, (_Float16)0.f};
#pragma unroll
            for (int j = 0; j < 4; ++j) *(h4*)(dst + j * 256 + F.lane * 4) = z; continue; }
        const float* src = MODE == 0 ? (r < MR ? F.x + (size_t)r * DM : F.meta + (size_t)((r - MR) & 15) * DM) : (r < MR ? F.out + (size_t)r * DM : hmeta + (size_t)(r - MR) * DM);
        f32x4 v[4]; float ss = 0.f;
#pragma unroll
        for (int j = 0; j < 4; ++j) { v[j] = *(const f32x4*)(src + j * 256 + F.lane * 4); ss += (v[j][0] * v[j][0] + v[j][1] * v[j][1]) + (v[j][2] * v[j][2] + v[j][3] * v[j][3]); }
        ss = wave_sum(ss, F.lane); const float rstd = rsqrtf(ss * (1.0f / DM) + 1e-6f);
#pragma unroll
        for (int j = 0; j < 4; ++j) { const f32x4 g = *(const f32x4*)(gain + j * 256 + F.lane * 4); h4 o;
#pragma unroll
            for (int e = 0; e < 4; ++e) o[e] = (_Float16)(v[j][e] * rstd * g[e]);
            *(h4*)(dst + j * 256 + F.lane * 4) = o; }
    }
}
__device__ __forceinline__ void final_norm(const Frame& F) {
    const int nw = F.G * 8;
    for (int r = F.bid * 8 + F.wave; r < MR; r += nw) {
        float* p = F.out + (size_t)r * DM; f32x4 v[4]; float ss = 0.f;
#pragma unroll
        for (int j = 0; j < 4; ++j) { v[j] = *(const f32x4*)(p + j * 256 + F.lane * 4); ss += (v[j][0] * v[j][0] + v[j][1] * v[j][1]) + (v[j][2] * v[j][2] + v[j][3] * v[j][3]); }
        ss = wave_sum(ss, F.lane); const float rstd = rsqrtf(ss * (1.0f / DM) + 1e-6f);
#pragma unroll
        for (int j = 0; j < 4; ++j) { const f32x4 g = *(const f32x4*)(F.final_norm + j * 256 + F.lane * 4); *(f32x4*)(p + j * 256 + F.lane * 4) = v[j] * rstd * g; }
    }
}
__device__ __forceinline__ void prologue(const Frame& F) {
    const int gtid = F.bid * NTHREADS + F.tid, gsz = F.G * NTHREADS;
    float* hmeta = (float*)(F.ws + WS_HMETA);
    for (int i = gtid; i < 256 * DM / 4; i += gsz) { const int row = i / (DM / 4), c4 = i % (DM / 4); f32x4 v = {0.f, 0.f, 0.f, 0.f}; if (row < NB * NMETA) v = *(const f32x4*)(F.meta + (size_t)(row & 15) * DM + c4 * 4); *(f32x4*)(hmeta + (size_t)row * DM + c4 * 4) = v; }
    f32x2* rope = (f32x2*)(F.ws + WS_ROPE);
    for (int i = gtid; i < TLEN * 32; i += gsz) { const int t = i >> 5, d = i & 31; const double rev = (double)t * ROPE_REV[d]; const float fr = (float)(rev - __builtin_floor(rev)); f32x2 cs; cs.x = __builtin_amdgcn_cosf(fr); cs.y = __builtin_amdgcn_sinf(fr); rope[i] = cs; }
    wtrans_all(F);
    norm_to_abuf<0>(F, F.norm_mix);
}
__device__ __forceinline__ int crow(int i, int h) { return (i & 3) + 8 * (i >> 2) + 4 * h; }
constexpr size_t WS_SCR = WS_U;
template <bool FROM_SCR> __device__ __forceinline__ void skinny_task(const unsigned char* A, int lda_bytes, const float* scr, const _Float16* Bt, int K, int n0, int k0, float* dst, int ldd, int lane) {
    const int r = lane & 31, h = lane >> 5;
    f32x16 acc;
#pragma unroll
    for (int i = 0; i < 16; ++i) acc[i] = 0.f;
#pragma unroll 1
    for (int kc = 0; kc < 4; ++kc) {
    h8 a[4], bb[4];
#pragma unroll
    for (int s = 0; s < 4; ++s) {
        const int k = k0 + 64 * kc + 16 * s + 8 * h;
        if (FROM_SCR) { const f32x4 x0 = *(const f32x4*)(scr + (size_t)r * DFF + k), x1 = *(const f32x4*)(scr + (size_t)r * DFF + k + 4);
#pragma unroll
            for (int e = 0; e < 4; ++e) { const float u = fmaxf(x0[e], 0.f), v = fmaxf(x1[e], 0.f); a[s][e] = (_Float16)(u * u); a[s][4 + e] = (_Float16)(v * v); } }
        else a[s] = *(const h8*)(A + (size_t)(MR + r) * lda_bytes + (size_t)k * 2);
        bb[s] = *(const h8*)(Bt + (size_t)(n0 + r) * K + k);
    }
#pragma unroll
    for (int s = 0; s < 4; ++s) acc = __builtin_amdgcn_mfma_f32_32x32x16_f16(a[s], bb[s], acc, 0, 0, 0);
    }
#pragma unroll
    for (int i = 0; i < 16; ++i) atomicAdd(dst + (size_t)crow(i, h) * ldd + n0 + r, acc[i]);
}
template <int MODE> __device__ __forceinline__ void skinny_meta(const Frame& F, const unsigned char* wl) {
    const int ntn = MODE == 1 ? 128 : 32, nks = MODE == 2 ? 16 : 4, ntask = ntn * nks;
    float* hmeta = (float*)(F.ws + WS_HMETA); float* scr = (float*)(F.ws + WS_SCR);
#pragma unroll 1
    for (int task = F.bid * 8 + F.wave; task < ntask; task += F.G * 8) {
        const int nt = task % ntn, ks = task / ntn;
        if (MODE == 0) skinny_task<false>(F.ws + WS_ABUF, DM * 2, nullptr, (const _Float16*)(wl + W_OUT_OFF), DM, nt * 32, ks * 256, hmeta, DM, F.lane);
        if (MODE == 1) skinny_task<false>(F.ws + WS_ABUF, DM * 2, nullptr, (const _Float16*)(wl + W_FF1_OFF), DM, nt * 32, ks * 256, scr, DFF, F.lane);
        if (MODE == 2) skinny_task<true>(nullptr, 0, scr, (const _Float16*)(wl + W_FF2_OFF), DFF, nt * 32, ks * 256, hmeta, DM, F.lane);
    }
}
__device__ __forceinline__ void zero_scr(const Frame& F) {
    f32x4* p = (f32x4*)(F.ws + WS_SCR); float z0 = 0.f; asm volatile("" : "+v"(z0)); const f32x4 z = {z0, z0, z0, z0};
    for (int i = F.bid * NTHREADS + F.tid; i < 32 * DFF / 4; i += F.G * NTHREADS) p[i] = z;
}
__device__ __forceinline__ void zero_abuf(const Frame& F) {
    u32x4* p = (u32x4*)(F.ws + WS_ABUF); const u32x4 z = {0u, 0u, 0u, 0u};
    for (size_t i = (size_t)F.bid * NTHREADS + F.tid; i < (size_t)MP * DM * 2 / 16; i += (size_t)F.G * NTHREADS) p[i] = z;
}

typedef short bf16x8v __attribute__((ext_vector_type(8)));
__constant__ unsigned char BUCKET_LUT[128] = {0, 1, 2, 3, 4, 5, 6, 7, 8, 9, 10, 11, 12, 13, 14, 15, 16, 16, 16, 17, 17, 18, 18, 18, 19, 19, 19, 20, 20, 20, 20, 21, 21, 21, 21, 22, 22, 22, 22, 22, 23, 23, 23, 23, 23, 23, 24, 24, 24, 24, 24, 24, 25, 25, 25, 25, 25, 25, 25, 26, 26, 26, 26, 26, 26, 26, 26, 27, 27, 27, 27, 27, 27, 27, 27, 27, 27, 28, 28, 28, 28, 28, 28, 28, 28, 28, 28, 29, 29, 29, 29, 29, 29, 29, 29, 29, 29, 29, 29, 30, 30, 30, 30, 30, 30, 30, 30, 30, 30, 30, 30, 30, 30, 31, 31, 31, 31, 31, 31, 31, 31, 31, 31, 31, 31, 31, 31, 31};
__device__ __forceinline__ bf16x8v pack_p(const f32x16& x, int s) {
    u32x4 p; p.x = cvt_pk_bf16(x[8 * s + 0], x[8 * s + 1]); p.y = cvt_pk_bf16(x[8 * s + 2], x[8 * s + 3]); p.z = cvt_pk_bf16(x[8 * s + 4], x[8 * s + 5]); p.w = cvt_pk_bf16(x[8 * s + 6], x[8 * s + 7]);
    return __builtin_bit_cast(bf16x8v, p);
}
#ifndef STAGGER
#define STAGGER 0
#endif
constexpr int TK = 128;
__device__ __forceinline__ bf16x8v vt_frag(LAS unsigned char* vimg, int dblk, int keybase, int s, int lane) {
    const int h = lane >> 5, blk = (lane >> 4) & 1, i16 = lane & 15, q = i16 >> 2, p = i16 & 3;
    LAS unsigned char* a = vimg + dblk * (TK * 64) + (keybase + 16 * s + 4 * h + q) * 64 + (16 * blk + 4 * p) * 2;
    const s16x4 lo = __builtin_amdgcn_ds_read_tr16_b64_v4i16((LAS s16x4*)a);
    const s16x4 hi = __builtin_amdgcn_ds_read_tr16_b64_v4i16((LAS s16x4*)(a + 8 * 64));
    return __builtin_shufflevector(lo, hi, 0, 1, 2, 3, 4, 5, 6, 7);
}

constexpr int KS_PITCH = 144;
constexpr int KBUF = TK * KS_PITCH, VBUF = 2 * TK * 64, B_KS = 0, B_VS = 4 * KBUF, B_LUT = B_VS + 4 * VBUF, B_END = B_LUT + 512;
__device__ __forceinline__ void mixB_unit(const Frame& F, int l, int b, int hh, int qblk, float lam, float oscale) {
    LAS unsigned char* L = F.lds + LDS_GEN;
    int lane_; { unsigned z0_ = 0u; asm volatile("" : "+s"(z0_)); lane_ = (int)__builtin_amdgcn_mbcnt_hi(~0u, __builtin_amdgcn_mbcnt_lo(~0u, z0_)); asm volatile("" : "+v"(lane_)); }
    const int lane = lane_, wave = F.wave, tid = wave * 64 + lane, r = lane & 31, h = lane >> 5;
    const unsigned char* proj = F.ws + WS_PROJ;
    const _Float16* QB = (const _Float16*)(proj + PJ_QB); const unsigned char* KB = proj + PJ_KB; const unsigned char* VB = proj + PJ_VB;
    const unsigned* kmax = (const unsigned*)(F.ws + WS_CTL) + CW_KMAX + 32 * l + 16;
    const bool meta_u = qblk < 0;
    const int qrow0 = meta_u ? MR + b * NMETA : b * SEQ + qblk * 256;
    const int qpos0 = meta_u ? 0 : NMETA + qblk * 256;
    const int nreal = meta_u ? 0 : 2 * qblk + 2;
    const int wq0 = 32 * wave;
    const bool wave_on = meta_u ? (wave == 0) : true;
    const int my_row = wave_on ? qrow0 + wq0 + r : qrow0, my_pos = qpos0 + wq0 + r;
    __syncthreads();
    if (tid < 128) ((LAS float*)(L + B_LUT))[tid] = F.rel_bias[BUCKET_LUT[tid] * 12 + 8 + hh] * LOG2E;
    float bmax = (lane < 32) ? F.rel_bias[lane * 12 + 8 + hh] * LOG2E : -1e30f;
    bmax = fmaxf(bmax, sx<16>(bmax, lane)); bmax = fmaxf(bmax, sx<8>(bmax, lane)); bmax = fmaxf(bmax, sx<4>(bmax, lane)); bmax = fmaxf(bmax, sx<2>(bmax, lane)); bmax = fmaxf(bmax, sx<1>(bmax, lane));
    bmax = bcast0(bmax);
    const float bfar = F.rel_bias[31 * 12 + 8 + hh] * LOG2E;
    h8 qf[2][2]; float mref[2]; bool safe = true;
#pragma unroll
    for (int c = 0; c < 2; ++c) {
        float n2 = 0.f;
#pragma unroll
        for (int s = 0; s < 2; ++s) { qf[c][s] = *(const h8*)(QB + (size_t)my_row * 256 + hh * 64 + c * 32 + 16 * s + 8 * h);
#pragma unroll
            for (int j = 0; j < 8; ++j) { const float v = (float)qf[c][s][j]; n2 += v * v; } }
        n2 = hsum32(n2, lane);
        mref[c] = sqrtf(n2 * __uint_as_float(kmax[hh * 2 + c])) * 1.002f + bmax;
        safe = safe && (mref[c] - bfar < 60.0f);
    }
    safe = __all(safe);
    if (safe) { mref[0] = bfar; mref[1] = bfar; }
    f32x16 O[2][2]; float lsum[2] = {0.f, 0.f};
#pragma unroll
    for (int c = 0; c < 2; ++c)
#pragma unroll
        for (int d = 0; d < 2; ++d)
#pragma unroll
            for (int i = 0; i < 16; ++i) O[c][d][i] = 0.f;
    const int skey = tid >> 3, sch = tid & 7;
    const unsigned kdst = skey * KS_PITCH + sch * 16, vdst = (sch >> 2) * (TK * 64) + skey * 64 + (sch & 3) * 16;
    const int ntiles = 1 + nreal;
    auto tile_row0 = [&](int t) -> int { return t == 0 ? MR + b * NMETA : b * SEQ + (t - 1) * TK; };
    u32x4 kreg[2], vreg[2];
#pragma unroll
    for (int j = 0; j < 2; ++j) { const size_t rr = (size_t)(tile_row0(0) + skey + 64 * j); kreg[j] = *(const u32x4*)(KB + rr * 512 + hh * 128 + sch * 16); vreg[j] = *(const u32x4*)(VB + rr * 512 + hh * 128 + sch * 16); }
#pragma unroll
    for (int j = 0; j < 2; ++j) { *(LAS u32x4*)(L + B_KS + kdst + j * 64 * KS_PITCH) = kreg[j]; *(LAS u32x4*)(L + B_VS + vdst + j * 64 * 64) = vreg[j]; }
    if (ntiles > 1) {
#pragma unroll
        for (int j = 0; j < 2; ++j) { const size_t rr = (size_t)(tile_row0(1) + skey + 64 * j); kreg[j] = *(const u32x4*)(KB + rr * 512 + hh * 128 + sch * 16); vreg[j] = *(const u32x4*)(VB + rr * 512 + hh * 128 + sch * 16); }
#pragma unroll
        for (int j = 0; j < 2; ++j) { *(LAS u32x4*)(L + B_KS + KBUF + kdst + j * 64 * KS_PITCH) = kreg[j]; *(LAS u32x4*)(L + B_VS + VBUF + vdst + j * 64 * 64) = vreg[j]; }
    }
    __syncthreads();
    const int wpos0 = qpos0 + wq0;
    if (wave >= 4) __builtin_amdgcn_s_setprio(1);
#pragma unroll 1
    for (int t = 0; t < ntiles; ++t) {
        const int buf = t & 3;
        if (STAGGER > 0 && wave >= 4 && (t & 1) == 0) __builtin_amdgcn_s_sleep(STAGGER);
        if (t + 2 < ntiles) {
#pragma unroll
            for (int j = 0; j < 2; ++j) { const size_t rr = (size_t)(tile_row0(t + 2) + skey + 64 * j); kreg[j] = *(const u32x4*)(KB + rr * 512 + hh * 128 + sch * 16); vreg[j] = *(const u32x4*)(VB + rr * 512 + hh * 128 + sch * 16); } }
        const int kpos0 = (t == 0) ? 0 : NMETA + (t - 1) * TK, nvalid = (t == 0) ? NMETA : TK;
        if (wave_on && kpos0 <= wpos0 + 31) {
            LAS unsigned char* Kb = L + B_KS + buf * KBUF; LAS unsigned char* Vb = L + B_VS + buf * VBUF;
#pragma unroll
            for (int sub = 0; sub < 4; ++sub) {
                if (sub * 32 >= nvalid || kpos0 + sub * 32 > wpos0 + 31) continue;
                const bool slow = !safe || (t == 0) || (kpos0 + sub * 32 + 31 > wpos0 - 128);
                h8 kfr[2][2]; bf16x8v vfr[2][2];
#pragma unroll
                for (int c = 0; c < 2; ++c)
#pragma unroll
                    for (int s = 0; s < 2; ++s) kfr[c][s] = *(const LAS h8*)(Kb + (sub * 32 + r) * KS_PITCH + (c * 32 + 16 * s + 8 * h) * 2);
#pragma unroll
                for (int d = 0; d < 2; ++d)
#pragma unroll
                    for (int s = 0; s < 2; ++s) vfr[d][s] = vt_frag(Vb, d, sub * 32, s, lane);
                __builtin_amdgcn_sched_barrier(0);
                f32x16 S[2];
#pragma unroll
                for (int c = 0; c < 2; ++c) {
#pragma unroll
                    for (int i = 0; i < 16; ++i) S[c][i] = 0.f;
#pragma unroll
                    for (int s = 0; s < 2; ++s) S[c] = __builtin_amdgcn_mfma_f32_32x32x16_f16(kfr[c][s], qf[c][s], S[c], 0, 0, 0);
                }
                if (slow) {
                    float bs[16];
#pragma unroll
                    for (int i = 0; i < 16; ++i) { const int dist = my_pos - (kpos0 + sub * 32 + crow(i, h)); bs[i] = ((const LAS float*)(L + B_LUT))[min(max(dist, 0), 127)]; }
#pragma unroll
                    for (int i = 0; i < 16; ++i) {
                        const int kidx = sub * 32 + crow(i, h), dist = my_pos - (kpos0 + kidx);
                        const bool ok = dist >= 0 && kidx < nvalid;
#pragma unroll
                        for (int c = 0; c < 2; ++c) { const float e = __builtin_amdgcn_exp2f(fminf(S[c][i] + (bs[i] - mref[c]), 80.f)); S[c][i] = ok ? e : 0.f; }
                    }
                }
#pragma unroll
                for (int c = 0; c < 2; ++c) {
                    __builtin_amdgcn_sched_barrier(0);
                    if (!slow) {
#pragma unroll
                        for (int i = 0; i < 16; ++i) S[c][i] = __builtin_amdgcn_exp2f(S[c][i]); }
                    const float a0 = (S[c][0] + S[c][1]) + (S[c][2] + S[c][3]), a1 = (S[c][4] + S[c][5]) + (S[c][6] + S[c][7]);
                    const float a2 = (S[c][8] + S[c][9]) + (S[c][10] + S[c][11]), a3 = (S[c][12] + S[c][13]) + (S[c][14] + S[c][15]);
                    lsum[c] += (a0 + a1) + (a2 + a3);
                    bf16x8v pf[2]; pf[0] = pack_p(S[c], 0); pf[1] = pack_p(S[c], 1);
                    __builtin_amdgcn_sched_barrier(0);
#pragma unroll
                    for (int d = 0; d < 2; ++d)
#pragma unroll
                        for (int s = 0; s < 2; ++s) O[c][d] = __builtin_amdgcn_mfma_f32_32x32x16_bf16(vfr[d][s], pf[s], O[c][d], 0, 0, 0);
                }
            }
        }
        if (t + 2 < ntiles) {
#pragma unroll
            for (int j = 0; j < 2; ++j) { *(LAS u32x4*)(L + B_KS + (buf ^ 2) * KBUF + kdst + j * 64 * KS_PITCH) = kreg[j]; *(LAS u32x4*)(L + B_VS + (buf ^ 2) * VBUF + vdst + j * 64 * 64) = vreg[j]; } }
        if (t & 1) { if (STAGGER > 0 && wave < 4) __builtin_amdgcn_s_sleep(STAGGER); __syncthreads(); }
    }
    __builtin_amdgcn_s_setprio(0);
    if (wave_on) {
        const float l0 = hsum32(lsum[0], lane), l1 = hsum32(lsum[1], lane);
        const float i0 = 1.0f / l0, i1 = lam / l1;
        float o[2][16], ss = 0.f;
#pragma unroll
        for (int d = 0; d < 2; ++d)
#pragma unroll
            for (int i = 0; i < 16; ++i) { o[d][i] = O[0][d][i] * i0 - O[1][d][i] * i1; ss += o[d][i] * o[d][i]; }
        ss = hsum32(ss, lane);
        const float rstd = rsqrtf(ss * (1.0f / 64.0f) + 1e-6f) * oscale;
        const float* gn = F.diff_norm + l * 64;
        if (!meta_u || r < NMETA) {
            _Float16* dst = (_Float16*)(F.ws + WS_ABUF) + (size_t)my_row * DM + 512 + hh * 64;
#pragma unroll
            for (int d = 0; d < 2; ++d)
#pragma unroll
                for (int g4 = 0; g4 < 4; ++g4) { const int d0 = 32 * d + 8 * g4 + 4 * h; const f32x4 gv = *(const f32x4*)(gn + d0);
                    u32x2 w; w.x = cvt_pk_f16(o[d][4 * g4 + 0] * rstd * gv[0], o[d][4 * g4 + 1] * rstd * gv[1]); w.y = cvt_pk_f16(o[d][4 * g4 + 2] * rstd * gv[2], o[d][4 * g4 + 3] * rstd * gv[3]);
                    *(u32x2*)(dst + d0) = w; }
        }
    }
}
__device__ __forceinline__ void mixB_phase(const Frame& F, int l) {
    const float* lp = F.diff_lambda + l * 128;
    float a = (F.lane < 32) ? lp[F.lane] * lp[32 + F.lane] : 0.f, c = (F.lane < 32) ? lp[64 + F.lane] * lp[96 + F.lane] : 0.f;
    a = wave_sum(a, F.lane); c = wave_sum(c, F.lane);
    const float linit = 0.8f - 0.6f * expf(-0.3f * (float)l);
    const float lam = expf(a) - expf(c) + linit, oscale = 1.0f - linit;
#pragma unroll 1
    for (int cidx = F.bid; cidx < 256; cidx += F.G) { const int bh = cidx & 7, i = cidx >> 3;
#pragma unroll 1
        for (int k = 0; k < 3; ++k) { if (k == 2 && cidx >= 8) break; mixB_unit(F, l, bh >> 2, bh & 3, k == 0 ? 63 - i : (k == 1 ? i : -1), lam, oscale); }
    }
}
__device__ __forceinline__ h8 tr_frag_nat(LAS unsigned char* img_blk, int rowbase, int s, int lane) {
    const int h = lane >> 5, blk = (lane >> 4) & 1, i16 = lane & 15, q = i16 >> 2, p = i16 & 3;
    LAS unsigned char* a = img_blk + (rowbase + 16 * s + 8 * h + q) * 64 + (16 * blk + 4 * p) * 2;
    const s16x4 lo = __builtin_amdgcn_ds_read_tr16_b64_v4i16((LAS s16x4*)a);
    const s16x4 hi = __builtin_amdgcn_ds_read_tr16_b64_v4i16((LAS s16x4*)(a + 4 * 64));
    return __builtin_bit_cast(h8, __builtin_shufflevector(lo, hi, 0, 1, 2, 3, 4, 5, 6, 7));
}
__device__ __forceinline__ h8 tr_frag_krow(LAS unsigned char* img_blk, int rowbase, int s, int lane) {
    const int h = lane >> 5, blk = (lane >> 4) & 1, i16 = lane & 15, q = i16 >> 2, p = i16 & 3;
    LAS unsigned char* a = img_blk + (rowbase + 16 * s + 4 * h + q) * 64 + (16 * blk + 4 * p) * 2;
    const s16x4 lo = __builtin_amdgcn_ds_read_tr16_b64_v4i16((LAS s16x4*)a);
    const s16x4 hi = __builtin_amdgcn_ds_read_tr16_b64_v4i16((LAS s16x4*)(a + 8 * 64));
    return __builtin_bit_cast(h8, __builtin_shufflevector(lo, hi, 0, 1, 2, 3, 4, 5, 6, 7));
}
__device__ __forceinline__ float ret_log2gamma(int hc) { return log2f(1.0f - exp2f(-5.0f - (float)hc)); }
__device__ __forceinline__ h8 scale_h8(const h8& v, float sc) { h8 o;
#pragma unroll
    for (int e = 0; e < 8; ++e) o[e] = (_Float16)((float)v[e] * sc);
    return o; }

__device__ __forceinline__ void mixC1_unit(const Frame& F, int b, int hp, int c) {
    LAS unsigned char* L = F.lds + LDS_GEN;
    const int tid = F.tid, lane = F.lane, wave = F.wave;
    const unsigned char* proj = F.ws + WS_PROJ;
    const int row0 = c == 0 ? MR + b * NMETA : b * SEQ + 128 * (c - 1), Lc = c == 0 ? NMETA : 128;
    __syncthreads();
#pragma unroll 1
    for (int idx = tid; idx < 4096; idx += NTHREADS) {
        const int head = idx >> 11, arr = (idx >> 10) & 1, j = (idx >> 3) & 127, ch = idx & 7, hc = 2 * hp + head;
        h8 v;
#pragma unroll
        for (int e = 0; e < 8; ++e) v[e] = (_Float16)0.f;
        if (j < Lc) { v = *(const h8*)(proj + (arr ? PJ_VC : PJ_KC) + (size_t)(row0 + j) * 512 + hc * 128 + ch * 16);
            if (arr) v = scale_h8(v, exp2f((float)(Lc - 1 - j) * ret_log2gamma(hc))); }
        *(LAS h8*)(L + head * 32768 + arr * 16384 + (ch >> 2) * 8192 + j * 64 + (ch & 3) * 16) = v;
    }
    __syncthreads();
    const int head = wave >> 2, mb = (wave >> 1) & 1, nb = wave & 1, r = lane & 31, h = lane >> 5;
    f32x16 acc;
#pragma unroll
    for (int i = 0; i < 16; ++i) acc[i] = 0.f;
#pragma unroll
    for (int s = 0; s < 8; ++s) { const h8 a = tr_frag_nat(L + head * 32768 + mb * 8192, 0, s, lane), bb = tr_frag_nat(L + head * 32768 + 16384 + nb * 8192, 0, s, lane);
        acc = __builtin_amdgcn_mfma_f32_32x32x16_f16(a, bb, acc, 0, 0, 0); }
    float* U = (float*)(F.ws + WS_U) + ((size_t)((b * 4 + 2 * hp + head) * 129 + c)) * 4096;
#pragma unroll
    for (int i = 0; i < 16; ++i) U[(32 * mb + crow(i, h)) * 64 + 32 * nb + r] = acc[i];
}
__device__ __forceinline__ void mixC1_phase(const Frame& F) {
#pragma unroll 1
    for (int u = F.bid; u < NB * 2 * 129; u += F.G) { const int c = u % 129, bh = u / 129; mixC1_unit(F, bh >> 1, bh & 1, c); }
}
__device__ __forceinline__ void mixC_scan(const Frame& F) {
    if (F.tid >= 128) return;
    const int e = F.bid * 128 + F.tid;
    if (e >= NB * 4 * 4096) return;
    const int bh = e >> 12, el = e & 4095, hc = bh & 3;
    const float lg = ret_log2gamma(hc), g128 = exp2f(128.f * lg), g16 = exp2f(16.f * lg);
    const float* U = (const float*)(F.ws + WS_U) + (size_t)bh * 129 * 4096 + el; float* S = (float*)(F.ws + WS_S) + (size_t)bh * 129 * 4096 + el;
    float st = U[0];
    S[4096] = st;
#pragma unroll 1
    for (int c0 = 1; c0 < 128; c0 += 16) {
        float u[16];
#pragma unroll
        for (int k = 0; k < 16; ++k) u[k] = (c0 + k < 128) ? U[(size_t)(c0 + k) * 4096] : 0.f;
#pragma unroll
        for (int k = 0; k < 16; ++k) if (c0 + k < 128) { st = st * g128 + u[k]; S[(size_t)(c0 + k + 1) * 4096] = st; }
    }
    (void)g16;
}
constexpr int C2_KI = 0, C2_VI = 128 * KS_PITCH, C2_ST = C2_VI + 16384, C2_HEAD = C2_ST + 64 * KS_PITCH;
__device__ __forceinline__ void mixC2_unit(const Frame& F, int l, int b, int hp, int c) {
    LAS unsigned char* L = F.lds + LDS_GEN;
    const int tid = F.tid, lane = F.lane, wave = F.wave, r = lane & 31, h = lane >> 5;
    const unsigned char* proj = F.ws + WS_PROJ;
    const int row0 = c == 0 ? MR + b * NMETA : b * SEQ + 128 * (c - 1), Lc = c == 0 ? NMETA : 128;
    __syncthreads();
#pragma unroll 1
    for (int idx = tid; idx < 4096; idx += NTHREADS) {
        const int head = idx >> 11, arr = (idx >> 10) & 1, j = (idx >> 3) & 127, ch = idx & 7, hc = 2 * hp + head;
        h8 v;
#pragma unroll
        for (int e = 0; e < 8; ++e) v[e] = (_Float16)0.f;
        if (j < Lc) v = *(const h8*)(proj + (arr ? PJ_VC : PJ_KC) + (size_t)(row0 + j) * 512 + hc * 128 + ch * 16);
        if (arr) *(LAS h8*)(L + head * C2_HEAD + C2_VI + (ch >> 2) * 8192 + j * 64 + (ch & 3) * 16) = v;
        else     *(LAS h8*)(L + head * C2_HEAD + C2_KI + j * KS_PITCH + ch * 16) = v;
    }
    if (c > 0) {
#pragma unroll 1
        for (int idx = tid; idx < 2 * 4096; idx += NTHREADS) { const int head = idx >> 12, el = idx & 4095, dk = el >> 6, dv = el & 63;
            const float v = ((const float*)(F.ws + WS_S))[((size_t)((b * 4 + 2 * hp + head) * 129 + c)) * 4096 + el];
            *(LAS _Float16*)(L + head * C2_HEAD + C2_ST + dv * KS_PITCH + dk * 2) = (_Float16)v; }
    }
    __syncthreads();
    const int head = wave >> 2, wq = wave & 3, hc = 2 * hp + head;
    if (wq * 32 < Lc) {
        LAS unsigned char* Hb = L + head * C2_HEAD;
        const int qi = wq * 32 + r, my_row = row0 + qi;
        const float lg = ret_log2gamma(hc);
        h8 qf[4];
#pragma unroll
        for (int s = 0; s < 4; ++s) qf[s] = *(const h8*)(proj + PJ_QC + (size_t)my_row * 512 + hc * 128 + (16 * s + 8 * h) * 2);
        f32x16 O[2];
#pragma unroll
        for (int d = 0; d < 2; ++d)
#pragma unroll
            for (int i = 0; i < 16; ++i) O[d][i] = 0.f;
        if (c > 0) {
#pragma unroll
            for (int d = 0; d < 2; ++d)
#pragma unroll
                for (int s = 0; s < 4; ++s) { const h8 a = *(const LAS h8*)(Hb + C2_ST + (32 * d + r) * KS_PITCH + (16 * s + 8 * h) * 2);
                    O[d] = __builtin_amdgcn_mfma_f32_32x32x16_f16(a, qf[s], O[d], 0, 0, 0); }
            const float qd = exp2f((float)(qi + 1) * lg);
#pragma unroll
            for (int d = 0; d < 2; ++d)
#pragma unroll
                for (int i = 0; i < 16; ++i) O[d][i] *= qd;
        }
#pragma unroll 1
        for (int jb = 0; jb <= wq; ++jb) {
            f32x16 S;
#pragma unroll
            for (int i = 0; i < 16; ++i) S[i] = 0.f;
#pragma unroll
            for (int s = 0; s < 4; ++s) { const h8 kf = *(const LAS h8*)(Hb + C2_KI + (32 * jb + r) * KS_PITCH + (16 * s + 8 * h) * 2);
                S = __builtin_amdgcn_mfma_f32_32x32x16_f16(kf, qf[s], S, 0, 0, 0); }
#pragma unroll
            for (int i = 0; i < 16; ++i) { const int dd = qi - (32 * jb + crow(i, h)); S[i] = dd >= 0 ? S[i] * exp2f((float)dd * lg) : 0.f; }
            h8 pf[2];
#pragma unroll
            for (int s = 0; s < 2; ++s) { u32x4 p; p.x = cvt_pk_f16(S[8 * s + 0], S[8 * s + 1]); p.y = cvt_pk_f16(S[8 * s + 2], S[8 * s + 3]); p.z = cvt_pk_f16(S[8 * s + 4], S[8 * s + 5]); p.w = cvt_pk_f16(S[8 * s + 6], S[8 * s + 7]); pf[s] = __builtin_bit_cast(h8, p); }
#pragma unroll
            for (int d = 0; d < 2; ++d)
#pragma unroll
                for (int s = 0; s < 2; ++s) { const h8 vf = tr_frag_krow(Hb + C2_VI + d * 8192, 32 * jb, s, lane);
                    O[d] = __builtin_amdgcn_mfma_f32_32x32x16_f16(vf, pf[s], O[d], 0, 0, 0); }
        }
        float ss = 0.f;
#pragma unroll
        for (int d = 0; d < 2; ++d)
#pragma unroll
            for (int i = 0; i < 16; ++i) ss += O[d][i] * O[d][i];
        ss = hsum32(ss, lane);
        const float rstd = rsqrtf(ss * (1.0f / 64.0f) + 1e-6f);
        if (qi < Lc) {
            const float* gn = F.ret_norm + l * 256 + hc * 64;
            const _Float16* gc = (const _Float16*)(proj + PJ_GC) + (size_t)my_row * 256 + hc * 64;
            _Float16* dst = (_Float16*)(F.ws + WS_ABUF) + (size_t)my_row * DM + 768 + hc * 64;
#pragma unroll
            for (int d = 0; d < 2; ++d)
#pragma unroll
                for (int g4 = 0; g4 < 4; ++g4) { const int d0 = 32 * d + 8 * g4 + 4 * h; const f32x4 gv = *(const f32x4*)(gn + d0); const h4 gg = *(const h4*)(gc + d0);
                    float o[4];
#pragma unroll
                    for (int e = 0; e < 4; ++e) { const float g = (float)gg[e]; o[e] = O[d][4 * g4 + e] * rstd * gv[e] * (g / (1.0f + __expf(-g))); }
                    u32x2 w; w.x = cvt_pk_f16(o[0], o[1]); w.y = cvt_pk_f16(o[2], o[3]); *(u32x2*)(dst + d0) = w; }
        }
    }
}
__device__ __forceinline__ void mixC2_phase(const Frame& F, int l) {
#pragma unroll 1
    for (int u = F.bid; u < NB * 2 * 129; u += F.G) { const int c = u % 129, bh = u / 129; mixC2_unit(F, l, bh >> 1, bh & 1, c); }
}
constexpr int IDX_HP = 257;
constexpr int IDX_HIST = 0, IDX_STATS = 32 * IDX_HP * 4, IDX_INFO = IDX_STATS + 2304, IDX_CCNT = IDX_INFO + 256, IDX_MASK = IDX_CCNT + 384, IDX_CAND = IDX_MASK + 65792, IDX_Q = IDX_CAND + 32 * 128 * 4, IDX_QPITCH = 1168, IDX_END = IDX_Q + 32 * IDX_QPITCH;
#ifndef PROBE_REP
#define PROBE_REP 0
#endif
#if PROBE_REP >= 40
#define PTS(v) do { __builtin_amdgcn_sched_barrier(0); v = (unsigned)__builtin_amdgcn_s_memtime(); __builtin_amdgcn_sched_barrier(0); } while (0)
#else
#define PTS(v) do {} while (0)
#endif
#if PROBE_REP >= 40 && PROBE_REP < 60
#define IPTS(v) PTS(v)
#else
#define IPTS(v) do {} while (0)
#endif
constexpr int IDX_CAP = 128, IDX_NBIN = 256, NSUB = 3;
static_assert(IDX_END + LDS_GEN <= LDS_BYTES, "indexer LDS");
struct KFrag { h8 v[4]; };
__device__ __forceinline__ KFrag idx_load_k(const unsigned char* krow_ptr, int h) { KFrag k;
#pragma unroll
    for (int s = 0; s < 4; ++s) k.v[s] = *(const h8*)(krow_ptr + (16 * s + 8 * h) * 2);
    return k; }
#define IDX_LOADQ(dst, hd) do { _Pragma("unroll") for (int s_ = 0; s_ < 4; ++s_) dst[s_] = *(const LAS h8*)(qimg_lane + ((hd) * 64 + 16 * s_) * 2); } while (0)
#define IDX_MFMA4(acc, q) do { _Pragma("unroll") for (int s_ = 0; s_ < 4; ++s_) acc = __builtin_amdgcn_mfma_f32_32x32x16_f16(kf.v[s_], q[s_], acc, 0, 0, 0); } while (0)
#define IDX_FMA(hd, S) do { _Pragma("unroll") for (int i_ = 0; i_ < 16; ++i_) sc[i_] = __builtin_fmaf(w[hd], __builtin_fabsf(S[i_]), sc[i_]); } while (0)
#define IDX_SB __builtin_amdgcn_sched_barrier(0)
__device__ __forceinline__ void idx_scores(const LAS unsigned char* qimg_lane, const float (&w)[8], const KFrag& kf, f32x16& sc) {
    h8 q[2][4]; f32x16 S[2];
    IDX_LOADQ(q[0], 8); IDX_SB;
#pragma unroll
    for (int i = 0; i < 16; ++i) sc[i] = 0.f;
    IDX_MFMA4(sc, q[0]); IDX_LOADQ(q[1], 0); IDX_SB;
#pragma unroll
    for (int hd = 0; hd < 8; ++hd) {
#pragma unroll
        for (int i = 0; i < 16; ++i) S[hd & 1][i] = 0.f;
        IDX_MFMA4(S[hd & 1], q[(hd + 1) & 1]);
        if (hd < 7) IDX_LOADQ(q[hd & 1], hd + 1);
        if (hd > 0) IDX_FMA(hd - 1, S[(hd - 1) & 1]);
        IDX_SB;
    }
    IDX_FMA(7, S[1]);
}
#define IDX_PIN(V) asm volatile("" : "+v"(V[0]), "+v"(V[1]), "+v"(V[2]), "+v"(V[3]), "+v"(V[4]), "+v"(V[5]), "+v"(V[6]), "+v"(V[7]), "+v"(V[8]), "+v"(V[9]), "+v"(V[10]), "+v"(V[11]), "+v"(V[12]), "+v"(V[13]), "+v"(V[14]), "+v"(V[15]))
#define IDX_MFMA4K(acc, q, KF) do { _Pragma("unroll") for (int s_ = 0; s_ < 4; ++s_) acc = __builtin_amdgcn_mfma_f32_32x32x16_f16(KF.v[s_], q[s_], acc, 0, 0, 0); } while (0)
#define IDX_FMA2(SC, hd, S) do { _Pragma("unroll") for (int i_ = 0; i_ < 16; ++i_) SC[i_] = __builtin_fmaf(w[hd], __builtin_fabsf(S[i_]), SC[i_]); } while (0)
__device__ __forceinline__ void idx_scores2(const LAS unsigned char* qimg_lane, const float (&w)[8], const KFrag& kfA, const KFrag& kfB, f32x16& scA, f32x16& scB) {
    h8 q[2][4]; f32x16 SA, SB;
    IDX_LOADQ(q[0], 8); IDX_SB;
#pragma unroll
    for (int i = 0; i < 16; ++i) { scA[i] = 0.f; scB[i] = 0.f; }
    IDX_MFMA4K(scA, q[0], kfA); IDX_MFMA4K(scB, q[0], kfB); IDX_LOADQ(q[1], 0); IDX_SB;
#pragma unroll
    for (int hd = 0; hd < 8; ++hd) {
#pragma unroll
        for (int i = 0; i < 16; ++i) SA[i] = 0.f;
        IDX_MFMA4K(SA, q[(hd + 1) & 1], kfA);
        if (hd > 0) { IDX_FMA2(scB, hd - 1, SB); IDX_PIN(scB); }
        IDX_SB;
#pragma unroll
        for (int i = 0; i < 16; ++i) SB[i] = 0.f;
        IDX_MFMA4K(SB, q[(hd + 1) & 1], kfB);
        if (hd < 7) IDX_LOADQ(q[hd & 1], hd + 1);
        IDX_FMA2(scA, hd, SA); IDX_PIN(scA);
        IDX_SB;
    }
    IDX_FMA2(scB, 7, SB);
}
template <int NS> __device__ __forceinline__ void idx_scoresN(const LAS unsigned char* qimg_lane, const float (&w)[8], KFrag (&kf)[NS], const unsigned char* const (&nextp)[NS], int h, f32x16 (&sc)[NS]) {
    h8 q[2][4]; f32x16 S[NS];
#if PROBE_REP == 30
    h8 zk = {0, 0, 0, 0, 0, 0, 0, 0}; asm volatile("" : "+v"(zk));
#endif
#if PROBE_REP == 31
    float wz = 0.f; asm volatile("" : "+v"(wz));
#define IDX_FMAZ(SC, S) do { _Pragma("unroll") for (int i_ = 0; i_ < 16; ++i_) SC[i_] = __builtin_fmaf(wz, __builtin_fabsf(S[i_]), SC[i_]); } while (0)
#else
#define IDX_FMAZ(SC, S) do {} while (0)
#endif
    IDX_LOADQ(q[0], 8); IDX_SB;
#pragma unroll
    for (int t = 0; t < NS; ++t) {
#pragma unroll
        for (int i = 0; i < 16; ++i) sc[t][i] = 0.f;
        IDX_MFMA4K(sc[t], q[0], kf[t]); }
    IDX_LOADQ(q[1], 0); IDX_SB;
#pragma unroll
    for (int hd = 0; hd < 8; ++hd) {
#pragma unroll
        for (int t = 0; t < NS; ++t) {
#pragma unroll
            for (int i = 0; i < 16; ++i) S[t][i] = 0.f;
            IDX_MFMA4K(S[t], q[(hd + 1) & 1], kf[t]);
#if PROBE_REP == 30
#pragma unroll
            for (int s_ = 0; s_ < 4; ++s_) S[t] = __builtin_amdgcn_mfma_f32_32x32x16_f16(zk, q[(hd + 1) & 1][s_], S[t], 0, 0, 0);
#endif
            if (t == 0 && hd < 7) IDX_LOADQ(q[hd & 1], hd + 1);
            if (hd == 7) kf[t] = idx_load_k(nextp[t], h);
            if (t > 0) { IDX_FMA2(sc[t - 1], hd, S[t - 1]); IDX_FMAZ(sc[t - 1], S[t - 1]); IDX_PIN(sc[t - 1]); }
            else if (hd > 0) { IDX_FMA2(sc[NS - 1], hd - 1, S[NS - 1]); IDX_FMAZ(sc[NS - 1], S[NS - 1]); IDX_PIN(sc[NS - 1]); }
            IDX_SB;
        }
    }
    IDX_FMA2(sc[NS - 1], 7, S[NS - 1]);
}
__device__ __forceinline__ int f_ord(float v) { const int i = __float_as_int(v); return i >= 0 ? i : (int)(0x80000000u - (unsigned)i); }
__device__ __forceinline__ float f_unord(int o) { return __int_as_float(o >= 0 ? o : (int)(0x80000000u - (unsigned)o)); }
__device__ __forceinline__ float idx_raw_edge(float B, float inv, float c0f) {
    if (!(B > -3.0e38f)) return -__builtin_inff();
    if (!(B < 3.0e38f)) return __builtin_inff();
    int lo = f_ord(-3.0e38f), hi = f_ord(3.0e38f);
#pragma unroll 1
    for (int it = 0; it < 34; ++it) { const int mid = lo + (int)(((unsigned)hi - (unsigned)lo) >> 1); if (__builtin_fmaf(f_unord(mid), inv, c0f) >= B) hi = mid; else lo = mid; }
    return f_unord(hi);
}
#define IDX_ACCBIT(m, s, t) asm("v_cmp_ge_f32 vcc, %1, %2\n\tv_addc_co_u32 %0, vcc, %0, %0, vcc" : "+v"(m) : "v"(s), "v"(t) : "vcc")
__device__ __forceinline__ int suffix_sum(int v, int lane) {
#pragma unroll
    for (int off = 1; off < 64; off <<= 1) { const int t = __builtin_amdgcn_ds_bpermute((lane + off) << 2, v); if (lane + off < 64) v += t; }
    return v;
}
__device__ __forceinline__ void mixA_index_unit(const Frame& F, int b, int g) {
    LAS unsigned char* L = F.lds + LDS_GEN;
    int lane_; { unsigned z0_ = 0u; asm volatile("" : "+s"(z0_)); lane_ = (int)__builtin_amdgcn_mbcnt_hi(~0u, __builtin_amdgcn_mbcnt_lo(~0u, z0_)); asm volatile("" : "+v"(lane_)); }
    int tid_ = F.wave * 64 + lane_; asm volatile("" : "+v"(tid_));
    const int tid = tid_, lane = lane_, wave = F.wave, r = lane & 31, h = lane >> 5;
    const unsigned char* proj = F.ws + WS_PROJ;
    const unsigned char* KI = proj + PJ_KI;
    const int nq = g == 0 ? NMETA : 32;
    const int qrow = g == 0 ? MR + b * NMETA + (r & 15) : b * SEQ + 32 * (g - 1) + r;
    const int tq0 = g == 0 ? 0 : NMETA + 32 * (g - 1);
    const bool qvalid = r < nq;
    auto ks_row0 = [&](int ks) -> int { return ks == 0 ? MR + b * NMETA : b * SEQ + 32 * (ks - 1); };
#if PROBE_REP >= 40 && PROBE_REP < 60
    unsigned accS = 0, accP = 0, accP2 = 0, accNC = 0, accNR = 0, tU0, tx0, tx1, tx2, tx3, tx4, tx5, tx6; IPTS(tU0);
#else
    unsigned tx0, tx1, tx2, tx3, tx4, tx5, tx6;
#endif
    __syncthreads();
    for (int i = tid; i < 32 * IDX_HP; i += NTHREADS) ((LAS unsigned*)(L + IDX_HIST))[i] = 0u;
    if (tid < 32) ((LAS unsigned*)(L + IDX_CCNT))[tid] = 0u;
    for (int i = tid; i < (g + 1) * 32; i += NTHREADS) ((LAS unsigned*)(L + IDX_MASK))[i] = 0u;
    auto krow = [&](int ks) -> const unsigned char* { return KI + (size_t)(ks_row0(ks <= g ? ks : g) + r) * 128; };
    const KFrag kf0 = idx_load_k(KI + (size_t)(b * SEQ + 32 * (wave & 3) + r) * 128, h);
    KFrag kf[NSUB];
#pragma unroll
    for (int u = 0; u < NSUB; ++u) kf[u] = idx_load_k(krow(NSUB * wave + u), h);
    float w[8];
    const LAS unsigned char* qf = L + IDX_Q + r * IDX_QPITCH + 8 * h * 2;
    { const float* WI = (const float*)(proj + PJ_WI) + (size_t)qrow * 8; const f32x4 w0 = *(const f32x4*)WI, w1 = *(const f32x4*)(WI + 4);
      w[0] = w0[0]; w[1] = w0[1]; w[2] = w0[2]; w[3] = w0[3]; w[4] = w1[0]; w[5] = w1[1]; w[6] = w1[2]; w[7] = w1[3]; }
    { const int qq = tid >> 4, dc = tid & 15; const int qr = g == 0 ? MR + b * NMETA + (qq & 15) : b * SEQ + 32 * (g - 1) + qq;
      const unsigned char* qsrc = proj + PJ_QI + (size_t)qr * 1024 + dc * 8; u32x2 qv[8];
#pragma unroll
      for (int hd = 0; hd < 8; ++hd) qv[hd] = *(const u32x2*)(qsrc + hd * 128);
      const float* WQ = (const float*)(proj + PJ_WI) + (size_t)qr * 8; const f32x4 wa = *(const f32x4*)WQ, wb = *(const f32x4*)(WQ + 4);
      const float wq[8] = {wa[0], wa[1], wa[2], wa[3], wb[0], wb[1], wb[2], wb[3]};
      float a4[4] = {0.f, 0.f, 0.f, 0.f};
#pragma unroll
      for (int hd = 0; hd < 8; ++hd) { const h4 q = __builtin_bit_cast(h4, qv[hd]);
#pragma unroll
          for (int e = 0; e < 4; ++e) a4[e] += wq[hd] * (float)q[e];
          *(LAS u32x2*)(L + IDX_Q + qq * IDX_QPITCH + hd * 128 + dc * 8) = qv[hd]; }
      u32x2 o; o.x = cvt_pk_f16(a4[0], a4[1]); o.y = cvt_pk_f16(a4[2], a4[3]);
      *(LAS u32x2*)(L + IDX_Q + qq * IDX_QPITCH + 1024 + dc * 8) = o; }
    __syncthreads();
    if (wave < 4) {
        f32x16 sc; idx_scores(qf, w, kf0, sc);
        float s1 = 0.f, s2 = 0.f;
#pragma unroll
        for (int i = 0; i < 16; ++i) { s1 += sc[i]; s2 += sc[i] * sc[i]; }
        s1 = hsum32(s1, lane); s2 = hsum32(s2, lane);
        if (h == 0) { ((LAS float*)(L + IDX_STATS))[(wave * 32 + r) * 2] = s1; ((LAS float*)(L + IDX_STATS))[(wave * 32 + r) * 2 + 1] = s2; }
    }
    __syncthreads();
    float c0f, inv;
    { float s1 = 0.f, s2 = 0.f;
#pragma unroll
      for (int k = 0; k < 4; ++k) { s1 += ((LAS float*)(L + IDX_STATS))[(k * 32 + r) * 2]; s2 += ((LAS float*)(L + IDX_STATS))[(k * 32 + r) * 2 + 1]; }
      const float mean = s1 * (1.0f / 128.0f), var = fmaxf(s2 * (1.0f / 128.0f) - mean * mean, 0.f), sd = fmaxf(sqrtf(var), 1e-12f);
      inv = (float)IDX_NBIN / (10.0f * sd); c0f = -(mean - 3.0f * sd) * inv; }
    LAS unsigned* hrow = (LAS unsigned*)(L + IDX_HIST) + r * IDX_HP;
    IPTS(tx0);
#if PROBE_REP == 12
    for (int rep12 = 0; rep12 < 2; ++rep12) { __syncthreads(); for (int i = tid; i < 32 * IDX_HP; i += NTHREADS) ((LAS unsigned*)(L + IDX_HIST))[i] = 0u; __syncthreads();
#else
    {
#endif
#pragma unroll 1
        for (int ks = NSUB * wave; ks <= g; ks += 8 * NSUB) {
            const unsigned char* nextp[NSUB];
#pragma unroll
            for (int u = 0; u < NSUB; ++u) nextp[u] = krow((ks + 8 * NSUB <= g ? ks + 8 * NSUB : NSUB * wave) + u);
#if PROBE_REP >= 40 && PROBE_REP < 60
            unsigned tb, tc, td; IPTS(tb);
#endif
            f32x16 scv[NSUB]; __builtin_amdgcn_s_setprio(1); idx_scoresN<NSUB>(qf, w, kf, nextp, h, scv); __builtin_amdgcn_s_setprio(0);
#if PROBE_REP >= 40 && PROBE_REP < 60
            IDX_PIN(scv[NSUB - 1]); IPTS(tc); accS += tc - tb;
#endif
#pragma unroll
            for (int u2 = 0; u2 < NSUB; ++u2) {
                const int kss = ks + u2; if (kss > g) continue;
                if (kss == 0 || kss == g) {
#pragma unroll
                    for (int i = 0; i < 16; ++i) {
                        const int kidx = crow(i, h);
                        const bool ok = qvalid && (kss == 0 ? kidx < NMETA && (g > 0 || kidx <= r) : kidx <= r);
                        if (ok) { const unsigned bin = (unsigned)__builtin_amdgcn_fmed3f(__builtin_fmaf(scv[u2][i], inv, c0f), 0.f, (float)(IDX_NBIN - 1)); __hip_atomic_fetch_add(hrow + bin, 1u, __ATOMIC_RELAXED, __HIP_MEMORY_SCOPE_WORKGROUP); }
                    }
                } else {
#pragma unroll
                    for (int i = 0; i < 16; ++i) { const unsigned bin = (unsigned)__builtin_amdgcn_fmed3f(__builtin_fmaf(scv[u2][i], inv, c0f), 0.f, (float)(IDX_NBIN - 1)); __hip_atomic_fetch_add(hrow + bin, 1u, __ATOMIC_RELAXED, __HIP_MEMORY_SCOPE_WORKGROUP); }
                }
            }
#if PROBE_REP >= 40 && PROBE_REP < 60
            IPTS(td); accP += td - tc;
#endif
        }
    }
    IPTS(tx1);
    __syncthreads();
    IPTS(tx2);
#pragma unroll 1
    for (int k = 0; k < 4; ++k) {
        const int row = 4 * wave + k;
        const LAS unsigned* hr = (const LAS unsigned*)(L + IDX_HIST) + row * IDX_HP + 4 * lane;
        const int c0 = (int)hr[0], c1 = (int)hr[1], c2 = (int)hr[2], c3 = (int)hr[3];
        const int SL = suffix_sum((c0 + c1) + (c2 + c3), lane), NT = __builtin_amdgcn_readlane(SL, 0);
        int bstar = -1, need = 0;
        if (NT > 256) {
            const unsigned long long ml = __ballot(SL >= 256); const int lL = 63 - __builtin_clzll(ml); const int sl = __builtin_amdgcn_readlane(SL, lL);
            const int t0 = __builtin_amdgcn_readlane(c0, lL), t1 = __builtin_amdgcn_readlane(c1, lL), t2 = __builtin_amdgcn_readlane(c2, lL), t3 = __builtin_amdgcn_readlane(c3, lL);
            int above = sl - ((t0 + t1) + (t2 + t3));
            if (above + t3 >= 256) bstar = 4 * lL + 3;
            else { above += t3; if (above + t2 >= 256) bstar = 4 * lL + 2; else { above += t2; if (above + t1 >= 256) bstar = 4 * lL + 1; else { above += t1; bstar = 4 * lL; } } }
            need = 256 - above;
        }
        if (lane == 0) { ((LAS int*)(L + IDX_INFO))[row * 2] = bstar; ((LAS int*)(L + IDX_INFO))[row * 2 + 1] = need; }
    }
    __syncthreads();
    float lo_f, hi_f;
    { const int bstar = ((LAS int*)(L + IDX_INFO))[r * 2];
      hi_f = bstar < 0 ? -__builtin_inff() : (bstar >= IDX_NBIN - 1 ? __builtin_inff() : (float)(bstar + 1));
      lo_f = bstar <= 0 ? -__builtin_inff() : (float)bstar; }
    const float hi_raw = idx_raw_edge(hi_f, inv, c0f), lo_raw = idx_raw_edge(lo_f, inv, c0f);
    const float lo_base = fmaxf(lo_f, 0.f);
    auto append = [&](float sv, int kb, int ci) {
        const unsigned slot = __hip_atomic_fetch_add((LAS unsigned*)(L + IDX_CCNT) + r, 1u, __ATOMIC_RELAXED, __HIP_MEMORY_SCOPE_WORKGROUP);
        if (slot < IDX_CAP) { const float fr = (__builtin_fmaf(sv, inv, c0f) - lo_base) * 131072.0f; const unsigned q = (unsigned)__builtin_amdgcn_fmed3f(fr, 0.f, 131071.0f);
            asm volatile("" : "+v"(kb));
            ((LAS unsigned*)(L + IDX_CAND))[r * IDX_CAP + slot] = (q << 15) | (unsigned)(kb - ci); } };
    {
#pragma unroll 1
        for (int ks = NSUB * wave; ks <= g; ks += 8 * NSUB) {
            const unsigned char* nextp[NSUB];
#pragma unroll
            for (int u = 0; u < NSUB; ++u) nextp[u] = krow((ks + 8 * NSUB <= g ? ks + 8 * NSUB : NSUB * wave) + u);
#if PROBE_REP >= 40 && PROBE_REP < 60
            unsigned tb, tc, td; IPTS(tb);
#endif
            f32x16 scv[NSUB]; __builtin_amdgcn_s_setprio(1); idx_scoresN<NSUB>(qf, w, kf, nextp, h, scv); __builtin_amdgcn_s_setprio(0);
#if PROBE_REP >= 40 && PROBE_REP < 60
            IDX_PIN(scv[NSUB - 1]); IPTS(tc); accS += tc - tb;
#endif
#pragma unroll
            for (int u2 = 0; u2 < NSUB; ++u2) {
                const int kss = ks + u2; if (kss > g) continue;
                unsigned part = 0u;
                if (kss == 0 || kss == g) {
#pragma unroll
                    for (int i = 0; i < 16; ++i) {
                        const int kidx = crow(i, h);
                        const bool ok = qvalid && (kss == 0 ? kidx < NMETA && (g > 0 || kidx <= r) : kidx <= r);
                        const bool ghi = scv[u2][i] >= hi_raw, glo = scv[u2][i] >= lo_raw;
                        part |= (ok && ghi) ? (1u << kidx) : 0u;
                        if (ok && glo && !ghi) append(scv[u2][i], 32767 - kss * 32 - 4 * h, (i & 3) + 8 * (i >> 2));
                    }
                } else {
                    unsigned mhi = 0u, mlo = 0u;
#pragma unroll
                    for (int i = 15; i >= 0; --i) { IDX_ACCBIT(mhi, scv[u2][i], hi_raw); IDX_ACCBIT(mlo, scv[u2][i], lo_raw); }
                    part = ((mhi & 0xFu) | ((mhi & 0xF0u) << 4) | ((mhi & 0xF00u) << 8) | ((mhi & 0xF000u) << 12)) << (4 * h);
                    const unsigned cm = mlo & ~mhi;
                    if (__ballot(cm != 0u) != 0ull) {
#pragma unroll
                        for (int i = 0; i < 16; ++i) if (cm & (1u << i)) append(scv[u2][i], 32767 - kss * 32 - 4 * h, (i & 3) + 8 * (i >> 2));
                    }
                }
                __hip_atomic_fetch_or((LAS unsigned*)(L + IDX_MASK) + kss * 32 + r, part, __ATOMIC_RELAXED, __HIP_MEMORY_SCOPE_WORKGROUP);
            }
#if PROBE_REP >= 40 && PROBE_REP < 60
            IPTS(td); accP2 += td - tc;
#endif
        }
    }
    IPTS(tx3);
    __syncthreads();
    IPTS(tx4);
    __builtin_amdgcn_s_setprio(0);
#pragma unroll 1
    for (int k = 0; k < 4; ++k) {
        const int row = 4 * wave + k;
        const int need = ((LAS int*)(L + IDX_INFO))[row * 2 + 1];
        int nc = (int)((LAS unsigned*)(L + IDX_CCNT))[row]; nc = nc < IDX_CAP ? nc : IDX_CAP;
        nc = __builtin_amdgcn_readfirstlane(nc);
#if PROBE_REP == 48
        accNC += (unsigned)nc; accNR += 128u;
#endif
        if (nc == 0) continue;
        const LAS unsigned* cb = (const LAS unsigned*)(L + IDX_CAND) + row * IDX_CAP;
        const bool v0 = lane < nc, v1 = lane + 64 < nc;
        const unsigned c0 = v0 ? cb[lane] : 0u, c1 = v1 ? cb[lane + 64] : 0u;
        int r0 = 0, r1 = 0;
        if (__builtin_amdgcn_readfirstlane(need) < nc) {
            const int n0 = nc < 64 ? nc : 64;
#pragma unroll 1
            for (int j = 0; j < n0; ++j) { const unsigned cj = (unsigned)__builtin_amdgcn_readlane((int)c0, j); r0 += cj > c0 ? 1 : 0; r1 += cj > c1 ? 1 : 0; }
#pragma unroll 1
            for (int j = 64; j < nc; ++j) { const unsigned cj = (unsigned)__builtin_amdgcn_readlane((int)c1, j - 64); r0 += cj > c0 ? 1 : 0; r1 += cj > c1 ? 1 : 0; }
        }
        const int k0 = 32767 - (int)(c0 & 32767u), k1 = 32767 - (int)(c1 & 32767u);
        if (v0 && r0 < need) __hip_atomic_fetch_or((LAS unsigned*)(L + IDX_MASK) + (k0 >> 5) * 32 + row, 1u << (k0 & 31), __ATOMIC_RELAXED, __HIP_MEMORY_SCOPE_WORKGROUP);
        if (v1 && r1 < need) __hip_atomic_fetch_or((LAS unsigned*)(L + IDX_MASK) + (k1 >> 5) * 32 + row, 1u << (k1 & 31), __ATOMIC_RELAXED, __HIP_MEMORY_SCOPE_WORKGROUP);
    }
    IPTS(tx5);
    __syncthreads();
    IPTS(tx6);
    unsigned* MK = (unsigned*)(F.ws + WS_MASK) + (size_t)b * NKS * TLEN;
    for (int i = tid; i < (g + 1) * 32; i += NTHREADS) { const int ks = i >> 5, rr = i & 31; if (rr < nq) MK[(size_t)ks * TLEN + tq0 + rr] = ((LAS unsigned*)(L + IDX_MASK))[i]; }
#if PROBE_REP >= 40 && PROBE_REP < 60
    { unsigned tU1; IPTS(tU1); if (lane == 0) { unsigned long long* pc = (unsigned long long*)(F.ws + WS_CTL) + 4096;
        const unsigned vals[12] = {tx0 - tU0, accS, accP, tU1 - tU0, accP2, tx2 - tx1, tx4 - tx3, tU1 - tx4, accNC, tx5 - tx4, tx6 - tx5, tU1 - tx6};
        atomicAdd(pc + (PROBE_REP - 40), (unsigned long long)vals[PROBE_REP - 40]); atomicAdd(pc + 3, (unsigned long long)(PROBE_REP == 48 ? accNR : tU1 - tU0)); } }
#endif
}
__device__ __forceinline__ void mixA_index_phase(const Frame& F) {
#pragma unroll 1
    for (int c = F.bid; c < 256; c += F.G) {
#pragma unroll 1
        for (int k = 0; k < 5; ++k) {
            int u; if (k == 0) u = c; else if (k == 1) u = 511 - c; else if (k == 2) u = 512 + c; else if (k == 3) u = 1023 - c; else { if (c >= 2) break; u = 1024 + c; }
            mixA_index_unit(F, u & 1, 512 - (u >> 1));
        }
    }
}

__device__ __forceinline__ void mixA3_unit(const Frame& F, int l, int b, int ha, int qblk) {
    LAS unsigned char* L = F.lds + LDS_GEN;
    int lane_; { unsigned z0_ = 0u; asm volatile("" : "+s"(z0_)); lane_ = (int)__builtin_amdgcn_mbcnt_hi(~0u, __builtin_amdgcn_mbcnt_lo(~0u, z0_)); asm volatile("" : "+v"(lane_)); }
    const int lane = lane_, wave = F.wave, tid = wave * 64 + lane, r = lane & 31, h = lane >> 5;
    const unsigned char* proj = F.ws + WS_PROJ;
    const _Float16* QA = (const _Float16*)(proj + PJ_QA); const unsigned char* KA = proj + PJ_KA; const unsigned char* VA = proj + PJ_VA;
    const unsigned* kmax = (const unsigned*)(F.ws + WS_CTL) + CW_KMAX + 32 * l;
    const unsigned* MK = (const unsigned*)(F.ws + WS_MASK) + (size_t)b * NKS * TLEN;
    const bool meta_u = qblk < 0;
    const int qrow0 = meta_u ? MR + b * NMETA : b * SEQ + qblk * 256;
    const int qpos0 = meta_u ? 0 : NMETA + qblk * 256;
    const int nreal = meta_u ? 0 : 2 * qblk + 2;
    const int wq0 = 32 * wave;
    const bool wave_on = meta_u ? (wave == 0) : true;
    const int my_row = wave_on ? qrow0 + wq0 + r : qrow0, my_pos = wave_on ? qpos0 + wq0 + r : 0;
    __syncthreads();
    if (tid < 128) ((LAS float*)(L + B_LUT))[tid] = F.rel_bias[BUCKET_LUT[tid] * 12 + ha] * LOG2E;
    float bmax = (lane < 32) ? F.rel_bias[lane * 12 + ha] * LOG2E : -1e30f;
    bmax = fmaxf(bmax, sx<16>(bmax, lane)); bmax = fmaxf(bmax, sx<8>(bmax, lane)); bmax = fmaxf(bmax, sx<4>(bmax, lane)); bmax = fmaxf(bmax, sx<2>(bmax, lane)); bmax = fmaxf(bmax, sx<1>(bmax, lane));
    bmax = bcast0(bmax);
    const float bfar = F.rel_bias[31 * 12 + ha] * LOG2E;
    h8 qf[4]; float mref; bool safe;
    { float n2 = 0.f;
#pragma unroll
      for (int s = 0; s < 4; ++s) { qf[s] = *(const h8*)(QA + (size_t)my_row * 512 + ha * 64 + 16 * s + 8 * h);
#pragma unroll
          for (int j = 0; j < 8; ++j) { const float v = (float)qf[s][j]; n2 += v * v; } }
      n2 = hsum32(n2, lane);
      mref = sqrtf(n2 * (__uint_as_float(kmax[ha * 2]) + __uint_as_float(kmax[ha * 2 + 1]))) * 1.002f + bmax;
      safe = __all(mref - bfar < 60.0f); if (safe) mref = bfar; }
    f32x16 O[2], Lacc;
#if PROBE_REP >= 60 && PROBE_REP < 70
    unsigned a3C = 0, a3S = 0, a3W = 0, a3t0, a3t1, a3t2, a3t3, a3U0; PTS(a3U0);
#endif
#pragma unroll
    for (int i = 0; i < 16; ++i) { O[0][i] = 0.f; O[1][i] = 0.f; Lacc[i] = 0.f; }
    bf16x8v ones; { const u32x4 o = {0x3F803F80u, 0x3F803F80u, 0x3F803F80u, 0x3F803F80u}; ones = __builtin_bit_cast(bf16x8v, o); }
    const int skey = tid >> 3, sch = tid & 7;
    const unsigned kdst = skey * KS_PITCH + sch * 16, vdst = (sch >> 2) * (TK * 64) + skey * 64 + (sch & 3) * 16;
    const int ntiles = 1 + nreal;
    auto tile_row0 = [&](int t) -> int { return t == 0 ? MR + b * NMETA : b * SEQ + (t - 1) * TK; };
    u32x4 kreg[2], vreg[2];
#pragma unroll
    for (int j = 0; j < 2; ++j) { const size_t rr = (size_t)(tile_row0(0) + skey + 64 * j); kreg[j] = *(const u32x4*)(KA + rr * 1024 + ha * 128 + sch * 16); vreg[j] = *(const u32x4*)(VA + rr * 1024 + ha * 128 + sch * 16); }
#pragma unroll
    for (int j = 0; j < 2; ++j) { *(LAS u32x4*)(L + B_KS + kdst + j * 64 * KS_PITCH) = kreg[j]; *(LAS u32x4*)(L + B_VS + vdst + j * 64 * 64) = vreg[j]; }
    if (ntiles > 1) {
#pragma unroll
        for (int j = 0; j < 2; ++j) { const size_t rr = (size_t)(tile_row0(1) + skey + 64 * j); kreg[j] = *(const u32x4*)(KA + rr * 1024 + ha * 128 + sch * 16); vreg[j] = *(const u32x4*)(VA + rr * 1024 + ha * 128 + sch * 16); }
#pragma unroll
        for (int j = 0; j < 2; ++j) { *(LAS u32x4*)(L + B_KS + KBUF + kdst + j * 64 * KS_PITCH) = kreg[j]; *(LAS u32x4*)(L + B_VS + VBUF + vdst + j * 64 * 64) = vreg[j]; }
    }
    __syncthreads();
    unsigned mw[4], mwn[4] = {0u, 0u, 0u, 0u};
    mw[0] = MK[my_pos]; mw[1] = 0u; mw[2] = 0u; mw[3] = 0u;
    const int wpos0 = qpos0 + wq0;
    if (wave >= 4) __builtin_amdgcn_s_setprio(1);
#pragma unroll 1
    for (int t = 0; t < ntiles; ++t) {
        const int buf = t & 3;
        if (STAGGER > 0 && wave >= 4 && (t & 1) == 0) __builtin_amdgcn_s_sleep(STAGGER);
        if (t + 2 < ntiles) {
#pragma unroll
            for (int j = 0; j < 2; ++j) { const size_t rr = (size_t)(tile_row0(t + 2) + skey + 64 * j); kreg[j] = *(const u32x4*)(KA + rr * 1024 + ha * 128 + sch * 16); vreg[j] = *(const u32x4*)(VA + rr * 1024 + ha * 128 + sch * 16); } }
        if (t + 1 < ntiles) {
#pragma unroll
            for (int j = 0; j < 4; ++j) mwn[j] = MK[(size_t)(1 + 4 * t + j) * TLEN + my_pos]; }
        const int kpos0 = (t == 0) ? 0 : NMETA + (t - 1) * TK, nvalid = (t == 0) ? NMETA : TK;
#if PROBE_REP >= 60 && PROBE_REP < 70
        PTS(a3t0);
#endif
        if (wave_on && kpos0 <= wpos0 + 31) {
            LAS unsigned char* Kb = L + B_KS + buf * KBUF; LAS unsigned char* Vb = L + B_VS + buf * VBUF;
#pragma unroll
            for (int sub = 0; sub < 4; ++sub) {
                if (sub * 32 >= nvalid || kpos0 + sub * 32 > wpos0 + 31) continue;
                const bool slow = !safe || (t == 0) || (kpos0 + sub * 32 + 31 > wpos0 - 128);
                const unsigned mword = mw[sub] >> (4 * h);
                f32x16 S;
                h8 kfr[4]; bf16x8v vfr[2][2];
#pragma unroll
                for (int s = 0; s < 4; ++s) kfr[s] = *(const LAS h8*)(Kb + (sub * 32 + r) * KS_PITCH + (16 * s + 8 * h) * 2);
#pragma unroll
                for (int d = 0; d < 2; ++d)
#pragma unroll
                    for (int s = 0; s < 2; ++s) vfr[d][s] = vt_frag(Vb, d, sub * 32, s, lane);
                __builtin_amdgcn_sched_barrier(0);
#pragma unroll
                for (int i = 0; i < 16; ++i) S[i] = 0.f;
#pragma unroll
                for (int s = 0; s < 4; ++s) S = __builtin_amdgcn_mfma_f32_32x32x16_f16(kfr[s], qf[s], S, 0, 0, 0);
                bf16x8v pf[2];
                if (slow) {
                    float bs[16];
#pragma unroll
                    for (int i = 0; i < 16; ++i) { const int dist = my_pos - (kpos0 + sub * 32 + crow(i, h)); bs[i] = ((const LAS float*)(L + B_LUT))[min(max(dist, 0), 127)]; }
#pragma unroll
                    for (int i = 0; i < 16; ++i) {
                        const int kidx = sub * 32 + crow(i, h), dist = my_pos - (kpos0 + kidx);
                        const bool ok = ((mword >> ((i & 3) + 8 * (i >> 2))) & 1u) != 0u && dist >= 0 && kidx < nvalid;
                        const float e = __builtin_amdgcn_exp2f(fminf(S[i] + (bs[i] - mref), 80.f));
                        S[i] = ok ? e : 0.f;
                    }
                    pf[0] = pack_p(S, 0); pf[1] = pack_p(S, 1);
                } else {
#pragma unroll
                    for (int i = 0; i < 16; ++i) S[i] = __uint_as_float(__float_as_uint(__builtin_amdgcn_exp2f(S[i])) & (unsigned)__builtin_amdgcn_sbfe((int)mword, (i & 3) + 8 * (i >> 2), 1));
                    pf[0] = pack_p(S, 0); pf[1] = pack_p(S, 1);
                }
#pragma unroll
                for (int s = 0; s < 2; ++s) { Lacc = __builtin_amdgcn_mfma_f32_32x32x16_bf16(ones, pf[s], Lacc, 0, 0, 0);
#pragma unroll
                    for (int d = 0; d < 2; ++d) O[d] = __builtin_amdgcn_mfma_f32_32x32x16_bf16(vfr[d][s], pf[s], O[d], 0, 0, 0); }
            }
        }
#if PROBE_REP >= 60 && PROBE_REP < 70
        asm volatile("" : "+v"(O[0][0]), "+v"(O[1][0]), "+v"(Lacc[0])); PTS(a3t1);
#endif
        if (t + 2 < ntiles) {
#pragma unroll
            for (int j = 0; j < 2; ++j) { *(LAS u32x4*)(L + B_KS + (buf ^ 2) * KBUF + kdst + j * 64 * KS_PITCH) = kreg[j]; *(LAS u32x4*)(L + B_VS + (buf ^ 2) * VBUF + vdst + j * 64 * 64) = vreg[j]; } }
#pragma unroll
        for (int j = 0; j < 4; ++j) mw[j] = mwn[j];
#if PROBE_REP >= 60 && PROBE_REP < 70
        PTS(a3t2);
#endif
        if (t & 1) { if (STAGGER > 0 && wave < 4) __builtin_amdgcn_s_sleep(STAGGER); __syncthreads(); }
#if PROBE_REP >= 60 && PROBE_REP < 70
        PTS(a3t3); a3C += a3t1 - a3t0; a3S += a3t2 - a3t1; a3W += a3t3 - a3t2;
#endif
    }
#if PROBE_REP >= 60 && PROBE_REP < 70
    { unsigned a3U1; PTS(a3U1); if (lane == 0) { unsigned long long* pc = (unsigned long long*)(F.ws + WS_CTL) + 4096;
        const unsigned vals[4] = {a3C, a3S, a3W, a3U1 - a3U0};
        atomicAdd(pc + (PROBE_REP - 40), (unsigned long long)vals[PROBE_REP - 60]); atomicAdd(pc + 23, (unsigned long long)(a3U1 - a3U0)); } }
#endif
    __builtin_amdgcn_s_setprio(0);
    if (wave_on) {
        const float il = 1.0f / Lacc[0];
        if (!meta_u || r < NMETA) {
            _Float16* dst = (_Float16*)(F.ws + WS_ABUF) + (size_t)my_row * DM + ha * 64;
#pragma unroll
            for (int d = 0; d < 2; ++d)
#pragma unroll
                for (int g4 = 0; g4 < 4; ++g4) { const int d0 = 32 * d + 8 * g4 + 4 * h;
                    u32x2 w; w.x = cvt_pk_f16(O[d][4 * g4 + 0] * il, O[d][4 * g4 + 1] * il); w.y = cvt_pk_f16(O[d][4 * g4 + 2] * il, O[d][4 * g4 + 3] * il);
                    *(u32x2*)(dst + d0) = w; }
        }
    }
}
__device__ __forceinline__ void mixA3_phase(const Frame& F, int l) {
#pragma unroll 1
    for (int c = F.bid; c < 256; c += F.G) { const int bh = c & 15, i1 = c >> 4, i2 = 31 - i1;
#pragma unroll 1
        for (int k = 0; k < 5; ++k) { if (k == 4 && c >= 16) break;
            const int qb = k == 0 ? 63 - i1 : (k == 1 ? 32 + i1 : (k == 2 ? i2 : (k == 3 ? i1 : -1)));
            mixA3_unit(F, l, bh >> 3, bh & 7, qb); }
    }
}
constexpr int NPHASES = 19;
__global__ void __launch_bounds__(NTHREADS, 2) fwd(Args args) {
    extern __shared__ __attribute__((aligned(16))) unsigned char lds_raw[];
    Frame F;
    F.x = args.in[0]; F.meta = args.in[1]; F.rel_bias = args.in[2]; F.w_in = args.in[3]; F.norm_mix = args.in[4]; F.diff_lambda = args.in[5]; F.diff_norm = args.in[6];
    F.ret_norm = args.in[7]; F.w_out = args.in[8]; F.norm_ff = args.in[9]; F.w_ff1 = args.in[10]; F.w_ff2 = args.in[11]; F.final_norm = args.in[12];
    F.out = args.out; F.ws = args.ws; F.lds = (LAS unsigned char*)lds_raw;
    F.bid = blockIdx.x; F.G = gridDim.x; F.tid = threadIdx.x; F.lane = F.tid & 63; F.wave = __builtin_amdgcn_readfirstlane(F.tid >> 6);
    if (F.tid < 64) ((LAS unsigned*)(F.lds + LDS_MISC))[F.tid] = 0u;
    __syncthreads();
    unsigned* ctl = (unsigned*)(F.ws + WS_CTL);
    XcdBarrier bar = xcd_barrier_post(ctl + CW_BAR, (volatile LAS unsigned*)(F.lds + LDS_MISC));
    const int lo = args.ph_lo, hi = args.ph_hi;
#define IN(k) (lo <= (k) && (k) < hi)
#ifndef PROBE_REP
#define PROBE_REP 0
#endif
#define RETID() do { unsigned z0_ = 0u; asm volatile("" : "+s"(z0_)); int t_ = (int)__builtin_amdgcn_mbcnt_hi(~0u, __builtin_amdgcn_mbcnt_lo(~0u, z0_)); asm volatile("" : "+v"(t_)); F.lane = t_; F.tid = F.wave * 64 + t_; } while (0)
#define REP(k) _Pragma("unroll 1") for (int rep_ = 0; rep_ < ((PROBE_REP == (k)) ? 2 : 1); ++rep_)
#define SEAM(k) do { if (IN(k) && IN((k) + 1)) xcd_barrier(bar, F.wave == 0 && F.lane == 0); } while (0)
    LAS unsigned char* stage = F.lds + LDS_GEN;
    if (IN(0)) { REP(10) prologue(F); SEAM(0);
#if PROBE_REP == 20
        for (int xb = 0; xb < 20; ++xb) xcd_barrier(bar, F.wave == 0 && F.lane == 0);
#endif
    }
#pragma unroll 1
    for (int l = 0; l < DEPTH; ++l) {
        const int pb = 1 + 9 * l;
        { RETID();
          size_t z_ = 0; int b_ = blockIdx.x, g_ = gridDim.x; asm volatile("" : "+s"(z_), "+s"(b_), "+s"(g_)); F.ws = args.ws + z_; F.out = args.out + z_; F.bid = b_; F.G = g_; }
        unsigned char* wl = F.ws + WS_W + (size_t)l * W_LAYER;
        unsigned char* proj = F.ws + WS_PROJ;
        if (IN(pb + 0)) {
            pg8::Gemm g{(const pg8::bf16_t*)(F.ws + WS_ABUF), (const pg8::bf16_t*)(wl + W_IN_OFF), MP, NPAD, DM}; pg8::StaticOrder S; S.init(MP, NPAD, F.G, F.bid);
            EpiInProj E{proj, (const f32x2*)(F.ws + WS_ROPE), ctl + CW_KMAX + 32 * l};
            pg8::gemm_phase<EpiInProj, pg8::StaticOrder, true, true>(stage, g, S, E, F.tid);
#if PROBE_REP == 7
            RETID(); pg8::gemm_phase<EpiInProj, pg8::StaticOrder, true, true>(stage, g, S, E, F.tid);
#endif
            SEAM(pb + 0);
        }
        if (IN(pb + 1)) { RETID(); REP(1) mixA_index_phase(F); RETID(); REP(2) mixC1_phase(F); SEAM(pb + 1); }
        if (IN(pb + 2)) { RETID(); REP(3) mixC_scan(F); RETID(); REP(4) mixB_phase(F, l); SEAM(pb + 2); }
        if (IN(pb + 3)) { RETID(); REP(5) mixA3_phase(F, l); RETID(); REP(6) mixC2_phase(F, l); SEAM(pb + 3); }
        if (IN(pb + 4)) { RETID();
            skinny_meta<0>(F, wl); RETID();
            pg8::Gemm g{(const pg8::bf16_t*)(F.ws + WS_ABUF), (const pg8::bf16_t*)(wl + W_OUT_OFF), MR, DM, DM}; pg8::StaticOrder S; S.init(MR, DM, F.G, F.bid);
            EpiRes E{l == 0 ? F.x : F.out, F.out, (float*)(F.ws + WS_HMETA)};
            pg8::gemm_phase<EpiRes, pg8::StaticOrder, true, true>(stage, g, S, E, F.tid);
            SEAM(pb + 4);
        }
        if (IN(pb + 5)) { RETID(); zero_scr(F); REP(8) norm_to_abuf<1>(F, F.norm_ff + (size_t)l * DM); SEAM(pb + 5); }
        if (IN(pb + 6)) { RETID();
            skinny_meta<1>(F, wl); RETID();
            pg8::Gemm g{(const pg8::bf16_t*)(F.ws + WS_ABUF), (const pg8::bf16_t*)(wl + W_FF1_OFF), MR, DFF, DM}; pg8::StaticOrder S; S.init(MR, DFF, F.G, F.bid);
            EpiRelu2 E{proj};
            pg8::gemm_phase<EpiRelu2, pg8::StaticOrder, true, true>(stage, g, S, E, F.tid);
#if PROBE_REP == 9
            RETID(); pg8::gemm_phase<EpiRelu2, pg8::StaticOrder, true, true>(stage, g, S, E, F.tid);
#endif
            SEAM(pb + 6);
        }
        if (IN(pb + 7)) { RETID();
            skinny_meta<2>(F, wl); RETID();
            pg8::Gemm g{(const pg8::bf16_t*)proj, (const pg8::bf16_t*)(wl + W_FF2_OFF), MR, DM, DFF}; pg8::StaticOrder S; S.init(MR, DM, F.G, F.bid);
            EpiRes E{F.out, F.out, (float*)(F.ws + WS_HMETA)};
#if PROBE_REP == 14
            { EpiRes E2{F.out, (float*)(F.ws + WS_ABUF), (float*)(F.ws + WS_U)}; pg8::gemm_phase<EpiRes, pg8::StaticOrder, true, true>(stage, g, S, E2, F.tid); RETID(); }
#endif
            pg8::gemm_phase<EpiRes, pg8::StaticOrder, true, true>(stage, g, S, E, F.tid);
            SEAM(pb + 7);
        }
        if (IN(pb + 8)) { RETID();
            if (l + 1 < DEPTH) { norm_to_abuf<1>(F, F.norm_mix + (size_t)(l + 1) * DM); SEAM(pb + 8); }
            else final_norm(F);
        }
    }
#if PROBE_REP >= 40
    RETID(); if (blockIdx.x == 0 && F.tid == 0) {
        const unsigned long long* pc = (const unsigned long long*)(args.ws + WS_CTL) + 4096;
        const unsigned long long vx = __hip_atomic_load(pc + (PROBE_REP - 40), __ATOMIC_RELAXED, __HIP_MEMORY_SCOPE_AGENT), vt = __hip_atomic_load(pc + (PROBE_REP < 60 ? 3 : (PROBE_REP < 70 ? 23 : 33)), __ATOMIC_RELAXED, __HIP_MEMORY_SCOPE_AGENT);
        const unsigned long long ticks = (unsigned long long)((float)vx / (float)vt * 1.0e6f);
        const unsigned long long t0 = __builtin_amdgcn_s_memrealtime();
        while (__builtin_amdgcn_s_memrealtime() - t0 < ticks) __builtin_amdgcn_s_sleep(16);
    }
#endif
#undef IN
#undef SEAM
}

#ifndef MK_SPLIT
#define MK_SPLIT 0
#endif
extern "C" void kernel_launch(void* const* d_in, const int* in_sizes, int n_in, void* d_out, int out_size, void* d_ws, size_t ws_size, hipStream_t stream) {
    static int grid = 0;
    if (grid == 0) {
        if (n_in != 13 || ws_size < WS_END) { fprintf(stderr, "kernel_launch: need 13 inputs and %zu bytes of workspace; got %d, %zu\n", (size_t)WS_END, n_in, ws_size); grid = -1; return; }
        int dev = 0, cus = 0, per_cu = 0;
        if (hipGetDevice(&dev) != hipSuccess || hipDeviceGetAttribute(&cus, hipDeviceAttributeMultiprocessorCount, dev) != hipSuccess) { grid = -1; return; }
        if (hipFuncSetAttribute((const void*)fwd, hipFuncAttributeMaxDynamicSharedMemorySize, LDS_BYTES) != hipSuccess) { fprintf(stderr, "kernel_launch: hipFuncSetAttribute failed\n"); grid = -1; return; }
        if (hipOccupancyMaxActiveBlocksPerMultiprocessor(&per_cu, (const void*)fwd, NTHREADS, LDS_BYTES) != hipSuccess || per_cu < 1) { fprintf(stderr, "kernel_launch: occupancy query says %d\n", per_cu); }
        (void)hipGetLastError();
        grid = cus;
    }
    if (grid < 0) return;
    (void)hipMemsetAsync((char*)d_ws + WS_CTL, 0, CTL_BYTES, stream);
    Args a{};
    for (int i = 0; i < 13; ++i) a.in[i] = (const float*)d_in[i];
    a.out = (float*)d_out; a.ws = (unsigned char*)d_ws;
#if MK_SPLIT
    for (int p = 0; p < NPHASES; ++p) { a.ph_lo = p; a.ph_hi = p + 1; hipLaunchKernelGGL(fwd, dim3(grid), dim3(NTHREADS), LDS_BYTES, stream, a); }
#else
    a.ph_lo = 0; a.ph_hi = NPHASES; hipLaunchKernelGGL(fwd, dim3(grid), dim3(NTHREADS), LDS_BYTES, stream, a);
#endif
}
```

```cpp
#include <hip/hip_runtime.h>
#include <cstdio>
#include <cstdint>
typedef _Float16 h8 __attribute__((ext_vector_type(8)));
typedef _Float16 h4 __attribute__((ext_vector_type(4)));
typedef _Float16 h2 __attribute__((ext_vector_type(2)));
typedef short s16x8 __attribute__((ext_vector_type(8)));
typedef short s16x4 __attribute__((ext_vector_type(4)));
typedef float f32x16 __attribute__((ext_vector_type(16)));
typedef float f32x2 __attribute__((ext_vector_type(2)));
typedef unsigned u32x2 __attribute__((ext_vector_type(2)));
namespace pg8 {
#define PG8_LAS __attribute__((address_space(3)))
typedef unsigned short bf16_t;
typedef short bf16x8 __attribute__((ext_vector_type(8)));
typedef float f32x4 __attribute__((ext_vector_type(4)));
typedef unsigned u32x4 __attribute__((ext_vector_type(4)));
constexpr int BM = 256, BK = 64, HALF = 128, HTB = HALF * BK * 2  , STAGE_BYTES = 8 * HTB, NXCD = 8, WGM = 8;

__host__ __device__ __forceinline__ int lds_byte(int r, int c) { const int st = (r >> 4) * 2 + (c >> 5), rr = r & 15, cc = c & 31, ob = rr * 64 + cc * 2; return st * 1024 + (ob ^ (((ob >> 9) & 1) << 5)); }
__host__ __device__ __forceinline__ void stage_rc(int b, int& R, int& C) { const int st = b / 1024, sb = b % 1024, swz = sb ^ (((sb >> 9) & 1) << 5); R = (st >> 1) * 16 + swz / 64; C = (st & 1) * 32 + (swz % 64) / 2; }
__host__ __device__ __forceinline__ int perm32(int rho) { const int n = rho >> 4, i = rho & 15; return 8 * (i >> 2) + 4 * n + (i & 3); }

struct Unit { int pm, pn; };
struct Gemm { const bf16_t* A; const bf16_t* Bt; int M, N, K; };

struct StaticOrder {
    int nM, nN, nwg, G, c;
    __host__ __device__ void init(int M, int N, int G_, int c_) { nM = M / BM; nN = N / BM; nwg = nM * nN; G = G_; c = c_; }
    __host__ __device__ bool next(int i, Unit& u) const {
        const long L = (long)i * G + c; if (L >= nwg) return false;
        int wgid = (int)L; { const int q = nwg / NXCD, r = nwg % NXCD, xcd = wgid % NXCD, off = wgid / NXCD; wgid = (xcd < r ? xcd * (q + 1) : r * (q + 1) + (xcd - r) * q) + off; }
        const int nig = WGM * nN, gid = wgid / nig, fm = gid * WGM, gsz = (nM - fm) < WGM ? (nM - fm) : WGM;
        u.pm = fm + ((wgid % nig) % gsz); u.pn = (wgid % nig) / gsz; return true;
    }
    __device__ __forceinline__ void a_ready(const Unit&) const {}
    __device__ __forceinline__ void done(const Unit&) const {}
};

template <class Epi, class Sched, bool ALIGN_EPI = false, bool SP2 = false>
__device__ __forceinline__ void gemm_phase(PG8_LAS unsigned char* lds, const Gemm g, const Sched& S, const Epi& E, int tid_in) {
    int tid_ = tid_in; asm volatile("" : "+v"(tid_));
    const int tid = tid_, wid = __builtin_amdgcn_readfirstlane(tid >> 6), lane = tid & 63, wr = wid >> 2, wc = wid & 3, fr = lane & 15, fq = lane >> 4;
    const int K = g.K, nt = K / BK;
    unsigned voffA[2], voffB[2];
#pragma unroll
    for (int i = 0; i < 2; ++i) { int R, C; stage_rc(tid * 16 + i * 8192, R, C); const int Rb = Epi::PERM ? ((R & ~31) + perm32(R & 31)) : R;
        voffA[i] = (unsigned)(R * K + C) * 2u; voffB[i] = (unsigned)(Rb * K + C) * 2u; }
    const size_t kstep = (size_t)(BK * 2);
    const size_t hstep = (size_t)HALF * K * 2;
    const size_t tstep = 2 * hstep;
    const unsigned ldsw = (unsigned)wid * 1024u;
    const int aoff = lds_byte(wr * 64 + fr, fq * 8), boff = lds_byte(wc * 32 + fr, fq * 8);
#define PG8_SA(b, h) (((b) * 2 + (h)) * HTB)
#define PG8_SB(b, h) ((4 + (b) * 2 + (h)) * HTB)
#define PG8_STAGE(bufoff, gbase, voff) do { _Pragma("unroll") for (int _i = 0; _i < 2; ++_i) \
        __builtin_amdgcn_global_load_lds((const unsigned*)((const char*)(gbase) + (voff)[_i]), (PG8_LAS unsigned*)(lds + (bufoff) + ldsw + _i * 8192), 16, 0, 0); } while (0)
#define PG8_LDA(dst, b, h) do { _Pragma("unroll") for (int m = 0; m < 4; ++m) _Pragma("unroll") for (int k = 0; k < 2; ++k) dst[m][k] = *(const PG8_LAS bf16x8*)(lds + PG8_SA(b, h) + aoff + m * 2048 + k * 1024); } while (0)
#define PG8_LDB(dst, b, h) do { _Pragma("unroll") for (int n = 0; n < 2; ++n) _Pragma("unroll") for (int k = 0; k < 2; ++k) dst[n][k] = *(const PG8_LAS bf16x8*)(lds + PG8_SB(b, h) + boff + n * 2048 + k * 1024); } while (0)
#define PG8_MMA(ai, bj, At, Bt) do { __builtin_amdgcn_s_setprio(1); _Pragma("unroll") for (int m = 0; m < 4; ++m) _Pragma("unroll") for (int n = 0; n < 2; ++n) _Pragma("unroll") for (int k = 0; k < 2; ++k) \
        acc[ai][bj][m][n] = __builtin_amdgcn_mfma_f32_16x16x32_f16(__builtin_bit_cast(h8, Bt[n][k]), __builtin_bit_cast(h8, At[m][k]), acc[ai][bj][m][n], 0, 0, 0); __builtin_amdgcn_s_setprio(0); } while (0)
#define PG8_WAIT_V(n) asm volatile("s_waitcnt vmcnt(" #n ")" ::: "memory")
#define PG8_WAIT_L(n) asm volatile("s_waitcnt lgkmcnt(" #n ")" ::: "memory")
#define PG8_BAR __builtin_amdgcn_s_barrier()
#define PG8_SCHED __builtin_amdgcn_sched_barrier(0)
    Unit cur, nxt; int ui = 0;
    if (!S.next(0, cur)) return;
    f32x4 acc[2][2][4][2];
#pragma unroll
    for (int a = 0; a < 2; ++a)
#pragma unroll
        for (int b = 0; b < 2; ++b)
#pragma unroll
            for (int m = 0; m < 4; ++m)
#pragma unroll
                for (int n = 0; n < 2; ++n) acc[a][b][m][n] = (f32x4){0.f, 0.f, 0.f, 0.f};
    bf16x8 At[4][2], B0[2][2], B1[2][2];
    const char* cA = (const char*)g.A + (size_t)cur.pm * tstep; const char* cB = (const char*)g.Bt + (size_t)cur.pn * tstep;
    S.a_ready(cur);
    if constexpr (SP2) {
        PG8_STAGE(PG8_SB(0, 0), cB, voffB); PG8_STAGE(PG8_SB(0, 1), cB + hstep, voffB); PG8_STAGE(PG8_SA(0, 0), cA, voffA); PG8_STAGE(PG8_SA(0, 1), cA + hstep, voffA);
        if (wr == 1) PG8_BAR;
        PG8_WAIT_V(2); PG8_BAR;
        PG8_STAGE(PG8_SB(1, 0), cB + kstep, voffB); PG8_STAGE(PG8_SA(1, 0), cA + kstep, voffA); PG8_STAGE(PG8_SB(1, 1), cB + hstep + kstep, voffB);
        PG8_WAIT_V(6); PG8_BAR;
    } else {
        PG8_STAGE(PG8_SB(0, 0), cB, voffB); PG8_STAGE(PG8_SA(0, 0), cA, voffA); PG8_STAGE(PG8_SB(0, 1), cB + hstep, voffB); PG8_STAGE(PG8_SA(0, 1), cA + hstep, voffA);
        if (wr == 1) PG8_BAR;
        PG8_WAIT_V(4); PG8_BAR;
        PG8_STAGE(PG8_SB(1, 0), cB + kstep, voffB); PG8_STAGE(PG8_SA(1, 0), cA + kstep, voffA); PG8_STAGE(PG8_SB(1, 1), cB + hstep + kstep, voffB);
        PG8_WAIT_V(6); PG8_BAR;
    }
    for (;;) {
        const bool has_next = S.next(ui + 1, nxt);
        const char* nA = has_next ? (const char*)g.A + (size_t)nxt.pm * tstep : cA; const char* nB = has_next ? (const char*)g.Bt + (size_t)nxt.pn * tstep : cB;
        for (int t = 0; t < nt; t += 2) {
            const bool last = (t == nt - 2);
            const char* a1 = cA + (size_t)(t + 1) * kstep;
            const char* a2 = last ? nA : cA + (size_t)(t + 2) * kstep; const char* b2 = last ? nB : cB + (size_t)(t + 2) * kstep;
            const char* a3 = a2 + kstep; const char* b3 = b2 + kstep;
            if (last && has_next) S.a_ready(nxt);
            if constexpr (SP2) {
            PG8_LDB(B0, 0, 0); PG8_LDB(B1, 0, 1); PG8_SCHED; PG8_LDA(At, 0, 0); PG8_STAGE(PG8_SA(1, 1), a1 + hstep, voffA);
            PG8_WAIT_V(8); PG8_WAIT_L(0); PG8_BAR; PG8_MMA(0, 0, At, B0); PG8_MMA(0, 1, At, B1); PG8_BAR; PG8_SCHED;
            PG8_LDA(At, 0, 1); PG8_STAGE(PG8_SB(0, 0), b2, voffB); PG8_STAGE(PG8_SB(0, 1), b2 + hstep, voffB); PG8_STAGE(PG8_SA(0, 0), a2, voffA);
            PG8_WAIT_V(8); PG8_WAIT_L(0); PG8_BAR; PG8_MMA(1, 0, At, B0); PG8_MMA(1, 1, At, B1); PG8_BAR; PG8_SCHED;
            PG8_LDB(B0, 1, 0); PG8_LDB(B1, 1, 1); PG8_SCHED; PG8_LDA(At, 1, 0); PG8_STAGE(PG8_SA(0, 1), a2 + hstep, voffA);
            PG8_WAIT_V(8); PG8_WAIT_L(0); PG8_BAR; PG8_MMA(0, 0, At, B0); PG8_MMA(0, 1, At, B1); PG8_BAR; PG8_SCHED;
            PG8_LDA(At, 1, 1); PG8_STAGE(PG8_SB(1, 0), b3, voffB); PG8_STAGE(PG8_SB(1, 1), b3 + hstep, voffB); PG8_STAGE(PG8_SA(1, 0), a3, voffA);
            PG8_WAIT_V(8); PG8_WAIT_L(0); PG8_BAR; PG8_MMA(1, 0, At, B0); PG8_MMA(1, 1, At, B1); PG8_BAR; PG8_SCHED;
            } else {
            PG8_LDB(B0, 0, 0); PG8_SCHED; PG8_LDA(At, 0, 0); PG8_STAGE(PG8_SA(1, 1), a1 + hstep, voffA);
            PG8_WAIT_L(8); PG8_BAR; PG8_WAIT_L(0); PG8_MMA(0, 0, At, B0); PG8_BAR; PG8_SCHED;
            PG8_LDB(B1, 0, 1); PG8_STAGE(PG8_SB(0, 0), b2, voffB);
            PG8_BAR; PG8_WAIT_L(0); PG8_MMA(0, 1, At, B1); PG8_BAR;
            PG8_LDA(At, 0, 1); PG8_STAGE(PG8_SA(0, 0), a2, voffA);
            PG8_BAR; PG8_WAIT_L(0); PG8_MMA(1, 0, At, B0); PG8_BAR; PG8_SCHED;
            PG8_STAGE(PG8_SB(0, 1), b2 + hstep, voffB);
            PG8_WAIT_V(6); PG8_BAR; PG8_MMA(1, 1, At, B1); PG8_BAR;
            PG8_LDB(B0, 1, 0); PG8_SCHED; PG8_LDA(At, 1, 0); PG8_STAGE(PG8_SA(0, 1), a2 + hstep, voffA);
            PG8_WAIT_L(8); PG8_BAR; PG8_WAIT_L(0); PG8_MMA(0, 0, At, B0); PG8_BAR; PG8_SCHED;
            PG8_LDB(B1, 1, 1); PG8_STAGE(PG8_SB(1, 0), b3, voffB);
            PG8_BAR; PG8_WAIT_L(0); PG8_MMA(0, 1, At, B1); PG8_BAR;
            PG8_LDA(At, 1, 1); PG8_STAGE(PG8_SA(1, 0), a3, voffA);
            PG8_BAR; PG8_WAIT_L(0); PG8_MMA(1, 0, At, B0); PG8_BAR; PG8_SCHED;
            PG8_STAGE(PG8_SB(1, 1), b3 + hstep, voffB);
            PG8_WAIT_V(6); PG8_BAR; PG8_MMA(1, 1, At, B1); PG8_BAR;
            }
        }
        if constexpr (ALIGN_EPI) { if (wr == 0) PG8_BAR; }
        if constexpr (!Epi::AFTER_DRAIN) { E(acc, cur, wr, wc, fr, fq); S.done(cur); }
        if (!has_next) break;
#pragma unroll
        for (int a = 0; a < 2; ++a)
#pragma unroll
            for (int b = 0; b < 2; ++b)
#pragma unroll
                for (int m = 0; m < 4; ++m)
#pragma unroll
                    for (int n = 0; n < 2; ++n) acc[a][b][m][n] = (f32x4){0.f, 0.f, 0.f, 0.f};
        cur = nxt; cA = nA; cB = nB; ++ui;
        if constexpr (ALIGN_EPI) { if (wr == 1) PG8_BAR; }
    }
    PG8_WAIT_V(0);
    if constexpr (!ALIGN_EPI) { if (wr == 0) PG8_BAR; }
    PG8_BAR;
    if constexpr (Epi::AFTER_DRAIN) { E.fused(acc, cur, wr, wc, fr, fq, lds, wid, lane); S.done(cur); }
#undef PG8_SA
#undef PG8_SB
#undef PG8_STAGE
#undef PG8_LDA
#undef PG8_LDB
#undef PG8_MMA
#undef PG8_WAIT_V
#undef PG8_WAIT_L
#undef PG8_BAR
#undef PG8_SCHED
}
}

#define XB_TMO      128
#define XB_XCNT(j)  (256  + 64 * (j))
#define XB_XSUB(j)  (1280 + 64 * (j))
#define XB_XGEN(j)  (2304 + 64 * (j))
#define XB_TOP      3328
#define XB_TOPGEN   3392
#define XCD_BAR_WORDS 3456
#define XB_SPIN_CAP (1u << 18)
#define LAS __attribute__((address_space(3)))

__device__ __forceinline__ unsigned xb_ld(unsigned* p)              { return __hip_atomic_load(p, __ATOMIC_RELAXED, __HIP_MEMORY_SCOPE_AGENT); }
__device__ __forceinline__ unsigned xb_add(unsigned* p, unsigned v) { return __hip_atomic_fetch_add(p, v, __ATOMIC_RELAXED, __HIP_MEMORY_SCOPE_AGENT); }
__device__ __forceinline__ unsigned xb_xcc_id() { return (unsigned)__builtin_amdgcn_s_getreg((3 << 11) | 20) & 0xFu; }
#define XB_SPIN(cond, bar) do { unsigned _sp = 0; while (cond) { __builtin_amdgcn_s_sleep(1); \
    if ((++_sp & 255u) == 0u) { if (xb_ld(&(bar)[XB_TMO])) break; if (_sp > XB_SPIN_CAP) { atomicAdd(&(bar)[XB_TMO], 1u); break; } } } } while (0)

struct XcdBarrier {
    unsigned* bar; unsigned x;
    volatile LAS unsigned* st;
};

__device__ __forceinline__ XcdBarrier xcd_barrier_post(unsigned* bar, volatile LAS unsigned* st) {
    XcdBarrier b; b.bar = bar; b.x = xb_xcc_id(); b.st = st;
    if (threadIdx.x == 0) (void)xb_add(&bar[XB_XCNT(b.x)], 1u);
    return b;
}
__device__ __forceinline__ void xcd_barrier_complete(unsigned* bar, unsigned x, unsigned& nloc, unsigned& nx) {
    const unsigned G = gridDim.x * gridDim.y * gridDim.z;
    unsigned sum, cnt, mine, sp = 0u;
    for (;;) {
        sum = 0u; cnt = 0u; mine = 0u;
#pragma unroll
        for (unsigned j = 0; j < 16; ++j) { const unsigned c = xb_ld(&bar[XB_XCNT(j)]); sum += c; cnt += (c > 0u) ? 1u : 0u; mine = (j == x) ? c : mine; }
        if (sum == G) break;
        __builtin_amdgcn_s_sleep(1);
        if ((++sp & 255u) == 0u) { if (xb_ld(&bar[XB_TMO])) break; if (sp > XB_SPIN_CAP) { atomicAdd(&bar[XB_TMO], 1u); break; } }
    }
    nloc = mine > 0u ? mine : 1u; nx = cnt > 0u ? cnt : 1u;
}

__device__ __forceinline__ void xcd_barrier(const XcdBarrier& b, const bool leader_thread) {
    asm volatile("s_waitcnt vmcnt(0)" ::: "memory");
    __syncthreads();
    if (leader_thread) {
        unsigned* bar = b.bar;
        __builtin_amdgcn_s_waitcnt(0);
        unsigned nloc = b.st[0], nx = b.st[1];
        if (nloc == 0u) { xcd_barrier_complete(bar, b.x, nloc, nx); b.st[0] = nloc; b.st[1] = nx; }
        const unsigned old = xb_add(&bar[XB_XSUB(b.x)], 1u);
        const unsigned gen = old / nloc;
        if (old + 1u == (gen + 1u) * nloc) {
            __builtin_amdgcn_fence(__ATOMIC_RELEASE, "agent");
            asm volatile("s_waitcnt vmcnt(0)" ::: "memory");
            const unsigned og = xb_add(&bar[XB_TOP], 1u);
            const unsigned tg = og / nx;
            if (og + 1u == (tg + 1u) * nx) xb_add(&bar[XB_TOPGEN], 1u);
            else XB_SPIN(xb_ld(&bar[XB_TOPGEN]) == tg, bar);
            __builtin_amdgcn_fence(__ATOMIC_ACQUIRE, "agent");
            xb_add(&bar[XB_XGEN(b.x)], 1u);
            asm volatile("s_waitcnt vmcnt(0)" ::: "memory");
        } else {
            XB_SPIN(xb_ld(&bar[XB_XGEN(b.x)]) == gen, bar);
            __builtin_amdgcn_fence(__ATOMIC_ACQUIRE, "agent");
            asm volatile("s_waitcnt vmcnt(0)" ::: "memory");
        }
    }
    __syncthreads();
}

constexpr int NB = 2, SEQ = 16384, TLEN = 16400, DM = 1024, NMETA = 16, DEPTH = 2;
constexpr int MR = NB * SEQ;
constexpr int MV = MR + NB * NMETA;
constexpr int MP = 33024;
constexpr int INCOLS = 3912, NPAD = 4096, DFF = 4096;
constexpr int NTHREADS = 512;
constexpr float LOG2E = 1.4426950408889634f;
constexpr float QA_SCALE = 0.125f * LOG2E;
constexpr float QB_SCALE = 0.17677669529663687f * LOG2E;
constexpr float WI_SCALE = 0.044194173824159216f;
constexpr int NKS = 513;

constexpr size_t al256(size_t x) { return (x + 255) & ~(size_t)255; }
constexpr size_t WS_CTL   = 0;
constexpr size_t CTL_BYTES = 65536;
constexpr size_t WS_HMETA = CTL_BYTES;
constexpr size_t WS_ROPE  = WS_HMETA + (size_t)256 * DM * 4;
constexpr size_t WS_W     = al256(WS_ROPE + (size_t)TLEN * 32 * 8);
constexpr size_t W_IN_OFF = 0, W_OUT_OFF = (size_t)NPAD * DM * 2, W_FF1_OFF = W_OUT_OFF + (size_t)DM * DM * 2,
                 W_FF2_OFF = W_FF1_OFF + (size_t)DFF * DM * 2, W_LAYER = W_FF2_OFF + (size_t)DM * DFF * 2;
constexpr size_t WS_ABUF  = al256(WS_W + DEPTH * W_LAYER);
constexpr size_t WS_MASK  = WS_ABUF + (size_t)MP * DM * 2;
constexpr size_t WS_U     = al256(WS_MASK + (size_t)NB * NKS * TLEN * 4);
constexpr size_t WS_S     = WS_U + (size_t)NB * 4 * 129 * 4096 * 4;
constexpr size_t WS_PROJ  = WS_S + (size_t)NB * 4 * 129 * 4096 * 4;
constexpr size_t P512 = (size_t)MP * 512 * 2, P256 = (size_t)MP * 256 * 2;
constexpr size_t PJ_QA = 0, PJ_KA = P512, PJ_VA = 2 * P512, PJ_QI = 3 * P512, PJ_256 = 4 * P512;
constexpr size_t PJ_QB = PJ_256, PJ_KB = PJ_256 + P256, PJ_VB = PJ_256 + 2 * P256, PJ_QC = PJ_256 + 3 * P256, PJ_KC = PJ_256 + 4 * P256,
                 PJ_VC = PJ_256 + 5 * P256, PJ_GC = PJ_256 + 6 * P256, PJ_KI = PJ_256 + 7 * P256, PJ_WI = PJ_KI + (size_t)MP * 64 * 2,
                 PJ_END = PJ_WI + (size_t)MP * 8 * 4;
constexpr size_t ACT_BYTES = (size_t)MP * DFF * 2;
constexpr size_t WS_END = WS_PROJ + (ACT_BYTES > PJ_END ? ACT_BYTES : PJ_END);
constexpr int CW_BAR = 0;
constexpr int CW_KMAX = 4096;

constexpr int LDS_BYTES = 156 * 1024;
constexpr int LDS_MISC = 0, LDS_GEN = 256;

struct Args { const float* in[13]; float* out; unsigned char* ws; int ph_lo, ph_hi; };

struct Frame {
    const float *x, *meta, *rel_bias, *w_in, *norm_mix, *diff_lambda, *diff_norm, *ret_norm, *w_out, *norm_ff, *w_ff1, *w_ff2, *final_norm;
    float* out; unsigned char* ws; LAS unsigned char* lds; int tid, lane, wave, bid, G;
};

__device__ __forceinline__ float shx(float v, int m, int lane) { return __builtin_bit_cast(float, __builtin_amdgcn_ds_bpermute((lane ^ m) << 2, __builtin_bit_cast(int, v))); }
template <int M> __device__ __forceinline__ float sx(float v, int lane) { return shx(v, M, lane); }
__device__ __forceinline__ float hsum32(float v, int lane) { return v + shx(v, 32, lane); }
__device__ __forceinline__ unsigned hor32(unsigned v, int lane) { return v | (unsigned)__builtin_amdgcn_ds_bpermute((lane ^ 32) << 2, (int)v); }
__device__ __forceinline__ float bcast0(float v) { return __builtin_bit_cast(float, __builtin_amdgcn_ds_bpermute(0, __builtin_bit_cast(int, v))); }
__device__ __forceinline__ float wave_sum(float v, int lane) { v = hsum32(v, lane); v += sx<16>(v, lane); v += sx<8>(v, lane); v += sx<4>(v, lane); v += sx<2>(v, lane); v += sx<1>(v, lane); return v; }
__device__ __forceinline__ unsigned cvt_pk_bf16(float lo, float hi) { unsigned r; asm volatile("v_cvt_pk_bf16_f32 %0, %1, %2" : "=v"(r) : "v"(lo), "v"(hi)); return r; }
__device__ __forceinline__ unsigned cvt_pk_f16(float lo, float hi) { h2 p; p.x = (_Float16)lo; p.y = (_Float16)hi; return __builtin_bit_cast(unsigned, p); }
typedef unsigned u32x4 __attribute__((ext_vector_type(4)));
typedef float f32x4 __attribute__((ext_vector_type(4)));
__device__ __forceinline__ u32x4 pack8(const f32x4& a, const f32x4& b, bool bf) {
    u32x4 w;
    if (bf) { w.x = cvt_pk_bf16(a[0], a[1]); w.y = cvt_pk_bf16(a[2], a[3]); w.z = cvt_pk_bf16(b[0], b[1]); w.w = cvt_pk_bf16(b[2], b[3]); }
    else    { w.x = cvt_pk_f16(a[0], a[1]);  w.y = cvt_pk_f16(a[2], a[3]);  w.z = cvt_pk_f16(b[0], b[1]);  w.w = cvt_pk_f16(b[2], b[3]); }
    return w;
}
__device__ __forceinline__ int row_pos(int r) { return r < MR ? (r & (SEQ - 1)) + NMETA : ((r - MR) & 15); }

__device__ __forceinline__ int incol_map(int n) {
    if (n < 2048) return n;
    if (n < 2816) return n - 2048 + 2120;
    if (n < 3328) {
        const int seg = (n - 2816) >> 8, c = (n - 2816) & 255, head = c >> 6, p = c & 63;
        const int g = p >> 3, nn = (p >> 2) & 1, i = p & 3, d = 32 * nn + 4 * g + i;
        return (seg ? 3144 : 2888) + head * 64 + d;
    }
    if (n < 3840) return n - 3328 + 3400;
    if (n < 3904) return n - 3840 + 2048;
    if (n < 3912) return n - 3904 + 2112;
    return -1;
}

__constant__ double ROPE_REV[32] = {0.15915494309189535, 0.11934937021124886, 0.08949940160889101, 0.06711508300522726, 0.050329212104487035, 0.03774158471741977, 0.0283021958306234, 0.02122365276477766, 0.015915494309189534, 0.011934937021124886, 0.008949940160889102, 0.006711508300522725, 0.005032921210448704, 0.003774158471741977, 0.00283021958306234, 0.0021223652764777662, 0.0015915494309189536, 0.0011934937021124885, 0.0008949940160889102, 0.0006711508300522726, 0.0005032921210448703, 0.00037741584717419774, 0.00028302195830623395, 0.0002122365276477766, 0.00015915494309189535, 0.00011934937021124886, 8.949940160889102e-05, 6.711508300522725e-05, 5.0329212104487035e-05, 3.774158471741978e-05, 2.8302195830623396e-05, 2.122365276477766e-05};

struct EpiInProj {
    static constexpr bool PERM = true, AFTER_DRAIN = false;
    unsigned char* proj; const f32x2* rope; unsigned* kmax;
    __device__ __forceinline__ void kmax_update(const pg8::f32x4 (&acc)[2][2][4][2], int bj, unsigned* word, int fr, int fq) const {
        float mx = 0.f; const int LN = fq * 16 + fr;
#pragma unroll
        for (int ai = 0; ai < 2; ++ai)
#pragma unroll
            for (int m = 0; m < 4; ++m) {
                const pg8::f32x4 a = acc[ai][bj][m][0], b = acc[ai][bj][m][1];
                float s = (a[0] * a[0] + a[1] * a[1]) + (a[2] * a[2] + a[3] * a[3]) + (b[0] * b[0] + b[1] * b[1]) + (b[2] * b[2] + b[3] * b[3]);
                s += sx<16>(s, LN); s = hsum32(s, LN);
                mx = fmaxf(mx, s);
            }
        mx = fmaxf(mx, sx<1>(mx, LN)); mx = fmaxf(mx, sx<2>(mx, LN)); mx = fmaxf(mx, sx<4>(mx, LN)); mx = fmaxf(mx, sx<8>(mx, LN));
        if (fr == 0 && fq == 0) atomicMax(word, __float_as_uint(mx));
    }
    __device__ __forceinline__ void operator()(const pg8::f32x4 (&acc)[2][2][4][2], const pg8::Unit& u, int wr, int wc, int fr, int fq) const {
        const int pn = u.pn, rbase = u.pm * 256 + wr * 64 + fr, cw = wc * 32 + 8 * fq;
        if (pn <= 7 || (pn <= 14 && pn != 11 && pn != 12)) {
            unsigned char* base; int ld, colt; float scale = 1.f; bool bf = false;
            if (pn <= 7) { const int arr = pn >> 1; base = proj + (size_t)arr * P512; ld = 512; colt = (pn & 1) * 256; if (arr == 0) scale = QA_SCALE; bf = (arr == 2); }
            else { const int arr = pn - 8; base = proj + PJ_256 + (size_t)arr * P256; ld = 256; colt = 0; if (arr == 0) scale = QB_SCALE; bf = (arr == 2); }
#pragma unroll
            for (int ai = 0; ai < 2; ++ai)
#pragma unroll
                for (int m = 0; m < 4; ++m) {
                    const int row = rbase + ai * 128 + m * 16;
#pragma unroll
                    for (int bj = 0; bj < 2; ++bj) {
                        const pg8::f32x4 v0 = acc[ai][bj][m][0] * scale, v1 = acc[ai][bj][m][1] * scale;
                        *(u32x4*)(base + ((size_t)row * ld + colt + bj * 128 + cw) * 2) = pack8(v0, v1, bf);
                    }
                }
            if (pn == 2 || pn == 3) {
#pragma unroll
                for (int bj = 0; bj < 2; ++bj) { const int head = ((pn & 1) * 256 + bj * 128 + wc * 32) >> 6; kmax_update(acc, bj, kmax + head * 2 + (wc & 1), fr, fq); }
            }
            if (pn == 9) {
#pragma unroll
                for (int bj = 0; bj < 2; ++bj) { const int head = 2 * bj + (wc >> 1); kmax_update(acc, bj, kmax + 16 + head * 2 + (wc & 1), fr, fq); }
            }
        } else if (pn == 11 || pn == 12) {
            unsigned char* base = proj + PJ_256 + (size_t)(pn - 8) * P256;
            const float sc = (pn == 12) ? 0.125f : 1.f;
            const int g = 4 * (wc & 1) + fq;
#pragma unroll
            for (int ai = 0; ai < 2; ++ai)
#pragma unroll
                for (int m = 0; m < 4; ++m) {
                    const int row = rbase + ai * 128 + m * 16, t = row_pos(row);
                    const pg8::f32x4 cs0 = *(const pg8::f32x4*)(rope + (size_t)t * 32 + 4 * g), cs1 = *(const pg8::f32x4*)(rope + (size_t)t * 32 + 4 * g + 2);
                    const float c[4] = {cs0[0], cs0[2], cs1[0], cs1[2]}, s[4] = {cs0[1], cs0[3], cs1[1], cs1[3]};
#pragma unroll
                    for (int bj = 0; bj < 2; ++bj) {
                        const pg8::f32x4 x1 = acc[ai][bj][m][0], x2 = acc[ai][bj][m][1];
                        float o1[4], o2[4];
#pragma unroll
                        for (int i = 0; i < 4; ++i) { o1[i] = (x1[i] * c[i] - x2[i] * s[i]) * sc; o2[i] = (x1[i] * s[i] + x2[i] * c[i]) * sc; }
                        const int head = 2 * bj + (wc >> 1);
                        unsigned char* rp = base + ((size_t)row * 256 + head * 64 + 4 * g) * 2;
                        u32x2 w1, w2; w1.x = cvt_pk_f16(o1[0], o1[1]); w1.y = cvt_pk_f16(o1[2], o1[3]); w2.x = cvt_pk_f16(o2[0], o2[1]); w2.y = cvt_pk_f16(o2[2], o2[3]);
                        *(u32x2*)rp = w1; *(u32x2*)(rp + 64) = w2;
                    }
                }
        } else {
#pragma unroll
            for (int ai = 0; ai < 2; ++ai)
#pragma unroll
                for (int m = 0; m < 4; ++m) {
                    const int row = rbase + ai * 128 + m * 16;
                    const pg8::f32x4 v0 = acc[ai][0][m][0], v1 = acc[ai][0][m][1];
                    if (wc < 2) *(u32x4*)(proj + PJ_KI + ((size_t)row * 64 + cw) * 2) = pack8(v0, v1, false);
                    else if (wc == 2 && fq == 0) { float* wp = (float*)(proj + PJ_WI) + (size_t)row * 8; *(pg8::f32x4*)wp = v0 * WI_SCALE; *(pg8::f32x4*)(wp + 4) = v1 * WI_SCALE; }
                }
        }
    }
};
struct EpiRes {
    static constexpr bool PERM = false, AFTER_DRAIN = false;
    const float* res_main; float* out_main; float* hmeta;
    __device__ __forceinline__ void operator()(const pg8::f32x4 (&acc)[2][2][4][2], const pg8::Unit& u, int wr, int wc, int fr, int fq) const {
        const bool mt = (u.pm * 256 >= MR);
        const float* rb = mt ? hmeta : res_main; float* ob = mt ? hmeta : out_main;
        const int row0 = (mt ? u.pm * 256 - MR : u.pm * 256) + wr * 64 + fr, col0 = u.pn * 256 + wc * 32 + 4 * fq;
#pragma unroll
        for (int ai = 0; ai < 2; ++ai)
#pragma unroll
            for (int m = 0; m < 4; ++m) {
                const size_t ro = (size_t)(row0 + ai * 128 + m * 16) * DM + col0;
#pragma unroll
                for (int bj = 0; bj < 2; ++bj)
#pragma unroll
                    for (int n = 0; n < 2; ++n) { const pg8::f32x4 v = *(const pg8::f32x4*)(rb + ro + bj * 128 + n * 16) + acc[ai][bj][m][n]; *(pg8::f32x4*)(ob + ro + bj * 128 + n * 16) = v; }
            }
    }
};
struct EpiRelu2 {
    static constexpr bool PERM = true, AFTER_DRAIN = false;
    unsigned char* act;
    __device__ __forceinline__ void operator()(const pg8::f32x4 (&acc)[2][2][4][2], const pg8::Unit& u, int wr, int wc, int fr, int fq) const {
        const int rbase = u.pm * 256 + wr * 64 + fr, col0 = u.pn * 256 + wc * 32 + 8 * fq;
#pragma unroll
        for (int ai = 0; ai < 2; ++ai)
#pragma unroll
            for (int m = 0; m < 4; ++m) {
                const int row = rbase + ai * 128 + m * 16;
#pragma unroll
                for (int bj = 0; bj < 2; ++bj) {
                    pg8::f32x4 v0 = acc[ai][bj][m][0], v1 = acc[ai][bj][m][1];
#pragma unroll
                    for (int i = 0; i < 4; ++i) { const float a = fmaxf(v0[i], 0.f), b = fmaxf(v1[i], 0.f); v0[i] = a * a; v1[i] = b * b; }
                    *(u32x4*)(act + ((size_t)row * DFF + col0 + bj * 128) * 2) = pack8(v0, v1, false);
                }
            }
    }
};

struct WTile { const float* src; _Float16* dst; int ld, K, k0, n0, mapped; };
constexpr int WT_PER_LAYER = 16 * 64 + 16 * 16 + 16 * 64 + 64 * 16, WT_TOTAL = DEPTH * WT_PER_LAYER;
__device__ __forceinline__ WTile wt_desc(const Frame& F, int t) {
    WTile d; const int l = t / WT_PER_LAYER; int r = t - l * WT_PER_LAYER;
    unsigned char* wl = F.ws + WS_W + (size_t)l * W_LAYER;
    if (r < 1024)      { d.src = F.w_in + (size_t)l * DM * INCOLS; d.dst = (_Float16*)(wl + W_IN_OFF);  d.ld = INCOLS; d.K = DM;  d.mapped = 1; d.k0 = (r & 15) * 64; d.n0 = (r >> 4) * 64; }
    else if (r < 1280) { r -= 1024; d.src = F.w_out + (size_t)l * DM * DM;  d.dst = (_Float16*)(wl + W_OUT_OFF); d.ld = DM;  d.K = DM;  d.mapped = 0; d.k0 = (r & 15) * 64; d.n0 = (r >> 4) * 64; }
    else if (r < 2304) { r -= 1280; d.src = F.w_ff1 + (size_t)l * DM * DFF; d.dst = (_Float16*)(wl + W_FF1_OFF); d.ld = DFF; d.K = DM;  d.mapped = 0; d.k0 = (r & 15) * 64; d.n0 = (r >> 4) * 64; }
    else               { r -= 2304; d.src = F.w_ff2 + (size_t)l * DFF * DM; d.dst = (_Float16*)(wl + W_FF2_OFF); d.ld = DM;  d.K = DFF; d.mapped = 0; d.k0 = (r & 63) * 64; d.n0 = (r >> 6) * 64; }
    return d;
}
__device__ __forceinline__ void wt_load(const WTile& d, int tid, f32x4& v0, f32x4& v1) {
    const int kk = tid >> 4, n4 = (tid & 15) * 4; const int sc = d.mapped ? incol_map(d.n0 + n4) : d.n0 + n4;
    v0 = (f32x4){0.f, 0.f, 0.f, 0.f}; v1 = v0;
    if (sc >= 0) { v0 = *(const f32x4*)(d.src + (size_t)(d.k0 + kk) * d.ld + sc); v1 = *(const f32x4*)(d.src + (size_t)(d.k0 + kk + 32) * d.ld + sc); }
}
__device__ __forceinline__ void wtrans_all(const Frame& F) {
    LAS float* tile = (LAS float*)(F.lds + LDS_GEN); const int tid = F.tid;
    int t = F.bid; if (t >= WT_TOTAL) return;
    WTile d = wt_desc(F, t); f32x4 v0, v1; wt_load(d, tid, v0, v1);
#pragma unroll 1
    for (;;) {
        const int tn = t + F.G; WTile dn = d; f32x4 n0 = v0, n1 = v1;
        if (tn < WT_TOTAL) { dn = wt_desc(F, tn); wt_load(dn, tid, n0, n1); }
        { const int kk = tid >> 4, n4 = (tid & 15) * 4;
#pragma unroll
          for (int e = 0; e < 4; ++e) { tile[kk * 65 + n4 + e] = v0[e]; tile[(kk + 32) * 65 + n4 + e] = v1[e]; } }
        __syncthreads();
        { const int nn = tid >> 3, k8 = (tid & 7) * 8; h8 o;
#pragma unroll
          for (int e = 0; e < 8; ++e) o[e] = (_Float16)tile[(k8 + e) * 65 + nn];
          *(h8*)(d.dst + (size_t)(d.n0 + nn) * d.K + d.k0 + k8) = o; }
        __syncthreads();
        if (tn >= WT_TOTAL) break;
        t = tn; d = dn; v0 = n0; v1 = n1;
    }
}
template <int MODE> __device__ __forceinline__ void norm_to_abuf(const Frame& F, const float* gain) {
    _Float16* abuf = (_Float16*)(F.ws + WS_ABUF); const float* hmeta = (const float*)(F.ws + WS_HMETA);
    const int nw = F.G * 8;
    for (int r = F.bid * 8 + F.wave; r < MP; r += nw) {
        _Float16* dst = abuf + (size_t)r * DM;
        if (r >= MV) { const h4 z = {(_Float16)0.f, (_Float16)0.f, (_Float16)0.f, (_Float16)0.f};
#pragma unroll
            for (int j = 0; j < 4; ++j) *(h4*)(dst + j * 256 + F.lane * 4) = z; continue; }
        const float* src = MODE == 0 ? (r < MR ? F.x + (size_t)r * DM : F.meta + (size_t)((r - MR) & 15) * DM) : (r < MR ? F.out + (size_t)r * DM : hmeta + (size_t)(r - MR) * DM);
        f32x4 v[4]; float ss = 0.f;
#pragma unroll
        for (int j = 0; j < 4; ++j) { v[j] = *(const f32x4*)(src + j * 256 + F.lane * 4); ss += (v[j][0] * v[j][0] + v[j][1] * v[j][1]) + (v[j][2] * v[j][2] + v[j][3] * v[j][3]); }
        ss = wave_sum(ss, F.lane); const float rstd = rsqrtf(ss * (1.0f / DM) + 1e-6f);
#pragma unroll
        for (int j = 0; j < 4; ++j) { const f32x4 g = *(const f32x4*)(gain + j * 256 + F.lane * 4); h4 o;
#pragma unroll
            for (int e = 0; e < 4; ++e) o[e] = (_Float16)(v[j][e] * rstd * g[e]);
            *(h4*)(dst + j * 256 + F.lane * 4) = o; }
    }
}
__device__ __forceinline__ void final_norm(const Frame& F) {
    const int nw = F.G * 8;
    for (int r = F.bid * 8 + F.wave; r < MR; r += nw) {
        float* p = F.out + (size_t)r * DM; f32x4 v[4]; float ss = 0.f;
#pragma unroll
        for (int j = 0; j < 4; ++j) { v[j] = *(const f32x4*)(p + j * 256 + F.lane * 4); ss += (v[j][0] * v[j][0] + v[j][1] * v[j][1]) + (v[j][2] * v[j][2] + v[j][3] * v[j][3]); }
        ss = wave_sum(ss, F.lane); const float rstd = rsqrtf(ss * (1.0f / DM) + 1e-6f);
#pragma unroll
        for (int j = 0; j < 4; ++j) { const f32x4 g = *(const f32x4*)(F.final_norm + j * 256 + F.lane * 4); *(f32x4*)(p + j * 256 + F.lane * 4) = v[j] * rstd * g; }
    }
}
__device__ __forceinline__ void prologue(const Frame& F) {
    const int gtid = F.bid * NTHREADS + F.tid, gsz = F.G * NTHREADS;
    float* hmeta = (float*)(F.ws + WS_HMETA);
    for (int i = gtid; i < 256 * DM / 4; i += gsz) { const int row = i / (DM / 4), c4 = i % (DM / 4); f32x4 v = {0.f, 0.f, 0.f, 0.f}; if (row < NB * NMETA) v = *(const f32x4*)(F.meta + (size_t)(row & 15) * DM + c4 * 4); *(f32x4*)(hmeta + (size_t)row * DM + c4 * 4) = v; }
    f32x2* rope = (f32x2*)(F.ws + WS_ROPE);
    for (int i = gtid; i < TLEN * 32; i += gsz) { const int t = i >> 5, d = i & 31; const double rev = (double)t * ROPE_REV[d]; const float fr = (float)(rev - __builtin_floor(rev)); f32x2 cs; cs.x = __builtin_amdgcn_cosf(fr); cs.y = __builtin_amdgcn_sinf(fr); rope[i] = cs; }
    wtrans_all(F);
    norm_to_abuf<0>(F, F.norm_mix);
}
__device__ __forceinline__ int crow(int i, int h) { return (i & 3) + 8 * (i >> 2) + 4 * h; }
constexpr size_t WS_SCR = WS_U;
template <bool FROM_SCR> __device__ __forceinline__ void skinny_task(const unsigned char* A, int lda_bytes, const float* scr, const _Float16* Bt, int K, int n0, int k0, float* dst, int ldd, int lane) {
    const int r = lane & 31, h = lane >> 5;
    f32x16 acc;
#pragma unroll
    for (int i = 0; i < 16; ++i) acc[i] = 0.f;
#pragma unroll 1
    for (int kc = 0; kc < 4; ++kc) {
    h8 a[4], bb[4];
#pragma unroll
    for (int s = 0; s < 4; ++s) {
        const int k = k0 + 64 * kc + 16 * s + 8 * h;
        if (FROM_SCR) { const f32x4 x0 = *(const f32x4*)(scr + (size_t)r * DFF + k), x1 = *(const f32x4*)(scr + (size_t)r * DFF + k + 4);
#pragma unroll
            for (int e = 0; e < 4; ++e) { const float u = fmaxf(x0[e], 0.f), v = fmaxf(x1[e], 0.f); a[s][e] = (_Float16)(u * u); a[s][4 + e] = (_Float16)(v * v); } }
        else a[s] = *(const h8*)(A + (size_t)(MR + r) * lda_bytes + (size_t)k * 2);
        bb[s] = *(const h8*)(Bt + (size_t)(n0 + r) * K + k);
    }
#pragma unroll
    for (int s = 0; s < 4; ++s) acc = __builtin_amdgcn_mfma_f32_32x32x16_f16(a[s], bb[s], acc, 0, 0, 0);
    }
#pragma unroll
    for (int i = 0; i < 16; ++i) atomicAdd(dst + (size_t)crow(i, h) * ldd + n0 + r, acc[i]);
}
template <int MODE> __device__ __forceinline__ void skinny_meta(const Frame& F, const unsigned char* wl) {
    const int ntn = MODE == 1 ? 128 : 32, nks = MODE == 2 ? 16 : 4, ntask = ntn * nks;
    float* hmeta = (float*)(F.ws + WS_HMETA); float* scr = (float*)(F.ws + WS_SCR);
#pragma unroll 1
    for (int task = F.bid * 8 + F.wave; task < ntask; task += F.G * 8) {
        const int nt = task % ntn, ks = task / ntn;
        if (MODE == 0) skinny_task<false>(F.ws + WS_ABUF, DM * 2, nullptr, (const _Float16*)(wl + W_OUT_OFF), DM, nt * 32, ks * 256, hmeta, DM, F.lane);
        if (MODE == 1) skinny_task<false>(F.ws + WS_ABUF, DM * 2, nullptr, (const _Float16*)(wl + W_FF1_OFF), DM, nt * 32, ks * 256, scr, DFF, F.lane);
        if (MODE == 2) skinny_task<true>(nullptr, 0, scr, (const _Float16*)(wl + W_FF2_OFF), DFF, nt * 32, ks * 256, hmeta, DM, F.lane);
    }
}
__device__ __forceinline__ void zero_scr(const Frame& F) {
    f32x4* p = (f32x4*)(F.ws + WS_SCR); float z0 = 0.f; asm volatile("" : "+v"(z0)); const f32x4 z = {z0, z0, z0, z0};
    for (int i = F.bid * NTHREADS + F.tid; i < 32 * DFF / 4; i += F.G * NTHREADS) p[i] = z;
}
__device__ __forceinline__ void zero_abuf(const Frame& F) {
    u32x4* p = (u32x4*)(F.ws + WS_ABUF); const u32x4 z = {0u, 0u, 0u, 0u};
    for (size_t i = (size_t)F.bid * NTHREADS + F.tid; i < (size_t)MP * DM * 2 / 16; i += (size_t)F.G * NTHREADS) p[i] = z;
}

typedef short bf16x8v __attribute__((ext_vector_type(8)));
__constant__ unsigned char BUCKET_LUT[128] = {0, 1, 2, 3, 4, 5, 6, 7, 8, 9, 10, 11, 12, 13, 14, 15, 16, 16, 16, 17, 17, 18, 18, 18, 19, 19, 19, 20, 20, 20, 20, 21, 21, 21, 21, 22, 22, 22, 22, 22, 23, 23, 23, 23, 23, 23, 24, 24, 24, 24, 24, 24, 25, 25, 25, 25, 25, 25, 25, 26, 26, 26, 26, 26, 26, 26, 26, 27, 27, 27, 27, 27, 27, 27, 27, 27, 27, 28, 28, 28, 28, 28, 28, 28, 28, 28, 28, 29, 29, 29, 29, 29, 29, 29, 29, 29, 29, 29, 29, 30, 30, 30, 30, 30, 30, 30, 30, 30, 30, 30, 30, 30, 30, 31, 31, 31, 31, 31, 31, 31, 31, 31, 31, 31, 31, 31, 31, 31};
__device__ __forceinline__ bf16x8v pack_p(const f32x16& x, int s) {
    u32x4 p; p.x = cvt_pk_bf16(x[8 * s + 0], x[8 * s + 1]); p.y = cvt_pk_bf16(x[8 * s + 2], x[8 * s + 3]); p.z = cvt_pk_bf16(x[8 * s + 4], x[8 * s + 5]); p.w = cvt_pk_bf16(x[8 * s + 6], x[8 * s + 7]);
    return __builtin_bit_cast(bf16x8v, p);
}
#ifndef STAGGER
#define STAGGER 0
#endif
constexpr int TK = 128;
__device__ __forceinline__ bf16x8v vt_frag(LAS unsigned char* vimg, int dblk, int keybase, int s, int lane) {
    const int h = lane >> 5, blk = (lane >> 4) & 1, i16 = lane & 15, q = i16 >> 2, p = i16 & 3;
    LAS unsigned char* a = vimg + dblk * (TK * 64) + (keybase + 16 * s + 4 * h + q) * 64 + (16 * blk + 4 * p) * 2;
    const s16x4 lo = __builtin_amdgcn_ds_read_tr16_b64_v4i16((LAS s16x4*)a);
    const s16x4 hi = __builtin_amdgcn_ds_read_tr16_b64_v4i16((LAS s16x4*)(a + 8 * 64));
    return __builtin_shufflevector(lo, hi, 0, 1, 2, 3, 4, 5, 6, 7);
}

constexpr int KS_PITCH = 144;
constexpr int KBUF = TK * KS_PITCH, VBUF = 2 * TK * 64, B_KS = 0, B_VS = 4 * KBUF, B_LUT = B_VS + 4 * VBUF, B_END = B_LUT + 512;
__device__ __forceinline__ void mixB_unit(const Frame& F, int l, int b, int hh, int qblk, float lam, float oscale) {
    LAS unsigned char* L = F.lds + LDS_GEN;
    int lane_; { unsigned z0_ = 0u; asm volatile("" : "+s"(z0_)); lane_ = (int)__builtin_amdgcn_mbcnt_hi(~0u, __builtin_amdgcn_mbcnt_lo(~0u, z0_)); asm volatile("" : "+v"(lane_)); }
    const int lane = lane_, wave = F.wave, tid = wave * 64 + lane, r = lane & 31, h = lane >> 5;
    const unsigned char* proj = F.ws + WS_PROJ;
    const _Float16* QB = (const _Float16*)(proj + PJ_QB); const unsigned char* KB = proj + PJ_KB; const unsigned char* VB = proj + PJ_VB;
    const unsigned* kmax = (const unsigned*)(F.ws + WS_CTL) + CW_KMAX + 32 * l + 16;
    const bool meta_u = qblk < 0;
    const int qrow0 = meta_u ? MR + b * NMETA : b * SEQ + qblk * 256;
    const int qpos0 = meta_u ? 0 : NMETA + qblk * 256;
    const int nreal = meta_u ? 0 : 2 * qblk + 2;
    const int wq0 = 32 * wave;
    const bool wave_on = meta_u ? (wave == 0) : true;
    const int my_row = wave_on ? qrow0 + wq0 + r : qrow0, my_pos = qpos0 + wq0 + r;
    __syncthreads();
    if (tid < 128) ((LAS float*)(L + B_LUT))[tid] = F.rel_bias[BUCKET_LUT[tid] * 12 + 8 + hh] * LOG2E;
    float bmax = (lane < 32) ? F.rel_bias[lane * 12 + 8 + hh] * LOG2E : -1e30f;
    bmax = fmaxf(bmax, sx<16>(bmax, lane)); bmax = fmaxf(bmax, sx<8>(bmax, lane)); bmax = fmaxf(bmax, sx<4>(bmax, lane)); bmax = fmaxf(bmax, sx<2>(bmax, lane)); bmax = fmaxf(bmax, sx<1>(bmax, lane));
    bmax = bcast0(bmax);
    const float bfar = F.rel_bias[31 * 12 + 8 + hh] * LOG2E;
    h8 qf[2][2]; float mref[2]; bool safe = true;
#pragma unroll
    for (int c = 0; c < 2; ++c) {
        float n2 = 0.f;
#pragma unroll
        for (int s = 0; s < 2; ++s) { qf[c][s] = *(const h8*)(QB + (size_t)my_row * 256 + hh * 64 + c * 32 + 16 * s + 8 * h);
#pragma unroll
            for (int j = 0; j < 8; ++j) { const float v = (float)qf[c][s][j]; n2 += v * v; } }
        n2 = hsum32(n2, lane);
        mref[c] = sqrtf(n2 * __uint_as_float(kmax[hh * 2 + c])) * 1.002f + bmax;
        safe = safe && (mref[c] - bfar < 60.0f);
    }
    safe = __all(safe);
    if (safe) { mref[0] = bfar; mref[1] = bfar; }
    f32x16 O[2][2]; f32x2 lsum2[2][2] = {{{0.f, 0.f}, {0.f, 0.f}}, {{0.f, 0.f}, {0.f, 0.f}}};
#pragma unroll
    for (int c = 0; c < 2; ++c)
#pragma unroll
        for (int d = 0; d < 2; ++d)
#pragma unroll
            for (int i = 0; i < 16; ++i) O[c][d][i] = 0.f;
    const int skey = tid >> 3, sch = tid & 7;
    const unsigned kdst = skey * KS_PITCH + sch * 16, vdst = (sch >> 2) * (TK * 64) + skey * 64 + (sch & 3) * 16;
    const int ntiles = 1 + nreal;
    auto tile_row0 = [&](int t) -> int { return t == 0 ? MR + b * NMETA : b * SEQ + (t - 1) * TK; };
    u32x4 kreg[2], vreg[2];
#pragma unroll
    for (int j = 0; j < 2; ++j) { const size_t rr = (size_t)(tile_row0(0) + skey + 64 * j); kreg[j] = *(const u32x4*)(KB + rr * 512 + hh * 128 + sch * 16); vreg[j] = *(const u32x4*)(VB + rr * 512 + hh * 128 + sch * 16); }
#pragma unroll
    for (int j = 0; j < 2; ++j) { *(LAS u32x4*)(L + B_KS + kdst + j * 64 * KS_PITCH) = kreg[j]; *(LAS u32x4*)(L + B_VS + vdst + j * 64 * 64) = vreg[j]; }
    if (ntiles > 1) {
#pragma unroll
        for (int j = 0; j < 2; ++j) { const size_t rr = (size_t)(tile_row0(1) + skey + 64 * j); kreg[j] = *(const u32x4*)(KB + rr * 512 + hh * 128 + sch * 16); vreg[j] = *(const u32x4*)(VB + rr * 512 + hh * 128 + sch * 16); }
#pragma unroll
        for (int j = 0; j < 2; ++j) { *(LAS u32x4*)(L + B_KS + KBUF + kdst + j * 64 * KS_PITCH) = kreg[j]; *(LAS u32x4*)(L + B_VS + VBUF + vdst + j * 64 * 64) = vreg[j]; }
    }
    __syncthreads();
    const int wpos0 = qpos0 + wq0;
    if (wave >= 4) __builtin_amdgcn_s_setprio(1);
#pragma unroll 1
    for (int t = 0; t < ntiles; ++t) {
        const int buf = t & 3;
        if (STAGGER > 0 && wave >= 4 && (t & 1) == 0) __builtin_amdgcn_s_sleep(STAGGER);
        if (t + 2 < ntiles) {
#pragma unroll
            for (int j = 0; j < 2; ++j) { const size_t rr = (size_t)(tile_row0(t + 2) + skey + 64 * j); kreg[j] = *(const u32x4*)(KB + rr * 512 + hh * 128 + sch * 16); vreg[j] = *(const u32x4*)(VB + rr * 512 + hh * 128 + sch * 16); } }
        const int kpos0 = (t == 0) ? 0 : NMETA + (t - 1) * TK, nvalid = (t == 0) ? NMETA : TK;
        if (wave_on && kpos0 <= wpos0 + 31) {
            LAS unsigned char* Kb = L + B_KS + buf * KBUF; LAS unsigned char* Vb = L + B_VS + buf * VBUF;
#pragma unroll
            for (int sub = 0; sub < 4; ++sub) {
                if (sub * 32 >= nvalid || kpos0 + sub * 32 > wpos0 + 31) continue;
                const bool slow = !safe || (t == 0) || (kpos0 + sub * 32 + 31 > wpos0 - 128);
                h8 kfr[2][2]; bf16x8v vfr[2][2];
#pragma unroll
                for (int c = 0; c < 2; ++c)
#pragma unroll
                    for (int s = 0; s < 2; ++s) kfr[c][s] = *(const LAS h8*)(Kb + (sub * 32 + r) * KS_PITCH + (c * 32 + 16 * s + 8 * h) * 2);
#pragma unroll
                for (int d = 0; d < 2; ++d)
#pragma unroll
                    for (int s = 0; s < 2; ++s) vfr[d][s] = vt_frag(Vb, d, sub * 32, s, lane);
                __builtin_amdgcn_sched_barrier(0);
                f32x16 S[2];
#pragma unroll
                for (int c = 0; c < 2; ++c) {
#pragma unroll
                    for (int i = 0; i < 16; ++i) S[c][i] = 0.f;
#pragma unroll
                    for (int s = 0; s < 2; ++s) S[c] = __builtin_amdgcn_mfma_f32_32x32x16_f16(kfr[c][s], qf[c][s], S[c], 0, 0, 0);
                }
                if (slow) {
                    float bs[16];
#pragma unroll
                    for (int i = 0; i < 16; ++i) { const int dist = my_pos - (kpos0 + sub * 32 + crow(i, h)); bs[i] = ((const LAS float*)(L + B_LUT))[min(max(dist, 0), 127)]; }
#pragma unroll
                    for (int i = 0; i < 16; ++i) {
                        const int kidx = sub * 32 + crow(i, h), dist = my_pos - (kpos0 + kidx);
                        const bool ok = dist >= 0 && kidx < nvalid;
#pragma unroll
                        for (int c = 0; c < 2; ++c) { const float e = __builtin_amdgcn_exp2f(fminf(S[c][i] + (bs[i] - mref[c]), 80.f)); S[c][i] = ok ? e : 0.f; }
                    }
                }
#pragma unroll
                for (int c = 0; c < 2; ++c) {
                    __builtin_amdgcn_sched_barrier(0);
                    if (!slow) {
#pragma unroll
                        for (int i = 0; i < 16; ++i) S[c][i] = __builtin_amdgcn_exp2f(S[c][i]); }
#pragma unroll
                    for (int m = 0; m < 8; ++m) { const f32x2 pr = {S[c][2 * m], S[c][2 * m + 1]}; lsum2[c][m & 1] += pr; }
                    bf16x8v pf[2]; pf[0] = pack_p(S[c], 0); pf[1] = pack_p(S[c], 1);
                    __builtin_amdgcn_sched_barrier(0);
#pragma unroll
                    for (int d = 0; d < 2; ++d)
#pragma unroll
                        for (int s = 0; s < 2; ++s) O[c][d] = __builtin_amdgcn_mfma_f32_32x32x16_bf16(vfr[d][s], pf[s], O[c][d], 0, 0, 0);
                }
            }
        }
        if (t + 2 < ntiles) {
#pragma unroll
            for (int j = 0; j < 2; ++j) { *(LAS u32x4*)(L + B_KS + (buf ^ 2) * KBUF + kdst + j * 64 * KS_PITCH) = kreg[j]; *(LAS u32x4*)(L + B_VS + (buf ^ 2) * VBUF + vdst + j * 64 * 64) = vreg[j]; } }
        if (t & 1) { if (STAGGER > 0 && wave < 4) __builtin_amdgcn_s_sleep(STAGGER); __syncthreads(); }
    }
    __builtin_amdgcn_s_setprio(0);
    if (wave_on) {
        const float l0 = hsum32((lsum2[0][0][0] + lsum2[0][0][1]) + (lsum2[0][1][0] + lsum2[0][1][1]), lane), l1 = hsum32((lsum2[1][0][0] + lsum2[1][0][1]) + (lsum2[1][1][0] + lsum2[1][1][1]), lane);
        const float i0 = 1.0f / l0, i1 = lam / l1;
        float o[2][16], ss = 0.f;
#pragma unroll
        for (int d = 0; d < 2; ++d)
#pragma unroll
            for (int i = 0; i < 16; ++i) { o[d][i] = O[0][d][i] * i0 - O[1][d][i] * i1; ss += o[d][i] * o[d][i]; }
        ss = hsum32(ss, lane);
        const float rstd = rsqrtf(ss * (1.0f / 64.0f) + 1e-6f) * oscale;
        const float* gn = F.diff_norm + l * 64;
        if (!meta_u || r < NMETA) {
            _Float16* dst = (_Float16*)(F.ws + WS_ABUF) + (size_t)my_row * DM + 512 + hh * 64;
#pragma unroll
            for (int d = 0; d < 2; ++d)
#pragma unroll
                for (int g4 = 0; g4 < 4; ++g4) { const int d0 = 32 * d + 8 * g4 + 4 * h; const f32x4 gv = *(const f32x4*)(gn + d0);
                    u32x2 w; w.x = cvt_pk_f16(o[d][4 * g4 + 0] * rstd * gv[0], o[d][4 * g4 + 1] * rstd * gv[1]); w.y = cvt_pk_f16(o[d][4 * g4 + 2] * rstd * gv[2], o[d][4 * g4 + 3] * rstd * gv[3]);
                    *(u32x2*)(dst + d0) = w; }
        }
    }
}
__device__ __forceinline__ void mixB_phase(const Frame& F, int l) {
    const float* lp = F.diff_lambda + l * 128;
    float a = (F.lane < 32) ? lp[F.lane] * lp[32 + F.lane] : 0.f, c = (F.lane < 32) ? lp[64 + F.lane] * lp[96 + F.lane] : 0.f;
    a = wave_sum(a, F.lane); c = wave_sum(c, F.lane);
    const float linit = 0.8f - 0.6f * expf(-0.3f * (float)l);
    const float lam = expf(a) - expf(c) + linit, oscale = 1.0f - linit;
#pragma unroll 1
    for (int cidx = F.bid; cidx < 256; cidx += F.G) { const int bh = cidx & 7, i = cidx >> 3;
#pragma unroll 1
        for (int k = 0; k < 3; ++k) { if (k == 2 && cidx >= 8) break; mixB_unit(F, l, bh >> 2, bh & 3, k == 0 ? 63 - i : (k == 1 ? i : -1), lam, oscale); }
    }
}
__device__ __forceinline__ h8 tr_frag_nat(LAS unsigned char* img_blk, int rowbase, int s, int lane) {
    const int h = lane >> 5, blk = (lane >> 4) & 1, i16 = lane & 15, q = i16 >> 2, p = i16 & 3;
    LAS unsigned char* a = img_blk + (rowbase + 16 * s + 8 * h + q) * 64 + (16 * blk + 4 * p) * 2;
    const s16x4 lo = __builtin_amdgcn_ds_read_tr16_b64_v4i16((LAS s16x4*)a);
    const s16x4 hi = __builtin_amdgcn_ds_read_tr16_b64_v4i16((LAS s16x4*)(a + 4 * 64));
    return __builtin_bit_cast(h8, __builtin_shufflevector(lo, hi, 0, 1, 2, 3, 4, 5, 6, 7));
}
__device__ __forceinline__ h8 tr_frag_krow(LAS unsigned char* img_blk, int rowbase, int s, int lane) {
    const int h = lane >> 5, blk = (lane >> 4) & 1, i16 = lane & 15, q = i16 >> 2, p = i16 & 3;
    LAS unsigned char* a = img_blk + (rowbase + 16 * s + 4 * h + q) * 64 + (16 * blk + 4 * p) * 2;
    const s16x4 lo = __builtin_amdgcn_ds_read_tr16_b64_v4i16((LAS s16x4*)a);
    const s16x4 hi = __builtin_amdgcn_ds_read_tr16_b64_v4i16((LAS s16x4*)(a + 8 * 64));
    return __builtin_bit_cast(h8, __builtin_shufflevector(lo, hi, 0, 1, 2, 3, 4, 5, 6, 7));
}
__device__ __forceinline__ float ret_log2gamma(int hc) { return log2f(1.0f - exp2f(-5.0f - (float)hc)); }
__device__ __forceinline__ h8 scale_h8(const h8& v, float sc) { h8 o;
#pragma unroll
    for (int e = 0; e < 8; ++e) o[e] = (_Float16)((float)v[e] * sc);
    return o; }

__device__ __forceinline__ void mixC1_unit(const Frame& F, int b, int hp, int c) {
    LAS unsigned char* L = F.lds + LDS_GEN;
    const int tid = F.tid, lane = F.lane, wave = F.wave;
    const unsigned char* proj = F.ws + WS_PROJ;
    const int row0 = c == 0 ? MR + b * NMETA : b * SEQ + 128 * (c - 1), Lc = c == 0 ? NMETA : 128;
    __syncthreads();
#pragma unroll 1
    for (int idx = tid; idx < 4096; idx += NTHREADS) {
        const int head = idx >> 11, arr = (idx >> 10) & 1, j = (idx >> 3) & 127, ch = idx & 7, hc = 2 * hp + head;
        h8 v;
#pragma unroll
        for (int e = 0; e < 8; ++e) v[e] = (_Float16)0.f;
        if (j < Lc) { v = *(const h8*)(proj + (arr ? PJ_VC : PJ_KC) + (size_t)(row0 + j) * 512 + hc * 128 + ch * 16);
            if (arr) v = scale_h8(v, exp2f((float)(Lc - 1 - j) * ret_log2gamma(hc))); }
        *(LAS h8*)(L + head * 32768 + arr * 16384 + (ch >> 2) * 8192 + j * 64 + (ch & 3) * 16) = v;
    }
    __syncthreads();
    const int head = wave >> 2, mb = (wave >> 1) & 1, nb = wave & 1, r = lane & 31, h = lane >> 5;
    f32x16 acc;
#pragma unroll
    for (int i = 0; i < 16; ++i) acc[i] = 0.f;
#pragma unroll
    for (int s = 0; s < 8; ++s) { const h8 a = tr_frag_nat(L + head * 32768 + mb * 8192, 0, s, lane), bb = tr_frag_nat(L + head * 32768 + 16384 + nb * 8192, 0, s, lane);
        acc = __builtin_amdgcn_mfma_f32_32x32x16_f16(a, bb, acc, 0, 0, 0); }
    float* U = (float*)(F.ws + WS_U) + ((size_t)((b * 4 + 2 * hp + head) * 129 + c)) * 4096;
#pragma unroll
    for (int i = 0; i < 16; ++i) U[(32 * mb + crow(i, h)) * 64 + 32 * nb + r] = acc[i];
}
__device__ __forceinline__ void mixC1_phase(const Frame& F) {
#pragma unroll 1
    for (int u = F.bid; u < NB * 2 * 129; u += F.G) { const int c = u % 129, bh = u / 129; mixC1_unit(F, bh >> 1, bh & 1, c); }
}
__device__ __forceinline__ void mixC_scan(const Frame& F) {
    if (F.tid >= 128) return;
    const int e = F.bid * 128 + F.tid;
    if (e >= NB * 4 * 4096) return;
    const int bh = e >> 12, el = e & 4095, hc = bh & 3;
    const float lg = ret_log2gamma(hc), g128 = exp2f(128.f * lg), g16 = exp2f(16.f * lg);
    const float* U = (const float*)(F.ws + WS_U) + (size_t)bh * 129 * 4096 + el; float* S = (float*)(F.ws + WS_S) + (size_t)bh * 129 * 4096 + el;
    float st = U[0];
    S[4096] = st;
#pragma unroll 1
    for (int c0 = 1; c0 < 128; c0 += 16) {
        float u[16];
#pragma unroll
        for (int k = 0; k < 16; ++k) u[k] = (c0 + k < 128) ? U[(size_t)(c0 + k) * 4096] : 0.f;
#pragma unroll
        for (int k = 0; k < 16; ++k) if (c0 + k < 128) { st = st * g128 + u[k]; S[(size_t)(c0 + k + 1) * 4096] = st; }
    }
    (void)g16;
}
constexpr int C2_KI = 0, C2_VI = 128 * KS_PITCH, C2_ST = C2_VI + 16384, C2_HEAD = C2_ST + 64 * KS_PITCH;
__device__ __forceinline__ void mixC2_unit(const Frame& F, int l, int b, int hp, int c) {
    LAS unsigned char* L = F.lds + LDS_GEN;
    const int tid = F.tid, lane = F.lane, wave = F.wave, r = lane & 31, h = lane >> 5;
    const unsigned char* proj = F.ws + WS_PROJ;
    const int row0 = c == 0 ? MR + b * NMETA : b * SEQ + 128 * (c - 1), Lc = c == 0 ? NMETA : 128;
    __syncthreads();
#pragma unroll 1
    for (int idx = tid; idx < 4096; idx += NTHREADS) {
        const int head = idx >> 11, arr = (idx >> 10) & 1, j = (idx >> 3) & 127, ch = idx & 7, hc = 2 * hp + head;
        h8 v;
#pragma unroll
        for (int e = 0; e < 8; ++e) v[e] = (_Float16)0.f;
        if (j < Lc) v = *(const h8*)(proj + (arr ? PJ_VC : PJ_KC) + (size_t)(row0 + j) * 512 + hc * 128 + ch * 16);
        if (arr) *(LAS h8*)(L + head * C2_HEAD + C2_VI + (ch >> 2) * 8192 + j * 64 + (ch & 3) * 16) = v;
        else     *(LAS h8*)(L + head * C2_HEAD + C2_KI + j * KS_PITCH + ch * 16) = v;
    }
    if (c > 0) {
#pragma unroll 1
        for (int idx = tid; idx < 2 * 4096; idx += NTHREADS) { const int head = idx >> 12, el = idx & 4095, dk = el >> 6, dv = el & 63;
            const float v = ((const float*)(F.ws + WS_S))[((size_t)((b * 4 + 2 * hp + head) * 129 + c)) * 4096 + el];
            *(LAS _Float16*)(L + head * C2_HEAD + C2_ST + dv * KS_PITCH + dk * 2) = (_Float16)v; }
    }
    __syncthreads();
    const int head = wave >> 2, wq = wave & 3, hc = 2 * hp + head;
    if (wq * 32 < Lc) {
        LAS unsigned char* Hb = L + head * C2_HEAD;
        const int qi = wq * 32 + r, my_row = row0 + qi;
        const float lg = ret_log2gamma(hc);
        h8 qf[4];
#pragma unroll
        for (int s = 0; s < 4; ++s) qf[s] = *(const h8*)(proj + PJ_QC + (size_t)my_row * 512 + hc * 128 + (16 * s + 8 * h) * 2);
        f32x16 O[2];
#pragma unroll
        for (int d = 0; d < 2; ++d)
#pragma unroll
            for (int i = 0; i < 16; ++i) O[d][i] = 0.f;
        if (c > 0) {
#pragma unroll
            for (int d = 0; d < 2; ++d)
#pragma unroll
                for (int s = 0; s < 4; ++s) { const h8 a = *(const LAS h8*)(Hb + C2_ST + (32 * d + r) * KS_PITCH + (16 * s + 8 * h) * 2);
                    O[d] = __builtin_amdgcn_mfma_f32_32x32x16_f16(a, qf[s], O[d], 0, 0, 0); }
            const float qd = exp2f((float)(qi + 1) * lg);
#pragma unroll
            for (int d = 0; d < 2; ++d)
#pragma unroll
                for (int i = 0; i < 16; ++i) O[d][i] *= qd;
        }
#pragma unroll 1
        for (int jb = 0; jb <= wq; ++jb) {
            f32x16 S;
#pragma unroll
            for (int i = 0; i < 16; ++i) S[i] = 0.f;
#pragma unroll
            for (int s = 0; s < 4; ++s) { const h8 kf = *(const LAS h8*)(Hb + C2_KI + (32 * jb + r) * KS_PITCH + (16 * s + 8 * h) * 2);
                S = __builtin_amdgcn_mfma_f32_32x32x16_f16(kf, qf[s], S, 0, 0, 0); }
#pragma unroll
            for (int i = 0; i < 16; ++i) { const int dd = qi - (32 * jb + crow(i, h)); S[i] = dd >= 0 ? S[i] * exp2f((float)dd * lg) : 0.f; }
            h8 pf[2];
#pragma unroll
            for (int s = 0; s < 2; ++s) { u32x4 p; p.x = cvt_pk_f16(S[8 * s + 0], S[8 * s + 1]); p.y = cvt_pk_f16(S[8 * s + 2], S[8 * s + 3]); p.z = cvt_pk_f16(S[8 * s + 4], S[8 * s + 5]); p.w = cvt_pk_f16(S[8 * s + 6], S[8 * s + 7]); pf[s] = __builtin_bit_cast(h8, p); }
#pragma unroll
            for (int d = 0; d < 2; ++d)
#pragma unroll
                for (int s = 0; s < 2; ++s) { const h8 vf = tr_frag_krow(Hb + C2_VI + d * 8192, 32 * jb, s, lane);
                    O[d] = __builtin_amdgcn_mfma_f32_32x32x16_f16(vf, pf[s], O[d], 0, 0, 0); }
        }
        float ss = 0.f;
#pragma unroll
        for (int d = 0; d < 2; ++d)
#pragma unroll
            for (int i = 0; i < 16; ++i) ss += O[d][i] * O[d][i];
        ss = hsum32(ss, lane);
        const float rstd = rsqrtf(ss * (1.0f / 64.0f) + 1e-6f);
        if (qi < Lc) {
            const float* gn = F.ret_norm + l * 256 + hc * 64;
            const _Float16* gc = (const _Float16*)(proj + PJ_GC) + (size_t)my_row * 256 + hc * 64;
            _Float16* dst = (_Float16*)(F.ws + WS_ABUF) + (size_t)my_row * DM + 768 + hc * 64;
#pragma unroll
            for (int d = 0; d < 2; ++d)
#pragma unroll
                for (int g4 = 0; g4 < 4; ++g4) { const int d0 = 32 * d + 8 * g4 + 4 * h; const f32x4 gv = *(const f32x4*)(gn + d0); const h4 gg = *(const h4*)(gc + d0);
                    float o[4];
#pragma unroll
                    for (int e = 0; e < 4; ++e) { const float g = (float)gg[e]; o[e] = O[d][4 * g4 + e] * rstd * gv[e] * (g / (1.0f + __expf(-g))); }
                    u32x2 w; w.x = cvt_pk_f16(o[0], o[1]); w.y = cvt_pk_f16(o[2], o[3]); *(u32x2*)(dst + d0) = w; }
        }
    }
}
__device__ __forceinline__ void mixC2_phase(const Frame& F, int l) {
#pragma unroll 1
    for (int u = F.bid; u < NB * 2 * 129; u += F.G) { const int c = u % 129, bh = u / 129; mixC2_unit(F, l, bh >> 1, bh & 1, c); }
}
constexpr int IDX_HP = 257;
constexpr int IDX_HIST = 0, IDX_STATS = 32 * IDX_HP * 4, IDX_INFO = IDX_STATS + 2304, IDX_CCNT = IDX_INFO + 256, IDX_MASK = IDX_CCNT + 384, IDX_CAND = IDX_MASK + 65792, IDX_Q = IDX_CAND + 32 * 128 * 4, IDX_QPITCH = 1168, IDX_END = IDX_Q + 32 * IDX_QPITCH;
#ifndef PROBE_REP
#define PROBE_REP 0
#endif
#if PROBE_REP >= 40
#define PTS(v) do { __builtin_amdgcn_sched_barrier(0); v = (unsigned)__builtin_amdgcn_s_memtime(); __builtin_amdgcn_sched_barrier(0); } while (0)
#else
#define PTS(v) do {} while (0)
#endif
#if PROBE_REP >= 40 && PROBE_REP < 60
#define IPTS(v) PTS(v)
#else
#define IPTS(v) do {} while (0)
#endif
constexpr int IDX_CAP = 128, IDX_NBIN = 256, NSUB = 3;
static_assert(IDX_END + LDS_GEN <= LDS_BYTES, "indexer LDS");
struct KFrag { h8 v[4]; };
__device__ __forceinline__ KFrag idx_load_k(const unsigned char* krow_ptr, int h) { KFrag k;
#pragma unroll
    for (int s = 0; s < 4; ++s) k.v[s] = *(const h8*)(krow_ptr + (16 * s + 8 * h) * 2);
    return k; }
#define IDX_LOADQ(dst, hd) do { _Pragma("unroll") for (int s_ = 0; s_ < 4; ++s_) dst[s_] = *(const LAS h8*)(qimg_lane + ((hd) * 64 + 16 * s_) * 2); } while (0)
#define IDX_MFMA4(acc, q) do { _Pragma("unroll") for (int s_ = 0; s_ < 4; ++s_) acc = __builtin_amdgcn_mfma_f32_32x32x16_f16(kf.v[s_], q[s_], acc, 0, 0, 0); } while (0)
#define IDX_FMA(hd, S) do { _Pragma("unroll") for (int i_ = 0; i_ < 16; ++i_) sc[i_] = __builtin_fmaf(w[hd], __builtin_fabsf(S[i_]), sc[i_]); } while (0)
#define IDX_SB __builtin_amdgcn_sched_barrier(0)
__device__ __forceinline__ void idx_scores(const LAS unsigned char* qimg_lane, const float (&w)[8], const KFrag& kf, f32x16& sc) {
    h8 q[2][4]; f32x16 S[2];
    IDX_LOADQ(q[0], 8); IDX_SB;
#pragma unroll
    for (int i = 0; i < 16; ++i) sc[i] = 0.f;
    IDX_MFMA4(sc, q[0]); IDX_LOADQ(q[1], 0); IDX_SB;
#pragma unroll
    for (int hd = 0; hd < 8; ++hd) {
#pragma unroll
        for (int i = 0; i < 16; ++i) S[hd & 1][i] = 0.f;
        IDX_MFMA4(S[hd & 1], q[(hd + 1) & 1]);
        if (hd < 7) IDX_LOADQ(q[hd & 1], hd + 1);
        if (hd > 0) IDX_FMA(hd - 1, S[(hd - 1) & 1]);
        IDX_SB;
    }
    IDX_FMA(7, S[1]);
}
#define IDX_PIN(V) asm volatile("" : "+v"(V[0]), "+v"(V[1]), "+v"(V[2]), "+v"(V[3]), "+v"(V[4]), "+v"(V[5]), "+v"(V[6]), "+v"(V[7]), "+v"(V[8]), "+v"(V[9]), "+v"(V[10]), "+v"(V[11]), "+v"(V[12]), "+v"(V[13]), "+v"(V[14]), "+v"(V[15]))
#define IDX_MFMA4K(acc, q, KF) do { _Pragma("unroll") for (int s_ = 0; s_ < 4; ++s_) acc = __builtin_amdgcn_mfma_f32_32x32x16_f16(KF.v[s_], q[s_], acc, 0, 0, 0); } while (0)
#define IDX_FMA2(SC, hd, S) do { _Pragma("unroll") for (int i_ = 0; i_ < 16; ++i_) SC[i_] = __builtin_fmaf(w[hd], __builtin_fabsf(S[i_]), SC[i_]); } while (0)
__device__ __forceinline__ void idx_scores2(const LAS unsigned char* qimg_lane, const float (&w)[8], const KFrag& kfA, const KFrag& kfB, f32x16& scA, f32x16& scB) {
    h8 q[2][4]; f32x16 SA, SB;
    IDX_LOADQ(q[0], 8); IDX_SB;
#pragma unroll
    for (int i = 0; i < 16; ++i) { scA[i] = 0.f; scB[i] = 0.f; }
    IDX_MFMA4K(scA, q[0], kfA); IDX_MFMA4K(scB, q[0], kfB); IDX_LOADQ(q[1], 0); IDX_SB;
#pragma unroll
    for (int hd = 0; hd < 8; ++hd) {
#pragma unroll
        for (int i = 0; i < 16; ++i) SA[i] = 0.f;
        IDX_MFMA4K(SA, q[(hd + 1) & 1], kfA);
        if (hd > 0) { IDX_FMA2(scB, hd - 1, SB); IDX_PIN(scB); }
        IDX_SB;
#pragma unroll
        for (int i = 0; i < 16; ++i) SB[i] = 0.f;
        IDX_MFMA4K(SB, q[(hd + 1) & 1], kfB);
        if (hd < 7) IDX_LOADQ(q[hd & 1], hd + 1);
        IDX_FMA2(scA, hd, SA); IDX_PIN(scA);
        IDX_SB;
    }
    IDX_FMA2(scB, 7, SB);
}
template <int NS> __device__ __forceinline__ void idx_scoresN(const LAS unsigned char* qimg_lane, const float (&w)[8], KFrag (&kf)[NS], const unsigned char* const (&nextp)[NS], int h, f32x16 (&sc)[NS]) {
    h8 q[2][4]; f32x16 S[NS];
#if PROBE_REP == 30
    h8 zk = {0, 0, 0, 0, 0, 0, 0, 0}; asm volatile("" : "+v"(zk));
#endif
#if PROBE_REP == 31
    float wz = 0.f; asm volatile("" : "+v"(wz));
#define IDX_FMAZ(SC, S) do { _Pragma("unroll") for (int i_ = 0; i_ < 16; ++i_) SC[i_] = __builtin_fmaf(wz, __builtin_fabsf(S[i_]), SC[i_]); } while (0)
#else
#define IDX_FMAZ(SC, S) do {} while (0)
#endif
    IDX_LOADQ(q[0], 8); IDX_SB;
#pragma unroll
    for (int t = 0; t < NS; ++t) {
#pragma unroll
        for (int i = 0; i < 16; ++i) sc[t][i] = 0.f;
        IDX_MFMA4K(sc[t], q[0], kf[t]); }
    IDX_LOADQ(q[1], 0); IDX_SB;
#pragma unroll
    for (int hd = 0; hd < 8; ++hd) {
#pragma unroll
        for (int t = 0; t < NS; ++t) {
#pragma unroll
            for (int i = 0; i < 16; ++i) S[t][i] = 0.f;
            IDX_MFMA4K(S[t], q[(hd + 1) & 1], kf[t]);
#if PROBE_REP == 30
#pragma unroll
            for (int s_ = 0; s_ < 4; ++s_) S[t] = __builtin_amdgcn_mfma_f32_32x32x16_f16(zk, q[(hd + 1) & 1][s_], S[t], 0, 0, 0);
#endif
            if (t == 0 && hd < 7) IDX_LOADQ(q[hd & 1], hd + 1);
            if (hd == 7) kf[t] = idx_load_k(nextp[t], h);
            if (t > 0) { IDX_FMA2(sc[t - 1], hd, S[t - 1]); IDX_FMAZ(sc[t - 1], S[t - 1]); IDX_PIN(sc[t - 1]); }
            else if (hd > 0) { IDX_FMA2(sc[NS - 1], hd - 1, S[NS - 1]); IDX_FMAZ(sc[NS - 1], S[NS - 1]); IDX_PIN(sc[NS - 1]); }
            IDX_SB;
        }
    }
    IDX_FMA2(sc[NS - 1], 7, S[NS - 1]);
}
__device__ __forceinline__ int f_ord(float v) { const int i = __float_as_int(v); return i >= 0 ? i : (int)(0x80000000u - (unsigned)i); }
__device__ __forceinline__ float f_unord(int o) { return __int_as_float(o >= 0 ? o : (int)(0x80000000u - (unsigned)o)); }
__device__ __forceinline__ float idx_raw_edge(float B, float inv, float c0f) {
    if (!(B > -3.0e38f)) return -__builtin_inff();
    if (!(B < 3.0e38f)) return __builtin_inff();
    int lo = f_ord(-3.0e38f), hi = f_ord(3.0e38f);
#pragma unroll 1
    for (int it = 0; it < 34; ++it) { const int mid = lo + (int)(((unsigned)hi - (unsigned)lo) >> 1); if (__builtin_fmaf(f_unord(mid), inv, c0f) >= B) hi = mid; else lo = mid; }
    return f_unord(hi);
}
#define IDX_ACCBIT(m, s, t) asm("v_cmp_ge_f32 vcc, %1, %2\n\tv_addc_co_u32 %0, vcc, %0, %0, vcc" : "+v"(m) : "v"(s), "v"(t) : "vcc")
__device__ __forceinline__ int suffix_sum(int v, int lane) {
#pragma unroll
    for (int off = 1; off < 64; off <<= 1) { const int t = __builtin_amdgcn_ds_bpermute((lane + off) << 2, v); if (lane + off < 64) v += t; }
    return v;
}
__device__ __forceinline__ void mixA_index_unit(const Frame& F, int b, int g) {
    LAS unsigned char* L = F.lds + LDS_GEN;
    int lane_; { unsigned z0_ = 0u; asm volatile("" : "+s"(z0_)); lane_ = (int)__builtin_amdgcn_mbcnt_hi(~0u, __builtin_amdgcn_mbcnt_lo(~0u, z0_)); asm volatile("" : "+v"(lane_)); }
    int tid_ = F.wave * 64 + lane_; asm volatile("" : "+v"(tid_));
    const int tid = tid_, lane = lane_, wave = F.wave, r = lane & 31, h = lane >> 5;
    const unsigned char* proj = F.ws + WS_PROJ;
    const unsigned char* KI = proj + PJ_KI;
    const int nq = g == 0 ? NMETA : 32;
    const int qrow = g == 0 ? MR + b * NMETA + (r & 15) : b * SEQ + 32 * (g - 1) + r;
    const int tq0 = g == 0 ? 0 : NMETA + 32 * (g - 1);
    const bool qvalid = r < nq;
    auto ks_row0 = [&](int ks) -> int { return ks == 0 ? MR + b * NMETA : b * SEQ + 32 * (ks - 1); };
#if PROBE_REP >= 40 && PROBE_REP < 60
    unsigned accS = 0, accP = 0, accP2 = 0, accNC = 0, accNR = 0, tU0, tx0, tx1, tx2, tx3, tx4, tx5, tx6; IPTS(tU0);
#else
    unsigned tx0, tx1, tx2, tx3, tx4, tx5, tx6;
#endif
    __syncthreads();
    for (int i = tid; i < 32 * IDX_HP; i += NTHREADS) ((LAS unsigned*)(L + IDX_HIST))[i] = 0u;
    if (tid < 32) ((LAS unsigned*)(L + IDX_CCNT))[tid] = 0u;
    for (int i = tid; i < (g + 1) * 32; i += NTHREADS) ((LAS unsigned*)(L + IDX_MASK))[i] = 0u;
    auto krow = [&](int ks) -> const unsigned char* { return KI + (size_t)(ks_row0(ks <= g ? ks : g) + r) * 128; };
    const KFrag kf0 = idx_load_k(KI + (size_t)(b * SEQ + 32 * (wave & 3) + r) * 128, h);
    KFrag kf[NSUB];
#pragma unroll
    for (int u = 0; u < NSUB; ++u) kf[u] = idx_load_k(krow(NSUB * wave + u), h);
    float w[8];
    const LAS unsigned char* qf = L + IDX_Q + r * IDX_QPITCH + 8 * h * 2;
    { const float* WI = (const float*)(proj + PJ_WI) + (size_t)qrow * 8; const f32x4 w0 = *(const f32x4*)WI, w1 = *(const f32x4*)(WI + 4);
      w[0] = w0[0]; w[1] = w0[1]; w[2] = w0[2]; w[3] = w0[3]; w[4] = w1[0]; w[5] = w1[1]; w[6] = w1[2]; w[7] = w1[3]; }
    { const int qq = tid >> 4, dc = tid & 15; const int qr = g == 0 ? MR + b * NMETA + (qq & 15) : b * SEQ + 32 * (g - 1) + qq;
      const unsigned char* qsrc = proj + PJ_QI + (size_t)qr * 1024 + dc * 8; u32x2 qv[8];
#pragma unroll
      for (int hd = 0; hd < 8; ++hd) qv[hd] = *(const u32x2*)(qsrc + hd * 128);
      const float* WQ = (const float*)(proj + PJ_WI) + (size_t)qr * 8; const f32x4 wa = *(const f32x4*)WQ, wb = *(const f32x4*)(WQ + 4);
      const float wq[8] = {wa[0], wa[1], wa[2], wa[3], wb[0], wb[1], wb[2], wb[3]};
      float a4[4] = {0.f, 0.f, 0.f, 0.f};
#pragma unroll
      for (int hd = 0; hd < 8; ++hd) { const h4 q = __builtin_bit_cast(h4, qv[hd]);
#pragma unroll
          for (int e = 0; e < 4; ++e) a4[e] += wq[hd] * (float)q[e];
          *(LAS u32x2*)(L + IDX_Q + qq * IDX_QPITCH + hd * 128 + dc * 8) = qv[hd]; }
      u32x2 o; o.x = cvt_pk_f16(a4[0], a4[1]); o.y = cvt_pk_f16(a4[2], a4[3]);
      *(LAS u32x2*)(L + IDX_Q + qq * IDX_QPITCH + 1024 + dc * 8) = o; }
    __syncthreads();
    if (wave < 4) {
        f32x16 sc; idx_scores(qf, w, kf0, sc);
        float s1 = 0.f, s2 = 0.f;
#pragma unroll
        for (int i = 0; i < 16; ++i) { s1 += sc[i]; s2 += sc[i] * sc[i]; }
        s1 = hsum32(s1, lane); s2 = hsum32(s2, lane);
        if (h == 0) { ((LAS float*)(L + IDX_STATS))[(wave * 32 + r) * 2] = s1; ((LAS float*)(L + IDX_STATS))[(wave * 32 + r) * 2 + 1] = s2; }
    }
    __syncthreads();
    float c0f, inv;
    { float s1 = 0.f, s2 = 0.f;
#pragma unroll
      for (int k = 0; k < 4; ++k) { s1 += ((LAS float*)(L + IDX_STATS))[(k * 32 + r) * 2]; s2 += ((LAS float*)(L + IDX_STATS))[(k * 32 + r) * 2 + 1]; }
      const float mean = s1 * (1.0f / 128.0f), var = fmaxf(s2 * (1.0f / 128.0f) - mean * mean, 0.f), sd = fmaxf(sqrtf(var), 1e-12f);
      inv = (float)IDX_NBIN / (10.0f * sd); c0f = -(mean - 3.0f * sd) * inv; }
    LAS unsigned* hrow = (LAS unsigned*)(L + IDX_HIST) + r * IDX_HP;
    IPTS(tx0);
#if PROBE_REP == 12
    for (int rep12 = 0; rep12 < 2; ++rep12) { __syncthreads(); for (int i = tid; i < 32 * IDX_HP; i += NTHREADS) ((LAS unsigned*)(L + IDX_HIST))[i] = 0u; __syncthreads();
#else
    {
#endif
#pragma unroll 1
        for (int ks = NSUB * wave; ks <= g; ks += 8 * NSUB) {
            const unsigned char* nextp[NSUB];
#pragma unroll
            for (int u = 0; u < NSUB; ++u) nextp[u] = krow((ks + 8 * NSUB <= g ? ks + 8 * NSUB : NSUB * wave) + u);
#if PROBE_REP >= 40 && PROBE_REP < 60
            unsigned tb, tc, td; IPTS(tb);
#endif
            f32x16 scv[NSUB]; __builtin_amdgcn_s_setprio(1); idx_scoresN<NSUB>(qf, w, kf, nextp, h, scv); __builtin_amdgcn_s_setprio(0);
#if PROBE_REP >= 40 && PROBE_REP < 60
            IDX_PIN(scv[NSUB - 1]); IPTS(tc); accS += tc - tb;
#endif
#pragma unroll
            for (int u2 = 0; u2 < NSUB; ++u2) {
                const int kss = ks + u2; if (kss > g) continue;
                if (kss == 0 || kss == g) {
#pragma unroll
                    for (int i = 0; i < 16; ++i) {
                        const int kidx = crow(i, h);
                        const bool ok = qvalid && (kss == 0 ? kidx < NMETA && (g > 0 || kidx <= r) : kidx <= r);
                        if (ok) { const unsigned bin = (unsigned)__builtin_amdgcn_fmed3f(__builtin_fmaf(scv[u2][i], inv, c0f), 0.f, (float)(IDX_NBIN - 1)); __hip_atomic_fetch_add(hrow + bin, 1u, __ATOMIC_RELAXED, __HIP_MEMORY_SCOPE_WORKGROUP); }
                    }
                } else {
#pragma unroll
                    for (int i = 0; i < 16; ++i) { const unsigned bin = (unsigned)__builtin_amdgcn_fmed3f(__builtin_fmaf(scv[u2][i], inv, c0f), 0.f, (float)(IDX_NBIN - 1)); __hip_atomic_fetch_add(hrow + bin, 1u, __ATOMIC_RELAXED, __HIP_MEMORY_SCOPE_WORKGROUP); }
                }
            }
#if PROBE_REP >= 40 && PROBE_REP < 60
            IPTS(td); accP += td - tc;
#endif
        }
    }
    IPTS(tx1);
    __syncthreads();
    IPTS(tx2);
#pragma unroll 1
    for (int k = 0; k < 4; ++k) {
        const int row = 4 * wave + k;
        const LAS unsigned* hr = (const LAS unsigned*)(L + IDX_HIST) + row * IDX_HP + 4 * lane;
        const int c0 = (int)hr[0], c1 = (int)hr[1], c2 = (int)hr[2], c3 = (int)hr[3];
        const int SL = suffix_sum((c0 + c1) + (c2 + c3), lane), NT = __builtin_amdgcn_readlane(SL, 0);
        int bstar = -1, need = 0;
        if (NT > 256) {
            const unsigned long long ml = __ballot(SL >= 256); const int lL = 63 - __builtin_clzll(ml); const int sl = __builtin_amdgcn_readlane(SL, lL);
            const int t0 = __builtin_amdgcn_readlane(c0, lL), t1 = __builtin_amdgcn_readlane(c1, lL), t2 = __builtin_amdgcn_readlane(c2, lL), t3 = __builtin_amdgcn_readlane(c3, lL);
            int above = sl - ((t0 + t1) + (t2 + t3));
            if (above + t3 >= 256) bstar = 4 * lL + 3;
            else { above += t3; if (above + t2 >= 256) bstar = 4 * lL + 2; else { above += t2; if (above + t1 >= 256) bstar = 4 * lL + 1; else { above += t1; bstar = 4 * lL; } } }
            need = 256 - above;
        }
        if (lane == 0) { ((LAS int*)(L + IDX_INFO))[row * 2] = bstar; ((LAS int*)(L + IDX_INFO))[row * 2 + 1] = need; }
    }
    __syncthreads();
    float lo_f, hi_f;
    { const int bstar = ((LAS int*)(L + IDX_INFO))[r * 2];
      hi_f = bstar < 0 ? -__builtin_inff() : (bstar >= IDX_NBIN - 1 ? __builtin_inff() : (float)(bstar + 1));
      lo_f = bstar <= 0 ? -__builtin_inff() : (float)bstar; }
    const float hi_raw = idx_raw_edge(hi_f, inv, c0f), lo_raw = idx_raw_edge(lo_f, inv, c0f);
    const float lo_base = fmaxf(lo_f, 0.f);
    auto append = [&](float sv, int kb, int ci) {
        const unsigned slot = __hip_atomic_fetch_add((LAS unsigned*)(L + IDX_CCNT) + r, 1u, __ATOMIC_RELAXED, __HIP_MEMORY_SCOPE_WORKGROUP);
        if (slot < IDX_CAP) { const float fr = (__builtin_fmaf(sv, inv, c0f) - lo_base) * 131072.0f; const unsigned q = (unsigned)__builtin_amdgcn_fmed3f(fr, 0.f, 131071.0f);
            asm volatile("" : "+v"(kb));
            ((LAS unsigned*)(L + IDX_CAND))[r * IDX_CAP + slot] = (q << 15) | (unsigned)(kb - ci); } };
    {
#pragma unroll 1
        for (int ks = NSUB * wave; ks <= g; ks += 8 * NSUB) {
            const unsigned char* nextp[NSUB];
#pragma unroll
            for (int u = 0; u < NSUB; ++u) nextp[u] = krow((ks + 8 * NSUB <= g ? ks + 8 * NSUB : NSUB * wave) + u);
#if PROBE_REP >= 40 && PROBE_REP < 60
            unsigned tb, tc, td; IPTS(tb);
#endif
            f32x16 scv[NSUB]; __builtin_amdgcn_s_setprio(1); idx_scoresN<NSUB>(qf, w, kf, nextp, h, scv); __builtin_amdgcn_s_setprio(0);
#if PROBE_REP >= 40 && PROBE_REP < 60
            IDX_PIN(scv[NSUB - 1]); IPTS(tc); accS += tc - tb;
#endif
#pragma unroll
            for (int u2 = 0; u2 < NSUB; ++u2) {
                const int kss = ks + u2; if (kss > g) continue;
                unsigned part = 0u;
                if (kss == 0 || kss == g) {
#pragma unroll
                    for (int i = 0; i < 16; ++i) {
                        const int kidx = crow(i, h);
                        const bool ok = qvalid && (kss == 0 ? kidx < NMETA && (g > 0 || kidx <= r) : kidx <= r);
                        const bool ghi = scv[u2][i] >= hi_raw, glo = scv[u2][i] >= lo_raw;
                        part |= (ok && ghi) ? (1u << kidx) : 0u;
                        if (ok && glo && !ghi) append(scv[u2][i], 32767 - kss * 32 - 4 * h, (i & 3) + 8 * (i >> 2));
                    }
                } else {
                    unsigned mhi = 0u, mlo = 0u;
#pragma unroll
                    for (int i = 15; i >= 0; --i) { IDX_ACCBIT(mhi, scv[u2][i], hi_raw); IDX_ACCBIT(mlo, scv[u2][i], lo_raw); }
                    part = ((mhi & 0xFu) | ((mhi & 0xF0u) << 4) | ((mhi & 0xF00u) << 8) | ((mhi & 0xF000u) << 12)) << (4 * h);
                    const unsigned cm = mlo & ~mhi;
                    if (__ballot(cm != 0u) != 0ull) {
#pragma unroll
                        for (int i = 0; i < 16; ++i) if (cm & (1u << i)) append(scv[u2][i], 32767 - kss * 32 - 4 * h, (i & 3) + 8 * (i >> 2));
                    }
                }
                __hip_atomic_fetch_or((LAS unsigned*)(L + IDX_MASK) + kss * 32 + r, part, __ATOMIC_RELAXED, __HIP_MEMORY_SCOPE_WORKGROUP);
            }
#if PROBE_REP >= 40 && PROBE_REP < 60
            IPTS(td); accP2 += td - tc;
#endif
        }
    }
    IPTS(tx3);
    __syncthreads();
    IPTS(tx4);
    __builtin_amdgcn_s_setprio(0);
#pragma unroll 1
    for (int k = 0; k < 4; ++k) {
        const int row = 4 * wave + k;
        const int need = ((LAS int*)(L + IDX_INFO))[row * 2 + 1];
        int nc = (int)((LAS unsigned*)(L + IDX_CCNT))[row]; nc = nc < IDX_CAP ? nc : IDX_CAP;
        nc = __builtin_amdgcn_readfirstlane(nc);
#if PROBE_REP == 48
        accNC += (unsigned)nc; accNR += 128u;
#endif
        if (nc == 0) continue;
        const LAS unsigned* cb = (const LAS unsigned*)(L + IDX_CAND) + row * IDX_CAP;
        const bool v0 = lane < nc, v1 = lane + 64 < nc;
        const unsigned c0 = v0 ? cb[lane] : 0u, c1 = v1 ? cb[lane + 64] : 0u;
        int r0 = 0, r1 = 0;
        if (__builtin_amdgcn_readfirstlane(need) < nc) {
            const int n0 = nc < 64 ? nc : 64;
#pragma unroll 1
            for (int j = 0; j < n0; ++j) { const unsigned cj = (unsigned)__builtin_amdgcn_readlane((int)c0, j); r0 += cj > c0 ? 1 : 0; r1 += cj > c1 ? 1 : 0; }
#pragma unroll 1
            for (int j = 64; j < nc; ++j) { const unsigned cj = (unsigned)__builtin_amdgcn_readlane((int)c1, j - 64); r0 += cj > c0 ? 1 : 0; r1 += cj > c1 ? 1 : 0; }
        }
        const int k0 = 32767 - (int)(c0 & 32767u), k1 = 32767 - (int)(c1 & 32767u);
        if (v0 && r0 < need) __hip_atomic_fetch_or((LAS unsigned*)(L + IDX_MASK) + (k0 >> 5) * 32 + row, 1u << (k0 & 31), __ATOMIC_RELAXED, __HIP_MEMORY_SCOPE_WORKGROUP);
        if (v1 && r1 < need) __hip_atomic_fetch_or((LAS unsigned*)(L + IDX_MASK) + (k1 >> 5) * 32 + row, 1u << (k1 & 31), __ATOMIC_RELAXED, __HIP_MEMORY_SCOPE_WORKGROUP);
    }
    IPTS(tx5);
    __syncthreads();
    IPTS(tx6);
    unsigned* MK = (unsigned*)(F.ws + WS_MASK) + (size_t)b * NKS * TLEN;
    for (int i = tid; i < (g + 1) * 32; i += NTHREADS) { const int ks = i >> 5, rr = i & 31; if (rr < nq) MK[(size_t)ks * TLEN + tq0 + rr] = ((LAS unsigned*)(L + IDX_MASK))[i]; }
#if PROBE_REP >= 40 && PROBE_REP < 60
    { unsigned tU1; IPTS(tU1); if (lane == 0) { unsigned long long* pc = (unsigned long long*)(F.ws + WS_CTL) + 4096;
        const unsigned vals[12] = {tx0 - tU0, accS, accP, tU1 - tU0, accP2, tx2 - tx1, tx4 - tx3, tU1 - tx4, accNC, tx5 - tx4, tx6 - tx5, tU1 - tx6};
        atomicAdd(pc + (PROBE_REP - 40), (unsigned long long)vals[PROBE_REP - 40]); atomicAdd(pc + 3, (unsigned long long)(PROBE_REP == 48 ? accNR : tU1 - tU0)); } }
#endif
}
__device__ __forceinline__ void mixA_index_phase(const Frame& F) {
#pragma unroll 1
    for (int c = F.bid; c < 256; c += F.G) {
#pragma unroll 1
        for (int k = 0; k < 5; ++k) {
            int u; if (k == 0) u = c; else if (k == 1) u = 511 - c; else if (k == 2) u = 512 + c; else if (k == 3) u = 1023 - c; else { if (c >= 2) break; u = 1024 + c; }
            mixA_index_unit(F, u & 1, 512 - (u >> 1));
        }
    }
}

__device__ __forceinline__ void mixA3_unit(const Frame& F, int l, int b, int ha, int qblk) {
    LAS unsigned char* L = F.lds + LDS_GEN;
    int lane_; { unsigned z0_ = 0u; asm volatile("" : "+s"(z0_)); lane_ = (int)__builtin_amdgcn_mbcnt_hi(~0u, __builtin_amdgcn_mbcnt_lo(~0u, z0_)); asm volatile("" : "+v"(lane_)); }
    const int lane = lane_, wave = F.wave, tid = wave * 64 + lane, r = lane & 31, h = lane >> 5;
    const unsigned char* proj = F.ws + WS_PROJ;
    const _Float16* QA = (const _Float16*)(proj + PJ_QA); const unsigned char* KA = proj + PJ_KA; const unsigned char* VA = proj + PJ_VA;
    const unsigned* kmax = (const unsigned*)(F.ws + WS_CTL) + CW_KMAX + 32 * l;
    const unsigned* MK = (const unsigned*)(F.ws + WS_MASK) + (size_t)b * NKS * TLEN;
    const bool meta_u = qblk < 0;
    const int qrow0 = meta_u ? MR + b * NMETA : b * SEQ + qblk * 256;
    const int qpos0 = meta_u ? 0 : NMETA + qblk * 256;
    const int nreal = meta_u ? 0 : 2 * qblk + 2;
    const int wq0 = 32 * wave;
    const bool wave_on = meta_u ? (wave == 0) : true;
    const int my_row = wave_on ? qrow0 + wq0 + r : qrow0, my_pos = wave_on ? qpos0 + wq0 + r : 0;
    __syncthreads();
    if (tid < 128) ((LAS float*)(L + B_LUT))[tid] = F.rel_bias[BUCKET_LUT[tid] * 12 + ha] * LOG2E;
    float bmax = (lane < 32) ? F.rel_bias[lane * 12 + ha] * LOG2E : -1e30f;
    bmax = fmaxf(bmax, sx<16>(bmax, lane)); bmax = fmaxf(bmax, sx<8>(bmax, lane)); bmax = fmaxf(bmax, sx<4>(bmax, lane)); bmax = fmaxf(bmax, sx<2>(bmax, lane)); bmax = fmaxf(bmax, sx<1>(bmax, lane));
    bmax = bcast0(bmax);
    const float bfar = F.rel_bias[31 * 12 + ha] * LOG2E;
    h8 qf[4]; float mref; bool safe;
    { float n2 = 0.f;
#pragma unroll
      for (int s = 0; s < 4; ++s) { qf[s] = *(const h8*)(QA + (size_t)my_row * 512 + ha * 64 + 16 * s + 8 * h);
#pragma unroll
          for (int j = 0; j < 8; ++j) { const float v = (float)qf[s][j]; n2 += v * v; } }
      n2 = hsum32(n2, lane);
      mref = sqrtf(n2 * (__uint_as_float(kmax[ha * 2]) + __uint_as_float(kmax[ha * 2 + 1]))) * 1.002f + bmax;
      safe = __all(mref - bfar < 60.0f); if (safe) mref = bfar; }
    f32x16 O[2], Lacc;
#if PROBE_REP >= 60 && PROBE_REP < 70
    unsigned a3C = 0, a3S = 0, a3W = 0, a3t0, a3t1, a3t2, a3t3, a3U0; PTS(a3U0);
#endif
#pragma unroll
    for (int i = 0; i < 16; ++i) { O[0][i] = 0.f; O[1][i] = 0.f; Lacc[i] = 0.f; }
    bf16x8v ones; { const u32x4 o = {0x3F803F80u, 0x3F803F80u, 0x3F803F80u, 0x3F803F80u}; ones = __builtin_bit_cast(bf16x8v, o); }
    const int skey = tid >> 3, sch = tid & 7;
    const unsigned kdst = skey * KS_PITCH + sch * 16, vdst = (sch >> 2) * (TK * 64) + skey * 64 + (sch & 3) * 16;
    const int ntiles = 1 + nreal;
    auto tile_row0 = [&](int t) -> int { return t == 0 ? MR + b * NMETA : b * SEQ + (t - 1) * TK; };
    u32x4 kreg[2], vreg[2];
#pragma unroll
    for (int j = 0; j < 2; ++j) { const size_t rr = (size_t)(tile_row0(0) + skey + 64 * j); kreg[j] = *(const u32x4*)(KA + rr * 1024 + ha * 128 + sch * 16); vreg[j] = *(const u32x4*)(VA + rr * 1024 + ha * 128 + sch * 16); }
#pragma unroll
    for (int j = 0; j < 2; ++j) { *(LAS u32x4*)(L + B_KS + kdst + j * 64 * KS_PITCH) = kreg[j]; *(LAS u32x4*)(L + B_VS + vdst + j * 64 * 64) = vreg[j]; }
    if (ntiles > 1) {
#pragma unroll
        for (int j = 0; j < 2; ++j) { const size_t rr = (size_t)(tile_row0(1) + skey + 64 * j); kreg[j] = *(const u32x4*)(KA + rr * 1024 + ha * 128 + sch * 16); vreg[j] = *(const u32x4*)(VA + rr * 1024 + ha * 128 + sch * 16); }
#pragma unroll
        for (int j = 0; j < 2; ++j) { *(LAS u32x4*)(L + B_KS + KBUF + kdst + j * 64 * KS_PITCH) = kreg[j]; *(LAS u32x4*)(L + B_VS + VBUF + vdst + j * 64 * 64) = vreg[j]; }
    }
    __syncthreads();
    unsigned mw[4], mwn[4] = {0u, 0u, 0u, 0u};
    mw[0] = MK[my_pos]; mw[1] = 0u; mw[2] = 0u; mw[3] = 0u;
    const int wpos0 = qpos0 + wq0;
    if (wave >= 4) __builtin_amdgcn_s_setprio(1);
#pragma unroll 1
    for (int t = 0; t < ntiles; ++t) {
        const int buf = t & 3;
        if (STAGGER > 0 && wave >= 4 && (t & 1) == 0) __builtin_amdgcn_s_sleep(STAGGER);
        if (t + 2 < ntiles) {
#pragma unroll
            for (int j = 0; j < 2; ++j) { const size_t rr = (size_t)(tile_row0(t + 2) + skey + 64 * j); kreg[j] = *(const u32x4*)(KA + rr * 1024 + ha * 128 + sch * 16); vreg[j] = *(const u32x4*)(VA + rr * 1024 + ha * 128 + sch * 16); } }
        if (t + 1 < ntiles) {
#pragma unroll
            for (int j = 0; j < 4; ++j) mwn[j] = MK[(size_t)(1 + 4 * t + j) * TLEN + my_pos]; }
        const int kpos0 = (t == 0) ? 0 : NMETA + (t - 1) * TK, nvalid = (t == 0) ? NMETA : TK;
#if PROBE_REP >= 60 && PROBE_REP < 70
        PTS(a3t0);
#endif
        if (wave_on && kpos0 <= wpos0 + 31) {
            LAS unsigned char* Kb = L + B_KS + buf * KBUF; LAS unsigned char* Vb = L + B_VS + buf * VBUF;
#pragma unroll
            for (int sub = 0; sub < 4; ++sub) {
                if (sub * 32 >= nvalid || kpos0 + sub * 32 > wpos0 + 31) continue;
                const bool slow = !safe || (t == 0) || (kpos0 + sub * 32 + 31 > wpos0 - 128);
                const unsigned mword = mw[sub] >> (4 * h);
                f32x16 S;
                h8 kfr[4]; bf16x8v vfr[2][2];
#pragma unroll
                for (int s = 0; s < 4; ++s) kfr[s] = *(const LAS h8*)(Kb + (sub * 32 + r) * KS_PITCH + (16 * s + 8 * h) * 2);
#pragma unroll
                for (int d = 0; d < 2; ++d)
#pragma unroll
                    for (int s = 0; s < 2; ++s) vfr[d][s] = vt_frag(Vb, d, sub * 32, s, lane);
                __builtin_amdgcn_sched_barrier(0);
#pragma unroll
                for (int i = 0; i < 16; ++i) S[i] = 0.f;
#pragma unroll
                for (int s = 0; s < 4; ++s) S = __builtin_amdgcn_mfma_f32_32x32x16_f16(kfr[s], qf[s], S, 0, 0, 0);
                bf16x8v pf[2];
                if (slow) {
                    float bs[16];
#pragma unroll
                    for (int i = 0; i < 16; ++i) { const int dist = my_pos - (kpos0 + sub * 32 + crow(i, h)); bs[i] = ((const LAS float*)(L + B_LUT))[min(max(dist, 0), 127)]; }
#pragma unroll
                    for (int i = 0; i < 16; ++i) {
                        const int kidx = sub * 32 + crow(i, h), dist = my_pos - (kpos0 + kidx);
                        const bool ok = ((mword >> ((i & 3) + 8 * (i >> 2))) & 1u) != 0u && dist >= 0 && kidx < nvalid;
                        const float e = __builtin_amdgcn_exp2f(fminf(S[i] + (bs[i] - mref), 80.f));
                        S[i] = ok ? e : 0.f;
                    }
                    pf[0] = pack_p(S, 0); pf[1] = pack_p(S, 1);
                } else {
#pragma unroll
                    for (int i = 0; i < 16; ++i) { unsigned sel; asm("v_bfe_i32 %0, %1, %2, 1" : "=v"(sel) : "v"(mword), "n"((i & 3) + 8 * (i >> 2)));
                        S[i] = __uint_as_float(__float_as_uint(__builtin_amdgcn_exp2f(S[i])) & sel); }
                    pf[0] = pack_p(S, 0); pf[1] = pack_p(S, 1);
                }
#pragma unroll
                for (int s = 0; s < 2; ++s) { Lacc = __builtin_amdgcn_mfma_f32_32x32x16_bf16(ones, pf[s], Lacc, 0, 0, 0);
#pragma unroll
                    for (int d = 0; d < 2; ++d) O[d] = __builtin_amdgcn_mfma_f32_32x32x16_bf16(vfr[d][s], pf[s], O[d], 0, 0, 0); }
            }
        }
#if PROBE_REP >= 60 && PROBE_REP < 70
        asm volatile("" : "+v"(O[0][0]), "+v"(O[1][0]), "+v"(Lacc[0])); PTS(a3t1);
#endif
        if (t + 2 < ntiles) {
#pragma unroll
            for (int j = 0; j < 2; ++j) { *(LAS u32x4*)(L + B_KS + (buf ^ 2) * KBUF + kdst + j * 64 * KS_PITCH) = kreg[j]; *(LAS u32x4*)(L + B_VS + (buf ^ 2) * VBUF + vdst + j * 64 * 64) = vreg[j]; } }
#pragma unroll
        for (int j = 0; j < 4; ++j) mw[j] = mwn[j];
#if PROBE_REP >= 60 && PROBE_REP < 70
        PTS(a3t2);
#endif
        if (t & 1) { if (STAGGER > 0 && wave < 4) __builtin_amdgcn_s_sleep(STAGGER); __syncthreads(); }
#if PROBE_REP >= 60 && PROBE_REP < 70
        PTS(a3t3); a3C += a3t1 - a3t0; a3S += a3t2 - a3t1; a3W += a3t3 - a3t2;
#endif
    }
#if PROBE_REP >= 60 && PROBE_REP < 70
    { unsigned a3U1; PTS(a3U1); if (lane == 0) { unsigned long long* pc = (unsigned long long*)(F.ws + WS_CTL) + 4096;
        const unsigned vals[4] = {a3C, a3S, a3W, a3U1 - a3U0};
        atomicAdd(pc + (PROBE_REP - 40), (unsigned long long)vals[PROBE_REP - 60]); atomicAdd(pc + 23, (unsigned long long)(a3U1 - a3U0)); } }
#endif
    __builtin_amdgcn_s_setprio(0);
    if (wave_on) {
        const float il = 1.0f / Lacc[0];
        if (!meta_u || r < NMETA) {
            _Float16* dst = (_Float16*)(F.ws + WS_ABUF) + (size_t)my_row * DM + ha * 64;
#pragma unroll
            for (int d = 0; d < 2; ++d)
#pragma unroll
                for (int g4 = 0; g4 < 4; ++g4) { const int d0 = 32 * d + 8 * g4 + 4 * h;
                    u32x2 w; w.x = cvt_pk_f16(O[d][4 * g4 + 0] * il, O[d][4 * g4 + 1] * il); w.y = cvt_pk_f16(O[d][4 * g4 + 2] * il, O[d][4 * g4 + 3] * il);
                    *(u32x2*)(dst + d0) = w; }
        }
    }
}
__device__ __forceinline__ void mixA3_phase(const Frame& F, int l) {
#pragma unroll 1
    for (int c = F.bid; c < 256; c += F.G) { const int bh = c & 15, i1 = c >> 4, i2 = 31 - i1;
#pragma unroll 1
        for (int k = 0; k < 5; ++k) { if (k == 4 && c >= 16) break;
            const int qb = k == 0 ? 63 - i1 : (k == 1 ? 32 + i1 : (k == 2 ? i2 : (k == 3 ? i1 : -1)));
            mixA3_unit(F, l, bh >> 3, bh & 7, qb); }
    }
}
constexpr int NPHASES = 19;
__global__ void __launch_bounds__(NTHREADS, 2) fwd(Args args) {
    extern __shared__ __attribute__((aligned(16))) unsigned char lds_raw[];
    Frame F;
    F.x = args.in[0]; F.meta = args.in[1]; F.rel_bias = args.in[2]; F.w_in = args.in[3]; F.norm_mix = args.in[4]; F.diff_lambda = args.in[5]; F.diff_norm = args.in[6];
    F.ret_norm = args.in[7]; F.w_out = args.in[8]; F.norm_ff = args.in[9]; F.w_ff1 = args.in[10]; F.w_ff2 = args.in[11]; F.final_norm = args.in[12];
    F.out = args.out; F.ws = args.ws; F.lds = (LAS unsigned char*)lds_raw;
    F.bid = blockIdx.x; F.G = gridDim.x; F.tid = threadIdx.x; F.lane = F.tid & 63; F.wave = __builtin_amdgcn_readfirstlane(F.tid >> 6);
    if (F.tid < 64) ((LAS unsigned*)(F.lds + LDS_MISC))[F.tid] = 0u;
    __syncthreads();
    unsigned* ctl = (unsigned*)(F.ws + WS_CTL);
    XcdBarrier bar = xcd_barrier_post(ctl + CW_BAR, (volatile LAS unsigned*)(F.lds + LDS_MISC));
    const int lo = args.ph_lo, hi = args.ph_hi;
#define IN(k) (lo <= (k) && (k) < hi)
#ifndef PROBE_REP
#define PROBE_REP 0
#endif
#define RETID() do { unsigned z0_ = 0u; asm volatile("" : "+s"(z0_)); int t_ = (int)__builtin_amdgcn_mbcnt_hi(~0u, __builtin_amdgcn_mbcnt_lo(~0u, z0_)); asm volatile("" : "+v"(t_)); F.lane = t_; F.tid = F.wave * 64 + t_; } while (0)
#define REP(k) _Pragma("unroll 1") for (int rep_ = 0; rep_ < ((PROBE_REP == (k)) ? 2 : 1); ++rep_)
#define SEAM(k) do { if (IN(k) && IN((k) + 1)) xcd_barrier(bar, F.wave == 0 && F.lane == 0); } while (0)
    LAS unsigned char* stage = F.lds + LDS_GEN;
    if (IN(0)) { REP(10) prologue(F); SEAM(0);
#if PROBE_REP == 20
        for (int xb = 0; xb < 20; ++xb) xcd_barrier(bar, F.wave == 0 && F.lane == 0);
#endif
    }
#pragma unroll 1
    for (int l = 0; l < DEPTH; ++l) {
        const int pb = 1 + 9 * l;
        { RETID();
          size_t z_ = 0; int b_ = blockIdx.x, g_ = gridDim.x; asm volatile("" : "+s"(z_), "+s"(b_), "+s"(g_)); F.ws = args.ws + z_; F.out = args.out + z_; F.bid = b_; F.G = g_; }
        unsigned char* wl = F.ws + WS_W + (size_t)l * W_LAYER;
        unsigned char* proj = F.ws + WS_PROJ;
        if (IN(pb + 0)) {
            pg8::Gemm g{(const pg8::bf16_t*)(F.ws + WS_ABUF), (const pg8::bf16_t*)(wl + W_IN_OFF), MP, NPAD, DM}; pg8::StaticOrder S; S.init(MP, NPAD, F.G, F.bid);
            EpiInProj E{proj, (const f32x2*)(F.ws + WS_ROPE), ctl + CW_KMAX + 32 * l};
            pg8::gemm_phase<EpiInProj, pg8::StaticOrder, true, true>(stage, g, S, E, F.tid);
#if PROBE_REP == 7
            RETID(); pg8::gemm_phase<EpiInProj, pg8::StaticOrder, true, true>(stage, g, S, E, F.tid);
#endif
            SEAM(pb + 0);
        }
        if (IN(pb + 1)) { RETID(); REP(1) mixA_index_phase(F); RETID(); REP(2) mixC1_phase(F); SEAM(pb + 1); }
        if (IN(pb + 2)) { RETID(); REP(3) mixC_scan(F); RETID(); REP(4) mixB_phase(F, l); SEAM(pb + 2); }
        if (IN(pb + 3)) { RETID(); REP(5) mixA3_phase(F, l); RETID(); REP(6) mixC2_phase(F, l); SEAM(pb + 3); }
        if (IN(pb + 4)) { RETID();
            skinny_meta<0>(F, wl); RETID();
            pg8::Gemm g{(const pg8::bf16_t*)(F.ws + WS_ABUF), (const pg8::bf16_t*)(wl + W_OUT_OFF), MR, DM, DM}; pg8::StaticOrder S; S.init(MR, DM, F.G, F.bid);
            EpiRes E{l == 0 ? F.x : F.out, F.out, (float*)(F.ws + WS_HMETA)};
            pg8::gemm_phase<EpiRes, pg8::StaticOrder, true, true>(stage, g, S, E, F.tid);
            SEAM(pb + 4);
        }
        if (IN(pb + 5)) { RETID(); zero_scr(F); REP(8) norm_to_abuf<1>(F, F.norm_ff + (size_t)l * DM); SEAM(pb + 5); }
        if (IN(pb + 6)) { RETID();
            skinny_meta<1>(F, wl); RETID();
            pg8::Gemm g{(const pg8::bf16_t*)(F.ws + WS_ABUF), (const pg8::bf16_t*)(wl + W_FF1_OFF), MR, DFF, DM}; pg8::StaticOrder S; S.init(MR, DFF, F.G, F.bid);
            EpiRelu2 E{proj};
            pg8::gemm_phase<EpiRelu2, pg8::StaticOrder, true, true>(stage, g, S, E, F.tid);
#if PROBE_REP == 9
            RETID(); pg8::gemm_phase<EpiRelu2, pg8::StaticOrder, true, true>(stage, g, S, E, F.tid);
#endif
            SEAM(pb + 6);
        }
        if (IN(pb + 7)) { RETID();
            skinny_meta<2>(F, wl); RETID();
            pg8::Gemm g{(const pg8::bf16_t*)proj, (const pg8::bf16_t*)(wl + W_FF2_OFF), MR, DM, DFF}; pg8::StaticOrder S; S.init(MR, DM, F.G, F.bid);
            EpiRes E{F.out, F.out, (float*)(F.ws + WS_HMETA)};
#if PROBE_REP == 14
            { EpiRes E2{F.out, (float*)(F.ws + WS_ABUF), (float*)(F.ws + WS_U)}; pg8::gemm_phase<EpiRes, pg8::StaticOrder, true, true>(stage, g, S, E2, F.tid); RETID(); }
#endif
            pg8::gemm_phase<EpiRes, pg8::StaticOrder, true, true>(stage, g, S, E, F.tid);
            SEAM(pb + 7);
        }
        if (IN(pb + 8)) { RETID();
            if (l + 1 < DEPTH) { norm_to_abuf<1>(F, F.norm_mix + (size_t)(l + 1) * DM); SEAM(pb + 8); }
            else final_norm(F);
        }
    }
#if PROBE_REP >= 40
    RETID(); if (blockIdx.x == 0 && F.tid == 0) {
        const unsigned long long* pc = (const unsigned long long*)(args.ws + WS_CTL) + 4096;
        const unsigned long long vx = __hip_atomic_load(pc + (PROBE_REP - 40), __ATOMIC_RELAXED, __HIP_MEMORY_SCOPE_AGENT), vt = __hip_atomic_load(pc + (PROBE_REP < 60 ? 3 : (PROBE_REP < 70 ? 23 : 33)), __ATOMIC_RELAXED, __HIP_MEMORY_SCOPE_AGENT);
        const unsigned long long ticks = (unsigned long long)((float)vx / (float)vt * 1.0e6f);
        const unsigned long long t0 = __builtin_amdgcn_s_memrealtime();
        while (__builtin_amdgcn_s_memrealtime() - t0 < ticks) __builtin_amdgcn_s_sleep(16);
    }
#endif
#undef IN
#undef SEAM
}

#ifndef MK_SPLIT
#define MK_SPLIT 0
#endif
extern "C" void kernel_launch(void* const* d_in, const int* in_sizes, int n_in, void* d_out, int out_size, void* d_ws, size_t ws_size, hipStream_t stream) {
    static int grid = 0;
    if (grid == 0) {
        if (n_in != 13 || ws_size < WS_END) { fprintf(stderr, "kernel_launch: need 13 inputs and %zu bytes of workspace; got %d, %zu\n", (size_t)WS_END, n_in, ws_size); grid = -1; return; }
        int dev = 0, cus = 0, per_cu = 0;
        if (hipGetDevice(&dev) != hipSuccess || hipDeviceGetAttribute(&cus, hipDeviceAttributeMultiprocessorCount, dev) != hipSuccess) { grid = -1; return; }
        if (hipFuncSetAttribute((const void*)fwd, hipFuncAttributeMaxDynamicSharedMemorySize, LDS_BYTES) != hipSuccess) { fprintf(stderr, "kernel_launch: hipFuncSetAttribute failed\n"); grid = -1; return; }
        if (hipOccupancyMaxActiveBlocksPerMultiprocessor(&per_cu, (const void*)fwd, NTHREADS, LDS_BYTES) != hipSuccess || per_cu < 1) { fprintf(stderr, "kernel_launch: occupancy query says %d\n", per_cu); }
        (void)hipGetLastError();
        grid = cus;
    }
    if (grid < 0) return;
    (void)hipMemsetAsync((char*)d_ws + WS_CTL, 0, CTL_BYTES, stream);
    Args a{};
    for (int i = 0; i < 13; ++i) a.in[i] = (const float*)d_in[i];
    a.out = (float*)d_out; a.ws = (unsigned char*)d_ws;
#if MK_SPLIT
    for (int p = 0; p < NPHASES; ++p) { a.ph_lo = p; a.ph_hi = p + 1; hipLaunchKernelGGL(fwd, dim3(grid), dim3(NTHREADS), LDS_BYTES, stream, a); }
#else
    a.ph_lo = 0; a.ph_hi = NPHASES; hipLaunchKernelGGL(fwd, dim3(grid), dim3(NTHREADS), LDS_BYTES, stream, a);
#endif
}
```

```cpp
#include <hip/hip_runtime.h>
#include <cstdio>
#include <cstdint>
typedef _Float16 h8 __attribute__((ext_vector_type(8)));
typedef _Float16 h4 __attribute__((ext_vector_type(4)));
typedef _Float16 h2 __attribute__((ext_vector_type(2)));
typedef short s16x8 __attribute__((ext_vector_type(8)));
typedef short s16x4 __attribute__((ext_vector_type(4)));
typedef float f32x16 __attribute__((ext_vector_type(16)));
typedef float f32x2 __attribute__((ext_vector_type(2)));
typedef unsigned u32x2 __attribute__((ext_vector_type(2)));
namespace pg8 {
#define PG8_LAS __attribute__((address_space(3)))
typedef unsigned short bf16_t;
typedef short bf16x8 __attribute__((ext_vector_type(8)));
typedef float f32x4 __attribute__((ext_vector_type(4)));
typedef unsigned u32x4 __attribute__((ext_vector_type(4)));
constexpr int BM = 256, BK = 64, HALF = 128, HTB = HALF * BK * 2  , STAGE_BYTES = 8 * HTB, NXCD = 8, WGM = 8;

__host__ __device__ __forceinline__ int lds_byte(int r, int c) { const int st = (r >> 4) * 2 + (c >> 5), rr = r & 15, cc = c & 31, ob = rr * 64 + cc * 2; return st * 1024 + (ob ^ (((ob >> 9) & 1) << 5)); }
__host__ __device__ __forceinline__ void stage_rc(int b, int& R, int& C) { const int st = b / 1024, sb = b % 1024, swz = sb ^ (((sb >> 9) & 1) << 5); R = (st >> 1) * 16 + swz / 64; C = (st & 1) * 32 + (swz % 64) / 2; }
__host__ __device__ __forceinline__ int perm32(int rho) { const int n = rho >> 4, i = rho & 15; return 8 * (i >> 2) + 4 * n + (i & 3); }

struct Unit { int pm, pn; };
struct Gemm { const bf16_t* A; const bf16_t* Bt; int M, N, K; };

struct StaticOrder {
    int nM, nN, nwg, G, c;
    __host__ __device__ void init(int M, int N, int G_, int c_) { nM = M / BM; nN = N / BM; nwg = nM * nN; G = G_; c = c_; }
    __host__ __device__ bool next(int i, Unit& u) const {
        const long L = (long)i * G + c; if (L >= nwg) return false;
        int wgid = (int)L; { const int q = nwg / NXCD, r = nwg % NXCD, xcd = wgid % NXCD, off = wgid / NXCD; wgid = (xcd < r ? xcd * (q + 1) : r * (q + 1) + (xcd - r) * q) + off; }
        const int nig = WGM * nN, gid = wgid / nig, fm = gid * WGM, gsz = (nM - fm) < WGM ? (nM - fm) : WGM;
        u.pm = fm + ((wgid % nig) % gsz); u.pn = (wgid % nig) / gsz; return true;
    }
    __device__ __forceinline__ void a_ready(const Unit&) const {}
    __device__ __forceinline__ void done(const Unit&) const {}
};

template <class Epi, class Sched, bool ALIGN_EPI = false, bool SP2 = false>
__device__ __forceinline__ void gemm_phase(PG8_LAS unsigned char* lds, const Gemm g, const Sched& S, const Epi& E, int tid_in) {
    int tid_ = tid_in; asm volatile("" : "+v"(tid_));
    const int tid = tid_, wid = __builtin_amdgcn_readfirstlane(tid >> 6), lane = tid & 63, wr = wid >> 2, wc = wid & 3, fr = lane & 15, fq = lane >> 4;
    const int K = g.K, nt = K / BK;
    unsigned voffA[2], voffB[2];
#pragma unroll
    for (int i = 0; i < 2; ++i) { int R, C; stage_rc(tid * 16 + i * 8192, R, C); const int Rb = Epi::PERM ? ((R & ~31) + perm32(R & 31)) : R;
        voffA[i] = (unsigned)(R * K + C) * 2u; voffB[i] = (unsigned)(Rb * K + C) * 2u; }
    const size_t kstep = (size_t)(BK * 2);
    const size_t hstep = (size_t)HALF * K * 2;
    const size_t tstep = 2 * hstep;
    const unsigned ldsw = (unsigned)wid * 1024u;
    const int aoff = lds_byte(wr * 64 + fr, fq * 8), boff = lds_byte(wc * 32 + fr, fq * 8);
#define PG8_SA(b, h) (((b) * 2 + (h)) * HTB)
#define PG8_SB(b, h) ((4 + (b) * 2 + (h)) * HTB)
#define PG8_STAGE(bufoff, gbase, voff) do { _Pragma("unroll") for (int _i = 0; _i < 2; ++_i) \
        __builtin_amdgcn_global_load_lds((const unsigned*)((const char*)(gbase) + (voff)[_i]), (PG8_LAS unsigned*)(lds + (bufoff) + ldsw + _i * 8192), 16, 0, 0); } while (0)
#define PG8_LDA(dst, b, h) do { _Pragma("unroll") for (int m = 0; m < 4; ++m) _Pragma("unroll") for (int k = 0; k < 2; ++k) dst[m][k] = *(const PG8_LAS bf16x8*)(lds + PG8_SA(b, h) + aoff + m * 2048 + k * 1024); } while (0)
#define PG8_LDB(dst, b, h) do { _Pragma("unroll") for (int n = 0; n < 2; ++n) _Pragma("unroll") for (int k = 0; k < 2; ++k) dst[n][k] = *(const PG8_LAS bf16x8*)(lds + PG8_SB(b, h) + boff + n * 2048 + k * 1024); } while (0)
#define PG8_MMA(ai, bj, At, Bt) do { __builtin_amdgcn_s_setprio(1); _Pragma("unroll") for (int m = 0; m < 4; ++m) _Pragma("unroll") for (int n = 0; n < 2; ++n) _Pragma("unroll") for (int k = 0; k < 2; ++k) \
        acc[ai][bj][m][n] = __builtin_amdgcn_mfma_f32_16x16x32_f16(__builtin_bit_cast(h8, Bt[n][k]), __builtin_bit_cast(h8, At[m][k]), acc[ai][bj][m][n], 0, 0, 0); __builtin_amdgcn_s_setprio(0); } while (0)
#define PG8_WAIT_V(n) asm volatile("s_waitcnt vmcnt(" #n ")" ::: "memory")
#define PG8_WAIT_L(n) asm volatile("s_waitcnt lgkmcnt(" #n ")" ::: "memory")
#define PG8_BAR __builtin_amdgcn_s_barrier()
#define PG8_SCHED __builtin_amdgcn_sched_barrier(0)
    Unit cur, nxt; int ui = 0;
    if (!S.next(0, cur)) return;
    f32x4 acc[2][2][4][2];
#pragma unroll
    for (int a = 0; a < 2; ++a)
#pragma unroll
        for (int b = 0; b < 2; ++b)
#pragma unroll
            for (int m = 0; m < 4; ++m)
#pragma unroll
                for (int n = 0; n < 2; ++n) acc[a][b][m][n] = (f32x4){0.f, 0.f, 0.f, 0.f};
    bf16x8 At[4][2], B0[2][2], B1[2][2];
    const char* cA = (const char*)g.A + (size_t)cur.pm * tstep; const char* cB = (const char*)g.Bt + (size_t)cur.pn * tstep;
    S.a_ready(cur);
    if constexpr (SP2) {
        PG8_STAGE(PG8_SB(0, 0), cB, voffB); PG8_STAGE(PG8_SB(0, 1), cB + hstep, voffB); PG8_STAGE(PG8_SA(0, 0), cA, voffA); PG8_STAGE(PG8_SA(0, 1), cA + hstep, voffA);
        if (wr == 1) PG8_BAR;
        PG8_WAIT_V(2); PG8_BAR;
        PG8_STAGE(PG8_SB(1, 0), cB + kstep, voffB); PG8_STAGE(PG8_SA(1, 0), cA + kstep, voffA); PG8_STAGE(PG8_SB(1, 1), cB + hstep + kstep, voffB);
        PG8_WAIT_V(6); PG8_BAR;
    } else {
        PG8_STAGE(PG8_SB(0, 0), cB, voffB); PG8_STAGE(PG8_SA(0, 0), cA, voffA); PG8_STAGE(PG8_SB(0, 1), cB + hstep, voffB); PG8_STAGE(PG8_SA(0, 1), cA + hstep, voffA);
        if (wr == 1) PG8_BAR;
        PG8_WAIT_V(4); PG8_BAR;
        PG8_STAGE(PG8_SB(1, 0), cB + kstep, voffB); PG8_STAGE(PG8_SA(1, 0), cA + kstep, voffA); PG8_STAGE(PG8_SB(1, 1), cB + hstep + kstep, voffB);
        PG8_WAIT_V(6); PG8_BAR;
    }
    for (;;) {
        const bool has_next = S.next(ui + 1, nxt);
        const char* nA = has_next ? (const char*)g.A + (size_t)nxt.pm * tstep : cA; const char* nB = has_next ? (const char*)g.Bt + (size_t)nxt.pn * tstep : cB;
        for (int t = 0; t < nt; t += 2) {
            const bool last = (t == nt - 2);
            const char* a1 = cA + (size_t)(t + 1) * kstep;
            const char* a2 = last ? nA : cA + (size_t)(t + 2) * kstep; const char* b2 = last ? nB : cB + (size_t)(t + 2) * kstep;
            const char* a3 = a2 + kstep; const char* b3 = b2 + kstep;
            if (last && has_next) S.a_ready(nxt);
            if constexpr (SP2) {
            PG8_LDB(B0, 0, 0); PG8_LDB(B1, 0, 1); PG8_SCHED; PG8_LDA(At, 0, 0); PG8_STAGE(PG8_SA(1, 1), a1 + hstep, voffA);
            PG8_WAIT_V(8); PG8_WAIT_L(0); PG8_BAR; PG8_MMA(0, 0, At, B0); PG8_MMA(0, 1, At, B1); PG8_BAR; PG8_SCHED;
            PG8_LDA(At, 0, 1); PG8_STAGE(PG8_SB(0, 0), b2, voffB); PG8_STAGE(PG8_SB(0, 1), b2 + hstep, voffB); PG8_STAGE(PG8_SA(0, 0), a2, voffA);
            PG8_WAIT_V(8); PG8_WAIT_L(0); PG8_BAR; PG8_MMA(1, 0, At, B0); PG8_MMA(1, 1, At, B1); PG8_BAR; PG8_SCHED;
            PG8_LDB(B0, 1, 0); PG8_LDB(B1, 1, 1); PG8_SCHED; PG8_LDA(At, 1, 0); PG8_STAGE(PG8_SA(0, 1), a2 + hstep, voffA);
            PG8_WAIT_V(8); PG8_WAIT_L(0); PG8_BAR; PG8_MMA(0, 0, At, B0); PG8_MMA(0, 1, At, B1); PG8_BAR; PG8_SCHED;
            PG8_LDA(At, 1, 1); PG8_STAGE(PG8_SB(1, 0), b3, voffB); PG8_STAGE(PG8_SB(1, 1), b3 + hstep, voffB); PG8_STAGE(PG8_SA(1, 0), a3, voffA);
            PG8_WAIT_V(8); PG8_WAIT_L(0); PG8_BAR; PG8_MMA(1, 0, At, B0); PG8_MMA(1, 1, At, B1); PG8_BAR; PG8_SCHED;
            } else {
            PG8_LDB(B0, 0, 0); PG8_SCHED; PG8_LDA(At, 0, 0); PG8_STAGE(PG8_SA(1, 1), a1 + hstep, voffA);
            PG8_WAIT_L(8); PG8_BAR; PG8_WAIT_L(0); PG8_MMA(0, 0, At, B0); PG8_BAR; PG8_SCHED;
            PG8_LDB(B1, 0, 1); PG8_STAGE(PG8_SB(0, 0), b2, voffB);
            PG8_BAR; PG8_WAIT_L(0); PG8_MMA(0, 1, At, B1); PG8_BAR;
            PG8_LDA(At, 0, 1); PG8_STAGE(PG8_SA(0, 0), a2, voffA);
            PG8_BAR; PG8_WAIT_L(0); PG8_MMA(1, 0, At, B0); PG8_BAR; PG8_SCHED;
            PG8_STAGE(PG8_SB(0, 1), b2 + hstep, voffB);
            PG8_WAIT_V(6); PG8_BAR; PG8_MMA(1, 1, At, B1); PG8_BAR;
            PG8_LDB(B0, 1, 0); PG8_SCHED; PG8_LDA(At, 1, 0); PG8_STAGE(PG8_SA(0, 1), a2 + hstep, voffA);
            PG8_WAIT_L(8); PG8_BAR; PG8_WAIT_L(0); PG8_MMA(0, 0, At, B0); PG8_BAR; PG8_SCHED;
            PG8_LDB(B1, 1, 1); PG8_STAGE(PG8_SB(1, 0), b3, voffB);
            PG8_BAR; PG8_WAIT_L(0); PG8_MMA(0, 1, At, B1); PG8_BAR;
            PG8_LDA(At, 1, 1); PG8_STAGE(PG8_SA(1, 0), a3, voffA);
            PG8_BAR; PG8_WAIT_L(0); PG8_MMA(1, 0, At, B0); PG8_BAR; PG8_SCHED;
            PG8_STAGE(PG8_SB(1, 1), b3 + hstep, voffB);
            PG8_WAIT_V(6); PG8_BAR; PG8_MMA(1, 1, At, B1); PG8_BAR;
            }
        }
        if constexpr (ALIGN_EPI) { if (wr == 0) PG8_BAR; }
        if constexpr (!Epi::AFTER_DRAIN) { E(acc, cur, wr, wc, fr, fq); S.done(cur); }
        if (!has_next) break;
#pragma unroll
        for (int a = 0; a < 2; ++a)
#pragma unroll
            for (int b = 0; b < 2; ++b)
#pragma unroll
                for (int m = 0; m < 4; ++m)
#pragma unroll
                    for (int n = 0; n < 2; ++n) acc[a][b][m][n] = (f32x4){0.f, 0.f, 0.f, 0.f};
        cur = nxt; cA = nA; cB = nB; ++ui;
        if constexpr (ALIGN_EPI) { if (wr == 1) PG8_BAR; }
    }
    PG8_WAIT_V(0);
    if constexpr (!ALIGN_EPI) { if (wr == 0) PG8_BAR; }
    PG8_BAR;
    if constexpr (Epi::AFTER_DRAIN) { E.fused(acc, cur, wr, wc, fr, fq, lds, wid, lane); S.done(cur); }
#undef PG8_SA
#undef PG8_SB
#undef PG8_STAGE
#undef PG8_LDA
#undef PG8_LDB
#undef PG8_MMA
#undef PG8_WAIT_V
#undef PG8_WAIT_L
#undef PG8_BAR
#undef PG8_SCHED
}
}

#define XB_TMO      128
#define XB_XCNT(j)  (256  + 64 * (j))
#define XB_XSUB(j)  (1280 + 64 * (j))
#define XB_XGEN(j)  (2304 + 64 * (j))
#define XB_TOP      3328
#define XB_TOPGEN   3392
#define XCD_BAR_WORDS 3456
#define XB_SPIN_CAP (1u << 18)
#define LAS __attribute__((address_space(3)))

__device__ __forceinline__ unsigned xb_ld(unsigned* p)              { return __hip_atomic_load(p, __ATOMIC_RELAXED, __HIP_MEMORY_SCOPE_AGENT); }
__device__ __forceinline__ unsigned xb_add(unsigned* p, unsigned v) { return __hip_atomic_fetch_add(p, v, __ATOMIC_RELAXED, __HIP_MEMORY_SCOPE_AGENT); }
__device__ __forceinline__ unsigned xb_xcc_id() { return (unsigned)__builtin_amdgcn_s_getreg((3 << 11) | 20) & 0xFu; }
#define XB_SPIN(cond, bar) do { unsigned _sp = 0; while (cond) { __builtin_amdgcn_s_sleep(1); \
    if ((++_sp & 255u) == 0u) { if (xb_ld(&(bar)[XB_TMO])) break; if (_sp > XB_SPIN_CAP) { atomicAdd(&(bar)[XB_TMO], 1u); break; } } } } while (0)

struct XcdBarrier {
    unsigned* bar; unsigned x;
    volatile LAS unsigned* st;
};

__device__ __forceinline__ XcdBarrier xcd_barrier_post(unsigned* bar, volatile LAS unsigned* st) {
    XcdBarrier b; b.bar = bar; b.x = xb_xcc_id(); b.st = st;
    if (threadIdx.x == 0) (void)xb_add(&bar[XB_XCNT(b.x)], 1u);
    return b;
}
__device__ __forceinline__ void xcd_barrier_complete(unsigned* bar, unsigned x, unsigned& nloc, unsigned& nx) {
    const unsigned G = gridDim.x * gridDim.y * gridDim.z;
    unsigned sum, cnt, mine, sp = 0u;
    for (;;) {
        sum = 0u; cnt = 0u; mine = 0u;
#pragma unroll
        for (unsigned j = 0; j < 16; ++j) { const unsigned c = xb_ld(&bar[XB_XCNT(j)]); sum += c; cnt += (c > 0u) ? 1u : 0u; mine = (j == x) ? c : mine; }
        if (sum == G) break;
        __builtin_amdgcn_s_sleep(1);
        if ((++sp & 255u) == 0u) { if (xb_ld(&bar[XB_TMO])) break; if (sp > XB_SPIN_CAP) { atomicAdd(&bar[XB_TMO], 1u); break; } }
    }
    nloc = mine > 0u ? mine : 1u; nx = cnt > 0u ? cnt : 1u;
}

__device__ __forceinline__ void xcd_barrier(const XcdBarrier& b, const bool leader_thread) {
    asm volatile("s_waitcnt vmcnt(0)" ::: "memory");
    __syncthreads();
    if (leader_thread) {
        unsigned* bar = b.bar;
        __builtin_amdgcn_s_waitcnt(0);
        unsigned nloc = b.st[0], nx = b.st[1];
        if (nloc == 0u) { xcd_barrier_complete(bar, b.x, nloc, nx); b.st[0] = nloc; b.st[1] = nx; }
        const unsigned old = xb_add(&bar[XB_XSUB(b.x)], 1u);
        const unsigned gen = old / nloc;
        if (old + 1u == (gen + 1u) * nloc) {
            __builtin_amdgcn_fence(__ATOMIC_RELEASE, "agent");
            asm volatile("s_waitcnt vmcnt(0)" ::: "memory");
            const unsigned og = xb_add(&bar[XB_TOP], 1u);
            const unsigned tg = og / nx;
            if (og + 1u == (tg + 1u) * nx) xb_add(&bar[XB_TOPGEN], 1u);
            else XB_SPIN(xb_ld(&bar[XB_TOPGEN]) == tg, bar);
            __builtin_amdgcn_fence(__ATOMIC_ACQUIRE, "agent");
            xb_add(&bar[XB_XGEN(b.x)], 1u);
            asm volatile("s_waitcnt vmcnt(0)" ::: "memory");
        } else {
            XB_SPIN(xb_ld(&bar[XB_XGEN(b.x)]) == gen, bar);
            __builtin_amdgcn_fence(__ATOMIC_ACQUIRE, "agent");
            asm volatile("s_waitcnt vmcnt(0)" ::: "memory");
        }
    }
    __syncthreads();
}

constexpr int NB = 2, SEQ = 16384, TLEN = 16400, DM = 1024, NMETA = 16, DEPTH = 2;
constexpr int MR = NB * SEQ;
constexpr int MV = MR + NB * NMETA;
constexpr int MP = 33024;
constexpr int INCOLS = 3912, NPAD = 4096, DFF = 4096;
constexpr int NTHREADS = 512;
constexpr float LOG2E = 1.4426950408889634f;
constexpr float QA_SCALE = 0.125f * LOG2E;
constexpr float QB_SCALE = 0.17677669529663687f * LOG2E;
constexpr float WI_SCALE = 0.044194173824159216f;
constexpr int NKS = 513;

constexpr size_t al256(size_t x) { return (x + 255) & ~(size_t)255; }
constexpr size_t WS_CTL   = 0;
constexpr size_t CTL_BYTES = 65536;
constexpr size_t WS_HMETA = CTL_BYTES;
constexpr size_t WS_ROPE  = WS_HMETA + (size_t)256 * DM * 4;
constexpr size_t WS_W     = al256(WS_ROPE + (size_t)TLEN * 32 * 8);
constexpr size_t W_IN_OFF = 0, W_OUT_OFF = (size_t)NPAD * DM * 2, W_FF1_OFF = W_OUT_OFF + (size_t)DM * DM * 2,
                 W_FF2_OFF = W_FF1_OFF + (size_t)DFF * DM * 2, W_LAYER = W_FF2_OFF + (size_t)DM * DFF * 2;
constexpr size_t WS_ABUF  = al256(WS_W + DEPTH * W_LAYER);
constexpr size_t WS_MASK  = WS_ABUF + (size_t)MP * DM * 2;
constexpr size_t WS_U     = al256(WS_MASK + (size_t)NB * NKS * TLEN * 4);
constexpr size_t WS_S     = WS_U + (size_t)NB * 4 * 129 * 4096 * 4;
constexpr size_t WS_PROJ  = WS_S + (size_t)NB * 4 * 129 * 4096 * 4;
constexpr size_t P512 = (size_t)MP * 512 * 2, P256 = (size_t)MP * 256 * 2;
constexpr size_t PJ_QA = 0, PJ_KA = P512, PJ_VA = 2 * P512, PJ_QI = 3 * P512, PJ_256 = 4 * P512;
constexpr size_t PJ_QB = PJ_256, PJ_KB = PJ_256 + P256, PJ_VB = PJ_256 + 2 * P256, PJ_QC = PJ_256 + 3 * P256, PJ_KC = PJ_256 + 4 * P256,
                 PJ_VC = PJ_256 + 5 * P256, PJ_GC = PJ_256 + 6 * P256, PJ_KI = PJ_256 + 7 * P256, PJ_WI = PJ_KI + (size_t)MP * 64 * 2,
                 PJ_END = PJ_WI + (size_t)MP * 8 * 4;
constexpr size_t ACT_BYTES = (size_t)MP * DFF * 2;
constexpr size_t WS_END = WS_PROJ + (ACT_BYTES > PJ_END ? ACT_BYTES : PJ_END);
constexpr int CW_BAR = 0;
constexpr int CW_KMAX = 4096;

constexpr int LDS_BYTES = 156 * 1024;
constexpr int LDS_MISC = 0, LDS_GEN = 256;

struct Args { const float* in[13]; float* out; unsigned char* ws; int ph_lo, ph_hi; };

struct Frame {
    const float *x, *meta, *rel_bias, *w_in, *norm_mix, *diff_lambda, *diff_norm, *ret_norm, *w_out, *norm_ff, *w_ff1, *w_ff2, *final_norm;
    float* out; unsigned char* ws; LAS unsigned char* lds; int tid, lane, wave, bid, G;
};

__device__ __forceinline__ float shx(float v, int m, int lane) { return __builtin_bit_cast(float, __builtin_amdgcn_ds_bpermute((lane ^ m) << 2, __builtin_bit_cast(int, v))); }
template <int M> __device__ __forceinline__ float sx(float v, int lane) { return shx(v, M, lane); }
__device__ __forceinline__ float hsum32(float v, int lane) { return v + shx(v, 32, lane); }
__device__ __forceinline__ unsigned hor32(unsigned v, int lane) { return v | (unsigned)__builtin_amdgcn_ds_bpermute((lane ^ 32) << 2, (int)v); }
__device__ __forceinline__ float bcast0(float v) { return __builtin_bit_cast(float, __builtin_amdgcn_ds_bpermute(0, __builtin_bit_cast(int, v))); }
__device__ __forceinline__ float wave_sum(float v, int lane) { v = hsum32(v, lane); v += sx<16>(v, lane); v += sx<8>(v, lane); v += sx<4>(v, lane); v += sx<2>(v, lane); v += sx<1>(v, lane); return v; }
__device__ __forceinline__ unsigned cvt_pk_bf16(float lo, float hi) { unsigned r; asm volatile("v_cvt_pk_bf16_f32 %0, %1, %2" : "=v"(r) : "v"(lo), "v"(hi)); return r; }
__device__ __forceinline__ unsigned cvt_pk_f16(float lo, float hi) { h2 p; p.x = (_Float16)lo; p.y = (_Float16)hi; return __builtin_bit_cast(unsigned, p); }
typedef unsigned u32x4 __attribute__((ext_vector_type(4)));
typedef float f32x4 __attribute__((ext_vector_type(4)));
__device__ __forceinline__ u32x4 pack8(const f32x4& a, const f32x4& b, bool bf) {
    u32x4 w;
    if (bf) { w.x = cvt_pk_bf16(a[0], a[1]); w.y = cvt_pk_bf16(a[2], a[3]); w.z = cvt_pk_bf16(b[0], b[1]); w.w = cvt_pk_bf16(b[2], b[3]); }
    else    { w.x = cvt_pk_f16(a[0], a[1]);  w.y = cvt_pk_f16(a[2], a[3]);  w.z = cvt_pk_f16(b[0], b[1]);  w.w = cvt_pk_f16(b[2], b[3]); }
    return w;
}
__device__ __forceinline__ int row_pos(int r) { return r < MR ? (r & (SEQ - 1)) + NMETA : ((r - MR) & 15); }

__device__ __forceinline__ int incol_map(int n) {
    if (n < 2048) return n;
    if (n < 2816) return n - 2048 + 2120;
    if (n < 3328) {
        const int seg = (n - 2816) >> 8, c = (n - 2816) & 255, head = c >> 6, p = c & 63;
        const int g = p >> 3, nn = (p >> 2) & 1, i = p & 3, d = 32 * nn + 4 * g + i;
        return (seg ? 3144 : 2888) + head * 64 + d;
    }
    if (n < 3840) return n - 3328 + 3400;
    if (n < 3904) return n - 3840 + 2048;
    if (n < 3912) return n - 3904 + 2112;
    return -1;
}

__constant__ double ROPE_REV[32] = {0.15915494309189535, 0.11934937021124886, 0.08949940160889101, 0.06711508300522726, 0.050329212104487035, 0.03774158471741977, 0.0283021958306234, 0.02122365276477766, 0.015915494309189534, 0.011934937021124886, 0.008949940160889102, 0.006711508300522725, 0.005032921210448704, 0.003774158471741977, 0.00283021958306234, 0.0021223652764777662, 0.0015915494309189536, 0.0011934937021124885, 0.0008949940160889102, 0.0006711508300522726, 0.0005032921210448703, 0.00037741584717419774, 0.00028302195830623395, 0.0002122365276477766, 0.00015915494309189535, 0.00011934937021124886, 8.949940160889102e-05, 6.711508300522725e-05, 5.0329212104487035e-05, 3.774158471741978e-05, 2.8302195830623396e-05, 2.122365276477766e-05};

struct EpiInProj {
    static constexpr bool PERM = true, AFTER_DRAIN = false;
    unsigned char* proj; const f32x2* rope; unsigned* kmax;
    __device__ __forceinline__ void kmax_update(const pg8::f32x4 (&acc)[2][2][4][2], int bj, unsigned* word, int fr, int fq) const {
        float mx = 0.f; const int LN = fq * 16 + fr;
#pragma unroll
        for (int ai = 0; ai < 2; ++ai)
#pragma unroll
            for (int m = 0; m < 4; ++m) {
                const pg8::f32x4 a = acc[ai][bj][m][0], b = acc[ai][bj][m][1];
                float s = (a[0] * a[0] + a[1] * a[1]) + (a[2] * a[2] + a[3] * a[3]) + (b[0] * b[0] + b[1] * b[1]) + (b[2] * b[2] + b[3] * b[3]);
                s += sx<16>(s, LN); s = hsum32(s, LN);
                mx = fmaxf(mx, s);
            }
        mx = fmaxf(mx, sx<1>(mx, LN)); mx = fmaxf(mx, sx<2>(mx, LN)); mx = fmaxf(mx, sx<4>(mx, LN)); mx = fmaxf(mx, sx<8>(mx, LN));
        if (fr == 0 && fq == 0) atomicMax(word, __float_as_uint(mx));
    }
    __device__ __forceinline__ void operator()(const pg8::f32x4 (&acc)[2][2][4][2], const pg8::Unit& u, int wr, int wc, int fr, int fq) const {
        const int pn = u.pn, rbase = u.pm * 256 + wr * 64 + fr, cw = wc * 32 + 8 * fq;
        if (pn <= 7 || (pn <= 14 && pn != 11 && pn != 12)) {
            unsigned char* base; int ld, colt; float scale = 1.f; bool bf = false;
            if (pn <= 7) { const int arr = pn >> 1; base = proj + (size_t)arr * P512; ld = 512; colt = (pn & 1) * 256; if (arr == 0) scale = QA_SCALE; bf = (arr == 2); }
            else { const int arr = pn - 8; base = proj + PJ_256 + (size_t)arr * P256; ld = 256; colt = 0; if (arr == 0) scale = QB_SCALE; bf = (arr == 2); }
#pragma unroll
            for (int ai = 0; ai < 2; ++ai)
#pragma unroll
                for (int m = 0; m < 4; ++m) {
                    const int row = rbase + ai * 128 + m * 16;
#pragma unroll
                    for (int bj = 0; bj < 2; ++bj) {
                        const pg8::f32x4 v0 = acc[ai][bj][m][0] * scale, v1 = acc[ai][bj][m][1] * scale;
                        *(u32x4*)(base + ((size_t)row * ld + colt + bj * 128 + cw) * 2) = pack8(v0, v1, bf);
                    }
                }
            if (pn == 2 || pn == 3) {
#pragma unroll
                for (int bj = 0; bj < 2; ++bj) { const int head = ((pn & 1) * 256 + bj * 128 + wc * 32) >> 6; kmax_update(acc, bj, kmax + head * 2 + (wc & 1), fr, fq); }
            }
            if (pn == 9) {
#pragma unroll
                for (int bj = 0; bj < 2; ++bj) { const int head = 2 * bj + (wc >> 1); kmax_update(acc, bj, kmax + 16 + head * 2 + (wc & 1), fr, fq); }
            }
        } else if (pn == 11 || pn == 12) {
            unsigned char* base = proj + PJ_256 + (size_t)(pn - 8) * P256;
            const float sc = (pn == 12) ? 0.125f : 1.f;
            const int g = 4 * (wc & 1) + fq;
#pragma unroll
            for (int ai = 0; ai < 2; ++ai)
#pragma unroll
                for (int m = 0; m < 4; ++m) {
                    const int row = rbase + ai * 128 + m * 16, t = row_pos(row);
                    const pg8::f32x4 cs0 = *(const pg8::f32x4*)(rope + (size_t)t * 32 + 4 * g), cs1 = *(const pg8::f32x4*)(rope + (size_t)t * 32 + 4 * g + 2);
                    const float c[4] = {cs0[0], cs0[2], cs1[0], cs1[2]}, s[4] = {cs0[1], cs0[3], cs1[1], cs1[3]};
#pragma unroll
                    for (int bj = 0; bj < 2; ++bj) {
                        const pg8::f32x4 x1 = acc[ai][bj][m][0], x2 = acc[ai][bj][m][1];
                        float o1[4], o2[4];
#pragma unroll
                        for (int i = 0; i < 4; ++i) { o1[i] = (x1[i] * c[i] - x2[i] * s[i]) * sc; o2[i] = (x1[i] * s[i] + x2[i] * c[i]) * sc; }
                        const int head = 2 * bj + (wc >> 1);
                        unsigned char* rp = base + ((size_t)row * 256 + head * 64 + 4 * g) * 2;
                        u32x2 w1, w2; w1.x = cvt_pk_f16(o1[0], o1[1]); w1.y = cvt_pk_f16(o1[2], o1[3]); w2.x = cvt_pk_f16(o2[0], o2[1]); w2.y = cvt_pk_f16(o2[2], o2[3]);
                        *(u32x2*)rp = w1; *(u32x2*)(rp + 64) = w2;
                    }
                }
        } else {
#pragma unroll
            for (int ai = 0; ai < 2; ++ai)
#pragma unroll
                for (int m = 0; m < 4; ++m) {
                    const int row = rbase + ai * 128 + m * 16;
                    const pg8::f32x4 v0 = acc[ai][0][m][0], v1 = acc[ai][0][m][1];
                    if (wc < 2) *(u32x4*)(proj + PJ_KI + ((size_t)row * 64 + cw) * 2) = pack8(v0, v1, false);
                    else if (wc == 2 && fq == 0) { float* wp = (float*)(proj + PJ_WI) + (size_t)row * 8; *(pg8::f32x4*)wp = v0 * WI_SCALE; *(pg8::f32x4*)(wp + 4) = v1 * WI_SCALE; }
                }
        }
    }
};
struct EpiRes {
    static constexpr bool PERM = false, AFTER_DRAIN = false;
    const float* res_main; float* out_main; float* hmeta;
    __device__ __forceinline__ void operator()(const pg8::f32x4 (&acc)[2][2][4][2], const pg8::Unit& u, int wr, int wc, int fr, int fq) const {
        const bool mt = (u.pm * 256 >= MR);
        const float* rb = mt ? hmeta : res_main; float* ob = mt ? hmeta : out_main;
        const int row0 = (mt ? u.pm * 256 - MR : u.pm * 256) + wr * 64 + fr, col0 = u.pn * 256 + wc * 32 + 4 * fq;
#pragma unroll
        for (int ai = 0; ai < 2; ++ai)
#pragma unroll
            for (int m = 0; m < 4; ++m) {
                const size_t ro = (size_t)(row0 + ai * 128 + m * 16) * DM + col0;
#pragma unroll
                for (int bj = 0; bj < 2; ++bj)
#pragma unroll
                    for (int n = 0; n < 2; ++n) { const pg8::f32x4 v = *(const pg8::f32x4*)(rb + ro + bj * 128 + n * 16) + acc[ai][bj][m][n]; *(pg8::f32x4*)(ob + ro + bj * 128 + n * 16) = v; }
            }
    }
};
struct EpiRelu2 {
    static constexpr bool PERM = true, AFTER_DRAIN = false;
    unsigned char* act;
    __device__ __forceinline__ void operator()(const pg8::f32x4 (&acc)[2][2][4][2], const pg8::Unit& u, int wr, int wc, int fr, int fq) const {
        const int rbase = u.pm * 256 + wr * 64 + fr, col0 = u.pn * 256 + wc * 32 + 8 * fq;
#pragma unroll
        for (int ai = 0; ai < 2; ++ai)
#pragma unroll
            for (int m = 0; m < 4; ++m) {
                const int row = rbase + ai * 128 + m * 16;
#pragma unroll
                for (int bj = 0; bj < 2; ++bj) {
                    pg8::f32x4 v0 = acc[ai][bj][m][0], v1 = acc[ai][bj][m][1];
#pragma unroll
                    for (int i = 0; i < 4; ++i) { const float a = fmaxf(v0[i], 0.f), b = fmaxf(v1[i], 0.f); v0[i] = a * a; v1[i] = b * b; }
                    *(u32x4*)(act + ((size_t)row * DFF + col0 + bj * 128) * 2) = pack8(v0, v1, false);
                }
            }
    }
};

struct WTile { const float* src; _Float16* dst; int ld, K, k0, n0, mapped; };
constexpr int WT_PER_LAYER = 16 * 64 + 16 * 16 + 16 * 64 + 64 * 16, WT_TOTAL = DEPTH * WT_PER_LAYER;
__device__ __forceinline__ WTile wt_desc(const Frame& F, int t) {
    WTile d; const int l = t / WT_PER_LAYER; int r = t - l * WT_PER_LAYER;
    unsigned char* wl = F.ws + WS_W + (size_t)l * W_LAYER;
    if (r < 1024)      { d.src = F.w_in + (size_t)l * DM * INCOLS; d.dst = (_Float16*)(wl + W_IN_OFF);  d.ld = INCOLS; d.K = DM;  d.mapped = 1; d.k0 = (r & 15) * 64; d.n0 = (r >> 4) * 64; }
    else if (r < 1280) { r -= 1024; d.src = F.w_out + (size_t)l * DM * DM;  d.dst = (_Float16*)(wl + W_OUT_OFF); d.ld = DM;  d.K = DM;  d.mapped = 0; d.k0 = (r & 15) * 64; d.n0 = (r >> 4) * 64; }
    else if (r < 2304) { r -= 1280; d.src = F.w_ff1 + (size_t)l * DM * DFF; d.dst = (_Float16*)(wl + W_FF1_OFF); d.ld = DFF; d.K = DM;  d.mapped = 0; d.k0 = (r & 15) * 64; d.n0 = (r >> 4) * 64; }
    else               { r -= 2304; d.src = F.w_ff2 + (size_t)l * DFF * DM; d.dst = (_Float16*)(wl + W_FF2_OFF); d.ld = DM;  d.K = DFF; d.mapped = 0; d.k0 = (r & 63) * 64; d.n0 = (r >> 6) * 64; }
    return d;
}
__device__ __forceinline__ void wt_load(const WTile& d, int tid, f32x4& v0, f32x4& v1) {
    const int kk = tid >> 4, n4 = (tid & 15) * 4; const int sc = d.mapped ? incol_map(d.n0 + n4) : d.n0 + n4;
    v0 = (f32x4){0.f, 0.f, 0.f, 0.f}; v1 = v0;
    if (sc >= 0) { v0 = *(const f32x4*)(d.src + (size_t)(d.k0 + kk) * d.ld + sc); v1 = *(const f32x4*)(d.src + (size_t)(d.k0 + kk + 32) * d.ld + sc); }
}
__device__ __forceinline__ void wtrans_all(const Frame& F) {
    LAS float* tile = (LAS float*)(F.lds + LDS_GEN); const int tid = F.tid;
    int t = F.bid; if (t >= WT_TOTAL) return;
    WTile d = wt_desc(F, t); f32x4 v0, v1; wt_load(d, tid, v0, v1);
#pragma unroll 1
    for (;;) {
        const int tn = t + F.G; WTile dn = d; f32x4 n0 = v0, n1 = v1;
        if (tn < WT_TOTAL) { dn = wt_desc(F, tn); wt_load(dn, tid, n0, n1); }
        { const int kk = tid >> 4, n4 = (tid & 15) * 4;
#pragma unroll
          for (int e = 0; e < 4; ++e) { tile[kk * 65 + n4 + e] = v0[e]; tile[(kk + 32) * 65 + n4 + e] = v1[e]; } }
        __syncthreads();
        { const int nn = tid >> 3, k8 = (tid & 7) * 8; h8 o;
#pragma unroll
          for (int e = 0; e < 8; ++e) o[e] = (_Float16)tile[(k8 + e) * 65 + nn];
          *(h8*)(d.dst + (size_t)(d.n0 + nn) * d.K + d.k0 + k8) = o; }
        __syncthreads();
        if (tn >= WT_TOTAL) break;
        t = tn; d = dn; v0 = n0; v1 = n1;
    }
}
template <int MODE> __device__ __forceinline__ void norm_to_abuf(const Frame& F, const float* gain) {
    _Float16* abuf = (_Float16*)(F.ws + WS_ABUF); const float* hmeta = (const float*)(F.ws + WS_HMETA);
    const int nw = F.G * 8;
    f32x4 g[4];
#pragma unroll
    for (int j = 0; j < 4; ++j) g[j] = *(const f32x4*)(gain + j * 256 + F.lane * 4);
    auto src_of = [&](int r) -> const float* { return MODE == 0 ? (r < MR ? F.x + (size_t)r * DM : F.meta + (size_t)((r - MR) & 15) * DM) : (r < MR ? F.out + (size_t)r * DM : hmeta + (size_t)(r - MR) * DM); };
    int r = F.bid * 8 + F.wave;
    f32x4 v[4] = {};
    if (r < MV) {
#pragma unroll
        for (int j = 0; j < 4; ++j) v[j] = *(const f32x4*)(src_of(r) + j * 256 + F.lane * 4); }
#pragma unroll 1
    for (; r < MP; r += nw) {
        const int rn = r + nw;
        f32x4 vn[4] = {};
        if (rn < MV) {
#pragma unroll
            for (int j = 0; j < 4; ++j) vn[j] = *(const f32x4*)(src_of(rn) + j * 256 + F.lane * 4); }
        _Float16* dst = abuf + (size_t)r * DM;
        if (r >= MV) { const h4 z = {(_Float16)0.f, (_Float16)0.f, (_Float16)0.f, (_Float16)0.f};
#pragma unroll
            for (int j = 0; j < 4; ++j) *(h4*)(dst + j * 256 + F.lane * 4) = z; }
        else {
            float ss = 0.f;
#pragma unroll
            for (int j = 0; j < 4; ++j) ss += (v[j][0] * v[j][0] + v[j][1] * v[j][1]) + (v[j][2] * v[j][2] + v[j][3] * v[j][3]);
            ss = wave_sum(ss, F.lane); const float rstd = rsqrtf(ss * (1.0f / DM) + 1e-6f);
#pragma unroll
            for (int j = 0; j < 4; ++j) { h4 o;
#pragma unroll
                for (int e = 0; e < 4; ++e) o[e] = (_Float16)(v[j][e] * rstd * g[j][e]);
                *(h4*)(dst + j * 256 + F.lane * 4) = o; }
        }
#pragma unroll
        for (int j = 0; j < 4; ++j) v[j] = vn[j];
    }
}
__device__ __forceinline__ void final_norm(const Frame& F) {
    const int nw = F.G * 8;
    f32x4 g[4];
#pragma unroll
    for (int j = 0; j < 4; ++j) g[j] = *(const f32x4*)(F.final_norm + j * 256 + F.lane * 4);
    int r = F.bid * 8 + F.wave;
    f32x4 v[4] = {};
    if (r < MR) {
#pragma unroll
        for (int j = 0; j < 4; ++j) v[j] = *(const f32x4*)(F.out + (size_t)r * DM + j * 256 + F.lane * 4); }
#pragma unroll 1
    for (; r < MR; r += nw) {
        const int rn = r + nw;
        f32x4 vn[4] = {};
        if (rn < MR) {
#pragma unroll
            for (int j = 0; j < 4; ++j) vn[j] = *(const f32x4*)(F.out + (size_t)rn * DM + j * 256 + F.lane * 4); }
        float* p = F.out + (size_t)r * DM; float ss = 0.f;
#pragma unroll
        for (int j = 0; j < 4; ++j) ss += (v[j][0] * v[j][0] + v[j][1] * v[j][1]) + (v[j][2] * v[j][2] + v[j][3] * v[j][3]);
        ss = wave_sum(ss, F.lane); const float rstd = rsqrtf(ss * (1.0f / DM) + 1e-6f);
#pragma unroll
        for (int j = 0; j < 4; ++j) *(f32x4*)(p + j * 256 + F.lane * 4) = v[j] * rstd * g[j];
#pragma unroll
        for (int j = 0; j < 4; ++j) v[j] = vn[j];
    }
}
__device__ __forceinline__ void prologue(const Frame& F) {
    const int gtid = F.bid * NTHREADS + F.tid, gsz = F.G * NTHREADS;
    float* hmeta = (float*)(F.ws + WS_HMETA);
    for (int i = gtid; i < 256 * DM / 4; i += gsz) { const int row = i / (DM / 4), c4 = i % (DM / 4); f32x4 v = {0.f, 0.f, 0.f, 0.f}; if (row < NB * NMETA) v = *(const f32x4*)(F.meta + (size_t)(row & 15) * DM + c4 * 4); *(f32x4*)(hmeta + (size_t)row * DM + c4 * 4) = v; }
    f32x2* rope = (f32x2*)(F.ws + WS_ROPE);
    for (int i = gtid; i < TLEN * 32; i += gsz) { const int t = i >> 5, d = i & 31; const double rev = (double)t * ROPE_REV[d]; const float fr = (float)(rev - __builtin_floor(rev)); f32x2 cs; cs.x = __builtin_amdgcn_cosf(fr); cs.y = __builtin_amdgcn_sinf(fr); rope[i] = cs; }
    wtrans_all(F);
    norm_to_abuf<0>(F, F.norm_mix);
}
__device__ __forceinline__ int crow(int i, int h) { return (i & 3) + 8 * (i >> 2) + 4 * h; }
constexpr size_t WS_SCR = WS_U;
template <bool FROM_SCR> __device__ __forceinline__ void skinny_task(const unsigned char* A, int lda_bytes, const float* scr, const _Float16* Bt, int K, int n0, int k0, float* dst, int ldd, int lane) {
    const int r = lane & 31, h = lane >> 5;
    f32x16 acc;
#pragma unroll
    for (int i = 0; i < 16; ++i) acc[i] = 0.f;
#pragma unroll 1
    for (int kc = 0; kc < 4; ++kc) {
    h8 a[4], bb[4];
#pragma unroll
    for (int s = 0; s < 4; ++s) {
        const int k = k0 + 64 * kc + 16 * s + 8 * h;
        if (FROM_SCR) { const f32x4 x0 = *(const f32x4*)(scr + (size_t)r * DFF + k), x1 = *(const f32x4*)(scr + (size_t)r * DFF + k + 4);
#pragma unroll
            for (int e = 0; e < 4; ++e) { const float u = fmaxf(x0[e], 0.f), v = fmaxf(x1[e], 0.f); a[s][e] = (_Float16)(u * u); a[s][4 + e] = (_Float16)(v * v); } }
        else a[s] = *(const h8*)(A + (size_t)(MR + r) * lda_bytes + (size_t)k * 2);
        bb[s] = *(const h8*)(Bt + (size_t)(n0 + r) * K + k);
    }
#pragma unroll
    for (int s = 0; s < 4; ++s) acc = __builtin_amdgcn_mfma_f32_32x32x16_f16(a[s], bb[s], acc, 0, 0, 0);
    }
#pragma unroll
    for (int i = 0; i < 16; ++i) atomicAdd(dst + (size_t)crow(i, h) * ldd + n0 + r, acc[i]);
}
template <int MODE> __device__ __forceinline__ void skinny_meta(const Frame& F, const unsigned char* wl) {
    const int ntn = MODE == 1 ? 128 : 32, nks = MODE == 2 ? 16 : 4, ntask = ntn * nks;
    float* hmeta = (float*)(F.ws + WS_HMETA); float* scr = (float*)(F.ws + WS_SCR);
#pragma unroll 1
    for (int task = F.bid * 8 + F.wave; task < ntask; task += F.G * 8) {
        const int nt = task % ntn, ks = task / ntn;
        if (MODE == 0) skinny_task<false>(F.ws + WS_ABUF, DM * 2, nullptr, (const _Float16*)(wl + W_OUT_OFF), DM, nt * 32, ks * 256, hmeta, DM, F.lane);
        if (MODE == 1) skinny_task<false>(F.ws + WS_ABUF, DM * 2, nullptr, (const _Float16*)(wl + W_FF1_OFF), DM, nt * 32, ks * 256, scr, DFF, F.lane);
        if (MODE == 2) skinny_task<true>(nullptr, 0, scr, (const _Float16*)(wl + W_FF2_OFF), DFF, nt * 32, ks * 256, hmeta, DM, F.lane);
    }
}
__device__ __forceinline__ void zero_scr(const Frame& F) {
    f32x4* p = (f32x4*)(F.ws + WS_SCR); float z0 = 0.f; asm volatile("" : "+v"(z0)); const f32x4 z = {z0, z0, z0, z0};
    for (int i = F.bid * NTHREADS + F.tid; i < 32 * DFF / 4; i += F.G * NTHREADS) p[i] = z;
}
__device__ __forceinline__ void zero_abuf(const Frame& F) {
    u32x4* p = (u32x4*)(F.ws + WS_ABUF); const u32x4 z = {0u, 0u, 0u, 0u};
    for (size_t i = (size_t)F.bid * NTHREADS + F.tid; i < (size_t)MP * DM * 2 / 16; i += (size_t)F.G * NTHREADS) p[i] = z;
}

typedef short bf16x8v __attribute__((ext_vector_type(8)));
__constant__ unsigned char BUCKET_LUT[128] = {0, 1, 2, 3, 4, 5, 6, 7, 8, 9, 10, 11, 12, 13, 14, 15, 16, 16, 16, 17, 17, 18, 18, 18, 19, 19, 19, 20, 20, 20, 20, 21, 21, 21, 21, 22, 22, 22, 22, 22, 23, 23, 23, 23, 23, 23, 24, 24, 24, 24, 24, 24, 25, 25, 25, 25, 25, 25, 25, 26, 26, 26, 26, 26, 26, 26, 26, 27, 27, 27, 27, 27, 27, 27, 27, 27, 27, 28, 28, 28, 28, 28, 28, 28, 28, 28, 28, 29, 29, 29, 29, 29, 29, 29, 29, 29, 29, 29, 29, 30, 30, 30, 30, 30, 30, 30, 30, 30, 30, 30, 30, 30, 30, 31, 31, 31, 31, 31, 31, 31, 31, 31, 31, 31, 31, 31, 31, 31};
__device__ __forceinline__ bf16x8v pack_p(const f32x16& x, int s) {
    u32x4 p; p.x = cvt_pk_bf16(x[8 * s + 0], x[8 * s + 1]); p.y = cvt_pk_bf16(x[8 * s + 2], x[8 * s + 3]); p.z = cvt_pk_bf16(x[8 * s + 4], x[8 * s + 5]); p.w = cvt_pk_bf16(x[8 * s + 6], x[8 * s + 7]);
    return __builtin_bit_cast(bf16x8v, p);
}
#ifndef STAGGER
#define STAGGER 0
#endif
constexpr int TK = 128;
__device__ __forceinline__ bf16x8v vt_frag(LAS unsigned char* vimg, int dblk, int keybase, int s, int lane) {
    const int h = lane >> 5, blk = (lane >> 4) & 1, i16 = lane & 15, q = i16 >> 2, p = i16 & 3;
    LAS unsigned char* a = vimg + dblk * (TK * 64) + (keybase + 16 * s + 4 * h + q) * 64 + (16 * blk + 4 * p) * 2;
    const s16x4 lo = __builtin_amdgcn_ds_read_tr16_b64_v4i16((LAS s16x4*)a);
    const s16x4 hi = __builtin_amdgcn_ds_read_tr16_b64_v4i16((LAS s16x4*)(a + 8 * 64));
    return __builtin_shufflevector(lo, hi, 0, 1, 2, 3, 4, 5, 6, 7);
}

constexpr int KS_PITCH = 144;
constexpr int KBUF = TK * KS_PITCH, VBUF = 2 * TK * 64, B_KS = 0, B_VS = 4 * KBUF, B_LUT = B_VS + 4 * VBUF, B_END = B_LUT + 512;
__device__ __forceinline__ void mixB_unit(const Frame& F, int l, int b, int hh, int qblk, float lam, float oscale) {
    LAS unsigned char* L = F.lds + LDS_GEN;
    int lane_; { unsigned z0_ = 0u; asm volatile("" : "+s"(z0_)); lane_ = (int)__builtin_amdgcn_mbcnt_hi(~0u, __builtin_amdgcn_mbcnt_lo(~0u, z0_)); asm volatile("" : "+v"(lane_)); }
    const int lane = lane_, wave = F.wave, tid = wave * 64 + lane, r = lane & 31, h = lane >> 5;
    const unsigned char* proj = F.ws + WS_PROJ;
    const _Float16* QB = (const _Float16*)(proj + PJ_QB); const unsigned char* KB = proj + PJ_KB; const unsigned char* VB = proj + PJ_VB;
    const unsigned* kmax = (const unsigned*)(F.ws + WS_CTL) + CW_KMAX + 32 * l + 16;
    const bool meta_u = qblk < 0;
    const int qrow0 = meta_u ? MR + b * NMETA : b * SEQ + qblk * 256;
    const int qpos0 = meta_u ? 0 : NMETA + qblk * 256;
    const int nreal = meta_u ? 0 : 2 * qblk + 2;
    const int wq0 = 32 * wave;
    const bool wave_on = meta_u ? (wave == 0) : true;
    const int my_row = wave_on ? qrow0 + wq0 + r : qrow0, my_pos = qpos0 + wq0 + r;
    __syncthreads();
    if (tid < 128) ((LAS float*)(L + B_LUT))[tid] = F.rel_bias[BUCKET_LUT[tid] * 12 + 8 + hh] * LOG2E;
    float bmax = (lane < 32) ? F.rel_bias[lane * 12 + 8 + hh] * LOG2E : -1e30f;
    bmax = fmaxf(bmax, sx<16>(bmax, lane)); bmax = fmaxf(bmax, sx<8>(bmax, lane)); bmax = fmaxf(bmax, sx<4>(bmax, lane)); bmax = fmaxf(bmax, sx<2>(bmax, lane)); bmax = fmaxf(bmax, sx<1>(bmax, lane));
    bmax = bcast0(bmax);
    const float bfar = F.rel_bias[31 * 12 + 8 + hh] * LOG2E;
    h8 qf[2][2]; float mref[2]; bool safe = true;
#pragma unroll
    for (int c = 0; c < 2; ++c) {
        float n2 = 0.f;
#pragma unroll
        for (int s = 0; s < 2; ++s) { qf[c][s] = *(const h8*)(QB + (size_t)my_row * 256 + hh * 64 + c * 32 + 16 * s + 8 * h);
#pragma unroll
            for (int j = 0; j < 8; ++j) { const float v = (float)qf[c][s][j]; n2 += v * v; } }
        n2 = hsum32(n2, lane);
        mref[c] = sqrtf(n2 * __uint_as_float(kmax[hh * 2 + c])) * 1.002f + bmax;
        safe = safe && (mref[c] - bfar < 60.0f);
    }
    safe = __all(safe);
    if (safe) { mref[0] = bfar; mref[1] = bfar; }
    f32x16 O[2][2]; f32x2 lsum2[2][2] = {{{0.f, 0.f}, {0.f, 0.f}}, {{0.f, 0.f}, {0.f, 0.f}}};
#pragma unroll
    for (int c = 0; c < 2; ++c)
#pragma unroll
        for (int d = 0; d < 2; ++d)
#pragma unroll
            for (int i = 0; i < 16; ++i) O[c][d][i] = 0.f;
    const int skey = tid >> 3, sch = tid & 7;
    const auto rsKV = __builtin_amdgcn_make_buffer_rsrc((void*)(KB + hh * 128), 0, 0x7fffffff, 0x00020000);
    const unsigned kvo0 = (unsigned)skey * 512u + (unsigned)sch * 16u, kvo1 = kvo0 + 64u * 512u;
    const unsigned kdst = skey * KS_PITCH + sch * 16, vdst = (sch >> 2) * (TK * 64) + skey * 64 + (sch & 3) * 16;
    const int ntiles = 1 + nreal;
    auto tile_row0 = [&](int t) -> int { return t == 0 ? MR + b * NMETA : b * SEQ + (t - 1) * TK; };
    u32x4 kreg[2], vreg[2];
#pragma unroll
    for (int j = 0; j < 2; ++j) { const unsigned so = (unsigned)tile_row0(0) * 512u; kreg[j] = __builtin_amdgcn_raw_buffer_load_b128(rsKV, j ? kvo1 : kvo0, so, 0); vreg[j] = __builtin_amdgcn_raw_buffer_load_b128(rsKV, j ? kvo1 : kvo0, so + (unsigned)(PJ_VB - PJ_KB), 0); }
#pragma unroll
    for (int j = 0; j < 2; ++j) { *(LAS u32x4*)(L + B_KS + kdst + j * 64 * KS_PITCH) = kreg[j]; *(LAS u32x4*)(L + B_VS + vdst + j * 64 * 64) = vreg[j]; }
    if (ntiles > 1) {
#pragma unroll
        for (int j = 0; j < 2; ++j) { const unsigned so = (unsigned)tile_row0(1) * 512u; kreg[j] = __builtin_amdgcn_raw_buffer_load_b128(rsKV, j ? kvo1 : kvo0, so, 0); vreg[j] = __builtin_amdgcn_raw_buffer_load_b128(rsKV, j ? kvo1 : kvo0, so + (unsigned)(PJ_VB - PJ_KB), 0); }
#pragma unroll
        for (int j = 0; j < 2; ++j) { *(LAS u32x4*)(L + B_KS + KBUF + kdst + j * 64 * KS_PITCH) = kreg[j]; *(LAS u32x4*)(L + B_VS + VBUF + vdst + j * 64 * 64) = vreg[j]; }
    }
    __syncthreads();
    const int wpos0 = qpos0 + wq0;
    if (wave >= 4) __builtin_amdgcn_s_setprio(1);
#pragma unroll 1
    for (int t = 0; t < ntiles; ++t) {
        const int buf = t & 3;
        if (STAGGER > 0 && wave >= 4 && (t & 1) == 0) __builtin_amdgcn_s_sleep(STAGGER);
        if (t + 2 < ntiles) {
#pragma unroll
            for (int j = 0; j < 2; ++j) { const unsigned so = (unsigned)tile_row0(t + 2) * 512u; kreg[j] = __builtin_amdgcn_raw_buffer_load_b128(rsKV, j ? kvo1 : kvo0, so, 0); vreg[j] = __builtin_amdgcn_raw_buffer_load_b128(rsKV, j ? kvo1 : kvo0, so + (unsigned)(PJ_VB - PJ_KB), 0); } }
        const int kpos0 = (t == 0) ? 0 : NMETA + (t - 1) * TK, nvalid = (t == 0) ? NMETA : TK;
        if (wave_on && kpos0 <= wpos0 + 31) {
            LAS unsigned char* Kb = L + B_KS + buf * KBUF; LAS unsigned char* Vb = L + B_VS + buf * VBUF;
#pragma unroll
            for (int sub = 0; sub < 4; ++sub) {
                if (sub * 32 >= nvalid || kpos0 + sub * 32 > wpos0 + 31) continue;
                const bool slow = !safe || (t == 0) || (kpos0 + sub * 32 + 31 > wpos0 - 128);
                h8 kfr[2][2]; bf16x8v vfr[2][2];
#pragma unroll
                for (int c = 0; c < 2; ++c)
#pragma unroll
                    for (int s = 0; s < 2; ++s) kfr[c][s] = *(const LAS h8*)(Kb + (sub * 32 + r) * KS_PITCH + (c * 32 + 16 * s + 8 * h) * 2);
#pragma unroll
                for (int d = 0; d < 2; ++d)
#pragma unroll
                    for (int s = 0; s < 2; ++s) vfr[d][s] = vt_frag(Vb, d, sub * 32, s, lane);
                __builtin_amdgcn_sched_barrier(0);
                f32x16 S[2];
#pragma unroll
                for (int c = 0; c < 2; ++c) {
#pragma unroll
                    for (int i = 0; i < 16; ++i) S[c][i] = 0.f;
#pragma unroll
                    for (int s = 0; s < 2; ++s) S[c] = __builtin_amdgcn_mfma_f32_32x32x16_f16(kfr[c][s], qf[c][s], S[c], 0, 0, 0);
                }
                if (slow) {
                    float bs[16];
#pragma unroll
                    for (int i = 0; i < 16; ++i) { const int dist = my_pos - (kpos0 + sub * 32 + crow(i, h)); bs[i] = ((const LAS float*)(L + B_LUT))[min(max(dist, 0), 127)]; }
#pragma unroll
                    for (int i = 0; i < 16; ++i) {
                        const int kidx = sub * 32 + crow(i, h), dist = my_pos - (kpos0 + kidx);
                        const bool ok = dist >= 0 && kidx < nvalid;
#pragma unroll
                        for (int c = 0; c < 2; ++c) { const float e = __builtin_amdgcn_exp2f(fminf(S[c][i] + (bs[i] - mref[c]), 80.f)); S[c][i] = ok ? e : 0.f; }
                    }
                }
#pragma unroll
                for (int c = 0; c < 2; ++c) {
                    __builtin_amdgcn_sched_barrier(0);
                    if (!slow) {
#pragma unroll
                        for (int i = 0; i < 16; ++i) S[c][i] = __builtin_amdgcn_exp2f(S[c][i]); }
#pragma unroll
                    for (int m = 0; m < 8; ++m) { const f32x2 pr = {S[c][2 * m], S[c][2 * m + 1]}; lsum2[c][m & 1] += pr; }
                    bf16x8v pf[2]; pf[0] = pack_p(S[c], 0); pf[1] = pack_p(S[c], 1);
                    __builtin_amdgcn_sched_barrier(0);
#pragma unroll
                    for (int d = 0; d < 2; ++d)
#pragma unroll
                        for (int s = 0; s < 2; ++s) O[c][d] = __builtin_amdgcn_mfma_f32_32x32x16_bf16(vfr[d][s], pf[s], O[c][d], 0, 0, 0);
                }
            }
        }
        if (t + 2 < ntiles) {
#pragma unroll
            for (int j = 0; j < 2; ++j) { *(LAS u32x4*)(L + B_KS + (buf ^ 2) * KBUF + kdst + j * 64 * KS_PITCH) = kreg[j]; *(LAS u32x4*)(L + B_VS + (buf ^ 2) * VBUF + vdst + j * 64 * 64) = vreg[j]; } }
        if (t & 1) { if (STAGGER > 0 && wave < 4) __builtin_amdgcn_s_sleep(STAGGER); __syncthreads(); }
    }
    __builtin_amdgcn_s_setprio(0);
    if (wave_on) {
        const float l0 = hsum32((lsum2[0][0][0] + lsum2[0][0][1]) + (lsum2[0][1][0] + lsum2[0][1][1]), lane), l1 = hsum32((lsum2[1][0][0] + lsum2[1][0][1]) + (lsum2[1][1][0] + lsum2[1][1][1]), lane);
        const float i0 = 1.0f / l0, i1 = lam / l1;
        float o[2][16], ss = 0.f;
#pragma unroll
        for (int d = 0; d < 2; ++d)
#pragma unroll
            for (int i = 0; i < 16; ++i) { o[d][i] = O[0][d][i] * i0 - O[1][d][i] * i1; ss += o[d][i] * o[d][i]; }
        ss = hsum32(ss, lane);
        const float rstd = rsqrtf(ss * (1.0f / 64.0f) + 1e-6f) * oscale;
        const float* gn = F.diff_norm + l * 64;
        f32x4 gvv[2][4];
#pragma unroll
        for (int d = 0; d < 2; ++d)
#pragma unroll
            for (int g4 = 0; g4 < 4; ++g4) gvv[d][g4] = *(const f32x4*)(gn + 32 * d + 8 * g4 + 4 * h);
        if (!meta_u || r < NMETA) {
            _Float16* dst = (_Float16*)(F.ws + WS_ABUF) + (size_t)my_row * DM + 512 + hh * 64;
#pragma unroll
            for (int d = 0; d < 2; ++d)
#pragma unroll
                for (int g4 = 0; g4 < 4; ++g4) { const int d0 = 32 * d + 8 * g4 + 4 * h; const f32x4 gv = gvv[d][g4];
                    u32x2 w; w.x = cvt_pk_f16(o[d][4 * g4 + 0] * rstd * gv[0], o[d][4 * g4 + 1] * rstd * gv[1]); w.y = cvt_pk_f16(o[d][4 * g4 + 2] * rstd * gv[2], o[d][4 * g4 + 3] * rstd * gv[3]);
                    *(u32x2*)(dst + d0) = w; }
        }
    }
}
__device__ __forceinline__ void mixB_phase(const Frame& F, int l) {
    const float* lp = F.diff_lambda + l * 128;
    float a = (F.lane < 32) ? lp[F.lane] * lp[32 + F.lane] : 0.f, c = (F.lane < 32) ? lp[64 + F.lane] * lp[96 + F.lane] : 0.f;
    a = wave_sum(a, F.lane); c = wave_sum(c, F.lane);
    const float linit = 0.8f - 0.6f * expf(-0.3f * (float)l);
    const float lam = expf(a) - expf(c) + linit, oscale = 1.0f - linit;
#pragma unroll 1
    for (int cidx = F.bid; cidx < 256; cidx += F.G) { const int bh = cidx & 7, i = cidx >> 3;
#pragma unroll 1
        for (int k = 0; k < 3; ++k) { if (k == 2 && cidx >= 8) break; mixB_unit(F, l, bh >> 2, bh & 3, k == 0 ? 63 - i : (k == 1 ? i : -1), lam, oscale); }
    }
}
__device__ __forceinline__ h8 tr_frag_nat(LAS unsigned char* img_blk, int rowbase, int s, int lane) {
    const int h = lane >> 5, blk = (lane >> 4) & 1, i16 = lane & 15, q = i16 >> 2, p = i16 & 3;
    LAS unsigned char* a = img_blk + (rowbase + 16 * s + 8 * h + q) * 64 + (16 * blk + 4 * p) * 2;
    const s16x4 lo = __builtin_amdgcn_ds_read_tr16_b64_v4i16((LAS s16x4*)a);
    const s16x4 hi = __builtin_amdgcn_ds_read_tr16_b64_v4i16((LAS s16x4*)(a + 4 * 64));
    return __builtin_bit_cast(h8, __builtin_shufflevector(lo, hi, 0, 1, 2, 3, 4, 5, 6, 7));
}
__device__ __forceinline__ h8 tr_frag_krow(LAS unsigned char* img_blk, int rowbase, int s, int lane) {
    const int h = lane >> 5, blk = (lane >> 4) & 1, i16 = lane & 15, q = i16 >> 2, p = i16 & 3;
    LAS unsigned char* a = img_blk + (rowbase + 16 * s + 4 * h + q) * 64 + (16 * blk + 4 * p) * 2;
    const s16x4 lo = __builtin_amdgcn_ds_read_tr16_b64_v4i16((LAS s16x4*)a);
    const s16x4 hi = __builtin_amdgcn_ds_read_tr16_b64_v4i16((LAS s16x4*)(a + 8 * 64));
    return __builtin_bit_cast(h8, __builtin_shufflevector(lo, hi, 0, 1, 2, 3, 4, 5, 6, 7));
}
__device__ __forceinline__ float ret_log2gamma(int hc) { return log2f(1.0f - exp2f(-5.0f - (float)hc)); }
__device__ __forceinline__ h8 scale_h8(const h8& v, float sc) { h8 o;
#pragma unroll
    for (int e = 0; e < 8; ++e) o[e] = (_Float16)((float)v[e] * sc);
    return o; }

__device__ __forceinline__ void mixC1_unit(const Frame& F, int b, int hp, int c) {
    LAS unsigned char* L = F.lds + LDS_GEN;
    const int tid = F.tid, lane = F.lane, wave = F.wave;
    const unsigned char* proj = F.ws + WS_PROJ;
    const int row0 = c == 0 ? MR + b * NMETA : b * SEQ + 128 * (c - 1), Lc = c == 0 ? NMETA : 128;
    __syncthreads();
#pragma unroll
    for (int idx = tid; idx < 4096; idx += NTHREADS) {
        const int head = idx >> 11, arr = (idx >> 10) & 1, j = (idx >> 3) & 127, ch = idx & 7, hc = 2 * hp + head;
        h8 v;
#pragma unroll
        for (int e = 0; e < 8; ++e) v[e] = (_Float16)0.f;
        if (j < Lc) { v = *(const h8*)(proj + (arr ? PJ_VC : PJ_KC) + (size_t)(row0 + j) * 512 + hc * 128 + ch * 16);
            if (arr) v = scale_h8(v, exp2f((float)(Lc - 1 - j) * ret_log2gamma(hc))); }
        *(LAS h8*)(L + head * 32768 + arr * 16384 + (ch >> 2) * 8192 + j * 64 + (ch & 3) * 16) = v;
    }
    __syncthreads();
    const int head = wave >> 2, mb = (wave >> 1) & 1, nb = wave & 1, r = lane & 31, h = lane >> 5;
    f32x16 acc;
#pragma unroll
    for (int i = 0; i < 16; ++i) acc[i] = 0.f;
#pragma unroll
    for (int s = 0; s < 8; ++s) { const h8 a = tr_frag_nat(L + head * 32768 + mb * 8192, 0, s, lane), bb = tr_frag_nat(L + head * 32768 + 16384 + nb * 8192, 0, s, lane);
        acc = __builtin_amdgcn_mfma_f32_32x32x16_f16(a, bb, acc, 0, 0, 0); }
    float* U = (float*)(F.ws + WS_U) + ((size_t)((b * 4 + 2 * hp + head) * 129 + c)) * 4096;
#pragma unroll
    for (int i = 0; i < 16; ++i) U[(32 * mb + crow(i, h)) * 64 + 32 * nb + r] = acc[i];
}
__device__ __forceinline__ void mixC1_phase(const Frame& F) {
#pragma unroll 1
    for (int base = 0; base < NB * 2 * 129; base += F.G) {
        const int u = base + (base + F.G <= NB * 2 * 129 ? F.bid : F.G - 1 - F.bid); if (u >= NB * 2 * 129) continue;
        const int c = u % 129, bh = u / 129; mixC1_unit(F, bh >> 1, bh & 1, c); }
}
__device__ __forceinline__ void mixC_scan(const Frame& F) {
    if (F.tid >= 128) return;
    const int e = F.bid * 128 + F.tid;
    if (e >= NB * 4 * 4096) return;
    const int bh = e >> 12, el = e & 4095, hc = bh & 3;
    const float lg = ret_log2gamma(hc), g128 = exp2f(128.f * lg), g16 = exp2f(16.f * lg);
    const float* U = (const float*)(F.ws + WS_U) + (size_t)bh * 129 * 4096 + el; float* S = (float*)(F.ws + WS_S) + (size_t)bh * 129 * 4096 + el;
    float st = U[0];
    S[4096] = st;
#pragma unroll 1
    for (int c0 = 1; c0 < 128; c0 += 64) {
        float u[64];
#pragma unroll
        for (int k = 0; k < 64; ++k) u[k] = (c0 + k < 128) ? U[(size_t)(c0 + k) * 4096] : 0.f;
#pragma unroll
        for (int k = 0; k < 64; ++k) if (c0 + k < 128) { st = st * g128 + u[k]; S[(size_t)(c0 + k + 1) * 4096] = st; }
    }
    (void)g16;
}
constexpr int C2_KI = 0, C2_VI = 128 * KS_PITCH, C2_ST = C2_VI + 16384, C2_HEAD = C2_ST + 64 * KS_PITCH;
__device__ __forceinline__ void mixC2_unit(const Frame& F, int l, int b, int hp, int c) {
    LAS unsigned char* L = F.lds + LDS_GEN;
    const int tid = F.tid, lane = F.lane, wave = F.wave, r = lane & 31, h = lane >> 5;
    const unsigned char* proj = F.ws + WS_PROJ;
    const int row0 = c == 0 ? MR + b * NMETA : b * SEQ + 128 * (c - 1), Lc = c == 0 ? NMETA : 128;
    __syncthreads();
#pragma unroll
    for (int idx = tid; idx < 4096; idx += NTHREADS) {
        const int head = idx >> 11, arr = (idx >> 10) & 1, j = (idx >> 3) & 127, ch = idx & 7, hc = 2 * hp + head;
        h8 v;
#pragma unroll
        for (int e = 0; e < 8; ++e) v[e] = (_Float16)0.f;
        if (j < Lc) v = *(const h8*)(proj + (arr ? PJ_VC : PJ_KC) + (size_t)(row0 + j) * 512 + hc * 128 + ch * 16);
        if (arr) *(LAS h8*)(L + head * C2_HEAD + C2_VI + (ch >> 2) * 8192 + j * 64 + (ch & 3) * 16) = v;
        else     *(LAS h8*)(L + head * C2_HEAD + C2_KI + j * KS_PITCH + ch * 16) = v;
    }
    if (c > 0) {
#pragma unroll
        for (int idx = tid; idx < 2 * 1024; idx += NTHREADS) { const int head = idx >> 10, el = (idx & 1023) * 4, dk = el >> 6, dv = el & 63;
            const f32x4 v = *(const f32x4*)((const float*)(F.ws + WS_S) + ((size_t)((b * 4 + 2 * hp + head) * 129 + c)) * 4096 + el);
#pragma unroll
            for (int e = 0; e < 4; ++e) *(LAS _Float16*)(L + head * C2_HEAD + C2_ST + (dv + e) * KS_PITCH + dk * 2) = (_Float16)v[e]; }
    }
    __syncthreads();
    const int head = wave >> 2, wq = wave & 3, hc = 2 * hp + head;
    if (wq * 32 < Lc) {
        LAS unsigned char* Hb = L + head * C2_HEAD;
        const int qi = wq * 32 + r, my_row = row0 + qi;
        const float lg = ret_log2gamma(hc);
        h8 qf[4];
#pragma unroll
        for (int s = 0; s < 4; ++s) qf[s] = *(const h8*)(proj + PJ_QC + (size_t)my_row * 512 + hc * 128 + (16 * s + 8 * h) * 2);
        f32x16 O[2];
#pragma unroll
        for (int d = 0; d < 2; ++d)
#pragma unroll
            for (int i = 0; i < 16; ++i) O[d][i] = 0.f;
        if (c > 0) {
#pragma unroll
            for (int d = 0; d < 2; ++d)
#pragma unroll
                for (int s = 0; s < 4; ++s) { const h8 a = *(const LAS h8*)(Hb + C2_ST + (32 * d + r) * KS_PITCH + (16 * s + 8 * h) * 2);
                    O[d] = __builtin_amdgcn_mfma_f32_32x32x16_f16(a, qf[s], O[d], 0, 0, 0); }
            const float qd = exp2f((float)(qi + 1) * lg);
#pragma unroll
            for (int d = 0; d < 2; ++d)
#pragma unroll
                for (int i = 0; i < 16; ++i) O[d][i] *= qd;
        }
#pragma unroll 1
        for (int jb = 0; jb <= wq; ++jb) {
            f32x16 S;
#pragma unroll
            for (int i = 0; i < 16; ++i) S[i] = 0.f;
#pragma unroll
            for (int s = 0; s < 4; ++s) { const h8 kf = *(const LAS h8*)(Hb + C2_KI + (32 * jb + r) * KS_PITCH + (16 * s + 8 * h) * 2);
                S = __builtin_amdgcn_mfma_f32_32x32x16_f16(kf, qf[s], S, 0, 0, 0); }
#pragma unroll
            for (int i = 0; i < 16; ++i) { const int dd = qi - (32 * jb + crow(i, h)); S[i] = dd >= 0 ? S[i] * exp2f((float)dd * lg) : 0.f; }
            h8 pf[2];
#pragma unroll
            for (int s = 0; s < 2; ++s) { u32x4 p; p.x = cvt_pk_f16(S[8 * s + 0], S[8 * s + 1]); p.y = cvt_pk_f16(S[8 * s + 2], S[8 * s + 3]); p.z = cvt_pk_f16(S[8 * s + 4], S[8 * s + 5]); p.w = cvt_pk_f16(S[8 * s + 6], S[8 * s + 7]); pf[s] = __builtin_bit_cast(h8, p); }
#pragma unroll
            for (int d = 0; d < 2; ++d)
#pragma unroll
                for (int s = 0; s < 2; ++s) { const h8 vf = tr_frag_krow(Hb + C2_VI + d * 8192, 32 * jb, s, lane);
                    O[d] = __builtin_amdgcn_mfma_f32_32x32x16_f16(vf, pf[s], O[d], 0, 0, 0); }
        }
        float ss = 0.f;
#pragma unroll
        for (int d = 0; d < 2; ++d)
#pragma unroll
            for (int i = 0; i < 16; ++i) ss += O[d][i] * O[d][i];
        ss = hsum32(ss, lane);
        const float rstd = rsqrtf(ss * (1.0f / 64.0f) + 1e-6f);
        if (qi < Lc) {
            const float* gn = F.ret_norm + l * 256 + hc * 64;
            const _Float16* gc = (const _Float16*)(proj + PJ_GC) + (size_t)my_row * 256 + hc * 64;
            _Float16* dst = (_Float16*)(F.ws + WS_ABUF) + (size_t)my_row * DM + 768 + hc * 64;
            f32x4 gvv[2][4]; h4 ggv[2][4];
#pragma unroll
            for (int d = 0; d < 2; ++d)
#pragma unroll
                for (int g4 = 0; g4 < 4; ++g4) { const int d0 = 32 * d + 8 * g4 + 4 * h; gvv[d][g4] = *(const f32x4*)(gn + d0); ggv[d][g4] = *(const h4*)(gc + d0); }
#pragma unroll
            for (int d = 0; d < 2; ++d)
#pragma unroll
                for (int g4 = 0; g4 < 4; ++g4) { const int d0 = 32 * d + 8 * g4 + 4 * h; const f32x4 gv = gvv[d][g4]; const h4 gg = ggv[d][g4];
                    float o[4];
#pragma unroll
                    for (int e = 0; e < 4; ++e) { const float g = (float)gg[e]; o[e] = O[d][4 * g4 + e] * rstd * gv[e] * (g / (1.0f + __expf(-g))); }
                    u32x2 w; w.x = cvt_pk_f16(o[0], o[1]); w.y = cvt_pk_f16(o[2], o[3]); *(u32x2*)(dst + d0) = w; }
        }
    }
}
__device__ __forceinline__ void mixC2_phase(const Frame& F, int l) {
#pragma unroll 1
    for (int base = 0; base < NB * 2 * 129; base += F.G) {
        const int u = base + (base + F.G <= NB * 2 * 129 ? F.bid : F.G - 1 - F.bid); if (u >= NB * 2 * 129) continue;
        const int c = u % 129, bh = u / 129; mixC2_unit(F, l, bh >> 1, bh & 1, c); }
}
__device__ __forceinline__ int mask_pos(int kk) { const int h = (kk >> 2) & 1, i = (kk & 3) + 4 * (kk >> 3); return 16 * (i & 1) + 8 * h + (i >> 1); }
typedef short s16x2v __attribute__((ext_vector_type(2)));
constexpr int IDX_HP = 257;
constexpr int IDX_HIST = 0, IDX_STATS = 32 * IDX_HP * 4, IDX_INFO = IDX_STATS + 2304, IDX_CCNT = IDX_INFO + 256, IDX_MASK = IDX_CCNT + 384, IDX_CAND = IDX_MASK + 65792, IDX_Q = IDX_CAND + 32 * 128 * 4, IDX_QPITCH = 1168, IDX_END = IDX_Q + 32 * IDX_QPITCH;
#ifndef PROBE_REP
#define PROBE_REP 0
#endif
#if PROBE_REP >= 40
#define PTS(v) do { __builtin_amdgcn_sched_barrier(0); v = (unsigned)__builtin_amdgcn_s_memtime(); __builtin_amdgcn_sched_barrier(0); } while (0)
#else
#define PTS(v) do {} while (0)
#endif
#if PROBE_REP >= 40 && PROBE_REP < 60
#define IPTS(v) PTS(v)
#else
#define IPTS(v) do {} while (0)
#endif
constexpr int IDX_CAP = 128, IDX_NBIN = 256, NSUB = 3;
static_assert(IDX_END + LDS_GEN <= LDS_BYTES, "indexer LDS");
static_assert(IDX_NBIN == 256, "idx_bin saturates at 255");
struct KFrag { h8 v[4]; };
struct KSrc { __amdgpu_buffer_rsrc_t rs; unsigned vo; };
__device__ __forceinline__ KFrag idx_load_k(const KSrc& ksrc, unsigned row0_bytes) { KFrag k;
#pragma unroll
    for (int s = 0; s < 4; ++s) k.v[s] = __builtin_bit_cast(h8, __builtin_amdgcn_raw_buffer_load_b128(ksrc.rs, ksrc.vo + 32u * s, row0_bytes, 0));
    return k; }
#define IDX_LOADQ(dst, hd) do { _Pragma("unroll") for (int s_ = 0; s_ < 4; ++s_) dst[s_] = *(const LAS h8*)(qimg_lane + ((hd) * 64 + 16 * s_) * 2); } while (0)
#define IDX_MFMA4(acc, q) do { _Pragma("unroll") for (int s_ = 0; s_ < 4; ++s_) acc = __builtin_amdgcn_mfma_f32_32x32x16_f16(kf.v[s_], q[s_], acc, 0, 0, 0); } while (0)
#define IDX_FMA(hd, S) do { _Pragma("unroll") for (int i_ = 0; i_ < 16; ++i_) sc[i_] = __builtin_fmaf(w[hd], __builtin_fabsf(S[i_]), sc[i_]); } while (0)
#define IDX_SB __builtin_amdgcn_sched_barrier(0)
__device__ __forceinline__ void idx_scores(const LAS unsigned char* qimg_lane, const float (&w)[8], const KFrag& kf, f32x16& sc) {
    h8 q[2][4]; f32x16 S[2];
    IDX_LOADQ(q[0], 8); IDX_SB;
#pragma unroll
    for (int i = 0; i < 16; ++i) sc[i] = 0.f;
    IDX_MFMA4(sc, q[0]); IDX_LOADQ(q[1], 0); IDX_SB;
#pragma unroll
    for (int hd = 0; hd < 8; ++hd) {
#pragma unroll
        for (int i = 0; i < 16; ++i) S[hd & 1][i] = 0.f;
        IDX_MFMA4(S[hd & 1], q[(hd + 1) & 1]);
        if (hd < 7) IDX_LOADQ(q[hd & 1], hd + 1);
        if (hd > 0) IDX_FMA(hd - 1, S[(hd - 1) & 1]);
        IDX_SB;
    }
    IDX_FMA(7, S[1]);
}
#define IDX_PIN(V) asm volatile("" : "+v"(V[0]), "+v"(V[1]), "+v"(V[2]), "+v"(V[3]), "+v"(V[4]), "+v"(V[5]), "+v"(V[6]), "+v"(V[7]), "+v"(V[8]), "+v"(V[9]), "+v"(V[10]), "+v"(V[11]), "+v"(V[12]), "+v"(V[13]), "+v"(V[14]), "+v"(V[15]))
#define IDX_MFMA4K(acc, q, KF) do { _Pragma("unroll") for (int s_ = 0; s_ < 4; ++s_) acc = __builtin_amdgcn_mfma_f32_32x32x16_f16(KF.v[s_], q[s_], acc, 0, 0, 0); } while (0)
#define IDX_FMA2(SC, hd, S) do { _Pragma("unroll") for (int i_ = 0; i_ < 16; ++i_) SC[i_] = __builtin_fmaf(w[hd], __builtin_fabsf(S[i_]), SC[i_]); } while (0)
__device__ __forceinline__ void idx_scores2(const LAS unsigned char* qimg_lane, const float (&w)[8], const KFrag& kfA, const KFrag& kfB, f32x16& scA, f32x16& scB) {
    h8 q[2][4]; f32x16 SA, SB;
    IDX_LOADQ(q[0], 8); IDX_SB;
#pragma unroll
    for (int i = 0; i < 16; ++i) { scA[i] = 0.f; scB[i] = 0.f; }
    IDX_MFMA4K(scA, q[0], kfA); IDX_MFMA4K(scB, q[0], kfB); IDX_LOADQ(q[1], 0); IDX_SB;
#pragma unroll
    for (int hd = 0; hd < 8; ++hd) {
#pragma unroll
        for (int i = 0; i < 16; ++i) SA[i] = 0.f;
        IDX_MFMA4K(SA, q[(hd + 1) & 1], kfA);
        if (hd > 0) { IDX_FMA2(scB, hd - 1, SB); IDX_PIN(scB); }
        IDX_SB;
#pragma unroll
        for (int i = 0; i < 16; ++i) SB[i] = 0.f;
        IDX_MFMA4K(SB, q[(hd + 1) & 1], kfB);
        if (hd < 7) IDX_LOADQ(q[hd & 1], hd + 1);
        IDX_FMA2(scA, hd, SA); IDX_PIN(scA);
        IDX_SB;
    }
    IDX_FMA2(scB, 7, SB);
}
template <int NS> __device__ __forceinline__ void idx_scoresN(const LAS unsigned char* qimg_lane, const float (&w)[8], KFrag (&kf)[NS], const KSrc& ksrc, const unsigned (&nextp)[NS], f32x16 (&sc)[NS]) {
    h8 q[2][4]; f32x16 S[NS];
#if PROBE_REP == 30
    h8 zk = {0, 0, 0, 0, 0, 0, 0, 0}; asm volatile("" : "+v"(zk));
#endif
#if PROBE_REP == 31
    float wz = 0.f; asm volatile("" : "+v"(wz));
#define IDX_FMAZ(SC, S) do { _Pragma("unroll") for (int i_ = 0; i_ < 16; ++i_) SC[i_] = __builtin_fmaf(wz, __builtin_fabsf(S[i_]), SC[i_]); } while (0)
#else
#define IDX_FMAZ(SC, S) do {} while (0)
#endif
    IDX_LOADQ(q[0], 8); IDX_SB;
#pragma unroll
    for (int t = 0; t < NS; ++t) {
#pragma unroll
        for (int i = 0; i < 16; ++i) sc[t][i] = 0.f;
        IDX_MFMA4K(sc[t], q[0], kf[t]); }
    IDX_LOADQ(q[1], 0); IDX_SB;
#pragma unroll
    for (int hd = 0; hd < 8; ++hd) {
#pragma unroll
        for (int t = 0; t < NS; ++t) {
#pragma unroll
            for (int i = 0; i < 16; ++i) S[t][i] = 0.f;
            IDX_MFMA4K(S[t], q[(hd + 1) & 1], kf[t]);
#if PROBE_REP == 30
#pragma unroll
            for (int s_ = 0; s_ < 4; ++s_) S[t] = __builtin_amdgcn_mfma_f32_32x32x16_f16(zk, q[(hd + 1) & 1][s_], S[t], 0, 0, 0);
#endif
            if (t == 0 && hd < 7) IDX_LOADQ(q[hd & 1], hd + 1);
            if (hd == 7) kf[t] = idx_load_k(ksrc, nextp[t]);
            if (t > 0) { IDX_FMA2(sc[t - 1], hd, S[t - 1]); IDX_FMAZ(sc[t - 1], S[t - 1]); IDX_PIN(sc[t - 1]); }
            else if (hd > 0) { IDX_FMA2(sc[NS - 1], hd - 1, S[NS - 1]); IDX_FMAZ(sc[NS - 1], S[NS - 1]); IDX_PIN(sc[NS - 1]); }
            IDX_SB;
        }
    }
    IDX_FMA2(sc[NS - 1], 7, S[NS - 1]);
}
__device__ __forceinline__ int f_ord(float v) { const int i = __float_as_int(v); return i >= 0 ? i : (int)(0x80000000u - (unsigned)i); }
__device__ __forceinline__ float f_unord(int o) { return __int_as_float(o >= 0 ? o : (int)(0x80000000u - (unsigned)o)); }
__device__ __forceinline__ unsigned idx_bin(float sv, float inv, float c0f) { return __builtin_amdgcn_cvt_pk_u8_f32(__builtin_fmaf(sv, inv, c0f), 0u, 0u); }
__device__ __forceinline__ float idx_raw_edge(float B, float inv, float c0f) {
    if (!(B > -3.0e38f)) return -__builtin_inff();
    if (!(B < 3.0e38f)) return __builtin_inff();
    int lo = f_ord(-3.0e38f), hi = f_ord(3.0e38f);
#pragma unroll 1
    for (int it = 0; it < 34; ++it) { const int mid = lo + (int)(((unsigned)hi - (unsigned)lo) >> 1); if ((float)idx_bin(f_unord(mid), inv, c0f) >= B) hi = mid; else lo = mid; }
    return f_unord(hi);
}
#define IDX_ACCBIT(m, s, t) asm("v_cmp_ge_f32 vcc, %1, %2\n\tv_addc_co_u32 %0, vcc, %0, %0, vcc" : "+v"(m) : "v"(s), "v"(t) : "vcc")
__device__ __forceinline__ int suffix_sum(int v, int lane) {
#pragma unroll
    for (int off = 1; off < 64; off <<= 1) { const int t = __builtin_amdgcn_ds_bpermute((lane + off) << 2, v); if (lane + off < 64) v += t; }
    return v;
}
__device__ __forceinline__ void mixA_index_unit(const Frame& F, int b, int g) {
    LAS unsigned char* L = F.lds + LDS_GEN;
    int lane_; { unsigned z0_ = 0u; asm volatile("" : "+s"(z0_)); lane_ = (int)__builtin_amdgcn_mbcnt_hi(~0u, __builtin_amdgcn_mbcnt_lo(~0u, z0_)); asm volatile("" : "+v"(lane_)); }
    int tid_ = F.wave * 64 + lane_; asm volatile("" : "+v"(tid_));
    const int tid = tid_, lane = lane_, wave = F.wave, r = lane & 31, h = lane >> 5;
    const unsigned char* proj = F.ws + WS_PROJ;
    const unsigned char* KI = proj + PJ_KI;
    const int nq = g == 0 ? NMETA : 32;
    const int qrow = g == 0 ? MR + b * NMETA + (r & 15) : b * SEQ + 32 * (g - 1) + r;
    const int tq0 = g == 0 ? 0 : NMETA + 32 * (g - 1);
    const bool qvalid = r < nq;
    auto ks_row0 = [&](int ks) -> int { return ks == 0 ? MR + b * NMETA : b * SEQ + 32 * (ks - 1); };
#if PROBE_REP >= 40 && PROBE_REP < 60
    unsigned accS = 0, accP = 0, accP2 = 0, accNC = 0, accNR = 0, tU0, tx0, tx1, tx2, tx3, tx4, tx5, tx6; IPTS(tU0);
#else
    unsigned tx0, tx1, tx2, tx3, tx4, tx5, tx6;
#endif
    __syncthreads();
    for (int i = tid; i < 32 * IDX_HP; i += NTHREADS) ((LAS unsigned*)(L + IDX_HIST))[i] = 0u;
    if (tid < 32) ((LAS unsigned*)(L + IDX_CCNT))[tid] = 0u;
    for (int i = tid; i < (g + 1) * 32; i += NTHREADS) ((LAS unsigned*)(L + IDX_MASK))[i] = 0u;
    const KSrc ksrc{__builtin_amdgcn_make_buffer_rsrc((void*)KI, 0, 0x7fffffff, 0x00020000), (unsigned)r * 128u + (unsigned)h * 16u};
    auto krow = [&](int ks) -> unsigned { return (unsigned)ks_row0(ks <= g ? ks : g) * 128u; };
    const KFrag kf0 = idx_load_k(ksrc, (unsigned)(b * SEQ + 32 * (wave & 3)) * 128u);
    KFrag kf[NSUB];
#pragma unroll
    for (int u = 0; u < NSUB; ++u) kf[u] = idx_load_k(ksrc, krow(NSUB * wave + u));
    float w[8];
    const LAS unsigned char* qf = L + IDX_Q + r * IDX_QPITCH + 8 * h * 2;
    { const float* WI = (const float*)(proj + PJ_WI) + (size_t)qrow * 8; const f32x4 w0 = *(const f32x4*)WI, w1 = *(const f32x4*)(WI + 4);
      w[0] = w0[0]; w[1] = w0[1]; w[2] = w0[2]; w[3] = w0[3]; w[4] = w1[0]; w[5] = w1[1]; w[6] = w1[2]; w[7] = w1[3]; }
    { const int qq = tid >> 4, dc = tid & 15; const int qr = g == 0 ? MR + b * NMETA + (qq & 15) : b * SEQ + 32 * (g - 1) + qq;
      const unsigned char* qsrc = proj + PJ_QI + (size_t)qr * 1024 + dc * 8; u32x2 qv[8];
#pragma unroll
      for (int hd = 0; hd < 8; ++hd) qv[hd] = *(const u32x2*)(qsrc + hd * 128);
      const float* WQ = (const float*)(proj + PJ_WI) + (size_t)qr * 8; const f32x4 wa = *(const f32x4*)WQ, wb = *(const f32x4*)(WQ + 4);
      const float wq[8] = {wa[0], wa[1], wa[2], wa[3], wb[0], wb[1], wb[2], wb[3]};
      float a4[4] = {0.f, 0.f, 0.f, 0.f};
#pragma unroll
      for (int hd = 0; hd < 8; ++hd) { const h4 q = __builtin_bit_cast(h4, qv[hd]);
#pragma unroll
          for (int e = 0; e < 4; ++e) a4[e] += wq[hd] * (float)q[e];
          *(LAS u32x2*)(L + IDX_Q + qq * IDX_QPITCH + hd * 128 + dc * 8) = qv[hd]; }
      u32x2 o; o.x = cvt_pk_f16(a4[0], a4[1]); o.y = cvt_pk_f16(a4[2], a4[3]);
      *(LAS u32x2*)(L + IDX_Q + qq * IDX_QPITCH + 1024 + dc * 8) = o; }
    __syncthreads();
    if (wave < 4) {
        f32x16 sc; idx_scores(qf, w, kf0, sc);
        float s1 = 0.f, s2 = 0.f;
#pragma unroll
        for (int i = 0; i < 16; ++i) { s1 += sc[i]; s2 += sc[i] * sc[i]; }
        s1 = hsum32(s1, lane); s2 = hsum32(s2, lane);
        if (h == 0) { ((LAS float*)(L + IDX_STATS))[(wave * 32 + r) * 2] = s1; ((LAS float*)(L + IDX_STATS))[(wave * 32 + r) * 2 + 1] = s2; }
    }
    __syncthreads();
    float c0f, inv;
    { float s1 = 0.f, s2 = 0.f;
#pragma unroll
      for (int k = 0; k < 4; ++k) { s1 += ((LAS float*)(L + IDX_STATS))[(k * 32 + r) * 2]; s2 += ((LAS float*)(L + IDX_STATS))[(k * 32 + r) * 2 + 1]; }
      const float mean = s1 * (1.0f / 128.0f), var = fmaxf(s2 * (1.0f / 128.0f) - mean * mean, 0.f), sd = fmaxf(sqrtf(var), 1e-12f);
      inv = (float)IDX_NBIN / (10.0f * sd); c0f = -(mean - 3.0f * sd) * inv; }
    LAS unsigned* hrow = (LAS unsigned*)(L + IDX_HIST) + r * IDX_HP;
    IPTS(tx0);
#if PROBE_REP == 12
    for (int rep12 = 0; rep12 < 2; ++rep12) { __syncthreads(); for (int i = tid; i < 32 * IDX_HP; i += NTHREADS) ((LAS unsigned*)(L + IDX_HIST))[i] = 0u; __syncthreads();
#else
    {
#endif
#pragma unroll 1
        for (int ks = NSUB * wave; ks <= g; ks += 8 * NSUB) {
            unsigned nextp[NSUB];
#pragma unroll
            for (int u = 0; u < NSUB; ++u) nextp[u] = krow((ks + 8 * NSUB <= g ? ks + 8 * NSUB : NSUB * wave) + u);
#if PROBE_REP >= 40 && PROBE_REP < 60
            unsigned tb, tc, td; IPTS(tb);
#endif
            f32x16 scv[NSUB]; __builtin_amdgcn_s_setprio(1); idx_scoresN<NSUB>(qf, w, kf, ksrc, nextp, scv); __builtin_amdgcn_s_setprio(0);
#if PROBE_REP >= 40 && PROBE_REP < 60
            IDX_PIN(scv[NSUB - 1]); IPTS(tc); accS += tc - tb;
#endif
#pragma unroll
            for (int u2 = 0; u2 < NSUB; ++u2) {
                const int kss = ks + u2; if (kss > g) continue;
                if (kss == 0 || kss == g) {
#pragma unroll
                    for (int i = 0; i < 16; ++i) {
                        const int kidx = crow(i, h);
                        const bool ok = qvalid && (kss == 0 ? kidx < NMETA && (g > 0 || kidx <= r) : kidx <= r);
                        if (ok) { const unsigned bin = idx_bin(scv[u2][i], inv, c0f); __hip_atomic_fetch_add(hrow + bin, 1u, __ATOMIC_RELAXED, __HIP_MEMORY_SCOPE_WORKGROUP); }
                    }
                } else {
#pragma unroll
                    for (int m = 0; m < 8; ++m) {
                        const f32x2 sp = {scv[u2][2 * m], scv[u2][2 * m + 1]}, iv = {inv, inv}, cv = {c0f, c0f};
                        const f32x2 xp = __builtin_elementwise_fma(sp, iv, cv);
                        __hip_atomic_fetch_add(hrow + __builtin_amdgcn_cvt_pk_u8_f32(xp.x, 0u, 0u), 1u, __ATOMIC_RELAXED, __HIP_MEMORY_SCOPE_WORKGROUP);
                        __hip_atomic_fetch_add(hrow + __builtin_amdgcn_cvt_pk_u8_f32(xp.y, 0u, 0u), 1u, __ATOMIC_RELAXED, __HIP_MEMORY_SCOPE_WORKGROUP); }
                }
            }
#if PROBE_REP >= 40 && PROBE_REP < 60
            IPTS(td); accP += td - tc;
#endif
        }
    }
    IPTS(tx1);
    __syncthreads();
    IPTS(tx2);
#pragma unroll 1
    for (int k = 0; k < 4; ++k) {
        const int row = 4 * wave + k;
        const LAS unsigned* hr = (const LAS unsigned*)(L + IDX_HIST) + row * IDX_HP + 4 * lane;
        const int c0 = (int)hr[0], c1 = (int)hr[1], c2 = (int)hr[2], c3 = (int)hr[3];
        const int SL = suffix_sum((c0 + c1) + (c2 + c3), lane), NT = __builtin_amdgcn_readlane(SL, 0);
        int bstar = -1, need = 0;
        if (NT > 256) {
            const unsigned long long ml = __ballot(SL >= 256); const int lL = 63 - __builtin_clzll(ml); const int sl = __builtin_amdgcn_readlane(SL, lL);
            const int t0 = __builtin_amdgcn_readlane(c0, lL), t1 = __builtin_amdgcn_readlane(c1, lL), t2 = __builtin_amdgcn_readlane(c2, lL), t3 = __builtin_amdgcn_readlane(c3, lL);
            int above = sl - ((t0 + t1) + (t2 + t3));
            if (above + t3 >= 256) bstar = 4 * lL + 3;
            else { above += t3; if (above + t2 >= 256) bstar = 4 * lL + 2; else { above += t2; if (above + t1 >= 256) bstar = 4 * lL + 1; else { above += t1; bstar = 4 * lL; } } }
            need = 256 - above;
        }
        if (lane == 0) { ((LAS int*)(L + IDX_INFO))[row * 2] = bstar; ((LAS int*)(L + IDX_INFO))[row * 2 + 1] = need; }
    }
    __syncthreads();
    float lo_f, hi_f;
    { const int bstar = ((LAS int*)(L + IDX_INFO))[r * 2];
      hi_f = bstar < 0 ? -__builtin_inff() : (bstar >= IDX_NBIN - 1 ? __builtin_inff() : (float)(bstar + 1));
      lo_f = bstar <= 0 ? -__builtin_inff() : (float)bstar; }
    const float hi_raw = idx_raw_edge(hi_f, inv, c0f), lo_raw = idx_raw_edge(lo_f, inv, c0f);
    const float lo_base = lo_raw > -3.0e38f ? __builtin_fmaf(lo_raw, inv, c0f) : (hi_raw < 3.0e38f ? __builtin_fmaf(hi_raw, inv, c0f) - 1.0f : 0.f);
    auto append = [&](float sv, int kb, int ci) {
        const unsigned slot = __hip_atomic_fetch_add((LAS unsigned*)(L + IDX_CCNT) + r, 1u, __ATOMIC_RELAXED, __HIP_MEMORY_SCOPE_WORKGROUP);
        if (slot < IDX_CAP) { const float fr = (__builtin_fmaf(sv, inv, c0f) - lo_base) * 131072.0f; const unsigned q = (unsigned)__builtin_amdgcn_fmed3f(fr, 0.f, 131071.0f);
            asm volatile("" : "+v"(kb));
            ((LAS unsigned*)(L + IDX_CAND))[r * IDX_CAP + slot] = (q << 15) | (unsigned)(kb - ci); } };
    {
#pragma unroll 1
        for (int ks = NSUB * wave; ks <= g; ks += 8 * NSUB) {
            unsigned nextp[NSUB];
#pragma unroll
            for (int u = 0; u < NSUB; ++u) nextp[u] = krow((ks + 8 * NSUB <= g ? ks + 8 * NSUB : NSUB * wave) + u);
#if PROBE_REP >= 40 && PROBE_REP < 60
            unsigned tb, tc, td; IPTS(tb);
#endif
            f32x16 scv[NSUB]; __builtin_amdgcn_s_setprio(1); idx_scoresN<NSUB>(qf, w, kf, ksrc, nextp, scv); __builtin_amdgcn_s_setprio(0);
#if PROBE_REP >= 40 && PROBE_REP < 60
            IDX_PIN(scv[NSUB - 1]); IPTS(tc); accS += tc - tb;
#endif
#pragma unroll
            for (int u2 = 0; u2 < NSUB; ++u2) {
                const int kss = ks + u2; if (kss > g) continue;
                unsigned part = 0u;
                if (kss == 0 || kss == g) {
#pragma unroll
                    for (int i = 0; i < 16; ++i) {
                        const int kidx = crow(i, h);
                        const bool ok = qvalid && (kss == 0 ? kidx < NMETA && (g > 0 || kidx <= r) : kidx <= r);
                        const bool ghi = scv[u2][i] >= hi_raw, glo = scv[u2][i] >= lo_raw;
                        part |= (ok && ghi) ? ((1u << (16 * (i & 1) + (i >> 1))) << (8 * h)) : 0u;
                        if (ok && glo && !ghi) append(scv[u2][i], 32767 - kss * 32 - 4 * h, (i & 3) + 8 * (i >> 2));
                    }
                } else {
                    unsigned mhe = 0u, mho = 0u;
#pragma unroll
                    for (int m = 7; m >= 0; --m) {
#pragma unroll
                        for (int e = 0; e < 2; ++e) {
                            const int i = 2 * m + e;
                            const bool below = scv[u2][i] < hi_raw;
                            const unsigned long long bh = __ballot(below);
                            { unsigned long long co_; if (e == 0) asm("v_addc_co_u32 %0, %1, %0, %0, %2" : "+v"(mhe), "=s"(co_) : "s"(bh)); else asm("v_addc_co_u32 %0, %1, %0, %0, %2" : "+v"(mho), "=s"(co_) : "s"(bh)); }
                            if (below && scv[u2][i] >= lo_raw) append(scv[u2][i], 32767 - kss * 32 - 4 * h, (i & 3) + 8 * (i >> 2));
                        }
                    }
                    part = ((mhe | (mho << 16)) ^ 0x00FF00FFu) << (8 * h);
                }
                __hip_atomic_fetch_or((LAS unsigned*)(L + IDX_MASK) + kss * 32 + r, part, __ATOMIC_RELAXED, __HIP_MEMORY_SCOPE_WORKGROUP);
            }
#if PROBE_REP >= 40 && PROBE_REP < 60
            IPTS(td); accP2 += td - tc;
#endif
        }
    }
    IPTS(tx3);
    __syncthreads();
    IPTS(tx4);
    __builtin_amdgcn_s_setprio(0);
#pragma unroll 1
    for (int k = 0; k < 4; ++k) {
        const int row = 4 * wave + k;
        const int need = ((LAS int*)(L + IDX_INFO))[row * 2 + 1];
        int nc = (int)((LAS unsigned*)(L + IDX_CCNT))[row]; nc = nc < IDX_CAP ? nc : IDX_CAP;
        nc = __builtin_amdgcn_readfirstlane(nc);
#if PROBE_REP == 48
        accNC += (unsigned)nc; accNR += 128u;
#endif
        if (nc == 0) continue;
        const LAS unsigned* cb = (const LAS unsigned*)(L + IDX_CAND) + row * IDX_CAP;
        const bool v0 = lane < nc, v1 = lane + 64 < nc;
        const unsigned c0 = v0 ? cb[lane] : 0u, c1 = v1 ? cb[lane + 64] : 0u;
        int r0 = 0, r1 = 0;
        if (__builtin_amdgcn_readfirstlane(need) < nc) {
            const int n0 = nc < 64 ? nc : 64;
#pragma unroll 1
            for (int j = 0; j < n0; ++j) { const unsigned cj = (unsigned)__builtin_amdgcn_readlane((int)c0, j); r0 += cj > c0 ? 1 : 0; r1 += cj > c1 ? 1 : 0; }
#pragma unroll 1
            for (int j = 64; j < nc; ++j) { const unsigned cj = (unsigned)__builtin_amdgcn_readlane((int)c1, j - 64); r0 += cj > c0 ? 1 : 0; r1 += cj > c1 ? 1 : 0; }
        }
        const int k0 = 32767 - (int)(c0 & 32767u), k1 = 32767 - (int)(c1 & 32767u);
        if (v0 && r0 < need) __hip_atomic_fetch_or((LAS unsigned*)(L + IDX_MASK) + (k0 >> 5) * 32 + row, 1u << mask_pos(k0 & 31), __ATOMIC_RELAXED, __HIP_MEMORY_SCOPE_WORKGROUP);
        if (v1 && r1 < need) __hip_atomic_fetch_or((LAS unsigned*)(L + IDX_MASK) + (k1 >> 5) * 32 + row, 1u << mask_pos(k1 & 31), __ATOMIC_RELAXED, __HIP_MEMORY_SCOPE_WORKGROUP);
    }
    IPTS(tx5);
    __syncthreads();
    IPTS(tx6);
    unsigned* MK = (unsigned*)(F.ws + WS_MASK) + (size_t)b * NKS * TLEN;
    for (int i = tid; i < (g + 1) * 32; i += NTHREADS) { const int ks = i >> 5, rr = i & 31; if (rr < nq) MK[(size_t)ks * TLEN + tq0 + rr] = ((LAS unsigned*)(L + IDX_MASK))[i]; }
#if PROBE_REP >= 40 && PROBE_REP < 60
    { unsigned tU1; IPTS(tU1); if (lane == 0) { unsigned long long* pc = (unsigned long long*)(F.ws + WS_CTL) + 4096;
        const unsigned vals[12] = {tx0 - tU0, accS, accP, tU1 - tU0, accP2, tx2 - tx1, tx4 - tx3, tU1 - tx4, accNC, tx5 - tx4, tx6 - tx5, tU1 - tx6};
        atomicAdd(pc + (PROBE_REP - 40), (unsigned long long)vals[PROBE_REP - 40]); atomicAdd(pc + 3, (unsigned long long)(PROBE_REP == 48 ? accNR : tU1 - tU0)); } }
#endif
}
__device__ __forceinline__ void mixA_index_phase(const Frame& F) {
#pragma unroll 1
    for (int c = F.bid; c < 256; c += F.G) {
#pragma unroll 1
        for (int k = 0; k < 5; ++k) {
            int u; if (k == 0) u = c; else if (k == 1) u = 511 - c; else if (k == 2) u = 512 + c; else if (k == 3) u = 1023 - c; else { if (c >= 2) break; u = 1024 + c; }
            mixA_index_unit(F, u & 1, 512 - (u >> 1));
        }
    }
}

__device__ __forceinline__ void mixA3_unit(const Frame& F, int l, int b, int ha, int qblk) {
    LAS unsigned char* L = F.lds + LDS_GEN;
    int lane_; { unsigned z0_ = 0u; asm volatile("" : "+s"(z0_)); lane_ = (int)__builtin_amdgcn_mbcnt_hi(~0u, __builtin_amdgcn_mbcnt_lo(~0u, z0_)); asm volatile("" : "+v"(lane_)); }
    const int lane = lane_, wave = F.wave, tid = wave * 64 + lane, r = lane & 31, h = lane >> 5;
    const unsigned char* proj = F.ws + WS_PROJ;
    const _Float16* QA = (const _Float16*)(proj + PJ_QA); const unsigned char* KA = proj + PJ_KA; const unsigned char* VA = proj + PJ_VA;
    const unsigned* kmax = (const unsigned*)(F.ws + WS_CTL) + CW_KMAX + 32 * l;
    const unsigned* MK = (const unsigned*)(F.ws + WS_MASK) + (size_t)b * NKS * TLEN;
    const bool meta_u = qblk < 0;
    const int qrow0 = meta_u ? MR + b * NMETA : b * SEQ + qblk * 256;
    const int qpos0 = meta_u ? 0 : NMETA + qblk * 256;
    const int nreal = meta_u ? 0 : 2 * qblk + 2;
    const int wq0 = 32 * wave;
    const bool wave_on = meta_u ? (wave == 0) : true;
    const int my_row = wave_on ? qrow0 + wq0 + r : qrow0, my_pos = wave_on ? qpos0 + wq0 + r : 0;
    __syncthreads();
    if (tid < 128) ((LAS float*)(L + B_LUT))[tid] = F.rel_bias[BUCKET_LUT[tid] * 12 + ha] * LOG2E;
    float bmax = (lane < 32) ? F.rel_bias[lane * 12 + ha] * LOG2E : -1e30f;
    bmax = fmaxf(bmax, sx<16>(bmax, lane)); bmax = fmaxf(bmax, sx<8>(bmax, lane)); bmax = fmaxf(bmax, sx<4>(bmax, lane)); bmax = fmaxf(bmax, sx<2>(bmax, lane)); bmax = fmaxf(bmax, sx<1>(bmax, lane));
    bmax = bcast0(bmax);
    const float bfar = F.rel_bias[31 * 12 + ha] * LOG2E;
    h8 qf[4]; float mref; bool safe;
    { float n2 = 0.f;
#pragma unroll
      for (int s = 0; s < 4; ++s) { qf[s] = *(const h8*)(QA + (size_t)my_row * 512 + ha * 64 + 16 * s + 8 * h);
#pragma unroll
          for (int j = 0; j < 8; ++j) { const float v = (float)qf[s][j]; n2 += v * v; } }
      n2 = hsum32(n2, lane);
      mref = sqrtf(n2 * (__uint_as_float(kmax[ha * 2]) + __uint_as_float(kmax[ha * 2 + 1]))) * 1.002f + bmax;
      safe = __all(mref - bfar < 60.0f); if (safe) mref = bfar; }
    f32x16 O[2], Lacc;
#if PROBE_REP >= 60 && PROBE_REP < 70
    unsigned a3C = 0, a3S = 0, a3W = 0, a3t0, a3t1, a3t2, a3t3, a3U0; PTS(a3U0);
#endif
#pragma unroll
    for (int i = 0; i < 16; ++i) { O[0][i] = 0.f; O[1][i] = 0.f; Lacc[i] = 0.f; }
    bf16x8v ones; { const u32x4 o = {0x3F803F80u, 0x3F803F80u, 0x3F803F80u, 0x3F803F80u}; ones = __builtin_bit_cast(bf16x8v, o); }
    const int skey = tid >> 3, sch = tid & 7;
    const auto rsKV = __builtin_amdgcn_make_buffer_rsrc((void*)(KA + ha * 128), 0, 0x7fffffff, 0x00020000);
    const auto rsM = __builtin_amdgcn_make_buffer_rsrc((void*)MK, 0, 0x7fffffff, 0x00020000);
    const unsigned kvo0 = (unsigned)skey * 1024u + (unsigned)sch * 16u, kvo1 = kvo0 + 64u * 1024u, mo = (unsigned)my_pos * 4u;
    const unsigned kdst = skey * KS_PITCH + sch * 16, vdst = (sch >> 2) * (TK * 64) + skey * 64 + (sch & 3) * 16;
    const int ntiles = 1 + nreal;
    auto tile_row0 = [&](int t) -> int { return t == 0 ? MR + b * NMETA : b * SEQ + (t - 1) * TK; };
    u32x4 kreg[2], vreg[2];
#pragma unroll
    for (int j = 0; j < 2; ++j) { const unsigned so = (unsigned)tile_row0(0) * 1024u; kreg[j] = __builtin_amdgcn_raw_buffer_load_b128(rsKV, j ? kvo1 : kvo0, so, 0); vreg[j] = __builtin_amdgcn_raw_buffer_load_b128(rsKV, j ? kvo1 : kvo0, so + (unsigned)(PJ_VA - PJ_KA), 0); }
#pragma unroll
    for (int j = 0; j < 2; ++j) { *(LAS u32x4*)(L + B_KS + kdst + j * 64 * KS_PITCH) = kreg[j]; *(LAS u32x4*)(L + B_VS + vdst + j * 64 * 64) = vreg[j]; }
    if (ntiles > 1) {
#pragma unroll
        for (int j = 0; j < 2; ++j) { const unsigned so = (unsigned)tile_row0(1) * 1024u; kreg[j] = __builtin_amdgcn_raw_buffer_load_b128(rsKV, j ? kvo1 : kvo0, so, 0); vreg[j] = __builtin_amdgcn_raw_buffer_load_b128(rsKV, j ? kvo1 : kvo0, so + (unsigned)(PJ_VA - PJ_KA), 0); }
#pragma unroll
        for (int j = 0; j < 2; ++j) { *(LAS u32x4*)(L + B_KS + KBUF + kdst + j * 64 * KS_PITCH) = kreg[j]; *(LAS u32x4*)(L + B_VS + VBUF + vdst + j * 64 * 64) = vreg[j]; }
    }
    __syncthreads();
    unsigned mw[4], mwn[4] = {0u, 0u, 0u, 0u};
    mw[0] = MK[my_pos]; mw[1] = 0u; mw[2] = 0u; mw[3] = 0u;
    const int wpos0 = qpos0 + wq0;
    asm volatile("" : "+v"(mw[0]));
    if (wave >= 4) __builtin_amdgcn_s_setprio(1);
#pragma unroll 1
    for (int t = 0; t < ntiles; ++t) {
        const int buf = t & 3;
        if (STAGGER > 0 && wave >= 4 && (t & 1) == 0) __builtin_amdgcn_s_sleep(STAGGER);
        if (t + 2 < ntiles) {
#pragma unroll
            for (int j = 0; j < 2; ++j) { const unsigned so = (unsigned)tile_row0(t + 2) * 1024u; kreg[j] = __builtin_amdgcn_raw_buffer_load_b128(rsKV, j ? kvo1 : kvo0, so, 0); vreg[j] = __builtin_amdgcn_raw_buffer_load_b128(rsKV, j ? kvo1 : kvo0, so + (unsigned)(PJ_VA - PJ_KA), 0); } }
        if (t + 1 < ntiles) {
#pragma unroll
            for (int j = 0; j < 4; ++j) mwn[j] = __builtin_amdgcn_raw_buffer_load_b32(rsM, mo, (unsigned)(1 + 4 * t + j) * (unsigned)(TLEN * 4), 0); }
        const int kpos0 = (t == 0) ? 0 : NMETA + (t - 1) * TK, nvalid = (t == 0) ? NMETA : TK;
#if PROBE_REP >= 60 && PROBE_REP < 70
        PTS(a3t0);
#endif
        if (wave_on && kpos0 <= wpos0 + 31) {
            LAS unsigned char* Kb = L + B_KS + buf * KBUF; LAS unsigned char* Vb = L + B_VS + buf * VBUF;
#pragma unroll
            for (int sub = 0; sub < 4; ++sub) {
                if (sub * 32 >= nvalid || kpos0 + sub * 32 > wpos0 + 31) continue;
                const bool slow = !safe || (t == 0) || (kpos0 + sub * 32 + 31 > wpos0 - 128);
                const unsigned mword = mw[sub] >> (8 * h);
                f32x16 S;
                h8 kfr[4]; bf16x8v vfr[2][2];
#pragma unroll
                for (int s = 0; s < 4; ++s) kfr[s] = *(const LAS h8*)(Kb + (sub * 32 + r) * KS_PITCH + (16 * s + 8 * h) * 2);
#pragma unroll
                for (int d = 0; d < 2; ++d)
#pragma unroll
                    for (int s = 0; s < 2; ++s) vfr[d][s] = vt_frag(Vb, d, sub * 32, s, lane);
                __builtin_amdgcn_sched_barrier(0);
#pragma unroll
                for (int i = 0; i < 16; ++i) S[i] = 0.f;
#pragma unroll
                for (int s = 0; s < 4; ++s) S = __builtin_amdgcn_mfma_f32_32x32x16_f16(kfr[s], qf[s], S, 0, 0, 0);
                bf16x8v pf[2];
                if (slow) {
                    float bs[16];
#pragma unroll
                    for (int i = 0; i < 16; ++i) { const int dist = my_pos - (kpos0 + sub * 32 + crow(i, h)); bs[i] = ((const LAS float*)(L + B_LUT))[min(max(dist, 0), 127)]; }
#pragma unroll
                    for (int i = 0; i < 16; ++i) {
                        const int kidx = sub * 32 + crow(i, h), dist = my_pos - (kpos0 + kidx);
                        const bool ok = ((mword >> (16 * (i & 1) + (i >> 1))) & 1u) != 0u && dist >= 0 && kidx < nvalid;
                        const float e = __builtin_amdgcn_exp2f(fminf(S[i] + (bs[i] - mref), 80.f));
                        S[i] = ok ? e : 0.f;
                    }
                    pf[0] = pack_p(S, 0); pf[1] = pack_p(S, 1);
                } else {
#pragma unroll
                    for (int i = 0; i < 16; ++i) S[i] = __builtin_amdgcn_exp2f(S[i]);
                    u32x4 pw[2];
#pragma unroll
                    for (int m = 0; m < 8; ++m) {
                        const s16x2v t2 = __builtin_bit_cast(s16x2v, mword << (15 - m));
                        const unsigned pm = __builtin_bit_cast(unsigned, t2 >> (s16x2v){15, 15});
                        pw[m >> 2][m & 3] = cvt_pk_bf16(S[2 * m], S[2 * m + 1]) & pm; }
                    pf[0] = __builtin_bit_cast(bf16x8v, pw[0]); pf[1] = __builtin_bit_cast(bf16x8v, pw[1]);
                }
#pragma unroll
                for (int s = 0; s < 2; ++s) { Lacc = __builtin_amdgcn_mfma_f32_32x32x16_bf16(ones, pf[s], Lacc, 0, 0, 0);
#pragma unroll
                    for (int d = 0; d < 2; ++d) O[d] = __builtin_amdgcn_mfma_f32_32x32x16_bf16(vfr[d][s], pf[s], O[d], 0, 0, 0); }
            }
        }
#if PROBE_REP >= 60 && PROBE_REP < 70
        asm volatile("" : "+v"(O[0][0]), "+v"(O[1][0]), "+v"(Lacc[0])); PTS(a3t1);
#endif
        if (t + 2 < ntiles) {
#pragma unroll
            for (int j = 0; j < 2; ++j) { *(LAS u32x4*)(L + B_KS + (buf ^ 2) * KBUF + kdst + j * 64 * KS_PITCH) = kreg[j]; *(LAS u32x4*)(L + B_VS + (buf ^ 2) * VBUF + vdst + j * 64 * 64) = vreg[j]; } }
#pragma unroll
        for (int j = 0; j < 4; ++j) mw[j] = mwn[j];
        asm volatile("" : "+v"(mw[0]), "+v"(mw[1]), "+v"(mw[2]), "+v"(mw[3]));
#if PROBE_REP >= 60 && PROBE_REP < 70
        PTS(a3t2);
#endif
        if (t & 1) { if (STAGGER > 0 && wave < 4) __builtin_amdgcn_s_sleep(STAGGER); __syncthreads(); }
#if PROBE_REP >= 60 && PROBE_REP < 70
        PTS(a3t3); a3C += a3t1 - a3t0; a3S += a3t2 - a3t1; a3W += a3t3 - a3t2;
#endif
    }
#if PROBE_REP >= 60 && PROBE_REP < 70
    { unsigned a3U1; PTS(a3U1); if (lane == 0) { unsigned long long* pc = (unsigned long long*)(F.ws + WS_CTL) + 4096;
        const unsigned vals[4] = {a3C, a3S, a3W, a3U1 - a3U0};
        atomicAdd(pc + (PROBE_REP - 40), (unsigned long long)vals[PROBE_REP - 60]); atomicAdd(pc + 23, (unsigned long long)(a3U1 - a3U0)); } }
#endif
    __builtin_amdgcn_s_setprio(0);
    if (wave_on) {
        const float il = 1.0f / Lacc[0];
        if (!meta_u || r < NMETA) {
            _Float16* dst = (_Float16*)(F.ws + WS_ABUF) + (size_t)my_row * DM + ha * 64;
#pragma unroll
            for (int d = 0; d < 2; ++d)
#pragma unroll
                for (int g4 = 0; g4 < 4; ++g4) { const int d0 = 32 * d + 8 * g4 + 4 * h;
                    u32x2 w; w.x = cvt_pk_f16(O[d][4 * g4 + 0] * il, O[d][4 * g4 + 1] * il); w.y = cvt_pk_f16(O[d][4 * g4 + 2] * il, O[d][4 * g4 + 3] * il);
                    *(u32x2*)(dst + d0) = w; }
        }
    }
}
__device__ __forceinline__ void mixA3_phase(const Frame& F, int l) {
#pragma unroll 1
    for (int c = F.bid; c < 256; c += F.G) { const int bh = c & 15, i1 = c >> 4, i2 = 31 - i1;
#pragma unroll 1
        for (int k = 0; k < 5; ++k) { if (k == 4 && c >= 16) break;
            const int qb = k == 0 ? 63 - i1 : (k == 1 ? 32 + i1 : (k == 2 ? i2 : (k == 3 ? i1 : -1)));
            mixA3_unit(F, l, bh >> 3, bh & 7, qb); }
    }
}
constexpr int NPHASES = 19;
__global__ void __launch_bounds__(NTHREADS, 2) fwd(Args args) {
    extern __shared__ __attribute__((aligned(16))) unsigned char lds_raw[];
    Frame F;
    F.x = args.in[0]; F.meta = args.in[1]; F.rel_bias = args.in[2]; F.w_in = args.in[3]; F.norm_mix = args.in[4]; F.diff_lambda = args.in[5]; F.diff_norm = args.in[6];
    F.ret_norm = args.in[7]; F.w_out = args.in[8]; F.norm_ff = args.in[9]; F.w_ff1 = args.in[10]; F.w_ff2 = args.in[11]; F.final_norm = args.in[12];
    F.out = args.out; F.ws = args.ws; F.lds = (LAS unsigned char*)lds_raw;
    F.bid = blockIdx.x; F.G = gridDim.x; F.tid = threadIdx.x; F.lane = F.tid & 63; F.wave = __builtin_amdgcn_readfirstlane(F.tid >> 6);
    if (F.tid < 64) ((LAS unsigned*)(F.lds + LDS_MISC))[F.tid] = 0u;
    __syncthreads();
    unsigned* ctl = (unsigned*)(F.ws + WS_CTL);
    XcdBarrier bar = xcd_barrier_post(ctl + CW_BAR, (volatile LAS unsigned*)(F.lds + LDS_MISC));
    const int lo = args.ph_lo, hi = args.ph_hi;
#define IN(k) (lo <= (k) && (k) < hi)
#ifndef PROBE_REP
#define PROBE_REP 0
#endif
#define RETID() do { unsigned z0_ = 0u; asm volatile("" : "+s"(z0_)); int t_ = (int)__builtin_amdgcn_mbcnt_hi(~0u, __builtin_amdgcn_mbcnt_lo(~0u, z0_)); asm volatile("" : "+v"(t_)); F.lane = t_; F.tid = F.wave * 64 + t_; } while (0)
#define REP(k) _Pragma("unroll 1") for (int rep_ = 0; rep_ < ((PROBE_REP == (k)) ? 2 : 1); ++rep_)
#define SEAM(k) do { if (IN(k) && IN((k) + 1)) xcd_barrier(bar, F.wave == 0 && F.lane == 0); } while (0)
    LAS unsigned char* stage = F.lds + LDS_GEN;
    if (IN(0)) { REP(10) prologue(F); SEAM(0);
#if PROBE_REP == 20
        for (int xb = 0; xb < 20; ++xb) xcd_barrier(bar, F.wave == 0 && F.lane == 0);
#endif
    }
#pragma unroll 1
    for (int l = 0; l < DEPTH; ++l) {
        const int pb = 1 + 9 * l;
        { RETID();
          size_t z_ = 0; int b_ = blockIdx.x, g_ = gridDim.x; asm volatile("" : "+s"(z_), "+s"(b_), "+s"(g_)); F.ws = args.ws + z_; F.out = args.out + z_; F.bid = b_; F.G = g_; }
        unsigned char* wl = F.ws + WS_W + (size_t)l * W_LAYER;
        unsigned char* proj = F.ws + WS_PROJ;
        if (IN(pb + 0)) {
            pg8::Gemm g{(const pg8::bf16_t*)(F.ws + WS_ABUF), (const pg8::bf16_t*)(wl + W_IN_OFF), MP, NPAD, DM}; pg8::StaticOrder S; S.init(MP, NPAD, F.G, F.bid);
            EpiInProj E{proj, (const f32x2*)(F.ws + WS_ROPE), ctl + CW_KMAX + 32 * l};
            pg8::gemm_phase<EpiInProj, pg8::StaticOrder, true, true>(stage, g, S, E, F.tid);
#if PROBE_REP == 7
            RETID(); pg8::gemm_phase<EpiInProj, pg8::StaticOrder, true, true>(stage, g, S, E, F.tid);
#endif
            SEAM(pb + 0);
        }
        if (IN(pb + 1)) { RETID(); REP(1) mixA_index_phase(F); RETID(); REP(2) mixC1_phase(F); SEAM(pb + 1); }
        if (IN(pb + 2)) { RETID(); REP(3) mixC_scan(F); RETID(); REP(4) mixB_phase(F, l); SEAM(pb + 2); }
        if (IN(pb + 3)) { RETID(); REP(5) mixA3_phase(F, l); RETID(); REP(6) mixC2_phase(F, l); SEAM(pb + 3); }
        if (IN(pb + 4)) { RETID();
            skinny_meta<0>(F, wl); RETID();
            pg8::Gemm g{(const pg8::bf16_t*)(F.ws + WS_ABUF), (const pg8::bf16_t*)(wl + W_OUT_OFF), MR, DM, DM}; pg8::StaticOrder S; S.init(MR, DM, F.G, F.bid);
            EpiRes E{l == 0 ? F.x : F.out, F.out, (float*)(F.ws + WS_HMETA)};
            pg8::gemm_phase<EpiRes, pg8::StaticOrder, true, true>(stage, g, S, E, F.tid);
            SEAM(pb + 4);
        }
        if (IN(pb + 5)) { RETID(); zero_scr(F); REP(8) norm_to_abuf<1>(F, F.norm_ff + (size_t)l * DM); SEAM(pb + 5); }
        if (IN(pb + 6)) { RETID();
            skinny_meta<1>(F, wl); RETID();
            pg8::Gemm g{(const pg8::bf16_t*)(F.ws + WS_ABUF), (const pg8::bf16_t*)(wl + W_FF1_OFF), MR, DFF, DM}; pg8::StaticOrder S; S.init(MR, DFF, F.G, F.bid);
            EpiRelu2 E{proj};
            pg8::gemm_phase<EpiRelu2, pg8::StaticOrder, true, true>(stage, g, S, E, F.tid);
#if PROBE_REP == 9
            RETID(); pg8::gemm_phase<EpiRelu2, pg8::StaticOrder, true, true>(stage, g, S, E, F.tid);
#endif
            SEAM(pb + 6);
        }
        if (IN(pb + 7)) { RETID();
            skinny_meta<2>(F, wl); RETID();
            pg8::Gemm g{(const pg8::bf16_t*)proj, (const pg8::bf16_t*)(wl + W_FF2_OFF), MR, DM, DFF}; pg8::StaticOrder S; S.init(MR, DM, F.G, F.bid);
            EpiRes E{F.out, F.out, (float*)(F.ws + WS_HMETA)};
#if PROBE_REP == 14
            { EpiRes E2{F.out, (float*)(F.ws + WS_ABUF), (float*)(F.ws + WS_U)}; pg8::gemm_phase<EpiRes, pg8::StaticOrder, true, true>(stage, g, S, E2, F.tid); RETID(); }
#endif
            pg8::gemm_phase<EpiRes, pg8::StaticOrder, true, true>(stage, g, S, E, F.tid);
            SEAM(pb + 7);
        }
        if (IN(pb + 8)) { RETID();
            if (l + 1 < DEPTH) { norm_to_abuf<1>(F, F.norm_mix + (size_t)(l + 1) * DM); SEAM(pb + 8); }
            else final_norm(F);
        }
    }
#if PROBE_REP >= 40
    RETID(); if (blockIdx.x == 0 && F.tid == 0) {
        const unsigned long long* pc = (const unsigned long long*)(args.ws + WS_CTL) + 4096;
        const unsigned long long vx = __hip_atomic_load(pc + (PROBE_REP - 40), __ATOMIC_RELAXED, __HIP_MEMORY_SCOPE_AGENT), vt = __hip_atomic_load(pc + (PROBE_REP < 60 ? 3 : (PROBE_REP < 70 ? 23 : 33)), __ATOMIC_RELAXED, __HIP_MEMORY_SCOPE_AGENT);
        const unsigned long long ticks = (unsigned long long)((float)vx / (float)vt * 1.0e6f);
        const unsigned long long t0 = __builtin_amdgcn_s_memrealtime();
        while (__builtin_amdgcn_s_memrealtime() - t0 < ticks) __builtin_amdgcn_s_sleep(16);
    }
#endif
#undef IN
#undef SEAM
}

#ifndef MK_SPLIT
#define MK_SPLIT 0
#endif
extern "C" void kernel_launch(void* const* d_in, const int* in_sizes, int n_in, void* d_out, int out_size, void* d_ws, size_t ws_size, hipStream_t stream) {
    static int grid = 0;
    if (grid == 0) {
        if (n_in != 13 || ws_size < WS_END) { fprintf(stderr, "kernel_launch: need 13 inputs and %zu bytes of workspace; got %d, %zu\n", (size_t)WS_END, n_in, ws_size); grid = -1; return; }
        int dev = 0, cus = 0, per_cu = 0;
        if (hipGetDevice(&dev) != hipSuccess || hipDeviceGetAttribute(&cus, hipDeviceAttributeMultiprocessorCount, dev) != hipSuccess) { grid = -1; return; }
        if (hipFuncSetAttribute((const void*)fwd, hipFuncAttributeMaxDynamicSharedMemorySize, LDS_BYTES) != hipSuccess) { fprintf(stderr, "kernel_launch: hipFuncSetAttribute failed\n"); grid = -1; return; }
        if (hipOccupancyMaxActiveBlocksPerMultiprocessor(&per_cu, (const void*)fwd, NTHREADS, LDS_BYTES) != hipSuccess || per_cu < 1) { fprintf(stderr, "kernel_launch: occupancy query says %d\n", per_cu); }
        (void)hipGetLastError();
        grid = cus;
    }
    if (grid < 0) return;
    (void)hipMemsetAsync((char*)d_ws + WS_CTL, 0, CTL_BYTES, stream);
    Args a{};
    for (int i = 0; i < 13; ++i) a.in[i] = (const float*)d_in[i];
    a.out = (float*)d_out; a.ws = (unsigned char*)d_ws;
#if MK_SPLIT
    for (int p = 0; p < NPHASES; ++p) { a.ph_lo = p; a.ph_hi = p + 1; hipLaunchKernelGGL(fwd, dim3(grid), dim3(NTHREADS), LDS_BYTES, stream, a); }
#else
    a.ph_lo = 0; a.ph_hi = NPHASES; hipLaunchKernelGGL(fwd, dim3(grid), dim3(NTHREADS), LDS_BYTES, stream, a);
#endif
}
```
